# Optimizing an MI355X kernel written in HIP

```python
import jax, jax.numpy as jnp
from jax import lax
import numpy as np

D_MODEL = 2048
BATCH = 2
SEQ = 8192
DEPTH = 4
DEC_BATCH = 16
DEC_SEQ = 16
PAST_LEN = 1024

CHUNK = 64
N_LEFT_CHUNKS = 8
WINDOW = N_LEFT_CHUNKS * CHUNK
BAND = (N_LEFT_CHUNKS + 1) * CHUNK
N_HEADS = 16
HEAD_DIM = D_MODEL // N_HEADS
MAX_REL = 128
N_REL = 2 * MAX_REL + 1
D_FF = -(-8 * D_MODEL // (3 * 256)) * 256
Q_BLOCK = 128
N_A_LAYERS = (DEPTH + 1) // 2
N_B_LAYERS = DEPTH // 2
FORGET_BIAS_INIT = 3.0
EPS = 1e-6
SCALE = HEAD_DIM ** -0.5
NEG = -1e30

kernel_name = "hybrid_chunkband_fox_stream_step"


def rms_norm(x, g):
    xf = x.astype(jnp.float32)
    y = xf * lax.rsqrt(jnp.mean(xf * xf, axis=-1, keepdims=True) + EPS)
    return (y * g.astype(jnp.float32)).astype(x.dtype)


def qkv_heads(h, w_qkv, g_q, g_k):
    b, s, _ = h.shape
    qkv = (h @ w_qkv).reshape(b, s, 3, N_HEADS, HEAD_DIM)
    return rms_norm(qkv[:, :, 0], g_q), rms_norm(qkv[:, :, 1], g_k), qkv[:, :, 2]


def masked_softmax(logits, mask):
    return jax.nn.softmax(jnp.where(mask, logits, NEG), axis=-1)


def rel_bias(table, q_pos, k_pos):
    d = jnp.clip(q_pos[:, None] - k_pos[None, :], -MAX_REL, MAX_REL) + MAX_REL
    return table[:, d].astype(jnp.float32)


def band_attention_prompt(q, k, v, table):
    b, s, H, hd = q.shape
    nc = s // CHUNK
    qc = q.reshape(b, nc, CHUNK, H, hd)
    pad = jnp.zeros((b, WINDOW, H, hd), k.dtype)
    kp = jnp.concatenate([pad, k], axis=1).reshape(b, nc + N_LEFT_CHUNKS, CHUNK, H, hd)
    vp = jnp.concatenate([pad, v], axis=1).reshape(b, nc + N_LEFT_CHUNKS, CHUNK, H, hd)
    idx = jnp.arange(nc)[:, None] + jnp.arange(N_LEFT_CHUNKS + 1)[None, :]
    kb = kp[:, idx].reshape(b, nc, BAND, H, hd)
    vb = vp[:, idx].reshape(b, nc, BAND, H, hd)
    bias = rel_bias(table, WINDOW + jnp.arange(CHUNK), jnp.arange(BAND))
    logits = jnp.einsum('bcqhd,bckhd->bchqk', qc, kb,
                        preferred_element_type=jnp.float32) * SCALE + bias[None, None]
    key_valid = jnp.repeat(idx >= N_LEFT_CHUNKS, CHUNK, axis=1)
    p = masked_softmax(logits, key_valid[None, :, None, None, :])
    out = jnp.einsum('bchqk,bckhd->bcqhd', p.astype(v.dtype), vb)
    return out.reshape(b, s, H * hd)


def band_attention_sample(q, k_new, v_new, k_cache, v_cache, table):
    L = k_cache.shape[1]
    b, n, H, hd = q.shape
    k = jnp.concatenate([k_cache.astype(k_new.dtype), k_new], axis=1)
    v = jnp.concatenate([v_cache.astype(v_new.dtype), v_new], axis=1)
    bias = rel_bias(table, L + jnp.arange(n), jnp.arange(L + n))
    logits = jnp.einsum('bqhd,bkhd->bhqk', q, k,
                        preferred_element_type=jnp.float32) * SCALE + bias[None]
    p = jax.nn.softmax(logits, axis=-1)
    out = jnp.einsum('bhqk,bkhd->bqhd', p.astype(v.dtype), v)
    return out.reshape(b, n, H * hd)


def log_forget(h, w_f, b_f):
    return jax.nn.log_sigmoid((h @ w_f).astype(jnp.float32) + b_f.astype(jnp.float32))


def forgetting_attention_prompt(q, k, v, logf):
    b, s, H, hd = q.shape
    nb = s // Q_BLOCK
    c = jnp.cumsum(logf, axis=1).transpose(0, 2, 1)
    qb = q.reshape(b, nb, Q_BLOCK, H, hd).transpose(1, 0, 2, 3, 4)
    cb = c.reshape(b, H, nb, Q_BLOCK).transpose(2, 0, 1, 3)
    starts = jnp.arange(nb) * Q_BLOCK
    k_pos = jnp.arange(s)

    def block(args):
        qi, ci, start = args
        logits = jnp.einsum('bqhd,bkhd->bhqk', qi, k, preferred_element_type=jnp.float32) * SCALE
        logits = logits + ci[..., None] - c[:, :, None, :]
        mask = k_pos[None, :] <= (start + jnp.arange(Q_BLOCK))[:, None]
        p = masked_softmax(logits, mask)
        return jnp.einsum('bhqk,bkhd->bqhd', p.astype(v.dtype), v)

    out = lax.map(block, (qb, cb, starts))
    return out.transpose(1, 0, 2, 3, 4).reshape(b, s, H * hd)


def forgetting_attention_sample(q, k_new, v_new, logf_new, k_cache, v_cache, logf_cache):
    L = k_cache.shape[1]
    b, n, H, hd = q.shape
    k = jnp.concatenate([k_cache.astype(k_new.dtype), k_new], axis=1)
    v = jnp.concatenate([v_cache.astype(v_new.dtype), v_new], axis=1)
    c = jnp.cumsum(jnp.concatenate([logf_cache.astype(jnp.float32), logf_new], axis=1),
                   axis=1).transpose(0, 2, 1)
    logits = jnp.einsum('bqhd,bkhd->bhqk', q, k, preferred_element_type=jnp.float32) * SCALE
    logits = logits + c[:, :, L:, None] - c[:, :, None, :]
    mask = jnp.arange(L + n)[None, :] <= (L + jnp.arange(n))[:, None]
    p = masked_softmax(logits, mask)
    out = jnp.einsum('bhqk,bkhd->bqhd', p.astype(v.dtype), v)
    return out.reshape(b, n, H * hd)


def swiglu(h, w_gate, w_up, w_down):
    return (jax.nn.silu(h @ w_gate) * (h @ w_up)) @ w_down


def setup_inputs(seed: int = 0) -> dict:
    key = jax.random.key(seed)
    ks = jax.random.split(key, 20)
    D, H, hd, F = D_MODEL, N_HEADS, HEAD_DIM, D_FF
    la = min(WINDOW, PAST_LEN)
    f32 = jnp.float32
    nrm = jax.random.normal
    return {
        'x_prompt': nrm(ks[0], (BATCH, SEQ, D), f32),
        'x_sample': nrm(ks[1], (DEC_BATCH, DEC_SEQ, D), f32),
        'cache_a_k': nrm(ks[2], (N_A_LAYERS, DEC_BATCH, la, H, hd), f32),
        'cache_a_v': nrm(ks[3], (N_A_LAYERS, DEC_BATCH, la, H, hd), f32),
        'cache_b_k': nrm(ks[4], (N_B_LAYERS, DEC_BATCH, PAST_LEN, H, hd), f32),
        'cache_b_v': nrm(ks[5], (N_B_LAYERS, DEC_BATCH, PAST_LEN, H, hd), f32),
        'cache_b_logf': jax.nn.log_sigmoid(FORGET_BIAS_INIT + nrm(ks[6], (N_B_LAYERS, DEC_BATCH, PAST_LEN, H), f32)),
        'g_attn': 1.0 + 0.05 * nrm(ks[7], (DEPTH, D), f32),
        'w_qkv': nrm(ks[8], (DEPTH, D, 3 * D), f32) * D ** -0.5,
        'g_q': 1.0 + 0.05 * nrm(ks[9], (DEPTH, hd), f32),
        'g_k': 1.0 + 0.05 * nrm(ks[10], (DEPTH, hd), f32),
        'w_o': nrm(ks[11], (DEPTH, D, D), f32) * D ** -0.5,
        'rel_table': 0.5 * nrm(ks[12], (N_A_LAYERS, H, N_REL), f32),
        'w_f': nrm(ks[13], (N_B_LAYERS, D, H), f32) * D ** -0.5,
        'b_f': FORGET_BIAS_INIT + 0.5 * nrm(ks[14], (N_B_LAYERS, H), f32),
        'g_ffn': 1.0 + 0.05 * nrm(ks[15], (DEPTH, D), f32),
        'w_gate': nrm(ks[16], (DEPTH, D, F), f32) * D ** -0.5,
        'w_up': nrm(ks[17], (DEPTH, D, F), f32) * D ** -0.5,
        'w_down': nrm(ks[18], (DEPTH, F, D), f32) * F ** -0.5,
    }


def reference(x_prompt, x_sample, cache_a_k, cache_a_v, cache_b_k, cache_b_v, cache_b_logf,
              g_attn, w_qkv, g_q, g_k, w_o, rel_table, w_f, b_f, g_ffn, w_gate, w_up, w_down):
    yp, ys = x_prompt, x_sample
    keep = min(WINDOW, x_prompt.shape[1])
    a_kp, a_vp, b_kp, b_vp, b_fp = [], [], [], [], []
    a_ks, a_vs, b_ks, b_vs, b_fs = [], [], [], [], []
    for layer in range(DEPTH):
        hp = rms_norm(yp, g_attn[layer])
        hs = rms_norm(ys, g_attn[layer])
        qp, kp, vp = qkv_heads(hp, w_qkv[layer], g_q[layer], g_k[layer])
        qs, ks, vs = qkv_heads(hs, w_qkv[layer], g_q[layer], g_k[layer])
        if layer % 2 == 0:
            ia = layer // 2
            mp = band_attention_prompt(qp, kp, vp, rel_table[ia])
            ms = band_attention_sample(qs, ks, vs, cache_a_k[ia], cache_a_v[ia], rel_table[ia])
            a_kp.append(kp[:, -keep:])
            a_vp.append(vp[:, -keep:])
            a_ks.append(ks)
            a_vs.append(vs)
        else:
            ib = layer // 2
            lfp = log_forget(hp, w_f[ib], b_f[ib])
            lfs = log_forget(hs, w_f[ib], b_f[ib])
            mp = forgetting_attention_prompt(qp, kp, vp, lfp)
            ms = forgetting_attention_sample(qs, ks, vs, lfs, cache_b_k[ib], cache_b_v[ib], cache_b_logf[ib])
            b_kp.append(kp)
            b_vp.append(vp)
            b_fp.append(lfp)
            b_ks.append(ks)
            b_vs.append(vs)
            b_fs.append(lfs)
        yp = yp + mp @ w_o[layer]
        ys = ys + ms @ w_o[layer]
        yp = yp + swiglu(rms_norm(yp, g_ffn[layer]), w_gate[layer], w_up[layer], w_down[layer])
        ys = ys + swiglu(rms_norm(ys, g_ffn[layer]), w_gate[layer], w_up[layer], w_down[layer])
    return (yp, ys,
            jnp.stack(a_kp), jnp.stack(a_vp), jnp.stack(b_kp), jnp.stack(b_vp), jnp.stack(b_fp),
            jnp.stack(a_ks), jnp.stack(a_vs), jnp.stack(b_ks), jnp.stack(b_vs), jnp.stack(b_fs))
```

```cpp
#include <hip/hip_runtime.h>
#include <cstdio>
#include <cstdint>
namespace pg8 {
#define PG8_LAS __attribute__((address_space(3)))
typedef unsigned short bf16_t;
typedef short bf16x8 __attribute__((ext_vector_type(8)));
typedef float f32x4 __attribute__((ext_vector_type(4)));
typedef unsigned u32x4 __attribute__((ext_vector_type(4)));
constexpr int BM = 256, BK = 64, HALF = 128, HTB = HALF * BK * 2  , STAGE_BYTES = 8 * HTB, NXCD = 8, WGM = 8;

__host__ __device__ __forceinline__ int lds_byte(int r, int c) { const int st = (r >> 4) * 2 + (c >> 5), rr = r & 15, cc = c & 31, ob = rr * 64 + cc * 2; return st * 1024 + (ob ^ (((ob >> 9) & 1) << 5)); }
__host__ __device__ __forceinline__ void stage_rc(int b, int& R, int& C) { const int st = b / 1024, sb = b % 1024, swz = sb ^ (((sb >> 9) & 1) << 5); R = (st >> 1) * 16 + swz / 64; C = (st & 1) * 32 + (swz % 64) / 2; }
__host__ __device__ __forceinline__ int perm32(int rho) { const int n = rho >> 4, i = rho & 15; return 8 * (i >> 2) + 4 * n + (i & 3); }

struct Unit { int pm, pn; };
struct Gemm { const bf16_t* A; const bf16_t* Bt; int M, N, K; };

struct StaticOrder {
    int nM, nN, nwg, G, c;
    __host__ __device__ void init(int M, int N, int G_, int c_) { nM = M / BM; nN = N / BM; nwg = nM * nN; G = G_; c = c_; }
    __host__ __device__ bool next(int i, Unit& u) const {
        const long L = (long)i * G + c; if (L >= nwg) return false;
        int wgid = (int)L; { const int q = nwg / NXCD, r = nwg % NXCD, xcd = wgid % NXCD, off = wgid / NXCD; wgid = (xcd < r ? xcd * (q + 1) : r * (q + 1) + (xcd - r) * q) + off; }
        const int nig = WGM * nN, gid = wgid / nig, fm = gid * WGM, gsz = (nM - fm) < WGM ? (nM - fm) : WGM;
        u.pm = fm + ((wgid % nig) % gsz); u.pn = (wgid % nig) / gsz; return true;
    }
    __device__ __forceinline__ void a_ready(const Unit&) const {}
    __device__ __forceinline__ void done(const Unit&) const {}
};

__device__ __forceinline__ unsigned cvt_pk_bf16(float lo, float hi) { unsigned r; asm volatile("v_cvt_pk_bf16_f32 %0, %1, %2" : "=v"(r) : "v"(lo), "v"(hi)); return r; }
struct EpiF32 {
    static constexpr bool PERM = false, AFTER_DRAIN = false;
    float* C; int ldc;
    __device__ __forceinline__ void operator()(const f32x4 (&acc)[2][2][4][2], const Unit& u, int wr, int wc, int fr, int fq) const {
        const int row0 = u.pm * BM + wr * 64 + fr, col0 = u.pn * BM + wc * 32 + 4 * fq;
#pragma unroll
        for (int ai = 0; ai < 2; ++ai)
#pragma unroll
            for (int m = 0; m < 4; ++m) { float* rowp = C + (size_t)(row0 + ai * HALF + m * 16) * ldc + col0;
#pragma unroll
                for (int bj = 0; bj < 2; ++bj)
#pragma unroll
                    for (int n = 0; n < 2; ++n) *(f32x4*)(rowp + bj * HALF + n * 16) = acc[ai][bj][m][n]; }
    }
};
template <class Epi, class Sched, bool ALIGN_EPI = false, bool SP2 = false>
__device__ __forceinline__ void gemm_phase(PG8_LAS unsigned char* lds, const Gemm g, const Sched& S, const Epi& E) {
    int tid_ = threadIdx.x; asm volatile("" : "+v"(tid_));
    const int tid = tid_, wid = __builtin_amdgcn_readfirstlane(tid >> 6), lane = tid & 63, wr = wid >> 2, wc = wid & 3, fr = lane & 15, fq = lane >> 4;
    const int K = g.K, nt = K / BK;
    unsigned voffA[2], voffB[2];
#pragma unroll
    for (int i = 0; i < 2; ++i) { int R, C; stage_rc(tid * 16 + i * 8192, R, C); const int Rb = Epi::PERM ? ((R & ~31) + perm32(R & 31)) : R;
        voffA[i] = (unsigned)(R * K + C) * 2u; voffB[i] = (unsigned)(Rb * K + C) * 2u; }
    const size_t kstep = (size_t)(BK * 2);
    const size_t hstep = (size_t)HALF * K * 2;
    const size_t tstep = 2 * hstep;
    const unsigned ldsw = (unsigned)wid * 1024u;
    const int aoff = lds_byte(wr * 64 + fr, fq * 8), boff = lds_byte(wc * 32 + fr, fq * 8);
#define PG8_SA(b, h) (((b) * 2 + (h)) * HTB)
#define PG8_SB(b, h) ((4 + (b) * 2 + (h)) * HTB)
#define PG8_STAGE(bufoff, gbase, voff) do { _Pragma("unroll") for (int _i = 0; _i < 2; ++_i) \
        __builtin_amdgcn_global_load_lds((const unsigned*)((const char*)(gbase) + (voff)[_i]), (PG8_LAS unsigned*)(lds + (bufoff) + ldsw + _i * 8192), 16, 0, 0); } while (0)
#define PG8_LDA(dst, b, h) do { _Pragma("unroll") for (int m = 0; m < 4; ++m) _Pragma("unroll") for (int k = 0; k < 2; ++k) dst[m][k] = *(const PG8_LAS bf16x8*)(lds + PG8_SA(b, h) + aoff + m * 2048 + k * 1024); } while (0)
#define PG8_LDB(dst, b, h) do { _Pragma("unroll") for (int n = 0; n < 2; ++n) _Pragma("unroll") for (int k = 0; k < 2; ++k) dst[n][k] = *(const PG8_LAS bf16x8*)(lds + PG8_SB(b, h) + boff + n * 2048 + k * 1024); } while (0)
#define PG8_MMA(ai, bj, At, Bt) do { __builtin_amdgcn_s_setprio(1); _Pragma("unroll") for (int m = 0; m < 4; ++m) _Pragma("unroll") for (int n = 0; n < 2; ++n) _Pragma("unroll") for (int k = 0; k < 2; ++k) \
        acc[ai][bj][m][n] = __builtin_amdgcn_mfma_f32_16x16x32_bf16(Bt[n][k], At[m][k], acc[ai][bj][m][n], 0, 0, 0); __builtin_amdgcn_s_setprio(0); } while (0)
#define PG8_WAIT_V(n) asm volatile("s_waitcnt vmcnt(" #n ")" ::: "memory")
#define PG8_WAIT_L(n) asm volatile("s_waitcnt lgkmcnt(" #n ")" ::: "memory")
#define PG8_BAR __builtin_amdgcn_s_barrier()
#define PG8_SCHED __builtin_amdgcn_sched_barrier(0)
    Unit cur, nxt; int ui = 0;
    if (!S.next(0, cur)) return;
    f32x4 acc[2][2][4][2];
#pragma unroll
    for (int a = 0; a < 2; ++a)
#pragma unroll
        for (int b = 0; b < 2; ++b)
#pragma unroll
            for (int m = 0; m < 4; ++m)
#pragma unroll
                for (int n = 0; n < 2; ++n) acc[a][b][m][n] = (f32x4){0.f, 0.f, 0.f, 0.f};
    bf16x8 At[4][2], B0[2][2], B1[2][2];
    const char* cA = (const char*)g.A + (size_t)cur.pm * tstep; const char* cB = (const char*)g.Bt + (size_t)cur.pn * tstep;
    S.a_ready(cur);
    if constexpr (SP2) {
        PG8_STAGE(PG8_SB(0, 0), cB, voffB); PG8_STAGE(PG8_SB(0, 1), cB + hstep, voffB); PG8_STAGE(PG8_SA(0, 0), cA, voffA); PG8_STAGE(PG8_SA(0, 1), cA + hstep, voffA);
        if (wr == 1) PG8_BAR;
        PG8_WAIT_V(2); PG8_BAR;
        PG8_STAGE(PG8_SB(1, 0), cB + kstep, voffB); PG8_STAGE(PG8_SA(1, 0), cA + kstep, voffA); PG8_STAGE(PG8_SB(1, 1), cB + hstep + kstep, voffB);
        PG8_WAIT_V(6); PG8_BAR;
    } else {
        PG8_STAGE(PG8_SB(0, 0), cB, voffB); PG8_STAGE(PG8_SA(0, 0), cA, voffA); PG8_STAGE(PG8_SB(0, 1), cB + hstep, voffB); PG8_STAGE(PG8_SA(0, 1), cA + hstep, voffA);
        if (wr == 1) PG8_BAR;
        PG8_WAIT_V(4); PG8_BAR;
        PG8_STAGE(PG8_SB(1, 0), cB + kstep, voffB); PG8_STAGE(PG8_SA(1, 0), cA + kstep, voffA); PG8_STAGE(PG8_SB(1, 1), cB + hstep + kstep, voffB);
        PG8_WAIT_V(6); PG8_BAR;
    }
    for (;;) {
        const bool has_next = S.next(ui + 1, nxt);
        const char* nA = has_next ? (const char*)g.A + (size_t)nxt.pm * tstep : cA; const char* nB = has_next ? (const char*)g.Bt + (size_t)nxt.pn * tstep : cB;
        for (int t = 0; t < nt; t += 2) {
            const bool last = (t == nt - 2);
            const char* a1 = cA + (size_t)(t + 1) * kstep;
            const char* a2 = last ? nA : cA + (size_t)(t + 2) * kstep; const char* b2 = last ? nB : cB + (size_t)(t + 2) * kstep;
            const char* a3 = a2 + kstep; const char* b3 = b2 + kstep;
            if (last && has_next) S.a_ready(nxt);
            if constexpr (SP2) {
            PG8_LDB(B0, 0, 0); PG8_LDB(B1, 0, 1); PG8_SCHED; PG8_LDA(At, 0, 0); PG8_STAGE(PG8_SA(1, 1), a1 + hstep, voffA);
            PG8_WAIT_V(8); PG8_WAIT_L(0); PG8_BAR; PG8_MMA(0, 0, At, B0); PG8_MMA(0, 1, At, B1); PG8_BAR; PG8_SCHED;
            PG8_LDA(At, 0, 1); PG8_STAGE(PG8_SB(0, 0), b2, voffB); PG8_STAGE(PG8_SB(0, 1), b2 + hstep, voffB); PG8_STAGE(PG8_SA(0, 0), a2, voffA);
            PG8_WAIT_V(8); PG8_WAIT_L(0); PG8_BAR; PG8_MMA(1, 0, At, B0); PG8_MMA(1, 1, At, B1); PG8_BAR; PG8_SCHED;
            PG8_LDB(B0, 1, 0); PG8_LDB(B1, 1, 1); PG8_SCHED; PG8_LDA(At, 1, 0); PG8_STAGE(PG8_SA(0, 1), a2 + hstep, voffA);
            PG8_WAIT_V(8); PG8_WAIT_L(0); PG8_BAR; PG8_MMA(0, 0, At, B0); PG8_MMA(0, 1, At, B1); PG8_BAR; PG8_SCHED;
            PG8_LDA(At, 1, 1); PG8_STAGE(PG8_SB(1, 0), b3, voffB); PG8_STAGE(PG8_SB(1, 1), b3 + hstep, voffB); PG8_STAGE(PG8_SA(1, 0), a3, voffA);
            PG8_WAIT_V(8); PG8_WAIT_L(0); PG8_BAR; PG8_MMA(1, 0, At, B0); PG8_MMA(1, 1, At, B1); PG8_BAR; PG8_SCHED;
            } else {
            PG8_LDB(B0, 0, 0); PG8_SCHED; PG8_LDA(At, 0, 0); PG8_STAGE(PG8_SA(1, 1), a1 + hstep, voffA);
            PG8_WAIT_L(8); PG8_BAR; PG8_WAIT_L(0); PG8_MMA(0, 0, At, B0); PG8_BAR; PG8_SCHED;
            PG8_LDB(B1, 0, 1); PG8_STAGE(PG8_SB(0, 0), b2, voffB);
            PG8_BAR; PG8_WAIT_L(0); PG8_MMA(0, 1, At, B1); PG8_BAR;
            PG8_LDA(At, 0, 1); PG8_STAGE(PG8_SA(0, 0), a2, voffA);
            PG8_BAR; PG8_WAIT_L(0); PG8_MMA(1, 0, At, B0); PG8_BAR; PG8_SCHED;
            PG8_STAGE(PG8_SB(0, 1), b2 + hstep, voffB);
            PG8_WAIT_V(6); PG8_BAR; PG8_MMA(1, 1, At, B1); PG8_BAR;
            PG8_LDB(B0, 1, 0); PG8_SCHED; PG8_LDA(At, 1, 0); PG8_STAGE(PG8_SA(0, 1), a2 + hstep, voffA);
            PG8_WAIT_L(8); PG8_BAR; PG8_WAIT_L(0); PG8_MMA(0, 0, At, B0); PG8_BAR; PG8_SCHED;
            PG8_LDB(B1, 1, 1); PG8_STAGE(PG8_SB(1, 0), b3, voffB);
            PG8_BAR; PG8_WAIT_L(0); PG8_MMA(0, 1, At, B1); PG8_BAR;
            PG8_LDA(At, 1, 1); PG8_STAGE(PG8_SA(1, 0), a3, voffA);
            PG8_BAR; PG8_WAIT_L(0); PG8_MMA(1, 0, At, B0); PG8_BAR; PG8_SCHED;
            PG8_STAGE(PG8_SB(1, 1), b3 + hstep, voffB);
            PG8_WAIT_V(6); PG8_BAR; PG8_MMA(1, 1, At, B1); PG8_BAR;
            }
        }
        if constexpr (ALIGN_EPI) { if (wr == 0) PG8_BAR; }
        if constexpr (!Epi::AFTER_DRAIN) { E(acc, cur, wr, wc, fr, fq); S.done(cur); }
        if (!has_next) break;
#pragma unroll
        for (int a = 0; a < 2; ++a)
#pragma unroll
            for (int b = 0; b < 2; ++b)
#pragma unroll
                for (int m = 0; m < 4; ++m)
#pragma unroll
                    for (int n = 0; n < 2; ++n) acc[a][b][m][n] = (f32x4){0.f, 0.f, 0.f, 0.f};
        cur = nxt; cA = nA; cB = nB; ++ui;
        if constexpr (ALIGN_EPI) { if (wr == 1) PG8_BAR; }
    }
    PG8_WAIT_V(0);
    if constexpr (!ALIGN_EPI) { if (wr == 0) PG8_BAR; }
    PG8_BAR;
    if constexpr (Epi::AFTER_DRAIN) { E.fused(acc, cur, wr, wc, fr, fq, lds, wid, lane); S.done(cur); }
#undef PG8_SA
#undef PG8_SB
#undef PG8_STAGE
#undef PG8_LDA
#undef PG8_LDB
#undef PG8_MMA
#undef PG8_WAIT_V
#undef PG8_WAIT_L
#undef PG8_BAR
#undef PG8_SCHED
}
}

constexpr int NWAVES = 8;
constexpr int NB = 2, T = 8192, D = 2048, NH = 16, HD = 128, FF = 5632, DEPTH = 4;
constexpr int SB = 16, SN = 16, PAST = 1024, WIN = 512, NREL = 257;
constexpr int MP = NB * T, MS = SB * SN, M = MP + MS;
constexpr int NQKV = 3 * D, NGU = 2 * FF;
constexpr int LS = PAST + SN;
constexpr float EPS = 1e-6f, SCALE = 0.08838834764831845f;
constexpr size_t O_Y = 0, O_YS = (size_t)MP * D, O_AKP = O_YS + (size_t)MS * D, SZ_AP = (size_t)2 * NB * WIN * D, O_AVP = O_AKP + SZ_AP, O_BKP = O_AVP + SZ_AP,
    SZ_BP = (size_t)2 * MP * D, O_BVP = O_BKP + SZ_BP, O_BFP = O_BVP + SZ_BP, SZ_BFP = (size_t)2 * MP * NH, O_AKS = O_BFP + SZ_BFP, SZ_S = (size_t)2 * MS * D,
    O_AVS = O_AKS + SZ_S, O_BKS = O_AVS + SZ_S, O_BVS = O_BKS + SZ_S, O_BFS = O_BVS + SZ_S, OUT_TOTAL = O_BFS + (size_t)2 * MS * NH;
static_assert(OUT_TOTAL == 181411840, "out size");
constexpr size_t MiB = 1u << 20;
constexpr size_t WS_CTL = 0, CTL_ZERO_BYTES = 1 * MiB;
constexpr size_t WS_WQKV = 2 * MiB, WS_WO = 98 * MiB, WS_WGU = 130 * MiB, WS_WD = 306 * MiB;
constexpr size_t WS_XB = 394 * MiB, WS_RSTD = 459 * MiB;
constexpr size_t WS_QP = 460 * MiB, WS_KP = 524 * MiB, WS_VP = 588 * MiB;
constexpr size_t WS_QS = 652 * MiB, WS_KSN = 653 * MiB, WS_VSN = 654 * MiB;
constexpr size_t WS_OB = 655 * MiB, WS_HB = 720 * MiB, WS_C32 = 899 * MiB;
constexpr size_t WS_LFP = 1289 * MiB, WS_CUMP = 1290 * MiB, WS_LFS = 1291 * MiB, WS_CUMS = 1293 * MiB, WS_END = 1295 * MiB;
static_assert(WS_WQKV + (size_t)DEPTH * NQKV * D * 2 <= WS_WO && WS_WO + (size_t)DEPTH * D * D * 2 <= WS_WGU && WS_WGU + (size_t)DEPTH * NGU * D * 2 <= WS_WD && WS_WD + (size_t)DEPTH * D * FF * 2 <= WS_XB, "ws map: weights");
static_assert(WS_XB + (size_t)M * D * 2 <= WS_RSTD && WS_OB + (size_t)M * D * 2 <= WS_HB && WS_HB + (size_t)M * FF * 2 <= WS_C32 && WS_C32 + (size_t)M * NQKV * 4 <= WS_LFP, "ws map: activations");
constexpr int CW_BAR = 4096;
constexpr int RING_OFF = 0, RING_BYTES = 131072;
constexpr int LDSCTL_OFF = RING_BYTES, MISC_OFF = LDSCTL_OFF + 320;
constexpr int LDS_BYTES = 147456;
#define GAS __attribute__((address_space(1)))
#define LAS __attribute__((address_space(3)))
typedef unsigned short bf16;
typedef unsigned v4u __attribute__((ext_vector_type(4)));
typedef float f32x4 __attribute__((ext_vector_type(4)));
typedef short bf16x8 __attribute__((ext_vector_type(8)));
typedef GAS unsigned gu32;
typedef GAS unsigned long long gu64;
#define RLX_AGENT __ATOMIC_RELAXED, __HIP_MEMORY_SCOPE_AGENT
#define LDS_WAIT() asm volatile("s_waitcnt lgkmcnt(0)" ::: "memory")
#define VM_WAIT() asm volatile("s_waitcnt vmcnt(0)" ::: "memory")
__device__ __forceinline__ unsigned long long rt() { return __builtin_amdgcn_s_memrealtime(); }
__device__ __forceinline__ unsigned f2bf(float f) { unsigned u = __builtin_bit_cast(unsigned, f); return (u + 0x7fffu + ((u >> 16) & 1u)) >> 16; }
__device__ __forceinline__ unsigned pk2(float lo, float hi) { return f2bf(lo) | (f2bf(hi) << 16); }

#define XB_TMO      128
#define XB_XCNT(j)  (256  + 64 * (j))
#define XB_XSUB(j)  (1280 + 64 * (j))
#define XB_XGEN(j)  (2304 + 64 * (j))
#define XB_TOP      3328
#define XB_TOPGEN   3392
#define XCD_BAR_WORDS 3456
#define XB_SPIN_CAP (1u << 22)

__device__ __forceinline__ unsigned xb_ld(unsigned* p)              { return __hip_atomic_load(p, __ATOMIC_RELAXED, __HIP_MEMORY_SCOPE_AGENT); }
__device__ __forceinline__ unsigned xb_add(unsigned* p, unsigned v) { return __hip_atomic_fetch_add(p, v, __ATOMIC_RELAXED, __HIP_MEMORY_SCOPE_AGENT); }
__device__ __forceinline__ unsigned xb_xcc_id() { return (unsigned)__builtin_amdgcn_s_getreg((3 << 11) | 20) & 0xFu; }
#define XB_SPIN(cond, bar) do { unsigned _sp = 0; while (cond) { __builtin_amdgcn_s_sleep(1); \
    if ((++_sp & 255u) == 0u) { if (xb_ld(&(bar)[XB_TMO])) break; if (_sp > XB_SPIN_CAP) { atomicAdd(&(bar)[XB_TMO], 1u); break; } } } } while (0)

struct XcdBarrier {
    unsigned* bar; unsigned x;
    volatile LAS unsigned* st;
};

__device__ __forceinline__ XcdBarrier xcd_barrier_post(unsigned* bar, volatile LAS unsigned* st) {
    XcdBarrier b; b.bar = bar; b.x = xb_xcc_id(); b.st = st;
    if (threadIdx.x == 0) (void)xb_add(&bar[XB_XCNT(b.x)], 1u);
    return b;
}
__device__ __forceinline__ void xcd_barrier_complete(unsigned* bar, unsigned x, unsigned& nloc, unsigned& nx) {
    const unsigned G = gridDim.x * gridDim.y * gridDim.z;
    unsigned sum, cnt, mine, sp = 0u;
    for (;;) {
        sum = 0u; cnt = 0u; mine = 0u;
#pragma unroll
        for (unsigned j = 0; j < 16; ++j) { const unsigned c = xb_ld(&bar[XB_XCNT(j)]); sum += c; cnt += (c > 0u) ? 1u : 0u; mine = (j == x) ? c : mine; }
        if (sum == G) break;
        __builtin_amdgcn_s_sleep(1);
        if ((++sp & 255u) == 0u) { if (xb_ld(&bar[XB_TMO])) break; if (sp > XB_SPIN_CAP) { atomicAdd(&bar[XB_TMO], 1u); break; } }
    }
    nloc = mine > 0u ? mine : 1u; nx = cnt > 0u ? cnt : 1u;
}

__device__ __forceinline__ void xcd_barrier(const XcdBarrier& b) {
    asm volatile("s_waitcnt vmcnt(0)" ::: "memory");
    __syncthreads();
    if (threadIdx.x == 0) {
        unsigned* bar = b.bar;
        __builtin_amdgcn_s_waitcnt(0);
        unsigned nloc = b.st[0], nx = b.st[1];
        if (nloc == 0u) { xcd_barrier_complete(bar, b.x, nloc, nx); b.st[0] = nloc; b.st[1] = nx; }
        const unsigned old = xb_add(&bar[XB_XSUB(b.x)], 1u);
        const unsigned gen = old / nloc;
        if (old + 1u == (gen + 1u) * nloc) {
            __builtin_amdgcn_fence(__ATOMIC_RELEASE, "agent");
            asm volatile("s_waitcnt vmcnt(0)" ::: "memory");
            const unsigned og = xb_add(&bar[XB_TOP], 1u);
            const unsigned tg = og / nx;
            if (og + 1u == (tg + 1u) * nx) xb_add(&bar[XB_TOPGEN], 1u);
            else XB_SPIN(xb_ld(&bar[XB_TOPGEN]) == tg, bar);
            __builtin_amdgcn_fence(__ATOMIC_ACQUIRE, "agent");
            xb_add(&bar[XB_XGEN(b.x)], 1u);
            asm volatile("s_waitcnt vmcnt(0)" ::: "memory");
        } else {
            XB_SPIN(xb_ld(&bar[XB_XGEN(b.x)]) == gen, bar);
            __builtin_amdgcn_fence(__ATOMIC_ACQUIRE, "agent");
            asm volatile("s_waitcnt vmcnt(0)" ::: "memory");
        }
    }
    __syncthreads();
}

typedef float f32x2 __attribute__((ext_vector_type(2)));
__device__ __forceinline__ float wave_sum(float v) {
#pragma unroll
    for (int o = 1; o < 64; o <<= 1) v += __shfl_xor(v, o);
    return v;
}
__device__ __forceinline__ float bf2f(unsigned b) { return __uint_as_float(b << 16); }

__device__ __forceinline__ void p0_transpose_item(const float* W, const float* g, int K, int N, bf16* WT, int mode, LAS float* scr, int item, int lane) {
    const int nblk = N / 32, kb = item / nblk, nb = item % nblk, k0 = 64 * kb, n0 = 32 * nb;
#pragma unroll 8
    for (int i = 0; i < 32; ++i) { const int kk = 2 * i + (lane >> 5); const float s = g ? g[k0 + kk] : 1.f; scr[kk * 33 + (lane & 31)] = W[(size_t)(k0 + kk) * N + n0 + (lane & 31)] * s; }
    LDS_WAIT(); asm volatile("" ::: "memory");
    const int c = lane & 7;
    const int drow0 = (mode == 0) ? n0 : (256 * (n0 >> 7) + (n0 & 127) + (mode == 2 ? 128 : 0));
#pragma unroll
    for (int j = 0; j < 4; ++j) { const int n = (lane >> 3) + 8 * j; const LAS float* s = scr + (8 * c) * 33 + n;
        v4u o; o.x = pk2(s[0 * 33], s[1 * 33]); o.y = pk2(s[2 * 33], s[3 * 33]); o.z = pk2(s[4 * 33], s[5 * 33]); o.w = pk2(s[6 * 33], s[7 * 33]);
        *(GAS v4u*)(WT + (size_t)(drow0 + n) * K + k0 + 8 * c) = o; }
    LDS_WAIT(); asm volatile("" ::: "memory");
}
__device__ __forceinline__ void row_update(const float* xold, const float* crow, float* xdst, bf16* xbrow, float* rstd_p, int lane) {
    const GAS f32x4* xr = (const GAS f32x4*)xold + lane; const GAS f32x4* cr = (const GAS f32x4*)crow + lane;
    GAS f32x4* xd = (GAS f32x4*)xdst + lane; GAS unsigned long long* o8 = (GAS unsigned long long*)xbrow + lane;
    float ss = 0.f;
#pragma unroll
    for (int j = 0; j < 8; ++j) { f32x4 v = xr[64 * j]; if (crow) v = v + cr[64 * j]; if (xdst) xd[64 * j] = v;
        ss += (v.x * v.x + v.y * v.y) + (v.z * v.z + v.w * v.w);
        o8[64 * j] = (unsigned long long)pk2(v.x, v.y) | ((unsigned long long)pk2(v.z, v.w) << 32); }
    ss = wave_sum(ss);
    if (lane == 0) *rstd_p = 1.f / sqrtf(ss * (1.f / D) + EPS);
}
__device__ __forceinline__ void scan_seq(const float* src, float* dst, int len, int lane) {
    const int seg = (len + 63) / 64, lo = lane * seg, hi = (lo + seg < len) ? lo + seg : len;
    float s = 0.f; for (int i = lo; i < hi; ++i) s += src[i];
    float incl = s;
#pragma unroll
    for (int o = 1; o < 64; o <<= 1) { const float t = __shfl_up(incl, o); if (lane >= o) incl += t; }
    float run = incl - s;
    for (int i = lo; i < hi; ++i) { run += src[i]; dst[i] = run; }
}
template <bool FOX>
__device__ __forceinline__ void attn_row(const bf16* Kn, const bf16* Vn, const float* Kc, const float* Vc, int ncache, int s_lo, int s_hi,
                                         const float* tab, const float* cum, int qpos, float q0, float q1, int lane, bf16* orow) {
    float m = -1e30f, l = 0.f, o0 = 0.f, o1 = 0.f;
    const float cq = FOX ? cum[qpos] : 0.f;
    for (int s0 = s_lo; s0 < s_hi; s0 += 4) {
        float lg[4], v0[4], v1[4];
#pragma unroll
        for (int j = 0; j < 4; ++j) {
            const int s = (s0 + j < s_hi) ? s0 + j : s_hi - 1;
            float k0, k1;
            if (s < ncache) { const f32x2 kk = *(const GAS f32x2*)(Kc + (size_t)s * D + 2 * lane), vv = *(const GAS f32x2*)(Vc + (size_t)s * D + 2 * lane); k0 = kk.x; k1 = kk.y; v0[j] = vv.x; v1[j] = vv.y; }
            else { const unsigned kk = *(const GAS unsigned*)(Kn + (size_t)(s - ncache) * HD + 2 * lane), vv = *(const GAS unsigned*)(Vn + (size_t)(s - ncache) * HD + 2 * lane);
                   k0 = bf2f(kk & 0xffffu); k1 = bf2f(kk >> 16); v0[j] = bf2f(vv & 0xffffu); v1[j] = bf2f(vv >> 16); }
            float bias;
            if (FOX) bias = cq - cum[s]; else { int d = qpos - s; d = d < -128 ? -128 : (d > 128 ? 128 : d); bias = tab[d + 128]; }
            lg[j] = q0 * k0 + q1 * k1; v0[j] = v0[j];
            lg[j] = wave_sum(lg[j]) * SCALE + bias;
            if (s0 + j >= s_hi) lg[j] = -__builtin_inff();
        }
#pragma unroll
        for (int j = 0; j < 4; ++j) {
            const float mn = fmaxf(m, lg[j]), corr = __expf(m - mn), p = __expf(lg[j] - mn);
            l = l * corr + p; o0 = o0 * corr + p * v0[j]; o1 = o1 * corr + p * v1[j]; m = mn;
        }
    }
    const float inv = 1.f / l;
    *(GAS unsigned*)(orow + 2 * lane) = pk2(o0 * inv, o1 * inv);
}
__device__ __forceinline__ int tperm(int r) { const int blk = r & 6144, x = r & 2047; return blk + (((r >> 11) & 1) ? 2047 - x : x); }

struct Args { const float* in[19]; float* out; unsigned char* ws; int ph_lo, ph_hi; };
constexpr int PH_PER_LAYER = 12, N_PHASES = 1 + DEPTH * PH_PER_LAYER;

typedef const __attribute__((address_space(4))) Args CArgs;
#define PH_BEGIN() CArgs* A; { unsigned long long k_ = (unsigned long long)__builtin_amdgcn_kernarg_segment_ptr(); asm volatile("" : "+s"(k_)); A = (CArgs*)k_; } \
    unsigned char* const ws = A->ws; float* const out = A->out; int bx = blockIdx.x; asm volatile("" : "+s"(bx)); (void)ws; (void)out; (void)bx
__global__ void __launch_bounds__(NWAVES * 64, 2) fwd_kernel(Args args_unused) {
    extern __shared__ __attribute__((aligned(16))) unsigned char lds_raw[];
    LAS unsigned char* lds = (LAS unsigned char*)lds_raw;
    volatile LAS unsigned* MISC = (volatile LAS unsigned*)(lds + MISC_OFF);
    const int tid = threadIdx.x, lane = tid & 63, wave = __builtin_amdgcn_readfirstlane(tid >> 6);
    const int G = gridDim.x;
    const int gw = blockIdx.x * NWAVES + wave, NGW = G * NWAVES;
    const long gt = (long)blockIdx.x * (NWAVES * 64) + tid, NGT = (long)G * (NWAVES * 64);
    for (int u = tid; u < (LDS_BYTES - LDSCTL_OFF) / 4; u += NWAVES * 64) ((LAS unsigned*)(lds + LDSCTL_OFF))[u] = 0u;
    __syncthreads();
    int lo, hi; XcdBarrier bar;
    { PH_BEGIN(); lo = A->ph_lo; hi = A->ph_hi; bar = xcd_barrier_post((unsigned*)((gu32*)(ws + WS_CTL) + CW_BAR), MISC + 8); }
#define IN(k) (lo <= (k) && (k) < hi)
#define SEAM(k) do { if (IN(k) && IN((k) + 1)) xcd_barrier(bar); } while (0)
#define P_WQKV ((bf16*)(ws + WS_WQKV))
#define P_WO ((bf16*)(ws + WS_WO))
#define P_WGU ((bf16*)(ws + WS_WGU))
#define P_WD ((bf16*)(ws + WS_WD))
#define P_XB ((bf16*)(ws + WS_XB))
#define P_RSTD ((float*)(ws + WS_RSTD))
#define P_QP ((bf16*)(ws + WS_QP))
#define P_KP ((bf16*)(ws + WS_KP))
#define P_VP ((bf16*)(ws + WS_VP))
#define P_QS ((bf16*)(ws + WS_QS))
#define P_KSN ((bf16*)(ws + WS_KSN))
#define P_VSN ((bf16*)(ws + WS_VSN))
#define P_OB ((bf16*)(ws + WS_OB))
#define P_HB ((bf16*)(ws + WS_HB))
#define P_C32 ((float*)(ws + WS_C32))
#define P_LFP ((float*)(ws + WS_LFP))
#define P_CUMP ((float*)(ws + WS_CUMP))
#define P_LFS ((float*)(ws + WS_LFS))
#define P_CUMS ((float*)(ws + WS_CUMS))
#define P_X (out + O_Y)

    if (IN(0)) { PH_BEGIN();
        LAS float* scr = (LAS float*)(lds + RING_OFF + wave * 16384);
        constexpr int I_QKV = (D / 64) * (NQKV / 32), I_O = (D / 64) * (D / 32), I_G = (D / 64) * (FF / 32), I_D = (FF / 64) * (D / 32), I_L = I_QKV + I_O + 2 * I_G + I_D;
        for (int it = gw; it < DEPTH * I_L; it += NGW) {
            const int L = it / I_L; int r = it % I_L;
            const float* ga = A->in[7] + (size_t)L * D; const float* gf = A->in[15] + (size_t)L * D;
            if (r < I_QKV) { p0_transpose_item(A->in[8] + (size_t)L * D * NQKV, ga, D, NQKV, P_WQKV + (size_t)L * NQKV * D, 0, scr, r, lane); continue; } r -= I_QKV;
            if (r < I_O) { p0_transpose_item(A->in[11] + (size_t)L * D * D, nullptr, D, D, P_WO + (size_t)L * D * D, 0, scr, r, lane); continue; } r -= I_O;
            if (r < I_G) { p0_transpose_item(A->in[16] + (size_t)L * D * FF, gf, D, FF, P_WGU + (size_t)L * NGU * D, 1, scr, r, lane); continue; } r -= I_G;
            if (r < I_G) { p0_transpose_item(A->in[17] + (size_t)L * D * FF, gf, D, FF, P_WGU + (size_t)L * NGU * D, 2, scr, r, lane); continue; } r -= I_G;
            p0_transpose_item(A->in[18] + (size_t)L * FF * D, nullptr, FF, D, P_WD + (size_t)L * D * FF, 0, scr, r, lane);
        }
        for (int row = gw; row < M; row += NGW) {
            const float* xr = row < MP ? A->in[0] + (size_t)row * D : A->in[1] + (size_t)(row - MP) * D;
            row_update(xr, nullptr, nullptr, P_XB + (size_t)row * D, P_RSTD + row, lane);
        }
    }
    SEAM(0);

    for (int layer = 0; layer < DEPTH; ++layer) {
        const int pb = 1 + layer * PH_PER_LAYER, li = layer >> 1; const bool fox = (layer & 1) != 0;
        if (IN(pb + 0)) { PH_BEGIN();
            pg8::Gemm g{P_XB, P_WQKV + (size_t)layer * NQKV * D, M, NQKV, D}; pg8::StaticOrder S; S.init(M, NQKV, G, bx);
            pg8::EpiF32 E{P_C32, NQKV};
            pg8::gemm_phase<pg8::EpiF32, pg8::StaticOrder, true, true>(lds + RING_OFF, g, S, E);
        }
        SEAM(pb + 0);
        if (IN(pb + 1)) { PH_BEGIN();
            const float* gq = A->in[9] + layer * HD; const float* gk = A->in[10] + layer * HD;
            for (long it = gw; it < (long)M * 48; it += NGW) {
                const int row = (int)(it / 48), slot = (int)(it % 48), which = slot >> 4, h = slot & 15;
                const f32x2 cv = *(const GAS f32x2*)(P_C32 + (size_t)row * NQKV + which * D + h * HD + 2 * lane);
                const float r = P_RSTD[row]; float v0 = cv.x * r, v1 = cv.y * r;
                if (which < 2) { const float s = wave_sum(v0 * v0 + v1 * v1); const float rr = 1.f / sqrtf(s * (1.f / HD) + EPS);
                    const float* gg = (which == 0 ? gq : gk) + 2 * lane; v0 = v0 * rr * gg[0]; v1 = v1 * rr * gg[1]; }
                const unsigned pk = pk2(v0, v1);
                if (row < MP) { const int b = row >> 13, t = row & (T - 1); bf16* dst = (which == 0 ? P_QP : (which == 1 ? P_KP : P_VP)) + ((size_t)(b * NH + h) * T + t) * HD + 2 * lane;
                    *(GAS unsigned*)dst = pk;
                    if (which > 0) {
                        if (!fox) { if (t >= T - WIN) { float* o = out + (which == 1 ? O_AKP : O_AVP) + ((size_t)((li * NB + b) * WIN + (t - (T - WIN)))) * D + h * HD + 2 * lane; *(GAS f32x2*)o = (f32x2){v0, v1}; } }
                        else { float* o = out + (which == 1 ? O_BKP : O_BVP) + ((size_t)li * MP + row) * D + h * HD + 2 * lane; *(GAS f32x2*)o = (f32x2){v0, v1}; } }
                } else { const int rs = row - MP, st = rs >> 4, i = rs & 15; bf16* dst = (which == 0 ? P_QS : (which == 1 ? P_KSN : P_VSN)) + ((size_t)((st * NH + h) * SN + i)) * HD + 2 * lane;
                    *(GAS unsigned*)dst = pk;
                    if (which > 0) { float* o = out + (fox ? (which == 1 ? O_BKS : O_BVS) : (which == 1 ? O_AKS : O_AVS)) + ((size_t)li * MS + rs) * D + h * HD + 2 * lane; *(GAS f32x2*)o = (f32x2){v0, v1}; } }
            }
            if (fox) {
                const float* ga = A->in[7] + (size_t)layer * D; const float* wf = A->in[13] + (size_t)li * D * NH; const float* bfp = A->in[14] + li * NH;
                for (long idx = gt; idx < (long)M * NH; idx += NGT) {
                    const int row = (int)(idx >> 4), h = (int)(idx & 15);
                    const bf16* xr = P_XB + (size_t)row * D; float acc = 0.f;
                    for (int k = 0; k < D; ++k) acc += bf2f(xr[k]) * ga[k] * wf[k * NH + h];
                    const float z = acc * P_RSTD[row] + bfp[h];
                    const float lf = fminf(z, 0.f) - log1pf(expf(-fabsf(z)));
                    if (row < MP) { out[O_BFP + ((size_t)li * MP + row) * NH + h] = lf; P_LFP[(size_t)((row >> 13) * NH + h) * T + (row & (T - 1))] = lf; }
                    else { const int rs = row - MP; out[O_BFS + ((size_t)li * MS + rs) * NH + h] = lf; P_LFS[(size_t)((rs >> 4) * NH + h) * LS + PAST + (rs & 15)] = lf; }
                }
                const float* clf = A->in[6] + (size_t)li * SB * PAST * NH;
                for (long idx = gt; idx < (long)SB * NH * PAST; idx += NGT) { const int unit = (int)(idx >> 10), j = (int)(idx & 1023), st = unit >> 4, h = unit & 15;
                    P_LFS[(size_t)unit * LS + j] = clf[((size_t)st * PAST + j) * NH + h]; }
            }
        }
        SEAM(pb + 1);
        if (IN(pb + 2) && fox) { PH_BEGIN();
            for (int sq = gw; sq < NB * NH + SB * NH; sq += NGW) {
                if (sq < NB * NH) scan_seq(P_LFP + (size_t)sq * T, P_CUMP + (size_t)sq * T, T, lane);
                else { const int u = sq - NB * NH; scan_seq(P_LFS + (size_t)u * LS, P_CUMS + (size_t)u * LS, LS, lane); }
            }
        }
        SEAM(pb + 2);
        if (IN(pb + 3)) { PH_BEGIN();
            for (long it = gw; it < (long)MP * NH + (long)MS * NH; it += NGW) {
                if (it < (long)MP * NH) {
                    const int bh = (int)(it >> 13), t = tperm((int)(it & (T - 1))), b = bh >> 4, h = bh & 15;
                    const unsigned qq = *(const GAS unsigned*)(P_QP + ((size_t)bh * T + t) * HD + 2 * lane); const float q0 = bf2f(qq & 0xffffu), q1 = bf2f(qq >> 16);
                    bf16* orow = P_OB + ((size_t)b * T + t) * D + h * HD;
                    const bf16* Kb = P_KP + (size_t)bh * T * HD; const bf16* Vb = P_VP + (size_t)bh * T * HD;
                    if (!fox) { const int c = t >> 6, s_lo = (c > 8 ? c - 8 : 0) * 64, s_hi = (c + 1) * 64;
                        attn_row<false>(Kb, Vb, nullptr, nullptr, 0, s_lo, s_hi, A->in[12] + (size_t)(li * NH + h) * NREL, nullptr, t, q0, q1, lane, orow); }
                    else attn_row<true>(Kb, Vb, nullptr, nullptr, 0, 0, t + 1, nullptr, P_CUMP + (size_t)bh * T, t, q0, q1, lane, orow);
                } else {
                    const int its = (int)(it - (long)MP * NH), unit = its >> 4, i = its & 15, st = unit >> 4, h = unit & 15;
                    const unsigned qq = *(const GAS unsigned*)(P_QS + ((size_t)unit * SN + i) * HD + 2 * lane); const float q0 = bf2f(qq & 0xffffu), q1 = bf2f(qq >> 16);
                    bf16* orow = P_OB + ((size_t)MP + st * SN + i) * D + h * HD;
                    const bf16* Kb = P_KSN + (size_t)unit * SN * HD; const bf16* Vb = P_VSN + (size_t)unit * SN * HD;
                    if (!fox) { const size_t co = ((size_t)(li * SB + st) * WIN) * D + h * HD;
                        attn_row<false>(Kb, Vb, A->in[2] + co, A->in[3] + co, WIN, 0, WIN + SN, A->in[12] + (size_t)(li * NH + h) * NREL, nullptr, WIN + i, q0, q1, lane, orow); }
                    else { const size_t co = ((size_t)(li * SB + st) * PAST) * D + h * HD;
                        attn_row<true>(Kb, Vb, A->in[4] + co, A->in[5] + co, PAST, 0, PAST + i + 1, nullptr, P_CUMS + (size_t)unit * LS, PAST + i, q0, q1, lane, orow); }
                }
            }
        }
        SEAM(pb + 3);
        if (IN(pb + 4)) { PH_BEGIN();
            pg8::Gemm g{P_OB, P_WO + (size_t)layer * D * D, M, D, D}; pg8::StaticOrder S; S.init(M, D, G, bx);
            pg8::EpiF32 E{P_C32, D};
            pg8::gemm_phase<pg8::EpiF32, pg8::StaticOrder, true, true>(lds + RING_OFF, g, S, E);
        }
        SEAM(pb + 4);
        if (IN(pb + 5)) { PH_BEGIN();
            for (int row = gw; row < M; row += NGW) {
                const float* xo = (layer == 0) ? (row < MP ? A->in[0] + (size_t)row * D : A->in[1] + (size_t)(row - MP) * D) : P_X + (size_t)row * D;
                row_update(xo, P_C32 + (size_t)row * D, P_X + (size_t)row * D, P_XB + (size_t)row * D, P_RSTD + row, lane);
            }
        }
        SEAM(pb + 5);
        for (int hf = 0; hf < 2; ++hf) {
            if (IN(pb + 6 + 2 * hf)) { PH_BEGIN();
                pg8::Gemm g{P_XB, P_WGU + (size_t)layer * NGU * D + (size_t)hf * FF * D, M, FF, D}; pg8::StaticOrder S; S.init(M, FF, G, bx);
                pg8::EpiF32 E{P_C32, FF};
                pg8::gemm_phase<pg8::EpiF32, pg8::StaticOrder, true, true>(lds + RING_OFF, g, S, E);
            }
            SEAM(pb + 6 + 2 * hf);
            if (IN(pb + 7 + 2 * hf)) { PH_BEGIN();
                constexpr int HW = FF / 2;
                for (long idx = gt; idx < (long)M * HW; idx += NGT) {
                    const int row = (int)(idx / HW), j = (int)(idx % HW), jt = j >> 7, c = j & 127;
                    const float r = P_RSTD[row]; const float* cr = P_C32 + (size_t)row * FF + 256 * jt + c;
                    const float gv = cr[0] * r, uv = cr[128] * r;
                    const float hv = gv / (1.f + __expf(-gv)) * uv;
                    P_HB[(size_t)row * FF + hf * HW + j] = (bf16)f2bf(hv);
                }
            }
            SEAM(pb + 7 + 2 * hf);
        }
        if (IN(pb + 10)) { PH_BEGIN();
            pg8::Gemm g{P_HB, P_WD + (size_t)layer * D * FF, M, D, FF}; pg8::StaticOrder S; S.init(M, D, G, bx);
            pg8::EpiF32 E{P_C32, D};
            pg8::gemm_phase<pg8::EpiF32, pg8::StaticOrder, true, true>(lds + RING_OFF, g, S, E);
        }
        SEAM(pb + 10);
        if (IN(pb + 11)) { PH_BEGIN();
            for (int row = gw; row < M; row += NGW) row_update(P_X + (size_t)row * D, P_C32 + (size_t)row * D, P_X + (size_t)row * D, P_XB + (size_t)row * D, P_RSTD + row, lane);
        }
        SEAM(pb + 11);
    }
#undef IN
#undef SEAM
}

#ifndef MK_SPLIT
#define MK_SPLIT 0
#endif
extern "C" void kernel_launch(void* const* d_in, const int* in_sizes, int n_in, void* d_out, int out_size, void* d_ws, size_t ws_size, hipStream_t stream) {
    static int grid = 0;
    if (grid == 0) {
        if (n_in != 19 || in_sizes[0] != MP * D || (size_t)out_size != OUT_TOTAL || ws_size < WS_END) { fprintf(stderr, "kernel_launch: shape mismatch (n_in %d in0 %d out %d ws %zu); nothing launched\n", n_in, n_in > 0 ? in_sizes[0] : -1, out_size, ws_size); grid = -1; return; }
        int dev = 0, cus = 0;
        if (hipGetDevice(&dev) != hipSuccess || hipDeviceGetAttribute(&cus, hipDeviceAttributeMultiprocessorCount, dev) != hipSuccess) { grid = -1; return; }
        if (hipFuncSetAttribute((const void*)fwd_kernel, hipFuncAttributeMaxDynamicSharedMemorySize, LDS_BYTES) != hipSuccess) { fprintf(stderr, "kernel_launch: hipFuncSetAttribute failed\n"); grid = -1; return; }
        int per_cu = 0;
        if (hipOccupancyMaxActiveBlocksPerMultiprocessor(&per_cu, (const void*)fwd_kernel, NWAVES * 64, LDS_BYTES) != hipSuccess || per_cu < 1) fprintf(stderr, "kernel_launch: occupancy query reports %d\n", per_cu);
        (void)hipGetLastError();
        grid = cus;
    }
    if (grid < 0) return;
    if (hipMemsetAsync((char*)d_ws + WS_CTL, 0, CTL_ZERO_BYTES, stream) != hipSuccess) return;
    Args a{};
    for (int i = 0; i < 19; ++i) a.in[i] = (const float*)d_in[i];
    a.out = (float*)d_out; a.ws = (unsigned char*)d_ws;
#if MK_SPLIT
    for (int p = 0; p < N_PHASES; ++p) { a.ph_lo = p; a.ph_hi = p + 1; hipLaunchKernelGGL(fwd_kernel, dim3(grid), dim3(NWAVES * 64), LDS_BYTES, stream, a); }
#else
    a.ph_lo = 0; a.ph_hi = N_PHASES;
    hipLaunchKernelGGL(fwd_kernel, dim3(grid), dim3(NWAVES * 64), LDS_BYTES, stream, a);
#endif
}
```

```cpp
#include <hip/hip_runtime.h>
#include <cstdio>
#include <cstdint>
namespace pg8 {
#define PG8_LAS __attribute__((address_space(3)))
typedef unsigned short bf16_t;
typedef short bf16x8 __attribute__((ext_vector_type(8)));
typedef float f32x4 __attribute__((ext_vector_type(4)));
typedef unsigned u32x4 __attribute__((ext_vector_type(4)));
constexpr int BM = 256, BK = 64, HALF = 128, HTB = HALF * BK * 2  , STAGE_BYTES = 8 * HTB, NXCD = 8, WGM = 2;

__host__ __device__ __forceinline__ int lds_byte(int r, int c) { const int st = (r >> 4) * 2 + (c >> 5), rr = r & 15, cc = c & 31, ob = rr * 64 + cc * 2; return st * 1024 + (ob ^ (((ob >> 9) & 1) << 5)); }
__host__ __device__ __forceinline__ void stage_rc(int b, int& R, int& C) { const int st = b / 1024, sb = b % 1024, swz = sb ^ (((sb >> 9) & 1) << 5); R = (st >> 1) * 16 + swz / 64; C = (st & 1) * 32 + (swz % 64) / 2; }
__host__ __device__ __forceinline__ int perm32(int rho) { const int n = rho >> 4, i = rho & 15; return 8 * (i >> 2) + 4 * n + (i & 3); }

struct Unit { int pm, pn; };
struct Gemm { const bf16_t* A; const bf16_t* Bt; int M, N, K; };

struct StaticOrder {
    int nM, nN, nwg, G, c;
    __host__ __device__ void init(int M, int N, int G_, int c_) { nM = M / BM; nN = N / BM; nwg = nM * nN; G = G_; c = c_; }
    __host__ __device__ bool next(int i, Unit& u) const {
        const long L = (long)i * G + c; if (L >= nwg) return false;
        int wgid = (int)L; { const int q = nwg / NXCD, r = nwg % NXCD, xcd = wgid % NXCD, off = wgid / NXCD; wgid = (xcd < r ? xcd * (q + 1) : r * (q + 1) + (xcd - r) * q) + off; }
        const int nig = WGM * nN, gid = wgid / nig, fm = gid * WGM, gsz = (nM - fm) < WGM ? (nM - fm) : WGM;
        u.pm = fm + ((wgid % nig) % gsz); u.pn = (wgid % nig) / gsz; return true;
    }
    __device__ __forceinline__ void a_ready(const Unit&) const {}
    __device__ __forceinline__ void done(const Unit&) const {}
};

__device__ __forceinline__ unsigned cvt_pk_bf16(float lo, float hi) { unsigned r; asm volatile("v_cvt_pk_bf16_f32 %0, %1, %2" : "=v"(r) : "v"(lo), "v"(hi)); return r; }
struct EpiF32 {
    static constexpr bool PERM = false, AFTER_DRAIN = false;
    float* C; int ldc;
    __device__ __forceinline__ void operator()(const f32x4 (&acc)[2][2][4][2], const Unit& u, int wr, int wc, int fr, int fq) const {
        const int row0 = u.pm * BM + wr * 64 + fr, col0 = u.pn * BM + wc * 32 + 4 * fq;
#pragma unroll
        for (int ai = 0; ai < 2; ++ai)
#pragma unroll
            for (int m = 0; m < 4; ++m) { float* rowp = C + (size_t)(row0 + ai * HALF + m * 16) * ldc + col0;
#pragma unroll
                for (int bj = 0; bj < 2; ++bj)
#pragma unroll
                    for (int n = 0; n < 2; ++n) *(f32x4*)(rowp + bj * HALF + n * 16) = acc[ai][bj][m][n]; }
    }
};
template <class Epi, class Sched, bool ALIGN_EPI = false, bool SP2 = false>
__device__ __forceinline__ void gemm_phase(PG8_LAS unsigned char* lds, const Gemm g, const Sched& S, const Epi& E, const int tid_in) {
    int tid_ = tid_in; asm volatile("" : "+v"(tid_));
    const int tid = tid_, wid = __builtin_amdgcn_readfirstlane(tid >> 6), lane = tid & 63, wr = wid >> 2, wc = wid & 3, fr = lane & 15, fq = lane >> 4;
    const int K = g.K, nt = K / BK;
    unsigned voffA[2], voffB[2];
#pragma unroll
    for (int i = 0; i < 2; ++i) { int R, C; stage_rc(tid * 16 + i * 8192, R, C); const int Rb = Epi::PERM ? ((R & ~31) + perm32(R & 31)) : R;
        voffA[i] = (unsigned)(R * K + C) * 2u; voffB[i] = (unsigned)(Rb * K + C) * 2u; }
    const size_t kstep = (size_t)(BK * 2);
    const size_t hstep = (size_t)HALF * K * 2;
    const size_t tstep = 2 * hstep;
    const unsigned ldsw = (unsigned)wid * 1024u;
    const int aoff = lds_byte(wr * 64 + fr, fq * 8), boff = lds_byte(wc * 32 + fr, fq * 8);
#define PG8_SA(b, h) (((b) * 2 + (h)) * HTB)
#define PG8_SB(b, h) ((4 + (b) * 2 + (h)) * HTB)
#define PG8_STAGE(bufoff, gbase, voff) do { _Pragma("unroll") for (int _i = 0; _i < 2; ++_i) \
        __builtin_amdgcn_global_load_lds((const unsigned*)((const char*)(gbase) + (voff)[_i]), (PG8_LAS unsigned*)(lds + (bufoff) + ldsw + _i * 8192), 16, 0, 0); } while (0)
#define PG8_LDA(dst, b, h) do { _Pragma("unroll") for (int m = 0; m < 4; ++m) _Pragma("unroll") for (int k = 0; k < 2; ++k) dst[m][k] = *(const PG8_LAS bf16x8*)(lds + PG8_SA(b, h) + aoff + m * 2048 + k * 1024); } while (0)
#define PG8_LDB(dst, b, h) do { _Pragma("unroll") for (int n = 0; n < 2; ++n) _Pragma("unroll") for (int k = 0; k < 2; ++k) dst[n][k] = *(const PG8_LAS bf16x8*)(lds + PG8_SB(b, h) + boff + n * 2048 + k * 1024); } while (0)
#define PG8_MMA(ai, bj, At, Bt) do { __builtin_amdgcn_s_setprio(1); _Pragma("unroll") for (int m = 0; m < 4; ++m) _Pragma("unroll") for (int n = 0; n < 2; ++n) _Pragma("unroll") for (int k = 0; k < 2; ++k) \
        acc[ai][bj][m][n] = __builtin_amdgcn_mfma_f32_16x16x32_bf16(Bt[n][k], At[m][k], acc[ai][bj][m][n], 0, 0, 0); __builtin_amdgcn_s_setprio(0); } while (0)
#define PG8_WAIT_V(n) asm volatile("s_waitcnt vmcnt(" #n ")" ::: "memory")
#define PG8_WAIT_L(n) asm volatile("s_waitcnt lgkmcnt(" #n ")" ::: "memory")
#define PG8_BAR __builtin_amdgcn_s_barrier()
#define PG8_SCHED __builtin_amdgcn_sched_barrier(0)
    Unit cur, nxt; int ui = 0;
    if (!S.next(0, cur)) return;
    f32x4 acc[2][2][4][2];
#pragma unroll
    for (int a = 0; a < 2; ++a)
#pragma unroll
        for (int b = 0; b < 2; ++b)
#pragma unroll
            for (int m = 0; m < 4; ++m)
#pragma unroll
                for (int n = 0; n < 2; ++n) acc[a][b][m][n] = (f32x4){0.f, 0.f, 0.f, 0.f};
    bf16x8 At[4][2], B0[2][2], B1[2][2];
    const char* cA = (const char*)g.A + (size_t)cur.pm * tstep; const char* cB = (const char*)g.Bt + (size_t)cur.pn * tstep;
    S.a_ready(cur);
    if constexpr (SP2) {
        PG8_STAGE(PG8_SB(0, 0), cB, voffB); PG8_STAGE(PG8_SB(0, 1), cB + hstep, voffB); PG8_STAGE(PG8_SA(0, 0), cA, voffA); PG8_STAGE(PG8_SA(0, 1), cA + hstep, voffA);
        if (wr == 1) PG8_BAR;
        PG8_WAIT_V(2); PG8_BAR;
        PG8_STAGE(PG8_SB(1, 0), cB + kstep, voffB); PG8_STAGE(PG8_SA(1, 0), cA + kstep, voffA); PG8_STAGE(PG8_SB(1, 1), cB + hstep + kstep, voffB);
        PG8_WAIT_V(6); PG8_BAR;
    } else {
        PG8_STAGE(PG8_SB(0, 0), cB, voffB); PG8_STAGE(PG8_SA(0, 0), cA, voffA); PG8_STAGE(PG8_SB(0, 1), cB + hstep, voffB); PG8_STAGE(PG8_SA(0, 1), cA + hstep, voffA);
        if (wr == 1) PG8_BAR;
        PG8_WAIT_V(4); PG8_BAR;
        PG8_STAGE(PG8_SB(1, 0), cB + kstep, voffB); PG8_STAGE(PG8_SA(1, 0), cA + kstep, voffA); PG8_STAGE(PG8_SB(1, 1), cB + hstep + kstep, voffB);
        PG8_WAIT_V(6); PG8_BAR;
    }
    for (;;) {
        const bool has_next = S.next(ui + 1, nxt);
        const char* nA = has_next ? (const char*)g.A + (size_t)nxt.pm * tstep : cA; const char* nB = has_next ? (const char*)g.Bt + (size_t)nxt.pn * tstep : cB;
        for (int t = 0; t < nt; t += 2) {
            const bool last = (t == nt - 2);
            const char* a1 = cA + (size_t)(t + 1) * kstep;
            const char* a2 = last ? nA : cA + (size_t)(t + 2) * kstep; const char* b2 = last ? nB : cB + (size_t)(t + 2) * kstep;
            const char* a3 = a2 + kstep; const char* b3 = b2 + kstep;
            if (last && has_next) S.a_ready(nxt);
            if constexpr (SP2) {
            PG8_LDB(B0, 0, 0); PG8_LDB(B1, 0, 1); PG8_SCHED; PG8_LDA(At, 0, 0); PG8_STAGE(PG8_SA(1, 1), a1 + hstep, voffA);
            PG8_WAIT_V(8); PG8_WAIT_L(0); PG8_BAR; PG8_MMA(0, 0, At, B0); PG8_MMA(0, 1, At, B1); PG8_BAR; PG8_SCHED;
            PG8_LDA(At, 0, 1); PG8_STAGE(PG8_SB(0, 0), b2, voffB); PG8_STAGE(PG8_SB(0, 1), b2 + hstep, voffB); PG8_STAGE(PG8_SA(0, 0), a2, voffA);
            PG8_WAIT_V(8); PG8_WAIT_L(0); PG8_BAR; PG8_MMA(1, 0, At, B0); PG8_MMA(1, 1, At, B1); PG8_BAR; PG8_SCHED;
            PG8_LDB(B0, 1, 0); PG8_LDB(B1, 1, 1); PG8_SCHED; PG8_LDA(At, 1, 0); PG8_STAGE(PG8_SA(0, 1), a2 + hstep, voffA);
            PG8_WAIT_V(8); PG8_WAIT_L(0); PG8_BAR; PG8_MMA(0, 0, At, B0); PG8_MMA(0, 1, At, B1); PG8_BAR; PG8_SCHED;
            PG8_LDA(At, 1, 1); PG8_STAGE(PG8_SB(1, 0), b3, voffB); PG8_STAGE(PG8_SB(1, 1), b3 + hstep, voffB); PG8_STAGE(PG8_SA(1, 0), a3, voffA);
            PG8_WAIT_V(8); PG8_WAIT_L(0); PG8_BAR; PG8_MMA(1, 0, At, B0); PG8_MMA(1, 1, At, B1); PG8_BAR; PG8_SCHED;
            } else {
            PG8_LDB(B0, 0, 0); PG8_SCHED; PG8_LDA(At, 0, 0); PG8_STAGE(PG8_SA(1, 1), a1 + hstep, voffA);
            PG8_WAIT_L(8); PG8_BAR; PG8_WAIT_L(0); PG8_MMA(0, 0, At, B0); PG8_BAR; PG8_SCHED;
            PG8_LDB(B1, 0, 1); PG8_STAGE(PG8_SB(0, 0), b2, voffB);
            PG8_BAR; PG8_WAIT_L(0); PG8_MMA(0, 1, At, B1); PG8_BAR;
            PG8_LDA(At, 0, 1); PG8_STAGE(PG8_SA(0, 0), a2, voffA);
            PG8_BAR; PG8_WAIT_L(0); PG8_MMA(1, 0, At, B0); PG8_BAR; PG8_SCHED;
            PG8_STAGE(PG8_SB(0, 1), b2 + hstep, voffB);
            PG8_WAIT_V(6); PG8_BAR; PG8_MMA(1, 1, At, B1); PG8_BAR;
            PG8_LDB(B0, 1, 0); PG8_SCHED; PG8_LDA(At, 1, 0); PG8_STAGE(PG8_SA(0, 1), a2 + hstep, voffA);
            PG8_WAIT_L(8); PG8_BAR; PG8_WAIT_L(0); PG8_MMA(0, 0, At, B0); PG8_BAR; PG8_SCHED;
            PG8_LDB(B1, 1, 1); PG8_STAGE(PG8_SB(1, 0), b3, voffB);
            PG8_BAR; PG8_WAIT_L(0); PG8_MMA(0, 1, At, B1); PG8_BAR;
            PG8_LDA(At, 1, 1); PG8_STAGE(PG8_SA(1, 0), a3, voffA);
            PG8_BAR; PG8_WAIT_L(0); PG8_MMA(1, 0, At, B0); PG8_BAR; PG8_SCHED;
            PG8_STAGE(PG8_SB(1, 1), b3 + hstep, voffB);
            PG8_WAIT_V(6); PG8_BAR; PG8_MMA(1, 1, At, B1); PG8_BAR;
            }
        }
        if constexpr (ALIGN_EPI) { if (wr == 0) PG8_BAR; }
        if constexpr (!Epi::AFTER_DRAIN) { E(acc, cur, wr, wc, fr, fq); S.done(cur); }
        if (!has_next) break;
#pragma unroll
        for (int a = 0; a < 2; ++a)
#pragma unroll
            for (int b = 0; b < 2; ++b)
#pragma unroll
                for (int m = 0; m < 4; ++m)
#pragma unroll
                    for (int n = 0; n < 2; ++n) acc[a][b][m][n] = (f32x4){0.f, 0.f, 0.f, 0.f};
        cur = nxt; cA = nA; cB = nB; ++ui;
        if constexpr (ALIGN_EPI) { if (wr == 1) PG8_BAR; }
    }
    PG8_WAIT_V(0);
    if constexpr (!ALIGN_EPI) { if (wr == 0) PG8_BAR; }
    PG8_BAR;
    if constexpr (Epi::AFTER_DRAIN) { E.fused(acc, cur, wr, wc, fr, fq, lds, wid, lane); S.done(cur); }
#undef PG8_SA
#undef PG8_SB
#undef PG8_STAGE
#undef PG8_LDA
#undef PG8_LDB
#undef PG8_MMA
#undef PG8_WAIT_V
#undef PG8_WAIT_L
#undef PG8_BAR
#undef PG8_SCHED
}
}

namespace pg8 {
typedef unsigned u32x2 __attribute__((ext_vector_type(2)));
typedef float f32x2 __attribute__((ext_vector_type(2)));
__device__ __forceinline__ void rows_rstd(float (&rs)[2][4], const float* ssq, int pm, int wr, int fr, int fq) {
    f32x4 pa[2][4], pb[2][4];
    const float* base = ssq + (size_t)(pm * BM + wr * 64 + fr) * 32 + fq * 8;
#pragma unroll
    for (int ai = 0; ai < 2; ++ai)
#pragma unroll
        for (int m = 0; m < 4; ++m) { pa[ai][m] = *(const f32x4*)(base + (ai * HALF + m * 16) * 32); pb[ai][m] = *(const f32x4*)(base + (ai * HALF + m * 16) * 32 + 4); }
#pragma unroll
    for (int ai = 0; ai < 2; ++ai)
#pragma unroll
        for (int m = 0; m < 4; ++m) { const f32x4 a = pa[ai][m], b = pb[ai][m];
            float s = ((a[0] + a[1]) + (a[2] + a[3])) + ((b[0] + b[1]) + (b[2] + b[3]));
            s += __shfl_xor(s, 16); s += __shfl_xor(s, 32);
            rs[ai][m] = __builtin_amdgcn_rsqf(s * (1.0f / 2048.0f) + 1e-6f); }
}
__device__ __forceinline__ f32x4 to_rowmajor(f32x4 v, int pidx) {
    f32x4 o; o[0] = __int_as_float(__builtin_amdgcn_ds_bpermute(pidx, __float_as_int(v[0]))); o[1] = __int_as_float(__builtin_amdgcn_ds_bpermute(pidx, __float_as_int(v[1])));
    o[2] = __int_as_float(__builtin_amdgcn_ds_bpermute(pidx, __float_as_int(v[2]))); o[3] = __int_as_float(__builtin_amdgcn_ds_bpermute(pidx, __float_as_int(v[3]))); return o;
}
__device__ __forceinline__ int rowmajor_pidx(int lane) { return (((lane & 3) << 4) | (lane >> 2)) << 2; }
__device__ __forceinline__ void rows_rstd_rm(float (&rs)[2][4], const float* ssq, int pm, int wr, int r2, int c2) {
    f32x4 pa[2][4], pb[2][4];
    const float* base = ssq + (size_t)(pm * BM + wr * 64 + r2) * 32 + c2 * 8;
#pragma unroll
    for (int ai = 0; ai < 2; ++ai)
#pragma unroll
        for (int m = 0; m < 4; ++m) { pa[ai][m] = *(const f32x4*)(base + (ai * HALF + m * 16) * 32); pb[ai][m] = *(const f32x4*)(base + (ai * HALF + m * 16) * 32 + 4); }
#pragma unroll
    for (int ai = 0; ai < 2; ++ai)
#pragma unroll
        for (int m = 0; m < 4; ++m) { const f32x4 a = pa[ai][m], b = pb[ai][m];
            float s = ((a[0] + a[1]) + (a[2] + a[3])) + ((b[0] + b[1]) + (b[2] + b[3]));
            s += __shfl_xor(s, 1); s += __shfl_xor(s, 2);
            rs[ai][m] = __builtin_amdgcn_rsqf(s * (1.0f / 2048.0f) + 1e-6f); }
}
__device__ __forceinline__ float row_rstd(const float* ssq, int row, int fq) {
    const f32x4 a = *(const f32x4*)(ssq + (size_t)row * 32 + fq * 8), b = *(const f32x4*)(ssq + (size_t)row * 32 + fq * 8 + 4);
    float s = ((a[0] + a[1]) + (a[2] + a[3])) + ((b[0] + b[1]) + (b[2] + b[3]));
    s += __shfl_xor(s, 16); s += __shfl_xor(s, 32);
    return __builtin_amdgcn_rsqf(s * (1.0f / 2048.0f) + 1e-6f);
}
struct EpiResid {
    static constexpr bool PERM = false, AFTER_DRAIN = false;
    const float* xin0; const float* xin1;
    float* X; bf16_t* XB; float* ssq;
    __device__ __forceinline__ void operator()(const f32x4 (&acc)[2][2][4][2], const Unit& u, int wr, int wc, int fr_, int fq_) const {
        const int lane = fq_ * 16 + fr_, r2 = lane >> 2, c2 = lane & 3, pidx = rowmajor_pidx(lane);
        const int row0 = u.pm * BM + wr * 64 + r2, col0 = u.pn * BM + wc * 32 + 4 * c2;
        const float* xin = (u.pm < 64) ? xin0 : xin1;
        f32x4 v[4][2][2];
#define EPR_LOAD(g) do { const size_t off_ = (size_t)(row0 + ((g) >> 2) * HALF + ((g) & 3) * 16) * 2048 + col0; _Pragma("unroll") for (int bj = 0; bj < 2; ++bj) _Pragma("unroll") for (int n = 0; n < 2; ++n) \
            v[(g) & 3][bj][n] = *(const f32x4*)(xin + off_ + bj * HALF + n * 16); } while (0)
        EPR_LOAD(0); EPR_LOAD(1); EPR_LOAD(2);
#pragma unroll
        for (int g = 0; g < 8; ++g) { const int ai = g >> 2, m = g & 3; const int row = row0 + ai * HALF + m * 16; const size_t off = (size_t)row * 2048 + col0; float s = 0.f;
            if (g + 3 < 8) EPR_LOAD(g + 3);
#pragma unroll
            for (int bj = 0; bj < 2; ++bj)
#pragma unroll
                for (int n = 0; n < 2; ++n) { const f32x4 x = v[g & 3][bj][n] + to_rowmajor(acc[ai][bj][m][n], pidx);
                    *(f32x4*)(X + off + bj * HALF + n * 16) = x;
                    u32x2 w; w.x = cvt_pk_bf16(x[0], x[1]); w.y = cvt_pk_bf16(x[2], x[3]); *(u32x2*)(XB + off + bj * HALF + n * 16) = w;
                    s += (x[0] * x[0] + x[1] * x[1]) + (x[2] * x[2] + x[3] * x[3]); }
            s += __shfl_xor(s, 1); s += __shfl_xor(s, 2);
            if (c2 == 0) ssq[(size_t)row * 32 + u.pn * 4 + wc] = s;
            asm volatile("" ::: "memory"); }
#undef EPR_LOAD
    }
};
struct EpiSwiglu {
    static constexpr bool PERM = true, AFTER_DRAIN = false;
    bf16_t* H; int ldh; const float* ssq;
    __device__ __forceinline__ void operator()(const f32x4 (&acc)[2][2][4][2], const Unit& u, int wr, int wc, int fr_, int fq_) const {
        const int lane = fq_ * 16 + fr_, r2 = lane >> 2, c2 = lane & 3, pidx = rowmajor_pidx(lane);
        const int row0 = u.pm * BM + wr * 64 + r2, col0 = u.pn * HALF + wc * 32 + 8 * c2;
        float rs[2][4]; rows_rstd_rm(rs, ssq, u.pm, wr, r2, c2);
#pragma unroll
        for (int ai = 0; ai < 2; ++ai)
#pragma unroll
            for (int m = 0; m < 4; ++m) { const float r = rs[ai][m], c1 = -1.4426950408889634f * r, ms = __builtin_amdgcn_rcpf(r * r); float hv[8];
#pragma unroll
                for (int n = 0; n < 2; ++n) { const f32x4 gv = to_rowmajor(acc[ai][0][m][n], pidx), uv = to_rowmajor(acc[ai][1][m][n], pidx);
#pragma unroll
                    for (int i = 0; i < 4; i += 2) {
                        const f32x2 g2 = (f32x2){gv[i], gv[i + 1]}, u2 = (f32x2){uv[i], uv[i + 1]}; const f32x2 t2 = g2 * c1;
                        f32x2 e2; e2.x = __builtin_amdgcn_exp2f(t2.x); e2.y = __builtin_amdgcn_exp2f(t2.y);
                        const f32x2 d2 = e2 * ms + ms; f32x2 s2; s2.x = __builtin_amdgcn_rcpf(d2.x); s2.y = __builtin_amdgcn_rcpf(d2.y);
                        const f32x2 h2 = (g2 * u2) * s2; hv[4 * n + i] = h2.x; hv[4 * n + i + 1] = h2.y; } }
                u32x4 w; w.x = cvt_pk_bf16(hv[0], hv[1]); w.y = cvt_pk_bf16(hv[2], hv[3]); w.z = cvt_pk_bf16(hv[4], hv[5]); w.w = cvt_pk_bf16(hv[6], hv[7]);
                *(u32x4*)(H + (size_t)(row0 + ai * HALF + m * 16) * ldh + col0) = w; }
    }
};
struct EpiQKV {
    static constexpr bool PERM = true, AFTER_DRAIN = false;
    const float* ssq; const float* gq; const float* gk;
    bf16_t* QP; size_t pstride;
    bf16_t* QS; bf16_t* KS; size_t sstride; int srows, lc;
    float* okp; size_t opstride; float* oks; size_t osstride;
    int fox;
    PG8_LAS float* red;
    __device__ __forceinline__ void operator()(const f32x4 (&acc)[2][2][4][2], const Unit& u, int wr, int wc, int fr_, int fq_) const {
        int fr = fr_, fq = fq_; asm volatile("" : "+v"(fr), "+v"(fq));
        const int which = u.pn >> 3, head0 = (u.pn & 7) * 2;
        const int lane_ = fq_ * 16 + fr_, r2 = lane_ >> 2, c2 = lane_ & 3, pidx = rowmajor_pidx(lane_);
        float rsv[2][4]; rows_rstd_rm(rsv, ssq, u.pm, wr, r2, c2);
        if (which < 2) {
#pragma unroll
            for (int ai = 0; ai < 2; ++ai)
#pragma unroll
                for (int m = 0; m < 4; ++m)
#pragma unroll
                    for (int bj = 0; bj < 2; ++bj) { float s = 0.f;
#pragma unroll
                        for (int n = 0; n < 2; ++n) { const f32x4 x = acc[ai][bj][m][n]; s += (x[0] * x[0] + x[1] * x[1]) + (x[2] * x[2] + x[3] * x[3]); }
                        s += __shfl_xor(s, 16); s += __shfl_xor(s, 32);
                        if (fq == 0) red[(wc * 256 + ai * HALF + wr * 64 + m * 16 + fr) * 2 + bj] = s; }
            asm volatile("s_waitcnt lgkmcnt(0)" ::: "memory"); __builtin_amdgcn_s_barrier(); asm volatile("" ::: "memory");
        }
        const int cih = wc * 32 + 8 * c2;
        f32x4 g0 = (f32x4){1.f, 1.f, 1.f, 1.f}, g1 = g0;
        if (which < 2) { const float* g = (which == 0 ? gq : gk) + cih; g0 = *(const f32x4*)g; g1 = *(const f32x4*)(g + 4); }
        const bool samp = u.pm >= 64;
        const bool f32out = which > 0 && (samp || fox || (u.pm & 31) >= 30);
        char* b16; char* b32 = nullptr; unsigned hs16, rowsz = 0;
        if (!samp) { const int bb = u.pm >> 5;
            b16 = (char*)(QP + (size_t)which * pstride + (size_t)(bb * 16 + head0) * (8192 * 128)); hs16 = 8192 * 128 * 2;
            if (f32out) b32 = (char*)(okp + (size_t)(which - 1) * opstride + (fox ? (size_t)bb * 8192 * 2048 : (size_t)bb * 512 * 2048) + head0 * 128);
        } else { rowsz = (which == 0) ? 16u : (unsigned)srows;
            b16 = (which == 0) ? (char*)QS : (char*)(KS + (size_t)(which == 2 ? 1 : 0) * sstride + (size_t)lc * 128); hs16 = rowsz * 256u;
            if (f32out) b32 = (char*)(oks + (size_t)(which - 1) * osstride + head0 * 128); }
        const int trow0 = samp ? 0 : ((u.pm & 31) * 256 - ((fox || !f32out) ? 0 : 7680));
#pragma unroll
        for (int ai = 0; ai < 2; ++ai)
#pragma unroll
            for (int m = 0; m < 4; ++m) { const int rit = ai * HALF + wr * 64 + m * 16 + r2;
                const float rs = rsv[ai][m];
                unsigned o16;
                if (!samp) o16 = (unsigned)((((u.pm & 31) * 256 + rit) * 128 + cih) * 2);
                else o16 = (unsigned)(((((rit >> 4) * 16 + head0) * rowsz + (rit & 15)) * 128 + cih) * 2);
                const unsigned o32 = (unsigned)(((trow0 + rit) * 2048 + cih) * 4);
#pragma unroll
                for (int bj = 0; bj < 2; ++bj) { float sc = rs;
                    if (which < 2) { const int ri = rit * 2 + bj; const float t = (red[ri] + red[512 + ri]) + (red[1024 + ri] + red[1536 + ri]);
                        sc = rs * __builtin_amdgcn_rsqf(t * rs * rs * (1.0f / 128.0f) + 1e-6f); }
                    const f32x4 x0 = to_rowmajor(acc[ai][bj][m][0], pidx) * sc * g0, x1 = to_rowmajor(acc[ai][bj][m][1], pidx) * sc * g1;
                    u32x4 w; w.x = cvt_pk_bf16(x0[0], x0[1]); w.y = cvt_pk_bf16(x0[2], x0[3]); w.z = cvt_pk_bf16(x1[0], x1[1]); w.w = cvt_pk_bf16(x1[2], x1[3]);
                    *(u32x4*)(b16 + (size_t)(o16 + (unsigned)bj * hs16)) = w;
                    if (f32out) { float* fo = (float*)(b32 + (size_t)(o32 + (unsigned)bj * 512u)); __builtin_nontemporal_store(x0, (f32x4*)fo); __builtin_nontemporal_store(x1, (f32x4*)(fo + 4)); } }
                asm volatile("" ::: "memory"); }
    }
};
}

namespace sk {
typedef short bf16x8 __attribute__((ext_vector_type(8)));
typedef float f32x4 __attribute__((ext_vector_type(4)));
typedef unsigned u32x2 __attribute__((ext_vector_type(2)));
typedef unsigned u32x4 __attribute__((ext_vector_type(4)));
typedef unsigned short bf16_t;
#define SLAS __attribute__((address_space(3)))
__device__ __forceinline__ unsigned cvtpk(float lo, float hi) { unsigned r; asm volatile("v_cvt_pk_bf16_f32 %0, %1, %2" : "=v"(r) : "v"(lo), "v"(hi)); return r; }
__device__ __forceinline__ float row_rstd(const float* ssq, int row, int fq) {
    const f32x4 a = *(const f32x4*)(ssq + (size_t)row * 32 + fq * 8), b = *(const f32x4*)(ssq + (size_t)row * 32 + fq * 8 + 4);
    float s = ((a[0] + a[1]) + (a[2] + a[3])) + ((b[0] + b[1]) + (b[2] + b[3]));
    s += __shfl_xor(s, 16); s += __shfl_xor(s, 32);
    return __builtin_amdgcn_rsqf(s * (1.0f / 2048.0f) + 1e-6f);
}
struct SkResid {
    static constexpr int MB = 2, NB = 2, NS = 6; static constexpr bool NEEDS_X = true;
    const float* xin; float* X; bf16_t* XB; float* ssq;
    __device__ __forceinline__ int brow(int ct, int ch, int n) const { return ct * 64 + ch * 32 + 16 * n; }
    __device__ __forceinline__ void partial(f32x4 (&acc)[MB][NB], int rt, int ct, int ch, int fr, int fq, SLAS float* red) const {
        f32x4 xo[MB][NB];
#pragma unroll
        for (int m = 0; m < MB; ++m)
#pragma unroll
            for (int n = 0; n < NB; ++n) xo[m][n] = *(const f32x4*)(xin + (size_t)(rt * 32 + 16 * m + fr) * 2048 + ct * 64 + ch * 32 + 16 * n + 4 * fq);
#pragma unroll
        for (int m = 0; m < MB; ++m) { float s = 0.f;
#pragma unroll
            for (int n = 0; n < NB; ++n) { const f32x4 x = xo[m][n] + acc[m][n]; acc[m][n] = x; s += (x[0] * x[0] + x[1] * x[1]) + (x[2] * x[2] + x[3] * x[3]); }
            s += __shfl_xor(s, 16); s += __shfl_xor(s, 32);
            if (fq == 0) red[ch * 32 + 16 * m + fr] = s; }
    }
    __device__ __forceinline__ void operator()(const f32x4 (&acc)[MB][NB], int rt, int ct, int ch, int fr, int fq, SLAS float* red) const {
#pragma unroll
        for (int m = 0; m < MB; ++m) { const int r = rt * 32 + 16 * m + fr; const size_t off = (size_t)r * 2048 + ct * 64 + ch * 32 + 4 * fq;
#pragma unroll
            for (int n = 0; n < NB; ++n) { const f32x4 x = acc[m][n];
                *(f32x4*)(X + off + 16 * n) = x; u32x2 w; w.x = cvtpk(x[0], x[1]); w.y = cvtpk(x[2], x[3]); *(u32x2*)(XB + off + 16 * n) = w; }
            if (ch == 0 && fq == 0) ssq[(size_t)r * 32 + ct] = red[16 * m + fr] + red[32 + 16 * m + fr]; }
    }
};
struct SkSwiglu {
    static constexpr int MB = 4, NB = 4, NS = 3; static constexpr bool NEEDS_X = false;
    bf16_t* H; int ldh; const float* ssq;
    __device__ __forceinline__ int brow(int ct, int ch, int n) const { return 256 * (ct >> 1) + (ct & 1) * 64 + ch * 32 + (n >= 2 ? 128 + 16 * (n - 2) : 16 * n); }
    __device__ __forceinline__ void partial(f32x4 (&acc)[MB][NB], int, int, int, int, int, SLAS float*) const {}
    __device__ __forceinline__ void operator()(const f32x4 (&acc)[MB][NB], int rt, int ct, int ch, int fr, int fq, SLAS float* red) const {
        float rs[MB];
        { f32x4 pa[MB], pb[MB];
#pragma unroll
          for (int m = 0; m < MB; ++m) { const float* sp = ssq + (size_t)(rt * 64 + 16 * m + fr) * 32 + fq * 8; pa[m] = *(const f32x4*)sp; pb[m] = *(const f32x4*)(sp + 4); }
#pragma unroll
          for (int m = 0; m < MB; ++m) { float s = ((pa[m][0] + pa[m][1]) + (pa[m][2] + pa[m][3])) + ((pb[m][0] + pb[m][1]) + (pb[m][2] + pb[m][3]));
              s += __shfl_xor(s, 16); s += __shfl_xor(s, 32); rs[m] = __builtin_amdgcn_rsqf(s * (1.0f / 2048.0f) + 1e-6f); } }
#pragma unroll
        for (int m = 0; m < MB; ++m) { const int r = rt * 64 + 16 * m + fr;
#pragma unroll
            for (int n = 0; n < 2; ++n) { float hv[4];
#pragma unroll
                for (int i = 0; i < 4; ++i) { const float g = acc[m][n][i] * rs[m], up = acc[m][n + 2][i] * rs[m]; hv[i] = g * __builtin_amdgcn_rcpf(1.0f + __expf(-g)) * up; }
                u32x2 w; w.x = cvtpk(hv[0], hv[1]); w.y = cvtpk(hv[2], hv[3]);
                *(u32x2*)(H + (size_t)r * ldh + 128 * (ct >> 1) + (ct & 1) * 64 + ch * 32 + 16 * n + 4 * fq) = w; } }
    }
};
struct SkQKV {
    static constexpr int MB = 4, NB = 4, NS = 3; static constexpr bool NEEDS_X = true;
    const float* ssq; const float* gq; const float* gk;
    bf16_t* QS; bf16_t* KS; size_t sstride; int srows, lc;
    float* oks; size_t osstride;
    __device__ __forceinline__ int brow(int ct, int ch, int n) const { return ct * 128 + ch * 64 + 16 * n; }
    __device__ __forceinline__ void partial(f32x4 (&acc)[MB][NB], int, int, int ch, int fr, int fq, SLAS float* red) const {
#pragma unroll
        for (int m = 0; m < MB; ++m) { float s = 0.f;
#pragma unroll
            for (int n = 0; n < NB; ++n) { const f32x4 x = acc[m][n]; s += (x[0] * x[0] + x[1] * x[1]) + (x[2] * x[2] + x[3] * x[3]); }
            s += __shfl_xor(s, 16); s += __shfl_xor(s, 32);
            if (fq == 0) red[ch * 64 + 16 * m + fr] = s; }
    }
    __device__ __forceinline__ void operator()(const f32x4 (&acc)[MB][NB], int rt, int ct, int ch, int fr, int fq, SLAS float* red) const {
        const int which = ct >> 4, h = ct & 15;
        const float* g = (which == 0 ? gq : gk) + ch * 64 + 4 * fq;
        bf16_t* b16 = (which == 0) ? QS : KS + (size_t)(which == 2 ? 1 : 0) * sstride + (size_t)lc * 128; const int rowsz = (which == 0) ? 16 : srows;
        float* b32 = oks + (size_t)(which > 0 ? which - 1 : 0) * osstride + h * 128 + ch * 64 + 4 * fq;
        float rs[MB];
        { f32x4 pa[MB], pb[MB];
#pragma unroll
          for (int m = 0; m < MB; ++m) { const float* sp = ssq + (size_t)(rt * 64 + 16 * m + fr) * 32 + fq * 8; pa[m] = *(const f32x4*)sp; pb[m] = *(const f32x4*)(sp + 4); }
#pragma unroll
          for (int m = 0; m < MB; ++m) { float s = ((pa[m][0] + pa[m][1]) + (pa[m][2] + pa[m][3])) + ((pb[m][0] + pb[m][1]) + (pb[m][2] + pb[m][3]));
              s += __shfl_xor(s, 16); s += __shfl_xor(s, 32); rs[m] = __builtin_amdgcn_rsqf(s * (1.0f / 2048.0f) + 1e-6f); } }
#pragma unroll
        for (int m = 0; m < MB; ++m) { const int r = rt * 64 + 16 * m + fr; float sc = rs[m];
            if (which < 2) { const float s = red[16 * m + fr] + red[64 + 16 * m + fr]; sc = rs[m] * __builtin_amdgcn_rsqf(s * rs[m] * rs[m] * (1.0f / 128.0f) + 1e-6f); }
            bf16_t* d16 = b16 + ((size_t)((r >> 4) * 16 + h) * rowsz + (r & 15)) * 128 + ch * 64 + 4 * fq; float* d32 = b32 + (size_t)r * 2048;
#pragma unroll
            for (int n = 0; n < NB; ++n) { f32x4 x = acc[m][n] * sc; if (which < 2) x = x * *(const f32x4*)(g + 16 * n);
                u32x2 w; w.x = cvtpk(x[0], x[1]); w.y = cvtpk(x[2], x[3]); *(u32x2*)(d16 + 16 * n) = w;
                if (which > 0) *(f32x4*)(d32 + 16 * n) = x; } }
    }
};
template <class Epi>
__device__ __forceinline__ void skinny_phase(SLAS unsigned char* lds, const bf16_t* A, const bf16_t* Bt, int nct, int K, unsigned* qc  , int tid, const Epi& E) {
    constexpr int MB = Epi::MB, NB = Epi::NB, NS = Epi::NS, NRT = 16 / MB, SLOT = MB * NB * 1024;
    const int lane = tid & 63, wid = __builtin_amdgcn_readfirstlane(tid >> 6), fr = lane & 15, fq = lane >> 4, kq = wid & 3, ch = wid >> 2;
    const int kw = K >> 2;
    SLAS float* red = (SLAS float*)(lds + 4 * SLOT);
    for (;;) {
        volatile SLAS int* tw = (volatile SLAS int*)(lds + 67712);
        if (tid == 0) *tw = (int)__hip_atomic_fetch_add(qc, 1u, __ATOMIC_RELAXED, __HIP_MEMORY_SCOPE_AGENT);
        __syncthreads();
        const int tile = __builtin_amdgcn_readfirstlane(*tw);
        if (tile >= NRT * nct) break;
        const int rt = tile % NRT, ct = tile / NRT;
        f32x4 acc[MB][NB];
#pragma unroll
        for (int m = 0; m < MB; ++m)
#pragma unroll
            for (int n = 0; n < NB; ++n) acc[m][n] = (f32x4){0.f, 0.f, 0.f, 0.f};
        const unsigned lo = (unsigned)(((lane >> 2) * K + kq * kw + (lane & 3) * 8) * 2);
        const int pidx = (((lane & 15) << 2) | (lane >> 4)) << 2;
        const char* ab = (const char*)(A + (size_t)(rt * 16 * MB) * K);
        const char* bb[NB];
#pragma unroll
        for (int n = 0; n < NB; ++n) bb[n] = (const char*)(Bt + (size_t)E.brow(ct, ch, n) * K);
        bf16x8 fa[NS][MB], fb[NS][NB];
#define SK_LOAD(st, ks) do { const unsigned o_ = lo + (unsigned)((ks) * 2); _Pragma("unroll") for (int m = 0; m < MB; ++m) fa[st][m] = *(const bf16x8*)(ab + (size_t)(o_ + (unsigned)(16 * m * K * 2))); \
            _Pragma("unroll") for (int n = 0; n < NB; ++n) fb[st][n] = *(const bf16x8*)(bb[n] + (size_t)o_); } while (0)
#define SK_PERM(v) do { u32x4 w_ = __builtin_bit_cast(u32x4, v); w_.x = (unsigned)__builtin_amdgcn_ds_bpermute(pidx, (int)w_.x); w_.y = (unsigned)__builtin_amdgcn_ds_bpermute(pidx, (int)w_.y); \
            w_.z = (unsigned)__builtin_amdgcn_ds_bpermute(pidx, (int)w_.z); w_.w = (unsigned)__builtin_amdgcn_ds_bpermute(pidx, (int)w_.w); v = __builtin_bit_cast(bf16x8, w_); } while (0)
#define SK_MMA(st) do { _Pragma("unroll") for (int m = 0; m < MB; ++m) SK_PERM(fa[st][m]); _Pragma("unroll") for (int n = 0; n < NB; ++n) SK_PERM(fb[st][n]); \
            _Pragma("unroll") for (int m = 0; m < MB; ++m) _Pragma("unroll") for (int n = 0; n < NB; ++n) acc[m][n] = __builtin_amdgcn_mfma_f32_16x16x32_bf16(fb[st][n], fa[st][m], acc[m][n], 0, 0, 0); } while (0)
#define SK_SB() __builtin_amdgcn_sched_barrier(0)
        const int nst = kw >> 5, kl = kw - 32;
#pragma unroll
        for (int j = 0; j < NS - 1; ++j) { SK_LOAD(j, (j * 32 < kw ? j * 32 : kl)); SK_SB(); }
        for (int s0 = 0; s0 < nst; s0 += NS) {
#pragma unroll
            for (int j = 0; j < NS; ++j) { const int kn = (s0 + j + NS - 1) * 32; SK_LOAD((j + NS - 1) % NS, kn < kw ? kn : kl); SK_SB(); if (s0 + j < nst) SK_MMA(j); SK_SB(); }
        }
#undef SK_SB
#undef SK_LOAD
#undef SK_MMA
#undef SK_PERM
#pragma unroll
        for (int half = 2; half >= 1; half >>= 1) {
            if (kq >= half && kq < 2 * half) { SLAS f32x4* s = (SLAS f32x4*)(lds + (ch * 2 + kq - half) * SLOT) + lane;
#pragma unroll
                for (int m = 0; m < MB; ++m)
#pragma unroll
                    for (int n = 0; n < NB; ++n) s[(m * NB + n) * 64] = acc[m][n]; }
            __syncthreads();
            if (kq < half) { const SLAS f32x4* s = (const SLAS f32x4*)(lds + (ch * 2 + kq) * SLOT) + lane;
#pragma unroll
                for (int m = 0; m < MB; ++m)
#pragma unroll
                    for (int n = 0; n < NB; ++n) acc[m][n] = acc[m][n] + s[(m * NB + n) * 64]; }
            __syncthreads();
        }
        if constexpr (Epi::NEEDS_X) { if (kq == 0) E.partial(acc, rt, ct, ch, fr, fq, red); __syncthreads(); }
        if (kq == 0) E(acc, rt, ct, ch, fr, fq, red);
        if constexpr (Epi::NEEDS_X) __syncthreads();
    }
}
}

namespace att {
typedef short bf16x8 __attribute__((ext_vector_type(8)));
typedef short s16x4 __attribute__((ext_vector_type(4)));
typedef float f32x16 __attribute__((ext_vector_type(16)));
typedef float f32x4 __attribute__((ext_vector_type(4)));
typedef unsigned u32x4 __attribute__((ext_vector_type(4)));
typedef unsigned short bf16;
#define ALAS __attribute__((address_space(3)))
constexpr int D = 128, NW = 8, QBLK = 32, KVBLK = 64, QB = NW * QBLK;
constexpr int SHM_V = KVBLK * D * 2, SHM_K = KVBLK * D * 2;
constexpr int OFF_V = 0, OFF_K = 2 * SHM_V, OFF_WS = 2 * SHM_V + 2 * SHM_K, OFF_TAB = OFF_WS + NW * 64 * 4, OFF_BIAS = OFF_TAB + 1024, LDS_END = OFF_BIAS + 8192 * 4 + 512;
constexpr float SCALE = 0.08838834764831845f, RSCALE = 11.313708498984761f;
constexpr float THR = 8.f;
#define KSWZ(row, colB) ((row) * 256 + ((colB) ^ (((row) & 7) << 4)))
#define SBAR() __builtin_amdgcn_sched_barrier(0)
__device__ __forceinline__ int v_st(int k, int c) { const int kk = (k & ~0xC) | ((k & 4) << 1) | ((k & 8) >> 1); return ((kk >> 3) * 4 + (c >> 5)) * 512 + ((kk & 7) * 32 + (c & 31)) * 2; }
__device__ __forceinline__ int v_rd_base(int lane) { return ((lane & 3) << 3) | (((lane >> 2) & 3) << 6) | (((lane >> 4) & 1) << 5) | (((lane >> 5) & 1) << 8); }
constexpr int v_rd_off(int d0, int ks, int half) { return d0 * 512 + ks * 4096 + half * 2048; }
__device__ __forceinline__ int crow(int r, int hi) { return (r & 3) + 8 * (r >> 2) + 4 * hi; }
__device__ __forceinline__ unsigned cvtpk(float lo, float hi) { unsigned r; asm volatile("v_cvt_pk_bf16_f32 %0, %1, %2" : "=v"(r) : "v"(lo), "v"(hi)); return r; }
__device__ __forceinline__ bf16x8 load8(const bf16* p) { return *reinterpret_cast<const bf16x8*>(p); }
__device__ __forceinline__ void mask_tile(f32x16& p0, f32x16& p1, int dq) {
    const float NEG = -__builtin_inff();
#pragma unroll
    for (int r = 0; r < 16; ++r) {
        const int c = (r & 3) + 8 * (r >> 2);
        if (dq - c < 0) p0[r] = NEG;
        if (dq - c - 32 < 0) p1[r] = NEG;
    }
}
__device__ __forceinline__ void partialSM(f32x16& p0, f32x16& p1, float& m_reg, float& mn, float& alpha) {
    float pmax = p0[0]; for (int r = 1; r < 16; ++r) pmax = fmaxf(pmax, p0[r]); for (int r = 0; r < 16; ++r) pmax = fmaxf(pmax, p1[r]);
    { auto rr = __builtin_amdgcn_permlane32_swap(__float_as_uint(pmax), __float_as_uint(pmax), false, false);
      pmax = fmaxf(__uint_as_float(rr[0]), __uint_as_float(rr[1])); }
    constexpr float C2 = 1.4426950408889634f * SCALE;
    if (__builtin_expect(__all((pmax - m_reg) * SCALE <= THR), 1)) { mn = m_reg; alpha = 1.f; }
    else { mn = fmaxf(m_reg, pmax); alpha = __builtin_amdgcn_exp2f((m_reg - mn) * C2); m_reg = mn; }
    const float mnL = -mn * C2;
    for (int r = 0; r < 16; ++r) p0[r] = fmaf(p0[r], C2, mnL); for (int r = 0; r < 16; ++r) p1[r] = fmaf(p1[r], C2, mnL);
    for (int r = 0; r < 16; ++r) p0[r] = __builtin_amdgcn_exp2f(p0[r]);
}
__device__ __forceinline__ void finishSM(f32x16& p0, f32x16& p1, float alpha, float& l_reg, bf16x8& pa0, bf16x8& pa1, bf16x8& pa2, bf16x8& pa3) {
    for (int r = 0; r < 16; ++r) p1[r] = __builtin_amdgcn_exp2f(p1[r]);
    float ps = 0; for (int r = 0; r < 16; ++r) ps += p0[r]; for (int r = 0; r < 16; ++r) ps += p1[r];
    { auto rr = __builtin_amdgcn_permlane32_swap(__float_as_uint(ps), __float_as_uint(ps), false, false);
      ps = __uint_as_float(rr[0]) + __uint_as_float(rr[1]); }
    l_reg = l_reg * alpha + ps;
#define PK4(P, B_, OUT) do { unsigned a0 = cvtpk(P[B_+0], P[B_+1]), a1 = cvtpk(P[B_+2], P[B_+3]);                          \
        unsigned b0 = cvtpk(P[B_+4], P[B_+5]), b1 = cvtpk(P[B_+6], P[B_+7]);                                             \
        auto r0 = __builtin_amdgcn_permlane32_swap(a0, b0, false, false); auto r1 = __builtin_amdgcn_permlane32_swap(a1, b1, false, false); \
        u32x4 w = {r0[0], r1[0], r0[1], r1[1]}; OUT = *reinterpret_cast<bf16x8*>(&w); } while (0)
    PK4(p0, 0, pa0); PK4(p0, 8, pa1); PK4(p1, 0, pa2); PK4(p1, 8, pa3);
#undef PK4
}
struct Blk {
    const bf16* Q; const bf16* K; const bf16* V; bf16* O;
    const float* aux;
    int P0;
    int jlo, jhi;
    int cap;
    int c0;
    float skipthr;
};
struct Nxt { const bf16* Q; const bf16* K; const bf16* V; int jlo; };
constexpr int OSTR = 2048;
struct Seam { bf16x8 qr[8]; bf16x8 st_v0, st_v1, st_k0, st_k1; };

template <int MODE, int KB>
__device__ __forceinline__ void qkt(f32x16& p0, f32x16& p1, ALAS const char* lds, int r32, int hi, const bf16x8* qr, bool act, int tile  , int dist  , int irow  ) {
    if (!act) { const float NEG = -__builtin_inff();
#pragma unroll
        for (int r = 0; r < 16; ++r) { p0[r] = NEG; p1[r] = NEG; } return; }
    if constexpr (MODE == 1) {
        ALAS const float* bp = (ALAS const float*)(lds + OFF_BIAS) + tile * 64 + 4 * hi;
#pragma unroll
        for (int i = 0; i < 4; ++i) { const f32x4 a = *(ALAS const f32x4*)(bp + 8 * i), b = *(ALAS const f32x4*)(bp + 32 + 8 * i);
            p0[4 * i] = a[0]; p0[4 * i + 1] = a[1]; p0[4 * i + 2] = a[2]; p0[4 * i + 3] = a[3]; p1[4 * i] = b[0]; p1[4 * i + 1] = b[1]; p1[4 * i + 2] = b[2]; p1[4 * i + 3] = b[3]; }
    } else {
        ALAS const float* R = (ALAS const float*)(lds + OFF_TAB);
        if (dist <= 2) { ALAS const float* rp = R + (191 - 64 * dist - irow + 4 * hi);
#pragma unroll
            for (int r = 0; r < 16; ++r) { p0[r] = rp[(r & 3) + 8 * (r >> 2)]; p1[r] = rp[32 + (r & 3) + 8 * (r >> 2)]; } }
        else { const float cf = R[0];
#pragma unroll
            for (int r = 0; r < 16; ++r) { p0[r] = cf; p1[r] = cf; } }
    }
    ALAS const char* K_lds = lds + OFF_K;
    ALAS const char* kb[4];
#pragma unroll
    for (int dd = 0; dd < 4; ++dd) kb[dd] = K_lds + KB * SHM_K + KSWZ(r32, (dd * 16 + hi * 8) * 2);
#pragma unroll
    for (int d0 = 0; d0 < 8; ++d0) { ALAS const char* a = kb[d0 & 3] + (d0 >> 2) * 128;
        bf16x8 b0 = *reinterpret_cast<ALAS const bf16x8*>(a);
        bf16x8 b1 = *reinterpret_cast<ALAS const bf16x8*>(a + 32 * 256);
        p0 = __builtin_amdgcn_mfma_f32_32x32x16_bf16(b0, qr[d0], p0, 0, 0, 0);
        p1 = __builtin_amdgcn_mfma_f32_32x32x16_bf16(b1, qr[d0], p1, 0, 0, 0); }
}
template <int MODE, int VB>
__device__ __forceinline__ void pv_tile(f32x16* o, int vb0, bf16x8 pa0, bf16x8 pa1, bf16x8 pa2, bf16x8 pa3, bool act) {
    if (!act) return;
#define TRRD(dst, off) asm volatile("ds_read_b64_tr_b16 %0, %1 offset:%2" : "=&v"(dst) : "v"(vb0), "i"(off) : "memory")
#define PV_D0(d0) do { s16x4 l0, l1, l2, l3, h0, h1, h2, h3; constexpr int b_ = VB * SHM_V + v_rd_off(d0, 0, 0); \
        TRRD(l0, b_); TRRD(h0, b_ + 2048); TRRD(l1, b_ + 4096); TRRD(h1, b_ + 6144); TRRD(l2, b_ + 8192); TRRD(h2, b_ + 10240); TRRD(l3, b_ + 12288); TRRD(h3, b_ + 14336); \
        asm volatile("s_waitcnt lgkmcnt(0)" ::: "memory"); SBAR();   \
        o[d0] = __builtin_amdgcn_mfma_f32_32x32x16_bf16(pa0, (bf16x8){l0[0], l0[1], l0[2], l0[3], h0[0], h0[1], h0[2], h0[3]}, o[d0], 0, 0, 0);   \
        o[d0] = __builtin_amdgcn_mfma_f32_32x32x16_bf16(pa1, (bf16x8){l1[0], l1[1], l1[2], l1[3], h1[0], h1[1], h1[2], h1[3]}, o[d0], 0, 0, 0);   \
        o[d0] = __builtin_amdgcn_mfma_f32_32x32x16_bf16(pa2, (bf16x8){l2[0], l2[1], l2[2], l2[3], h2[0], h2[1], h2[2], h2[3]}, o[d0], 0, 0, 0);   \
        o[d0] = __builtin_amdgcn_mfma_f32_32x32x16_bf16(pa3, (bf16x8){l3[0], l3[1], l3[2], l3[3], h3[0], h3[1], h3[2], h3[3]}, o[d0], 0, 0, 0); } while (0)
    PV_D0(0); PV_D0(1); PV_D0(2); PV_D0(3);
#undef PV_D0
#undef TRRD
}
#define AROW(p, k0, rr) ((const bf16*)((const char*)(p) + (size_t)(unsigned)(((k0) + (rr)) * (D * 2) + sc * 2)))
#define VMW() asm volatile("s_waitcnt vmcnt(0)" ::: "memory")
#define VMWN(n) asm volatile("s_waitcnt vmcnt(%0)" :: "i"(n) : "memory")
#define SLOAD_H(Kp, Vp, k0) do { S.st_v0 = load8(AROW(Vp, k0, sr)); S.st_v1 = load8(AROW(Vp, k0, 32 + sr));              \
                         S.st_k0 = load8(AROW(Kp, k0, sr)); S.st_k1 = load8(AROW(Kp, k0, 32 + sr)); } while (0)
#define SWRITE_HK(bf) do { *(ALAS bf16x8*)(K_lds + (bf) * SHM_K + kws) = S.st_k0; *(ALAS bf16x8*)(K_lds + (bf) * SHM_K + kws + 32 * 256) = S.st_k1; } while (0)
#define SWRITE_HV(bf) do { *(ALAS bf16x8*)(V_lds + (bf) * SHM_V + vst0) = S.st_v0; *(ALAS bf16x8*)(V_lds + (bf) * SHM_V + vst1) = S.st_v1; } while (0)
#define SWRITE_H(bf) do { SWRITE_HV(bf); SWRITE_HK(bf); } while (0)
template <int MODE>
__device__ __forceinline__ float build_bias(const Blk& b, ALAS char* lds, int tid) {
    asm volatile("" : "+v"(tid));
    if constexpr (MODE == 0) {
        if (tid < 256) { int d = 191 - tid; d = d < -128 ? -128 : (d > 128 ? 128 : d); ((ALAS float*)(lds + OFF_TAB))[tid] = b.aux[d + 128] * RSCALE; }
        return 0.f;
    } else {
        const int nk = b.jhi * 64, nv = b.cap + 1, e0 = tid * 16, lane = tid & 63, wid = tid >> 6;
        float v[16];
#pragma unroll
        for (int i = 0; i < 4; ++i) { f32x4 x = (f32x4){0.f, 0.f, 0.f, 0.f};
            if (e0 + 4 * i < nv) x = *(const f32x4*)(b.aux + e0 + 4 * i);
            v[4 * i] = x[0]; v[4 * i + 1] = x[1]; v[4 * i + 2] = x[2]; v[4 * i + 3] = x[3]; }
        float run = 0.f;
#pragma unroll
        for (int i = 15; i >= 0; --i) { const float x = v[i]; v[i] = run; run += x; }
        float incl = run;
#pragma unroll
        for (int o = 1; o < 64; o <<= 1) { const float t = __int_as_float(__builtin_amdgcn_ds_bpermute(((lane + o) & 63) << 2, __float_as_int(incl))); if (lane + o < 64) incl += t; }
        ALAS float* wt = (ALAS float*)(lds + OFF_TAB);
        if (lane == 0) wt[wid] = incl;
        asm volatile("s_waitcnt lgkmcnt(0)" ::: "memory"); __builtin_amdgcn_s_barrier(); asm volatile("" ::: "memory");
        float after = incl - run;
#pragma unroll
        for (int w = 1; w < 8; ++w) { const float t = wt[w]; if (w > wid) after += t; }
        if (e0 < nk) { ALAS f32x4* o4 = (ALAS f32x4*)(lds + OFF_BIAS) + tid * 4;
#pragma unroll
            for (int i = 0; i < 4; ++i) o4[i] = (f32x4){(v[4 * i] + after) * RSCALE, (v[4 * i + 1] + after) * RSCALE, (v[4 * i + 2] + after) * RSCALE, (v[4 * i + 3] + after) * RSCALE}; }
        return after;
    }
}
template <int MODE>
__device__ __forceinline__ void attn_prime(const Blk& cur, ALAS char* lds, Seam& S, int tid) {
    asm volatile("" : "+v"(tid));
    const int wid = __builtin_amdgcn_readfirstlane(tid >> 6), lane = tid & 63, r32 = lane & 31, hi = lane >> 5;
    const int sr = tid >> 4, sc = (tid & 15) * 8, kws = KSWZ(sr, sc * 2); ALAS char* K_lds = lds + OFF_K;
    const int kb0 = cur.jlo * KVBLK;
    const int qrow = wid * QBLK + r32;
#pragma unroll
    for (int d0 = 0; d0 < 8; ++d0) S.qr[d0] = load8((const bf16*)((const char*)cur.Q + (size_t)(unsigned)(qrow * (D * 2) + hi * 16 + d0 * 32)));
    SLOAD_H(cur.K, cur.V, kb0); VMW(); SWRITE_HK(0);
    __syncthreads();
}
template <int MODE, class IssueFn, class NextFn>
__device__ __forceinline__ void attn_block(const Blk& cur, IssueFn&& issue_fn, NextFn&& next_fn, ALAS char* lds, Seam& S, int tid) {
    asm volatile("" : "+v"(tid));
    const int wid = __builtin_amdgcn_readfirstlane(tid >> 6), lane = tid & 63, r32 = lane & 31, hi = lane >> 5;
    bf16x8 kd[8];
    if constexpr (MODE == 1) { const char* kp = (const char*)cur.K + (size_t)(unsigned)((cur.P0 + wid * QBLK + r32) * (D * 2) + hi * 16);
#pragma unroll
        for (int d0 = 0; d0 < 8; ++d0) kd[d0] = load8((const bf16*)(kp + d0 * 32)); }
    const float s_end = build_bias<MODE>(cur, lds, tid);
    asm volatile("s_waitcnt lgkmcnt(0)" ::: "memory"); __syncthreads();
    int j_lo = cur.jlo;
    const int sr = tid >> 4, sc = (tid & 15) * 8, vst0 = v_st(sr, sc), vst1 = v_st(32 + sr, sc), kws = KSWZ(sr, sc * 2);
    ALAS char* V_lds = lds + OFF_V; ALAS char* K_lds = lds + OFF_K;
    if constexpr (MODE == 1) {
        float dsum = 0.f;
#pragma unroll
        for (int d0 = 0; d0 < 8; ++d0) { const u32x4 qa = *reinterpret_cast<const u32x4*>(&S.qr[d0]), ka = *reinterpret_cast<const u32x4*>(&kd[d0]);
#pragma unroll
            for (int i = 0; i < 4; ++i) { dsum = fmaf(__uint_as_float(qa[i] << 16), __uint_as_float(ka[i] << 16), dsum);
                dsum = fmaf(__uint_as_float(qa[i] & 0xffff0000u), __uint_as_float(ka[i] & 0xffff0000u), dsum); } }
        { auto rr = __builtin_amdgcn_permlane32_swap(__float_as_uint(dsum), __float_as_uint(dsum), false, false); dsum = __uint_as_float(rr[0]) + __uint_as_float(rr[1]); }
        float gv = (((ALAS const float*)(lds + OFF_BIAS))[cur.P0 + wid * QBLK + r32] + dsum) * SCALE;
#pragma unroll
        for (int o = 1; o < 32; o <<= 1) gv = fminf(gv, __shfl_xor(gv, o));
        ALAS float* wg = (ALAS float*)(lds + OFF_TAB) + 32;
        if (lane == 0) wg[wid] = gv;
        asm volatile("s_waitcnt lgkmcnt(0)" ::: "memory"); __builtin_amdgcn_s_barrier(); asm volatile("" ::: "memory");
        float G = wg[0];
#pragma unroll
        for (int w = 1; w < 8; ++w) G = fminf(G, wg[w]);
        const bool pred = ((tid & 3) == 3) && ((tid >> 2) < (cur.P0 >> 6)) && (s_end < G - cur.skipthr);
        const int cnt = __builtin_popcountll(__ballot(pred));
        ALAS int* wcnt = (ALAS int*)(lds + OFF_TAB) + 16;
        if (lane == 0) wcnt[wid] = cnt;
        asm volatile("s_waitcnt lgkmcnt(0)" ::: "memory"); __builtin_amdgcn_s_barrier(); asm volatile("" ::: "memory");
        int tot = 0;
#pragma unroll
        for (int w = 0; w < 8; ++w) tot += wcnt[w];
        j_lo = __builtin_amdgcn_readfirstlane(tot);
        if (j_lo != cur.jlo) {
            SLOAD_H(cur.K, cur.V, j_lo * KVBLK); VMW(); SWRITE_HK(0); }
        __syncthreads();
    }
    const int NT = cur.jhi - j_lo;
    const int wlim = cur.P0 + wid * QBLK;
    const int qm = wlim + r32 - 4 * hi;
    const int cw = cur.c0 + (wid >> 1);
    const int irow = (wid & 1) * 32 + r32;
    ALAS float* wsf = (ALAS float*)(lds + OFF_WS) + wid * 64; ALAS float* li_l = wsf; ALAS float* al_l = wsf + 32;
    float m_reg = -1e30f, l_reg = 0; f32x16 o[4] = {};
    const int vb0 = (int)(unsigned)(unsigned long long)V_lds + v_rd_base(lane);
    const bf16* Kh = cur.K; const bf16* Vh = cur.V;
#define RESC(a) do { if (__any((a) < 1.f)) { if (hi == 0) al_l[r32] = (a); asm volatile("s_waitcnt lgkmcnt(0)" ::: "memory");              \
                     for (int d_ = 0; d_ < 4; ++d_) for (int r = 0; r < 16; ++r) o[d_][r] *= al_l[crow(r, hi)]; } } while (0)
#define KBASE(t) ((j_lo + (t)) * KVBLK)
#define ACT(t) (MODE == 1 ? (KBASE(t) <= wlim + QBLK - 1) : ((j_lo + (t)) >= cw - 8 && (j_lo + (t)) <= cw))
#define MASKT(P0_, P1_, t) do { if (MODE == 1) { const int kb_ = KBASE(t); if (kb_ + KVBLK - 1 > wlim) mask_tile(P0_, P1_, qm - kb_); } } while (0)
#define QKT(KB, PX0, PX1, t) qkt<MODE, KB>(PX0, PX1, lds, r32, hi, S.qr, ACT(t), j_lo + (t), cw - (j_lo + (t)), irow)
    constexpr int NQL = 8;
#define SEAM_K0() do { VMWN(NQL); SWRITE_HK(0); SBAR(); } while (0)
    f32x16 pA0, pA1, pB0, pB1; float mnA, mnB, alA, alB; bf16x8 pa0, pa1, pa2, pa3;
    SWRITE_HV(0); SBAR();
    if (NT > 1) SLOAD_H(Kh, Vh, KBASE(1));
    SBAR(); QKT(0, pA0, pA1, 0);
    MASKT(pA0, pA1, 0); partialSM(pA0, pA1, m_reg, mnA, alA);
    if (NT > 1) { VMW(); SWRITE_H(1); }
    __syncthreads();
#define HALF_STEP(PX0, PX1, mnX, alX, PY0, PY1, alY, t, KB, VB, SB) do {                                                      \
        SBAR(); QKT(KB, PX0, PX1, t);                                                                                          \
        finishSM(PY0, PY1, alY, l_reg, pa0, pa1, pa2, pa3); SBAR();                                                           \
        if ((t) + 1 < NT) { SLOAD_H(Kh, Vh, KBASE((t) + 1)); SBAR(); }                                                        \
        pv_tile<MODE, VB>(o, vb0, pa0, pa1, pa2, pa3, ACT((t) - 1)); MASKT(PX0, PX1, (t)); partialSM(PX0, PX1, m_reg, mnX, alX);   \
        __syncthreads();                                                                                                      \
        if ((t) + 1 < NT) { VMW(); SWRITE_H(SB); }                                                                            \
        RESC(alX); __syncthreads(); } while (0)
    if (NT < 3) issue_fn();
    for (int t = 1; t + 1 < NT; t += 2) {
        if (t + 3 >= NT) issue_fn();
        HALF_STEP(pB0, pB1, mnB, alB, pA0, pA1, alA, t, 1, 0, 0);
        HALF_STEP(pA0, pA1, mnA, alA, pB0, pB1, alB, t + 1, 0, 1, 1);
    }
    Nxt nxt; next_fn(nxt);
    const int kbn = nxt.jlo * KVBLK;
    const bool even = (NT & 1) == 0;
    if (even) { SBAR(); QKT(1, pB0, pB1, NT - 1); SBAR(); }
    SLOAD_H(nxt.K, nxt.V, kbn); SBAR();
    { const int qrow = wid * QBLK + r32;
#pragma unroll
      for (int d0 = 0; d0 < 8; ++d0) S.qr[d0] = load8((const bf16*)((const char*)nxt.Q + (size_t)(unsigned)(qrow * (D * 2) + hi * 16 + d0 * 32))); }
    SBAR();
    finishSM(pA0, pA1, alA, l_reg, pa0, pa1, pa2, pa3); SBAR();
    pv_tile<MODE, 0>(o, vb0, pa0, pa1, pa2, pa3, ACT(even ? NT - 2 : NT - 1));
    if (even) { MASKT(pB0, pB1, NT - 1); partialSM(pB0, pB1, m_reg, mnB, alB); __syncthreads(); RESC(alB);
        finishSM(pB0, pB1, alB, l_reg, pa0, pa1, pa2, pa3); SBAR(); pv_tile<MODE, 1>(o, vb0, pa0, pa1, pa2, pa3, ACT(NT - 1)); }
    SBAR(); SEAM_K0();
    __syncthreads();
    if (hi == 0) li_l[r32] = l_reg; asm volatile("s_waitcnt lgkmcnt(0)" ::: "memory");
    float rli[16];
#pragma unroll
    for (int r = 0; r < 16; ++r) rli[r] = __builtin_amdgcn_rcpf(li_l[crow(r, hi)]);
    ALAS char* stg = lds + OFF_V + wid * 4096 + (4 * hi) * 128 + r32 * 2;
    ALAS const char* srd = lds + OFF_V + wid * 4096 + (lane >> 3) * 128 + (lane & 7) * 16;
    unsigned ooff = (unsigned)(((wid * QBLK + (lane >> 3)) * OSTR + (lane & 7) * 8) * 2);
    asm volatile("" : "+v"(ooff));
#pragma unroll
    for (int ps = 0; ps < 2; ++ps) {
#pragma unroll
        for (int dd = 0; dd < 2; ++dd)
#pragma unroll
            for (int r = 0; r < 16; r += 2) { const unsigned w = cvtpk(o[2 * ps + dd][r] * rli[r], o[2 * ps + dd][r + 1] * rli[r + 1]);
                ALAS char* a = stg + ((r & 3) + 8 * (r >> 2)) * 128 + dd * 64;
                *(ALAS unsigned short*)a = (unsigned short)w; *(ALAS unsigned short*)(a + 128) = (unsigned short)(w >> 16); }
        asm volatile("s_waitcnt lgkmcnt(0)" ::: "memory");
        u32x4 q[4];
#pragma unroll
        for (int i = 0; i < 4; ++i) q[i] = *(ALAS const u32x4*)(srd + i * 1024);
        asm volatile("s_waitcnt lgkmcnt(0)" ::: "memory");
#pragma unroll
        for (int i = 0; i < 4; ++i) *(u32x4*)((char*)cur.O + (size_t)(ooff + (unsigned)(i * 8 * OSTR * 2 + ps * 128))) = q[i];
    }
    __syncthreads();
#undef RESC
#undef KBASE
#undef ACT
#undef MASKT
#undef QKT
#undef SEAM_K0
#undef HALF_STEP
}
#undef AROW
#undef VMW
#undef VMWN
#undef SLOAD_H
#undef SWRITE_HK
#undef SWRITE_HV
#undef SWRITE_H
}

constexpr int NWAVES = 8;
constexpr int NB = 2, T = 8192, D = 2048, NH = 16, HD = 128, FF = 5632, DEPTH = 4;
constexpr int SB = 16, SN = 16, PAST = 1024, WIN = 512, NREL = 257;
constexpr int MP = NB * T, MS = SB * SN, M = MP + MS;
constexpr int NQKV = 3 * D, NGU = 2 * FF;
constexpr int LS = PAST + SN;
constexpr float EPS = 1e-6f, SCALE = 0.08838834764831845f;
constexpr size_t O_Y = 0, O_YS = (size_t)MP * D, O_AKP = O_YS + (size_t)MS * D, SZ_AP = (size_t)2 * NB * WIN * D, O_AVP = O_AKP + SZ_AP, O_BKP = O_AVP + SZ_AP,
    SZ_BP = (size_t)2 * MP * D, O_BVP = O_BKP + SZ_BP, O_BFP = O_BVP + SZ_BP, SZ_BFP = (size_t)2 * MP * NH, O_AKS = O_BFP + SZ_BFP, SZ_S = (size_t)2 * MS * D,
    O_AVS = O_AKS + SZ_S, O_BKS = O_AVS + SZ_S, O_BVS = O_BKS + SZ_S, O_BFS = O_BVS + SZ_S, OUT_TOTAL = O_BFS + (size_t)2 * MS * NH;
static_assert(OUT_TOTAL == 181411840, "out size");
constexpr size_t MiB = 1u << 20;
constexpr size_t WS_CTL = 0, CTL_ZERO_BYTES = 1 * MiB;
constexpr size_t WS_WQKV = 2 * MiB, WS_WO = 98 * MiB, WS_WGU = 130 * MiB, WS_WD = 306 * MiB;
constexpr size_t WS_XB = 394 * MiB, WS_SSQ = 459 * MiB;
constexpr size_t WS_QP = 462 * MiB, WS_KP = 526 * MiB, WS_VP = 590 * MiB;
constexpr size_t WS_QS = 654 * MiB;
constexpr size_t WS_OB = 655 * MiB, WS_HB = 720 * MiB;
constexpr size_t WS_KSN = 899 * MiB, WS_VSN = 900 * MiB;
constexpr size_t WS_LFP = 1315 * MiB, WS_WF = 1316 * MiB  , WS_LFS = 1317 * MiB, WS_CUMS = 1319 * MiB, WS_END = 1321 * MiB;
static_assert(WS_WQKV + (size_t)DEPTH * NQKV * D * 2 <= WS_WO && WS_WO + (size_t)DEPTH * D * D * 2 <= WS_WGU && WS_WGU + (size_t)DEPTH * NGU * D * 2 <= WS_WD && WS_WD + (size_t)DEPTH * D * FF * 2 <= WS_XB, "ws map: weights");
static_assert(WS_XB + (size_t)M * D * 2 <= WS_SSQ && WS_SSQ + (size_t)M * 32 * 4 <= WS_QP && WS_OB + (size_t)M * D * 2 <= WS_HB && WS_HB + (size_t)M * FF * 2 <= WS_KSN, "ws map: activations");
constexpr int CW_BAR = 4096, CW_QUEUE = 8192, CW_SKQ = 8192 + 256;
constexpr size_t WS_QKM = WS_WF + 512 * 1024;
constexpr int RING_OFF = 0, RING_BYTES = 131072;
constexpr int LDSCTL_OFF = RING_BYTES, MISC_OFF = LDSCTL_OFF + 320, RED_OFF = LDSCTL_OFF + 1024;
constexpr int LDS_BYTES = 147456;
#define GAS __attribute__((address_space(1)))
#define LAS __attribute__((address_space(3)))
typedef unsigned short bf16;
typedef unsigned v4u __attribute__((ext_vector_type(4)));
typedef float f32x4 __attribute__((ext_vector_type(4)));
typedef short bf16x8 __attribute__((ext_vector_type(8)));
typedef GAS unsigned gu32;
typedef GAS unsigned long long gu64;
#define RLX_AGENT __ATOMIC_RELAXED, __HIP_MEMORY_SCOPE_AGENT
#define LDS_WAIT() asm volatile("s_waitcnt lgkmcnt(0)" ::: "memory")
#define VM_WAIT() asm volatile("s_waitcnt vmcnt(0)" ::: "memory")
__device__ __forceinline__ unsigned long long rt() { return __builtin_amdgcn_s_memrealtime(); }
__device__ __forceinline__ unsigned f2bf(float f) { unsigned u = __builtin_bit_cast(unsigned, f); return (u + 0x7fffu + ((u >> 16) & 1u)) >> 16; }
__device__ __forceinline__ unsigned pk2(float lo, float hi) { return f2bf(lo) | (f2bf(hi) << 16); }

#define XB_TMO      128
#define XB_XCNT(j)  (256  + 64 * (j))
#define XB_XSUB(j)  (1280 + 64 * (j))
#define XB_XGEN(j)  (2304 + 64 * (j))
#define XB_TOP      3328
#define XB_TOPGEN   3392
#define XCD_BAR_WORDS 3456
#define XB_SPIN_CAP (1u << 22)

__device__ __forceinline__ unsigned xb_ld(unsigned* p)              { return __hip_atomic_load(p, __ATOMIC_RELAXED, __HIP_MEMORY_SCOPE_AGENT); }
__device__ __forceinline__ unsigned xb_add(unsigned* p, unsigned v) { return __hip_atomic_fetch_add(p, v, __ATOMIC_RELAXED, __HIP_MEMORY_SCOPE_AGENT); }
__device__ __forceinline__ unsigned xb_xcc_id() { return (unsigned)__builtin_amdgcn_s_getreg((3 << 11) | 20) & 0xFu; }
#define XB_SPIN(cond, bar) do { unsigned _sp = 0; while (cond) { __builtin_amdgcn_s_sleep(1); \
    if ((++_sp & 255u) == 0u) { if (xb_ld(&(bar)[XB_TMO])) break; if (_sp > XB_SPIN_CAP) { atomicAdd(&(bar)[XB_TMO], 1u); break; } } } } while (0)

struct XcdBarrier {
    unsigned* bar; unsigned x;
    volatile LAS unsigned* st;
};

__device__ __forceinline__ XcdBarrier xcd_barrier_post(unsigned* bar, volatile LAS unsigned* st, const bool leader  ) {
    XcdBarrier b; b.bar = bar; b.x = xb_xcc_id(); b.st = st;
    if (leader) (void)xb_add(&bar[XB_XCNT(b.x)], 1u);
    return b;
}
__device__ __forceinline__ void xcd_barrier_complete(unsigned* bar, unsigned x, unsigned& nloc, unsigned& nx) {
    const unsigned G = gridDim.x * gridDim.y * gridDim.z;
    unsigned sum, cnt, mine, sp = 0u;
    for (;;) {
        sum = 0u; cnt = 0u; mine = 0u;
#pragma unroll
        for (unsigned j = 0; j < 16; ++j) { const unsigned c = xb_ld(&bar[XB_XCNT(j)]); sum += c; cnt += (c > 0u) ? 1u : 0u; mine = (j == x) ? c : mine; }
        if (sum == G) break;
        __builtin_amdgcn_s_sleep(1);
        if ((++sp & 255u) == 0u) { if (xb_ld(&bar[XB_TMO])) break; if (sp > XB_SPIN_CAP) { atomicAdd(&bar[XB_TMO], 1u); break; } }
    }
    nloc = mine > 0u ? mine : 1u; nx = cnt > 0u ? cnt : 1u;
}

__device__ __forceinline__ void xcd_barrier(const XcdBarrier& b, const bool leader  ) {
    asm volatile("s_waitcnt vmcnt(0)" ::: "memory");
    __syncthreads();
    if (leader) {
        unsigned* bar = b.bar;
        __builtin_amdgcn_s_waitcnt(0);
        unsigned nloc = b.st[0], nx = b.st[1];
        if (nloc == 0u) { xcd_barrier_complete(bar, b.x, nloc, nx); b.st[0] = nloc; b.st[1] = nx; }
        const unsigned old = xb_add(&bar[XB_XSUB(b.x)], 1u);
        const unsigned gen = old / nloc;
        if (old + 1u == (gen + 1u) * nloc) {
            __builtin_amdgcn_fence(__ATOMIC_RELEASE, "agent");
            asm volatile("s_waitcnt vmcnt(0)" ::: "memory");
            const unsigned og = xb_add(&bar[XB_TOP], 1u);
            const unsigned tg = og / nx;
            if (og + 1u == (tg + 1u) * nx) xb_add(&bar[XB_TOPGEN], 1u);
            else XB_SPIN(xb_ld(&bar[XB_TOPGEN]) == tg, bar);
            __builtin_amdgcn_fence(__ATOMIC_ACQUIRE, "agent");
            xb_add(&bar[XB_XGEN(b.x)], 1u);
            asm volatile("s_waitcnt vmcnt(0)" ::: "memory");
        } else {
            XB_SPIN(xb_ld(&bar[XB_XGEN(b.x)]) == gen, bar);
            __builtin_amdgcn_fence(__ATOMIC_ACQUIRE, "agent");
            asm volatile("s_waitcnt vmcnt(0)" ::: "memory");
        }
    }
    __syncthreads();
}

typedef float f32x2 __attribute__((ext_vector_type(2)));
__device__ __forceinline__ float wave_sum(float v) {
#pragma unroll
    for (int o = 1; o < 64; o <<= 1) v += __shfl_xor(v, o);
    return v;
}
__device__ __forceinline__ float bf2f(unsigned b) { return __uint_as_float(b << 16); }

__device__ __forceinline__ void p0_transpose_item(const float* W, const float* g, int K, int N, bf16* WT, int mode, LAS float* scr, int item, int lane) {
    const int nblk = N / 32, kb = item / nblk, nb = item % nblk, k0 = 64 * kb, n0 = 32 * nb;
    const int kr = lane >> 3, nc = (lane & 7) * 4;
    f32x4 v[8]; float gs[8];
#pragma unroll
    for (int i = 0; i < 8; ++i) { v[i] = *(const GAS f32x4*)(W + (size_t)(k0 + kr + 8 * i) * N + n0 + nc); gs[i] = g ? g[k0 + kr + 8 * i] : 1.f; }
#pragma unroll
    for (int i = 0; i < 8; ++i) { LAS float* s = scr + (kr + 8 * i) * 33 + nc; s[0] = v[i].x * gs[i]; s[1] = v[i].y * gs[i]; s[2] = v[i].z * gs[i]; s[3] = v[i].w * gs[i]; }
    LDS_WAIT(); asm volatile("" ::: "memory");
    const int c = lane & 7;
    const int drow0 = (mode == 0) ? n0 : (256 * (n0 >> 7) + (n0 & 127) + (mode == 2 ? 128 : 0));
#pragma unroll
    for (int j = 0; j < 4; ++j) { const int n = (lane >> 3) + 8 * j; const LAS float* s = scr + (8 * c) * 33 + n;
        v4u o; o.x = pk2(s[0 * 33], s[1 * 33]); o.y = pk2(s[2 * 33], s[3 * 33]); o.z = pk2(s[4 * 33], s[5 * 33]); o.w = pk2(s[6 * 33], s[7 * 33]);
        *(GAS v4u*)(WT + (size_t)(drow0 + n) * K + k0 + 8 * c) = o; }
    LDS_WAIT(); asm volatile("" ::: "memory");
}
__device__ __forceinline__ void p0_item128(const float* W, const float* g, int K, int N, bf16* WT, int mode, LAS float* scr, int item, int lane) {
    const int nblk = N / 32, kb = item / nblk, nb = item % nblk, k0 = 128 * kb, n0 = 32 * nb;
    const int kr = lane >> 3, nc = (lane & 7) * 4;
    f32x4 v[16]; float gs[16];
#pragma unroll
    for (int i = 0; i < 16; ++i) { v[i] = *(const GAS f32x4*)(W + (size_t)(k0 + kr + 8 * i) * N + n0 + nc); gs[i] = g ? g[k0 + kr + 8 * i] : 1.f; }
    const int c = lane & 7;
    const int drow0 = (mode == 0) ? n0 : (256 * (n0 >> 7) + (n0 & 127) + (mode == 2 ? 128 : 0));
#pragma unroll
    for (int hf = 0; hf < 2; ++hf) {
#pragma unroll
        for (int i = 0; i < 8; ++i) { LAS float* s = scr + (kr + 8 * i) * 33 + nc; const f32x4 x = v[hf * 8 + i]; const float gg = gs[hf * 8 + i]; s[0] = x.x * gg; s[1] = x.y * gg; s[2] = x.z * gg; s[3] = x.w * gg; }
        LDS_WAIT(); asm volatile("" ::: "memory");
#pragma unroll
        for (int j = 0; j < 4; ++j) { const int n = (lane >> 3) + 8 * j; const LAS float* s = scr + (8 * c) * 33 + n;
            v4u o; o.x = pk2(s[0 * 33], s[1 * 33]); o.y = pk2(s[2 * 33], s[3 * 33]); o.z = pk2(s[4 * 33], s[5 * 33]); o.w = pk2(s[6 * 33], s[7 * 33]);
            *(GAS v4u*)(WT + (size_t)(drow0 + n) * K + k0 + 64 * hf + 8 * c) = o; }
        LDS_WAIT(); asm volatile("" ::: "memory");
    }
}
constexpr int CI_QKV = (D / 128) * (NQKV / 32), CI_O = (D / 128) * (D / 32), CI_G = (D / 128) * (FF / 32), CI_D = (FF / 128) * (D / 32), CI_L = CI_O + 2 * CI_G + CI_D;
__device__ __forceinline__ int conv_group_items(int grp) { return grp == 0 ? CI_QKV : (grp <= 3 ? CI_L + CI_QKV : CI_L); }
__device__ __forceinline__ void conv_item(const float* const __attribute__((address_space(4)))* in, unsigned char* ws, int grp, int it, LAS float* scr, int lane) {
    bf16* WQKV = (bf16*)(ws + WS_WQKV); bf16* WO = (bf16*)(ws + WS_WO); bf16* WGU = (bf16*)(ws + WS_WGU); bf16* WD = (bf16*)(ws + WS_WD);
    int r = it;
    if (grp > 0) { const int L = grp - 1; const float* gf = in[15] + (size_t)L * D;
        if (r < CI_O) { p0_item128(in[11] + (size_t)L * D * D, nullptr, D, D, WO + (size_t)L * D * D, 0, scr, r, lane); return; } r -= CI_O;
        if (r < CI_G) { p0_item128(in[16] + (size_t)L * D * FF, gf, D, FF, WGU + (size_t)L * NGU * D, 1, scr, r, lane); return; } r -= CI_G;
        if (r < CI_G) { p0_item128(in[17] + (size_t)L * D * FF, gf, D, FF, WGU + (size_t)L * NGU * D, 2, scr, r, lane); return; } r -= CI_G;
        if (r < CI_D) { p0_item128(in[18] + (size_t)L * FF * D, nullptr, FF, D, WD + (size_t)L * D * FF, 0, scr, r, lane); return; } r -= CI_D;
    }
    const int Lq = grp;
    p0_item128(in[8] + (size_t)Lq * D * NQKV, in[7] + (size_t)Lq * D, D, NQKV, WQKV + (size_t)Lq * NQKV * D, 0, scr, r, lane);
}
constexpr int N_SLICE = 256;
struct ConvD { const float* W; const float* g; bf16* WT; int K, N, mode, item; };
__device__ __forceinline__ ConvD conv_desc(const float* const __attribute__((address_space(4)))* in, unsigned char* ws, int grp, int it) {
    ConvD d; int r = it; const int L = grp - 1;
    if (r < CI_O) { d.W = in[11] + (size_t)L * D * D; d.g = nullptr; d.WT = (bf16*)(ws + WS_WO) + (size_t)L * D * D; d.K = D; d.N = D; d.mode = 0; d.item = r; return d; } r -= CI_O;
    if (r < 2 * CI_G) { const int up = r >= CI_G ? 1 : 0; d.W = in[16 + up] + (size_t)L * D * FF; d.g = in[15] + (size_t)L * D; d.WT = (bf16*)(ws + WS_WGU) + (size_t)L * NGU * D; d.K = D; d.N = FF; d.mode = 1 + up; d.item = r - up * CI_G; return d; } r -= 2 * CI_G;
    if (r < CI_D) { d.W = in[18] + (size_t)L * FF * D; d.g = nullptr; d.WT = (bf16*)(ws + WS_WD) + (size_t)L * D * FF; d.K = FF; d.N = D; d.mode = 0; d.item = r; return d; } r -= CI_D;
    d.W = in[8] + (size_t)grp * D * NQKV; d.g = in[7] + (size_t)grp * D; d.WT = (bf16*)(ws + WS_WQKV) + (size_t)grp * NQKV * D; d.K = D; d.N = NQKV; d.mode = 0; d.item = r; return d;
}
__device__ __forceinline__ void p0_load128(const ConvD& d, f32x4 (&v)[16], float (&gs)[16], int lane) {
    const int nblk = d.N / 32, kb = d.item / nblk, nb = d.item % nblk, k0 = 128 * kb, n0 = 32 * nb;
    const int kr = lane >> 3, nc = (lane & 7) * 4;
#pragma unroll
    for (int i = 0; i < 16; ++i) { v[i] = *(const GAS f32x4*)(d.W + (size_t)(k0 + kr + 8 * i) * d.N + n0 + nc); gs[i] = d.g ? d.g[k0 + kr + 8 * i] : 1.f; }
}
__device__ __forceinline__ void p0_finish128(const ConvD& d, const f32x4 (&v)[16], const float (&gs)[16], LAS float* scr, int lane) {
    const int nblk = d.N / 32, kb = d.item / nblk, nb = d.item % nblk, k0 = 128 * kb, n0 = 32 * nb;
    const int kr = lane >> 3, nc = (lane & 7) * 4, c = lane & 7;
    const int drow0 = (d.mode == 0) ? n0 : (256 * (n0 >> 7) + (n0 & 127) + (d.mode == 2 ? 128 : 0));
#pragma unroll
    for (int hf = 0; hf < 2; ++hf) {
#pragma unroll
        for (int i = 0; i < 8; ++i) { LAS float* s = scr + (kr + 8 * i) * 33 + nc; const f32x4 x = v[hf * 8 + i]; const float gg = gs[hf * 8 + i]; s[0] = x.x * gg; s[1] = x.y * gg; s[2] = x.z * gg; s[3] = x.w * gg; }
        LDS_WAIT(); asm volatile("" ::: "memory");
#pragma unroll
        for (int j = 0; j < 4; ++j) { const int n = (lane >> 3) + 8 * j; const LAS float* s = scr + (8 * c) * 33 + n;
            v4u o; o.x = pk2(s[0 * 33], s[1 * 33]); o.y = pk2(s[2 * 33], s[3 * 33]); o.z = pk2(s[4 * 33], s[5 * 33]); o.w = pk2(s[6 * 33], s[7 * 33]);
            *(GAS v4u*)(d.WT + (size_t)(drow0 + n) * d.K + k0 + 64 * hf + 8 * c) = o; }
        LDS_WAIT(); asm volatile("" ::: "memory");
    }
}
__device__ __forceinline__ void conv_slice(const float* const __attribute__((address_space(4)))* in, unsigned char* ws, int grp, int slice, LAS unsigned char* lds, int tid) {
    asm volatile("" : "+v"(tid));
    const int lane = tid & 63, wave = __builtin_amdgcn_readfirstlane(tid >> 6);
    LAS float* scr = (LAS float*)(lds + wave * 16384);
    const int ni = conv_group_items(grp), per = (ni + N_SLICE - 1) / N_SLICE, i0 = slice * per, i1 = (i0 + per < ni) ? i0 + per : ni;
    const int first = i0 + wave, n = (first < i1) ? (i1 - first + NWAVES - 1) / NWAVES : 0;
    if (n > 0) {
        f32x4 vA[16], vB[16]; float gA[16], gB[16];
        ConvD dA = conv_desc(in, ws, grp, first), dB = dA; p0_load128(dA, vA, gA, lane);
#pragma unroll 1
        for (int j = 0; j < n; j += 2) {
            dB = conv_desc(in, ws, grp, first + NWAVES * (j + 1 < n ? j + 1 : n - 1)); p0_load128(dB, vB, gB, lane); __builtin_amdgcn_sched_barrier(0);
            p0_finish128(dA, vA, gA, scr, lane); __builtin_amdgcn_sched_barrier(0);
            dA = conv_desc(in, ws, grp, first + NWAVES * (j + 2 < n ? j + 2 : n - 1)); p0_load128(dA, vA, gA, lane); __builtin_amdgcn_sched_barrier(0);
            if (j + 1 < n) p0_finish128(dB, vB, gB, scr, lane);
            __builtin_amdgcn_sched_barrier(0);
        }
    }
    __syncthreads();
}
__device__ __forceinline__ void row_update(const float* xold, const float* crow, float* xdst, bf16* xbrow, float* rstd_p, int lane) {
    const GAS f32x4* xr = (const GAS f32x4*)xold + lane; const GAS f32x4* cr = (const GAS f32x4*)crow + lane;
    GAS f32x4* xd = (GAS f32x4*)xdst + lane; GAS unsigned long long* o8 = (GAS unsigned long long*)xbrow + lane;
    float ss = 0.f;
#pragma unroll
    for (int j = 0; j < 8; ++j) { f32x4 v = xr[64 * j]; if (crow) v = v + cr[64 * j]; if (xdst) xd[64 * j] = v;
        ss += (v.x * v.x + v.y * v.y) + (v.z * v.z + v.w * v.w);
        o8[64 * j] = (unsigned long long)pk2(v.x, v.y) | ((unsigned long long)pk2(v.z, v.w) << 32); }
    ss = wave_sum(ss);
    if (lane < 32) rstd_p[lane] = (lane == 0) ? ss : 0.f;
}

template <int MODE>
__device__ __forceinline__ void sample_attn(LAS char* lds, int u, int li, unsigned char* ws, const float* rel, const float* kcache, const float* vcache, int tid) {
    asm volatile("" : "+v"(tid));
    constexpr int L = (MODE == 0) ? WIN : PAST, Lk = L + SN, NKB = Lk / 16, LkP = (Lk + 31) / 32 * 32, NST = LkP / 32, PP = LkP;
    constexpr int OFF_P = att::OFF_BIAS + 4352, OFF_RI = OFF_P + 16 * 1056 * 2;
    static_assert(16 * Lk * 4 <= att::OFF_TAB && OFF_RI + 64 <= 131072 && 8 * 16 * 128 * 4 <= att::OFF_TAB, "sample attention LDS map");
    const int lane = tid & 63, wid = __builtin_amdgcn_readfirstlane(tid >> 6), fr = lane & 15, fq = lane >> 4, st = u >> 4, h = u & 15;
    LAS float* S = (LAS float*)lds; LAS unsigned short* P = (LAS unsigned short*)(lds + OFF_P); LAS float* RI = (LAS float*)(lds + OFF_RI);
    const bf16* QSp = (const bf16*)(ws + WS_QS) + (size_t)u * SN * HD; const bf16* KNp = (const bf16*)(ws + WS_KSN) + (size_t)u * SN * HD; const bf16* VNp = (const bf16*)(ws + WS_VSN) + (size_t)u * SN * HD;
    const float* kc = kcache + ((size_t)(li * SB + st) * L) * D + h * HD; const float* vc = vcache + ((size_t)(li * SB + st) * L) * D + h * HD;
    if constexpr (MODE == 1) {
        att::Blk b; b.aux = (const float*)(ws + WS_LFS) + (size_t)u * LS; b.jhi = 17; b.cap = LS - 1; b.jlo = 0; b.P0 = PAST; b.c0 = 0; b.skipthr = 0.f; b.Q = nullptr; b.K = nullptr; b.V = nullptr; b.O = nullptr;
        (void)att::build_bias<1>(b, lds, tid);
    }
    pg8::bf16x8 qf[4];
#pragma unroll
    for (int ds = 0; ds < 4; ++ds) qf[ds] = *(const pg8::bf16x8*)(QSp + (size_t)fr * HD + ds * 32 + fq * 8);
    asm volatile("s_waitcnt lgkmcnt(0)" ::: "memory"); __syncthreads();
#define SA_SCORE(accv, key0_) do { f32x4 lg_; _Pragma("unroll") for (int r = 0; r < 4; ++r) { const int key = (key0_) + 4 * fq + r; float v_; \
            if (MODE == 1) { v_ = ((accv)[r] + ((LAS const float*)(lds + att::OFF_BIAS))[key]) * SCALE; if (key > L + fr) v_ = -__builtin_inff(); } \
            else { int dd = L + fr - key; dd = dd < -128 ? -128 : (dd > 128 ? 128 : dd); v_ = (accv)[r] * SCALE + rel[(size_t)(li * NH + h) * NREL + dd + 128]; } \
            lg_[r] = v_; } *(LAS f32x4*)(S + fr * Lk + (key0_) + 4 * fq) = lg_; } while (0)
    constexpr int NCB = L / 16 / NWAVES;
#pragma unroll 1
    for (int i = 0; i < NCB; i += 2) {
        f32x4 ka[2][4], kb2[2][4];
#pragma unroll
        for (int u2 = 0; u2 < 2; ++u2) { const float* kr = kc + (size_t)((wid + (i + u2) * NWAVES) * 16 + fr) * D + fq * 8;
#pragma unroll
            for (int ds = 0; ds < 4; ++ds) { ka[u2][ds] = *(const GAS f32x4*)(kr + ds * 32); kb2[u2][ds] = *(const GAS f32x4*)(kr + ds * 32 + 4); } }
#pragma unroll
        for (int u2 = 0; u2 < 2; ++u2) { pg8::f32x4 acc = (pg8::f32x4){0.f, 0.f, 0.f, 0.f};
#pragma unroll
            for (int ds = 0; ds < 4; ++ds) { const f32x4 a = ka[u2][ds], b2 = kb2[u2][ds];
                v4u w; w.x = pk2(a.x, a.y); w.y = pk2(a.z, a.w); w.z = pk2(b2.x, b2.y); w.w = pk2(b2.z, b2.w);
                acc = __builtin_amdgcn_mfma_f32_16x16x32_bf16(__builtin_bit_cast(pg8::bf16x8, w), qf[ds], acc, 0, 0, 0); }
            SA_SCORE(acc, (wid + (i + u2) * NWAVES) * 16); }
    }
    if (wid == 0) { const bf16* kr = KNp + (size_t)fr * HD + fq * 8; pg8::f32x4 acc = (pg8::f32x4){0.f, 0.f, 0.f, 0.f};
#pragma unroll
        for (int ds = 0; ds < 4; ++ds) acc = __builtin_amdgcn_mfma_f32_16x16x32_bf16(*(const pg8::bf16x8*)(kr + ds * 32), qf[ds], acc, 0, 0, 0);
        SA_SCORE(acc, L); }
#undef SA_SCORE
    asm volatile("s_waitcnt lgkmcnt(0)" ::: "memory"); __syncthreads();
#pragma unroll 1
    for (int rr = 0; rr < 2; ++rr) { const int q = 2 * wid + rr; LAS const float* sr = S + q * Lk; float m = -1e30f;
        for (int k = lane; k < Lk; k += 64) m = fmaxf(m, sr[k]);
#pragma unroll
        for (int o = 1; o < 64; o <<= 1) m = fmaxf(m, __int_as_float(__builtin_amdgcn_ds_bpermute(((lane ^ o) & 63) << 2, __float_as_int(m))));
        float sum = 0.f;
        for (int k = lane; k < PP; k += 64) { float p = 0.f; if (k < Lk) { p = __expf(sr[k] - m); sum += p; } P[q * 1056 + k] = (unsigned short)f2bf(p); }
#pragma unroll
        for (int o = 1; o < 64; o <<= 1) sum += __int_as_float(__builtin_amdgcn_ds_bpermute(((lane ^ o) & 63) << 2, __float_as_int(sum)));
        if (lane == 0) RI[q] = 1.0f / sum; }
    asm volatile("s_waitcnt lgkmcnt(0)" ::: "memory"); __syncthreads();
    pg8::f32x4 oacc[8];
#pragma unroll
    for (int db = 0; db < 8; ++db) oacc[db] = (pg8::f32x4){0.f, 0.f, 0.f, 0.f};
    constexpr int NCS = L / 32 / NWAVES;
#pragma unroll 1
    for (int i = 0; i < NCS; i += 2) {
        f32x4 ev[2][2][8];
#pragma unroll
        for (int u2 = 0; u2 < 2; ++u2) { const float* vr = vc + (size_t)((wid + (i + u2) * NWAVES) * 32 + fq * 8) * D + 4 * fr;
#pragma unroll
            for (int hf = 0; hf < 2; ++hf)
#pragma unroll
                for (int j = 0; j < 8; ++j) ev[u2][hf][j] = *(const GAS f32x4*)(vr + (size_t)j * D + hf * 64); }
#pragma unroll
        for (int u2 = 0; u2 < 2; ++u2) { const pg8::bf16x8 pf = *(LAS const pg8::bf16x8*)(P + fr * 1056 + (wid + (i + u2) * NWAVES) * 32 + fq * 8);
#pragma unroll
            for (int hf = 0; hf < 2; ++hf)
#pragma unroll
                for (int c = 0; c < 4; ++c) { v4u w; w.x = pk2(ev[u2][hf][0][c], ev[u2][hf][1][c]); w.y = pk2(ev[u2][hf][2][c], ev[u2][hf][3][c]); w.z = pk2(ev[u2][hf][4][c], ev[u2][hf][5][c]); w.w = pk2(ev[u2][hf][6][c], ev[u2][hf][7][c]);
                    oacc[hf * 4 + c] = __builtin_amdgcn_mfma_f32_16x16x32_bf16(__builtin_bit_cast(pg8::bf16x8, w), pf, oacc[hf * 4 + c], 0, 0, 0); } }
    }
    if (wid == 0) { const int kq = L + fq * 8; const pg8::bf16x8 pf = *(LAS const pg8::bf16x8*)(P + fr * 1056 + kq);
        const bool ok = fq < 2; const bf16* vr = VNp + (size_t)(ok ? (kq - L) : 0) * HD + 4 * fr;
#pragma unroll
        for (int hf = 0; hf < 2; ++hf)
#pragma unroll
            for (int c = 0; c < 4; ++c) { unsigned e[8];
#pragma unroll
                for (int j = 0; j < 8; ++j) e[j] = ok ? (unsigned)vr[(size_t)j * HD + hf * 64 + c] : 0u;
                v4u w; w.x = e[0] | (e[1] << 16); w.y = e[2] | (e[3] << 16); w.z = e[4] | (e[5] << 16); w.w = e[6] | (e[7] << 16);
                oacc[hf * 4 + c] = __builtin_amdgcn_mfma_f32_16x16x32_bf16(__builtin_bit_cast(pg8::bf16x8, w), pf, oacc[hf * 4 + c], 0, 0, 0); } }
    LAS float* PO = (LAS float*)lds;
#pragma unroll
    for (int hf = 0; hf < 2; ++hf)
#pragma unroll
        for (int r = 0; r < 4; ++r) *(LAS f32x4*)(PO + (wid * 16 + fr) * 128 + hf * 64 + 16 * fq + 4 * r) = (f32x4){oacc[hf * 4][r], oacc[hf * 4 + 1][r], oacc[hf * 4 + 2][r], oacc[hf * 4 + 3][r]};
    asm volatile("s_waitcnt lgkmcnt(0)" ::: "memory"); __syncthreads();
    { const int q = tid >> 5, d4 = (tid & 31) * 4; f32x4 s = *(LAS const f32x4*)(PO + q * 128 + d4);
#pragma unroll
      for (int w = 1; w < 8; ++w) { const f32x4 t = *(LAS const f32x4*)(PO + (w * 16 + q) * 128 + d4); s = s + t; }
      const float ri = RI[q];
      bf16* o = (bf16*)(ws + WS_OB) + ((size_t)MP + st * SN + q) * D + h * HD + d4;
      *(GAS unsigned long long*)o = (unsigned long long)pk2(s.x * ri, s.y * ri) | ((unsigned long long)pk2(s.z * ri, s.w * ri) << 32); }
    __syncthreads();
}

constexpr int N_PROMPT = NB * NH * 32, N_UNIT = SB * NH, N_POS = N_PROMPT + N_UNIT + N_SLICE;
static_assert(N_UNIT == N_SLICE && N_PROMPT >= 2 * N_UNIT, "ticket layout");
template <int MODE> __device__ __forceinline__ void pos_decode(int pos, int& kind, int& id) {
    if (pos < 4 * N_UNIT) { const int g = pos >> 2, r = pos & 3; if (r == 2) { kind = 1; id = g; } else if (r == 3) { kind = 2; id = g; } else { kind = 0; id = 2 * g + r; } }
    else { kind = 0; id = pos - 2 * N_UNIT; }
}
template <int MODE>
__device__ __forceinline__ void get_blk(int p, int li, unsigned char* ws, const float* rel, att::Blk& b) {
    bf16* QPp = (bf16*)(ws + WS_QP); bf16* KPp = (bf16*)(ws + WS_KP); bf16* VPp = (bf16*)(ws + WS_VP); bf16* OBp = (bf16*)(ws + WS_OB);
    int bh, qb;
    bh = p & 31; qb = 31 - (p >> 5);
    const int bb = bh >> 4, h = bh & 15;
    b.Q = QPp + ((size_t)bh * T + qb * 256) * HD; b.K = KPp + (size_t)bh * T * HD; b.V = VPp + (size_t)bh * T * HD; b.O = OBp + ((size_t)bb * T + qb * 256) * D + h * HD; b.P0 = qb * 256;
    if (MODE == 0) { b.aux = rel + (size_t)(li * NH + h) * NREL; b.c0 = qb * 4; b.jlo = b.c0 > 8 ? b.c0 - 8 : 0; b.jhi = b.c0 + 4; b.cap = 1 << 29; b.skipthr = __builtin_inff(); }
    else { b.aux = (const float*)(ws + WS_LFP) + (size_t)bh * T; b.c0 = 0; b.jlo = 0; b.jhi = 4 * (qb + 1); b.cap = qb * 256 + 255; b.skipthr = ((const float*)(ws + WS_QKM))[li]; }
}
__device__ __forceinline__ int take_ticket(gu32* qc, LAS unsigned char* lds, int tid) {
    volatile LAS int* w = (volatile LAS int*)(lds + 131008);
    if (tid == 0) *w = (int)__hip_atomic_fetch_add(qc, 1u, RLX_AGENT);
    __syncthreads();
    return __builtin_amdgcn_readfirstlane(*w);
}
template <int MODE>
__device__ __forceinline__ void attn_phase(LAS unsigned char* lds, int bx, int G, int layer, unsigned char* ws, const float* const __attribute__((address_space(4)))* in, const int tid) {
    att::Blk cur; att::Nxt nxt; att::Seam S;
    const int li = layer >> 1;
    const float* rel = in[12]; const float* kcache = in[MODE == 1 ? 4 : 2]; const float* vcache = in[MODE == 1 ? 5 : 3];
    gu32* qc = (gu32*)(ws + WS_CTL) + CW_QUEUE + 64 * layer;
    int pos = take_ticket(qc, lds, tid);
    while (pos < N_POS) {
        int kind, id; pos_decode<MODE>(pos, kind, id);
        if (kind != 0) {
            if (kind == 1) sample_attn<MODE>((LAS char*)lds, id, li, ws, rel, kcache, vcache, tid);
            else conv_slice(in, ws, layer + 1, id, lds, tid);
            pos = take_ticket(qc, lds, tid); continue; }
        get_blk<MODE>(id, li, ws, rel, cur);
        att::attn_prime<MODE>(cur, (LAS char*)lds, S, tid);
        for (;;) {
            int np = N_POS, id2 = 0; bool nf = false;
            int tk = 0;
            att::attn_block<MODE>(cur, [&]() { if (tid == 0) tk = (int)__hip_atomic_fetch_add(qc, 1u, RLX_AGENT); },
                [&](att::Nxt& nxt) {
                { volatile LAS int* w = (volatile LAS int*)(lds + 131008); if (tid == 0) *w = tk; __syncthreads(); np = __builtin_amdgcn_readfirstlane(*w); }
                int k2 = 3; if (np < N_POS) pos_decode<MODE>(np, k2, id2);
                nf = (k2 == 0);
                att::Blk nb; if (nf) { get_blk<MODE>(id2, li, ws, rel, nb); nxt.Q = nb.Q; nxt.K = nb.K; nxt.V = nb.V; nxt.jlo = nb.jlo; } else { nxt.Q = cur.Q; nxt.K = cur.K; nxt.V = cur.V; nxt.jlo = cur.jlo; }
            }, (LAS char*)lds, S, tid);
            pos = np;
            if (!nf) break;
            int id3 = id2; asm volatile("" : "+s"(id3));
            get_blk<MODE>(id3, li, ws, rel, cur);
        }
    }
}

struct Args { const float* in[19]; float* out; unsigned char* ws; int ph_lo, ph_hi; };
constexpr int PH_PER_LAYER = 5, N_PHASES = 1 + DEPTH * PH_PER_LAYER;

typedef const __attribute__((address_space(4))) Args CArgs;
#define PH_BEGIN() CArgs* A; { unsigned long long k_ = (unsigned long long)__builtin_amdgcn_kernarg_segment_ptr(); asm volatile("" : "+s"(k_)); A = (CArgs*)k_; } \
    unsigned char* const ws = A->ws; float* const out = A->out; int bx = blockIdx.x; asm volatile("" : "+s"(bx)); (void)ws; (void)out; (void)bx; \
    unsigned m1_ = ~0u; int ws_ = wave_s; asm volatile("" : "+s"(m1_), "+s"(ws_)); int tid = ws_ * 64 + (int)__builtin_amdgcn_mbcnt_hi(m1_, __builtin_amdgcn_mbcnt_lo(m1_, 0u)); asm volatile("" : "+v"(tid)); const int lane = tid & 63, wave = wave_s; (void)lane; (void)wave; \
    const int gw = bx * NWAVES + wave, NGW = G * NWAVES; const long gt = (long)bx * (NWAVES * 64) + tid, NGT = (long)G * (NWAVES * 64); (void)gw; (void)NGW; (void)gt; (void)NGT
__global__ void __launch_bounds__(NWAVES * 64, 2) fwd_kernel(Args args_unused) {
    extern __shared__ __attribute__((aligned(16))) unsigned char lds_raw[];
    LAS unsigned char* lds = (LAS unsigned char*)lds_raw;
    volatile LAS unsigned* MISC = (volatile LAS unsigned*)(lds + MISC_OFF);
    const int G = gridDim.x;
    const int wave_s = __builtin_amdgcn_readfirstlane((int)threadIdx.x >> 6);
    for (int u = threadIdx.x; u < (LDS_BYTES - LDSCTL_OFF) / 4; u += NWAVES * 64) ((LAS unsigned*)(lds + LDSCTL_OFF))[u] = 0u;
    __syncthreads();
    int lo, hi; XcdBarrier bar;
    { PH_BEGIN(); lo = A->ph_lo; hi = A->ph_hi; bar = xcd_barrier_post((unsigned*)((gu32*)(ws + WS_CTL) + CW_BAR), MISC + 8, tid == 0); }
#define IN(k) (lo <= (k) && (k) < hi)
#define SEAM(k) do { if (IN(k) && IN((k) + 1)) { XcdBarrier b2_ = bar; unsigned m2_ = ~0u; int w2_ = wave_s; asm volatile("" : "+s"(b2_.bar), "+s"(m2_), "+s"(w2_)); \
    xcd_barrier(b2_, w2_ == 0 && __builtin_amdgcn_mbcnt_hi(m2_, __builtin_amdgcn_mbcnt_lo(m2_, 0u)) == 0u); } } while (0)
#define P_WQKV ((bf16*)(ws + WS_WQKV))
#define P_WO ((bf16*)(ws + WS_WO))
#define P_WGU ((bf16*)(ws + WS_WGU))
#define P_WD ((bf16*)(ws + WS_WD))
#define P_XB ((bf16*)(ws + WS_XB))
#define P_SSQ ((float*)(ws + WS_SSQ))
#define P_QP ((bf16*)(ws + WS_QP))
#define P_KP ((bf16*)(ws + WS_KP))
#define P_VP ((bf16*)(ws + WS_VP))
#define P_QS ((bf16*)(ws + WS_QS))
#define P_OB ((bf16*)(ws + WS_OB))
#define P_HB ((bf16*)(ws + WS_HB))
#define P_LFP ((float*)(ws + WS_LFP))
#define P_LFS ((float*)(ws + WS_LFS))
#define P_KSN ((bf16*)(ws + WS_KSN))
#define P_VSN ((bf16*)(ws + WS_VSN))
#define P_WF ((bf16*)(ws + WS_WF))
#define P_X (out + O_Y)

    if (IN(0)) { PH_BEGIN();
        LAS float* scr = (LAS float*)(lds + RING_OFF + wave * 16384);
        for (int it = gw; it < conv_group_items(0); it += NGW) conv_item(A->in, ws, 0, it, scr, lane);
        for (int row = gw; row < M; row += NGW) {
            const float* xr = row < MP ? A->in[0] + (size_t)row * D : A->in[1] + (size_t)(row - MP) * D;
            row_update(xr, nullptr, nullptr, P_XB + (size_t)row * D, P_SSQ + (size_t)row * 32, lane);
        }
        for (long idx = gt; idx < 2L * NH * D; idx += NGT) { const int ib = (int)(idx >> 15), h = (int)((idx >> 11) & 15), k = (int)(idx & (D - 1));
            P_WF[idx] = (bf16)f2bf(A->in[7][(size_t)(2 * ib + 1) * D + k] * A->in[13][((size_t)ib * D + k) * NH + h]); }
        if (gw == 0) {
#pragma unroll 1
            for (int ib = 0; ib < 2; ++ib) { const float* gq = A->in[9] + (2 * ib + 1) * HD; const float* gk = A->in[10] + (2 * ib + 1) * HD;
                float mqk = fmaxf(fabsf(gq[lane] * gk[lane]), fabsf(gq[lane + 64] * gk[lane + 64]));
#pragma unroll
                for (int o = 1; o < 64; o <<= 1) mqk = fmaxf(mqk, __shfl_xor(mqk, o));
                if (lane == 0) ((float*)(ws + WS_QKM))[ib] = 11.313708499f * mqk * 1.02f + 40.0f; }
        }
    }
    SEAM(0);

#pragma unroll 1
    for (int layer = 0; layer < DEPTH; ++layer) {
        const int pb = 1 + layer * PH_PER_LAYER, li = layer >> 1; const bool fox = (layer & 1) != 0;
        if (IN(pb + 0)) { PH_BEGIN();
            if (fox) {
                const bf16* wfp = P_WF + (size_t)li * NH * D; const float* bfp = A->in[14] + li * NH;
                const int fr = lane & 15, fq = lane >> 4, lr = lane >> 2, lc = lane & 3, pidx = (((lane & 15) << 2) | (lane >> 4)) << 2;
                const int nidle = (G > 192) ? (G - 192) * NWAVES : NGW, gw0 = (G > 192) ? (bx - 192) * NWAVES + wave : gw;
                if (gw0 >= 0)
                for (int grp = gw0; grp < M / 16; grp += nidle) {
                    const int row = grp * 16 + fr;
                    const char* ap = (const char*)(P_XB + (size_t)(grp * 16 + lr) * D) + lc * 16; const char* bp = (const char*)(wfp + (size_t)lr * D) + lc * 16;
                    pg8::f32x4 acc = (pg8::f32x4){0.f, 0.f, 0.f, 0.f};
#pragma unroll 8
                    for (int ks = 0; ks < D / 32; ++ks) { pg8::u32x4 av = *(const pg8::u32x4*)(ap + ks * 64), bv = *(const pg8::u32x4*)(bp + ks * 64);
                        av.x = (unsigned)__builtin_amdgcn_ds_bpermute(pidx, (int)av.x); av.y = (unsigned)__builtin_amdgcn_ds_bpermute(pidx, (int)av.y); av.z = (unsigned)__builtin_amdgcn_ds_bpermute(pidx, (int)av.z); av.w = (unsigned)__builtin_amdgcn_ds_bpermute(pidx, (int)av.w);
                        bv.x = (unsigned)__builtin_amdgcn_ds_bpermute(pidx, (int)bv.x); bv.y = (unsigned)__builtin_amdgcn_ds_bpermute(pidx, (int)bv.y); bv.z = (unsigned)__builtin_amdgcn_ds_bpermute(pidx, (int)bv.z); bv.w = (unsigned)__builtin_amdgcn_ds_bpermute(pidx, (int)bv.w);
                        acc = __builtin_amdgcn_mfma_f32_16x16x32_bf16(__builtin_bit_cast(pg8::bf16x8, bv), __builtin_bit_cast(pg8::bf16x8, av), acc, 0, 0, 0); }
                    const float rs = pg8::row_rstd(P_SSQ, row, fq);
                    const pg8::f32x4 bb = *(const pg8::f32x4*)(bfp + 4 * fq); pg8::f32x4 lf;
#pragma unroll
                    for (int i = 0; i < 4; ++i) { const float z = acc[i] * rs + bb[i]; lf[i] = fminf(z, 0.f) - log1pf(expf(-fabsf(z))); }
                    if (row < MP) { *(pg8::f32x4*)(out + O_BFP + ((size_t)li * MP + row) * NH + 4 * fq) = lf;
#pragma unroll
                        for (int i = 0; i < 4; ++i) P_LFP[(size_t)((row >> 13) * NH + 4 * fq + i) * T + (row & (T - 1))] = lf[i]; }
                    else { const int rs2 = row - MP; *(pg8::f32x4*)(out + O_BFS + ((size_t)li * MS + rs2) * NH + 4 * fq) = lf;
#pragma unroll
                        for (int i = 0; i < 4; ++i) P_LFS[(size_t)((rs2 >> 4) * NH + 4 * fq + i) * LS + PAST + (rs2 & 15)] = lf[i]; }
                }
                const float* clf = A->in[6] + (size_t)li * SB * PAST * NH;
                for (long idx = gt; idx < (long)SB * NH * PAST; idx += NGT) { const int unit = (int)(idx >> 10), j = (int)(idx & 1023), st = unit >> 4, h = unit & 15;
                    P_LFS[(size_t)unit * LS + j] = clf[((size_t)st * PAST + j) * NH + h]; }
            }
            pg8::Gemm g{P_XB, P_WQKV + (size_t)layer * NQKV * D, MP, NQKV, D}; pg8::StaticOrder S; S.init(MP, NQKV, G, bx);
            pg8::EpiQKV E;
            E.ssq = P_SSQ; E.gq = A->in[9] + layer * HD; E.gk = A->in[10] + layer * HD; E.QP = P_QP; E.pstride = (WS_KP - WS_QP) / 2; E.QS = P_QS;
            E.srows = SN; E.lc = 0; E.KS = P_KSN; E.sstride = (WS_VSN - WS_KSN) / 2;
            E.okp = out + (fox ? O_BKP + (size_t)li * MP * D : O_AKP + (size_t)li * NB * WIN * D); E.opstride = fox ? SZ_BP : SZ_AP;
            E.oks = out + (fox ? O_BKS : O_AKS) + (size_t)li * MS * D; E.osstride = SZ_S;
            E.fox = fox ? 1 : 0; E.red = (LAS float*)(lds + RED_OFF);
            pg8::gemm_phase<pg8::EpiQKV, pg8::StaticOrder, true, true>(lds + RING_OFF, g, S, E, tid);
            __syncthreads();
            {
                sk::SkQKV K2; K2.ssq = P_SSQ + (size_t)MP * 32; K2.gq = A->in[9] + layer * HD; K2.gk = A->in[10] + layer * HD; K2.QS = P_QS;
                K2.srows = SN; K2.lc = 0; K2.KS = P_KSN; K2.sstride = (WS_VSN - WS_KSN) / 2;
                K2.oks = out + (fox ? O_BKS : O_AKS) + (size_t)li * MS * D; K2.osstride = SZ_S;
                sk::skinny_phase<sk::SkQKV>(lds + RING_OFF, P_XB + (size_t)MP * D, P_WQKV + (size_t)layer * NQKV * D, NQKV / 128, D, (unsigned*)((gu32*)(ws + WS_CTL) + CW_SKQ + 64 * (layer * 4 + 0)), tid, K2);
            }
        }
        SEAM(pb + 0);
        if (IN(pb + 1)) { PH_BEGIN();
            if (fox) attn_phase<1>(lds + RING_OFF, bx, G, layer, ws, A->in, tid);
            else attn_phase<0>(lds + RING_OFF, bx, G, layer, ws, A->in, tid);
        }
        SEAM(pb + 1);
        if (IN(pb + 2)) { PH_BEGIN();
            pg8::Gemm g{P_OB, P_WO + (size_t)layer * D * D, MP, D, D}; pg8::StaticOrder S; S.init(MP, D, G, bx);
            pg8::EpiResid E;
            E.xin0 = (layer == 0) ? A->in[0] : P_X; E.xin1 = (layer == 0) ? A->in[1] - (size_t)MP * D : P_X; E.X = P_X; E.XB = P_XB; E.ssq = P_SSQ;
            pg8::gemm_phase<pg8::EpiResid, pg8::StaticOrder, true, true>(lds + RING_OFF, g, S, E, tid);
            __syncthreads();
            {   sk::SkResid K2; K2.xin = (layer == 0) ? A->in[1] : P_X + (size_t)MP * D; K2.X = P_X + (size_t)MP * D; K2.XB = P_XB + (size_t)MP * D; K2.ssq = P_SSQ + (size_t)MP * 32;
                sk::skinny_phase<sk::SkResid>(lds + RING_OFF, P_OB + (size_t)MP * D, P_WO + (size_t)layer * D * D, D / 64, D, (unsigned*)((gu32*)(ws + WS_CTL) + CW_SKQ + 64 * (layer * 4 + 1)), tid, K2); }
        }
        SEAM(pb + 2);
        if (IN(pb + 3)) { PH_BEGIN();
            pg8::Gemm g{P_XB, P_WGU + (size_t)layer * NGU * D, MP, NGU, D}; pg8::StaticOrder S; S.init(MP, NGU, G, bx);
            pg8::EpiSwiglu E{P_HB, FF, P_SSQ};
            pg8::gemm_phase<pg8::EpiSwiglu, pg8::StaticOrder, true, true>(lds + RING_OFF, g, S, E, tid);
            __syncthreads();
            {   sk::SkSwiglu K2{P_HB + (size_t)MP * FF, FF, P_SSQ + (size_t)MP * 32};
                sk::skinny_phase<sk::SkSwiglu>(lds + RING_OFF, P_XB + (size_t)MP * D, P_WGU + (size_t)layer * NGU * D, NGU / 128, D, (unsigned*)((gu32*)(ws + WS_CTL) + CW_SKQ + 64 * (layer * 4 + 2)), tid, K2); }
        }
        SEAM(pb + 3);
        if (IN(pb + 4)) { PH_BEGIN();
            pg8::Gemm g{P_HB, P_WD + (size_t)layer * D * FF, MP, D, FF}; pg8::StaticOrder S; S.init(MP, D, G, bx);
            pg8::EpiResid E;
            E.xin0 = P_X; E.xin1 = P_X; E.X = P_X; E.XB = P_XB; E.ssq = P_SSQ;
            pg8::gemm_phase<pg8::EpiResid, pg8::StaticOrder, true, true>(lds + RING_OFF, g, S, E, tid);
            __syncthreads();
            {   sk::SkResid K2; K2.xin = P_X + (size_t)MP * D; K2.X = P_X + (size_t)MP * D; K2.XB = P_XB + (size_t)MP * D; K2.ssq = P_SSQ + (size_t)MP * 32;
                sk::skinny_phase<sk::SkResid>(lds + RING_OFF, P_HB + (size_t)MP * FF, P_WD + (size_t)layer * D * FF, D / 64, FF, (unsigned*)((gu32*)(ws + WS_CTL) + CW_SKQ + 64 * (layer * 4 + 3)), tid, K2); }
        }
        SEAM(pb + 4);
    }
#undef IN
#undef SEAM
}

#ifndef MK_SPLIT
#define MK_SPLIT 0
#endif
extern "C" void kernel_launch(void* const* d_in, const int* in_sizes, int n_in, void* d_out, int out_size, void* d_ws, size_t ws_size, hipStream_t stream) {
    static int grid = 0;
    if (grid == 0) {
        if (n_in != 19 || in_sizes[0] != MP * D || (size_t)out_size != OUT_TOTAL || ws_size < WS_END) { fprintf(stderr, "kernel_launch: shape mismatch (n_in %d in0 %d out %d ws %zu); nothing launched\n", n_in, n_in > 0 ? in_sizes[0] : -1, out_size, ws_size); grid = -1; return; }
        int dev = 0, cus = 0;
        if (hipGetDevice(&dev) != hipSuccess || hipDeviceGetAttribute(&cus, hipDeviceAttributeMultiprocessorCount, dev) != hipSuccess) { grid = -1; return; }
        if (hipFuncSetAttribute((const void*)fwd_kernel, hipFuncAttributeMaxDynamicSharedMemorySize, LDS_BYTES) != hipSuccess) { fprintf(stderr, "kernel_launch: hipFuncSetAttribute failed\n"); grid = -1; return; }
        int per_cu = 0;
        if (hipOccupancyMaxActiveBlocksPerMultiprocessor(&per_cu, (const void*)fwd_kernel, NWAVES * 64, LDS_BYTES) != hipSuccess || per_cu < 1) fprintf(stderr, "kernel_launch: occupancy query reports %d\n", per_cu);
        (void)hipGetLastError();
        grid = cus;
    }
    if (grid < 0) return;
    if (hipMemsetAsync((char*)d_ws + WS_CTL, 0, CTL_ZERO_BYTES, stream) != hipSuccess) return;
    Args a{};
    for (int i = 0; i < 19; ++i) a.in[i] = (const float*)d_in[i];
    a.out = (float*)d_out; a.ws = (unsigned char*)d_ws;
#if MK_SPLIT
    for (int p = 0; p < N_PHASES; ++p) { a.ph_lo = p; a.ph_hi = p + 1; hipLaunchKernelGGL(fwd_kernel, dim3(grid), dim3(NWAVES * 64), LDS_BYTES, stream, a); }
#else
    a.ph_lo = 0; a.ph_hi = N_PHASES;
    hipLaunchKernelGGL(fwd_kernel, dim3(grid), dim3(NWAVES * 64), LDS_BYTES, stream, a);
#endif
}
```

```cpp
#include <hip/hip_runtime.h>
#include <cstdio>
#include <cstdint>
namespace pg8 {
#define PG8_LAS __attribute__((address_space(3)))
typedef unsigned short bf16_t;
typedef short bf16x8 __attribute__((ext_vector_type(8)));
typedef float f32x4 __attribute__((ext_vector_type(4)));
typedef unsigned u32x4 __attribute__((ext_vector_type(4)));
constexpr int BM = 256, BK = 64, HALF = 128, HTB = HALF * BK * 2  , STAGE_BYTES = 8 * HTB, NXCD = 8, WGM = 2;

__host__ __device__ __forceinline__ int lds_byte(int r, int c) { const int st = (r >> 4) * 2 + (c >> 5), rr = r & 15, cc = c & 31, ob = rr * 64 + cc * 2; return st * 1024 + (ob ^ (((ob >> 9) & 1) << 5)); }
__host__ __device__ __forceinline__ void stage_rc(int b, int& R, int& C) { const int st = b / 1024, sb = b % 1024, swz = sb ^ (((sb >> 9) & 1) << 5); R = (st >> 1) * 16 + swz / 64; C = (st & 1) * 32 + (swz % 64) / 2; }
__host__ __device__ __forceinline__ int perm32(int rho) { const int n = rho >> 4, i = rho & 15; return 8 * (i >> 2) + 4 * n + (i & 3); }

struct Unit { int pm, pn; };
struct Gemm { const bf16_t* A; const bf16_t* Bt; int M, N, K; };

struct StaticOrder {
    int nM, nN, nwg, G, c;
    __host__ __device__ void init(int M, int N, int G_, int c_) { nM = M / BM; nN = N / BM; nwg = nM * nN; G = G_; c = c_; }
    __host__ __device__ bool next(int i, Unit& u) const {
        const long L = (long)i * G + c; if (L >= nwg) return false;
        int wgid = (int)L; { const int q = nwg / NXCD, r = nwg % NXCD, xcd = wgid % NXCD, off = wgid / NXCD; wgid = (xcd < r ? xcd * (q + 1) : r * (q + 1) + (xcd - r) * q) + off; }
        const int nig = WGM * nN, gid = wgid / nig, fm = gid * WGM, gsz = (nM - fm) < WGM ? (nM - fm) : WGM;
        u.pm = fm + ((wgid % nig) % gsz); u.pn = (wgid % nig) / gsz; return true;
    }
    __device__ __forceinline__ void a_ready(const Unit&) const {}
    __device__ __forceinline__ void done(const Unit&) const {}
};

__device__ __forceinline__ unsigned cvt_pk_bf16(float lo, float hi) { unsigned r; asm volatile("v_cvt_pk_bf16_f32 %0, %1, %2" : "=v"(r) : "v"(lo), "v"(hi)); return r; }
struct EpiF32 {
    static constexpr bool PERM = false, AFTER_DRAIN = false;
    float* C; int ldc;
    __device__ __forceinline__ void operator()(const f32x4 (&acc)[2][2][4][2], const Unit& u, int wr, int wc, int fr, int fq) const {
        const int row0 = u.pm * BM + wr * 64 + fr, col0 = u.pn * BM + wc * 32 + 4 * fq;
#pragma unroll
        for (int ai = 0; ai < 2; ++ai)
#pragma unroll
            for (int m = 0; m < 4; ++m) { float* rowp = C + (size_t)(row0 + ai * HALF + m * 16) * ldc + col0;
#pragma unroll
                for (int bj = 0; bj < 2; ++bj)
#pragma unroll
                    for (int n = 0; n < 2; ++n) *(f32x4*)(rowp + bj * HALF + n * 16) = acc[ai][bj][m][n]; }
    }
};
template <class Epi, class Sched, bool ALIGN_EPI = false, bool SP2 = false>
__device__ __forceinline__ void gemm_phase(PG8_LAS unsigned char* lds, const Gemm g, const Sched& S, const Epi& E, const int tid_in) {
    int tid_ = tid_in; asm volatile("" : "+v"(tid_));
    const int tid = tid_, wid = __builtin_amdgcn_readfirstlane(tid >> 6), lane = tid & 63, wr = wid >> 2, wc = wid & 3, fr = lane & 15, fq = lane >> 4;
    const int K = g.K, nt = K / BK;
    unsigned voffA[2], voffB[2];
#pragma unroll
    for (int i = 0; i < 2; ++i) { int R, C; stage_rc(tid * 16 + i * 8192, R, C); const int Rb = Epi::PERM ? ((R & ~31) + perm32(R & 31)) : R;
        voffA[i] = (unsigned)(R * K + C) * 2u; voffB[i] = (unsigned)(Rb * K + C) * 2u; }
    const size_t kstep = (size_t)(BK * 2);
    const size_t hstep = (size_t)HALF * K * 2;
    const size_t tstep = 2 * hstep;
    const unsigned ldsw = (unsigned)wid * 1024u;
    const int aoff = lds_byte(wr * 64 + fr, fq * 8), boff = lds_byte(wc * 32 + fr, fq * 8);
#define PG8_SA(b, h) (((b) * 2 + (h)) * HTB)
#define PG8_SB(b, h) ((4 + (b) * 2 + (h)) * HTB)
#define PG8_STAGE(bufoff, gbase, voff) do { _Pragma("unroll") for (int _i = 0; _i < 2; ++_i) \
        __builtin_amdgcn_global_load_lds((const unsigned*)((const char*)(gbase) + (voff)[_i]), (PG8_LAS unsigned*)(lds + (bufoff) + ldsw + _i * 8192), 16, 0, 0); } while (0)
#define PG8_LDA(dst, b, h) do { _Pragma("unroll") for (int m = 0; m < 4; ++m) _Pragma("unroll") for (int k = 0; k < 2; ++k) dst[m][k] = *(const PG8_LAS bf16x8*)(lds + PG8_SA(b, h) + aoff + m * 2048 + k * 1024); } while (0)
#define PG8_LDB(dst, b, h) do { _Pragma("unroll") for (int n = 0; n < 2; ++n) _Pragma("unroll") for (int k = 0; k < 2; ++k) dst[n][k] = *(const PG8_LAS bf16x8*)(lds + PG8_SB(b, h) + boff + n * 2048 + k * 1024); } while (0)
#define PG8_MMA(ai, bj, At, Bt) do { __builtin_amdgcn_s_setprio(1); _Pragma("unroll") for (int m = 0; m < 4; ++m) _Pragma("unroll") for (int n = 0; n < 2; ++n) _Pragma("unroll") for (int k = 0; k < 2; ++k) \
        acc[ai][bj][m][n] = __builtin_amdgcn_mfma_f32_16x16x32_bf16(Bt[n][k], At[m][k], acc[ai][bj][m][n], 0, 0, 0); __builtin_amdgcn_s_setprio(0); } while (0)
#define PG8_WAIT_V(n) asm volatile("s_waitcnt vmcnt(" #n ")" ::: "memory")
#define PG8_WAIT_L(n) asm volatile("s_waitcnt lgkmcnt(" #n ")" ::: "memory")
#define PG8_BAR __builtin_amdgcn_s_barrier()
#define PG8_SCHED __builtin_amdgcn_sched_barrier(0)
    Unit cur, nxt; int ui = 0;
    if (!S.next(0, cur)) return;
    f32x4 acc[2][2][4][2];
#pragma unroll
    for (int a = 0; a < 2; ++a)
#pragma unroll
        for (int b = 0; b < 2; ++b)
#pragma unroll
            for (int m = 0; m < 4; ++m)
#pragma unroll
                for (int n = 0; n < 2; ++n) acc[a][b][m][n] = (f32x4){0.f, 0.f, 0.f, 0.f};
    bf16x8 At[4][2], B0[2][2], B1[2][2];
    const char* cA = (const char*)g.A + (size_t)cur.pm * tstep; const char* cB = (const char*)g.Bt + (size_t)cur.pn * tstep;
    S.a_ready(cur);
    if constexpr (SP2) {
        PG8_STAGE(PG8_SB(0, 0), cB, voffB); PG8_STAGE(PG8_SB(0, 1), cB + hstep, voffB); PG8_STAGE(PG8_SA(0, 0), cA, voffA); PG8_STAGE(PG8_SA(0, 1), cA + hstep, voffA);
        if (wr == 1) PG8_BAR;
        PG8_WAIT_V(2); PG8_BAR;
        PG8_STAGE(PG8_SB(1, 0), cB + kstep, voffB); PG8_STAGE(PG8_SA(1, 0), cA + kstep, voffA); PG8_STAGE(PG8_SB(1, 1), cB + hstep + kstep, voffB);
        PG8_WAIT_V(6); PG8_BAR;
    } else {
        PG8_STAGE(PG8_SB(0, 0), cB, voffB); PG8_STAGE(PG8_SA(0, 0), cA, voffA); PG8_STAGE(PG8_SB(0, 1), cB + hstep, voffB); PG8_STAGE(PG8_SA(0, 1), cA + hstep, voffA);
        if (wr == 1) PG8_BAR;
        PG8_WAIT_V(4); PG8_BAR;
        PG8_STAGE(PG8_SB(1, 0), cB + kstep, voffB); PG8_STAGE(PG8_SA(1, 0), cA + kstep, voffA); PG8_STAGE(PG8_SB(1, 1), cB + hstep + kstep, voffB);
        PG8_WAIT_V(6); PG8_BAR;
    }
    for (;;) {
        const bool has_next = S.next(ui + 1, nxt);
        const char* nA = has_next ? (const char*)g.A + (size_t)nxt.pm * tstep : cA; const char* nB = has_next ? (const char*)g.Bt + (size_t)nxt.pn * tstep : cB;
        for (int t = 0; t < nt; t += 2) {
            const bool last = (t == nt - 2);
            const char* a1 = cA + (size_t)(t + 1) * kstep;
            const char* a2 = last ? nA : cA + (size_t)(t + 2) * kstep; const char* b2 = last ? nB : cB + (size_t)(t + 2) * kstep;
            const char* a3 = a2 + kstep; const char* b3 = b2 + kstep;
            if (last && has_next) S.a_ready(nxt);
            if constexpr (SP2) {
            PG8_LDB(B0, 0, 0); PG8_LDB(B1, 0, 1); PG8_SCHED; PG8_LDA(At, 0, 0); PG8_STAGE(PG8_SA(1, 1), a1 + hstep, voffA);
            PG8_WAIT_V(8); PG8_WAIT_L(0); PG8_BAR; PG8_MMA(0, 0, At, B0); PG8_MMA(0, 1, At, B1); PG8_BAR; PG8_SCHED;
            PG8_LDA(At, 0, 1); PG8_STAGE(PG8_SB(0, 0), b2, voffB); PG8_STAGE(PG8_SB(0, 1), b2 + hstep, voffB); PG8_STAGE(PG8_SA(0, 0), a2, voffA);
            PG8_WAIT_V(8); PG8_WAIT_L(0); PG8_BAR; PG8_MMA(1, 0, At, B0); PG8_MMA(1, 1, At, B1); PG8_BAR; PG8_SCHED;
            PG8_LDB(B0, 1, 0); PG8_LDB(B1, 1, 1); PG8_SCHED; PG8_LDA(At, 1, 0); PG8_STAGE(PG8_SA(0, 1), a2 + hstep, voffA);
            PG8_WAIT_V(8); PG8_WAIT_L(0); PG8_BAR; PG8_MMA(0, 0, At, B0); PG8_MMA(0, 1, At, B1); PG8_BAR; PG8_SCHED;
            PG8_LDA(At, 1, 1); PG8_STAGE(PG8_SB(1, 0), b3, voffB); PG8_STAGE(PG8_SB(1, 1), b3 + hstep, voffB); PG8_STAGE(PG8_SA(1, 0), a3, voffA);
            PG8_WAIT_V(8); PG8_WAIT_L(0); PG8_BAR; PG8_MMA(1, 0, At, B0); PG8_MMA(1, 1, At, B1); PG8_BAR; PG8_SCHED;
            } else {
            PG8_LDB(B0, 0, 0); PG8_SCHED; PG8_LDA(At, 0, 0); PG8_STAGE(PG8_SA(1, 1), a1 + hstep, voffA);
            PG8_WAIT_L(8); PG8_BAR; PG8_WAIT_L(0); PG8_MMA(0, 0, At, B0); PG8_BAR; PG8_SCHED;
            PG8_LDB(B1, 0, 1); PG8_STAGE(PG8_SB(0, 0), b2, voffB);
            PG8_BAR; PG8_WAIT_L(0); PG8_MMA(0, 1, At, B1); PG8_BAR;
            PG8_LDA(At, 0, 1); PG8_STAGE(PG8_SA(0, 0), a2, voffA);
            PG8_BAR; PG8_WAIT_L(0); PG8_MMA(1, 0, At, B0); PG8_BAR; PG8_SCHED;
            PG8_STAGE(PG8_SB(0, 1), b2 + hstep, voffB);
            PG8_WAIT_V(6); PG8_BAR; PG8_MMA(1, 1, At, B1); PG8_BAR;
            PG8_LDB(B0, 1, 0); PG8_SCHED; PG8_LDA(At, 1, 0); PG8_STAGE(PG8_SA(0, 1), a2 + hstep, voffA);
            PG8_WAIT_L(8); PG8_BAR; PG8_WAIT_L(0); PG8_MMA(0, 0, At, B0); PG8_BAR; PG8_SCHED;
            PG8_LDB(B1, 1, 1); PG8_STAGE(PG8_SB(1, 0), b3, voffB);
            PG8_BAR; PG8_WAIT_L(0); PG8_MMA(0, 1, At, B1); PG8_BAR;
            PG8_LDA(At, 1, 1); PG8_STAGE(PG8_SA(1, 0), a3, voffA);
            PG8_BAR; PG8_WAIT_L(0); PG8_MMA(1, 0, At, B0); PG8_BAR; PG8_SCHED;
            PG8_STAGE(PG8_SB(1, 1), b3 + hstep, voffB);
            PG8_WAIT_V(6); PG8_BAR; PG8_MMA(1, 1, At, B1); PG8_BAR;
            }
        }
        if constexpr (ALIGN_EPI) { if (wr == 0) PG8_BAR; }
        if constexpr (!Epi::AFTER_DRAIN) { E(acc, cur, wr, wc, fr, fq); S.done(cur); }
        if (!has_next) break;
#pragma unroll
        for (int a = 0; a < 2; ++a)
#pragma unroll
            for (int b = 0; b < 2; ++b)
#pragma unroll
                for (int m = 0; m < 4; ++m)
#pragma unroll
                    for (int n = 0; n < 2; ++n) acc[a][b][m][n] = (f32x4){0.f, 0.f, 0.f, 0.f};
        cur = nxt; cA = nA; cB = nB; ++ui;
        if constexpr (ALIGN_EPI) { if (wr == 1) PG8_BAR; }
    }
    PG8_WAIT_V(0);
    if constexpr (!ALIGN_EPI) { if (wr == 0) PG8_BAR; }
    PG8_BAR;
    if constexpr (Epi::AFTER_DRAIN) { E.fused(acc, cur, wr, wc, fr, fq, lds, wid, lane); S.done(cur); }
#undef PG8_SA
#undef PG8_SB
#undef PG8_STAGE
#undef PG8_LDA
#undef PG8_LDB
#undef PG8_MMA
#undef PG8_WAIT_V
#undef PG8_WAIT_L
#undef PG8_BAR
#undef PG8_SCHED
}
}

namespace pg8 {
typedef unsigned u32x2 __attribute__((ext_vector_type(2)));
typedef float f32x2 __attribute__((ext_vector_type(2)));
__device__ __forceinline__ void rows_rstd(float (&rs)[2][4], const float* ssq, int pm, int wr, int fr, int fq) {
    f32x4 pa[2][4], pb[2][4];
    const float* base = ssq + (size_t)(pm * BM + wr * 64 + fr) * 32 + fq * 8;
#pragma unroll
    for (int ai = 0; ai < 2; ++ai)
#pragma unroll
        for (int m = 0; m < 4; ++m) { pa[ai][m] = *(const f32x4*)(base + (ai * HALF + m * 16) * 32); pb[ai][m] = *(const f32x4*)(base + (ai * HALF + m * 16) * 32 + 4); }
#pragma unroll
    for (int ai = 0; ai < 2; ++ai)
#pragma unroll
        for (int m = 0; m < 4; ++m) { const f32x4 a = pa[ai][m], b = pb[ai][m];
            float s = ((a[0] + a[1]) + (a[2] + a[3])) + ((b[0] + b[1]) + (b[2] + b[3]));
            s += __shfl_xor(s, 16); s += __shfl_xor(s, 32);
            rs[ai][m] = __builtin_amdgcn_rsqf(s * (1.0f / 2048.0f) + 1e-6f); }
}
__device__ __forceinline__ f32x4 to_rowmajor(f32x4 v, int pidx) {
    f32x4 o; o[0] = __int_as_float(__builtin_amdgcn_ds_bpermute(pidx, __float_as_int(v[0]))); o[1] = __int_as_float(__builtin_amdgcn_ds_bpermute(pidx, __float_as_int(v[1])));
    o[2] = __int_as_float(__builtin_amdgcn_ds_bpermute(pidx, __float_as_int(v[2]))); o[3] = __int_as_float(__builtin_amdgcn_ds_bpermute(pidx, __float_as_int(v[3]))); return o;
}
__device__ __forceinline__ int rowmajor_pidx(int lane) { return (((lane & 3) << 4) | (lane >> 2)) << 2; }
__device__ __forceinline__ void rows_rstd_rm(float (&rs)[2][4], const float* ssq, int pm, int wr, int r2, int c2) {
    f32x4 pa[2][4], pb[2][4];
    const float* base = ssq + (size_t)(pm * BM + wr * 64 + r2) * 32 + c2 * 8;
#pragma unroll
    for (int ai = 0; ai < 2; ++ai)
#pragma unroll
        for (int m = 0; m < 4; ++m) { pa[ai][m] = *(const f32x4*)(base + (ai * HALF + m * 16) * 32); pb[ai][m] = *(const f32x4*)(base + (ai * HALF + m * 16) * 32 + 4); }
#pragma unroll
    for (int ai = 0; ai < 2; ++ai)
#pragma unroll
        for (int m = 0; m < 4; ++m) { const f32x4 a = pa[ai][m], b = pb[ai][m];
            float s = ((a[0] + a[1]) + (a[2] + a[3])) + ((b[0] + b[1]) + (b[2] + b[3]));
            s += __shfl_xor(s, 1); s += __shfl_xor(s, 2);
            rs[ai][m] = __builtin_amdgcn_rsqf(s * (1.0f / 2048.0f) + 1e-6f); }
}
__device__ __forceinline__ float row_rstd(const float* ssq, int row, int fq) {
    const f32x4 a = *(const f32x4*)(ssq + (size_t)row * 32 + fq * 8), b = *(const f32x4*)(ssq + (size_t)row * 32 + fq * 8 + 4);
    float s = ((a[0] + a[1]) + (a[2] + a[3])) + ((b[0] + b[1]) + (b[2] + b[3]));
    s += __shfl_xor(s, 16); s += __shfl_xor(s, 32);
    return __builtin_amdgcn_rsqf(s * (1.0f / 2048.0f) + 1e-6f);
}
struct EpiResid {
    static constexpr bool PERM = false, AFTER_DRAIN = false;
    float* X; bf16_t* XB; float* ssq;
    __device__ __forceinline__ void operator()(const f32x4 (&acc)[2][2][4][2], const Unit& u, int wr, int wc, int fr_, int fq_) const {
        const int lane = fq_ * 16 + fr_, r2 = lane >> 2, c2 = lane & 3, pidx = rowmajor_pidx(lane);
        const int row0 = u.pm * BM + wr * 64 + r2, col0 = u.pn * BM + wc * 32 + 4 * c2;
        u32x2 v[4][2][2];
#define EPR_LOAD(g) do { const size_t off_ = (size_t)(row0 + ((g) >> 2) * HALF + ((g) & 3) * 16) * 2048 + col0; _Pragma("unroll") for (int bj = 0; bj < 2; ++bj) _Pragma("unroll") for (int n = 0; n < 2; ++n) \
            v[(g) & 3][bj][n] = *(const u32x2*)(XB + off_ + bj * HALF + n * 16); } while (0)
        EPR_LOAD(0); EPR_LOAD(1); EPR_LOAD(2);
#pragma unroll
        for (int g = 0; g < 8; ++g) { const int ai = g >> 2, m = g & 3; const int row = row0 + ai * HALF + m * 16; const size_t off = (size_t)row * 2048 + col0; float s = 0.f;
            if (g + 3 < 8) EPR_LOAD(g + 3);
#pragma unroll
            for (int bj = 0; bj < 2; ++bj)
#pragma unroll
                for (int n = 0; n < 2; ++n) { const u32x2 xo = v[g & 3][bj][n];
                    const f32x4 x = (f32x4){__uint_as_float(xo.x << 16), __uint_as_float(xo.x & 0xffff0000u), __uint_as_float(xo.y << 16), __uint_as_float(xo.y & 0xffff0000u)} + to_rowmajor(acc[ai][bj][m][n], pidx);
                    if (X != nullptr) *(f32x4*)(X + off + bj * HALF + n * 16) = x;
                    u32x2 w; w.x = cvt_pk_bf16(x[0], x[1]); w.y = cvt_pk_bf16(x[2], x[3]); *(u32x2*)(XB + off + bj * HALF + n * 16) = w;
                    s += (x[0] * x[0] + x[1] * x[1]) + (x[2] * x[2] + x[3] * x[3]); }
            s += __shfl_xor(s, 1); s += __shfl_xor(s, 2);
            if (c2 == 0) ssq[(size_t)row * 32 + u.pn * 4 + wc] = s;
            asm volatile("" ::: "memory"); }
#undef EPR_LOAD
    }
};
struct EpiSwiglu {
    static constexpr bool PERM = true, AFTER_DRAIN = false;
    bf16_t* H; int ldh; const float* ssq;
    __device__ __forceinline__ void operator()(const f32x4 (&acc)[2][2][4][2], const Unit& u, int wr, int wc, int fr_, int fq_) const {
        const int lane = fq_ * 16 + fr_, r2 = lane >> 2, c2 = lane & 3, pidx = rowmajor_pidx(lane);
        const int row0 = u.pm * BM + wr * 64 + r2, col0 = u.pn * HALF + wc * 32 + 8 * c2;
        float rs[2][4]; rows_rstd_rm(rs, ssq, u.pm, wr, r2, c2);
#pragma unroll
        for (int ai = 0; ai < 2; ++ai)
#pragma unroll
            for (int m = 0; m < 4; ++m) { const float r = rs[ai][m], c1 = -1.4426950408889634f * r, ms = __builtin_amdgcn_rcpf(r * r); float hv[8];
#pragma unroll
                for (int n = 0; n < 2; ++n) { const f32x4 gv = to_rowmajor(acc[ai][0][m][n], pidx), uv = to_rowmajor(acc[ai][1][m][n], pidx);
#pragma unroll
                    for (int i = 0; i < 4; i += 2) {
                        const f32x2 g2 = (f32x2){gv[i], gv[i + 1]}, u2 = (f32x2){uv[i], uv[i + 1]}; const f32x2 t2 = g2 * c1;
                        f32x2 e2; e2.x = __builtin_amdgcn_exp2f(t2.x); e2.y = __builtin_amdgcn_exp2f(t2.y);
                        const f32x2 d2 = e2 * ms + ms; f32x2 s2; s2.x = __builtin_amdgcn_rcpf(d2.x); s2.y = __builtin_amdgcn_rcpf(d2.y);
                        const f32x2 h2 = (g2 * u2) * s2; hv[4 * n + i] = h2.x; hv[4 * n + i + 1] = h2.y; } }
                u32x4 w; w.x = cvt_pk_bf16(hv[0], hv[1]); w.y = cvt_pk_bf16(hv[2], hv[3]); w.z = cvt_pk_bf16(hv[4], hv[5]); w.w = cvt_pk_bf16(hv[6], hv[7]);
                *(u32x4*)(H + (size_t)(row0 + ai * HALF + m * 16) * ldh + col0) = w; }
    }
};
struct EpiQKV {
    static constexpr bool PERM = true, AFTER_DRAIN = false;
    const float* ssq; const float* gq; const float* gk;
    bf16_t* QP; size_t pstride;
    bf16_t* QS; bf16_t* KS; size_t sstride; int srows, lc;
    float* okp; size_t opstride; float* oks; size_t osstride;
    int fox;
    PG8_LAS float* red;
    __device__ __forceinline__ void operator()(const f32x4 (&acc)[2][2][4][2], const Unit& u, int wr, int wc, int fr_, int fq_) const {
        int fr = fr_, fq = fq_; asm volatile("" : "+v"(fr), "+v"(fq));
        const int which = u.pn >> 3, head0 = (u.pn & 7) * 2;
        const int lane_ = fq_ * 16 + fr_, r2 = lane_ >> 2, c2 = lane_ & 3, pidx = rowmajor_pidx(lane_);
        float rsv[2][4]; rows_rstd_rm(rsv, ssq, u.pm, wr, r2, c2);
        if (which < 2) {
#pragma unroll
            for (int ai = 0; ai < 2; ++ai)
#pragma unroll
                for (int m = 0; m < 4; ++m)
#pragma unroll
                    for (int bj = 0; bj < 2; ++bj) { float s = 0.f;
#pragma unroll
                        for (int n = 0; n < 2; ++n) { const f32x4 x = acc[ai][bj][m][n]; s += (x[0] * x[0] + x[1] * x[1]) + (x[2] * x[2] + x[3] * x[3]); }
                        s += __shfl_xor(s, 16); s += __shfl_xor(s, 32);
                        if (fq == 0) red[(wc * 256 + ai * HALF + wr * 64 + m * 16 + fr) * 2 + bj] = s; }
            asm volatile("s_waitcnt lgkmcnt(0)" ::: "memory"); __builtin_amdgcn_s_barrier(); asm volatile("" ::: "memory");
        }
        const int cih = wc * 32 + 8 * c2;
        f32x4 g0 = (f32x4){1.f, 1.f, 1.f, 1.f}, g1 = g0;
        if (which < 2) { const float* g = (which == 0 ? gq : gk) + cih; g0 = *(const f32x4*)g; g1 = *(const f32x4*)(g + 4); }
        const bool samp = u.pm >= 64;
        const bool f32out = which > 0 && (samp || fox || (u.pm & 31) >= 30);
        char* b16; char* b32 = nullptr; unsigned hs16, rowsz = 0;
        if (!samp) { const int bb = u.pm >> 5;
            b16 = (char*)(QP + (size_t)which * pstride + (size_t)(bb * 16 + head0) * (8192 * 128)); hs16 = 8192 * 128 * 2;
            if (f32out) b32 = (char*)(okp + (size_t)(which - 1) * opstride + (fox ? (size_t)bb * 8192 * 2048 : (size_t)bb * 512 * 2048) + head0 * 128);
        } else { rowsz = (which == 0) ? 16u : (unsigned)srows;
            b16 = (which == 0) ? (char*)QS : (char*)(KS + (size_t)(which == 2 ? 1 : 0) * sstride + (size_t)lc * 128); hs16 = rowsz * 256u;
            if (f32out) b32 = (char*)(oks + (size_t)(which - 1) * osstride + head0 * 128); }
        const int trow0 = samp ? 0 : ((u.pm & 31) * 256 - ((fox || !f32out) ? 0 : 7680));
#pragma unroll
        for (int ai = 0; ai < 2; ++ai)
#pragma unroll
            for (int m = 0; m < 4; ++m) { const int rit = ai * HALF + wr * 64 + m * 16 + r2;
                const float rs = rsv[ai][m];
                unsigned o16;
                if (!samp) o16 = (unsigned)((((u.pm & 31) * 256 + rit) * 128 + cih) * 2);
                else o16 = (unsigned)(((((rit >> 4) * 16 + head0) * rowsz + (rit & 15)) * 128 + cih) * 2);
                const unsigned o32 = (unsigned)(((trow0 + rit) * 2048 + cih) * 4);
#pragma unroll
                for (int bj = 0; bj < 2; ++bj) { float sc = rs;
                    if (which < 2) { const int ri = rit * 2 + bj; const float t = (red[ri] + red[512 + ri]) + (red[1024 + ri] + red[1536 + ri]);
                        sc = rs * __builtin_amdgcn_rsqf(t * rs * rs * (1.0f / 128.0f) + 1e-6f); }
                    const f32x4 x0 = to_rowmajor(acc[ai][bj][m][0], pidx) * sc * g0, x1 = to_rowmajor(acc[ai][bj][m][1], pidx) * sc * g1;
                    u32x4 w; w.x = cvt_pk_bf16(x0[0], x0[1]); w.y = cvt_pk_bf16(x0[2], x0[3]); w.z = cvt_pk_bf16(x1[0], x1[1]); w.w = cvt_pk_bf16(x1[2], x1[3]);
                    *(u32x4*)(b16 + (size_t)(o16 + (unsigned)bj * hs16)) = w;
                    if (f32out) { float* fo = (float*)(b32 + (size_t)(o32 + (unsigned)bj * 512u)); __builtin_nontemporal_store(x0, (f32x4*)fo); __builtin_nontemporal_store(x1, (f32x4*)(fo + 4)); } }
                asm volatile("" ::: "memory"); }
    }
};
}

namespace sk {
typedef short bf16x8 __attribute__((ext_vector_type(8)));
typedef float f32x4 __attribute__((ext_vector_type(4)));
typedef unsigned u32x2 __attribute__((ext_vector_type(2)));
typedef unsigned u32x4 __attribute__((ext_vector_type(4)));
typedef unsigned short bf16_t;
#define SLAS __attribute__((address_space(3)))
__device__ __forceinline__ unsigned cvtpk(float lo, float hi) { unsigned r; asm volatile("v_cvt_pk_bf16_f32 %0, %1, %2" : "=v"(r) : "v"(lo), "v"(hi)); return r; }
__device__ __forceinline__ float row_rstd(const float* ssq, int row, int fq) {
    const f32x4 a = *(const f32x4*)(ssq + (size_t)row * 32 + fq * 8), b = *(const f32x4*)(ssq + (size_t)row * 32 + fq * 8 + 4);
    float s = ((a[0] + a[1]) + (a[2] + a[3])) + ((b[0] + b[1]) + (b[2] + b[3]));
    s += __shfl_xor(s, 16); s += __shfl_xor(s, 32);
    return __builtin_amdgcn_rsqf(s * (1.0f / 2048.0f) + 1e-6f);
}
struct SkResid {
    static constexpr int MB = 2, NB = 2, NS = 6; static constexpr bool NEEDS_X = true;
    const float* xin; float* X; bf16_t* XB; float* ssq;
    __device__ __forceinline__ int brow(int ct, int ch, int n) const { return ct * 64 + ch * 32 + 16 * n; }
    __device__ __forceinline__ void partial(f32x4 (&acc)[MB][NB], int rt, int ct, int ch, int fr, int fq, SLAS float* red) const {
        f32x4 xo[MB][NB];
#pragma unroll
        for (int m = 0; m < MB; ++m)
#pragma unroll
            for (int n = 0; n < NB; ++n) xo[m][n] = *(const f32x4*)(xin + (size_t)(rt * 32 + 16 * m + fr) * 2048 + ct * 64 + ch * 32 + 16 * n + 4 * fq);
#pragma unroll
        for (int m = 0; m < MB; ++m) { float s = 0.f;
#pragma unroll
            for (int n = 0; n < NB; ++n) { const f32x4 x = xo[m][n] + acc[m][n]; acc[m][n] = x; s += (x[0] * x[0] + x[1] * x[1]) + (x[2] * x[2] + x[3] * x[3]); }
            s += __shfl_xor(s, 16); s += __shfl_xor(s, 32);
            if (fq == 0) red[ch * 32 + 16 * m + fr] = s; }
    }
    __device__ __forceinline__ void operator()(const f32x4 (&acc)[MB][NB], int rt, int ct, int ch, int fr, int fq, SLAS float* red) const {
#pragma unroll
        for (int m = 0; m < MB; ++m) { const int r = rt * 32 + 16 * m + fr; const size_t off = (size_t)r * 2048 + ct * 64 + ch * 32 + 4 * fq;
#pragma unroll
            for (int n = 0; n < NB; ++n) { const f32x4 x = acc[m][n];
                *(f32x4*)(X + off + 16 * n) = x; u32x2 w; w.x = cvtpk(x[0], x[1]); w.y = cvtpk(x[2], x[3]); *(u32x2*)(XB + off + 16 * n) = w; }
            if (ch == 0 && fq == 0) ssq[(size_t)r * 32 + ct] = red[16 * m + fr] + red[32 + 16 * m + fr]; }
    }
};
struct SkSwiglu {
    static constexpr int MB = 4, NB = 4, NS = 3; static constexpr bool NEEDS_X = false;
    bf16_t* H; int ldh; const float* ssq;
    __device__ __forceinline__ int brow(int ct, int ch, int n) const { return 256 * (ct >> 1) + (ct & 1) * 64 + ch * 32 + (n >= 2 ? 128 + 16 * (n - 2) : 16 * n); }
    __device__ __forceinline__ void partial(f32x4 (&acc)[MB][NB], int, int, int, int, int, SLAS float*) const {}
    __device__ __forceinline__ void operator()(const f32x4 (&acc)[MB][NB], int rt, int ct, int ch, int fr, int fq, SLAS float* red) const {
        float rs[MB];
        { f32x4 pa[MB], pb[MB];
#pragma unroll
          for (int m = 0; m < MB; ++m) { const float* sp = ssq + (size_t)(rt * 64 + 16 * m + fr) * 32 + fq * 8; pa[m] = *(const f32x4*)sp; pb[m] = *(const f32x4*)(sp + 4); }
#pragma unroll
          for (int m = 0; m < MB; ++m) { float s = ((pa[m][0] + pa[m][1]) + (pa[m][2] + pa[m][3])) + ((pb[m][0] + pb[m][1]) + (pb[m][2] + pb[m][3]));
              s += __shfl_xor(s, 16); s += __shfl_xor(s, 32); rs[m] = __builtin_amdgcn_rsqf(s * (1.0f / 2048.0f) + 1e-6f); } }
#pragma unroll
        for (int m = 0; m < MB; ++m) { const int r = rt * 64 + 16 * m + fr;
#pragma unroll
            for (int n = 0; n < 2; ++n) { float hv[4];
#pragma unroll
                for (int i = 0; i < 4; ++i) { const float g = acc[m][n][i] * rs[m], up = acc[m][n + 2][i] * rs[m]; hv[i] = g * __builtin_amdgcn_rcpf(1.0f + __expf(-g)) * up; }
                u32x2 w; w.x = cvtpk(hv[0], hv[1]); w.y = cvtpk(hv[2], hv[3]);
                *(u32x2*)(H + (size_t)r * ldh + 128 * (ct >> 1) + (ct & 1) * 64 + ch * 32 + 16 * n + 4 * fq) = w; } }
    }
};
struct SkQKV {
    static constexpr int MB = 4, NB = 4, NS = 3; static constexpr bool NEEDS_X = true;
    const float* ssq; const float* gq; const float* gk;
    bf16_t* QS; bf16_t* KS; size_t sstride; int srows, lc;
    float* oks; size_t osstride;
    __device__ __forceinline__ int brow(int ct, int ch, int n) const { return ct * 128 + ch * 64 + 16 * n; }
    __device__ __forceinline__ void partial(f32x4 (&acc)[MB][NB], int, int, int ch, int fr, int fq, SLAS float* red) const {
#pragma unroll
        for (int m = 0; m < MB; ++m) { float s = 0.f;
#pragma unroll
            for (int n = 0; n < NB; ++n) { const f32x4 x = acc[m][n]; s += (x[0] * x[0] + x[1] * x[1]) + (x[2] * x[2] + x[3] * x[3]); }
            s += __shfl_xor(s, 16); s += __shfl_xor(s, 32);
            if (fq == 0) red[ch * 64 + 16 * m + fr] = s; }
    }
    __device__ __forceinline__ void operator()(const f32x4 (&acc)[MB][NB], int rt, int ct, int ch, int fr, int fq, SLAS float* red) const {
        const int which = ct >> 4, h = ct & 15;
        const float* g = (which == 0 ? gq : gk) + ch * 64 + 4 * fq;
        bf16_t* b16 = (which == 0) ? QS : KS + (size_t)(which == 2 ? 1 : 0) * sstride + (size_t)lc * 128; const int rowsz = (which == 0) ? 16 : srows;
        float* b32 = oks + (size_t)(which > 0 ? which - 1 : 0) * osstride + h * 128 + ch * 64 + 4 * fq;
        float rs[MB];
        { f32x4 pa[MB], pb[MB];
#pragma unroll
          for (int m = 0; m < MB; ++m) { const float* sp = ssq + (size_t)(rt * 64 + 16 * m + fr) * 32 + fq * 8; pa[m] = *(const f32x4*)sp; pb[m] = *(const f32x4*)(sp + 4); }
#pragma unroll
          for (int m = 0; m < MB; ++m) { float s = ((pa[m][0] + pa[m][1]) + (pa[m][2] + pa[m][3])) + ((pb[m][0] + pb[m][1]) + (pb[m][2] + pb[m][3]));
              s += __shfl_xor(s, 16); s += __shfl_xor(s, 32); rs[m] = __builtin_amdgcn_rsqf(s * (1.0f / 2048.0f) + 1e-6f); } }
#pragma unroll
        for (int m = 0; m < MB; ++m) { const int r = rt * 64 + 16 * m + fr; float sc = rs[m];
            if (which < 2) { const float s = red[16 * m + fr] + red[64 + 16 * m + fr]; sc = rs[m] * __builtin_amdgcn_rsqf(s * rs[m] * rs[m] * (1.0f / 128.0f) + 1e-6f); }
            bf16_t* d16 = b16 + ((size_t)((r >> 4) * 16 + h) * rowsz + (r & 15)) * 128 + ch * 64 + 4 * fq; float* d32 = b32 + (size_t)r * 2048;
#pragma unroll
            for (int n = 0; n < NB; ++n) { f32x4 x = acc[m][n] * sc; if (which < 2) x = x * *(const f32x4*)(g + 16 * n);
                u32x2 w; w.x = cvtpk(x[0], x[1]); w.y = cvtpk(x[2], x[3]); *(u32x2*)(d16 + 16 * n) = w;
                if (which > 0) *(f32x4*)(d32 + 16 * n) = x; } }
    }
};
template <class Epi>
__device__ __forceinline__ void skinny_phase(SLAS unsigned char* lds, const bf16_t* A, const bf16_t* Bt, int nct, int K, unsigned* qc  , int tid, const Epi& E) {
    constexpr int MB = Epi::MB, NB = Epi::NB, NS = Epi::NS, NRT = 16 / MB, SLOT = MB * NB * 1024;
    const int lane = tid & 63, wid = __builtin_amdgcn_readfirstlane(tid >> 6), fr = lane & 15, fq = lane >> 4, kq = wid & 3, ch = wid >> 2;
    const int kw = K >> 2;
    SLAS float* red = (SLAS float*)(lds + 4 * SLOT);
    for (;;) {
        volatile SLAS int* tw = (volatile SLAS int*)(lds + 67712);
        if (tid == 0) *tw = (int)__hip_atomic_fetch_add(qc, 1u, __ATOMIC_RELAXED, __HIP_MEMORY_SCOPE_AGENT);
        __syncthreads();
        const int tile = __builtin_amdgcn_readfirstlane(*tw);
        if (tile >= NRT * nct) break;
        const int rt = tile % NRT, ct = tile / NRT;
        f32x4 acc[MB][NB];
#pragma unroll
        for (int m = 0; m < MB; ++m)
#pragma unroll
            for (int n = 0; n < NB; ++n) acc[m][n] = (f32x4){0.f, 0.f, 0.f, 0.f};
        const unsigned lo = (unsigned)(((lane >> 2) * K + kq * kw + (lane & 3) * 8) * 2);
        const int pidx = (((lane & 15) << 2) | (lane >> 4)) << 2;
        const char* ab = (const char*)(A + (size_t)(rt * 16 * MB) * K);
        const char* bb[NB];
#pragma unroll
        for (int n = 0; n < NB; ++n) bb[n] = (const char*)(Bt + (size_t)E.brow(ct, ch, n) * K);
        bf16x8 fa[NS][MB], fb[NS][NB];
#define SK_LOAD(st, ks) do { const unsigned o_ = lo + (unsigned)((ks) * 2); _Pragma("unroll") for (int m = 0; m < MB; ++m) fa[st][m] = *(const bf16x8*)(ab + (size_t)(o_ + (unsigned)(16 * m * K * 2))); \
            _Pragma("unroll") for (int n = 0; n < NB; ++n) fb[st][n] = *(const bf16x8*)(bb[n] + (size_t)o_); } while (0)
#define SK_PERM(v) do { u32x4 w_ = __builtin_bit_cast(u32x4, v); w_.x = (unsigned)__builtin_amdgcn_ds_bpermute(pidx, (int)w_.x); w_.y = (unsigned)__builtin_amdgcn_ds_bpermute(pidx, (int)w_.y); \
            w_.z = (unsigned)__builtin_amdgcn_ds_bpermute(pidx, (int)w_.z); w_.w = (unsigned)__builtin_amdgcn_ds_bpermute(pidx, (int)w_.w); v = __builtin_bit_cast(bf16x8, w_); } while (0)
#define SK_MMA(st) do { _Pragma("unroll") for (int m = 0; m < MB; ++m) SK_PERM(fa[st][m]); _Pragma("unroll") for (int n = 0; n < NB; ++n) SK_PERM(fb[st][n]); \
            _Pragma("unroll") for (int m = 0; m < MB; ++m) _Pragma("unroll") for (int n = 0; n < NB; ++n) acc[m][n] = __builtin_amdgcn_mfma_f32_16x16x32_bf16(fb[st][n], fa[st][m], acc[m][n], 0, 0, 0); } while (0)
#define SK_SB() __builtin_amdgcn_sched_barrier(0)
        const int nst = kw >> 5, kl = kw - 32;
#pragma unroll
        for (int j = 0; j < NS - 1; ++j) { SK_LOAD(j, (j * 32 < kw ? j * 32 : kl)); SK_SB(); }
        for (int s0 = 0; s0 < nst; s0 += NS) {
#pragma unroll
            for (int j = 0; j < NS; ++j) { const int kn = (s0 + j + NS - 1) * 32; SK_LOAD((j + NS - 1) % NS, kn < kw ? kn : kl); SK_SB(); if (s0 + j < nst) SK_MMA(j); SK_SB(); }
        }
#undef SK_SB
#undef SK_LOAD
#undef SK_MMA
#undef SK_PERM
#pragma unroll
        for (int half = 2; half >= 1; half >>= 1) {
            if (kq >= half && kq < 2 * half) { SLAS f32x4* s = (SLAS f32x4*)(lds + (ch * 2 + kq - half) * SLOT) + lane;
#pragma unroll
                for (int m = 0; m < MB; ++m)
#pragma unroll
                    for (int n = 0; n < NB; ++n) s[(m * NB + n) * 64] = acc[m][n]; }
            __syncthreads();
            if (kq < half) { const SLAS f32x4* s = (const SLAS f32x4*)(lds + (ch * 2 + kq) * SLOT) + lane;
#pragma unroll
                for (int m = 0; m < MB; ++m)
#pragma unroll
                    for (int n = 0; n < NB; ++n) acc[m][n] = acc[m][n] + s[(m * NB + n) * 64]; }
            __syncthreads();
        }
        if constexpr (Epi::NEEDS_X) { if (kq == 0) E.partial(acc, rt, ct, ch, fr, fq, red); __syncthreads(); }
        if (kq == 0) E(acc, rt, ct, ch, fr, fq, red);
        if constexpr (Epi::NEEDS_X) __syncthreads();
    }
}
}

namespace att {
typedef short bf16x8 __attribute__((ext_vector_type(8)));
typedef short s16x4 __attribute__((ext_vector_type(4)));
typedef float f32x16 __attribute__((ext_vector_type(16)));
typedef float f32x4 __attribute__((ext_vector_type(4)));
typedef unsigned u32x4 __attribute__((ext_vector_type(4)));
typedef unsigned short bf16;
#define ALAS __attribute__((address_space(3)))
constexpr int D = 128, NW = 8, QBLK = 32, KVBLK = 64, QB = NW * QBLK;
constexpr int SHM_V = KVBLK * D * 2, SHM_K = KVBLK * D * 2;
constexpr int OFF_V = 0, OFF_K = 2 * SHM_V, OFF_WS = 2 * SHM_V + 2 * SHM_K, OFF_TAB = OFF_WS + NW * 64 * 4, OFF_BIAS = OFF_TAB + 1024, LDS_END = OFF_BIAS + 8192 * 4 + 512;
constexpr float SCALE = 0.08838834764831845f, RSCALE = 11.313708498984761f;
constexpr float THR = 8.f;
#define KSWZ(row, colB) ((row) * 256 + ((colB) ^ (((row) & 7) << 4)))
#define SBAR() __builtin_amdgcn_sched_barrier(0)
__device__ __forceinline__ int v_st(int k, int c) { const int kk = (k & ~0xC) | ((k & 4) << 1) | ((k & 8) >> 1); return ((kk >> 3) * 4 + (c >> 5)) * 512 + ((kk & 7) * 32 + (c & 31)) * 2; }
__device__ __forceinline__ int v_rd_base(int lane) { return ((lane & 3) << 3) | (((lane >> 2) & 3) << 6) | (((lane >> 4) & 1) << 5) | (((lane >> 5) & 1) << 8); }
constexpr int v_rd_off(int d0, int ks, int half) { return d0 * 512 + ks * 4096 + half * 2048; }
__device__ __forceinline__ int crow(int r, int hi) { return (r & 3) + 8 * (r >> 2) + 4 * hi; }
__device__ __forceinline__ unsigned cvtpk(float lo, float hi) { unsigned r; asm volatile("v_cvt_pk_bf16_f32 %0, %1, %2" : "=v"(r) : "v"(lo), "v"(hi)); return r; }
__device__ __forceinline__ bf16x8 load8(const bf16* p) { return *reinterpret_cast<const bf16x8*>(p); }
__device__ __forceinline__ void mask_tile(f32x16& p0, f32x16& p1, int dq) {
    const float NEG = -__builtin_inff();
#pragma unroll
    for (int r = 0; r < 16; ++r) {
        const int c = (r & 3) + 8 * (r >> 2);
        if (dq - c < 0) p0[r] = NEG;
        if (dq - c - 32 < 0) p1[r] = NEG;
    }
}
__device__ __forceinline__ void partialSM(f32x16& p0, f32x16& p1, float& m_reg, float& mn, float& alpha) {
    float pmax = p0[0]; for (int r = 1; r < 16; ++r) pmax = fmaxf(pmax, p0[r]); for (int r = 0; r < 16; ++r) pmax = fmaxf(pmax, p1[r]);
    { auto rr = __builtin_amdgcn_permlane32_swap(__float_as_uint(pmax), __float_as_uint(pmax), false, false);
      pmax = fmaxf(__uint_as_float(rr[0]), __uint_as_float(rr[1])); }
    constexpr float C2 = 1.4426950408889634f * SCALE;
    if (__builtin_expect(__all((pmax - m_reg) * SCALE <= THR), 1)) { mn = m_reg; alpha = 1.f; }
    else { mn = fmaxf(m_reg, pmax); alpha = __builtin_amdgcn_exp2f((m_reg - mn) * C2); m_reg = mn; }
    const float mnL = -mn * C2;
    for (int r = 0; r < 16; ++r) p0[r] = fmaf(p0[r], C2, mnL); for (int r = 0; r < 16; ++r) p1[r] = fmaf(p1[r], C2, mnL);
    for (int r = 0; r < 16; ++r) p0[r] = __builtin_amdgcn_exp2f(p0[r]);
}
__device__ __forceinline__ void finishSM(f32x16& p0, f32x16& p1, float alpha, float& l_reg, bf16x8& pa0, bf16x8& pa1, bf16x8& pa2, bf16x8& pa3) {
    for (int r = 0; r < 16; ++r) p1[r] = __builtin_amdgcn_exp2f(p1[r]);
    float ps = 0; for (int r = 0; r < 16; ++r) ps += p0[r]; for (int r = 0; r < 16; ++r) ps += p1[r];
    { auto rr = __builtin_amdgcn_permlane32_swap(__float_as_uint(ps), __float_as_uint(ps), false, false);
      ps = __uint_as_float(rr[0]) + __uint_as_float(rr[1]); }
    l_reg = l_reg * alpha + ps;
#define PK4(P, B_, OUT) do { unsigned a0 = cvtpk(P[B_+0], P[B_+1]), a1 = cvtpk(P[B_+2], P[B_+3]);                          \
        unsigned b0 = cvtpk(P[B_+4], P[B_+5]), b1 = cvtpk(P[B_+6], P[B_+7]);                                             \
        auto r0 = __builtin_amdgcn_permlane32_swap(a0, b0, false, false); auto r1 = __builtin_amdgcn_permlane32_swap(a1, b1, false, false); \
        u32x4 w = {r0[0], r1[0], r0[1], r1[1]}; OUT = *reinterpret_cast<bf16x8*>(&w); } while (0)
    PK4(p0, 0, pa0); PK4(p0, 8, pa1); PK4(p1, 0, pa2); PK4(p1, 8, pa3);
#undef PK4
}
struct Blk {
    const bf16* Q; const bf16* K; const bf16* V; bf16* O;
    const float* aux;
    int P0;
    int jlo, jhi;
    int cap;
    int c0;
    float skipthr;
};
struct Nxt { const bf16* Q; const bf16* K; const bf16* V; int jlo; };
constexpr int OSTR = 2048;
struct Seam { bf16x8 qr[8]; bf16x8 st_v0, st_v1, st_k0, st_k1; };

template <int MODE, int KB>
__device__ __forceinline__ void qkt(f32x16& p0, f32x16& p1, ALAS const char* lds, int r32, int hi, const bf16x8* qr, bool act, int tile  , int dist  , int irow  ) {
    if (!act) { const float NEG = -__builtin_inff();
#pragma unroll
        for (int r = 0; r < 16; ++r) { p0[r] = NEG; p1[r] = NEG; } return; }
    if constexpr (MODE == 1) {
        ALAS const float* bp = (ALAS const float*)(lds + OFF_BIAS) + tile * 64 + 4 * hi;
#pragma unroll
        for (int i = 0; i < 4; ++i) { const f32x4 a = *(ALAS const f32x4*)(bp + 8 * i), b = *(ALAS const f32x4*)(bp + 32 + 8 * i);
            p0[4 * i] = a[0]; p0[4 * i + 1] = a[1]; p0[4 * i + 2] = a[2]; p0[4 * i + 3] = a[3]; p1[4 * i] = b[0]; p1[4 * i + 1] = b[1]; p1[4 * i + 2] = b[2]; p1[4 * i + 3] = b[3]; }
    } else {
        ALAS const float* R = (ALAS const float*)(lds + OFF_TAB);
        if (dist <= 2) { ALAS const float* rp = R + (191 - 64 * dist - irow + 4 * hi);
#pragma unroll
            for (int r = 0; r < 16; ++r) { p0[r] = rp[(r & 3) + 8 * (r >> 2)]; p1[r] = rp[32 + (r & 3) + 8 * (r >> 2)]; } }
        else { const float cf = R[0];
#pragma unroll
            for (int r = 0; r < 16; ++r) { p0[r] = cf; p1[r] = cf; } }
    }
    ALAS const char* K_lds = lds + OFF_K;
    ALAS const char* kb[4];
#pragma unroll
    for (int dd = 0; dd < 4; ++dd) kb[dd] = K_lds + KB * SHM_K + KSWZ(r32, (dd * 16 + hi * 8) * 2);
#pragma unroll
    for (int d0 = 0; d0 < 8; ++d0) { ALAS const char* a = kb[d0 & 3] + (d0 >> 2) * 128;
        bf16x8 b0 = *reinterpret_cast<ALAS const bf16x8*>(a);
        bf16x8 b1 = *reinterpret_cast<ALAS const bf16x8*>(a + 32 * 256);
        p0 = __builtin_amdgcn_mfma_f32_32x32x16_bf16(b0, qr[d0], p0, 0, 0, 0);
        p1 = __builtin_amdgcn_mfma_f32_32x32x16_bf16(b1, qr[d0], p1, 0, 0, 0); }
}
template <int MODE, int VB>
__device__ __forceinline__ void pv_tile(f32x16* o, int vb0, bf16x8 pa0, bf16x8 pa1, bf16x8 pa2, bf16x8 pa3, bool act) {
    if (!act) return;
#define TRRD(dst, off) asm volatile("ds_read_b64_tr_b16 %0, %1 offset:%2" : "=&v"(dst) : "v"(vb0), "i"(off) : "memory")
#define PV_D0(d0) do { s16x4 l0, l1, l2, l3, h0, h1, h2, h3; constexpr int b_ = VB * SHM_V + v_rd_off(d0, 0, 0); \
        TRRD(l0, b_); TRRD(h0, b_ + 2048); TRRD(l1, b_ + 4096); TRRD(h1, b_ + 6144); TRRD(l2, b_ + 8192); TRRD(h2, b_ + 10240); TRRD(l3, b_ + 12288); TRRD(h3, b_ + 14336); \
        asm volatile("s_waitcnt lgkmcnt(0)" ::: "memory"); SBAR();   \
        o[d0] = __builtin_amdgcn_mfma_f32_32x32x16_bf16(pa0, (bf16x8){l0[0], l0[1], l0[2], l0[3], h0[0], h0[1], h0[2], h0[3]}, o[d0], 0, 0, 0);   \
        o[d0] = __builtin_amdgcn_mfma_f32_32x32x16_bf16(pa1, (bf16x8){l1[0], l1[1], l1[2], l1[3], h1[0], h1[1], h1[2], h1[3]}, o[d0], 0, 0, 0);   \
        o[d0] = __builtin_amdgcn_mfma_f32_32x32x16_bf16(pa2, (bf16x8){l2[0], l2[1], l2[2], l2[3], h2[0], h2[1], h2[2], h2[3]}, o[d0], 0, 0, 0);   \
        o[d0] = __builtin_amdgcn_mfma_f32_32x32x16_bf16(pa3, (bf16x8){l3[0], l3[1], l3[2], l3[3], h3[0], h3[1], h3[2], h3[3]}, o[d0], 0, 0, 0); } while (0)
    PV_D0(0); PV_D0(1); PV_D0(2); PV_D0(3);
#undef PV_D0
#undef TRRD
}
#define AROW(p, k0, rr) ((const bf16*)((const char*)(p) + (size_t)(unsigned)(((k0) + (rr)) * (D * 2) + sc * 2)))
#define VMW() asm volatile("s_waitcnt vmcnt(0)" ::: "memory")
#define VMWN(n) asm volatile("s_waitcnt vmcnt(%0)" :: "i"(n) : "memory")
#define SLOAD_H(Kp, Vp, k0) do { S.st_v0 = load8(AROW(Vp, k0, sr)); S.st_v1 = load8(AROW(Vp, k0, 32 + sr));              \
                         S.st_k0 = load8(AROW(Kp, k0, sr)); S.st_k1 = load8(AROW(Kp, k0, 32 + sr)); } while (0)
#define SWRITE_HK(bf) do { *(ALAS bf16x8*)(K_lds + (bf) * SHM_K + kws) = S.st_k0; *(ALAS bf16x8*)(K_lds + (bf) * SHM_K + kws + 32 * 256) = S.st_k1; } while (0)
#define SWRITE_HV(bf) do { *(ALAS bf16x8*)(V_lds + (bf) * SHM_V + vst0) = S.st_v0; *(ALAS bf16x8*)(V_lds + (bf) * SHM_V + vst1) = S.st_v1; } while (0)
#define SWRITE_H(bf) do { SWRITE_HV(bf); SWRITE_HK(bf); } while (0)
template <int MODE>
__device__ __forceinline__ float build_bias(const Blk& b, ALAS char* lds, int tid) {
    asm volatile("" : "+v"(tid));
    if constexpr (MODE == 0) {
        if (tid < 256) { int d = 191 - tid; d = d < -128 ? -128 : (d > 128 ? 128 : d); ((ALAS float*)(lds + OFF_TAB))[tid] = b.aux[d + 128] * RSCALE; }
        return 0.f;
    } else {
        const int nk = b.jhi * 64, nv = b.cap + 1, e0 = tid * 16, lane = tid & 63, wid = tid >> 6;
        float v[16];
#pragma unroll
        for (int i = 0; i < 4; ++i) { f32x4 x = (f32x4){0.f, 0.f, 0.f, 0.f};
            if (e0 + 4 * i < nv) x = *(const f32x4*)(b.aux + e0 + 4 * i);
            v[4 * i] = x[0]; v[4 * i + 1] = x[1]; v[4 * i + 2] = x[2]; v[4 * i + 3] = x[3]; }
        float run = 0.f;
#pragma unroll
        for (int i = 15; i >= 0; --i) { const float x = v[i]; v[i] = run; run += x; }
        float incl = run;
#pragma unroll
        for (int o = 1; o < 64; o <<= 1) { const float t = __int_as_float(__builtin_amdgcn_ds_bpermute(((lane + o) & 63) << 2, __float_as_int(incl))); if (lane + o < 64) incl += t; }
        ALAS float* wt = (ALAS float*)(lds + OFF_TAB);
        if (lane == 0) wt[wid] = incl;
        asm volatile("s_waitcnt lgkmcnt(0)" ::: "memory"); __builtin_amdgcn_s_barrier(); asm volatile("" ::: "memory");
        float after = incl - run;
#pragma unroll
        for (int w = 1; w < 8; ++w) { const float t = wt[w]; if (w > wid) after += t; }
        if (e0 < nk) { ALAS f32x4* o4 = (ALAS f32x4*)(lds + OFF_BIAS) + tid * 4;
#pragma unroll
            for (int i = 0; i < 4; ++i) o4[i] = (f32x4){(v[4 * i] + after) * RSCALE, (v[4 * i + 1] + after) * RSCALE, (v[4 * i + 2] + after) * RSCALE, (v[4 * i + 3] + after) * RSCALE}; }
        return after;
    }
}
template <int MODE>
__device__ __forceinline__ void attn_prime(const Blk& cur, ALAS char* lds, Seam& S, int tid) {
    asm volatile("" : "+v"(tid));
    const int wid = __builtin_amdgcn_readfirstlane(tid >> 6), lane = tid & 63, r32 = lane & 31, hi = lane >> 5;
    const int sr = tid >> 4, sc = (tid & 15) * 8, kws = KSWZ(sr, sc * 2); ALAS char* K_lds = lds + OFF_K;
    const int kb0 = cur.jlo * KVBLK;
    const int qrow = wid * QBLK + r32;
#pragma unroll
    for (int d0 = 0; d0 < 8; ++d0) S.qr[d0] = load8((const bf16*)((const char*)cur.Q + (size_t)(unsigned)(qrow * (D * 2) + hi * 16 + d0 * 32)));
    SLOAD_H(cur.K, cur.V, kb0); VMW(); SWRITE_HK(0);
    __syncthreads();
}
template <int MODE, class IssueFn, class NextFn>
__device__ __forceinline__ void attn_block(const Blk& cur, IssueFn&& issue_fn, NextFn&& next_fn, ALAS char* lds, Seam& S, int tid) {
    asm volatile("" : "+v"(tid));
    const int wid = __builtin_amdgcn_readfirstlane(tid >> 6), lane = tid & 63, r32 = lane & 31, hi = lane >> 5;
    bf16x8 kd[8];
    if constexpr (MODE == 1) { const char* kp = (const char*)cur.K + (size_t)(unsigned)((cur.P0 + wid * QBLK + r32) * (D * 2) + hi * 16);
#pragma unroll
        for (int d0 = 0; d0 < 8; ++d0) kd[d0] = load8((const bf16*)(kp + d0 * 32)); }
    const float s_end = build_bias<MODE>(cur, lds, tid);
    asm volatile("s_waitcnt lgkmcnt(0)" ::: "memory"); __syncthreads();
    int j_lo = cur.jlo;
    const int sr = tid >> 4, sc = (tid & 15) * 8, vst0 = v_st(sr, sc), vst1 = v_st(32 + sr, sc), kws = KSWZ(sr, sc * 2);
    ALAS char* V_lds = lds + OFF_V; ALAS char* K_lds = lds + OFF_K;
    if constexpr (MODE == 1) {
        float dsum = 0.f;
#pragma unroll
        for (int d0 = 0; d0 < 8; ++d0) { const u32x4 qa = *reinterpret_cast<const u32x4*>(&S.qr[d0]), ka = *reinterpret_cast<const u32x4*>(&kd[d0]);
#pragma unroll
            for (int i = 0; i < 4; ++i) { dsum = fmaf(__uint_as_float(qa[i] << 16), __uint_as_float(ka[i] << 16), dsum);
                dsum = fmaf(__uint_as_float(qa[i] & 0xffff0000u), __uint_as_float(ka[i] & 0xffff0000u), dsum); } }
        { auto rr = __builtin_amdgcn_permlane32_swap(__float_as_uint(dsum), __float_as_uint(dsum), false, false); dsum = __uint_as_float(rr[0]) + __uint_as_float(rr[1]); }
        float gv = (((ALAS const float*)(lds + OFF_BIAS))[cur.P0 + wid * QBLK + r32] + dsum) * SCALE;
#pragma unroll
        for (int o = 1; o < 32; o <<= 1) gv = fminf(gv, __shfl_xor(gv, o));
        ALAS float* wg = (ALAS float*)(lds + OFF_TAB) + 32;
        if (lane == 0) wg[wid] = gv;
        asm volatile("s_waitcnt lgkmcnt(0)" ::: "memory"); __builtin_amdgcn_s_barrier(); asm volatile("" ::: "memory");
        float G = wg[0];
#pragma unroll
        for (int w = 1; w < 8; ++w) G = fminf(G, wg[w]);
        const bool pred = ((tid & 3) == 3) && ((tid >> 2) < (cur.P0 >> 6)) && (s_end < G - cur.skipthr);
        const int cnt = __builtin_popcountll(__ballot(pred));
        ALAS int* wcnt = (ALAS int*)(lds + OFF_TAB) + 16;
        if (lane == 0) wcnt[wid] = cnt;
        asm volatile("s_waitcnt lgkmcnt(0)" ::: "memory"); __builtin_amdgcn_s_barrier(); asm volatile("" ::: "memory");
        int tot = 0;
#pragma unroll
        for (int w = 0; w < 8; ++w) tot += wcnt[w];
        j_lo = __builtin_amdgcn_readfirstlane(tot);
        if (j_lo != cur.jlo) {
            SLOAD_H(cur.K, cur.V, j_lo * KVBLK); VMW(); SWRITE_HK(0); }
        __syncthreads();
    }
    const int NT = cur.jhi - j_lo;
    const int wlim = cur.P0 + wid * QBLK;
    const int qm = wlim + r32 - 4 * hi;
    const int cw = cur.c0 + (wid >> 1);
    const int irow = (wid & 1) * 32 + r32;
    ALAS float* wsf = (ALAS float*)(lds + OFF_WS) + wid * 64; ALAS float* li_l = wsf; ALAS float* al_l = wsf + 32;
    float m_reg = -1e30f, l_reg = 0; f32x16 o[4] = {};
    const int vb0 = (int)(unsigned)(unsigned long long)V_lds + v_rd_base(lane);
    const bf16* Kh = cur.K; const bf16* Vh = cur.V;
#define RESC(a) do { if (__any((a) < 1.f)) { if (hi == 0) al_l[r32] = (a); asm volatile("s_waitcnt lgkmcnt(0)" ::: "memory");              \
                     for (int d_ = 0; d_ < 4; ++d_) for (int r = 0; r < 16; ++r) o[d_][r] *= al_l[crow(r, hi)]; } } while (0)
#define KBASE(t) ((j_lo + (t)) * KVBLK)
#define ACT(t) (MODE == 1 ? (KBASE(t) <= wlim + QBLK - 1) : ((j_lo + (t)) >= cw - 8 && (j_lo + (t)) <= cw))
#define MASKT(P0_, P1_, t) do { if (MODE == 1) { const int kb_ = KBASE(t); if (kb_ + KVBLK - 1 > wlim) mask_tile(P0_, P1_, qm - kb_); } } while (0)
#define QKT(KB, PX0, PX1, t) qkt<MODE, KB>(PX0, PX1, lds, r32, hi, S.qr, ACT(t), j_lo + (t), cw - (j_lo + (t)), irow)
    constexpr int NQL = 8;
#define SEAM_K0() do { VMWN(NQL); SWRITE_HK(0); SBAR(); } while (0)
    f32x16 pA0, pA1, pB0, pB1; float mnA, mnB, alA, alB; bf16x8 pa0, pa1, pa2, pa3;
    SWRITE_HV(0); SBAR();
    if (NT > 1) SLOAD_H(Kh, Vh, KBASE(1));
    SBAR(); QKT(0, pA0, pA1, 0);
    MASKT(pA0, pA1, 0); partialSM(pA0, pA1, m_reg, mnA, alA);
    if (NT > 1) { VMW(); SWRITE_H(1); }
    __syncthreads();
#define HALF_STEP(PX0, PX1, mnX, alX, PY0, PY1, alY, t, KB, VB, SB) do {                                                      \
        SBAR(); QKT(KB, PX0, PX1, t);                                                                                          \
        finishSM(PY0, PY1, alY, l_reg, pa0, pa1, pa2, pa3); SBAR();                                                           \
        if ((t) + 1 < NT) { SLOAD_H(Kh, Vh, KBASE((t) + 1)); SBAR(); }                                                        \
        pv_tile<MODE, VB>(o, vb0, pa0, pa1, pa2, pa3, ACT((t) - 1)); MASKT(PX0, PX1, (t)); partialSM(PX0, PX1, m_reg, mnX, alX);   \
        __syncthreads();                                                                                                      \
        if ((t) + 1 < NT) { VMW(); SWRITE_H(SB); }                                                                            \
        RESC(alX); __syncthreads(); } while (0)
    if (NT < 3) issue_fn();
    for (int t = 1; t + 1 < NT; t += 2) {
        if (t + 3 >= NT) issue_fn();
        HALF_STEP(pB0, pB1, mnB, alB, pA0, pA1, alA, t, 1, 0, 0);
        HALF_STEP(pA0, pA1, mnA, alA, pB0, pB1, alB, t + 1, 0, 1, 1);
    }
    Nxt nxt; next_fn(nxt);
    const int kbn = nxt.jlo * KVBLK;
    const bool even = (NT & 1) == 0;
    if (even) { SBAR(); QKT(1, pB0, pB1, NT - 1); SBAR(); }
    SLOAD_H(nxt.K, nxt.V, kbn); SBAR();
    { const int qrow = wid * QBLK + r32;
#pragma unroll
      for (int d0 = 0; d0 < 8; ++d0) S.qr[d0] = load8((const bf16*)((const char*)nxt.Q + (size_t)(unsigned)(qrow * (D * 2) + hi * 16 + d0 * 32))); }
    SBAR();
    finishSM(pA0, pA1, alA, l_reg, pa0, pa1, pa2, pa3); SBAR();
    pv_tile<MODE, 0>(o, vb0, pa0, pa1, pa2, pa3, ACT(even ? NT - 2 : NT - 1));
    if (even) { MASKT(pB0, pB1, NT - 1); partialSM(pB0, pB1, m_reg, mnB, alB); __syncthreads(); RESC(alB);
        finishSM(pB0, pB1, alB, l_reg, pa0, pa1, pa2, pa3); SBAR(); pv_tile<MODE, 1>(o, vb0, pa0, pa1, pa2, pa3, ACT(NT - 1)); }
    SBAR(); SEAM_K0();
    __syncthreads();
    if (hi == 0) li_l[r32] = l_reg; asm volatile("s_waitcnt lgkmcnt(0)" ::: "memory");
    float rli[16];
#pragma unroll
    for (int r = 0; r < 16; ++r) rli[r] = __builtin_amdgcn_rcpf(li_l[crow(r, hi)]);
    ALAS char* stg = lds + OFF_V + wid * 4096 + (4 * hi) * 128 + r32 * 2;
    ALAS const char* srd = lds + OFF_V + wid * 4096 + (lane >> 3) * 128 + (lane & 7) * 16;
    unsigned ooff = (unsigned)(((wid * QBLK + (lane >> 3)) * OSTR + (lane & 7) * 8) * 2);
    asm volatile("" : "+v"(ooff));
#pragma unroll
    for (int ps = 0; ps < 2; ++ps) {
#pragma unroll
        for (int dd = 0; dd < 2; ++dd)
#pragma unroll
            for (int r = 0; r < 16; r += 2) { const unsigned w = cvtpk(o[2 * ps + dd][r] * rli[r], o[2 * ps + dd][r + 1] * rli[r + 1]);
                ALAS char* a = stg + ((r & 3) + 8 * (r >> 2)) * 128 + dd * 64;
                *(ALAS unsigned short*)a = (unsigned short)w; *(ALAS unsigned short*)(a + 128) = (unsigned short)(w >> 16); }
        asm volatile("s_waitcnt lgkmcnt(0)" ::: "memory");
        u32x4 q[4];
#pragma unroll
        for (int i = 0; i < 4; ++i) q[i] = *(ALAS const u32x4*)(srd + i * 1024);
        asm volatile("s_waitcnt lgkmcnt(0)" ::: "memory");
#pragma unroll
        for (int i = 0; i < 4; ++i) *(u32x4*)((char*)cur.O + (size_t)(ooff + (unsigned)(i * 8 * OSTR * 2 + ps * 128))) = q[i];
    }
    __syncthreads();
#undef RESC
#undef KBASE
#undef ACT
#undef MASKT
#undef QKT
#undef SEAM_K0
#undef HALF_STEP
}
#undef AROW
#undef VMW
#undef VMWN
#undef SLOAD_H
#undef SWRITE_HK
#undef SWRITE_HV
#undef SWRITE_H
}

constexpr int NWAVES = 8;
constexpr int NB = 2, T = 8192, D = 2048, NH = 16, HD = 128, FF = 5632, DEPTH = 4;
constexpr int SB = 16, SN = 16, PAST = 1024, WIN = 512, NREL = 257;
constexpr int MP = NB * T, MS = SB * SN, M = MP + MS;
constexpr int NQKV = 3 * D, NGU = 2 * FF;
constexpr int LS = PAST + SN;
constexpr float EPS = 1e-6f, SCALE = 0.08838834764831845f;
constexpr size_t O_Y = 0, O_YS = (size_t)MP * D, O_AKP = O_YS + (size_t)MS * D, SZ_AP = (size_t)2 * NB * WIN * D, O_AVP = O_AKP + SZ_AP, O_BKP = O_AVP + SZ_AP,
    SZ_BP = (size_t)2 * MP * D, O_BVP = O_BKP + SZ_BP, O_BFP = O_BVP + SZ_BP, SZ_BFP = (size_t)2 * MP * NH, O_AKS = O_BFP + SZ_BFP, SZ_S = (size_t)2 * MS * D,
    O_AVS = O_AKS + SZ_S, O_BKS = O_AVS + SZ_S, O_BVS = O_BKS + SZ_S, O_BFS = O_BVS + SZ_S, OUT_TOTAL = O_BFS + (size_t)2 * MS * NH;
static_assert(OUT_TOTAL == 181411840, "out size");
constexpr size_t MiB = 1u << 20;
constexpr size_t WS_CTL = 0, CTL_ZERO_BYTES = 1 * MiB;
constexpr size_t WS_WQKV = 2 * MiB, WS_WO = 98 * MiB, WS_WGU = 130 * MiB, WS_WD = 306 * MiB;
constexpr size_t WS_XB = 394 * MiB, WS_SSQ = 459 * MiB;
constexpr size_t WS_QP = 462 * MiB, WS_KP = 526 * MiB, WS_VP = 590 * MiB;
constexpr size_t WS_QS = 654 * MiB;
constexpr size_t WS_OB = 655 * MiB, WS_HB = 720 * MiB;
constexpr size_t WS_KSN = 899 * MiB, WS_VSN = 900 * MiB;
constexpr size_t WS_LFP = 1315 * MiB, WS_WF = 1316 * MiB  , WS_LFS = 1317 * MiB, WS_CUMS = 1319 * MiB, WS_END = 1321 * MiB;
static_assert(WS_WQKV + (size_t)DEPTH * NQKV * D * 2 <= WS_WO && WS_WO + (size_t)DEPTH * D * D * 2 <= WS_WGU && WS_WGU + (size_t)DEPTH * NGU * D * 2 <= WS_WD && WS_WD + (size_t)DEPTH * D * FF * 2 <= WS_XB, "ws map: weights");
static_assert(WS_XB + (size_t)M * D * 2 <= WS_SSQ && WS_SSQ + (size_t)M * 32 * 4 <= WS_QP && WS_OB + (size_t)M * D * 2 <= WS_HB && WS_HB + (size_t)M * FF * 2 <= WS_KSN, "ws map: activations");
constexpr int CW_BAR = 4096, CW_QUEUE = 8192, CW_SKQ = 8192 + 256;
constexpr size_t WS_QKM = WS_WF + 512 * 1024;
constexpr int RING_OFF = 0, RING_BYTES = 131072;
constexpr int LDSCTL_OFF = RING_BYTES, MISC_OFF = LDSCTL_OFF + 320, RED_OFF = LDSCTL_OFF + 1024;
constexpr int LDS_BYTES = 147456;
#define GAS __attribute__((address_space(1)))
#define LAS __attribute__((address_space(3)))
typedef unsigned short bf16;
typedef unsigned v4u __attribute__((ext_vector_type(4)));
typedef float f32x4 __attribute__((ext_vector_type(4)));
typedef short bf16x8 __attribute__((ext_vector_type(8)));
typedef GAS unsigned gu32;
typedef GAS unsigned long long gu64;
#define RLX_AGENT __ATOMIC_RELAXED, __HIP_MEMORY_SCOPE_AGENT
#define LDS_WAIT() asm volatile("s_waitcnt lgkmcnt(0)" ::: "memory")
#define VM_WAIT() asm volatile("s_waitcnt vmcnt(0)" ::: "memory")
__device__ __forceinline__ unsigned long long rt() { return __builtin_amdgcn_s_memrealtime(); }
__device__ __forceinline__ unsigned f2bf(float f) { unsigned u = __builtin_bit_cast(unsigned, f); return (u + 0x7fffu + ((u >> 16) & 1u)) >> 16; }
__device__ __forceinline__ unsigned pk2(float lo, float hi) { return f2bf(lo) | (f2bf(hi) << 16); }

#define XB_TMO      128
#define XB_XCNT(j)  (256  + 64 * (j))
#define XB_XSUB(j)  (1280 + 64 * (j))
#define XB_XGEN(j)  (2304 + 64 * (j))
#define XB_TOP      3328
#define XB_TOPGEN   3392
#define XCD_BAR_WORDS 3456
#define XB_SPIN_CAP (1u << 22)

__device__ __forceinline__ unsigned xb_ld(unsigned* p)              { return __hip_atomic_load(p, __ATOMIC_RELAXED, __HIP_MEMORY_SCOPE_AGENT); }
__device__ __forceinline__ unsigned xb_add(unsigned* p, unsigned v) { return __hip_atomic_fetch_add(p, v, __ATOMIC_RELAXED, __HIP_MEMORY_SCOPE_AGENT); }
__device__ __forceinline__ unsigned xb_xcc_id() { return (unsigned)__builtin_amdgcn_s_getreg((3 << 11) | 20) & 0xFu; }
#define XB_SPIN(cond, bar) do { unsigned _sp = 0; while (cond) { __builtin_amdgcn_s_sleep(1); \
    if ((++_sp & 255u) == 0u) { if (xb_ld(&(bar)[XB_TMO])) break; if (_sp > XB_SPIN_CAP) { atomicAdd(&(bar)[XB_TMO], 1u); break; } } } } while (0)

struct XcdBarrier {
    unsigned* bar; unsigned x;
    volatile LAS unsigned* st;
};

__device__ __forceinline__ XcdBarrier xcd_barrier_post(unsigned* bar, volatile LAS unsigned* st, const bool leader  ) {
    XcdBarrier b; b.bar = bar; b.x = xb_xcc_id(); b.st = st;
    if (leader) (void)xb_add(&bar[XB_XCNT(b.x)], 1u);
    return b;
}
__device__ __forceinline__ void xcd_barrier_complete(unsigned* bar, unsigned x, unsigned& nloc, unsigned& nx) {
    const unsigned G = gridDim.x * gridDim.y * gridDim.z;
    unsigned sum, cnt, mine, sp = 0u;
    for (;;) {
        sum = 0u; cnt = 0u; mine = 0u;
#pragma unroll
        for (unsigned j = 0; j < 16; ++j) { const unsigned c = xb_ld(&bar[XB_XCNT(j)]); sum += c; cnt += (c > 0u) ? 1u : 0u; mine = (j == x) ? c : mine; }
        if (sum == G) break;
        __builtin_amdgcn_s_sleep(1);
        if ((++sp & 255u) == 0u) { if (xb_ld(&bar[XB_TMO])) break; if (sp > XB_SPIN_CAP) { atomicAdd(&bar[XB_TMO], 1u); break; } }
    }
    nloc = mine > 0u ? mine : 1u; nx = cnt > 0u ? cnt : 1u;
}

__device__ __forceinline__ void xcd_barrier(const XcdBarrier& b, const bool leader  ) {
    asm volatile("s_waitcnt vmcnt(0)" ::: "memory");
    __syncthreads();
    if (leader) {
        unsigned* bar = b.bar;
        __builtin_amdgcn_s_waitcnt(0);
        unsigned nloc = b.st[0], nx = b.st[1];
        if (nloc == 0u) { xcd_barrier_complete(bar, b.x, nloc, nx); b.st[0] = nloc; b.st[1] = nx; }
        const unsigned old = xb_add(&bar[XB_XSUB(b.x)], 1u);
        const unsigned gen = old / nloc;
        if (old + 1u == (gen + 1u) * nloc) {
            __builtin_amdgcn_fence(__ATOMIC_RELEASE, "agent");
            asm volatile("s_waitcnt vmcnt(0)" ::: "memory");
            const unsigned og = xb_add(&bar[XB_TOP], 1u);
            const unsigned tg = og / nx;
            if (og + 1u == (tg + 1u) * nx) xb_add(&bar[XB_TOPGEN], 1u);
            else XB_SPIN(xb_ld(&bar[XB_TOPGEN]) == tg, bar);
            __builtin_amdgcn_fence(__ATOMIC_ACQUIRE, "agent");
            xb_add(&bar[XB_XGEN(b.x)], 1u);
            asm volatile("s_waitcnt vmcnt(0)" ::: "memory");
        } else {
            XB_SPIN(xb_ld(&bar[XB_XGEN(b.x)]) == gen, bar);
            __builtin_amdgcn_fence(__ATOMIC_ACQUIRE, "agent");
            asm volatile("s_waitcnt vmcnt(0)" ::: "memory");
        }
    }
    __syncthreads();
}

typedef float f32x2 __attribute__((ext_vector_type(2)));
__device__ __forceinline__ float wave_sum(float v) {
#pragma unroll
    for (int o = 1; o < 64; o <<= 1) v += __shfl_xor(v, o);
    return v;
}
__device__ __forceinline__ float bf2f(unsigned b) { return __uint_as_float(b << 16); }

__device__ __forceinline__ void p0_transpose_item(const float* W, const float* g, int K, int N, bf16* WT, int mode, LAS float* scr, int item, int lane) {
    const int nblk = N / 32, kb = item / nblk, nb = item % nblk, k0 = 64 * kb, n0 = 32 * nb;
    const int kr = lane >> 3, nc = (lane & 7) * 4;
    f32x4 v[8]; float gs[8];
#pragma unroll
    for (int i = 0; i < 8; ++i) { v[i] = *(const GAS f32x4*)(W + (size_t)(k0 + kr + 8 * i) * N + n0 + nc); gs[i] = g ? g[k0 + kr + 8 * i] : 1.f; }
#pragma unroll
    for (int i = 0; i < 8; ++i) { LAS float* s = scr + (kr + 8 * i) * 33 + nc; s[0] = v[i].x * gs[i]; s[1] = v[i].y * gs[i]; s[2] = v[i].z * gs[i]; s[3] = v[i].w * gs[i]; }
    LDS_WAIT(); asm volatile("" ::: "memory");
    const int c = lane & 7;
    const int drow0 = (mode == 0) ? n0 : (256 * (n0 >> 7) + (n0 & 127) + (mode == 2 ? 128 : 0));
#pragma unroll
    for (int j = 0; j < 4; ++j) { const int n = (lane >> 3) + 8 * j; const LAS float* s = scr + (8 * c) * 33 + n;
        v4u o; o.x = pk2(s[0 * 33], s[1 * 33]); o.y = pk2(s[2 * 33], s[3 * 33]); o.z = pk2(s[4 * 33], s[5 * 33]); o.w = pk2(s[6 * 33], s[7 * 33]);
        *(GAS v4u*)(WT + (size_t)(drow0 + n) * K + k0 + 8 * c) = o; }
    LDS_WAIT(); asm volatile("" ::: "memory");
}
__device__ __forceinline__ void p0_item128(const float* W, const float* g, int K, int N, bf16* WT, int mode, LAS float* scr, int item, int lane) {
    const int nblk = N / 32, kb = item / nblk, nb = item % nblk, k0 = 128 * kb, n0 = 32 * nb;
    const int kr = lane >> 3, nc = (lane & 7) * 4;
    f32x4 v[16]; float gs[16];
#pragma unroll
    for (int i = 0; i < 16; ++i) { v[i] = *(const GAS f32x4*)(W + (size_t)(k0 + kr + 8 * i) * N + n0 + nc); gs[i] = g ? g[k0 + kr + 8 * i] : 1.f; }
    const int c = lane & 7;
    const int drow0 = (mode == 0) ? n0 : (256 * (n0 >> 7) + (n0 & 127) + (mode == 2 ? 128 : 0));
#pragma unroll
    for (int hf = 0; hf < 2; ++hf) {
#pragma unroll
        for (int i = 0; i < 8; ++i) { LAS float* s = scr + (kr + 8 * i) * 33 + nc; const f32x4 x = v[hf * 8 + i]; const float gg = gs[hf * 8 + i]; s[0] = x.x * gg; s[1] = x.y * gg; s[2] = x.z * gg; s[3] = x.w * gg; }
        LDS_WAIT(); asm volatile("" ::: "memory");
#pragma unroll
        for (int j = 0; j < 4; ++j) { const int n = (lane >> 3) + 8 * j; const LAS float* s = scr + (8 * c) * 33 + n;
            v4u o; o.x = pk2(s[0 * 33], s[1 * 33]); o.y = pk2(s[2 * 33], s[3 * 33]); o.z = pk2(s[4 * 33], s[5 * 33]); o.w = pk2(s[6 * 33], s[7 * 33]);
            *(GAS v4u*)(WT + (size_t)(drow0 + n) * K + k0 + 64 * hf + 8 * c) = o; }
        LDS_WAIT(); asm volatile("" ::: "memory");
    }
}
constexpr int CI_QKV = (D / 128) * (NQKV / 32), CI_O = (D / 128) * (D / 32), CI_G = (D / 128) * (FF / 32), CI_D = (FF / 128) * (D / 32), CI_L = CI_O + 2 * CI_G + CI_D;
__device__ __forceinline__ int conv_group_items(int grp) { return grp == 0 ? CI_QKV : (grp <= 3 ? CI_L + CI_QKV : CI_L); }
__device__ __forceinline__ void conv_item(const float* const __attribute__((address_space(4)))* in, unsigned char* ws, int grp, int it, LAS float* scr, int lane) {
    bf16* WQKV = (bf16*)(ws + WS_WQKV); bf16* WO = (bf16*)(ws + WS_WO); bf16* WGU = (bf16*)(ws + WS_WGU); bf16* WD = (bf16*)(ws + WS_WD);
    int r = it;
    if (grp > 0) { const int L = grp - 1; const float* gf = in[15] + (size_t)L * D;
        if (r < CI_O) { p0_item128(in[11] + (size_t)L * D * D, nullptr, D, D, WO + (size_t)L * D * D, 0, scr, r, lane); return; } r -= CI_O;
        if (r < CI_G) { p0_item128(in[16] + (size_t)L * D * FF, gf, D, FF, WGU + (size_t)L * NGU * D, 1, scr, r, lane); return; } r -= CI_G;
        if (r < CI_G) { p0_item128(in[17] + (size_t)L * D * FF, gf, D, FF, WGU + (size_t)L * NGU * D, 2, scr, r, lane); return; } r -= CI_G;
        if (r < CI_D) { p0_item128(in[18] + (size_t)L * FF * D, nullptr, FF, D, WD + (size_t)L * D * FF, 0, scr, r, lane); return; } r -= CI_D;
    }
    const int Lq = grp;
    p0_item128(in[8] + (size_t)Lq * D * NQKV, in[7] + (size_t)Lq * D, D, NQKV, WQKV + (size_t)Lq * NQKV * D, 0, scr, r, lane);
}
constexpr int N_SLICE = 256;
struct ConvD { const float* W; const float* g; bf16* WT; int K, N, mode, item; };
__device__ __forceinline__ ConvD conv_desc(const float* const __attribute__((address_space(4)))* in, unsigned char* ws, int grp, int it) {
    ConvD d; int r = it; const int L = grp - 1;
    if (r < CI_O) { d.W = in[11] + (size_t)L * D * D; d.g = nullptr; d.WT = (bf16*)(ws + WS_WO) + (size_t)L * D * D; d.K = D; d.N = D; d.mode = 0; d.item = r; return d; } r -= CI_O;
    if (r < 2 * CI_G) { const int up = r >= CI_G ? 1 : 0; d.W = in[16 + up] + (size_t)L * D * FF; d.g = in[15] + (size_t)L * D; d.WT = (bf16*)(ws + WS_WGU) + (size_t)L * NGU * D; d.K = D; d.N = FF; d.mode = 1 + up; d.item = r - up * CI_G; return d; } r -= 2 * CI_G;
    if (r < CI_D) { d.W = in[18] + (size_t)L * FF * D; d.g = nullptr; d.WT = (bf16*)(ws + WS_WD) + (size_t)L * D * FF; d.K = FF; d.N = D; d.mode = 0; d.item = r; return d; } r -= CI_D;
    d.W = in[8] + (size_t)grp * D * NQKV; d.g = in[7] + (size_t)grp * D; d.WT = (bf16*)(ws + WS_WQKV) + (size_t)grp * NQKV * D; d.K = D; d.N = NQKV; d.mode = 0; d.item = r; return d;
}
__device__ __forceinline__ void p0_load128(const ConvD& d, f32x4 (&v)[16], float (&gs)[16], int lane) {
    const int nblk = d.N / 32, kb = d.item / nblk, nb = d.item % nblk, k0 = 128 * kb, n0 = 32 * nb;
    const int kr = lane >> 3, nc = (lane & 7) * 4;
#pragma unroll
    for (int i = 0; i < 16; ++i) { v[i] = *(const GAS f32x4*)(d.W + (size_t)(k0 + kr + 8 * i) * d.N + n0 + nc); gs[i] = d.g ? d.g[k0 + kr + 8 * i] : 1.f; }
}
__device__ __forceinline__ void p0_finish128(const ConvD& d, const f32x4 (&v)[16], const float (&gs)[16], LAS float* scr, int lane) {
    const int nblk = d.N / 32, kb = d.item / nblk, nb = d.item % nblk, k0 = 128 * kb, n0 = 32 * nb;
    const int kr = lane >> 3, nc = (lane & 7) * 4, c = lane & 7;
    const int drow0 = (d.mode == 0) ? n0 : (256 * (n0 >> 7) + (n0 & 127) + (d.mode == 2 ? 128 : 0));
#pragma unroll
    for (int hf = 0; hf < 2; ++hf) {
#pragma unroll
        for (int i = 0; i < 8; ++i) { LAS float* s = scr + (kr + 8 * i) * 33 + nc; const f32x4 x = v[hf * 8 + i]; const float gg = gs[hf * 8 + i]; s[0] = x.x * gg; s[1] = x.y * gg; s[2] = x.z * gg; s[3] = x.w * gg; }
        LDS_WAIT(); asm volatile("" ::: "memory");
#pragma unroll
        for (int j = 0; j < 4; ++j) { const int n = (lane >> 3) + 8 * j; const LAS float* s = scr + (8 * c) * 33 + n;
            v4u o; o.x = pk2(s[0 * 33], s[1 * 33]); o.y = pk2(s[2 * 33], s[3 * 33]); o.z = pk2(s[4 * 33], s[5 * 33]); o.w = pk2(s[6 * 33], s[7 * 33]);
            *(GAS v4u*)(d.WT + (size_t)(drow0 + n) * d.K + k0 + 64 * hf + 8 * c) = o; }
        LDS_WAIT(); asm volatile("" ::: "memory");
    }
}
__device__ __forceinline__ void conv_slice(const float* const __attribute__((address_space(4)))* in, unsigned char* ws, int grp, int slice, LAS unsigned char* lds, int tid) {
    asm volatile("" : "+v"(tid));
    const int lane = tid & 63, wave = __builtin_amdgcn_readfirstlane(tid >> 6);
    LAS float* scr = (LAS float*)(lds + wave * 16384);
    const int ni = conv_group_items(grp), per = (ni + N_SLICE - 1) / N_SLICE, i0 = slice * per, i1 = (i0 + per < ni) ? i0 + per : ni;
    const int first = i0 + wave, n = (first < i1) ? (i1 - first + NWAVES - 1) / NWAVES : 0;
    if (n > 0) {
        f32x4 vA[16], vB[16]; float gA[16], gB[16];
        ConvD dA = conv_desc(in, ws, grp, first), dB = dA; p0_load128(dA, vA, gA, lane);
#pragma unroll 1
        for (int j = 0; j < n; j += 2) {
            dB = conv_desc(in, ws, grp, first + NWAVES * (j + 1 < n ? j + 1 : n - 1)); p0_load128(dB, vB, gB, lane); __builtin_amdgcn_sched_barrier(0);
            p0_finish128(dA, vA, gA, scr, lane); __builtin_amdgcn_sched_barrier(0);
            dA = conv_desc(in, ws, grp, first + NWAVES * (j + 2 < n ? j + 2 : n - 1)); p0_load128(dA, vA, gA, lane); __builtin_amdgcn_sched_barrier(0);
            if (j + 1 < n) p0_finish128(dB, vB, gB, scr, lane);
            __builtin_amdgcn_sched_barrier(0);
        }
    }
    __syncthreads();
}
__device__ __forceinline__ void row_update(const float* xold, const float* crow, float* xdst, bf16* xbrow, float* rstd_p, int lane) {
    const GAS f32x4* xr = (const GAS f32x4*)xold + lane; const GAS f32x4* cr = (const GAS f32x4*)crow + lane;
    GAS f32x4* xd = (GAS f32x4*)xdst + lane; GAS unsigned long long* o8 = (GAS unsigned long long*)xbrow + lane;
    float ss = 0.f;
#pragma unroll
    for (int j = 0; j < 8; ++j) { f32x4 v = xr[64 * j]; if (crow) v = v + cr[64 * j]; if (xdst) xd[64 * j] = v;
        ss += (v.x * v.x + v.y * v.y) + (v.z * v.z + v.w * v.w);
        o8[64 * j] = (unsigned long long)pk2(v.x, v.y) | ((unsigned long long)pk2(v.z, v.w) << 32); }
    ss = wave_sum(ss);
    if (lane < 32) rstd_p[lane] = (lane == 0) ? ss : 0.f;
}

template <int MODE>
__device__ __forceinline__ void sample_attn(LAS char* lds, int u, int li, unsigned char* ws, const float* rel, const float* kcache, const float* vcache, int tid) {
    asm volatile("" : "+v"(tid));
    constexpr int L = (MODE == 0) ? WIN : PAST, Lk = L + SN, NKB = Lk / 16, LkP = (Lk + 31) / 32 * 32, NST = LkP / 32, PP = LkP;
    constexpr int OFF_P = att::OFF_BIAS + 4352, OFF_RI = OFF_P + 16 * 1056 * 2;
    static_assert(16 * Lk * 4 <= att::OFF_TAB && OFF_RI + 64 <= 131072 && 8 * 16 * 128 * 4 <= att::OFF_TAB, "sample attention LDS map");
    const int lane = tid & 63, wid = __builtin_amdgcn_readfirstlane(tid >> 6), fr = lane & 15, fq = lane >> 4, st = u >> 4, h = u & 15;
    LAS float* S = (LAS float*)lds; LAS unsigned short* P = (LAS unsigned short*)(lds + OFF_P); LAS float* RI = (LAS float*)(lds + OFF_RI);
    const bf16* QSp = (const bf16*)(ws + WS_QS) + (size_t)u * SN * HD; const bf16* KNp = (const bf16*)(ws + WS_KSN) + (size_t)u * SN * HD; const bf16* VNp = (const bf16*)(ws + WS_VSN) + (size_t)u * SN * HD;
    const float* kc = kcache + ((size_t)(li * SB + st) * L) * D + h * HD; const float* vc = vcache + ((size_t)(li * SB + st) * L) * D + h * HD;
    if constexpr (MODE == 1) {
        att::Blk b; b.aux = (const float*)(ws + WS_LFS) + (size_t)u * LS; b.jhi = 17; b.cap = LS - 1; b.jlo = 0; b.P0 = PAST; b.c0 = 0; b.skipthr = 0.f; b.Q = nullptr; b.K = nullptr; b.V = nullptr; b.O = nullptr;
        (void)att::build_bias<1>(b, lds, tid);
    }
    pg8::bf16x8 qf[4];
#pragma unroll
    for (int ds = 0; ds < 4; ++ds) qf[ds] = *(const pg8::bf16x8*)(QSp + (size_t)fr * HD + ds * 32 + fq * 8);
    asm volatile("s_waitcnt lgkmcnt(0)" ::: "memory"); __syncthreads();
#define SA_SCORE(accv, key0_) do { f32x4 lg_; _Pragma("unroll") for (int r = 0; r < 4; ++r) { const int key = (key0_) + 4 * fq + r; float v_; \
            if (MODE == 1) { v_ = ((accv)[r] + ((LAS const float*)(lds + att::OFF_BIAS))[key]) * SCALE; if (key > L + fr) v_ = -__builtin_inff(); } \
            else { int dd = L + fr - key; dd = dd < -128 ? -128 : (dd > 128 ? 128 : dd); v_ = (accv)[r] * SCALE + rel[(size_t)(li * NH + h) * NREL + dd + 128]; } \
            lg_[r] = v_; } *(LAS f32x4*)(S + fr * Lk + (key0_) + 4 * fq) = lg_; } while (0)
    constexpr int NCB = L / 16 / NWAVES;
#pragma unroll 1
    for (int i = 0; i < NCB; i += 2) {
        f32x4 ka[2][4], kb2[2][4];
#pragma unroll
        for (int u2 = 0; u2 < 2; ++u2) { const float* kr = kc + (size_t)((wid + (i + u2) * NWAVES) * 16 + fr) * D + fq * 8;
#pragma unroll
            for (int ds = 0; ds < 4; ++ds) { ka[u2][ds] = *(const GAS f32x4*)(kr + ds * 32); kb2[u2][ds] = *(const GAS f32x4*)(kr + ds * 32 + 4); } }
#pragma unroll
        for (int u2 = 0; u2 < 2; ++u2) { pg8::f32x4 acc = (pg8::f32x4){0.f, 0.f, 0.f, 0.f};
#pragma unroll
            for (int ds = 0; ds < 4; ++ds) { const f32x4 a = ka[u2][ds], b2 = kb2[u2][ds];
                v4u w; w.x = pk2(a.x, a.y); w.y = pk2(a.z, a.w); w.z = pk2(b2.x, b2.y); w.w = pk2(b2.z, b2.w);
                acc = __builtin_amdgcn_mfma_f32_16x16x32_bf16(__builtin_bit_cast(pg8::bf16x8, w), qf[ds], acc, 0, 0, 0); }
            SA_SCORE(acc, (wid + (i + u2) * NWAVES) * 16); }
    }
    if (wid == 0) { const bf16* kr = KNp + (size_t)fr * HD + fq * 8; pg8::f32x4 acc = (pg8::f32x4){0.f, 0.f, 0.f, 0.f};
#pragma unroll
        for (int ds = 0; ds < 4; ++ds) acc = __builtin_amdgcn_mfma_f32_16x16x32_bf16(*(const pg8::bf16x8*)(kr + ds * 32), qf[ds], acc, 0, 0, 0);
        SA_SCORE(acc, L); }
#undef SA_SCORE
    asm volatile("s_waitcnt lgkmcnt(0)" ::: "memory"); __syncthreads();
#pragma unroll 1
    for (int rr = 0; rr < 2; ++rr) { const int q = 2 * wid + rr; LAS const float* sr = S + q * Lk; float m = -1e30f;
        for (int k = lane; k < Lk; k += 64) m = fmaxf(m, sr[k]);
#pragma unroll
        for (int o = 1; o < 64; o <<= 1) m = fmaxf(m, __int_as_float(__builtin_amdgcn_ds_bpermute(((lane ^ o) & 63) << 2, __float_as_int(m))));
        float sum = 0.f;
        for (int k = lane; k < PP; k += 64) { float p = 0.f; if (k < Lk) { p = __expf(sr[k] - m); sum += p; } P[q * 1056 + k] = (unsigned short)f2bf(p); }
#pragma unroll
        for (int o = 1; o < 64; o <<= 1) sum += __int_as_float(__builtin_amdgcn_ds_bpermute(((lane ^ o) & 63) << 2, __float_as_int(sum)));
        if (lane == 0) RI[q] = 1.0f / sum; }
    asm volatile("s_waitcnt lgkmcnt(0)" ::: "memory"); __syncthreads();
    pg8::f32x4 oacc[8];
#pragma unroll
    for (int db = 0; db < 8; ++db) oacc[db] = (pg8::f32x4){0.f, 0.f, 0.f, 0.f};
    constexpr int NCS = L / 32 / NWAVES;
#pragma unroll 1
    for (int i = 0; i < NCS; i += 2) {
        f32x4 ev[2][2][8];
#pragma unroll
        for (int u2 = 0; u2 < 2; ++u2) { const float* vr = vc + (size_t)((wid + (i + u2) * NWAVES) * 32 + fq * 8) * D + 4 * fr;
#pragma unroll
            for (int hf = 0; hf < 2; ++hf)
#pragma unroll
                for (int j = 0; j < 8; ++j) ev[u2][hf][j] = *(const GAS f32x4*)(vr + (size_t)j * D + hf * 64); }
#pragma unroll
        for (int u2 = 0; u2 < 2; ++u2) { const pg8::bf16x8 pf = *(LAS const pg8::bf16x8*)(P + fr * 1056 + (wid + (i + u2) * NWAVES) * 32 + fq * 8);
#pragma unroll
            for (int hf = 0; hf < 2; ++hf)
#pragma unroll
                for (int c = 0; c < 4; ++c) { v4u w; w.x = pk2(ev[u2][hf][0][c], ev[u2][hf][1][c]); w.y = pk2(ev[u2][hf][2][c], ev[u2][hf][3][c]); w.z = pk2(ev[u2][hf][4][c], ev[u2][hf][5][c]); w.w = pk2(ev[u2][hf][6][c], ev[u2][hf][7][c]);
                    oacc[hf * 4 + c] = __builtin_amdgcn_mfma_f32_16x16x32_bf16(__builtin_bit_cast(pg8::bf16x8, w), pf, oacc[hf * 4 + c], 0, 0, 0); } }
    }
    if (wid == 0) { const int kq = L + fq * 8; const pg8::bf16x8 pf = *(LAS const pg8::bf16x8*)(P + fr * 1056 + kq);
        const bool ok = fq < 2; const bf16* vr = VNp + (size_t)(ok ? (kq - L) : 0) * HD + 4 * fr;
#pragma unroll
        for (int hf = 0; hf < 2; ++hf)
#pragma unroll
            for (int c = 0; c < 4; ++c) { unsigned e[8];
#pragma unroll
                for (int j = 0; j < 8; ++j) e[j] = ok ? (unsigned)vr[(size_t)j * HD + hf * 64 + c] : 0u;
                v4u w; w.x = e[0] | (e[1] << 16); w.y = e[2] | (e[3] << 16); w.z = e[4] | (e[5] << 16); w.w = e[6] | (e[7] << 16);
                oacc[hf * 4 + c] = __builtin_amdgcn_mfma_f32_16x16x32_bf16(__builtin_bit_cast(pg8::bf16x8, w), pf, oacc[hf * 4 + c], 0, 0, 0); } }
    LAS float* PO = (LAS float*)lds;
#pragma unroll
    for (int hf = 0; hf < 2; ++hf)
#pragma unroll
        for (int r = 0; r < 4; ++r) *(LAS f32x4*)(PO + (wid * 16 + fr) * 128 + hf * 64 + 16 * fq + 4 * r) = (f32x4){oacc[hf * 4][r], oacc[hf * 4 + 1][r], oacc[hf * 4 + 2][r], oacc[hf * 4 + 3][r]};
    asm volatile("s_waitcnt lgkmcnt(0)" ::: "memory"); __syncthreads();
    { const int q = tid >> 5, d4 = (tid & 31) * 4; f32x4 s = *(LAS const f32x4*)(PO + q * 128 + d4);
#pragma unroll
      for (int w = 1; w < 8; ++w) { const f32x4 t = *(LAS const f32x4*)(PO + (w * 16 + q) * 128 + d4); s = s + t; }
      const float ri = RI[q];
      bf16* o = (bf16*)(ws + WS_OB) + ((size_t)MP + st * SN + q) * D + h * HD + d4;
      *(GAS unsigned long long*)o = (unsigned long long)pk2(s.x * ri, s.y * ri) | ((unsigned long long)pk2(s.z * ri, s.w * ri) << 32); }
    __syncthreads();
}

constexpr int N_PROMPT = NB * NH * 32, N_UNIT = SB * NH, N_POS = N_PROMPT + N_UNIT + N_SLICE;
static_assert(N_UNIT == N_SLICE && N_PROMPT >= 2 * N_UNIT, "ticket layout");
template <int MODE> __device__ __forceinline__ void pos_decode(int pos, int& kind, int& id) {
    if (pos < 4 * N_UNIT) { const int g = pos >> 2, r = pos & 3; if (r == 2) { kind = 1; id = g; } else if (r == 3) { kind = 2; id = g; } else { kind = 0; id = 2 * g + r; } }
    else { kind = 0; id = pos - 2 * N_UNIT; }
}
template <int MODE>
__device__ __forceinline__ void get_blk(int p, int li, unsigned char* ws, const float* rel, att::Blk& b) {
    bf16* QPp = (bf16*)(ws + WS_QP); bf16* KPp = (bf16*)(ws + WS_KP); bf16* VPp = (bf16*)(ws + WS_VP); bf16* OBp = (bf16*)(ws + WS_OB);
    int bh, qb;
    bh = p & 31; qb = 31 - (p >> 5);
    const int bb = bh >> 4, h = bh & 15;
    b.Q = QPp + ((size_t)bh * T + qb * 256) * HD; b.K = KPp + (size_t)bh * T * HD; b.V = VPp + (size_t)bh * T * HD; b.O = OBp + ((size_t)bb * T + qb * 256) * D + h * HD; b.P0 = qb * 256;
    if (MODE == 0) { b.aux = rel + (size_t)(li * NH + h) * NREL; b.c0 = qb * 4; b.jlo = b.c0 > 8 ? b.c0 - 8 : 0; b.jhi = b.c0 + 4; b.cap = 1 << 29; b.skipthr = __builtin_inff(); }
    else { b.aux = (const float*)(ws + WS_LFP) + (size_t)bh * T; b.c0 = 0; b.jlo = 0; b.jhi = 4 * (qb + 1); b.cap = qb * 256 + 255; b.skipthr = ((const float*)(ws + WS_QKM))[li]; }
}
__device__ __forceinline__ int take_ticket(gu32* qc, LAS unsigned char* lds, int tid) {
    volatile LAS int* w = (volatile LAS int*)(lds + 131008);
    if (tid == 0) *w = (int)__hip_atomic_fetch_add(qc, 1u, RLX_AGENT);
    __syncthreads();
    return __builtin_amdgcn_readfirstlane(*w);
}
template <int MODE>
__device__ __forceinline__ void attn_phase(LAS unsigned char* lds, int bx, int G, int layer, unsigned char* ws, const float* const __attribute__((address_space(4)))* in, const int tid) {
    att::Blk cur; att::Nxt nxt; att::Seam S;
    const int li = layer >> 1;
    const float* rel = in[12]; const float* kcache = in[MODE == 1 ? 4 : 2]; const float* vcache = in[MODE == 1 ? 5 : 3];
    gu32* qc = (gu32*)(ws + WS_CTL) + CW_QUEUE + 64 * layer;
    int pos = take_ticket(qc, lds, tid);
    while (pos < N_POS) {
        int kind, id; pos_decode<MODE>(pos, kind, id);
        if (kind != 0) {
            if (kind == 1) sample_attn<MODE>((LAS char*)lds, id, li, ws, rel, kcache, vcache, tid);
            else conv_slice(in, ws, layer + 1, id, lds, tid);
            pos = take_ticket(qc, lds, tid); continue; }
        get_blk<MODE>(id, li, ws, rel, cur);
        att::attn_prime<MODE>(cur, (LAS char*)lds, S, tid);
        for (;;) {
            int np = N_POS, id2 = 0; bool nf = false;
            int tk = 0;
            att::attn_block<MODE>(cur, [&]() { if (tid == 0) tk = (int)__hip_atomic_fetch_add(qc, 1u, RLX_AGENT); },
                [&](att::Nxt& nxt) {
                { volatile LAS int* w = (volatile LAS int*)(lds + 131008); if (tid == 0) *w = tk; __syncthreads(); np = __builtin_amdgcn_readfirstlane(*w); }
                int k2 = 3; if (np < N_POS) pos_decode<MODE>(np, k2, id2);
                nf = (k2 == 0);
                att::Blk nb; if (nf) { get_blk<MODE>(id2, li, ws, rel, nb); nxt.Q = nb.Q; nxt.K = nb.K; nxt.V = nb.V; nxt.jlo = nb.jlo; } else { nxt.Q = cur.Q; nxt.K = cur.K; nxt.V = cur.V; nxt.jlo = cur.jlo; }
            }, (LAS char*)lds, S, tid);
            pos = np;
            if (!nf) break;
            int id3 = id2; asm volatile("" : "+s"(id3));
            get_blk<MODE>(id3, li, ws, rel, cur);
        }
    }
}

struct Args { const float* in[19]; float* out; unsigned char* ws; int ph_lo, ph_hi; };
constexpr int PH_PER_LAYER = 5, N_PHASES = 1 + DEPTH * PH_PER_LAYER;

typedef const __attribute__((address_space(4))) Args CArgs;
#define PH_BEGIN() CArgs* A; { unsigned long long k_ = (unsigned long long)__builtin_amdgcn_kernarg_segment_ptr(); asm volatile("" : "+s"(k_)); A = (CArgs*)k_; } \
    unsigned char* const ws = A->ws; float* const out = A->out; int bx = blockIdx.x; asm volatile("" : "+s"(bx)); (void)ws; (void)out; (void)bx; \
    unsigned m1_ = ~0u; int ws_ = wave_s; asm volatile("" : "+s"(m1_), "+s"(ws_)); int tid = ws_ * 64 + (int)__builtin_amdgcn_mbcnt_hi(m1_, __builtin_amdgcn_mbcnt_lo(m1_, 0u)); asm volatile("" : "+v"(tid)); const int lane = tid & 63, wave = wave_s; (void)lane; (void)wave; \
    const int gw = bx * NWAVES + wave, NGW = G * NWAVES; const long gt = (long)bx * (NWAVES * 64) + tid, NGT = (long)G * (NWAVES * 64); (void)gw; (void)NGW; (void)gt; (void)NGT
__global__ void __launch_bounds__(NWAVES * 64, 2) fwd_kernel(Args args_unused) {
    extern __shared__ __attribute__((aligned(16))) unsigned char lds_raw[];
    LAS unsigned char* lds = (LAS unsigned char*)lds_raw;
    volatile LAS unsigned* MISC = (volatile LAS unsigned*)(lds + MISC_OFF);
    const int G = gridDim.x;
    const int wave_s = __builtin_amdgcn_readfirstlane((int)threadIdx.x >> 6);
    for (int u = threadIdx.x; u < (LDS_BYTES - LDSCTL_OFF) / 4; u += NWAVES * 64) ((LAS unsigned*)(lds + LDSCTL_OFF))[u] = 0u;
    __syncthreads();
    int lo, hi; XcdBarrier bar;
    { PH_BEGIN(); lo = A->ph_lo; hi = A->ph_hi; bar = xcd_barrier_post((unsigned*)((gu32*)(ws + WS_CTL) + CW_BAR), MISC + 8, tid == 0); }
#define IN(k) (lo <= (k) && (k) < hi)
#define SEAM(k) do { if (IN(k) && IN((k) + 1)) { XcdBarrier b2_ = bar; unsigned m2_ = ~0u; int w2_ = wave_s; asm volatile("" : "+s"(b2_.bar), "+s"(m2_), "+s"(w2_)); \
    xcd_barrier(b2_, w2_ == 0 && __builtin_amdgcn_mbcnt_hi(m2_, __builtin_amdgcn_mbcnt_lo(m2_, 0u)) == 0u); } } while (0)
#define P_WQKV ((bf16*)(ws + WS_WQKV))
#define P_WO ((bf16*)(ws + WS_WO))
#define P_WGU ((bf16*)(ws + WS_WGU))
#define P_WD ((bf16*)(ws + WS_WD))
#define P_XB ((bf16*)(ws + WS_XB))
#define P_SSQ ((float*)(ws + WS_SSQ))
#define P_QP ((bf16*)(ws + WS_QP))
#define P_KP ((bf16*)(ws + WS_KP))
#define P_VP ((bf16*)(ws + WS_VP))
#define P_QS ((bf16*)(ws + WS_QS))
#define P_OB ((bf16*)(ws + WS_OB))
#define P_HB ((bf16*)(ws + WS_HB))
#define P_LFP ((float*)(ws + WS_LFP))
#define P_LFS ((float*)(ws + WS_LFS))
#define P_KSN ((bf16*)(ws + WS_KSN))
#define P_VSN ((bf16*)(ws + WS_VSN))
#define P_WF ((bf16*)(ws + WS_WF))
#define P_X (out + O_Y)

    if (IN(0)) { PH_BEGIN();
        LAS float* scr = (LAS float*)(lds + RING_OFF + wave * 16384);
        for (int it = gw; it < conv_group_items(0); it += NGW) conv_item(A->in, ws, 0, it, scr, lane);
        for (int row = gw; row < M; row += NGW) {
            const float* xr = row < MP ? A->in[0] + (size_t)row * D : A->in[1] + (size_t)(row - MP) * D;
            row_update(xr, nullptr, nullptr, P_XB + (size_t)row * D, P_SSQ + (size_t)row * 32, lane);
        }
        for (long idx = gt; idx < 2L * NH * D; idx += NGT) { const int ib = (int)(idx >> 15), h = (int)((idx >> 11) & 15), k = (int)(idx & (D - 1));
            P_WF[idx] = (bf16)f2bf(A->in[7][(size_t)(2 * ib + 1) * D + k] * A->in[13][((size_t)ib * D + k) * NH + h]); }
        if (gw == 0) {
#pragma unroll 1
            for (int ib = 0; ib < 2; ++ib) { const float* gq = A->in[9] + (2 * ib + 1) * HD; const float* gk = A->in[10] + (2 * ib + 1) * HD;
                float mqk = fmaxf(fabsf(gq[lane] * gk[lane]), fabsf(gq[lane + 64] * gk[lane + 64]));
#pragma unroll
                for (int o = 1; o < 64; o <<= 1) mqk = fmaxf(mqk, __shfl_xor(mqk, o));
                if (lane == 0) ((float*)(ws + WS_QKM))[ib] = 11.313708499f * mqk * 1.02f + 40.0f; }
        }
    }
    SEAM(0);

#pragma unroll 1
    for (int layer = 0; layer < DEPTH; ++layer) {
        const int pb = 1 + layer * PH_PER_LAYER, li = layer >> 1; const bool fox = (layer & 1) != 0;
        if (IN(pb + 0)) { PH_BEGIN();
            if (fox) {
                const bf16* wfp = P_WF + (size_t)li * NH * D; const float* bfp = A->in[14] + li * NH;
                const int fr = lane & 15, fq = lane >> 4, lr = lane >> 2, lc = lane & 3, pidx = (((lane & 15) << 2) | (lane >> 4)) << 2;
                const int nidle = (G > 192) ? (G - 192) * NWAVES : NGW, gw0 = (G > 192) ? (bx - 192) * NWAVES + wave : gw;
                if (gw0 >= 0)
                for (int grp = gw0; grp < M / 16; grp += nidle) {
                    const int row = grp * 16 + fr;
                    const char* ap = (const char*)(P_XB + (size_t)(grp * 16 + lr) * D) + lc * 16; const char* bp = (const char*)(wfp + (size_t)lr * D) + lc * 16;
                    pg8::f32x4 acc = (pg8::f32x4){0.f, 0.f, 0.f, 0.f};
#pragma unroll 8
                    for (int ks = 0; ks < D / 32; ++ks) { pg8::u32x4 av = *(const pg8::u32x4*)(ap + ks * 64), bv = *(const pg8::u32x4*)(bp + ks * 64);
                        av.x = (unsigned)__builtin_amdgcn_ds_bpermute(pidx, (int)av.x); av.y = (unsigned)__builtin_amdgcn_ds_bpermute(pidx, (int)av.y); av.z = (unsigned)__builtin_amdgcn_ds_bpermute(pidx, (int)av.z); av.w = (unsigned)__builtin_amdgcn_ds_bpermute(pidx, (int)av.w);
                        bv.x = (unsigned)__builtin_amdgcn_ds_bpermute(pidx, (int)bv.x); bv.y = (unsigned)__builtin_amdgcn_ds_bpermute(pidx, (int)bv.y); bv.z = (unsigned)__builtin_amdgcn_ds_bpermute(pidx, (int)bv.z); bv.w = (unsigned)__builtin_amdgcn_ds_bpermute(pidx, (int)bv.w);
                        acc = __builtin_amdgcn_mfma_f32_16x16x32_bf16(__builtin_bit_cast(pg8::bf16x8, bv), __builtin_bit_cast(pg8::bf16x8, av), acc, 0, 0, 0); }
                    const float rs = pg8::row_rstd(P_SSQ, row, fq);
                    const pg8::f32x4 bb = *(const pg8::f32x4*)(bfp + 4 * fq); pg8::f32x4 lf;
#pragma unroll
                    for (int i = 0; i < 4; ++i) { const float z = acc[i] * rs + bb[i]; lf[i] = fminf(z, 0.f) - log1pf(expf(-fabsf(z))); }
                    if (row < MP) { *(pg8::f32x4*)(out + O_BFP + ((size_t)li * MP + row) * NH + 4 * fq) = lf;
#pragma unroll
                        for (int i = 0; i < 4; ++i) P_LFP[(size_t)((row >> 13) * NH + 4 * fq + i) * T + (row & (T - 1))] = lf[i]; }
                    else { const int rs2 = row - MP; *(pg8::f32x4*)(out + O_BFS + ((size_t)li * MS + rs2) * NH + 4 * fq) = lf;
#pragma unroll
                        for (int i = 0; i < 4; ++i) P_LFS[(size_t)((rs2 >> 4) * NH + 4 * fq + i) * LS + PAST + (rs2 & 15)] = lf[i]; }
                }
                const float* clf = A->in[6] + (size_t)li * SB * PAST * NH;
                for (long idx = gt; idx < (long)SB * NH * PAST; idx += NGT) { const int unit = (int)(idx >> 10), j = (int)(idx & 1023), st = unit >> 4, h = unit & 15;
                    P_LFS[(size_t)unit * LS + j] = clf[((size_t)st * PAST + j) * NH + h]; }
            }
            pg8::Gemm g{P_XB, P_WQKV + (size_t)layer * NQKV * D, MP, NQKV, D}; pg8::StaticOrder S; S.init(MP, NQKV, G, bx);
            pg8::EpiQKV E;
            E.ssq = P_SSQ; E.gq = A->in[9] + layer * HD; E.gk = A->in[10] + layer * HD; E.QP = P_QP; E.pstride = (WS_KP - WS_QP) / 2; E.QS = P_QS;
            E.srows = SN; E.lc = 0; E.KS = P_KSN; E.sstride = (WS_VSN - WS_KSN) / 2;
            E.okp = out + (fox ? O_BKP + (size_t)li * MP * D : O_AKP + (size_t)li * NB * WIN * D); E.opstride = fox ? SZ_BP : SZ_AP;
            E.oks = out + (fox ? O_BKS : O_AKS) + (size_t)li * MS * D; E.osstride = SZ_S;
            E.fox = fox ? 1 : 0; E.red = (LAS float*)(lds + RED_OFF);
            pg8::gemm_phase<pg8::EpiQKV, pg8::StaticOrder, true, true>(lds + RING_OFF, g, S, E, tid);
            __syncthreads();
            {
                sk::SkQKV K2; K2.ssq = P_SSQ + (size_t)MP * 32; K2.gq = A->in[9] + layer * HD; K2.gk = A->in[10] + layer * HD; K2.QS = P_QS;
                K2.srows = SN; K2.lc = 0; K2.KS = P_KSN; K2.sstride = (WS_VSN - WS_KSN) / 2;
                K2.oks = out + (fox ? O_BKS : O_AKS) + (size_t)li * MS * D; K2.osstride = SZ_S;
                sk::skinny_phase<sk::SkQKV>(lds + RING_OFF, P_XB + (size_t)MP * D, P_WQKV + (size_t)layer * NQKV * D, NQKV / 128, D, (unsigned*)((gu32*)(ws + WS_CTL) + CW_SKQ + 64 * (layer * 4 + 0)), tid, K2);
            }
        }
        SEAM(pb + 0);
        if (IN(pb + 1)) { PH_BEGIN();
            if (fox) attn_phase<1>(lds + RING_OFF, bx, G, layer, ws, A->in, tid);
            else attn_phase<0>(lds + RING_OFF, bx, G, layer, ws, A->in, tid);
        }
        SEAM(pb + 1);
        if (IN(pb + 2)) { PH_BEGIN();
            pg8::Gemm g{P_OB, P_WO + (size_t)layer * D * D, MP, D, D}; pg8::StaticOrder S; S.init(MP, D, G, bx);
            pg8::EpiResid E;
            E.X = nullptr; E.XB = P_XB; E.ssq = P_SSQ;
            pg8::gemm_phase<pg8::EpiResid, pg8::StaticOrder, true, true>(lds + RING_OFF, g, S, E, tid);
            __syncthreads();
            {   sk::SkResid K2; K2.xin = (layer == 0) ? A->in[1] : P_X + (size_t)MP * D; K2.X = P_X + (size_t)MP * D; K2.XB = P_XB + (size_t)MP * D; K2.ssq = P_SSQ + (size_t)MP * 32;
                sk::skinny_phase<sk::SkResid>(lds + RING_OFF, P_OB + (size_t)MP * D, P_WO + (size_t)layer * D * D, D / 64, D, (unsigned*)((gu32*)(ws + WS_CTL) + CW_SKQ + 64 * (layer * 4 + 1)), tid, K2); }
        }
        SEAM(pb + 2);
        if (IN(pb + 3)) { PH_BEGIN();
            pg8::Gemm g{P_XB, P_WGU + (size_t)layer * NGU * D, MP, NGU, D}; pg8::StaticOrder S; S.init(MP, NGU, G, bx);
            pg8::EpiSwiglu E{P_HB, FF, P_SSQ};
            pg8::gemm_phase<pg8::EpiSwiglu, pg8::StaticOrder, true, true>(lds + RING_OFF, g, S, E, tid);
            __syncthreads();
            {   sk::SkSwiglu K2{P_HB + (size_t)MP * FF, FF, P_SSQ + (size_t)MP * 32};
                sk::skinny_phase<sk::SkSwiglu>(lds + RING_OFF, P_XB + (size_t)MP * D, P_WGU + (size_t)layer * NGU * D, NGU / 128, D, (unsigned*)((gu32*)(ws + WS_CTL) + CW_SKQ + 64 * (layer * 4 + 2)), tid, K2); }
        }
        SEAM(pb + 3);
        if (IN(pb + 4)) { PH_BEGIN();
            pg8::Gemm g{P_HB, P_WD + (size_t)layer * D * FF, MP, D, FF}; pg8::StaticOrder S; S.init(MP, D, G, bx);
            pg8::EpiResid E;
            E.X = (layer == DEPTH - 1) ? P_X : nullptr; E.XB = P_XB; E.ssq = P_SSQ;
            pg8::gemm_phase<pg8::EpiResid, pg8::StaticOrder, true, true>(lds + RING_OFF, g, S, E, tid);
            __syncthreads();
            {   sk::SkResid K2; K2.xin = P_X + (size_t)MP * D; K2.X = P_X + (size_t)MP * D; K2.XB = P_XB + (size_t)MP * D; K2.ssq = P_SSQ + (size_t)MP * 32;
                sk::skinny_phase<sk::SkResid>(lds + RING_OFF, P_HB + (size_t)MP * FF, P_WD + (size_t)layer * D * FF, D / 64, FF, (unsigned*)((gu32*)(ws + WS_CTL) + CW_SKQ + 64 * (layer * 4 + 3)), tid, K2); }
        }
        SEAM(pb + 4);
    }
#undef IN
#undef SEAM
}

#ifndef MK_SPLIT
#define MK_SPLIT 0
#endif
extern "C" void kernel_launch(void* const* d_in, const int* in_sizes, int n_in, void* d_out, int out_size, void* d_ws, size_t ws_size, hipStream_t stream) {
    static int grid = 0;
    if (grid == 0) {
        if (n_in != 19 || in_sizes[0] != MP * D || (size_t)out_size != OUT_TOTAL || ws_size < WS_END) { fprintf(stderr, "kernel_launch: shape mismatch (n_in %d in0 %d out %d ws %zu); nothing launched\n", n_in, n_in > 0 ? in_sizes[0] : -1, out_size, ws_size); grid = -1; return; }
        int dev = 0, cus = 0;
        if (hipGetDevice(&dev) != hipSuccess || hipDeviceGetAttribute(&cus, hipDeviceAttributeMultiprocessorCount, dev) != hipSuccess) { grid = -1; return; }
        if (hipFuncSetAttribute((const void*)fwd_kernel, hipFuncAttributeMaxDynamicSharedMemorySize, LDS_BYTES) != hipSuccess) { fprintf(stderr, "kernel_launch: hipFuncSetAttribute failed\n"); grid = -1; return; }
        int per_cu = 0;
        if (hipOccupancyMaxActiveBlocksPerMultiprocessor(&per_cu, (const void*)fwd_kernel, NWAVES * 64, LDS_BYTES) != hipSuccess || per_cu < 1) fprintf(stderr, "kernel_launch: occupancy query reports %d\n", per_cu);
        (void)hipGetLastError();
        grid = cus;
    }
    if (grid < 0) return;
    if (hipMemsetAsync((char*)d_ws + WS_CTL, 0, CTL_ZERO_BYTES, stream) != hipSuccess) return;
    Args a{};
    for (int i = 0; i < 19; ++i) a.in[i] = (const float*)d_in[i];
    a.out = (float*)d_out; a.ws = (unsigned char*)d_ws;
#if MK_SPLIT
    for (int p = 0; p < N_PHASES; ++p) { a.ph_lo = p; a.ph_hi = p + 1; hipLaunchKernelGGL(fwd_kernel, dim3(grid), dim3(NWAVES * 64), LDS_BYTES, stream, a); }
#else
    a.ph_lo = 0; a.ph_hi = N_PHASES;
    hipLaunchKernelGGL(fwd_kernel, dim3(grid), dim3(NWAVES * 64), LDS_BYTES, stream, a);
#endif
}
```

```cpp
#include <hip/hip_runtime.h>
#include <cstdio>
#include <cstdint>
namespace pg8 {
#define PG8_LAS __attribute__((address_space(3)))
typedef unsigned short bf16_t;
typedef short bf16x8 __attribute__((ext_vector_type(8)));
typedef float f32x4 __attribute__((ext_vector_type(4)));
typedef unsigned u32x4 __attribute__((ext_vector_type(4)));
constexpr int BM = 256, BK = 64, HALF = 128, HTB = HALF * BK * 2  , STAGE_BYTES = 8 * HTB, NXCD = 8, WGM = 2;

__host__ __device__ __forceinline__ int lds_byte(int r, int c) { const int st = (r >> 4) * 2 + (c >> 5), rr = r & 15, cc = c & 31, ob = rr * 64 + cc * 2; return st * 1024 + (ob ^ (((ob >> 9) & 1) << 5)); }
__host__ __device__ __forceinline__ void stage_rc(int b, int& R, int& C) { const int st = b / 1024, sb = b % 1024, swz = sb ^ (((sb >> 9) & 1) << 5); R = (st >> 1) * 16 + swz / 64; C = (st & 1) * 32 + (swz % 64) / 2; }
__host__ __device__ __forceinline__ int perm32(int rho) { const int n = rho >> 4, i = rho & 15; return 8 * (i >> 2) + 4 * n + (i & 3); }

struct Unit { int pm, pn; };
struct Gemm { const bf16_t* A; const bf16_t* Bt; int M, N, K; };

struct StaticOrder {
    int nM, nN, nwg, G, c;
    __host__ __device__ void init(int M, int N, int G_, int c_) { nM = M / BM; nN = N / BM; nwg = nM * nN; G = G_; c = c_; }
    __host__ __device__ bool next(int i, Unit& u) const {
        const long L = (long)i * G + c; if (L >= nwg) return false;
        int wgid = (int)L; { const int q = nwg / NXCD, r = nwg % NXCD, xcd = wgid % NXCD, off = wgid / NXCD; wgid = (xcd < r ? xcd * (q + 1) : r * (q + 1) + (xcd - r) * q) + off; }
        const int nig = WGM * nN, gid = wgid / nig, fm = gid * WGM, gsz = (nM - fm) < WGM ? (nM - fm) : WGM;
        u.pm = fm + ((wgid % nig) % gsz); u.pn = (wgid % nig) / gsz; return true;
    }
    __device__ __forceinline__ void a_ready(const Unit&) const {}
    __device__ __forceinline__ void done(const Unit&) const {}
};

__device__ __forceinline__ unsigned cvt_pk_bf16(float lo, float hi) { unsigned r; asm volatile("v_cvt_pk_bf16_f32 %0, %1, %2" : "=v"(r) : "v"(lo), "v"(hi)); return r; }
struct EpiF32 {
    static constexpr bool PERM = false, AFTER_DRAIN = false;
    float* C; int ldc;
    __device__ __forceinline__ void operator()(const f32x4 (&acc)[2][2][4][2], const Unit& u, int wr, int wc, int fr, int fq) const {
        const int row0 = u.pm * BM + wr * 64 + fr, col0 = u.pn * BM + wc * 32 + 4 * fq;
#pragma unroll
        for (int ai = 0; ai < 2; ++ai)
#pragma unroll
            for (int m = 0; m < 4; ++m) { float* rowp = C + (size_t)(row0 + ai * HALF + m * 16) * ldc + col0;
#pragma unroll
                for (int bj = 0; bj < 2; ++bj)
#pragma unroll
                    for (int n = 0; n < 2; ++n) *(f32x4*)(rowp + bj * HALF + n * 16) = acc[ai][bj][m][n]; }
    }
};
template <class Epi, class Sched, bool ALIGN_EPI = false, bool SP2 = false>
__device__ __forceinline__ void gemm_phase(PG8_LAS unsigned char* lds, const Gemm g, const Sched& S, const Epi& E, const int tid_in) {
    int tid_ = tid_in; asm volatile("" : "+v"(tid_));
    const int tid = tid_, wid = __builtin_amdgcn_readfirstlane(tid >> 6), lane = tid & 63, wr = wid >> 2, wc = wid & 3, fr = lane & 15, fq = lane >> 4;
    const int K = g.K, nt = K / BK;
    unsigned voffA[2], voffB[2];
#pragma unroll
    for (int i = 0; i < 2; ++i) { int R, C; stage_rc(tid * 16 + i * 8192, R, C); const int Rb = Epi::PERM ? ((R & ~31) + perm32(R & 31)) : R;
        voffA[i] = (unsigned)(R * K + C) * 2u; voffB[i] = (unsigned)(Rb * K + C) * 2u; }
    const size_t kstep = (size_t)(BK * 2);
    const size_t hstep = (size_t)HALF * K * 2;
    const size_t tstep = 2 * hstep;
    const unsigned ldsw = (unsigned)wid * 1024u;
    const int aoff = lds_byte(wr * 64 + fr, fq * 8), boff = lds_byte(wc * 32 + fr, fq * 8);
#define PG8_SA(b, h) (((b) * 2 + (h)) * HTB)
#define PG8_SB(b, h) ((4 + (b) * 2 + (h)) * HTB)
#define PG8_STAGE(bufoff, gbase, voff) do { _Pragma("unroll") for (int _i = 0; _i < 2; ++_i) \
        __builtin_amdgcn_global_load_lds((const unsigned*)((const char*)(gbase) + (voff)[_i]), (PG8_LAS unsigned*)(lds + (bufoff) + ldsw + _i * 8192), 16, 0, 0); } while (0)
#define PG8_LDA(dst, b, h) do { _Pragma("unroll") for (int m = 0; m < 4; ++m) _Pragma("unroll") for (int k = 0; k < 2; ++k) dst[m][k] = *(const PG8_LAS bf16x8*)(lds + PG8_SA(b, h) + aoff + m * 2048 + k * 1024); } while (0)
#define PG8_LDB(dst, b, h) do { _Pragma("unroll") for (int n = 0; n < 2; ++n) _Pragma("unroll") for (int k = 0; k < 2; ++k) dst[n][k] = *(const PG8_LAS bf16x8*)(lds + PG8_SB(b, h) + boff + n * 2048 + k * 1024); } while (0)
#define PG8_MMA(ai, bj, At, Bt) do { __builtin_amdgcn_s_setprio(1); _Pragma("unroll") for (int m = 0; m < 4; ++m) _Pragma("unroll") for (int n = 0; n < 2; ++n) _Pragma("unroll") for (int k = 0; k < 2; ++k) \
        acc[ai][bj][m][n] = __builtin_amdgcn_mfma_f32_16x16x32_bf16(Bt[n][k], At[m][k], acc[ai][bj][m][n], 0, 0, 0); __builtin_amdgcn_s_setprio(0); } while (0)
#define PG8_WAIT_V(n) asm volatile("s_waitcnt vmcnt(" #n ")" ::: "memory")
#define PG8_WAIT_L(n) asm volatile("s_waitcnt lgkmcnt(" #n ")" ::: "memory")
#define PG8_BAR __builtin_amdgcn_s_barrier()
#define PG8_SCHED __builtin_amdgcn_sched_barrier(0)
    Unit cur, nxt; int ui = 0;
    if (!S.next(0, cur)) return;
    f32x4 acc[2][2][4][2];
#pragma unroll
    for (int a = 0; a < 2; ++a)
#pragma unroll
        for (int b = 0; b < 2; ++b)
#pragma unroll
            for (int m = 0; m < 4; ++m)
#pragma unroll
                for (int n = 0; n < 2; ++n) acc[a][b][m][n] = (f32x4){0.f, 0.f, 0.f, 0.f};
    bf16x8 At[4][2], B0[2][2], B1[2][2];
    const char* cA = (const char*)g.A + (size_t)cur.pm * tstep; const char* cB = (const char*)g.Bt + (size_t)cur.pn * tstep;
    S.a_ready(cur);
    if constexpr (SP2) {
        PG8_STAGE(PG8_SB(0, 0), cB, voffB); PG8_STAGE(PG8_SB(0, 1), cB + hstep, voffB); PG8_STAGE(PG8_SA(0, 0), cA, voffA); PG8_STAGE(PG8_SA(0, 1), cA + hstep, voffA);
        if (wr == 1) PG8_BAR;
        PG8_WAIT_V(2); PG8_BAR;
        PG8_STAGE(PG8_SB(1, 0), cB + kstep, voffB); PG8_STAGE(PG8_SA(1, 0), cA + kstep, voffA); PG8_STAGE(PG8_SB(1, 1), cB + hstep + kstep, voffB);
        PG8_WAIT_V(6); PG8_BAR;
    } else {
        PG8_STAGE(PG8_SB(0, 0), cB, voffB); PG8_STAGE(PG8_SA(0, 0), cA, voffA); PG8_STAGE(PG8_SB(0, 1), cB + hstep, voffB); PG8_STAGE(PG8_SA(0, 1), cA + hstep, voffA);
        if (wr == 1) PG8_BAR;
        PG8_WAIT_V(4); PG8_BAR;
        PG8_STAGE(PG8_SB(1, 0), cB + kstep, voffB); PG8_STAGE(PG8_SA(1, 0), cA + kstep, voffA); PG8_STAGE(PG8_SB(1, 1), cB + hstep + kstep, voffB);
        PG8_WAIT_V(6); PG8_BAR;
    }
    for (;;) {
        const bool has_next = S.next(ui + 1, nxt);
        const char* nA = has_next ? (const char*)g.A + (size_t)nxt.pm * tstep : cA; const char* nB = has_next ? (const char*)g.Bt + (size_t)nxt.pn * tstep : cB;
        for (int t = 0; t < nt; t += 2) {
            const bool last = (t == nt - 2);
            const char* a1 = cA + (size_t)(t + 1) * kstep;
            const char* a2 = last ? nA : cA + (size_t)(t + 2) * kstep; const char* b2 = last ? nB : cB + (size_t)(t + 2) * kstep;
            const char* a3 = a2 + kstep; const char* b3 = b2 + kstep;
            if (last && has_next) S.a_ready(nxt);
            if constexpr (SP2) {
            PG8_LDB(B0, 0, 0); PG8_LDB(B1, 0, 1); PG8_SCHED; PG8_LDA(At, 0, 0); PG8_STAGE(PG8_SA(1, 1), a1 + hstep, voffA);
            PG8_WAIT_V(8); PG8_WAIT_L(0); PG8_BAR; PG8_MMA(0, 0, At, B0); PG8_MMA(0, 1, At, B1); PG8_BAR; PG8_SCHED;
            PG8_LDA(At, 0, 1); PG8_STAGE(PG8_SB(0, 0), b2, voffB); PG8_STAGE(PG8_SB(0, 1), b2 + hstep, voffB); PG8_STAGE(PG8_SA(0, 0), a2, voffA);
            PG8_WAIT_V(8); PG8_WAIT_L(0); PG8_BAR; PG8_MMA(1, 0, At, B0); PG8_MMA(1, 1, At, B1); PG8_BAR; PG8_SCHED;
            PG8_LDB(B0, 1, 0); PG8_LDB(B1, 1, 1); PG8_SCHED; PG8_LDA(At, 1, 0); PG8_STAGE(PG8_SA(0, 1), a2 + hstep, voffA);
            PG8_WAIT_V(8); PG8_WAIT_L(0); PG8_BAR; PG8_MMA(0, 0, At, B0); PG8_MMA(0, 1, At, B1); PG8_BAR; PG8_SCHED;
            PG8_LDA(At, 1, 1); PG8_STAGE(PG8_SB(1, 0), b3, voffB); PG8_STAGE(PG8_SB(1, 1), b3 + hstep, voffB); PG8_STAGE(PG8_SA(1, 0), a3, voffA);
            PG8_WAIT_V(8); PG8_WAIT_L(0); PG8_BAR; PG8_MMA(1, 0, At, B0); PG8_MMA(1, 1, At, B1); PG8_BAR; PG8_SCHED;
            } else {
            PG8_LDB(B0, 0, 0); PG8_SCHED; PG8_LDA(At, 0, 0); PG8_STAGE(PG8_SA(1, 1), a1 + hstep, voffA);
            PG8_WAIT_L(8); PG8_BAR; PG8_WAIT_L(0); PG8_MMA(0, 0, At, B0); PG8_BAR; PG8_SCHED;
            PG8_LDB(B1, 0, 1); PG8_STAGE(PG8_SB(0, 0), b2, voffB);
            PG8_BAR; PG8_WAIT_L(0); PG8_MMA(0, 1, At, B1); PG8_BAR;
            PG8_LDA(At, 0, 1); PG8_STAGE(PG8_SA(0, 0), a2, voffA);
            PG8_BAR; PG8_WAIT_L(0); PG8_MMA(1, 0, At, B0); PG8_BAR; PG8_SCHED;
            PG8_STAGE(PG8_SB(0, 1), b2 + hstep, voffB);
            PG8_WAIT_V(6); PG8_BAR; PG8_MMA(1, 1, At, B1); PG8_BAR;
            PG8_LDB(B0, 1, 0); PG8_SCHED; PG8_LDA(At, 1, 0); PG8_STAGE(PG8_SA(0, 1), a2 + hstep, voffA);
            PG8_WAIT_L(8); PG8_BAR; PG8_WAIT_L(0); PG8_MMA(0, 0, At, B0); PG8_BAR; PG8_SCHED;
            PG8_LDB(B1, 1, 1); PG8_STAGE(PG8_SB(1, 0), b3, voffB);
            PG8_BAR; PG8_WAIT_L(0); PG8_MMA(0, 1, At, B1); PG8_BAR;
            PG8_LDA(At, 1, 1); PG8_STAGE(PG8_SA(1, 0), a3, voffA);
            PG8_BAR; PG8_WAIT_L(0); PG8_MMA(1, 0, At, B0); PG8_BAR; PG8_SCHED;
            PG8_STAGE(PG8_SB(1, 1), b3 + hstep, voffB);
            PG8_WAIT_V(6); PG8_BAR; PG8_MMA(1, 1, At, B1); PG8_BAR;
            }
        }
        if constexpr (ALIGN_EPI) { if (wr == 0) PG8_BAR; }
        if constexpr (!Epi::AFTER_DRAIN) { E(acc, cur, wr, wc, fr, fq); S.done(cur); }
        if (!has_next) break;
#pragma unroll
        for (int a = 0; a < 2; ++a)
#pragma unroll
            for (int b = 0; b < 2; ++b)
#pragma unroll
                for (int m = 0; m < 4; ++m)
#pragma unroll
                    for (int n = 0; n < 2; ++n) acc[a][b][m][n] = (f32x4){0.f, 0.f, 0.f, 0.f};
        cur = nxt; cA = nA; cB = nB; ++ui;
        if constexpr (ALIGN_EPI) { if (wr == 1) PG8_BAR; }
    }
    PG8_WAIT_V(0);
    if constexpr (!ALIGN_EPI) { if (wr == 0) PG8_BAR; }
    PG8_BAR;
    if constexpr (Epi::AFTER_DRAIN) { E.fused(acc, cur, wr, wc, fr, fq, lds, wid, lane); S.done(cur); }
#undef PG8_SA
#undef PG8_SB
#undef PG8_STAGE
#undef PG8_LDA
#undef PG8_LDB
#undef PG8_MMA
#undef PG8_WAIT_V
#undef PG8_WAIT_L
#undef PG8_BAR
#undef PG8_SCHED
}
}

namespace pg8 {
typedef unsigned u32x2 __attribute__((ext_vector_type(2)));
typedef float f32x2 __attribute__((ext_vector_type(2)));
__device__ __forceinline__ void rows_rstd(float (&rs)[2][4], const float* ssq, int pm, int wr, int fr, int fq) {
    f32x4 pa[2][4], pb[2][4];
    const float* base = ssq + (size_t)(pm * BM + wr * 64 + fr) * 32 + fq * 8;
#pragma unroll
    for (int ai = 0; ai < 2; ++ai)
#pragma unroll
        for (int m = 0; m < 4; ++m) { pa[ai][m] = *(const f32x4*)(base + (ai * HALF + m * 16) * 32); pb[ai][m] = *(const f32x4*)(base + (ai * HALF + m * 16) * 32 + 4); }
#pragma unroll
    for (int ai = 0; ai < 2; ++ai)
#pragma unroll
        for (int m = 0; m < 4; ++m) { const f32x4 a = pa[ai][m], b = pb[ai][m];
            float s = ((a[0] + a[1]) + (a[2] + a[3])) + ((b[0] + b[1]) + (b[2] + b[3]));
            s += __shfl_xor(s, 16); s += __shfl_xor(s, 32);
            rs[ai][m] = __builtin_amdgcn_rsqf(s * (1.0f / 2048.0f) + 1e-6f); }
}
__device__ __forceinline__ f32x4 to_rowmajor(f32x4 v, int pidx) {
    f32x4 o; o[0] = __int_as_float(__builtin_amdgcn_ds_bpermute(pidx, __float_as_int(v[0]))); o[1] = __int_as_float(__builtin_amdgcn_ds_bpermute(pidx, __float_as_int(v[1])));
    o[2] = __int_as_float(__builtin_amdgcn_ds_bpermute(pidx, __float_as_int(v[2]))); o[3] = __int_as_float(__builtin_amdgcn_ds_bpermute(pidx, __float_as_int(v[3]))); return o;
}
__device__ __forceinline__ int rowmajor_pidx(int lane) { return (((lane & 3) << 4) | (lane >> 2)) << 2; }
__device__ __forceinline__ void rows_rstd_rm(float (&rs)[2][4], const float* ssq, int pm, int wr, int r2, int c2) {
    f32x4 pa[2][4], pb[2][4];
    const float* base = ssq + (size_t)(pm * BM + wr * 64 + r2) * 32 + c2 * 8;
#pragma unroll
    for (int ai = 0; ai < 2; ++ai)
#pragma unroll
        for (int m = 0; m < 4; ++m) { pa[ai][m] = *(const f32x4*)(base + (ai * HALF + m * 16) * 32); pb[ai][m] = *(const f32x4*)(base + (ai * HALF + m * 16) * 32 + 4); }
#pragma unroll
    for (int ai = 0; ai < 2; ++ai)
#pragma unroll
        for (int m = 0; m < 4; ++m) { const f32x4 a = pa[ai][m], b = pb[ai][m];
            float s = ((a[0] + a[1]) + (a[2] + a[3])) + ((b[0] + b[1]) + (b[2] + b[3]));
            s += __shfl_xor(s, 1); s += __shfl_xor(s, 2);
            rs[ai][m] = __builtin_amdgcn_rsqf(s * (1.0f / 2048.0f) + 1e-6f); }
}
__device__ __forceinline__ float row_rstd(const float* ssq, int row, int fq) {
    const f32x4 a = *(const f32x4*)(ssq + (size_t)row * 32 + fq * 8), b = *(const f32x4*)(ssq + (size_t)row * 32 + fq * 8 + 4);
    float s = ((a[0] + a[1]) + (a[2] + a[3])) + ((b[0] + b[1]) + (b[2] + b[3]));
    s += __shfl_xor(s, 16); s += __shfl_xor(s, 32);
    return __builtin_amdgcn_rsqf(s * (1.0f / 2048.0f) + 1e-6f);
}
struct EpiResid {
    static constexpr bool PERM = false, AFTER_DRAIN = false;
    float* X; bf16_t* XB; float* ssq;
    __device__ __forceinline__ void operator()(const f32x4 (&acc)[2][2][4][2], const Unit& u, int wr, int wc, int fr_, int fq_) const {
        const int lane = fq_ * 16 + fr_, r2 = lane >> 2, c2 = lane & 3, pidx = rowmajor_pidx(lane);
        const int row0 = u.pm * BM + wr * 64 + r2, col0 = u.pn * BM + wc * 32 + 4 * c2;
        u32x2 v[4][2][2];
#define EPR_LOAD(g) do { const size_t off_ = (size_t)(row0 + ((g) >> 2) * HALF + ((g) & 3) * 16) * 2048 + col0; _Pragma("unroll") for (int bj = 0; bj < 2; ++bj) _Pragma("unroll") for (int n = 0; n < 2; ++n) \
            v[(g) & 3][bj][n] = *(const u32x2*)(XB + off_ + bj * HALF + n * 16); } while (0)
        EPR_LOAD(0); EPR_LOAD(1); EPR_LOAD(2);
#pragma unroll
        for (int g = 0; g < 8; ++g) { const int ai = g >> 2, m = g & 3; const int row = row0 + ai * HALF + m * 16; const size_t off = (size_t)row * 2048 + col0; float s = 0.f;
            if (g + 3 < 8) EPR_LOAD(g + 3);
#pragma unroll
            for (int bj = 0; bj < 2; ++bj)
#pragma unroll
                for (int n = 0; n < 2; ++n) { const u32x2 xo = v[g & 3][bj][n];
                    const f32x4 x = (f32x4){__uint_as_float(xo.x << 16), __uint_as_float(xo.x & 0xffff0000u), __uint_as_float(xo.y << 16), __uint_as_float(xo.y & 0xffff0000u)} + to_rowmajor(acc[ai][bj][m][n], pidx);
                    if (X != nullptr) *(f32x4*)(X + off + bj * HALF + n * 16) = x;
                    u32x2 w; w.x = cvt_pk_bf16(x[0], x[1]); w.y = cvt_pk_bf16(x[2], x[3]); *(u32x2*)(XB + off + bj * HALF + n * 16) = w;
                    s += (x[0] * x[0] + x[1] * x[1]) + (x[2] * x[2] + x[3] * x[3]); }
            s += __shfl_xor(s, 1); s += __shfl_xor(s, 2);
            if (c2 == 0) ssq[(size_t)row * 32 + u.pn * 4 + wc] = s;
            asm volatile("" ::: "memory"); }
#undef EPR_LOAD
    }
};
struct EpiSwiglu {
    static constexpr bool PERM = true, AFTER_DRAIN = false;
    bf16_t* H; int ldh; const float* ssq;
    __device__ __forceinline__ void operator()(const f32x4 (&acc)[2][2][4][2], const Unit& u, int wr, int wc, int fr_, int fq_) const {
        const int lane = fq_ * 16 + fr_, r2 = lane >> 2, c2 = lane & 3, pidx = rowmajor_pidx(lane);
        const int row0 = u.pm * BM + wr * 64 + r2, col0 = u.pn * HALF + wc * 32 + 8 * c2;
        float rs[2][4]; rows_rstd_rm(rs, ssq, u.pm, wr, r2, c2);
#pragma unroll
        for (int ai = 0; ai < 2; ++ai)
#pragma unroll
            for (int m = 0; m < 4; ++m) { const float r = rs[ai][m], c1 = -1.4426950408889634f * r, ms = __builtin_amdgcn_rcpf(r * r); float hv[8];
#pragma unroll
                for (int n = 0; n < 2; ++n) { const f32x4 gv = to_rowmajor(acc[ai][0][m][n], pidx), uv = to_rowmajor(acc[ai][1][m][n], pidx);
#pragma unroll
                    for (int i = 0; i < 4; i += 2) {
                        const f32x2 g2 = (f32x2){gv[i], gv[i + 1]}, u2 = (f32x2){uv[i], uv[i + 1]}; const f32x2 t2 = g2 * c1;
                        f32x2 e2; e2.x = __builtin_amdgcn_exp2f(t2.x); e2.y = __builtin_amdgcn_exp2f(t2.y);
                        const f32x2 d2 = e2 * ms + ms; f32x2 s2; s2.x = __builtin_amdgcn_rcpf(d2.x); s2.y = __builtin_amdgcn_rcpf(d2.y);
                        const f32x2 h2 = (g2 * u2) * s2; hv[4 * n + i] = h2.x; hv[4 * n + i + 1] = h2.y; } }
                u32x4 w; w.x = cvt_pk_bf16(hv[0], hv[1]); w.y = cvt_pk_bf16(hv[2], hv[3]); w.z = cvt_pk_bf16(hv[4], hv[5]); w.w = cvt_pk_bf16(hv[6], hv[7]);
                *(u32x4*)(H + (size_t)(row0 + ai * HALF + m * 16) * ldh + col0) = w; }
    }
};
struct EpiQKV {
    static constexpr bool PERM = true, AFTER_DRAIN = false;
    const float* ssq; const float* gq; const float* gk;
    bf16_t* QP; size_t pstride;
    bf16_t* QS; bf16_t* KS; size_t sstride; int srows, lc;
    float* okp; size_t opstride; float* oks; size_t osstride;
    int fox;
    PG8_LAS float* red;
    __device__ __forceinline__ void operator()(const f32x4 (&acc)[2][2][4][2], const Unit& u, int wr, int wc, int fr_, int fq_) const {
        int fr = fr_, fq = fq_; asm volatile("" : "+v"(fr), "+v"(fq));
        const int which = u.pn >> 3, head0 = (u.pn & 7) * 2;
        const int lane_ = fq_ * 16 + fr_, r2 = lane_ >> 2, c2 = lane_ & 3, pidx = rowmajor_pidx(lane_);
        float rsv[2][4]; rows_rstd_rm(rsv, ssq, u.pm, wr, r2, c2);
        if (which < 2) {
#pragma unroll
            for (int ai = 0; ai < 2; ++ai)
#pragma unroll
                for (int m = 0; m < 4; ++m)
#pragma unroll
                    for (int bj = 0; bj < 2; ++bj) { float s = 0.f;
#pragma unroll
                        for (int n = 0; n < 2; ++n) { const f32x4 x = acc[ai][bj][m][n]; s += (x[0] * x[0] + x[1] * x[1]) + (x[2] * x[2] + x[3] * x[3]); }
                        s += __shfl_xor(s, 16); s += __shfl_xor(s, 32);
                        if (fq == 0) red[(wc * 256 + ai * HALF + wr * 64 + m * 16 + fr) * 2 + bj] = s; }
            asm volatile("s_waitcnt lgkmcnt(0)" ::: "memory"); __builtin_amdgcn_s_barrier(); asm volatile("" ::: "memory");
        }
        const int cih = wc * 32 + 8 * c2;
        f32x4 g0 = (f32x4){1.f, 1.f, 1.f, 1.f}, g1 = g0;
        if (which < 2) { const float* g = (which == 0 ? gq : gk) + cih; g0 = *(const f32x4*)g; g1 = *(const f32x4*)(g + 4); }
        const bool samp = u.pm >= 64;
        const bool f32out = which > 0 && (samp || fox || (u.pm & 31) >= 30);
        char* b16; char* b32 = nullptr; unsigned hs16, rowsz = 0;
        if (!samp) { const int bb = u.pm >> 5;
            b16 = (char*)(QP + (size_t)which * pstride + (size_t)(bb * 16 + head0) * (8192 * 128)); hs16 = 8192 * 128 * 2;
            if (f32out) b32 = (char*)(okp + (size_t)(which - 1) * opstride + (fox ? (size_t)bb * 8192 * 2048 : (size_t)bb * 512 * 2048) + head0 * 128);
        } else { rowsz = (which == 0) ? 16u : (unsigned)srows;
            b16 = (which == 0) ? (char*)QS : (char*)(KS + (size_t)(which == 2 ? 1 : 0) * sstride + (size_t)lc * 128); hs16 = rowsz * 256u;
            if (f32out) b32 = (char*)(oks + (size_t)(which - 1) * osstride + head0 * 128); }
        const int trow0 = samp ? 0 : ((u.pm & 31) * 256 - ((fox || !f32out) ? 0 : 7680));
#pragma unroll
        for (int ai = 0; ai < 2; ++ai)
#pragma unroll
            for (int m = 0; m < 4; ++m) { const int rit = ai * HALF + wr * 64 + m * 16 + r2;
                const float rs = rsv[ai][m];
                unsigned o16;
                if (!samp) o16 = (unsigned)((((u.pm & 31) * 256 + rit) * 128 + cih) * 2);
                else o16 = (unsigned)(((((rit >> 4) * 16 + head0) * rowsz + (rit & 15)) * 128 + cih) * 2);
                const unsigned o32 = (unsigned)(((trow0 + rit) * 2048 + cih) * 4);
#pragma unroll
                for (int bj = 0; bj < 2; ++bj) { float sc = rs;
                    if (which < 2) { const int ri = rit * 2 + bj; const float t = (red[ri] + red[512 + ri]) + (red[1024 + ri] + red[1536 + ri]);
                        sc = rs * __builtin_amdgcn_rsqf(t * rs * rs * (1.0f / 128.0f) + 1e-6f); }
                    const f32x4 x0 = to_rowmajor(acc[ai][bj][m][0], pidx) * sc * g0, x1 = to_rowmajor(acc[ai][bj][m][1], pidx) * sc * g1;
                    u32x4 w; w.x = cvt_pk_bf16(x0[0], x0[1]); w.y = cvt_pk_bf16(x0[2], x0[3]); w.z = cvt_pk_bf16(x1[0], x1[1]); w.w = cvt_pk_bf16(x1[2], x1[3]);
                    *(u32x4*)(b16 + (size_t)(o16 + (unsigned)bj * hs16)) = w;
                    if (f32out) { float* fo = (float*)(b32 + (size_t)(o32 + (unsigned)bj * 512u)); *(f32x4*)fo = x0; *(f32x4*)(fo + 4) = x1; } }
                asm volatile("" ::: "memory"); }
    }
};
}

namespace sk {
typedef short bf16x8 __attribute__((ext_vector_type(8)));
typedef float f32x4 __attribute__((ext_vector_type(4)));
typedef unsigned u32x2 __attribute__((ext_vector_type(2)));
typedef unsigned u32x4 __attribute__((ext_vector_type(4)));
typedef unsigned short bf16_t;
#define SLAS __attribute__((address_space(3)))
__device__ __forceinline__ unsigned cvtpk(float lo, float hi) { unsigned r; asm volatile("v_cvt_pk_bf16_f32 %0, %1, %2" : "=v"(r) : "v"(lo), "v"(hi)); return r; }
__device__ __forceinline__ float row_rstd(const float* ssq, int row, int fq) {
    const f32x4 a = *(const f32x4*)(ssq + (size_t)row * 32 + fq * 8), b = *(const f32x4*)(ssq + (size_t)row * 32 + fq * 8 + 4);
    float s = ((a[0] + a[1]) + (a[2] + a[3])) + ((b[0] + b[1]) + (b[2] + b[3]));
    s += __shfl_xor(s, 16); s += __shfl_xor(s, 32);
    return __builtin_amdgcn_rsqf(s * (1.0f / 2048.0f) + 1e-6f);
}
struct SkResid {
    static constexpr int MB = 2, NB = 2, NS = 6; static constexpr bool NEEDS_X = true;
    const float* xin; float* X; bf16_t* XB; float* ssq;
    __device__ __forceinline__ int brow(int ct, int ch, int n) const { return ct * 64 + ch * 32 + 16 * n; }
    __device__ __forceinline__ void partial(f32x4 (&acc)[MB][NB], int rt, int ct, int ch, int fr, int fq, SLAS float* red) const {
        f32x4 xo[MB][NB];
#pragma unroll
        for (int m = 0; m < MB; ++m)
#pragma unroll
            for (int n = 0; n < NB; ++n) xo[m][n] = *(const f32x4*)(xin + (size_t)(rt * 32 + 16 * m + fr) * 2048 + ct * 64 + ch * 32 + 16 * n + 4 * fq);
#pragma unroll
        for (int m = 0; m < MB; ++m) { float s = 0.f;
#pragma unroll
            for (int n = 0; n < NB; ++n) { const f32x4 x = xo[m][n] + acc[m][n]; acc[m][n] = x; s += (x[0] * x[0] + x[1] * x[1]) + (x[2] * x[2] + x[3] * x[3]); }
            s += __shfl_xor(s, 16); s += __shfl_xor(s, 32);
            if (fq == 0) red[ch * 32 + 16 * m + fr] = s; }
    }
    __device__ __forceinline__ void operator()(const f32x4 (&acc)[MB][NB], int rt, int ct, int ch, int fr, int fq, SLAS float* red) const {
#pragma unroll
        for (int m = 0; m < MB; ++m) { const int r = rt * 32 + 16 * m + fr; const size_t off = (size_t)r * 2048 + ct * 64 + ch * 32 + 4 * fq;
#pragma unroll
            for (int n = 0; n < NB; ++n) { const f32x4 x = acc[m][n];
                *(f32x4*)(X + off + 16 * n) = x; u32x2 w; w.x = cvtpk(x[0], x[1]); w.y = cvtpk(x[2], x[3]); *(u32x2*)(XB + off + 16 * n) = w; }
            if (ch == 0 && fq == 0) ssq[(size_t)r * 32 + ct] = red[16 * m + fr] + red[32 + 16 * m + fr]; }
    }
};
struct SkSwiglu {
    static constexpr int MB = 4, NB = 4, NS = 3; static constexpr bool NEEDS_X = false;
    bf16_t* H; int ldh; const float* ssq;
    __device__ __forceinline__ int brow(int ct, int ch, int n) const { return 256 * (ct >> 1) + (ct & 1) * 64 + ch * 32 + (n >= 2 ? 128 + 16 * (n - 2) : 16 * n); }
    __device__ __forceinline__ void partial(f32x4 (&acc)[MB][NB], int, int, int, int, int, SLAS float*) const {}
    __device__ __forceinline__ void operator()(const f32x4 (&acc)[MB][NB], int rt, int ct, int ch, int fr, int fq, SLAS float* red) const {
        float rs[MB];
        { f32x4 pa[MB], pb[MB];
#pragma unroll
          for (int m = 0; m < MB; ++m) { const float* sp = ssq + (size_t)(rt * 64 + 16 * m + fr) * 32 + fq * 8; pa[m] = *(const f32x4*)sp; pb[m] = *(const f32x4*)(sp + 4); }
#pragma unroll
          for (int m = 0; m < MB; ++m) { float s = ((pa[m][0] + pa[m][1]) + (pa[m][2] + pa[m][3])) + ((pb[m][0] + pb[m][1]) + (pb[m][2] + pb[m][3]));
              s += __shfl_xor(s, 16); s += __shfl_xor(s, 32); rs[m] = __builtin_amdgcn_rsqf(s * (1.0f / 2048.0f) + 1e-6f); } }
#pragma unroll
        for (int m = 0; m < MB; ++m) { const int r = rt * 64 + 16 * m + fr;
#pragma unroll
            for (int n = 0; n < 2; ++n) { float hv[4];
#pragma unroll
                for (int i = 0; i < 4; ++i) { const float g = acc[m][n][i] * rs[m], up = acc[m][n + 2][i] * rs[m]; hv[i] = g * __builtin_amdgcn_rcpf(1.0f + __expf(-g)) * up; }
                u32x2 w; w.x = cvtpk(hv[0], hv[1]); w.y = cvtpk(hv[2], hv[3]);
                *(u32x2*)(H + (size_t)r * ldh + 128 * (ct >> 1) + (ct & 1) * 64 + ch * 32 + 16 * n + 4 * fq) = w; } }
    }
};
struct SkQKV {
    static constexpr int MB = 4, NB = 4, NS = 3; static constexpr bool NEEDS_X = true;
    const float* ssq; const float* gq; const float* gk;
    bf16_t* QS; bf16_t* KS; size_t sstride; int srows, lc;
    float* oks; size_t osstride;
    __device__ __forceinline__ int brow(int ct, int ch, int n) const { return ct * 128 + ch * 64 + 16 * n; }
    __device__ __forceinline__ void partial(f32x4 (&acc)[MB][NB], int, int, int ch, int fr, int fq, SLAS float* red) const {
#pragma unroll
        for (int m = 0; m < MB; ++m) { float s = 0.f;
#pragma unroll
            for (int n = 0; n < NB; ++n) { const f32x4 x = acc[m][n]; s += (x[0] * x[0] + x[1] * x[1]) + (x[2] * x[2] + x[3] * x[3]); }
            s += __shfl_xor(s, 16); s += __shfl_xor(s, 32);
            if (fq == 0) red[ch * 64 + 16 * m + fr] = s; }
    }
    __device__ __forceinline__ void operator()(const f32x4 (&acc)[MB][NB], int rt, int ct, int ch, int fr, int fq, SLAS float* red) const {
        const int which = ct >> 4, h = ct & 15;
        const float* g = (which == 0 ? gq : gk) + ch * 64 + 4 * fq;
        bf16_t* b16 = (which == 0) ? QS : KS + (size_t)(which == 2 ? 1 : 0) * sstride + (size_t)lc * 128; const int rowsz = (which == 0) ? 16 : srows;
        float* b32 = oks + (size_t)(which > 0 ? which - 1 : 0) * osstride + h * 128 + ch * 64 + 4 * fq;
        float rs[MB];
        { f32x4 pa[MB], pb[MB];
#pragma unroll
          for (int m = 0; m < MB; ++m) { const float* sp = ssq + (size_t)(rt * 64 + 16 * m + fr) * 32 + fq * 8; pa[m] = *(const f32x4*)sp; pb[m] = *(const f32x4*)(sp + 4); }
#pragma unroll
          for (int m = 0; m < MB; ++m) { float s = ((pa[m][0] + pa[m][1]) + (pa[m][2] + pa[m][3])) + ((pb[m][0] + pb[m][1]) + (pb[m][2] + pb[m][3]));
              s += __shfl_xor(s, 16); s += __shfl_xor(s, 32); rs[m] = __builtin_amdgcn_rsqf(s * (1.0f / 2048.0f) + 1e-6f); } }
#pragma unroll
        for (int m = 0; m < MB; ++m) { const int r = rt * 64 + 16 * m + fr; float sc = rs[m];
            if (which < 2) { const float s = red[16 * m + fr] + red[64 + 16 * m + fr]; sc = rs[m] * __builtin_amdgcn_rsqf(s * rs[m] * rs[m] * (1.0f / 128.0f) + 1e-6f); }
            bf16_t* d16 = b16 + ((size_t)((r >> 4) * 16 + h) * rowsz + (r & 15)) * 128 + ch * 64 + 4 * fq; float* d32 = b32 + (size_t)r * 2048;
#pragma unroll
            for (int n = 0; n < NB; ++n) { f32x4 x = acc[m][n] * sc; if (which < 2) x = x * *(const f32x4*)(g + 16 * n);
                u32x2 w; w.x = cvtpk(x[0], x[1]); w.y = cvtpk(x[2], x[3]); *(u32x2*)(d16 + 16 * n) = w;
                if (which > 0) *(f32x4*)(d32 + 16 * n) = x; } }
    }
};
template <class Epi>
__device__ __forceinline__ void skinny_phase(SLAS unsigned char* lds, const bf16_t* A, const bf16_t* Bt, int nct, int K, unsigned* qc  , int tid, const Epi& E) {
    constexpr int MB = Epi::MB, NB = Epi::NB, NS = Epi::NS, NRT = 16 / MB, SLOT = MB * NB * 1024;
    const int lane = tid & 63, wid = __builtin_amdgcn_readfirstlane(tid >> 6), fr = lane & 15, fq = lane >> 4, kq = wid & 3, ch = wid >> 2;
    const int kw = K >> 2;
    SLAS float* red = (SLAS float*)(lds + 4 * SLOT);
    for (;;) {
        volatile SLAS int* tw = (volatile SLAS int*)(lds + 67712);
        if (tid == 0) *tw = (int)__hip_atomic_fetch_add(qc, 1u, __ATOMIC_RELAXED, __HIP_MEMORY_SCOPE_AGENT);
        __syncthreads();
        const int tile = __builtin_amdgcn_readfirstlane(*tw);
        if (tile >= NRT * nct) break;
        const int rt = tile % NRT, ct = tile / NRT;
        f32x4 acc[MB][NB];
#pragma unroll
        for (int m = 0; m < MB; ++m)
#pragma unroll
            for (int n = 0; n < NB; ++n) acc[m][n] = (f32x4){0.f, 0.f, 0.f, 0.f};
        const unsigned lo = (unsigned)(((lane >> 2) * K + kq * kw + (lane & 3) * 8) * 2);
        const int pidx = (((lane & 15) << 2) | (lane >> 4)) << 2;
        const char* ab = (const char*)(A + (size_t)(rt * 16 * MB) * K);
        const char* bb[NB];
#pragma unroll
        for (int n = 0; n < NB; ++n) bb[n] = (const char*)(Bt + (size_t)E.brow(ct, ch, n) * K);
        bf16x8 fa[NS][MB], fb[NS][NB];
#define SK_LOAD(st, ks) do { const unsigned o_ = lo + (unsigned)((ks) * 2); _Pragma("unroll") for (int m = 0; m < MB; ++m) fa[st][m] = *(const bf16x8*)(ab + (size_t)(o_ + (unsigned)(16 * m * K * 2))); \
            _Pragma("unroll") for (int n = 0; n < NB; ++n) fb[st][n] = *(const bf16x8*)(bb[n] + (size_t)o_); } while (0)
#define SK_PERM(v) do { u32x4 w_ = __builtin_bit_cast(u32x4, v); w_.x = (unsigned)__builtin_amdgcn_ds_bpermute(pidx, (int)w_.x); w_.y = (unsigned)__builtin_amdgcn_ds_bpermute(pidx, (int)w_.y); \
            w_.z = (unsigned)__builtin_amdgcn_ds_bpermute(pidx, (int)w_.z); w_.w = (unsigned)__builtin_amdgcn_ds_bpermute(pidx, (int)w_.w); v = __builtin_bit_cast(bf16x8, w_); } while (0)
#define SK_MMA(st) do { _Pragma("unroll") for (int m = 0; m < MB; ++m) SK_PERM(fa[st][m]); _Pragma("unroll") for (int n = 0; n < NB; ++n) SK_PERM(fb[st][n]); \
            _Pragma("unroll") for (int m = 0; m < MB; ++m) _Pragma("unroll") for (int n = 0; n < NB; ++n) acc[m][n] = __builtin_amdgcn_mfma_f32_16x16x32_bf16(fb[st][n], fa[st][m], acc[m][n], 0, 0, 0); } while (0)
#define SK_SB() __builtin_amdgcn_sched_barrier(0)
        const int nst = kw >> 5, kl = kw - 32;
#pragma unroll
        for (int j = 0; j < NS - 1; ++j) { SK_LOAD(j, (j * 32 < kw ? j * 32 : kl)); SK_SB(); }
        for (int s0 = 0; s0 < nst; s0 += NS) {
#pragma unroll
            for (int j = 0; j < NS; ++j) { const int kn = (s0 + j + NS - 1) * 32; SK_LOAD((j + NS - 1) % NS, kn < kw ? kn : kl); SK_SB(); if (s0 + j < nst) SK_MMA(j); SK_SB(); }
        }
#undef SK_SB
#undef SK_LOAD
#undef SK_MMA
#undef SK_PERM
#pragma unroll
        for (int half = 2; half >= 1; half >>= 1) {
            if (kq >= half && kq < 2 * half) { SLAS f32x4* s = (SLAS f32x4*)(lds + (ch * 2 + kq - half) * SLOT) + lane;
#pragma unroll
                for (int m = 0; m < MB; ++m)
#pragma unroll
                    for (int n = 0; n < NB; ++n) s[(m * NB + n) * 64] = acc[m][n]; }
            __syncthreads();
            if (kq < half) { const SLAS f32x4* s = (const SLAS f32x4*)(lds + (ch * 2 + kq) * SLOT) + lane;
#pragma unroll
                for (int m = 0; m < MB; ++m)
#pragma unroll
                    for (int n = 0; n < NB; ++n) acc[m][n] = acc[m][n] + s[(m * NB + n) * 64]; }
            __syncthreads();
        }
        if constexpr (Epi::NEEDS_X) { if (kq == 0) E.partial(acc, rt, ct, ch, fr, fq, red); __syncthreads(); }
        if (kq == 0) E(acc, rt, ct, ch, fr, fq, red);
        if constexpr (Epi::NEEDS_X) __syncthreads();
    }
}
}

namespace att {
typedef short bf16x8 __attribute__((ext_vector_type(8)));
typedef short s16x4 __attribute__((ext_vector_type(4)));
typedef float f32x16 __attribute__((ext_vector_type(16)));
typedef float f32x4 __attribute__((ext_vector_type(4)));
typedef unsigned u32x4 __attribute__((ext_vector_type(4)));
typedef unsigned short bf16;
#define ALAS __attribute__((address_space(3)))
constexpr int D = 128, NW = 8, QBLK = 32, KVBLK = 64, QB = NW * QBLK;
constexpr int SHM_V = KVBLK * D * 2, SHM_K = KVBLK * D * 2;
constexpr int OFF_V = 0, OFF_K = 2 * SHM_V, OFF_WS = 2 * SHM_V + 2 * SHM_K, OFF_TAB = OFF_WS + NW * 64 * 4, OFF_BIAS = OFF_TAB + 1024, LDS_END = OFF_BIAS + 8192 * 4 + 512;
constexpr float SCALE = 0.08838834764831845f, RSCALE = 11.313708498984761f;
constexpr float THR = 8.f;
#define KSWZ(row, colB) ((row) * 256 + ((colB) ^ (((row) & 7) << 4)))
#define SBAR() __builtin_amdgcn_sched_barrier(0)
__device__ __forceinline__ int v_st(int k, int c) { const int kk = (k & ~0xC) | ((k & 4) << 1) | ((k & 8) >> 1); return ((kk >> 3) * 4 + (c >> 5)) * 512 + ((kk & 7) * 32 + (c & 31)) * 2; }
__device__ __forceinline__ int v_rd_base(int lane) { return ((lane & 3) << 3) | (((lane >> 2) & 3) << 6) | (((lane >> 4) & 1) << 5) | (((lane >> 5) & 1) << 8); }
constexpr int v_rd_off(int d0, int ks, int half) { return d0 * 512 + ks * 4096 + half * 2048; }
__device__ __forceinline__ int crow(int r, int hi) { return (r & 3) + 8 * (r >> 2) + 4 * hi; }
__device__ __forceinline__ unsigned cvtpk(float lo, float hi) { unsigned r; asm volatile("v_cvt_pk_bf16_f32 %0, %1, %2" : "=v"(r) : "v"(lo), "v"(hi)); return r; }
__device__ __forceinline__ bf16x8 load8(const bf16* p) { return *reinterpret_cast<const bf16x8*>(p); }
__device__ __forceinline__ void mask_tile(f32x16& p0, f32x16& p1, int dq) {
    const float NEG = -__builtin_inff();
#pragma unroll
    for (int r = 0; r < 16; ++r) {
        const int c = (r & 3) + 8 * (r >> 2);
        if (dq - c < 0) p0[r] = NEG;
        if (dq - c - 32 < 0) p1[r] = NEG;
    }
}
__device__ __forceinline__ void partialSM(f32x16& p0, f32x16& p1, float& m_reg, float& mn, float& alpha) {
    float pmax = p0[0]; for (int r = 1; r < 16; ++r) pmax = fmaxf(pmax, p0[r]); for (int r = 0; r < 16; ++r) pmax = fmaxf(pmax, p1[r]);
    { auto rr = __builtin_amdgcn_permlane32_swap(__float_as_uint(pmax), __float_as_uint(pmax), false, false);
      pmax = fmaxf(__uint_as_float(rr[0]), __uint_as_float(rr[1])); }
    constexpr float C2 = 1.4426950408889634f * SCALE;
    if (__builtin_expect(__all((pmax - m_reg) * SCALE <= THR), 1)) { mn = m_reg; alpha = 1.f; }
    else { mn = fmaxf(m_reg, pmax); alpha = __builtin_amdgcn_exp2f((m_reg - mn) * C2); m_reg = mn; }
    const float mnL = -mn * C2;
    for (int r = 0; r < 16; ++r) p0[r] = fmaf(p0[r], C2, mnL); for (int r = 0; r < 16; ++r) p1[r] = fmaf(p1[r], C2, mnL);
    for (int r = 0; r < 16; ++r) p0[r] = __builtin_amdgcn_exp2f(p0[r]);
}
__device__ __forceinline__ void finishSM(f32x16& p0, f32x16& p1, float alpha, float& l_reg, bf16x8& pa0, bf16x8& pa1, bf16x8& pa2, bf16x8& pa3) {
    for (int r = 0; r < 16; ++r) p1[r] = __builtin_amdgcn_exp2f(p1[r]);
    float ps = 0; for (int r = 0; r < 16; ++r) ps += p0[r]; for (int r = 0; r < 16; ++r) ps += p1[r];
    { auto rr = __builtin_amdgcn_permlane32_swap(__float_as_uint(ps), __float_as_uint(ps), false, false);
      ps = __uint_as_float(rr[0]) + __uint_as_float(rr[1]); }
    l_reg = l_reg * alpha + ps;
#define PK4(P, B_, OUT) do { unsigned a0 = cvtpk(P[B_+0], P[B_+1]), a1 = cvtpk(P[B_+2], P[B_+3]);                          \
        unsigned b0 = cvtpk(P[B_+4], P[B_+5]), b1 = cvtpk(P[B_+6], P[B_+7]);                                             \
        auto r0 = __builtin_amdgcn_permlane32_swap(a0, b0, false, false); auto r1 = __builtin_amdgcn_permlane32_swap(a1, b1, false, false); \
        u32x4 w = {r0[0], r1[0], r0[1], r1[1]}; OUT = *reinterpret_cast<bf16x8*>(&w); } while (0)
    PK4(p0, 0, pa0); PK4(p0, 8, pa1); PK4(p1, 0, pa2); PK4(p1, 8, pa3);
#undef PK4
}
struct Blk {
    const bf16* Q; const bf16* K; const bf16* V; bf16* O;
    const float* aux;
    int P0;
    int jlo, jhi;
    int cap;
    int c0;
    float skipthr;
};
struct Nxt { const bf16* Q; const bf16* K; const bf16* V; int jlo; };
constexpr int OSTR = 2048;
struct Seam { bf16x8 qr[8]; bf16x8 st_v0, st_v1, st_k0, st_k1; };

template <int MODE, int KB>
__device__ __forceinline__ void qkt(f32x16& p0, f32x16& p1, ALAS const char* lds, int r32, int hi, const bf16x8* qr, bool act, int tile  , int dist  , int irow  ) {
    if (!act) { const float NEG = -__builtin_inff();
#pragma unroll
        for (int r = 0; r < 16; ++r) { p0[r] = NEG; p1[r] = NEG; } return; }
    if constexpr (MODE == 1) {
        ALAS const float* bp = (ALAS const float*)(lds + OFF_BIAS) + tile * 64 + 4 * hi;
#pragma unroll
        for (int i = 0; i < 4; ++i) { const f32x4 a = *(ALAS const f32x4*)(bp + 8 * i), b = *(ALAS const f32x4*)(bp + 32 + 8 * i);
            p0[4 * i] = a[0]; p0[4 * i + 1] = a[1]; p0[4 * i + 2] = a[2]; p0[4 * i + 3] = a[3]; p1[4 * i] = b[0]; p1[4 * i + 1] = b[1]; p1[4 * i + 2] = b[2]; p1[4 * i + 3] = b[3]; }
    } else {
        ALAS const float* R = (ALAS const float*)(lds + OFF_TAB);
        if (dist <= 2) { ALAS const float* rp = R + (191 - 64 * dist - irow + 4 * hi);
#pragma unroll
            for (int r = 0; r < 16; ++r) { p0[r] = rp[(r & 3) + 8 * (r >> 2)]; p1[r] = rp[32 + (r & 3) + 8 * (r >> 2)]; } }
        else { const float cf = R[0];
#pragma unroll
            for (int r = 0; r < 16; ++r) { p0[r] = cf; p1[r] = cf; } }
    }
    ALAS const char* K_lds = lds + OFF_K;
    ALAS const char* kb[4];
#pragma unroll
    for (int dd = 0; dd < 4; ++dd) kb[dd] = K_lds + KB * SHM_K + KSWZ(r32, (dd * 16 + hi * 8) * 2);
#pragma unroll
    for (int d0 = 0; d0 < 8; ++d0) { ALAS const char* a = kb[d0 & 3] + (d0 >> 2) * 128;
        bf16x8 b0 = *reinterpret_cast<ALAS const bf16x8*>(a);
        bf16x8 b1 = *reinterpret_cast<ALAS const bf16x8*>(a + 32 * 256);
        p0 = __builtin_amdgcn_mfma_f32_32x32x16_bf16(b0, qr[d0], p0, 0, 0, 0);
        p1 = __builtin_amdgcn_mfma_f32_32x32x16_bf16(b1, qr[d0], p1, 0, 0, 0); }
}
template <int MODE, int VB>
__device__ __forceinline__ void pv_tile(f32x16* o, int vb0, bf16x8 pa0, bf16x8 pa1, bf16x8 pa2, bf16x8 pa3, bool act) {
    if (!act) return;
#define TRRD(dst, off) asm volatile("ds_read_b64_tr_b16 %0, %1 offset:%2" : "=&v"(dst) : "v"(vb0), "i"(off) : "memory")
#define PV_D0(d0) do { s16x4 l0, l1, l2, l3, h0, h1, h2, h3; constexpr int b_ = VB * SHM_V + v_rd_off(d0, 0, 0); \
        TRRD(l0, b_); TRRD(h0, b_ + 2048); TRRD(l1, b_ + 4096); TRRD(h1, b_ + 6144); TRRD(l2, b_ + 8192); TRRD(h2, b_ + 10240); TRRD(l3, b_ + 12288); TRRD(h3, b_ + 14336); \
        asm volatile("s_waitcnt lgkmcnt(0)" ::: "memory"); SBAR();   \
        o[d0] = __builtin_amdgcn_mfma_f32_32x32x16_bf16(pa0, (bf16x8){l0[0], l0[1], l0[2], l0[3], h0[0], h0[1], h0[2], h0[3]}, o[d0], 0, 0, 0);   \
        o[d0] = __builtin_amdgcn_mfma_f32_32x32x16_bf16(pa1, (bf16x8){l1[0], l1[1], l1[2], l1[3], h1[0], h1[1], h1[2], h1[3]}, o[d0], 0, 0, 0);   \
        o[d0] = __builtin_amdgcn_mfma_f32_32x32x16_bf16(pa2, (bf16x8){l2[0], l2[1], l2[2], l2[3], h2[0], h2[1], h2[2], h2[3]}, o[d0], 0, 0, 0);   \
        o[d0] = __builtin_amdgcn_mfma_f32_32x32x16_bf16(pa3, (bf16x8){l3[0], l3[1], l3[2], l3[3], h3[0], h3[1], h3[2], h3[3]}, o[d0], 0, 0, 0); } while (0)
    PV_D0(0); PV_D0(1); PV_D0(2); PV_D0(3);
#undef PV_D0
#undef TRRD
}
#define AROW(p, k0, rr) ((const bf16*)((const char*)(p) + (size_t)(unsigned)(((k0) + (rr)) * (D * 2) + sc * 2)))
#define VMW() asm volatile("s_waitcnt vmcnt(0)" ::: "memory")
#define VMWN(n) asm volatile("s_waitcnt vmcnt(%0)" :: "i"(n) : "memory")
#define SLOAD_H(Kp, Vp, k0) do { S.st_v0 = load8(AROW(Vp, k0, sr)); S.st_v1 = load8(AROW(Vp, k0, 32 + sr));              \
                         S.st_k0 = load8(AROW(Kp, k0, sr)); S.st_k1 = load8(AROW(Kp, k0, 32 + sr)); } while (0)
#define SWRITE_HK(bf) do { *(ALAS bf16x8*)(K_lds + (bf) * SHM_K + kws) = S.st_k0; *(ALAS bf16x8*)(K_lds + (bf) * SHM_K + kws + 32 * 256) = S.st_k1; } while (0)
#define SWRITE_HV(bf) do { *(ALAS bf16x8*)(V_lds + (bf) * SHM_V + vst0) = S.st_v0; *(ALAS bf16x8*)(V_lds + (bf) * SHM_V + vst1) = S.st_v1; } while (0)
#define SWRITE_H(bf) do { SWRITE_HV(bf); SWRITE_HK(bf); } while (0)
template <int MODE>
__device__ __forceinline__ float build_bias(const Blk& b, ALAS char* lds, int tid) {
    asm volatile("" : "+v"(tid));
    if constexpr (MODE == 0) {
        if (tid < 256) { int d = 191 - tid; d = d < -128 ? -128 : (d > 128 ? 128 : d); ((ALAS float*)(lds + OFF_TAB))[tid] = b.aux[d + 128] * RSCALE; }
        return 0.f;
    } else {
        const int nk = b.jhi * 64, nv = b.cap + 1, e0 = tid * 16, lane = tid & 63, wid = tid >> 6;
        float v[16];
#pragma unroll
        for (int i = 0; i < 4; ++i) { f32x4 x = (f32x4){0.f, 0.f, 0.f, 0.f};
            if (e0 + 4 * i < nv) x = *(const f32x4*)(b.aux + e0 + 4 * i);
            v[4 * i] = x[0]; v[4 * i + 1] = x[1]; v[4 * i + 2] = x[2]; v[4 * i + 3] = x[3]; }
        float run = 0.f;
#pragma unroll
        for (int i = 15; i >= 0; --i) { const float x = v[i]; v[i] = run; run += x; }
        float incl = run;
#pragma unroll
        for (int o = 1; o < 64; o <<= 1) { const float t = __int_as_float(__builtin_amdgcn_ds_bpermute(((lane + o) & 63) << 2, __float_as_int(incl))); if (lane + o < 64) incl += t; }
        ALAS float* wt = (ALAS float*)(lds + OFF_TAB);
        if (lane == 0) wt[wid] = incl;
        asm volatile("s_waitcnt lgkmcnt(0)" ::: "memory"); __builtin_amdgcn_s_barrier(); asm volatile("" ::: "memory");
        float after = incl - run;
#pragma unroll
        for (int w = 1; w < 8; ++w) { const float t = wt[w]; if (w > wid) after += t; }
        if (e0 < nk) { ALAS f32x4* o4 = (ALAS f32x4*)(lds + OFF_BIAS) + tid * 4;
#pragma unroll
            for (int i = 0; i < 4; ++i) o4[i] = (f32x4){(v[4 * i] + after) * RSCALE, (v[4 * i + 1] + after) * RSCALE, (v[4 * i + 2] + after) * RSCALE, (v[4 * i + 3] + after) * RSCALE}; }
        return after;
    }
}
template <int MODE>
__device__ __forceinline__ void attn_prime(const Blk& cur, ALAS char* lds, Seam& S, int tid) {
    asm volatile("" : "+v"(tid));
    const int wid = __builtin_amdgcn_readfirstlane(tid >> 6), lane = tid & 63, r32 = lane & 31, hi = lane >> 5;
    const int sr = tid >> 4, sc = (tid & 15) * 8, kws = KSWZ(sr, sc * 2); ALAS char* K_lds = lds + OFF_K;
    const int kb0 = cur.jlo * KVBLK;
    const int qrow = wid * QBLK + r32;
#pragma unroll
    for (int d0 = 0; d0 < 8; ++d0) S.qr[d0] = load8((const bf16*)((const char*)cur.Q + (size_t)(unsigned)(qrow * (D * 2) + hi * 16 + d0 * 32)));
    SLOAD_H(cur.K, cur.V, kb0); VMW(); SWRITE_HK(0);
    __syncthreads();
}
template <int MODE, class IssueFn, class NextFn>
__device__ __forceinline__ void attn_block(const Blk& cur, IssueFn&& issue_fn, NextFn&& next_fn, ALAS char* lds, Seam& S, int tid) {
    asm volatile("" : "+v"(tid));
    const int wid = __builtin_amdgcn_readfirstlane(tid >> 6), lane = tid & 63, r32 = lane & 31, hi = lane >> 5;
    bf16x8 kd[8];
    if constexpr (MODE == 1) { const char* kp = (const char*)cur.K + (size_t)(unsigned)((cur.P0 + wid * QBLK + r32) * (D * 2) + hi * 16);
#pragma unroll
        for (int d0 = 0; d0 < 8; ++d0) kd[d0] = load8((const bf16*)(kp + d0 * 32)); }
    const float s_end = build_bias<MODE>(cur, lds, tid);
    asm volatile("s_waitcnt lgkmcnt(0)" ::: "memory"); __syncthreads();
    int j_lo = cur.jlo;
    const int sr = tid >> 4, sc = (tid & 15) * 8, vst0 = v_st(sr, sc), vst1 = v_st(32 + sr, sc), kws = KSWZ(sr, sc * 2);
    ALAS char* V_lds = lds + OFF_V; ALAS char* K_lds = lds + OFF_K;
    if constexpr (MODE == 1) {
        float dsum = 0.f;
#pragma unroll
        for (int d0 = 0; d0 < 8; ++d0) { const u32x4 qa = *reinterpret_cast<const u32x4*>(&S.qr[d0]), ka = *reinterpret_cast<const u32x4*>(&kd[d0]);
#pragma unroll
            for (int i = 0; i < 4; ++i) { dsum = fmaf(__uint_as_float(qa[i] << 16), __uint_as_float(ka[i] << 16), dsum);
                dsum = fmaf(__uint_as_float(qa[i] & 0xffff0000u), __uint_as_float(ka[i] & 0xffff0000u), dsum); } }
        { auto rr = __builtin_amdgcn_permlane32_swap(__float_as_uint(dsum), __float_as_uint(dsum), false, false); dsum = __uint_as_float(rr[0]) + __uint_as_float(rr[1]); }
        float gv = (((ALAS const float*)(lds + OFF_BIAS))[cur.P0 + wid * QBLK + r32] + dsum) * SCALE;
#pragma unroll
        for (int o = 1; o < 32; o <<= 1) gv = fminf(gv, __shfl_xor(gv, o));
        ALAS float* wg = (ALAS float*)(lds + OFF_TAB) + 32;
        if (lane == 0) wg[wid] = gv;
        asm volatile("s_waitcnt lgkmcnt(0)" ::: "memory"); __builtin_amdgcn_s_barrier(); asm volatile("" ::: "memory");
        float G = wg[0];
#pragma unroll
        for (int w = 1; w < 8; ++w) G = fminf(G, wg[w]);
        const bool pred = ((tid & 3) == 3) && ((tid >> 2) < (cur.P0 >> 6)) && (s_end < G - cur.skipthr);
        const int cnt = __builtin_popcountll(__ballot(pred));
        ALAS int* wcnt = (ALAS int*)(lds + OFF_TAB) + 16;
        if (lane == 0) wcnt[wid] = cnt;
        asm volatile("s_waitcnt lgkmcnt(0)" ::: "memory"); __builtin_amdgcn_s_barrier(); asm volatile("" ::: "memory");
        int tot = 0;
#pragma unroll
        for (int w = 0; w < 8; ++w) tot += wcnt[w];
        j_lo = __builtin_amdgcn_readfirstlane(tot);
        if (j_lo != cur.jlo) {
            SLOAD_H(cur.K, cur.V, j_lo * KVBLK); VMW(); SWRITE_HK(0); }
        __syncthreads();
    }
    const int NT = cur.jhi - j_lo;
    const int wlim = cur.P0 + wid * QBLK;
    const int qm = wlim + r32 - 4 * hi;
    const int cw = cur.c0 + (wid >> 1);
    const int irow = (wid & 1) * 32 + r32;
    ALAS float* wsf = (ALAS float*)(lds + OFF_WS) + wid * 64; ALAS float* li_l = wsf; ALAS float* al_l = wsf + 32;
    float m_reg = -1e30f, l_reg = 0; f32x16 o[4] = {};
    const int vb0 = (int)(unsigned)(unsigned long long)V_lds + v_rd_base(lane);
    const bf16* Kh = cur.K; const bf16* Vh = cur.V;
#define RESC(a) do { if (__any((a) < 1.f)) { if (hi == 0) al_l[r32] = (a); asm volatile("s_waitcnt lgkmcnt(0)" ::: "memory");              \
                     for (int d_ = 0; d_ < 4; ++d_) for (int r = 0; r < 16; ++r) o[d_][r] *= al_l[crow(r, hi)]; } } while (0)
#define KBASE(t) ((j_lo + (t)) * KVBLK)
#define ACT(t) (MODE == 1 ? (KBASE(t) <= wlim + QBLK - 1) : ((j_lo + (t)) >= cw - 8 && (j_lo + (t)) <= cw))
#define MASKT(P0_, P1_, t) do { if (MODE == 1) { const int kb_ = KBASE(t); if (kb_ + KVBLK - 1 > wlim) mask_tile(P0_, P1_, qm - kb_); } } while (0)
#define QKT(KB, PX0, PX1, t) qkt<MODE, KB>(PX0, PX1, lds, r32, hi, S.qr, ACT(t), j_lo + (t), cw - (j_lo + (t)), irow)
    constexpr int NQL = 8;
#define SEAM_K0() do { VMWN(NQL); SWRITE_HK(0); SBAR(); } while (0)
    f32x16 pA0, pA1, pB0, pB1; float mnA, mnB, alA, alB; bf16x8 pa0, pa1, pa2, pa3;
    SWRITE_HV(0); SBAR();
    if (NT > 1) SLOAD_H(Kh, Vh, KBASE(1));
    SBAR(); QKT(0, pA0, pA1, 0);
    MASKT(pA0, pA1, 0); partialSM(pA0, pA1, m_reg, mnA, alA);
    if (NT > 1) { VMW(); SWRITE_H(1); }
    __syncthreads();
#define HALF_STEP(PX0, PX1, mnX, alX, PY0, PY1, alY, t, KB, VB, SB) do {                                                      \
        SBAR(); QKT(KB, PX0, PX1, t);                                                                                          \
        finishSM(PY0, PY1, alY, l_reg, pa0, pa1, pa2, pa3); SBAR();                                                           \
        if ((t) + 1 < NT) { SLOAD_H(Kh, Vh, KBASE((t) + 1)); SBAR(); }                                                        \
        pv_tile<MODE, VB>(o, vb0, pa0, pa1, pa2, pa3, ACT((t) - 1)); MASKT(PX0, PX1, (t)); partialSM(PX0, PX1, m_reg, mnX, alX);   \
        __syncthreads();                                                                                                      \
        if ((t) + 1 < NT) { VMW(); SWRITE_H(SB); }                                                                            \
        RESC(alX); __syncthreads(); } while (0)
    if (NT < 3) issue_fn();
    for (int t = 1; t + 1 < NT; t += 2) {
        if (t + 3 >= NT) issue_fn();
        HALF_STEP(pB0, pB1, mnB, alB, pA0, pA1, alA, t, 1, 0, 0);
        HALF_STEP(pA0, pA1, mnA, alA, pB0, pB1, alB, t + 1, 0, 1, 1);
    }
    Nxt nxt; next_fn(nxt);
    const int kbn = nxt.jlo * KVBLK;
    const bool even = (NT & 1) == 0;
    if (even) { SBAR(); QKT(1, pB0, pB1, NT - 1); SBAR(); }
    SLOAD_H(nxt.K, nxt.V, kbn); SBAR();
    { const int qrow = wid * QBLK + r32;
#pragma unroll
      for (int d0 = 0; d0 < 8; ++d0) S.qr[d0] = load8((const bf16*)((const char*)nxt.Q + (size_t)(unsigned)(qrow * (D * 2) + hi * 16 + d0 * 32))); }
    SBAR();
    finishSM(pA0, pA1, alA, l_reg, pa0, pa1, pa2, pa3); SBAR();
    pv_tile<MODE, 0>(o, vb0, pa0, pa1, pa2, pa3, ACT(even ? NT - 2 : NT - 1));
    if (even) { MASKT(pB0, pB1, NT - 1); partialSM(pB0, pB1, m_reg, mnB, alB); __syncthreads(); RESC(alB);
        finishSM(pB0, pB1, alB, l_reg, pa0, pa1, pa2, pa3); SBAR(); pv_tile<MODE, 1>(o, vb0, pa0, pa1, pa2, pa3, ACT(NT - 1)); }
    SBAR(); SEAM_K0();
    __syncthreads();
    if (hi == 0) li_l[r32] = l_reg; asm volatile("s_waitcnt lgkmcnt(0)" ::: "memory");
    float rli[16];
#pragma unroll
    for (int r = 0; r < 16; ++r) rli[r] = __builtin_amdgcn_rcpf(li_l[crow(r, hi)]);
    ALAS char* stg = lds + OFF_V + wid * 4096 + (4 * hi) * 128 + r32 * 2;
    ALAS const char* srd = lds + OFF_V + wid * 4096 + (lane >> 3) * 128 + (lane & 7) * 16;
    unsigned ooff = (unsigned)(((wid * QBLK + (lane >> 3)) * OSTR + (lane & 7) * 8) * 2);
    asm volatile("" : "+v"(ooff));
#pragma unroll
    for (int ps = 0; ps < 2; ++ps) {
#pragma unroll
        for (int dd = 0; dd < 2; ++dd)
#pragma unroll
            for (int r = 0; r < 16; r += 2) { const unsigned w = cvtpk(o[2 * ps + dd][r] * rli[r], o[2 * ps + dd][r + 1] * rli[r + 1]);
                ALAS char* a = stg + ((r & 3) + 8 * (r >> 2)) * 128 + dd * 64;
                *(ALAS unsigned short*)a = (unsigned short)w; *(ALAS unsigned short*)(a + 128) = (unsigned short)(w >> 16); }
        asm volatile("s_waitcnt lgkmcnt(0)" ::: "memory");
        u32x4 q[4];
#pragma unroll
        for (int i = 0; i < 4; ++i) q[i] = *(ALAS const u32x4*)(srd + i * 1024);
        asm volatile("s_waitcnt lgkmcnt(0)" ::: "memory");
#pragma unroll
        for (int i = 0; i < 4; ++i) *(u32x4*)((char*)cur.O + (size_t)(ooff + (unsigned)(i * 8 * OSTR * 2 + ps * 128))) = q[i];
    }
    __syncthreads();
#undef RESC
#undef KBASE
#undef ACT
#undef MASKT
#undef QKT
#undef SEAM_K0
#undef HALF_STEP
}
#undef AROW
#undef VMW
#undef VMWN
#undef SLOAD_H
#undef SWRITE_HK
#undef SWRITE_HV
#undef SWRITE_H
}

constexpr int NWAVES = 8;
constexpr int NB = 2, T = 8192, D = 2048, NH = 16, HD = 128, FF = 5632, DEPTH = 4;
constexpr int SB = 16, SN = 16, PAST = 1024, WIN = 512, NREL = 257;
constexpr int MP = NB * T, MS = SB * SN, M = MP + MS;
constexpr int NQKV = 3 * D, NGU = 2 * FF;
constexpr int LS = PAST + SN;
constexpr float EPS = 1e-6f, SCALE = 0.08838834764831845f;
constexpr size_t O_Y = 0, O_YS = (size_t)MP * D, O_AKP = O_YS + (size_t)MS * D, SZ_AP = (size_t)2 * NB * WIN * D, O_AVP = O_AKP + SZ_AP, O_BKP = O_AVP + SZ_AP,
    SZ_BP = (size_t)2 * MP * D, O_BVP = O_BKP + SZ_BP, O_BFP = O_BVP + SZ_BP, SZ_BFP = (size_t)2 * MP * NH, O_AKS = O_BFP + SZ_BFP, SZ_S = (size_t)2 * MS * D,
    O_AVS = O_AKS + SZ_S, O_BKS = O_AVS + SZ_S, O_BVS = O_BKS + SZ_S, O_BFS = O_BVS + SZ_S, OUT_TOTAL = O_BFS + (size_t)2 * MS * NH;
static_assert(OUT_TOTAL == 181411840, "out size");
constexpr size_t MiB = 1u << 20;
constexpr size_t WS_CTL = 0, CTL_ZERO_BYTES = 1 * MiB;
constexpr size_t WS_WQKV = 2 * MiB, WS_WO = 98 * MiB, WS_WGU = 130 * MiB, WS_WD = 306 * MiB;
constexpr size_t WS_XB = 394 * MiB, WS_SSQ = 459 * MiB;
constexpr size_t WS_QP = 462 * MiB, WS_KP = 526 * MiB, WS_VP = 590 * MiB;
constexpr size_t WS_QS = 654 * MiB;
constexpr size_t WS_OB = 655 * MiB, WS_HB = 720 * MiB;
constexpr size_t WS_KSN = 899 * MiB, WS_VSN = 900 * MiB;
constexpr size_t WS_LFP = 1315 * MiB, WS_WF = 1316 * MiB  , WS_LFS = 1317 * MiB, WS_CUMS = 1319 * MiB, WS_END = 1321 * MiB;
static_assert(WS_WQKV + (size_t)DEPTH * NQKV * D * 2 <= WS_WO && WS_WO + (size_t)DEPTH * D * D * 2 <= WS_WGU && WS_WGU + (size_t)DEPTH * NGU * D * 2 <= WS_WD && WS_WD + (size_t)DEPTH * D * FF * 2 <= WS_XB, "ws map: weights");
static_assert(WS_XB + (size_t)M * D * 2 <= WS_SSQ && WS_SSQ + (size_t)M * 32 * 4 <= WS_QP && WS_OB + (size_t)M * D * 2 <= WS_HB && WS_HB + (size_t)M * FF * 2 <= WS_KSN, "ws map: activations");
constexpr int CW_BAR = 4096, CW_QUEUE = 8192, CW_SKQ = 8192 + 256;
constexpr size_t WS_QKM = WS_WF + 512 * 1024;
constexpr int RING_OFF = 0, RING_BYTES = 131072;
constexpr int LDSCTL_OFF = RING_BYTES, MISC_OFF = LDSCTL_OFF + 320, RED_OFF = LDSCTL_OFF + 1024;
constexpr int LDS_BYTES = 147456;
#define GAS __attribute__((address_space(1)))
#define LAS __attribute__((address_space(3)))
typedef unsigned short bf16;
typedef unsigned v4u __attribute__((ext_vector_type(4)));
typedef float f32x4 __attribute__((ext_vector_type(4)));
typedef short bf16x8 __attribute__((ext_vector_type(8)));
typedef GAS unsigned gu32;
typedef GAS unsigned long long gu64;
#define RLX_AGENT __ATOMIC_RELAXED, __HIP_MEMORY_SCOPE_AGENT
#define LDS_WAIT() asm volatile("s_waitcnt lgkmcnt(0)" ::: "memory")
#define VM_WAIT() asm volatile("s_waitcnt vmcnt(0)" ::: "memory")
__device__ __forceinline__ unsigned long long rt() { return __builtin_amdgcn_s_memrealtime(); }
__device__ __forceinline__ unsigned f2bf(float f) { unsigned u = __builtin_bit_cast(unsigned, f); return (u + 0x7fffu + ((u >> 16) & 1u)) >> 16; }
__device__ __forceinline__ unsigned pk2(float lo, float hi) { return f2bf(lo) | (f2bf(hi) << 16); }

#define XB_TMO      128
#define XB_XCNT(j)  (256  + 64 * (j))
#define XB_XSUB(j)  (1280 + 64 * (j))
#define XB_XGEN(j)  (2304 + 64 * (j))
#define XB_TOP      3328
#define XB_TOPGEN   3392
#define XCD_BAR_WORDS 3456
#define XB_SPIN_CAP (1u << 22)

__device__ __forceinline__ unsigned xb_ld(unsigned* p)              { return __hip_atomic_load(p, __ATOMIC_RELAXED, __HIP_MEMORY_SCOPE_AGENT); }
__device__ __forceinline__ unsigned xb_add(unsigned* p, unsigned v) { return __hip_atomic_fetch_add(p, v, __ATOMIC_RELAXED, __HIP_MEMORY_SCOPE_AGENT); }
__device__ __forceinline__ unsigned xb_xcc_id() { return (unsigned)__builtin_amdgcn_s_getreg((3 << 11) | 20) & 0xFu; }
#define XB_SPIN(cond, bar) do { unsigned _sp = 0; while (cond) { __builtin_amdgcn_s_sleep(1); \
    if ((++_sp & 255u) == 0u) { if (xb_ld(&(bar)[XB_TMO])) break; if (_sp > XB_SPIN_CAP) { atomicAdd(&(bar)[XB_TMO], 1u); break; } } } } while (0)

struct XcdBarrier {
    unsigned* bar; unsigned x;
    volatile LAS unsigned* st;
};

__device__ __forceinline__ XcdBarrier xcd_barrier_post(unsigned* bar, volatile LAS unsigned* st, const bool leader  ) {
    XcdBarrier b; b.bar = bar; b.x = xb_xcc_id(); b.st = st;
    if (leader) (void)xb_add(&bar[XB_XCNT(b.x)], 1u);
    return b;
}
__device__ __forceinline__ void xcd_barrier_complete(unsigned* bar, unsigned x, unsigned& nloc, unsigned& nx) {
    const unsigned G = gridDim.x * gridDim.y * gridDim.z;
    unsigned sum, cnt, mine, sp = 0u;
    for (;;) {
        sum = 0u; cnt = 0u; mine = 0u;
#pragma unroll
        for (unsigned j = 0; j < 16; ++j) { const unsigned c = xb_ld(&bar[XB_XCNT(j)]); sum += c; cnt += (c > 0u) ? 1u : 0u; mine = (j == x) ? c : mine; }
        if (sum == G) break;
        __builtin_amdgcn_s_sleep(1);
        if ((++sp & 255u) == 0u) { if (xb_ld(&bar[XB_TMO])) break; if (sp > XB_SPIN_CAP) { atomicAdd(&bar[XB_TMO], 1u); break; } }
    }
    nloc = mine > 0u ? mine : 1u; nx = cnt > 0u ? cnt : 1u;
}

__device__ __forceinline__ void xcd_barrier(const XcdBarrier& b, const bool leader  ) {
    asm volatile("s_waitcnt vmcnt(0)" ::: "memory");
    __syncthreads();
    if (leader) {
        unsigned* bar = b.bar;
        __builtin_amdgcn_s_waitcnt(0);
        unsigned nloc = b.st[0], nx = b.st[1];
        if (nloc == 0u) { xcd_barrier_complete(bar, b.x, nloc, nx); b.st[0] = nloc; b.st[1] = nx; }
        const unsigned old = xb_add(&bar[XB_XSUB(b.x)], 1u);
        const unsigned gen = old / nloc;
        if (old + 1u == (gen + 1u) * nloc) {
            __builtin_amdgcn_fence(__ATOMIC_RELEASE, "agent");
            asm volatile("s_waitcnt vmcnt(0)" ::: "memory");
            const unsigned og = xb_add(&bar[XB_TOP], 1u);
            const unsigned tg = og / nx;
            if (og + 1u == (tg + 1u) * nx) xb_add(&bar[XB_TOPGEN], 1u);
            else XB_SPIN(xb_ld(&bar[XB_TOPGEN]) == tg, bar);
            __builtin_amdgcn_fence(__ATOMIC_ACQUIRE, "agent");
            xb_add(&bar[XB_XGEN(b.x)], 1u);
            asm volatile("s_waitcnt vmcnt(0)" ::: "memory");
        } else {
            XB_SPIN(xb_ld(&bar[XB_XGEN(b.x)]) == gen, bar);
            __builtin_amdgcn_fence(__ATOMIC_ACQUIRE, "agent");
            asm volatile("s_waitcnt vmcnt(0)" ::: "memory");
        }
    }
    __syncthreads();
}

typedef float f32x2 __attribute__((ext_vector_type(2)));
__device__ __forceinline__ float wave_sum(float v) {
#pragma unroll
    for (int o = 1; o < 64; o <<= 1) v += __shfl_xor(v, o);
    return v;
}
__device__ __forceinline__ float bf2f(unsigned b) { return __uint_as_float(b << 16); }

__device__ __forceinline__ void p0_transpose_item(const float* W, const float* g, int K, int N, bf16* WT, int mode, LAS float* scr, int item, int lane) {
    const int nblk = N / 32, kb = item / nblk, nb = item % nblk, k0 = 64 * kb, n0 = 32 * nb;
    const int kr = lane >> 3, nc = (lane & 7) * 4;
    f32x4 v[8]; float gs[8];
#pragma unroll
    for (int i = 0; i < 8; ++i) { v[i] = *(const GAS f32x4*)(W + (size_t)(k0 + kr + 8 * i) * N + n0 + nc); gs[i] = g ? g[k0 + kr + 8 * i] : 1.f; }
#pragma unroll
    for (int i = 0; i < 8; ++i) { LAS float* s = scr + (kr + 8 * i) * 33 + nc; s[0] = v[i].x * gs[i]; s[1] = v[i].y * gs[i]; s[2] = v[i].z * gs[i]; s[3] = v[i].w * gs[i]; }
    LDS_WAIT(); asm volatile("" ::: "memory");
    const int c = lane & 7;
    const int drow0 = (mode == 0) ? n0 : (256 * (n0 >> 7) + (n0 & 127) + (mode == 2 ? 128 : 0));
#pragma unroll
    for (int j = 0; j < 4; ++j) { const int n = (lane >> 3) + 8 * j; const LAS float* s = scr + (8 * c) * 33 + n;
        v4u o; o.x = pk2(s[0 * 33], s[1 * 33]); o.y = pk2(s[2 * 33], s[3 * 33]); o.z = pk2(s[4 * 33], s[5 * 33]); o.w = pk2(s[6 * 33], s[7 * 33]);
        *(GAS v4u*)(WT + (size_t)(drow0 + n) * K + k0 + 8 * c) = o; }
    LDS_WAIT(); asm volatile("" ::: "memory");
}
__device__ __forceinline__ void p0_item128(const float* W, const float* g, int K, int N, bf16* WT, int mode, LAS float* scr, int item, int lane) {
    const int nblk = N / 32, kb = item / nblk, nb = item % nblk, k0 = 128 * kb, n0 = 32 * nb;
    const int kr = lane >> 3, nc = (lane & 7) * 4;
    f32x4 v[16]; float gs[16];
#pragma unroll
    for (int i = 0; i < 16; ++i) { v[i] = *(const GAS f32x4*)(W + (size_t)(k0 + kr + 8 * i) * N + n0 + nc); gs[i] = g ? g[k0 + kr + 8 * i] : 1.f; }
    const int c = lane & 7;
    const int drow0 = (mode == 0) ? n0 : (256 * (n0 >> 7) + (n0 & 127) + (mode == 2 ? 128 : 0));
#pragma unroll
    for (int hf = 0; hf < 2; ++hf) {
#pragma unroll
        for (int i = 0; i < 8; ++i) { LAS float* s = scr + (kr + 8 * i) * 33 + nc; const f32x4 x = v[hf * 8 + i]; const float gg = gs[hf * 8 + i]; s[0] = x.x * gg; s[1] = x.y * gg; s[2] = x.z * gg; s[3] = x.w * gg; }
        LDS_WAIT(); asm volatile("" ::: "memory");
#pragma unroll
        for (int j = 0; j < 4; ++j) { const int n = (lane >> 3) + 8 * j; const LAS float* s = scr + (8 * c) * 33 + n;
            v4u o; o.x = pk2(s[0 * 33], s[1 * 33]); o.y = pk2(s[2 * 33], s[3 * 33]); o.z = pk2(s[4 * 33], s[5 * 33]); o.w = pk2(s[6 * 33], s[7 * 33]);
            *(GAS v4u*)(WT + (size_t)(drow0 + n) * K + k0 + 64 * hf + 8 * c) = o; }
        LDS_WAIT(); asm volatile("" ::: "memory");
    }
}
constexpr int CI_QKV = (D / 128) * (NQKV / 32), CI_O = (D / 128) * (D / 32), CI_G = (D / 128) * (FF / 32), CI_D = (FF / 128) * (D / 32), CI_L = CI_O + 2 * CI_G + CI_D;
__device__ __forceinline__ int conv_group_items(int grp) { return grp == 0 ? CI_QKV : (grp <= 3 ? CI_L + CI_QKV : CI_L); }
__device__ __forceinline__ void conv_item(const float* const __attribute__((address_space(4)))* in, unsigned char* ws, int grp, int it, LAS float* scr, int lane) {
    bf16* WQKV = (bf16*)(ws + WS_WQKV); bf16* WO = (bf16*)(ws + WS_WO); bf16* WGU = (bf16*)(ws + WS_WGU); bf16* WD = (bf16*)(ws + WS_WD);
    int r = it;
    if (grp > 0) { const int L = grp - 1; const float* gf = in[15] + (size_t)L * D;
        if (r < CI_O) { p0_item128(in[11] + (size_t)L * D * D, nullptr, D, D, WO + (size_t)L * D * D, 0, scr, r, lane); return; } r -= CI_O;
        if (r < CI_G) { p0_item128(in[16] + (size_t)L * D * FF, gf, D, FF, WGU + (size_t)L * NGU * D, 1, scr, r, lane); return; } r -= CI_G;
        if (r < CI_G) { p0_item128(in[17] + (size_t)L * D * FF, gf, D, FF, WGU + (size_t)L * NGU * D, 2, scr, r, lane); return; } r -= CI_G;
        if (r < CI_D) { p0_item128(in[18] + (size_t)L * FF * D, nullptr, FF, D, WD + (size_t)L * D * FF, 0, scr, r, lane); return; } r -= CI_D;
    }
    const int Lq = grp;
    p0_item128(in[8] + (size_t)Lq * D * NQKV, in[7] + (size_t)Lq * D, D, NQKV, WQKV + (size_t)Lq * NQKV * D, 0, scr, r, lane);
}
constexpr int N_SLICE = 256;
struct ConvD { const float* W; const float* g; bf16* WT; int K, N, mode, item; };
__device__ __forceinline__ ConvD conv_desc(const float* const __attribute__((address_space(4)))* in, unsigned char* ws, int grp, int it) {
    ConvD d; int r = it; const int L = grp - 1;
    if (r < CI_O) { d.W = in[11] + (size_t)L * D * D; d.g = nullptr; d.WT = (bf16*)(ws + WS_WO) + (size_t)L * D * D; d.K = D; d.N = D; d.mode = 0; d.item = r; return d; } r -= CI_O;
    if (r < 2 * CI_G) { const int up = r >= CI_G ? 1 : 0; d.W = in[16 + up] + (size_t)L * D * FF; d.g = in[15] + (size_t)L * D; d.WT = (bf16*)(ws + WS_WGU) + (size_t)L * NGU * D; d.K = D; d.N = FF; d.mode = 1 + up; d.item = r - up * CI_G; return d; } r -= 2 * CI_G;
    if (r < CI_D) { d.W = in[18] + (size_t)L * FF * D; d.g = nullptr; d.WT = (bf16*)(ws + WS_WD) + (size_t)L * D * FF; d.K = FF; d.N = D; d.mode = 0; d.item = r; return d; } r -= CI_D;
    d.W = in[8] + (size_t)grp * D * NQKV; d.g = in[7] + (size_t)grp * D; d.WT = (bf16*)(ws + WS_WQKV) + (size_t)grp * NQKV * D; d.K = D; d.N = NQKV; d.mode = 0; d.item = r; return d;
}
__device__ __forceinline__ void p0_load128(const ConvD& d, f32x4 (&v)[16], float (&gs)[16], int lane) {
    const int nblk = d.N / 32, kb = d.item / nblk, nb = d.item % nblk, k0 = 128 * kb, n0 = 32 * nb;
    const int kr = lane >> 3, nc = (lane & 7) * 4;
#pragma unroll
    for (int i = 0; i < 16; ++i) { v[i] = *(const GAS f32x4*)(d.W + (size_t)(k0 + kr + 8 * i) * d.N + n0 + nc); gs[i] = d.g ? d.g[k0 + kr + 8 * i] : 1.f; }
}
__device__ __forceinline__ void p0_finish128(const ConvD& d, const f32x4 (&v)[16], const float (&gs)[16], LAS float* scr, int lane) {
    const int nblk = d.N / 32, kb = d.item / nblk, nb = d.item % nblk, k0 = 128 * kb, n0 = 32 * nb;
    const int kr = lane >> 3, nc = (lane & 7) * 4, c = lane & 7;
    const int drow0 = (d.mode == 0) ? n0 : (256 * (n0 >> 7) + (n0 & 127) + (d.mode == 2 ? 128 : 0));
#pragma unroll
    for (int hf = 0; hf < 2; ++hf) {
#pragma unroll
        for (int i = 0; i < 8; ++i) { LAS float* s = scr + (kr + 8 * i) * 33 + nc; const f32x4 x = v[hf * 8 + i]; const float gg = gs[hf * 8 + i]; s[0] = x.x * gg; s[1] = x.y * gg; s[2] = x.z * gg; s[3] = x.w * gg; }
        LDS_WAIT(); asm volatile("" ::: "memory");
#pragma unroll
        for (int j = 0; j < 4; ++j) { const int n = (lane >> 3) + 8 * j; const LAS float* s = scr + (8 * c) * 33 + n;
            v4u o; o.x = pk2(s[0 * 33], s[1 * 33]); o.y = pk2(s[2 * 33], s[3 * 33]); o.z = pk2(s[4 * 33], s[5 * 33]); o.w = pk2(s[6 * 33], s[7 * 33]);
            *(GAS v4u*)(d.WT + (size_t)(drow0 + n) * d.K + k0 + 64 * hf + 8 * c) = o; }
        LDS_WAIT(); asm volatile("" ::: "memory");
    }
}
__device__ __forceinline__ void conv_slice(const float* const __attribute__((address_space(4)))* in, unsigned char* ws, int grp, int slice, LAS unsigned char* lds, int tid) {
    asm volatile("" : "+v"(tid));
    const int lane = tid & 63, wave = __builtin_amdgcn_readfirstlane(tid >> 6);
    LAS float* scr = (LAS float*)(lds + wave * 16384);
    const int ni = conv_group_items(grp), per = (ni + N_SLICE - 1) / N_SLICE, i0 = slice * per, i1 = (i0 + per < ni) ? i0 + per : ni;
    const int first = i0 + wave, n = (first < i1) ? (i1 - first + NWAVES - 1) / NWAVES : 0;
    if (n > 0) {
        f32x4 vA[16], vB[16]; float gA[16], gB[16];
        ConvD dA = conv_desc(in, ws, grp, first), dB = dA; p0_load128(dA, vA, gA, lane);
#pragma unroll 1
        for (int j = 0; j < n; j += 2) {
            dB = conv_desc(in, ws, grp, first + NWAVES * (j + 1 < n ? j + 1 : n - 1)); p0_load128(dB, vB, gB, lane); __builtin_amdgcn_sched_barrier(0);
            p0_finish128(dA, vA, gA, scr, lane); __builtin_amdgcn_sched_barrier(0);
            dA = conv_desc(in, ws, grp, first + NWAVES * (j + 2 < n ? j + 2 : n - 1)); p0_load128(dA, vA, gA, lane); __builtin_amdgcn_sched_barrier(0);
            if (j + 1 < n) p0_finish128(dB, vB, gB, scr, lane);
            __builtin_amdgcn_sched_barrier(0);
        }
    }
    __syncthreads();
}
__device__ __forceinline__ void row_update(const float* xold, const float* crow, float* xdst, bf16* xbrow, float* rstd_p, int lane) {
    const GAS f32x4* xr = (const GAS f32x4*)xold + lane; const GAS f32x4* cr = (const GAS f32x4*)crow + lane;
    GAS f32x4* xd = (GAS f32x4*)xdst + lane; GAS unsigned long long* o8 = (GAS unsigned long long*)xbrow + lane;
    float ss = 0.f;
#pragma unroll
    for (int j = 0; j < 8; ++j) { f32x4 v = xr[64 * j]; if (crow) v = v + cr[64 * j]; if (xdst) xd[64 * j] = v;
        ss += (v.x * v.x + v.y * v.y) + (v.z * v.z + v.w * v.w);
        o8[64 * j] = (unsigned long long)pk2(v.x, v.y) | ((unsigned long long)pk2(v.z, v.w) << 32); }
    ss = wave_sum(ss);
    if (lane < 32) rstd_p[lane] = (lane == 0) ? ss : 0.f;
}

template <int MODE>
__device__ __forceinline__ void sample_attn(LAS char* lds, int u, int li, unsigned char* ws, const float* rel, const float* kcache, const float* vcache, int tid) {
    asm volatile("" : "+v"(tid));
    constexpr int L = (MODE == 0) ? WIN : PAST, Lk = L + SN, NKB = Lk / 16, LkP = (Lk + 31) / 32 * 32, NST = LkP / 32, PP = LkP;
    constexpr int OFF_P = att::OFF_BIAS + 4352, OFF_RI = OFF_P + 16 * 1056 * 2;
    static_assert(16 * Lk * 4 <= att::OFF_TAB && OFF_RI + 64 <= 131072 && 8 * 16 * 128 * 4 <= att::OFF_TAB, "sample attention LDS map");
    const int lane = tid & 63, wid = __builtin_amdgcn_readfirstlane(tid >> 6), fr = lane & 15, fq = lane >> 4, st = u >> 4, h = u & 15;
    LAS float* S = (LAS float*)lds; LAS unsigned short* P = (LAS unsigned short*)(lds + OFF_P); LAS float* RI = (LAS float*)(lds + OFF_RI);
    const bf16* QSp = (const bf16*)(ws + WS_QS) + (size_t)u * SN * HD; const bf16* KNp = (const bf16*)(ws + WS_KSN) + (size_t)u * SN * HD; const bf16* VNp = (const bf16*)(ws + WS_VSN) + (size_t)u * SN * HD;
    const float* kc = kcache + ((size_t)(li * SB + st) * L) * D + h * HD; const float* vc = vcache + ((size_t)(li * SB + st) * L) * D + h * HD;
    if constexpr (MODE == 1) {
        att::Blk b; b.aux = (const float*)(ws + WS_LFS) + (size_t)u * LS; b.jhi = 17; b.cap = LS - 1; b.jlo = 0; b.P0 = PAST; b.c0 = 0; b.skipthr = 0.f; b.Q = nullptr; b.K = nullptr; b.V = nullptr; b.O = nullptr;
        (void)att::build_bias<1>(b, lds, tid);
    }
    pg8::bf16x8 qf[4];
#pragma unroll
    for (int ds = 0; ds < 4; ++ds) qf[ds] = *(const pg8::bf16x8*)(QSp + (size_t)fr * HD + ds * 32 + fq * 8);
    asm volatile("s_waitcnt lgkmcnt(0)" ::: "memory"); __syncthreads();
#define SA_SCORE(accv, key0_) do { f32x4 lg_; _Pragma("unroll") for (int r = 0; r < 4; ++r) { const int key = (key0_) + 4 * fq + r; float v_; \
            if (MODE == 1) { v_ = ((accv)[r] + ((LAS const float*)(lds + att::OFF_BIAS))[key]) * SCALE; if (key > L + fr) v_ = -__builtin_inff(); } \
            else { int dd = L + fr - key; dd = dd < -128 ? -128 : (dd > 128 ? 128 : dd); v_ = (accv)[r] * SCALE + rel[(size_t)(li * NH + h) * NREL + dd + 128]; } \
            lg_[r] = v_; } *(LAS f32x4*)(S + fr * Lk + (key0_) + 4 * fq) = lg_; } while (0)
    constexpr int NCB = L / 16 / NWAVES;
#pragma unroll 1
    for (int i = 0; i < NCB; i += 2) {
        f32x4 ka[2][4], kb2[2][4];
#pragma unroll
        for (int u2 = 0; u2 < 2; ++u2) { const float* kr = kc + (size_t)((wid + (i + u2) * NWAVES) * 16 + fr) * D + fq * 8;
#pragma unroll
            for (int ds = 0; ds < 4; ++ds) { ka[u2][ds] = *(const GAS f32x4*)(kr + ds * 32); kb2[u2][ds] = *(const GAS f32x4*)(kr + ds * 32 + 4); } }
#pragma unroll
        for (int u2 = 0; u2 < 2; ++u2) { pg8::f32x4 acc = (pg8::f32x4){0.f, 0.f, 0.f, 0.f};
#pragma unroll
            for (int ds = 0; ds < 4; ++ds) { const f32x4 a = ka[u2][ds], b2 = kb2[u2][ds];
                v4u w; w.x = pk2(a.x, a.y); w.y = pk2(a.z, a.w); w.z = pk2(b2.x, b2.y); w.w = pk2(b2.z, b2.w);
                acc = __builtin_amdgcn_mfma_f32_16x16x32_bf16(__builtin_bit_cast(pg8::bf16x8, w), qf[ds], acc, 0, 0, 0); }
            SA_SCORE(acc, (wid + (i + u2) * NWAVES) * 16); }
    }
    if (wid == 0) { const bf16* kr = KNp + (size_t)fr * HD + fq * 8; pg8::f32x4 acc = (pg8::f32x4){0.f, 0.f, 0.f, 0.f};
#pragma unroll
        for (int ds = 0; ds < 4; ++ds) acc = __builtin_amdgcn_mfma_f32_16x16x32_bf16(*(const pg8::bf16x8*)(kr + ds * 32), qf[ds], acc, 0, 0, 0);
        SA_SCORE(acc, L); }
#undef SA_SCORE
    asm volatile("s_waitcnt lgkmcnt(0)" ::: "memory"); __syncthreads();
#pragma unroll 1
    for (int rr = 0; rr < 2; ++rr) { const int q = 2 * wid + rr; LAS const float* sr = S + q * Lk; float m = -1e30f;
        for (int k = lane; k < Lk; k += 64) m = fmaxf(m, sr[k]);
#pragma unroll
        for (int o = 1; o < 64; o <<= 1) m = fmaxf(m, __int_as_float(__builtin_amdgcn_ds_bpermute(((lane ^ o) & 63) << 2, __float_as_int(m))));
        float sum = 0.f;
        for (int k = lane; k < PP; k += 64) { float p = 0.f; if (k < Lk) { p = __expf(sr[k] - m); sum += p; } P[q * 1056 + k] = (unsigned short)f2bf(p); }
#pragma unroll
        for (int o = 1; o < 64; o <<= 1) sum += __int_as_float(__builtin_amdgcn_ds_bpermute(((lane ^ o) & 63) << 2, __float_as_int(sum)));
        if (lane == 0) RI[q] = 1.0f / sum; }
    asm volatile("s_waitcnt lgkmcnt(0)" ::: "memory"); __syncthreads();
    pg8::f32x4 oacc[8];
#pragma unroll
    for (int db = 0; db < 8; ++db) oacc[db] = (pg8::f32x4){0.f, 0.f, 0.f, 0.f};
    constexpr int NCS = L / 32 / NWAVES;
#pragma unroll 1
    for (int i = 0; i < NCS; i += 2) {
        f32x4 ev[2][2][8];
#pragma unroll
        for (int u2 = 0; u2 < 2; ++u2) { const float* vr = vc + (size_t)((wid + (i + u2) * NWAVES) * 32 + fq * 8) * D + 4 * fr;
#pragma unroll
            for (int hf = 0; hf < 2; ++hf)
#pragma unroll
                for (int j = 0; j < 8; ++j) ev[u2][hf][j] = *(const GAS f32x4*)(vr + (size_t)j * D + hf * 64); }
#pragma unroll
        for (int u2 = 0; u2 < 2; ++u2) { const pg8::bf16x8 pf = *(LAS const pg8::bf16x8*)(P + fr * 1056 + (wid + (i + u2) * NWAVES) * 32 + fq * 8);
#pragma unroll
            for (int hf = 0; hf < 2; ++hf)
#pragma unroll
                for (int c = 0; c < 4; ++c) { v4u w; w.x = pk2(ev[u2][hf][0][c], ev[u2][hf][1][c]); w.y = pk2(ev[u2][hf][2][c], ev[u2][hf][3][c]); w.z = pk2(ev[u2][hf][4][c], ev[u2][hf][5][c]); w.w = pk2(ev[u2][hf][6][c], ev[u2][hf][7][c]);
                    oacc[hf * 4 + c] = __builtin_amdgcn_mfma_f32_16x16x32_bf16(__builtin_bit_cast(pg8::bf16x8, w), pf, oacc[hf * 4 + c], 0, 0, 0); } }
    }
    if (wid == 0) { const int kq = L + fq * 8; const pg8::bf16x8 pf = *(LAS const pg8::bf16x8*)(P + fr * 1056 + kq);
        const bool ok = fq < 2; const bf16* vr = VNp + (size_t)(ok ? (kq - L) : 0) * HD + 4 * fr;
#pragma unroll
        for (int hf = 0; hf < 2; ++hf)
#pragma unroll
            for (int c = 0; c < 4; ++c) { unsigned e[8];
#pragma unroll
                for (int j = 0; j < 8; ++j) e[j] = ok ? (unsigned)vr[(size_t)j * HD + hf * 64 + c] : 0u;
                v4u w; w.x = e[0] | (e[1] << 16); w.y = e[2] | (e[3] << 16); w.z = e[4] | (e[5] << 16); w.w = e[6] | (e[7] << 16);
                oacc[hf * 4 + c] = __builtin_amdgcn_mfma_f32_16x16x32_bf16(__builtin_bit_cast(pg8::bf16x8, w), pf, oacc[hf * 4 + c], 0, 0, 0); } }
    LAS float* PO = (LAS float*)lds;
#pragma unroll
    for (int hf = 0; hf < 2; ++hf)
#pragma unroll
        for (int r = 0; r < 4; ++r) *(LAS f32x4*)(PO + (wid * 16 + fr) * 128 + hf * 64 + 16 * fq + 4 * r) = (f32x4){oacc[hf * 4][r], oacc[hf * 4 + 1][r], oacc[hf * 4 + 2][r], oacc[hf * 4 + 3][r]};
    asm volatile("s_waitcnt lgkmcnt(0)" ::: "memory"); __syncthreads();
    { const int q = tid >> 5, d4 = (tid & 31) * 4; f32x4 s = *(LAS const f32x4*)(PO + q * 128 + d4);
#pragma unroll
      for (int w = 1; w < 8; ++w) { const f32x4 t = *(LAS const f32x4*)(PO + (w * 16 + q) * 128 + d4); s = s + t; }
      const float ri = RI[q];
      bf16* o = (bf16*)(ws + WS_OB) + ((size_t)MP + st * SN + q) * D + h * HD + d4;
      *(GAS unsigned long long*)o = (unsigned long long)pk2(s.x * ri, s.y * ri) | ((unsigned long long)pk2(s.z * ri, s.w * ri) << 32); }
    __syncthreads();
}

constexpr int N_PROMPT = NB * NH * 32, N_UNIT = SB * NH, N_POS = N_PROMPT + N_UNIT + N_SLICE;
static_assert(N_UNIT == N_SLICE && N_PROMPT >= 2 * N_UNIT, "ticket layout");
template <int MODE> __device__ __forceinline__ void pos_decode(int pos, int& kind, int& id) {
    if (pos < 4 * N_UNIT) { const int g = pos >> 2, r = pos & 3; if (r == 2) { kind = 1; id = g; } else if (r == 3) { kind = 2; id = g; } else { kind = 0; id = 2 * g + r; } }
    else { kind = 0; id = pos - 2 * N_UNIT; }
}
template <int MODE>
__device__ __forceinline__ void get_blk(int p, int li, unsigned char* ws, const float* rel, att::Blk& b) {
    bf16* QPp = (bf16*)(ws + WS_QP); bf16* KPp = (bf16*)(ws + WS_KP); bf16* VPp = (bf16*)(ws + WS_VP); bf16* OBp = (bf16*)(ws + WS_OB);
    int bh, qb;
    bh = p & 31; qb = 31 - (p >> 5);
    const int bb = bh >> 4, h = bh & 15;
    b.Q = QPp + ((size_t)bh * T + qb * 256) * HD; b.K = KPp + (size_t)bh * T * HD; b.V = VPp + (size_t)bh * T * HD; b.O = OBp + ((size_t)bb * T + qb * 256) * D + h * HD; b.P0 = qb * 256;
    if (MODE == 0) { b.aux = rel + (size_t)(li * NH + h) * NREL; b.c0 = qb * 4; b.jlo = b.c0 > 8 ? b.c0 - 8 : 0; b.jhi = b.c0 + 4; b.cap = 1 << 29; b.skipthr = __builtin_inff(); }
    else { b.aux = (const float*)(ws + WS_LFP) + (size_t)bh * T; b.c0 = 0; b.jlo = 0; b.jhi = 4 * (qb + 1); b.cap = qb * 256 + 255; b.skipthr = ((const float*)(ws + WS_QKM))[li]; }
}
__device__ __forceinline__ int take_ticket(gu32* qc, LAS unsigned char* lds, int tid) {
    volatile LAS int* w = (volatile LAS int*)(lds + 131008);
    if (tid == 0) *w = (int)__hip_atomic_fetch_add(qc, 1u, RLX_AGENT);
    __syncthreads();
    return __builtin_amdgcn_readfirstlane(*w);
}
template <int MODE>
__device__ __forceinline__ void attn_phase(LAS unsigned char* lds, int bx, int G, int layer, unsigned char* ws, const float* const __attribute__((address_space(4)))* in, const int tid) {
    att::Blk cur; att::Nxt nxt; att::Seam S;
    const int li = layer >> 1;
    const float* rel = in[12]; const float* kcache = in[MODE == 1 ? 4 : 2]; const float* vcache = in[MODE == 1 ? 5 : 3];
    gu32* qc = (gu32*)(ws + WS_CTL) + CW_QUEUE + 64 * layer;
    int pos = take_ticket(qc, lds, tid);
    while (pos < N_POS) {
        int kind, id; pos_decode<MODE>(pos, kind, id);
        if (kind != 0) {
            if (kind == 1) sample_attn<MODE>((LAS char*)lds, id, li, ws, rel, kcache, vcache, tid);
            else conv_slice(in, ws, layer + 1, id, lds, tid);
            pos = take_ticket(qc, lds, tid); continue; }
        get_blk<MODE>(id, li, ws, rel, cur);
        att::attn_prime<MODE>(cur, (LAS char*)lds, S, tid);
        for (;;) {
            int np = N_POS, id2 = 0; bool nf = false;
            int tk = 0;
            att::attn_block<MODE>(cur, [&]() { if (tid == 0) tk = (int)__hip_atomic_fetch_add(qc, 1u, RLX_AGENT); },
                [&](att::Nxt& nxt) {
                { volatile LAS int* w = (volatile LAS int*)(lds + 131008); if (tid == 0) *w = tk; __syncthreads(); np = __builtin_amdgcn_readfirstlane(*w); }
                int k2 = 3; if (np < N_POS) pos_decode<MODE>(np, k2, id2);
                nf = (k2 == 0);
                att::Blk nb; if (nf) { get_blk<MODE>(id2, li, ws, rel, nb); nxt.Q = nb.Q; nxt.K = nb.K; nxt.V = nb.V; nxt.jlo = nb.jlo; } else { nxt.Q = cur.Q; nxt.K = cur.K; nxt.V = cur.V; nxt.jlo = cur.jlo; }
            }, (LAS char*)lds, S, tid);
            pos = np;
            if (!nf) break;
            int id3 = id2; asm volatile("" : "+s"(id3));
            get_blk<MODE>(id3, li, ws, rel, cur);
        }
    }
}

struct Args { const float* in[19]; float* out; unsigned char* ws; int ph_lo, ph_hi; };
constexpr int PH_PER_LAYER = 5, N_PHASES = 1 + DEPTH * PH_PER_LAYER;

typedef const __attribute__((address_space(4))) Args CArgs;
#define PH_BEGIN() CArgs* A; { unsigned long long k_ = (unsigned long long)__builtin_amdgcn_kernarg_segment_ptr(); asm volatile("" : "+s"(k_)); A = (CArgs*)k_; } \
    unsigned char* const ws = A->ws; float* const out = A->out; int bx = blockIdx.x; asm volatile("" : "+s"(bx)); (void)ws; (void)out; (void)bx; \
    unsigned m1_ = ~0u; int ws_ = wave_s; asm volatile("" : "+s"(m1_), "+s"(ws_)); int tid = ws_ * 64 + (int)__builtin_amdgcn_mbcnt_hi(m1_, __builtin_amdgcn_mbcnt_lo(m1_, 0u)); asm volatile("" : "+v"(tid)); const int lane = tid & 63, wave = wave_s; (void)lane; (void)wave; \
    const int gw = bx * NWAVES + wave, NGW = G * NWAVES; const long gt = (long)bx * (NWAVES * 64) + tid, NGT = (long)G * (NWAVES * 64); (void)gw; (void)NGW; (void)gt; (void)NGT
__global__ void __launch_bounds__(NWAVES * 64, 2) fwd_kernel(Args args_unused) {
    extern __shared__ __attribute__((aligned(16))) unsigned char lds_raw[];
    LAS unsigned char* lds = (LAS unsigned char*)lds_raw;
    volatile LAS unsigned* MISC = (volatile LAS unsigned*)(lds + MISC_OFF);
    const int G = gridDim.x;
    const int wave_s = __builtin_amdgcn_readfirstlane((int)threadIdx.x >> 6);
    for (int u = threadIdx.x; u < (LDS_BYTES - LDSCTL_OFF) / 4; u += NWAVES * 64) ((LAS unsigned*)(lds + LDSCTL_OFF))[u] = 0u;
    __syncthreads();
    int lo, hi; XcdBarrier bar;
    { PH_BEGIN(); lo = A->ph_lo; hi = A->ph_hi; bar = xcd_barrier_post((unsigned*)((gu32*)(ws + WS_CTL) + CW_BAR), MISC + 8, tid == 0); }
#define IN(k) (lo <= (k) && (k) < hi)
#define SEAM(k) do { if (IN(k) && IN((k) + 1)) { XcdBarrier b2_ = bar; unsigned m2_ = ~0u; int w2_ = wave_s; asm volatile("" : "+s"(b2_.bar), "+s"(m2_), "+s"(w2_)); \
    xcd_barrier(b2_, w2_ == 0 && __builtin_amdgcn_mbcnt_hi(m2_, __builtin_amdgcn_mbcnt_lo(m2_, 0u)) == 0u); } } while (0)
#define P_WQKV ((bf16*)(ws + WS_WQKV))
#define P_WO ((bf16*)(ws + WS_WO))
#define P_WGU ((bf16*)(ws + WS_WGU))
#define P_WD ((bf16*)(ws + WS_WD))
#define P_XB ((bf16*)(ws + WS_XB))
#define P_SSQ ((float*)(ws + WS_SSQ))
#define P_QP ((bf16*)(ws + WS_QP))
#define P_KP ((bf16*)(ws + WS_KP))
#define P_VP ((bf16*)(ws + WS_VP))
#define P_QS ((bf16*)(ws + WS_QS))
#define P_OB ((bf16*)(ws + WS_OB))
#define P_HB ((bf16*)(ws + WS_HB))
#define P_LFP ((float*)(ws + WS_LFP))
#define P_LFS ((float*)(ws + WS_LFS))
#define P_KSN ((bf16*)(ws + WS_KSN))
#define P_VSN ((bf16*)(ws + WS_VSN))
#define P_WF ((bf16*)(ws + WS_WF))
#define P_X (out + O_Y)

    if (IN(0)) { PH_BEGIN();
        LAS float* scr = (LAS float*)(lds + RING_OFF + wave * 16384);
        for (int it = gw; it < conv_group_items(0); it += NGW) conv_item(A->in, ws, 0, it, scr, lane);
        for (int row = gw; row < M; row += NGW) {
            const float* xr = row < MP ? A->in[0] + (size_t)row * D : A->in[1] + (size_t)(row - MP) * D;
            row_update(xr, nullptr, nullptr, P_XB + (size_t)row * D, P_SSQ + (size_t)row * 32, lane);
        }
        for (long idx = gt; idx < 2L * NH * D; idx += NGT) { const int ib = (int)(idx >> 15), h = (int)((idx >> 11) & 15), k = (int)(idx & (D - 1));
            P_WF[idx] = (bf16)f2bf(A->in[7][(size_t)(2 * ib + 1) * D + k] * A->in[13][((size_t)ib * D + k) * NH + h]); }
        if (gw == 0) {
#pragma unroll 1
            for (int ib = 0; ib < 2; ++ib) { const float* gq = A->in[9] + (2 * ib + 1) * HD; const float* gk = A->in[10] + (2 * ib + 1) * HD;
                float mqk = fmaxf(fabsf(gq[lane] * gk[lane]), fabsf(gq[lane + 64] * gk[lane + 64]));
#pragma unroll
                for (int o = 1; o < 64; o <<= 1) mqk = fmaxf(mqk, __shfl_xor(mqk, o));
                if (lane == 0) ((float*)(ws + WS_QKM))[ib] = 11.313708499f * mqk * 1.02f + 40.0f; }
        }
    }
    SEAM(0);

#pragma unroll 1
    for (int layer = 0; layer < DEPTH; ++layer) {
        const int pb = 1 + layer * PH_PER_LAYER, li = layer >> 1; const bool fox = (layer & 1) != 0;
        if (IN(pb + 0)) { PH_BEGIN();
            if (fox) {
                const bf16* wfp = P_WF + (size_t)li * NH * D; const float* bfp = A->in[14] + li * NH;
                const int fr = lane & 15, fq = lane >> 4, lr = lane >> 2, lc = lane & 3, pidx = (((lane & 15) << 2) | (lane >> 4)) << 2;
                const int nidle = (G > 192) ? (G - 192) * NWAVES : NGW, gw0 = (G > 192) ? (bx - 192) * NWAVES + wave : gw;
                if (gw0 >= 0)
                for (int grp = gw0; grp < M / 16; grp += nidle) {
                    const int row = grp * 16 + fr;
                    const char* ap = (const char*)(P_XB + (size_t)(grp * 16 + lr) * D) + lc * 16; const char* bp = (const char*)(wfp + (size_t)lr * D) + lc * 16;
                    pg8::f32x4 acc = (pg8::f32x4){0.f, 0.f, 0.f, 0.f};
#pragma unroll 8
                    for (int ks = 0; ks < D / 32; ++ks) { pg8::u32x4 av = *(const pg8::u32x4*)(ap + ks * 64), bv = *(const pg8::u32x4*)(bp + ks * 64);
                        av.x = (unsigned)__builtin_amdgcn_ds_bpermute(pidx, (int)av.x); av.y = (unsigned)__builtin_amdgcn_ds_bpermute(pidx, (int)av.y); av.z = (unsigned)__builtin_amdgcn_ds_bpermute(pidx, (int)av.z); av.w = (unsigned)__builtin_amdgcn_ds_bpermute(pidx, (int)av.w);
                        bv.x = (unsigned)__builtin_amdgcn_ds_bpermute(pidx, (int)bv.x); bv.y = (unsigned)__builtin_amdgcn_ds_bpermute(pidx, (int)bv.y); bv.z = (unsigned)__builtin_amdgcn_ds_bpermute(pidx, (int)bv.z); bv.w = (unsigned)__builtin_amdgcn_ds_bpermute(pidx, (int)bv.w);
                        acc = __builtin_amdgcn_mfma_f32_16x16x32_bf16(__builtin_bit_cast(pg8::bf16x8, bv), __builtin_bit_cast(pg8::bf16x8, av), acc, 0, 0, 0); }
                    const float rs = pg8::row_rstd(P_SSQ, row, fq);
                    const pg8::f32x4 bb = *(const pg8::f32x4*)(bfp + 4 * fq); pg8::f32x4 lf;
#pragma unroll
                    for (int i = 0; i < 4; ++i) { const float z = acc[i] * rs + bb[i]; lf[i] = fminf(z, 0.f) - log1pf(expf(-fabsf(z))); }
                    if (row < MP) { *(pg8::f32x4*)(out + O_BFP + ((size_t)li * MP + row) * NH + 4 * fq) = lf;
#pragma unroll
                        for (int i = 0; i < 4; ++i) P_LFP[(size_t)((row >> 13) * NH + 4 * fq + i) * T + (row & (T - 1))] = lf[i]; }
                    else { const int rs2 = row - MP; *(pg8::f32x4*)(out + O_BFS + ((size_t)li * MS + rs2) * NH + 4 * fq) = lf;
#pragma unroll
                        for (int i = 0; i < 4; ++i) P_LFS[(size_t)((rs2 >> 4) * NH + 4 * fq + i) * LS + PAST + (rs2 & 15)] = lf[i]; }
                }
                const float* clf = A->in[6] + (size_t)li * SB * PAST * NH;
                for (long idx = gt; idx < (long)SB * NH * PAST; idx += NGT) { const int unit = (int)(idx >> 10), j = (int)(idx & 1023), st = unit >> 4, h = unit & 15;
                    P_LFS[(size_t)unit * LS + j] = clf[((size_t)st * PAST + j) * NH + h]; }
            }
            pg8::Gemm g{P_XB, P_WQKV + (size_t)layer * NQKV * D, MP, NQKV, D}; pg8::StaticOrder S; S.init(MP, NQKV, G, bx);
            pg8::EpiQKV E;
            E.ssq = P_SSQ; E.gq = A->in[9] + layer * HD; E.gk = A->in[10] + layer * HD; E.QP = P_QP; E.pstride = (WS_KP - WS_QP) / 2; E.QS = P_QS;
            E.srows = SN; E.lc = 0; E.KS = P_KSN; E.sstride = (WS_VSN - WS_KSN) / 2;
            E.okp = out + (fox ? O_BKP + (size_t)li * MP * D : O_AKP + (size_t)li * NB * WIN * D); E.opstride = fox ? SZ_BP : SZ_AP;
            E.oks = out + (fox ? O_BKS : O_AKS) + (size_t)li * MS * D; E.osstride = SZ_S;
            E.fox = fox ? 1 : 0; E.red = (LAS float*)(lds + RED_OFF);
            pg8::gemm_phase<pg8::EpiQKV, pg8::StaticOrder, true, true>(lds + RING_OFF, g, S, E, tid);
            __syncthreads();
            {
                sk::SkQKV K2; K2.ssq = P_SSQ + (size_t)MP * 32; K2.gq = A->in[9] + layer * HD; K2.gk = A->in[10] + layer * HD; K2.QS = P_QS;
                K2.srows = SN; K2.lc = 0; K2.KS = P_KSN; K2.sstride = (WS_VSN - WS_KSN) / 2;
                K2.oks = out + (fox ? O_BKS : O_AKS) + (size_t)li * MS * D; K2.osstride = SZ_S;
                sk::skinny_phase<sk::SkQKV>(lds + RING_OFF, P_XB + (size_t)MP * D, P_WQKV + (size_t)layer * NQKV * D, NQKV / 128, D, (unsigned*)((gu32*)(ws + WS_CTL) + CW_SKQ + 64 * (layer * 4 + 0)), tid, K2);
            }
        }
        SEAM(pb + 0);
        if (IN(pb + 1)) { PH_BEGIN();
            if (fox) attn_phase<1>(lds + RING_OFF, bx, G, layer, ws, A->in, tid);
            else attn_phase<0>(lds + RING_OFF, bx, G, layer, ws, A->in, tid);
        }
        SEAM(pb + 1);
        if (IN(pb + 2)) { PH_BEGIN();
            pg8::Gemm g{P_OB, P_WO + (size_t)layer * D * D, MP, D, D}; pg8::StaticOrder S; S.init(MP, D, G, bx);
            pg8::EpiResid E;
            E.X = nullptr; E.XB = P_XB; E.ssq = P_SSQ;
            pg8::gemm_phase<pg8::EpiResid, pg8::StaticOrder, true, true>(lds + RING_OFF, g, S, E, tid);
            __syncthreads();
            {   sk::SkResid K2; K2.xin = (layer == 0) ? A->in[1] : P_X + (size_t)MP * D; K2.X = P_X + (size_t)MP * D; K2.XB = P_XB + (size_t)MP * D; K2.ssq = P_SSQ + (size_t)MP * 32;
                sk::skinny_phase<sk::SkResid>(lds + RING_OFF, P_OB + (size_t)MP * D, P_WO + (size_t)layer * D * D, D / 64, D, (unsigned*)((gu32*)(ws + WS_CTL) + CW_SKQ + 64 * (layer * 4 + 1)), tid, K2); }
        }
        SEAM(pb + 2);
        if (IN(pb + 3)) { PH_BEGIN();
            pg8::Gemm g{P_XB, P_WGU + (size_t)layer * NGU * D, MP, NGU, D}; pg8::StaticOrder S; S.init(MP, NGU, G, bx);
            pg8::EpiSwiglu E{P_HB, FF, P_SSQ};
            pg8::gemm_phase<pg8::EpiSwiglu, pg8::StaticOrder, true, true>(lds + RING_OFF, g, S, E, tid);
            __syncthreads();
            {   sk::SkSwiglu K2{P_HB + (size_t)MP * FF, FF, P_SSQ + (size_t)MP * 32};
                sk::skinny_phase<sk::SkSwiglu>(lds + RING_OFF, P_XB + (size_t)MP * D, P_WGU + (size_t)layer * NGU * D, NGU / 128, D, (unsigned*)((gu32*)(ws + WS_CTL) + CW_SKQ + 64 * (layer * 4 + 2)), tid, K2); }
        }
        SEAM(pb + 3);
        if (IN(pb + 4)) { PH_BEGIN();
            pg8::Gemm g{P_HB, P_WD + (size_t)layer * D * FF, MP, D, FF}; pg8::StaticOrder S; S.init(MP, D, G, bx);
            pg8::EpiResid E;
            E.X = (layer == DEPTH - 1) ? P_X : nullptr; E.XB = P_XB; E.ssq = P_SSQ;
            pg8::gemm_phase<pg8::EpiResid, pg8::StaticOrder, true, true>(lds + RING_OFF, g, S, E, tid);
            __syncthreads();
            {   sk::SkResid K2; K2.xin = P_X + (size_t)MP * D; K2.X = P_X + (size_t)MP * D; K2.XB = P_XB + (size_t)MP * D; K2.ssq = P_SSQ + (size_t)MP * 32;
                sk::skinny_phase<sk::SkResid>(lds + RING_OFF, P_HB + (size_t)MP * FF, P_WD + (size_t)layer * D * FF, D / 64, FF, (unsigned*)((gu32*)(ws + WS_CTL) + CW_SKQ + 64 * (layer * 4 + 3)), tid, K2); }
        }
        SEAM(pb + 4);
    }
#undef IN
#undef SEAM
}

#ifndef MK_SPLIT
#define MK_SPLIT 0
#endif
extern "C" void kernel_launch(void* const* d_in, const int* in_sizes, int n_in, void* d_out, int out_size, void* d_ws, size_t ws_size, hipStream_t stream) {
    static int grid = 0;
    if (grid == 0) {
        if (n_in != 19 || in_sizes[0] != MP * D || (size_t)out_size != OUT_TOTAL || ws_size < WS_END) { fprintf(stderr, "kernel_launch: shape mismatch (n_in %d in0 %d out %d ws %zu); nothing launched\n", n_in, n_in > 0 ? in_sizes[0] : -1, out_size, ws_size); grid = -1; return; }
        int dev = 0, cus = 0;
        if (hipGetDevice(&dev) != hipSuccess || hipDeviceGetAttribute(&cus, hipDeviceAttributeMultiprocessorCount, dev) != hipSuccess) { grid = -1; return; }
        if (hipFuncSetAttribute((const void*)fwd_kernel, hipFuncAttributeMaxDynamicSharedMemorySize, LDS_BYTES) != hipSuccess) { fprintf(stderr, "kernel_launch: hipFuncSetAttribute failed\n"); grid = -1; return; }
        int per_cu = 0;
        if (hipOccupancyMaxActiveBlocksPerMultiprocessor(&per_cu, (const void*)fwd_kernel, NWAVES * 64, LDS_BYTES) != hipSuccess || per_cu < 1) fprintf(stderr, "kernel_launch: occupancy query reports %d\n", per_cu);
        (void)hipGetLastError();
        grid = cus;
    }
    if (grid < 0) return;
    if (hipMemsetAsync((char*)d_ws + WS_CTL, 0, CTL_ZERO_BYTES, stream) != hipSuccess) return;
    Args a{};
    for (int i = 0; i < 19; ++i) a.in[i] = (const float*)d_in[i];
    a.out = (float*)d_out; a.ws = (unsigned char*)d_ws;
#if MK_SPLIT
    for (int p = 0; p < N_PHASES; ++p) { a.ph_lo = p; a.ph_hi = p + 1; hipLaunchKernelGGL(fwd_kernel, dim3(grid), dim3(NWAVES * 64), LDS_BYTES, stream, a); }
#else
    a.ph_lo = 0; a.ph_hi = N_PHASES;
    hipLaunchKernelGGL(fwd_kernel, dim3(grid), dim3(NWAVES * 64), LDS_BYTES, stream, a);
#endif
}
```

```cpp
#include <hip/hip_runtime.h>
#include <cstdio>
#include <cstdint>
namespace pg8 {
#define PG8_LAS __attribute__((address_space(3)))
typedef unsigned short bf16_t;
typedef short bf16x8 __attribute__((ext_vector_type(8)));
typedef float f32x4 __attribute__((ext_vector_type(4)));
typedef unsigned u32x4 __attribute__((ext_vector_type(4)));
constexpr int BM = 256, BK = 64, HALF = 128, HTB = HALF * BK * 2  , STAGE_BYTES = 8 * HTB, NXCD = 8, WGM = 2;

__host__ __device__ __forceinline__ int lds_byte(int r, int c) { const int st = (r >> 4) * 2 + (c >> 5), rr = r & 15, cc = c & 31, ob = rr * 64 + cc * 2; return st * 1024 + (ob ^ (((ob >> 9) & 1) << 5)); }
__host__ __device__ __forceinline__ void stage_rc(int b, int& R, int& C) { const int st = b / 1024, sb = b % 1024, swz = sb ^ (((sb >> 9) & 1) << 5); R = (st >> 1) * 16 + swz / 64; C = (st & 1) * 32 + (swz % 64) / 2; }
__host__ __device__ __forceinline__ int perm32(int rho) { const int n = rho >> 4, i = rho & 15; return 8 * (i >> 2) + 4 * n + (i & 3); }

struct Unit { int pm, pn; };
struct Gemm { const bf16_t* A; const bf16_t* Bt; int M, N, K; };

struct StaticOrder {
    int nM, nN, nwg, G, c;
    __host__ __device__ void init(int M, int N, int G_, int c_) { nM = M / BM; nN = N / BM; nwg = nM * nN; G = G_; c = c_; }
    __host__ __device__ bool next(int i, Unit& u) const {
        const long L = (long)i * G + c; if (L >= nwg) return false;
        int wgid = (int)L; { const int q = nwg / NXCD, r = nwg % NXCD, xcd = wgid % NXCD, off = wgid / NXCD; wgid = (xcd < r ? xcd * (q + 1) : r * (q + 1) + (xcd - r) * q) + off; }
        const int nig = WGM * nN, gid = wgid / nig, fm = gid * WGM, gsz = (nM - fm) < WGM ? (nM - fm) : WGM;
        u.pm = fm + ((wgid % nig) % gsz); u.pn = (wgid % nig) / gsz; return true;
    }
    __device__ __forceinline__ void a_ready(const Unit&) const {}
    __device__ __forceinline__ void done(const Unit&) const {}
};

__device__ __forceinline__ unsigned cvt_pk_bf16(float lo, float hi) { unsigned r; asm volatile("v_cvt_pk_bf16_f32 %0, %1, %2" : "=v"(r) : "v"(lo), "v"(hi)); return r; }
struct EpiF32 {
    static constexpr bool PERM = false, AFTER_DRAIN = false;
    float* C; int ldc;
    __device__ __forceinline__ void operator()(const f32x4 (&acc)[2][2][4][2], const Unit& u, int wr, int wc, int fr, int fq) const {
        const int row0 = u.pm * BM + wr * 64 + fr, col0 = u.pn * BM + wc * 32 + 4 * fq;
#pragma unroll
        for (int ai = 0; ai < 2; ++ai)
#pragma unroll
            for (int m = 0; m < 4; ++m) { float* rowp = C + (size_t)(row0 + ai * HALF + m * 16) * ldc + col0;
#pragma unroll
                for (int bj = 0; bj < 2; ++bj)
#pragma unroll
                    for (int n = 0; n < 2; ++n) *(f32x4*)(rowp + bj * HALF + n * 16) = acc[ai][bj][m][n]; }
    }
};
template <class Epi, class Sched, bool ALIGN_EPI = false, bool SP2 = false>
__device__ __forceinline__ void gemm_phase(PG8_LAS unsigned char* lds, const Gemm g, const Sched& S, const Epi& E, const int tid_in) {
    int tid_ = tid_in; asm volatile("" : "+v"(tid_));
    const int tid = tid_, wid = __builtin_amdgcn_readfirstlane(tid >> 6), lane = tid & 63, wr = wid >> 2, wc = wid & 3, fr = lane & 15, fq = lane >> 4;
    const int K = g.K, nt = K / BK;
    unsigned voffA[2], voffB[2];
#pragma unroll
    for (int i = 0; i < 2; ++i) { int R, C; stage_rc(tid * 16 + i * 8192, R, C); const int Rb = Epi::PERM ? ((R & ~31) + perm32(R & 31)) : R;
        voffA[i] = (unsigned)(R * K + C) * 2u; voffB[i] = (unsigned)(Rb * K + C) * 2u; }
    const size_t kstep = (size_t)(BK * 2);
    const size_t hstep = (size_t)HALF * K * 2;
    const size_t tstep = 2 * hstep;
    const unsigned ldsw = (unsigned)wid * 1024u;
    const int aoff = lds_byte(wr * 64 + fr, fq * 8), boff = lds_byte(wc * 32 + fr, fq * 8);
#define PG8_SA(b, h) (((b) * 2 + (h)) * HTB)
#define PG8_SB(b, h) ((4 + (b) * 2 + (h)) * HTB)
#define PG8_STAGE(bufoff, gbase, voff) do { _Pragma("unroll") for (int _i = 0; _i < 2; ++_i) \
        __builtin_amdgcn_global_load_lds((const unsigned*)((const char*)(gbase) + (voff)[_i]), (PG8_LAS unsigned*)(lds + (bufoff) + ldsw + _i * 8192), 16, 0, 0); } while (0)
#define PG8_LDA(dst, b, h) do { _Pragma("unroll") for (int m = 0; m < 4; ++m) _Pragma("unroll") for (int k = 0; k < 2; ++k) dst[m][k] = *(const PG8_LAS bf16x8*)(lds + PG8_SA(b, h) + aoff + m * 2048 + k * 1024); } while (0)
#define PG8_LDB(dst, b, h) do { _Pragma("unroll") for (int n = 0; n < 2; ++n) _Pragma("unroll") for (int k = 0; k < 2; ++k) dst[n][k] = *(const PG8_LAS bf16x8*)(lds + PG8_SB(b, h) + boff + n * 2048 + k * 1024); } while (0)
#define PG8_MMA(ai, bj, At, Bt) do { __builtin_amdgcn_s_setprio(1); _Pragma("unroll") for (int m = 0; m < 4; ++m) _Pragma("unroll") for (int n = 0; n < 2; ++n) _Pragma("unroll") for (int k = 0; k < 2; ++k) \
        acc[ai][bj][m][n] = __builtin_amdgcn_mfma_f32_16x16x32_bf16(Bt[n][k], At[m][k], acc[ai][bj][m][n], 0, 0, 0); __builtin_amdgcn_s_setprio(0); } while (0)
#define PG8_WAIT_V(n) asm volatile("s_waitcnt vmcnt(" #n ")" ::: "memory")
#define PG8_WAIT_L(n) asm volatile("s_waitcnt lgkmcnt(" #n ")" ::: "memory")
#define PG8_BAR __builtin_amdgcn_s_barrier()
#define PG8_SCHED __builtin_amdgcn_sched_barrier(0)
    Unit cur, nxt; int ui = 0;
    if (!S.next(0, cur)) return;
    f32x4 acc[2][2][4][2];
#pragma unroll
    for (int a = 0; a < 2; ++a)
#pragma unroll
        for (int b = 0; b < 2; ++b)
#pragma unroll
            for (int m = 0; m < 4; ++m)
#pragma unroll
                for (int n = 0; n < 2; ++n) acc[a][b][m][n] = (f32x4){0.f, 0.f, 0.f, 0.f};
    bf16x8 At[4][2], B0[2][2], B1[2][2];
    const char* cA = (const char*)g.A + (size_t)cur.pm * tstep; const char* cB = (const char*)g.Bt + (size_t)cur.pn * tstep;
    S.a_ready(cur);
    if constexpr (SP2) {
        PG8_STAGE(PG8_SB(0, 0), cB, voffB); PG8_STAGE(PG8_SB(0, 1), cB + hstep, voffB); PG8_STAGE(PG8_SA(0, 0), cA, voffA); PG8_STAGE(PG8_SA(0, 1), cA + hstep, voffA);
        if (wr == 1) PG8_BAR;
        PG8_WAIT_V(2); PG8_BAR;
        PG8_STAGE(PG8_SB(1, 0), cB + kstep, voffB); PG8_STAGE(PG8_SA(1, 0), cA + kstep, voffA); PG8_STAGE(PG8_SB(1, 1), cB + hstep + kstep, voffB);
        PG8_WAIT_V(6); PG8_BAR;
    } else {
        PG8_STAGE(PG8_SB(0, 0), cB, voffB); PG8_STAGE(PG8_SA(0, 0), cA, voffA); PG8_STAGE(PG8_SB(0, 1), cB + hstep, voffB); PG8_STAGE(PG8_SA(0, 1), cA + hstep, voffA);
        if (wr == 1) PG8_BAR;
        PG8_WAIT_V(4); PG8_BAR;
        PG8_STAGE(PG8_SB(1, 0), cB + kstep, voffB); PG8_STAGE(PG8_SA(1, 0), cA + kstep, voffA); PG8_STAGE(PG8_SB(1, 1), cB + hstep + kstep, voffB);
        PG8_WAIT_V(6); PG8_BAR;
    }
    for (;;) {
        const bool has_next = S.next(ui + 1, nxt);
        const char* nA = has_next ? (const char*)g.A + (size_t)nxt.pm * tstep : cA; const char* nB = has_next ? (const char*)g.Bt + (size_t)nxt.pn * tstep : cB;
        for (int t = 0; t < nt; t += 2) {
            const bool last = (t == nt - 2);
            const char* a1 = cA + (size_t)(t + 1) * kstep;
            const char* a2 = last ? nA : cA + (size_t)(t + 2) * kstep; const char* b2 = last ? nB : cB + (size_t)(t + 2) * kstep;
            const char* a3 = a2 + kstep; const char* b3 = b2 + kstep;
            if (last && has_next) S.a_ready(nxt);
            if constexpr (SP2) {
            PG8_LDB(B0, 0, 0); PG8_LDB(B1, 0, 1); PG8_SCHED; PG8_LDA(At, 0, 0); PG8_STAGE(PG8_SA(1, 1), a1 + hstep, voffA);
            PG8_WAIT_V(8); PG8_WAIT_L(0); PG8_BAR; PG8_MMA(0, 0, At, B0); PG8_MMA(0, 1, At, B1); PG8_BAR; PG8_SCHED;
            PG8_LDA(At, 0, 1); PG8_STAGE(PG8_SB(0, 0), b2, voffB); PG8_STAGE(PG8_SB(0, 1), b2 + hstep, voffB); PG8_STAGE(PG8_SA(0, 0), a2, voffA);
            PG8_WAIT_V(8); PG8_WAIT_L(0); PG8_BAR; PG8_MMA(1, 0, At, B0); PG8_MMA(1, 1, At, B1); PG8_BAR; PG8_SCHED;
            PG8_LDB(B0, 1, 0); PG8_LDB(B1, 1, 1); PG8_SCHED; PG8_LDA(At, 1, 0); PG8_STAGE(PG8_SA(0, 1), a2 + hstep, voffA);
            PG8_WAIT_V(8); PG8_WAIT_L(0); PG8_BAR; PG8_MMA(0, 0, At, B0); PG8_MMA(0, 1, At, B1); PG8_BAR; PG8_SCHED;
            PG8_LDA(At, 1, 1); PG8_STAGE(PG8_SB(1, 0), b3, voffB); PG8_STAGE(PG8_SB(1, 1), b3 + hstep, voffB); PG8_STAGE(PG8_SA(1, 0), a3, voffA);
            PG8_WAIT_V(8); PG8_WAIT_L(0); PG8_BAR; PG8_MMA(1, 0, At, B0); PG8_MMA(1, 1, At, B1); PG8_BAR; PG8_SCHED;
            } else {
            PG8_LDB(B0, 0, 0); PG8_SCHED; PG8_LDA(At, 0, 0); PG8_STAGE(PG8_SA(1, 1), a1 + hstep, voffA);
            PG8_WAIT_L(8); PG8_BAR; PG8_WAIT_L(0); PG8_MMA(0, 0, At, B0); PG8_BAR; PG8_SCHED;
            PG8_LDB(B1, 0, 1); PG8_STAGE(PG8_SB(0, 0), b2, voffB);
            PG8_BAR; PG8_WAIT_L(0); PG8_MMA(0, 1, At, B1); PG8_BAR;
            PG8_LDA(At, 0, 1); PG8_STAGE(PG8_SA(0, 0), a2, voffA);
            PG8_BAR; PG8_WAIT_L(0); PG8_MMA(1, 0, At, B0); PG8_BAR; PG8_SCHED;
            PG8_STAGE(PG8_SB(0, 1), b2 + hstep, voffB);
            PG8_WAIT_V(6); PG8_BAR; PG8_MMA(1, 1, At, B1); PG8_BAR;
            PG8_LDB(B0, 1, 0); PG8_SCHED; PG8_LDA(At, 1, 0); PG8_STAGE(PG8_SA(0, 1), a2 + hstep, voffA);
            PG8_WAIT_L(8); PG8_BAR; PG8_WAIT_L(0); PG8_MMA(0, 0, At, B0); PG8_BAR; PG8_SCHED;
            PG8_LDB(B1, 1, 1); PG8_STAGE(PG8_SB(1, 0), b3, voffB);
            PG8_BAR; PG8_WAIT_L(0); PG8_MMA(0, 1, At, B1); PG8_BAR;
            PG8_LDA(At, 1, 1); PG8_STAGE(PG8_SA(1, 0), a3, voffA);
            PG8_BAR; PG8_WAIT_L(0); PG8_MMA(1, 0, At, B0); PG8_BAR; PG8_SCHED;
            PG8_STAGE(PG8_SB(1, 1), b3 + hstep, voffB);
            PG8_WAIT_V(6); PG8_BAR; PG8_MMA(1, 1, At, B1); PG8_BAR;
            }
        }
        if constexpr (ALIGN_EPI) { if (wr == 0) PG8_BAR; }
        if constexpr (!Epi::AFTER_DRAIN) { E(acc, cur, wr, wc, fr, fq); S.done(cur); }
        if (!has_next) break;
#pragma unroll
        for (int a = 0; a < 2; ++a)
#pragma unroll
            for (int b = 0; b < 2; ++b)
#pragma unroll
                for (int m = 0; m < 4; ++m)
#pragma unroll
                    for (int n = 0; n < 2; ++n) acc[a][b][m][n] = (f32x4){0.f, 0.f, 0.f, 0.f};
        cur = nxt; cA = nA; cB = nB; ++ui;
        if constexpr (ALIGN_EPI) { if (wr == 1) PG8_BAR; }
    }
    PG8_WAIT_V(0);
    if constexpr (!ALIGN_EPI) { if (wr == 0) PG8_BAR; }
    PG8_BAR;
    if constexpr (Epi::AFTER_DRAIN) { E.fused(acc, cur, wr, wc, fr, fq, lds, wid, lane); S.done(cur); }
#undef PG8_SA
#undef PG8_SB
#undef PG8_STAGE
#undef PG8_LDA
#undef PG8_LDB
#undef PG8_MMA
#undef PG8_WAIT_V
#undef PG8_WAIT_L
#undef PG8_BAR
#undef PG8_SCHED
}
}

namespace pg8 {
typedef unsigned u32x2 __attribute__((ext_vector_type(2)));
typedef float f32x2 __attribute__((ext_vector_type(2)));
__device__ __forceinline__ void rows_rstd(float (&rs)[2][4], const float* ssq, int pm, int wr, int fr, int fq) {
    f32x4 pa[2][4], pb[2][4];
    const float* base = ssq + (size_t)(pm * BM + wr * 64 + fr) * 32 + fq * 8;
#pragma unroll
    for (int ai = 0; ai < 2; ++ai)
#pragma unroll
        for (int m = 0; m < 4; ++m) { pa[ai][m] = *(const f32x4*)(base + (ai * HALF + m * 16) * 32); pb[ai][m] = *(const f32x4*)(base + (ai * HALF + m * 16) * 32 + 4); }
#pragma unroll
    for (int ai = 0; ai < 2; ++ai)
#pragma unroll
        for (int m = 0; m < 4; ++m) { const f32x4 a = pa[ai][m], b = pb[ai][m];
            float s = ((a[0] + a[1]) + (a[2] + a[3])) + ((b[0] + b[1]) + (b[2] + b[3]));
            s += __shfl_xor(s, 16); s += __shfl_xor(s, 32);
            rs[ai][m] = __builtin_amdgcn_rsqf(s * (1.0f / 2048.0f) + 1e-6f); }
}
__device__ __forceinline__ f32x4 to_rowmajor(f32x4 v, int pidx) {
    f32x4 o; o[0] = __int_as_float(__builtin_amdgcn_ds_bpermute(pidx, __float_as_int(v[0]))); o[1] = __int_as_float(__builtin_amdgcn_ds_bpermute(pidx, __float_as_int(v[1])));
    o[2] = __int_as_float(__builtin_amdgcn_ds_bpermute(pidx, __float_as_int(v[2]))); o[3] = __int_as_float(__builtin_amdgcn_ds_bpermute(pidx, __float_as_int(v[3]))); return o;
}
__device__ __forceinline__ int rowmajor_pidx(int lane) { return (((lane & 3) << 4) | (lane >> 2)) << 2; }
__device__ __forceinline__ void rows_rstd_rm(float (&rs)[2][4], const float* ssq, int pm, int wr, int r2, int c2) {
    f32x4 pa[2][4], pb[2][4];
    const float* base = ssq + (size_t)(pm * BM + wr * 64 + r2) * 32 + c2 * 8;
#pragma unroll
    for (int ai = 0; ai < 2; ++ai)
#pragma unroll
        for (int m = 0; m < 4; ++m) { pa[ai][m] = *(const f32x4*)(base + (ai * HALF + m * 16) * 32); pb[ai][m] = *(const f32x4*)(base + (ai * HALF + m * 16) * 32 + 4); }
#pragma unroll
    for (int ai = 0; ai < 2; ++ai)
#pragma unroll
        for (int m = 0; m < 4; ++m) { const f32x4 a = pa[ai][m], b = pb[ai][m];
            float s = ((a[0] + a[1]) + (a[2] + a[3])) + ((b[0] + b[1]) + (b[2] + b[3]));
            s += __shfl_xor(s, 1); s += __shfl_xor(s, 2);
            rs[ai][m] = __builtin_amdgcn_rsqf(s * (1.0f / 2048.0f) + 1e-6f); }
}
__device__ __forceinline__ float row_rstd(const float* ssq, int row, int fq) {
    const f32x4 a = *(const f32x4*)(ssq + (size_t)row * 32 + fq * 8), b = *(const f32x4*)(ssq + (size_t)row * 32 + fq * 8 + 4);
    float s = ((a[0] + a[1]) + (a[2] + a[3])) + ((b[0] + b[1]) + (b[2] + b[3]));
    s += __shfl_xor(s, 16); s += __shfl_xor(s, 32);
    return __builtin_amdgcn_rsqf(s * (1.0f / 2048.0f) + 1e-6f);
}
struct EpiResid {
    static constexpr bool PERM = false, AFTER_DRAIN = false;
    float* X; bf16_t* XB; float* ssq;
    __device__ __forceinline__ void operator()(const f32x4 (&acc)[2][2][4][2], const Unit& u, int wr, int wc, int fr_, int fq_) const {
        const int lane = fq_ * 16 + fr_, r2 = lane >> 2, c2 = lane & 3, pidx = rowmajor_pidx(lane);
        const int row0 = u.pm * BM + wr * 64 + r2, col0 = u.pn * BM + wc * 32 + 4 * c2;
        u32x2 v[4][2][2];
#define EPR_LOAD(g) do { const size_t off_ = (size_t)(row0 + ((g) >> 2) * HALF + ((g) & 3) * 16) * 2048 + col0; _Pragma("unroll") for (int bj = 0; bj < 2; ++bj) _Pragma("unroll") for (int n = 0; n < 2; ++n) \
            v[(g) & 3][bj][n] = *(const u32x2*)(XB + off_ + bj * HALF + n * 16); } while (0)
        EPR_LOAD(0); EPR_LOAD(1); EPR_LOAD(2);
#pragma unroll
        for (int g = 0; g < 8; ++g) { const int ai = g >> 2, m = g & 3; const int row = row0 + ai * HALF + m * 16; const size_t off = (size_t)row * 2048 + col0; float s = 0.f;
            if (g + 3 < 8) EPR_LOAD(g + 3);
#pragma unroll
            for (int bj = 0; bj < 2; ++bj)
#pragma unroll
                for (int n = 0; n < 2; ++n) { const u32x2 xo = v[g & 3][bj][n];
                    const f32x4 x = (f32x4){__uint_as_float(xo.x << 16), __uint_as_float(xo.x & 0xffff0000u), __uint_as_float(xo.y << 16), __uint_as_float(xo.y & 0xffff0000u)} + to_rowmajor(acc[ai][bj][m][n], pidx);
                    if (X != nullptr) *(f32x4*)(X + off + bj * HALF + n * 16) = x;
                    u32x2 w; w.x = cvt_pk_bf16(x[0], x[1]); w.y = cvt_pk_bf16(x[2], x[3]); *(u32x2*)(XB + off + bj * HALF + n * 16) = w;
                    s += (x[0] * x[0] + x[1] * x[1]) + (x[2] * x[2] + x[3] * x[3]); }
            s += __shfl_xor(s, 1); s += __shfl_xor(s, 2);
            if (c2 == 0) ssq[(size_t)row * 32 + u.pn * 4 + wc] = s;
            asm volatile("" ::: "memory"); }
#undef EPR_LOAD
    }
};
struct EpiSwiglu {
    static constexpr bool PERM = true, AFTER_DRAIN = false;
    bf16_t* H; int ldh; const float* ssq;
    __device__ __forceinline__ void operator()(const f32x4 (&acc)[2][2][4][2], const Unit& u, int wr, int wc, int fr_, int fq_) const {
        const int lane = fq_ * 16 + fr_, r2 = lane >> 2, c2 = lane & 3, pidx = rowmajor_pidx(lane);
        const int row0 = u.pm * BM + wr * 64 + r2, col0 = u.pn * HALF + wc * 32 + 8 * c2;
        f32x4 pa[2][4], pb[2][4];
        { const float* base = ssq + (size_t)(u.pm * BM + wr * 64 + r2) * 32 + c2 * 8;
#pragma unroll
          for (int ai = 0; ai < 2; ++ai)
#pragma unroll
            for (int m = 0; m < 4; ++m) { pa[ai][m] = *(const f32x4*)(base + (ai * HALF + m * 16) * 32); pb[ai][m] = *(const f32x4*)(base + (ai * HALF + m * 16) * 32 + 4); } }
        __builtin_amdgcn_sched_barrier(0);
        f32x4 rm[2][2][4][2];
#pragma unroll
        for (int ai = 0; ai < 2; ++ai)
#pragma unroll
            for (int bj = 0; bj < 2; ++bj)
#pragma unroll
                for (int m = 0; m < 4; ++m)
#pragma unroll
                    for (int n = 0; n < 2; ++n) rm[ai][bj][m][n] = to_rowmajor(acc[ai][bj][m][n], pidx);
        __builtin_amdgcn_sched_barrier(0);
        float rs[2][4];
#pragma unroll
        for (int ai = 0; ai < 2; ++ai)
#pragma unroll
            for (int m = 0; m < 4; ++m) { const f32x4 a = pa[ai][m], b = pb[ai][m];
                float sq = ((a[0] + a[1]) + (a[2] + a[3])) + ((b[0] + b[1]) + (b[2] + b[3]));
                sq += __shfl_xor(sq, 1); sq += __shfl_xor(sq, 2);
                rs[ai][m] = __builtin_amdgcn_rsqf(sq * (1.0f / 2048.0f) + 1e-6f); }
#pragma unroll
        for (int ai = 0; ai < 2; ++ai)
#pragma unroll
            for (int m = 0; m < 4; ++m) { const float r = rs[ai][m], c1 = -1.4426950408889634f * r, ms = __builtin_amdgcn_rcpf(r * r); float hv[8];
#pragma unroll
                for (int n = 0; n < 2; ++n) { const f32x4 gv = rm[ai][0][m][n], uv = rm[ai][1][m][n];
#pragma unroll
                    for (int i = 0; i < 4; i += 2) {
                        const f32x2 g2 = (f32x2){gv[i], gv[i + 1]}, u2 = (f32x2){uv[i], uv[i + 1]}; const f32x2 t2 = g2 * c1;
                        f32x2 e2; e2.x = __builtin_amdgcn_exp2f(t2.x); e2.y = __builtin_amdgcn_exp2f(t2.y);
                        const f32x2 d2 = e2 * ms + ms; f32x2 s2; s2.x = __builtin_amdgcn_rcpf(d2.x); s2.y = __builtin_amdgcn_rcpf(d2.y);
                        const f32x2 h2 = (g2 * u2) * s2; hv[4 * n + i] = h2.x; hv[4 * n + i + 1] = h2.y; } }
                u32x4 w; w.x = cvt_pk_bf16(hv[0], hv[1]); w.y = cvt_pk_bf16(hv[2], hv[3]); w.z = cvt_pk_bf16(hv[4], hv[5]); w.w = cvt_pk_bf16(hv[6], hv[7]);
                *(u32x4*)(H + (size_t)(row0 + ai * HALF + m * 16) * ldh + col0) = w; }
    }
};
struct EpiQKV {
    static constexpr bool PERM = true, AFTER_DRAIN = false;
    const float* ssq; const float* gq; const float* gk;
    bf16_t* QP; size_t pstride;
    bf16_t* QS; bf16_t* KS; size_t sstride; int srows, lc;
    float* okp; size_t opstride; float* oks; size_t osstride;
    int fox;
    PG8_LAS float* red;
    __device__ __forceinline__ void operator()(const f32x4 (&acc)[2][2][4][2], const Unit& u, int wr, int wc, int fr_, int fq_) const {
        int fr = fr_, fq = fq_; asm volatile("" : "+v"(fr), "+v"(fq));
        const int which = u.pn >> 3, head0 = (u.pn & 7) * 2;
        const int lane_ = fq_ * 16 + fr_, r2 = lane_ >> 2, c2 = lane_ & 3, pidx = rowmajor_pidx(lane_);
        float rsv[2][4]; rows_rstd_rm(rsv, ssq, u.pm, wr, r2, c2);
        if (which < 2) {
#pragma unroll
            for (int ai = 0; ai < 2; ++ai)
#pragma unroll
                for (int m = 0; m < 4; ++m)
#pragma unroll
                    for (int bj = 0; bj < 2; ++bj) { float s = 0.f;
#pragma unroll
                        for (int n = 0; n < 2; ++n) { const f32x4 x = acc[ai][bj][m][n]; s += (x[0] * x[0] + x[1] * x[1]) + (x[2] * x[2] + x[3] * x[3]); }
                        s += __shfl_xor(s, 16); s += __shfl_xor(s, 32);
                        if (fq == 0) red[(wc * 256 + ai * HALF + wr * 64 + m * 16 + fr) * 2 + bj] = s; }
            asm volatile("s_waitcnt lgkmcnt(0)" ::: "memory"); __builtin_amdgcn_s_barrier(); asm volatile("" ::: "memory");
        }
        const int cih = wc * 32 + 8 * c2;
        f32x4 g0 = (f32x4){1.f, 1.f, 1.f, 1.f}, g1 = g0;
        if (which < 2) { const float* g = (which == 0 ? gq : gk) + cih; g0 = *(const f32x4*)g; g1 = *(const f32x4*)(g + 4); }
        const bool samp = u.pm >= 64;
        const bool f32out = which > 0 && (samp || fox || (u.pm & 31) >= 30);
        char* b16; char* b32 = nullptr; unsigned hs16, rowsz = 0;
        if (!samp) { const int bb = u.pm >> 5;
            b16 = (char*)(QP + (size_t)which * pstride + (size_t)(bb * 16 + head0) * (8192 * 128)); hs16 = 8192 * 128 * 2;
            if (f32out) b32 = (char*)(okp + (size_t)(which - 1) * opstride + (fox ? (size_t)bb * 8192 * 2048 : (size_t)bb * 512 * 2048) + head0 * 128);
        } else { rowsz = (which == 0) ? 16u : (unsigned)srows;
            b16 = (which == 0) ? (char*)QS : (char*)(KS + (size_t)(which == 2 ? 1 : 0) * sstride + (size_t)lc * 128); hs16 = rowsz * 256u;
            if (f32out) b32 = (char*)(oks + (size_t)(which - 1) * osstride + head0 * 128); }
        const int trow0 = samp ? 0 : ((u.pm & 31) * 256 - ((fox || !f32out) ? 0 : 7680));
#pragma unroll
        for (int ai = 0; ai < 2; ++ai)
#pragma unroll
            for (int m = 0; m < 4; ++m) { const int rit = ai * HALF + wr * 64 + m * 16 + r2;
                const float rs = rsv[ai][m];
                unsigned o16;
                if (!samp) o16 = (unsigned)((((u.pm & 31) * 256 + rit) * 128 + cih) * 2);
                else o16 = (unsigned)(((((rit >> 4) * 16 + head0) * rowsz + (rit & 15)) * 128 + cih) * 2);
                const unsigned o32 = (unsigned)(((trow0 + rit) * 2048 + cih) * 4);
#pragma unroll
                for (int bj = 0; bj < 2; ++bj) { float sc = rs;
                    if (which < 2) { const int ri = rit * 2 + bj; const float t = (red[ri] + red[512 + ri]) + (red[1024 + ri] + red[1536 + ri]);
                        sc = rs * __builtin_amdgcn_rsqf(t * rs * rs * (1.0f / 128.0f) + 1e-6f); }
                    const f32x4 x0 = to_rowmajor(acc[ai][bj][m][0], pidx) * sc * g0, x1 = to_rowmajor(acc[ai][bj][m][1], pidx) * sc * g1;
                    u32x4 w; w.x = cvt_pk_bf16(x0[0], x0[1]); w.y = cvt_pk_bf16(x0[2], x0[3]); w.z = cvt_pk_bf16(x1[0], x1[1]); w.w = cvt_pk_bf16(x1[2], x1[3]);
                    *(u32x4*)(b16 + (size_t)(o16 + (unsigned)bj * hs16)) = w;
                    if (f32out) { float* fo = (float*)(b32 + (size_t)(o32 + (unsigned)bj * 512u)); __builtin_nontemporal_store(x0, (f32x4*)fo); __builtin_nontemporal_store(x1, (f32x4*)(fo + 4)); } }
                asm volatile("" ::: "memory"); }
    }
};
}

namespace sk {
typedef short bf16x8 __attribute__((ext_vector_type(8)));
typedef float f32x4 __attribute__((ext_vector_type(4)));
typedef unsigned u32x2 __attribute__((ext_vector_type(2)));
typedef unsigned u32x4 __attribute__((ext_vector_type(4)));
typedef unsigned short bf16_t;
#define SLAS __attribute__((address_space(3)))
__device__ __forceinline__ unsigned cvtpk(float lo, float hi) { unsigned r; asm volatile("v_cvt_pk_bf16_f32 %0, %1, %2" : "=v"(r) : "v"(lo), "v"(hi)); return r; }
__device__ __forceinline__ float row_rstd(const float* ssq, int row, int fq) {
    const f32x4 a = *(const f32x4*)(ssq + (size_t)row * 32 + fq * 8), b = *(const f32x4*)(ssq + (size_t)row * 32 + fq * 8 + 4);
    float s = ((a[0] + a[1]) + (a[2] + a[3])) + ((b[0] + b[1]) + (b[2] + b[3]));
    s += __shfl_xor(s, 16); s += __shfl_xor(s, 32);
    return __builtin_amdgcn_rsqf(s * (1.0f / 2048.0f) + 1e-6f);
}
struct SkResid {
    static constexpr int MB = 2, NB = 2, NS = 6; static constexpr bool NEEDS_X = true;
    const float* xin; float* X; bf16_t* XB; float* ssq;
    __device__ __forceinline__ int brow(int ct, int ch, int n) const { return ct * 64 + ch * 32 + 16 * n; }
    __device__ __forceinline__ void partial(f32x4 (&acc)[MB][NB], int rt, int ct, int ch, int fr, int fq, SLAS float* red) const {
        f32x4 xo[MB][NB];
#pragma unroll
        for (int m = 0; m < MB; ++m)
#pragma unroll
            for (int n = 0; n < NB; ++n) xo[m][n] = *(const f32x4*)(xin + (size_t)(rt * 32 + 16 * m + fr) * 2048 + ct * 64 + ch * 32 + 16 * n + 4 * fq);
#pragma unroll
        for (int m = 0; m < MB; ++m) { float s = 0.f;
#pragma unroll
            for (int n = 0; n < NB; ++n) { const f32x4 x = xo[m][n] + acc[m][n]; acc[m][n] = x; s += (x[0] * x[0] + x[1] * x[1]) + (x[2] * x[2] + x[3] * x[3]); }
            s += __shfl_xor(s, 16); s += __shfl_xor(s, 32);
            if (fq == 0) red[ch * 32 + 16 * m + fr] = s; }
    }
    __device__ __forceinline__ void operator()(const f32x4 (&acc)[MB][NB], int rt, int ct, int ch, int fr, int fq, SLAS float* red) const {
#pragma unroll
        for (int m = 0; m < MB; ++m) { const int r = rt * 32 + 16 * m + fr; const size_t off = (size_t)r * 2048 + ct * 64 + ch * 32 + 4 * fq;
#pragma unroll
            for (int n = 0; n < NB; ++n) { const f32x4 x = acc[m][n];
                *(f32x4*)(X + off + 16 * n) = x; u32x2 w; w.x = cvtpk(x[0], x[1]); w.y = cvtpk(x[2], x[3]); *(u32x2*)(XB + off + 16 * n) = w; }
            if (ch == 0 && fq == 0) ssq[(size_t)r * 32 + ct] = red[16 * m + fr] + red[32 + 16 * m + fr]; }
    }
};
struct SkSwiglu {
    static constexpr int MB = 4, NB = 4, NS = 3; static constexpr bool NEEDS_X = false;
    bf16_t* H; int ldh; const float* ssq;
    __device__ __forceinline__ int brow(int ct, int ch, int n) const { return 256 * (ct >> 1) + (ct & 1) * 64 + ch * 32 + (n >= 2 ? 128 + 16 * (n - 2) : 16 * n); }
    __device__ __forceinline__ void partial(f32x4 (&acc)[MB][NB], int, int, int, int, int, SLAS float*) const {}
    __device__ __forceinline__ void operator()(const f32x4 (&acc)[MB][NB], int rt, int ct, int ch, int fr, int fq, SLAS float* red) const {
        float rs[MB];
        { f32x4 pa[MB], pb[MB];
#pragma unroll
          for (int m = 0; m < MB; ++m) { const float* sp = ssq + (size_t)(rt * 64 + 16 * m + fr) * 32 + fq * 8; pa[m] = *(const f32x4*)sp; pb[m] = *(const f32x4*)(sp + 4); }
#pragma unroll
          for (int m = 0; m < MB; ++m) { float s = ((pa[m][0] + pa[m][1]) + (pa[m][2] + pa[m][3])) + ((pb[m][0] + pb[m][1]) + (pb[m][2] + pb[m][3]));
              s += __shfl_xor(s, 16); s += __shfl_xor(s, 32); rs[m] = __builtin_amdgcn_rsqf(s * (1.0f / 2048.0f) + 1e-6f); } }
#pragma unroll
        for (int m = 0; m < MB; ++m) { const int r = rt * 64 + 16 * m + fr;
#pragma unroll
            for (int n = 0; n < 2; ++n) { float hv[4];
#pragma unroll
                for (int i = 0; i < 4; ++i) { const float g = acc[m][n][i] * rs[m], up = acc[m][n + 2][i] * rs[m]; hv[i] = g * __builtin_amdgcn_rcpf(1.0f + __expf(-g)) * up; }
                u32x2 w; w.x = cvtpk(hv[0], hv[1]); w.y = cvtpk(hv[2], hv[3]);
                *(u32x2*)(H + (size_t)r * ldh + 128 * (ct >> 1) + (ct & 1) * 64 + ch * 32 + 16 * n + 4 * fq) = w; } }
    }
};
struct SkQKV {
    static constexpr int MB = 4, NB = 4, NS = 3; static constexpr bool NEEDS_X = true;
    const float* ssq; const float* gq; const float* gk;
    bf16_t* QS; bf16_t* KS; size_t sstride; int srows, lc;
    float* oks; size_t osstride;
    __device__ __forceinline__ int brow(int ct, int ch, int n) const { return ct * 128 + ch * 64 + 16 * n; }
    __device__ __forceinline__ void partial(f32x4 (&acc)[MB][NB], int, int, int ch, int fr, int fq, SLAS float* red) const {
#pragma unroll
        for (int m = 0; m < MB; ++m) { float s = 0.f;
#pragma unroll
            for (int n = 0; n < NB; ++n) { const f32x4 x = acc[m][n]; s += (x[0] * x[0] + x[1] * x[1]) + (x[2] * x[2] + x[3] * x[3]); }
            s += __shfl_xor(s, 16); s += __shfl_xor(s, 32);
            if (fq == 0) red[ch * 64 + 16 * m + fr] = s; }
    }
    __device__ __forceinline__ void operator()(const f32x4 (&acc)[MB][NB], int rt, int ct, int ch, int fr, int fq, SLAS float* red) const {
        const int which = ct >> 4, h = ct & 15;
        const float* g = (which == 0 ? gq : gk) + ch * 64 + 4 * fq;
        bf16_t* b16 = (which == 0) ? QS : KS + (size_t)(which == 2 ? 1 : 0) * sstride + (size_t)lc * 128; const int rowsz = (which == 0) ? 16 : srows;
        float* b32 = oks + (size_t)(which > 0 ? which - 1 : 0) * osstride + h * 128 + ch * 64 + 4 * fq;
        float rs[MB];
        { f32x4 pa[MB], pb[MB];
#pragma unroll
          for (int m = 0; m < MB; ++m) { const float* sp = ssq + (size_t)(rt * 64 + 16 * m + fr) * 32 + fq * 8; pa[m] = *(const f32x4*)sp; pb[m] = *(const f32x4*)(sp + 4); }
#pragma unroll
          for (int m = 0; m < MB; ++m) { float s = ((pa[m][0] + pa[m][1]) + (pa[m][2] + pa[m][3])) + ((pb[m][0] + pb[m][1]) + (pb[m][2] + pb[m][3]));
              s += __shfl_xor(s, 16); s += __shfl_xor(s, 32); rs[m] = __builtin_amdgcn_rsqf(s * (1.0f / 2048.0f) + 1e-6f); } }
#pragma unroll
        for (int m = 0; m < MB; ++m) { const int r = rt * 64 + 16 * m + fr; float sc = rs[m];
            if (which < 2) { const float s = red[16 * m + fr] + red[64 + 16 * m + fr]; sc = rs[m] * __builtin_amdgcn_rsqf(s * rs[m] * rs[m] * (1.0f / 128.0f) + 1e-6f); }
            bf16_t* d16 = b16 + ((size_t)((r >> 4) * 16 + h) * rowsz + (r & 15)) * 128 + ch * 64 + 4 * fq; float* d32 = b32 + (size_t)r * 2048;
#pragma unroll
            for (int n = 0; n < NB; ++n) { f32x4 x = acc[m][n] * sc; if (which < 2) x = x * *(const f32x4*)(g + 16 * n);
                u32x2 w; w.x = cvtpk(x[0], x[1]); w.y = cvtpk(x[2], x[3]); *(u32x2*)(d16 + 16 * n) = w;
                if (which > 0) *(f32x4*)(d32 + 16 * n) = x; } }
    }
};
template <class Epi>
__device__ __forceinline__ void skinny_phase(SLAS unsigned char* lds, const bf16_t* A, const bf16_t* Bt, int nct, int K, unsigned* qc  , int tid, const Epi& E) {
    constexpr int MB = Epi::MB, NB = Epi::NB, NS = Epi::NS, NRT = 16 / MB, SLOT = MB * NB * 1024;
    const int lane = tid & 63, wid = __builtin_amdgcn_readfirstlane(tid >> 6), fr = lane & 15, fq = lane >> 4, kq = wid & 3, ch = wid >> 2;
    const int kw = K >> 2;
    SLAS float* red = (SLAS float*)(lds + 4 * SLOT);
    for (;;) {
        volatile SLAS int* tw = (volatile SLAS int*)(lds + 67712);
        if (tid == 0) *tw = (int)__hip_atomic_fetch_add(qc, 1u, __ATOMIC_RELAXED, __HIP_MEMORY_SCOPE_AGENT);
        __syncthreads();
        const int tile = __builtin_amdgcn_readfirstlane(*tw);
        if (tile >= NRT * nct) break;
        const int rt = tile % NRT, ct = tile / NRT;
        f32x4 acc[MB][NB];
#pragma unroll
        for (int m = 0; m < MB; ++m)
#pragma unroll
            for (int n = 0; n < NB; ++n) acc[m][n] = (f32x4){0.f, 0.f, 0.f, 0.f};
        const unsigned lo = (unsigned)(((lane >> 2) * K + kq * kw + (lane & 3) * 8) * 2);
        const int pidx = (((lane & 15) << 2) | (lane >> 4)) << 2;
        const char* ab = (const char*)(A + (size_t)(rt * 16 * MB) * K);
        const char* bb[NB];
#pragma unroll
        for (int n = 0; n < NB; ++n) bb[n] = (const char*)(Bt + (size_t)E.brow(ct, ch, n) * K);
        bf16x8 fa[NS][MB], fb[NS][NB];
#define SK_LOAD(st, ks) do { const unsigned o_ = lo + (unsigned)((ks) * 2); _Pragma("unroll") for (int m = 0; m < MB; ++m) fa[st][m] = *(const bf16x8*)(ab + (size_t)(o_ + (unsigned)(16 * m * K * 2))); \
            _Pragma("unroll") for (int n = 0; n < NB; ++n) fb[st][n] = *(const bf16x8*)(bb[n] + (size_t)o_); } while (0)
#define SK_PERM(v) do { u32x4 w_ = __builtin_bit_cast(u32x4, v); w_.x = (unsigned)__builtin_amdgcn_ds_bpermute(pidx, (int)w_.x); w_.y = (unsigned)__builtin_amdgcn_ds_bpermute(pidx, (int)w_.y); \
            w_.z = (unsigned)__builtin_amdgcn_ds_bpermute(pidx, (int)w_.z); w_.w = (unsigned)__builtin_amdgcn_ds_bpermute(pidx, (int)w_.w); v = __builtin_bit_cast(bf16x8, w_); } while (0)
#define SK_MMA(st) do { _Pragma("unroll") for (int m = 0; m < MB; ++m) SK_PERM(fa[st][m]); _Pragma("unroll") for (int n = 0; n < NB; ++n) SK_PERM(fb[st][n]); \
            _Pragma("unroll") for (int m = 0; m < MB; ++m) _Pragma("unroll") for (int n = 0; n < NB; ++n) acc[m][n] = __builtin_amdgcn_mfma_f32_16x16x32_bf16(fb[st][n], fa[st][m], acc[m][n], 0, 0, 0); } while (0)
#define SK_SB() __builtin_amdgcn_sched_barrier(0)
        const int nst = kw >> 5, kl = kw - 32;
#pragma unroll
        for (int j = 0; j < NS - 1; ++j) { SK_LOAD(j, (j * 32 < kw ? j * 32 : kl)); SK_SB(); }
        for (int s0 = 0; s0 < nst; s0 += NS) {
#pragma unroll
            for (int j = 0; j < NS; ++j) { const int kn = (s0 + j + NS - 1) * 32; SK_LOAD((j + NS - 1) % NS, kn < kw ? kn : kl); SK_SB(); if (s0 + j < nst) SK_MMA(j); SK_SB(); }
        }
#undef SK_SB
#undef SK_LOAD
#undef SK_MMA
#undef SK_PERM
#pragma unroll
        for (int half = 2; half >= 1; half >>= 1) {
            if (kq >= half && kq < 2 * half) { SLAS f32x4* s = (SLAS f32x4*)(lds + (ch * 2 + kq - half) * SLOT) + lane;
#pragma unroll
                for (int m = 0; m < MB; ++m)
#pragma unroll
                    for (int n = 0; n < NB; ++n) s[(m * NB + n) * 64] = acc[m][n]; }
            __syncthreads();
            if (kq < half) { const SLAS f32x4* s = (const SLAS f32x4*)(lds + (ch * 2 + kq) * SLOT) + lane;
#pragma unroll
                for (int m = 0; m < MB; ++m)
#pragma unroll
                    for (int n = 0; n < NB; ++n) acc[m][n] = acc[m][n] + s[(m * NB + n) * 64]; }
            __syncthreads();
        }
        if constexpr (Epi::NEEDS_X) { if (kq == 0) E.partial(acc, rt, ct, ch, fr, fq, red); __syncthreads(); }
        if (kq == 0) E(acc, rt, ct, ch, fr, fq, red);
        if constexpr (Epi::NEEDS_X) __syncthreads();
    }
}
}

namespace att {
typedef short bf16x8 __attribute__((ext_vector_type(8)));
typedef short s16x4 __attribute__((ext_vector_type(4)));
typedef float f32x16 __attribute__((ext_vector_type(16)));
typedef float f32x4 __attribute__((ext_vector_type(4)));
typedef unsigned u32x4 __attribute__((ext_vector_type(4)));
typedef unsigned short bf16;
#define ALAS __attribute__((address_space(3)))
constexpr int D = 128, NW = 8, QBLK = 32, KVBLK = 64, QB = NW * QBLK;
constexpr int SHM_V = KVBLK * D * 2, SHM_K = KVBLK * D * 2;
constexpr int OFF_V = 0, OFF_K = 2 * SHM_V, OFF_WS = 2 * SHM_V + 2 * SHM_K, OFF_TAB = OFF_WS + NW * 64 * 4, OFF_BIAS = OFF_TAB + 1024, LDS_END = OFF_BIAS + 8192 * 4 + 512;
constexpr float SCALE = 0.08838834764831845f, RSCALE = 11.313708498984761f;
constexpr float THR = 8.f;
#define KSWZ(row, colB) ((row) * 256 + ((colB) ^ (((row) & 7) << 4)))
#define SBAR() __builtin_amdgcn_sched_barrier(0)
__device__ __forceinline__ int v_st(int k, int c) { const int kk = (k & ~0xC) | ((k & 4) << 1) | ((k & 8) >> 1); return ((kk >> 3) * 4 + (c >> 5)) * 512 + ((kk & 7) * 32 + (c & 31)) * 2; }
__device__ __forceinline__ int v_rd_base(int lane) { return ((lane & 3) << 3) | (((lane >> 2) & 3) << 6) | (((lane >> 4) & 1) << 5) | (((lane >> 5) & 1) << 8); }
constexpr int v_rd_off(int d0, int ks, int half) { return d0 * 512 + ks * 4096 + half * 2048; }
__device__ __forceinline__ int crow(int r, int hi) { return (r & 3) + 8 * (r >> 2) + 4 * hi; }
__device__ __forceinline__ unsigned cvtpk(float lo, float hi) { unsigned r; asm volatile("v_cvt_pk_bf16_f32 %0, %1, %2" : "=v"(r) : "v"(lo), "v"(hi)); return r; }
__device__ __forceinline__ bf16x8 load8(const bf16* p) { return *reinterpret_cast<const bf16x8*>(p); }
__device__ __forceinline__ void mask_tile(f32x16& p0, f32x16& p1, int dq) {
    const float NEG = -__builtin_inff();
#pragma unroll
    for (int r = 0; r < 16; ++r) {
        const int c = (r & 3) + 8 * (r >> 2);
        if (dq - c < 0) p0[r] = NEG;
        if (dq - c - 32 < 0) p1[r] = NEG;
    }
}
__device__ __forceinline__ void partialSM(f32x16& p0, f32x16& p1, float& m_reg, float& mn, float& alpha) {
    float pmax = p0[0]; for (int r = 1; r < 16; ++r) pmax = fmaxf(pmax, p0[r]); for (int r = 0; r < 16; ++r) pmax = fmaxf(pmax, p1[r]);
    { auto rr = __builtin_amdgcn_permlane32_swap(__float_as_uint(pmax), __float_as_uint(pmax), false, false);
      pmax = fmaxf(__uint_as_float(rr[0]), __uint_as_float(rr[1])); }
    constexpr float C2 = 1.4426950408889634f * SCALE;
    if (__builtin_expect(__all((pmax - m_reg) * SCALE <= THR), 1)) { mn = m_reg; alpha = 1.f; }
    else { mn = fmaxf(m_reg, pmax); alpha = __builtin_amdgcn_exp2f((m_reg - mn) * C2); m_reg = mn; }
    const float mnL = -mn * C2;
    for (int r = 0; r < 16; ++r) p0[r] = fmaf(p0[r], C2, mnL); for (int r = 0; r < 16; ++r) p1[r] = fmaf(p1[r], C2, mnL);
    for (int r = 0; r < 16; ++r) p0[r] = __builtin_amdgcn_exp2f(p0[r]);
}
__device__ __forceinline__ void finishSM(f32x16& p0, f32x16& p1, float alpha, float& l_reg, bf16x8& pa0, bf16x8& pa1, bf16x8& pa2, bf16x8& pa3) {
    for (int r = 0; r < 16; ++r) p1[r] = __builtin_amdgcn_exp2f(p1[r]);
    float ps = 0; for (int r = 0; r < 16; ++r) ps += p0[r]; for (int r = 0; r < 16; ++r) ps += p1[r];
    { auto rr = __builtin_amdgcn_permlane32_swap(__float_as_uint(ps), __float_as_uint(ps), false, false);
      ps = __uint_as_float(rr[0]) + __uint_as_float(rr[1]); }
    l_reg = l_reg * alpha + ps;
#define PK4(P, B_, OUT) do { unsigned a0 = cvtpk(P[B_+0], P[B_+1]), a1 = cvtpk(P[B_+2], P[B_+3]);                          \
        unsigned b0 = cvtpk(P[B_+4], P[B_+5]), b1 = cvtpk(P[B_+6], P[B_+7]);                                             \
        auto r0 = __builtin_amdgcn_permlane32_swap(a0, b0, false, false); auto r1 = __builtin_amdgcn_permlane32_swap(a1, b1, false, false); \
        u32x4 w = {r0[0], r1[0], r0[1], r1[1]}; OUT = *reinterpret_cast<bf16x8*>(&w); } while (0)
    PK4(p0, 0, pa0); PK4(p0, 8, pa1); PK4(p1, 0, pa2); PK4(p1, 8, pa3);
#undef PK4
}
struct Blk {
    const bf16* Q; const bf16* K; const bf16* V; bf16* O;
    const float* aux;
    int P0;
    int jlo, jhi;
    int cap;
    int c0;
    float skipthr;
};
struct Nxt { const bf16* Q; const bf16* K; const bf16* V; int jlo; };
constexpr int OSTR = 2048;
struct Seam { bf16x8 qr[8]; bf16x8 st_v0, st_v1, st_k0, st_k1; };

template <int MODE, int KB>
__device__ __forceinline__ void qkt(f32x16& p0, f32x16& p1, ALAS const char* lds, int r32, int hi, const bf16x8* qr, bool act, int tile  , int dist  , int irow  ) {
    if (!act) { const float NEG = -__builtin_inff();
#pragma unroll
        for (int r = 0; r < 16; ++r) { p0[r] = NEG; p1[r] = NEG; } return; }
    if constexpr (MODE == 1) {
        ALAS const float* bp = (ALAS const float*)(lds + OFF_BIAS) + tile * 64 + 4 * hi;
#pragma unroll
        for (int i = 0; i < 4; ++i) { const f32x4 a = *(ALAS const f32x4*)(bp + 8 * i), b = *(ALAS const f32x4*)(bp + 32 + 8 * i);
            p0[4 * i] = a[0]; p0[4 * i + 1] = a[1]; p0[4 * i + 2] = a[2]; p0[4 * i + 3] = a[3]; p1[4 * i] = b[0]; p1[4 * i + 1] = b[1]; p1[4 * i + 2] = b[2]; p1[4 * i + 3] = b[3]; }
    } else {
        ALAS const float* R = (ALAS const float*)(lds + OFF_TAB);
        if (dist <= 2) { ALAS const float* rp = R + (191 - 64 * dist - irow + 4 * hi);
#pragma unroll
            for (int r = 0; r < 16; ++r) { p0[r] = rp[(r & 3) + 8 * (r >> 2)]; p1[r] = rp[32 + (r & 3) + 8 * (r >> 2)]; } }
        else { const float cf = R[0];
#pragma unroll
            for (int r = 0; r < 16; ++r) { p0[r] = cf; p1[r] = cf; } }
    }
    ALAS const char* K_lds = lds + OFF_K;
    ALAS const char* kb[4];
#pragma unroll
    for (int dd = 0; dd < 4; ++dd) kb[dd] = K_lds + KB * SHM_K + KSWZ(r32, (dd * 16 + hi * 8) * 2);
#pragma unroll
    for (int d0 = 0; d0 < 8; ++d0) { ALAS const char* a = kb[d0 & 3] + (d0 >> 2) * 128;
        bf16x8 b0 = *reinterpret_cast<ALAS const bf16x8*>(a);
        bf16x8 b1 = *reinterpret_cast<ALAS const bf16x8*>(a + 32 * 256);
        p0 = __builtin_amdgcn_mfma_f32_32x32x16_bf16(b0, qr[d0], p0, 0, 0, 0);
        p1 = __builtin_amdgcn_mfma_f32_32x32x16_bf16(b1, qr[d0], p1, 0, 0, 0); }
}
template <int MODE, int VB>
__device__ __forceinline__ void pv_tile(f32x16* o, int vb0, bf16x8 pa0, bf16x8 pa1, bf16x8 pa2, bf16x8 pa3, bool act) {
    if (!act) return;
#define TRRD(dst, off) asm volatile("ds_read_b64_tr_b16 %0, %1 offset:%2" : "=&v"(dst) : "v"(vb0), "i"(off) : "memory")
#define PV_D0(d0) do { s16x4 l0, l1, l2, l3, h0, h1, h2, h3; constexpr int b_ = VB * SHM_V + v_rd_off(d0, 0, 0); \
        TRRD(l0, b_); TRRD(h0, b_ + 2048); TRRD(l1, b_ + 4096); TRRD(h1, b_ + 6144); TRRD(l2, b_ + 8192); TRRD(h2, b_ + 10240); TRRD(l3, b_ + 12288); TRRD(h3, b_ + 14336); \
        asm volatile("s_waitcnt lgkmcnt(0)" ::: "memory"); SBAR();   \
        o[d0] = __builtin_amdgcn_mfma_f32_32x32x16_bf16(pa0, (bf16x8){l0[0], l0[1], l0[2], l0[3], h0[0], h0[1], h0[2], h0[3]}, o[d0], 0, 0, 0);   \
        o[d0] = __builtin_amdgcn_mfma_f32_32x32x16_bf16(pa1, (bf16x8){l1[0], l1[1], l1[2], l1[3], h1[0], h1[1], h1[2], h1[3]}, o[d0], 0, 0, 0);   \
        o[d0] = __builtin_amdgcn_mfma_f32_32x32x16_bf16(pa2, (bf16x8){l2[0], l2[1], l2[2], l2[3], h2[0], h2[1], h2[2], h2[3]}, o[d0], 0, 0, 0);   \
        o[d0] = __builtin_amdgcn_mfma_f32_32x32x16_bf16(pa3, (bf16x8){l3[0], l3[1], l3[2], l3[3], h3[0], h3[1], h3[2], h3[3]}, o[d0], 0, 0, 0); } while (0)
    PV_D0(0); PV_D0(1); PV_D0(2); PV_D0(3);
#undef PV_D0
#undef TRRD
}
#define AROW(p, k0, rr) ((const bf16*)((const char*)(p) + (size_t)(unsigned)(((k0) + (rr)) * (D * 2) + sc * 2)))
#define VMW() asm volatile("s_waitcnt vmcnt(0)" ::: "memory")
#define VMWN(n) asm volatile("s_waitcnt vmcnt(%0)" :: "i"(n) : "memory")
#define SLOAD_H(Kp, Vp, k0) do { S.st_v0 = load8(AROW(Vp, k0, sr)); S.st_v1 = load8(AROW(Vp, k0, 32 + sr));              \
                         S.st_k0 = load8(AROW(Kp, k0, sr)); S.st_k1 = load8(AROW(Kp, k0, 32 + sr)); } while (0)
#define SWRITE_HK(bf) do { *(ALAS bf16x8*)(K_lds + (bf) * SHM_K + kws) = S.st_k0; *(ALAS bf16x8*)(K_lds + (bf) * SHM_K + kws + 32 * 256) = S.st_k1; } while (0)
#define SWRITE_HV(bf) do { *(ALAS bf16x8*)(V_lds + (bf) * SHM_V + vst0) = S.st_v0; *(ALAS bf16x8*)(V_lds + (bf) * SHM_V + vst1) = S.st_v1; } while (0)
#define SWRITE_H(bf) do { SWRITE_HV(bf); SWRITE_HK(bf); } while (0)
template <int MODE>
__device__ __forceinline__ float build_bias(const Blk& b, ALAS char* lds, int tid) {
    asm volatile("" : "+v"(tid));
    if constexpr (MODE == 0) {
        if (tid < 256) { int d = 191 - tid; d = d < -128 ? -128 : (d > 128 ? 128 : d); ((ALAS float*)(lds + OFF_TAB))[tid] = b.aux[d + 128] * RSCALE; }
        return 0.f;
    } else {
        const int nk = b.jhi * 64, nv = b.cap + 1, e0 = tid * 16, lane = tid & 63, wid = tid >> 6;
        float v[16];
#pragma unroll
        for (int i = 0; i < 4; ++i) { f32x4 x = (f32x4){0.f, 0.f, 0.f, 0.f};
            if (e0 + 4 * i < nv) x = *(const f32x4*)(b.aux + e0 + 4 * i);
            v[4 * i] = x[0]; v[4 * i + 1] = x[1]; v[4 * i + 2] = x[2]; v[4 * i + 3] = x[3]; }
        float run = 0.f;
#pragma unroll
        for (int i = 15; i >= 0; --i) { const float x = v[i]; v[i] = run; run += x; }
        float incl = run;
#pragma unroll
        for (int o = 1; o < 64; o <<= 1) { const float t = __int_as_float(__builtin_amdgcn_ds_bpermute(((lane + o) & 63) << 2, __float_as_int(incl))); if (lane + o < 64) incl += t; }
        ALAS float* wt = (ALAS float*)(lds + OFF_TAB);
        if (lane == 0) wt[wid] = incl;
        asm volatile("s_waitcnt lgkmcnt(0)" ::: "memory"); __builtin_amdgcn_s_barrier(); asm volatile("" ::: "memory");
        float after = incl - run;
#pragma unroll
        for (int w = 1; w < 8; ++w) { const float t = wt[w]; if (w > wid) after += t; }
        if (e0 < nk) { ALAS f32x4* o4 = (ALAS f32x4*)(lds + OFF_BIAS) + tid * 4;
#pragma unroll
            for (int i = 0; i < 4; ++i) o4[i] = (f32x4){(v[4 * i] + after) * RSCALE, (v[4 * i + 1] + after) * RSCALE, (v[4 * i + 2] + after) * RSCALE, (v[4 * i + 3] + after) * RSCALE}; }
        return after;
    }
}
template <int MODE>
__device__ __forceinline__ void attn_prime(const Blk& cur, ALAS char* lds, Seam& S, int tid) {
    asm volatile("" : "+v"(tid));
    const int wid = __builtin_amdgcn_readfirstlane(tid >> 6), lane = tid & 63, r32 = lane & 31, hi = lane >> 5;
    const int sr = tid >> 4, sc = (tid & 15) * 8, kws = KSWZ(sr, sc * 2); ALAS char* K_lds = lds + OFF_K;
    const int kb0 = cur.jlo * KVBLK;
    const int qrow = wid * QBLK + r32;
#pragma unroll
    for (int d0 = 0; d0 < 8; ++d0) S.qr[d0] = load8((const bf16*)((const char*)cur.Q + (size_t)(unsigned)(qrow * (D * 2) + hi * 16 + d0 * 32)));
    SLOAD_H(cur.K, cur.V, kb0); VMW(); SWRITE_HK(0);
    __syncthreads();
}
template <int MODE, class IssueFn, class NextFn>
__device__ __forceinline__ void attn_block(const Blk& cur, IssueFn&& issue_fn, NextFn&& next_fn, ALAS char* lds, Seam& S, int tid) {
    asm volatile("" : "+v"(tid));
    const int wid = __builtin_amdgcn_readfirstlane(tid >> 6), lane = tid & 63, r32 = lane & 31, hi = lane >> 5;
    bf16x8 kd[8];
    if constexpr (MODE == 1) { const char* kp = (const char*)cur.K + (size_t)(unsigned)((cur.P0 + wid * QBLK + r32) * (D * 2) + hi * 16);
#pragma unroll
        for (int d0 = 0; d0 < 8; ++d0) kd[d0] = load8((const bf16*)(kp + d0 * 32)); }
    const float s_end = build_bias<MODE>(cur, lds, tid);
    asm volatile("s_waitcnt lgkmcnt(0)" ::: "memory"); __syncthreads();
    int j_lo = cur.jlo;
    const int sr = tid >> 4, sc = (tid & 15) * 8, vst0 = v_st(sr, sc), vst1 = v_st(32 + sr, sc), kws = KSWZ(sr, sc * 2);
    ALAS char* V_lds = lds + OFF_V; ALAS char* K_lds = lds + OFF_K;
    if constexpr (MODE == 1) {
        float dsum = 0.f;
#pragma unroll
        for (int d0 = 0; d0 < 8; ++d0) { const u32x4 qa = *reinterpret_cast<const u32x4*>(&S.qr[d0]), ka = *reinterpret_cast<const u32x4*>(&kd[d0]);
#pragma unroll
            for (int i = 0; i < 4; ++i) { dsum = fmaf(__uint_as_float(qa[i] << 16), __uint_as_float(ka[i] << 16), dsum);
                dsum = fmaf(__uint_as_float(qa[i] & 0xffff0000u), __uint_as_float(ka[i] & 0xffff0000u), dsum); } }
        { auto rr = __builtin_amdgcn_permlane32_swap(__float_as_uint(dsum), __float_as_uint(dsum), false, false); dsum = __uint_as_float(rr[0]) + __uint_as_float(rr[1]); }
        float gv = (((ALAS const float*)(lds + OFF_BIAS))[cur.P0 + wid * QBLK + r32] + dsum) * SCALE;
#pragma unroll
        for (int o = 1; o < 32; o <<= 1) gv = fminf(gv, __shfl_xor(gv, o));
        ALAS float* wg = (ALAS float*)(lds + OFF_TAB) + 32;
        if (lane == 0) wg[wid] = gv;
        asm volatile("s_waitcnt lgkmcnt(0)" ::: "memory"); __builtin_amdgcn_s_barrier(); asm volatile("" ::: "memory");
        float G = wg[0];
#pragma unroll
        for (int w = 1; w < 8; ++w) G = fminf(G, wg[w]);
        const bool pred = ((tid & 3) == 3) && ((tid >> 2) < (cur.P0 >> 6)) && (s_end < G - cur.skipthr);
        const int cnt = __builtin_popcountll(__ballot(pred));
        ALAS int* wcnt = (ALAS int*)(lds + OFF_TAB) + 16;
        if (lane == 0) wcnt[wid] = cnt;
        asm volatile("s_waitcnt lgkmcnt(0)" ::: "memory"); __builtin_amdgcn_s_barrier(); asm volatile("" ::: "memory");
        int tot = 0;
#pragma unroll
        for (int w = 0; w < 8; ++w) tot += wcnt[w];
        j_lo = __builtin_amdgcn_readfirstlane(tot);
        if (j_lo != cur.jlo) {
            SLOAD_H(cur.K, cur.V, j_lo * KVBLK); VMW(); SWRITE_HK(0); }
        __syncthreads();
    }
    const int NT = cur.jhi - j_lo;
    const int wlim = cur.P0 + wid * QBLK;
    const int qm = wlim + r32 - 4 * hi;
    const int cw = cur.c0 + (wid >> 1);
    const int irow = (wid & 1) * 32 + r32;
    ALAS float* wsf = (ALAS float*)(lds + OFF_WS) + wid * 64; ALAS float* li_l = wsf; ALAS float* al_l = wsf + 32;
    float m_reg = -1e30f, l_reg = 0; f32x16 o[4] = {};
    const int vb0 = (int)(unsigned)(unsigned long long)V_lds + v_rd_base(lane);
    const bf16* Kh = cur.K; const bf16* Vh = cur.V;
#define RESC(a) do { if (__any((a) < 1.f)) { if (hi == 0) al_l[r32] = (a); asm volatile("s_waitcnt lgkmcnt(0)" ::: "memory");              \
                     for (int d_ = 0; d_ < 4; ++d_) for (int r = 0; r < 16; ++r) o[d_][r] *= al_l[crow(r, hi)]; } } while (0)
#define KBASE(t) ((j_lo + (t)) * KVBLK)
#define ACT(t) (MODE == 1 ? (KBASE(t) <= wlim + QBLK - 1) : ((j_lo + (t)) >= cw - 8 && (j_lo + (t)) <= cw))
#define MASKT(P0_, P1_, t) do { if (MODE == 1) { const int kb_ = KBASE(t); if (kb_ + KVBLK - 1 > wlim) mask_tile(P0_, P1_, qm - kb_); } } while (0)
#define QKT(KB, PX0, PX1, t) qkt<MODE, KB>(PX0, PX1, lds, r32, hi, S.qr, ACT(t), j_lo + (t), cw - (j_lo + (t)), irow)
    constexpr int NQL = 8;
#define SEAM_K0() do { VMWN(NQL); SWRITE_HK(0); SBAR(); } while (0)
    f32x16 pA0, pA1, pB0, pB1; float mnA, mnB, alA, alB; bf16x8 pa0, pa1, pa2, pa3;
    SWRITE_HV(0); SBAR();
    if (NT > 1) SLOAD_H(Kh, Vh, KBASE(1));
    SBAR(); QKT(0, pA0, pA1, 0);
    MASKT(pA0, pA1, 0); partialSM(pA0, pA1, m_reg, mnA, alA);
    if (NT > 1) { VMW(); SWRITE_H(1); }
    __syncthreads();
#define HALF_STEP(PX0, PX1, mnX, alX, PY0, PY1, alY, t, KB, VB, SB) do {                                                      \
        SBAR(); QKT(KB, PX0, PX1, t);                                                                                          \
        finishSM(PY0, PY1, alY, l_reg, pa0, pa1, pa2, pa3); SBAR();                                                           \
        if ((t) + 1 < NT) { SLOAD_H(Kh, Vh, KBASE((t) + 1)); SBAR(); }                                                        \
        pv_tile<MODE, VB>(o, vb0, pa0, pa1, pa2, pa3, ACT((t) - 1)); MASKT(PX0, PX1, (t)); partialSM(PX0, PX1, m_reg, mnX, alX);   \
        __syncthreads();                                                                                                      \
        if ((t) + 1 < NT) { VMW(); SWRITE_H(SB); }                                                                            \
        RESC(alX); __syncthreads(); } while (0)
    if (NT < 3) issue_fn();
    for (int t = 1; t + 1 < NT; t += 2) {
        if (t + 3 >= NT) issue_fn();
        HALF_STEP(pB0, pB1, mnB, alB, pA0, pA1, alA, t, 1, 0, 0);
        HALF_STEP(pA0, pA1, mnA, alA, pB0, pB1, alB, t + 1, 0, 1, 1);
    }
    Nxt nxt; next_fn(nxt);
    const int kbn = nxt.jlo * KVBLK;
    const bool even = (NT & 1) == 0;
    if (even) { SBAR(); QKT(1, pB0, pB1, NT - 1); SBAR(); }
    SLOAD_H(nxt.K, nxt.V, kbn); SBAR();
    { const int qrow = wid * QBLK + r32;
#pragma unroll
      for (int d0 = 0; d0 < 8; ++d0) S.qr[d0] = load8((const bf16*)((const char*)nxt.Q + (size_t)(unsigned)(qrow * (D * 2) + hi * 16 + d0 * 32))); }
    SBAR();
    finishSM(pA0, pA1, alA, l_reg, pa0, pa1, pa2, pa3); SBAR();
    pv_tile<MODE, 0>(o, vb0, pa0, pa1, pa2, pa3, ACT(even ? NT - 2 : NT - 1));
    if (even) { MASKT(pB0, pB1, NT - 1); partialSM(pB0, pB1, m_reg, mnB, alB); __syncthreads(); RESC(alB);
        finishSM(pB0, pB1, alB, l_reg, pa0, pa1, pa2, pa3); SBAR(); pv_tile<MODE, 1>(o, vb0, pa0, pa1, pa2, pa3, ACT(NT - 1)); }
    SBAR(); SEAM_K0();
    __syncthreads();
    if (hi == 0) li_l[r32] = l_reg; asm volatile("s_waitcnt lgkmcnt(0)" ::: "memory");
    float rli[16];
#pragma unroll
    for (int r = 0; r < 16; ++r) rli[r] = __builtin_amdgcn_rcpf(li_l[crow(r, hi)]);
    ALAS char* stg = lds + OFF_V + wid * 4096 + (4 * hi) * 128 + r32 * 2;
    ALAS const char* srd = lds + OFF_V + wid * 4096 + (lane >> 3) * 128 + (lane & 7) * 16;
    unsigned ooff = (unsigned)(((wid * QBLK + (lane >> 3)) * OSTR + (lane & 7) * 8) * 2);
    asm volatile("" : "+v"(ooff));
#pragma unroll
    for (int ps = 0; ps < 2; ++ps) {
#pragma unroll
        for (int dd = 0; dd < 2; ++dd)
#pragma unroll
            for (int r = 0; r < 16; r += 2) { const unsigned w = cvtpk(o[2 * ps + dd][r] * rli[r], o[2 * ps + dd][r + 1] * rli[r + 1]);
                ALAS char* a = stg + ((r & 3) + 8 * (r >> 2)) * 128 + dd * 64;
                *(ALAS unsigned short*)a = (unsigned short)w; *(ALAS unsigned short*)(a + 128) = (unsigned short)(w >> 16); }
        asm volatile("s_waitcnt lgkmcnt(0)" ::: "memory");
        u32x4 q[4];
#pragma unroll
        for (int i = 0; i < 4; ++i) q[i] = *(ALAS const u32x4*)(srd + i * 1024);
        asm volatile("s_waitcnt lgkmcnt(0)" ::: "memory");
#pragma unroll
        for (int i = 0; i < 4; ++i) *(u32x4*)((char*)cur.O + (size_t)(ooff + (unsigned)(i * 8 * OSTR * 2 + ps * 128))) = q[i];
    }
    __syncthreads();
#undef RESC
#undef KBASE
#undef ACT
#undef MASKT
#undef QKT
#undef SEAM_K0
#undef HALF_STEP
}
#undef AROW
#undef VMW
#undef VMWN
#undef SLOAD_H
#undef SWRITE_HK
#undef SWRITE_HV
#undef SWRITE_H
}

constexpr int NWAVES = 8;
constexpr int NB = 2, T = 8192, D = 2048, NH = 16, HD = 128, FF = 5632, DEPTH = 4;
constexpr int SB = 16, SN = 16, PAST = 1024, WIN = 512, NREL = 257;
constexpr int MP = NB * T, MS = SB * SN, M = MP + MS;
constexpr int NQKV = 3 * D, NGU = 2 * FF;
constexpr int LS = PAST + SN;
constexpr float EPS = 1e-6f, SCALE = 0.08838834764831845f;
constexpr size_t O_Y = 0, O_YS = (size_t)MP * D, O_AKP = O_YS + (size_t)MS * D, SZ_AP = (size_t)2 * NB * WIN * D, O_AVP = O_AKP + SZ_AP, O_BKP = O_AVP + SZ_AP,
    SZ_BP = (size_t)2 * MP * D, O_BVP = O_BKP + SZ_BP, O_BFP = O_BVP + SZ_BP, SZ_BFP = (size_t)2 * MP * NH, O_AKS = O_BFP + SZ_BFP, SZ_S = (size_t)2 * MS * D,
    O_AVS = O_AKS + SZ_S, O_BKS = O_AVS + SZ_S, O_BVS = O_BKS + SZ_S, O_BFS = O_BVS + SZ_S, OUT_TOTAL = O_BFS + (size_t)2 * MS * NH;
static_assert(OUT_TOTAL == 181411840, "out size");
constexpr size_t MiB = 1u << 20;
constexpr size_t WS_CTL = 0, CTL_ZERO_BYTES = 1 * MiB;
constexpr size_t WS_WQKV = 2 * MiB, WS_WO = 98 * MiB, WS_WGU = 130 * MiB, WS_WD = 306 * MiB;
constexpr size_t WS_XB = 394 * MiB, WS_SSQ = 459 * MiB;
constexpr size_t WS_QP = 462 * MiB, WS_KP = 526 * MiB, WS_VP = 590 * MiB;
constexpr size_t WS_QS = 654 * MiB;
constexpr size_t WS_OB = 655 * MiB, WS_HB = 720 * MiB;
constexpr size_t WS_KSN = 899 * MiB, WS_VSN = 900 * MiB;
constexpr size_t WS_LFP = 1315 * MiB, WS_WF = 1316 * MiB  , WS_LFS = 1317 * MiB, WS_CUMS = 1319 * MiB, WS_END = 1321 * MiB;
static_assert(WS_WQKV + (size_t)DEPTH * NQKV * D * 2 <= WS_WO && WS_WO + (size_t)DEPTH * D * D * 2 <= WS_WGU && WS_WGU + (size_t)DEPTH * NGU * D * 2 <= WS_WD && WS_WD + (size_t)DEPTH * D * FF * 2 <= WS_XB, "ws map: weights");
static_assert(WS_XB + (size_t)M * D * 2 <= WS_SSQ && WS_SSQ + (size_t)M * 32 * 4 <= WS_QP && WS_OB + (size_t)M * D * 2 <= WS_HB && WS_HB + (size_t)M * FF * 2 <= WS_KSN, "ws map: activations");
constexpr int CW_BAR = 4096, CW_QUEUE = 8192, CW_SKQ = 8192 + 256;
constexpr size_t WS_QKM = WS_WF + 512 * 1024;
constexpr int RING_OFF = 0, RING_BYTES = 131072;
constexpr int LDSCTL_OFF = RING_BYTES, MISC_OFF = LDSCTL_OFF + 320, RED_OFF = LDSCTL_OFF + 1024;
constexpr int LDS_BYTES = 147456;
#define GAS __attribute__((address_space(1)))
#define LAS __attribute__((address_space(3)))
typedef unsigned short bf16;
typedef unsigned v4u __attribute__((ext_vector_type(4)));
typedef float f32x4 __attribute__((ext_vector_type(4)));
typedef short bf16x8 __attribute__((ext_vector_type(8)));
typedef GAS unsigned gu32;
typedef GAS unsigned long long gu64;
#define RLX_AGENT __ATOMIC_RELAXED, __HIP_MEMORY_SCOPE_AGENT
#define LDS_WAIT() asm volatile("s_waitcnt lgkmcnt(0)" ::: "memory")
#define VM_WAIT() asm volatile("s_waitcnt vmcnt(0)" ::: "memory")
__device__ __forceinline__ unsigned long long rt() { return __builtin_amdgcn_s_memrealtime(); }
__device__ __forceinline__ unsigned f2bf(float f) { unsigned u = __builtin_bit_cast(unsigned, f); return (u + 0x7fffu + ((u >> 16) & 1u)) >> 16; }
__device__ __forceinline__ unsigned pk2(float lo, float hi) { return f2bf(lo) | (f2bf(hi) << 16); }

#define XB_TMO      128
#define XB_XCNT(j)  (256  + 64 * (j))
#define XB_XSUB(j)  (1280 + 64 * (j))
#define XB_XGEN(j)  (2304 + 64 * (j))
#define XB_TOP      3328
#define XB_TOPGEN   3392
#define XCD_BAR_WORDS 3456
#define XB_SPIN_CAP (1u << 22)

__device__ __forceinline__ unsigned xb_ld(unsigned* p)              { return __hip_atomic_load(p, __ATOMIC_RELAXED, __HIP_MEMORY_SCOPE_AGENT); }
__device__ __forceinline__ unsigned xb_add(unsigned* p, unsigned v) { return __hip_atomic_fetch_add(p, v, __ATOMIC_RELAXED, __HIP_MEMORY_SCOPE_AGENT); }
__device__ __forceinline__ unsigned xb_xcc_id() { return (unsigned)__builtin_amdgcn_s_getreg((3 << 11) | 20) & 0xFu; }
#define XB_SPIN(cond, bar) do { unsigned _sp = 0; while (cond) { __builtin_amdgcn_s_sleep(1); \
    if ((++_sp & 255u) == 0u) { if (xb_ld(&(bar)[XB_TMO])) break; if (_sp > XB_SPIN_CAP) { atomicAdd(&(bar)[XB_TMO], 1u); break; } } } } while (0)

struct XcdBarrier {
    unsigned* bar; unsigned x;
    volatile LAS unsigned* st;
};

__device__ __forceinline__ XcdBarrier xcd_barrier_post(unsigned* bar, volatile LAS unsigned* st, const bool leader  ) {
    XcdBarrier b; b.bar = bar; b.x = xb_xcc_id(); b.st = st;
    if (leader) (void)xb_add(&bar[XB_XCNT(b.x)], 1u);
    return b;
}
__device__ __forceinline__ void xcd_barrier_complete(unsigned* bar, unsigned x, unsigned& nloc, unsigned& nx) {
    const unsigned G = gridDim.x * gridDim.y * gridDim.z;
    unsigned sum, cnt, mine, sp = 0u;
    for (;;) {
        sum = 0u; cnt = 0u; mine = 0u;
#pragma unroll
        for (unsigned j = 0; j < 16; ++j) { const unsigned c = xb_ld(&bar[XB_XCNT(j)]); sum += c; cnt += (c > 0u) ? 1u : 0u; mine = (j == x) ? c : mine; }
        if (sum == G) break;
        __builtin_amdgcn_s_sleep(1);
        if ((++sp & 255u) == 0u) { if (xb_ld(&bar[XB_TMO])) break; if (sp > XB_SPIN_CAP) { atomicAdd(&bar[XB_TMO], 1u); break; } }
    }
    nloc = mine > 0u ? mine : 1u; nx = cnt > 0u ? cnt : 1u;
}

__device__ __forceinline__ void xcd_barrier(const XcdBarrier& b, const bool leader  ) {
    asm volatile("s_waitcnt vmcnt(0)" ::: "memory");
    __syncthreads();
    if (leader) {
        unsigned* bar = b.bar;
        __builtin_amdgcn_s_waitcnt(0);
        unsigned nloc = b.st[0], nx = b.st[1];
        if (nloc == 0u) { xcd_barrier_complete(bar, b.x, nloc, nx); b.st[0] = nloc; b.st[1] = nx; }
        const unsigned old = xb_add(&bar[XB_XSUB(b.x)], 1u);
        const unsigned gen = old / nloc;
        if (old + 1u == (gen + 1u) * nloc) {
            __builtin_amdgcn_fence(__ATOMIC_RELEASE, "agent");
            asm volatile("s_waitcnt vmcnt(0)" ::: "memory");
            const unsigned og = xb_add(&bar[XB_TOP], 1u);
            const unsigned tg = og / nx;
            if (og + 1u == (tg + 1u) * nx) xb_add(&bar[XB_TOPGEN], 1u);
            else XB_SPIN(xb_ld(&bar[XB_TOPGEN]) == tg, bar);
            __builtin_amdgcn_fence(__ATOMIC_ACQUIRE, "agent");
            xb_add(&bar[XB_XGEN(b.x)], 1u);
            asm volatile("s_waitcnt vmcnt(0)" ::: "memory");
        } else {
            XB_SPIN(xb_ld(&bar[XB_XGEN(b.x)]) == gen, bar);
            __builtin_amdgcn_fence(__ATOMIC_ACQUIRE, "agent");
            asm volatile("s_waitcnt vmcnt(0)" ::: "memory");
        }
    }
    __syncthreads();
}

typedef float f32x2 __attribute__((ext_vector_type(2)));
__device__ __forceinline__ float wave_sum(float v) {
#pragma unroll
    for (int o = 1; o < 64; o <<= 1) v += __shfl_xor(v, o);
    return v;
}
__device__ __forceinline__ float bf2f(unsigned b) { return __uint_as_float(b << 16); }

__device__ __forceinline__ void p0_transpose_item(const float* W, const float* g, int K, int N, bf16* WT, int mode, LAS float* scr, int item, int lane) {
    const int nblk = N / 32, kb = item / nblk, nb = item % nblk, k0 = 64 * kb, n0 = 32 * nb;
    const int kr = lane >> 3, nc = (lane & 7) * 4;
    f32x4 v[8]; float gs[8];
#pragma unroll
    for (int i = 0; i < 8; ++i) { v[i] = *(const GAS f32x4*)(W + (size_t)(k0 + kr + 8 * i) * N + n0 + nc); gs[i] = g ? g[k0 + kr + 8 * i] : 1.f; }
#pragma unroll
    for (int i = 0; i < 8; ++i) { LAS float* s = scr + (kr + 8 * i) * 33 + nc; s[0] = v[i].x * gs[i]; s[1] = v[i].y * gs[i]; s[2] = v[i].z * gs[i]; s[3] = v[i].w * gs[i]; }
    LDS_WAIT(); asm volatile("" ::: "memory");
    const int c = lane & 7;
    const int drow0 = (mode == 0) ? n0 : (256 * (n0 >> 7) + (n0 & 127) + (mode == 2 ? 128 : 0));
#pragma unroll
    for (int j = 0; j < 4; ++j) { const int n = (lane >> 3) + 8 * j; const LAS float* s = scr + (8 * c) * 33 + n;
        v4u o; o.x = pk2(s[0 * 33], s[1 * 33]); o.y = pk2(s[2 * 33], s[3 * 33]); o.z = pk2(s[4 * 33], s[5 * 33]); o.w = pk2(s[6 * 33], s[7 * 33]);
        *(GAS v4u*)(WT + (size_t)(drow0 + n) * K + k0 + 8 * c) = o; }
    LDS_WAIT(); asm volatile("" ::: "memory");
}
__device__ __forceinline__ void p0_item128(const float* W, const float* g, int K, int N, bf16* WT, int mode, LAS float* scr, int item, int lane) {
    const int nblk = N / 32, kb = item / nblk, nb = item % nblk, k0 = 128 * kb, n0 = 32 * nb;
    const int kr = lane >> 3, nc = (lane & 7) * 4;
    f32x4 v[16]; float gs[16];
#pragma unroll
    for (int i = 0; i < 16; ++i) { v[i] = *(const GAS f32x4*)(W + (size_t)(k0 + kr + 8 * i) * N + n0 + nc); gs[i] = g ? g[k0 + kr + 8 * i] : 1.f; }
    const int c = lane & 7;
    const int drow0 = (mode == 0) ? n0 : (256 * (n0 >> 7) + (n0 & 127) + (mode == 2 ? 128 : 0));
#pragma unroll
    for (int hf = 0; hf < 2; ++hf) {
#pragma unroll
        for (int i = 0; i < 8; ++i) { LAS float* s = scr + (kr + 8 * i) * 33 + nc; const f32x4 x = v[hf * 8 + i]; const float gg = gs[hf * 8 + i]; s[0] = x.x * gg; s[1] = x.y * gg; s[2] = x.z * gg; s[3] = x.w * gg; }
        LDS_WAIT(); asm volatile("" ::: "memory");
#pragma unroll
        for (int j = 0; j < 4; ++j) { const int n = (lane >> 3) + 8 * j; const LAS float* s = scr + (8 * c) * 33 + n;
            v4u o; o.x = pk2(s[0 * 33], s[1 * 33]); o.y = pk2(s[2 * 33], s[3 * 33]); o.z = pk2(s[4 * 33], s[5 * 33]); o.w = pk2(s[6 * 33], s[7 * 33]);
            *(GAS v4u*)(WT + (size_t)(drow0 + n) * K + k0 + 64 * hf + 8 * c) = o; }
        LDS_WAIT(); asm volatile("" ::: "memory");
    }
}
constexpr int CI_QKV = (D / 128) * (NQKV / 32), CI_O = (D / 128) * (D / 32), CI_G = (D / 128) * (FF / 32), CI_D = (FF / 128) * (D / 32), CI_L = CI_O + 2 * CI_G + CI_D;
__device__ __forceinline__ int conv_group_items(int grp) { return grp == 0 ? CI_QKV : (grp <= 3 ? CI_L + CI_QKV : CI_L); }
__device__ __forceinline__ void conv_item(const float* const __attribute__((address_space(4)))* in, unsigned char* ws, int grp, int it, LAS float* scr, int lane) {
    bf16* WQKV = (bf16*)(ws + WS_WQKV); bf16* WO = (bf16*)(ws + WS_WO); bf16* WGU = (bf16*)(ws + WS_WGU); bf16* WD = (bf16*)(ws + WS_WD);
    int r = it;
    if (grp > 0) { const int L = grp - 1; const float* gf = in[15] + (size_t)L * D;
        if (r < CI_O) { p0_item128(in[11] + (size_t)L * D * D, nullptr, D, D, WO + (size_t)L * D * D, 0, scr, r, lane); return; } r -= CI_O;
        if (r < CI_G) { p0_item128(in[16] + (size_t)L * D * FF, gf, D, FF, WGU + (size_t)L * NGU * D, 1, scr, r, lane); return; } r -= CI_G;
        if (r < CI_G) { p0_item128(in[17] + (size_t)L * D * FF, gf, D, FF, WGU + (size_t)L * NGU * D, 2, scr, r, lane); return; } r -= CI_G;
        if (r < CI_D) { p0_item128(in[18] + (size_t)L * FF * D, nullptr, FF, D, WD + (size_t)L * D * FF, 0, scr, r, lane); return; } r -= CI_D;
    }
    const int Lq = grp;
    p0_item128(in[8] + (size_t)Lq * D * NQKV, in[7] + (size_t)Lq * D, D, NQKV, WQKV + (size_t)Lq * NQKV * D, 0, scr, r, lane);
}
constexpr int N_SLICE = 256;
struct ConvD { const float* W; const float* g; bf16* WT; int K, N, mode, item; };
__device__ __forceinline__ ConvD conv_desc(const float* const __attribute__((address_space(4)))* in, unsigned char* ws, int grp, int it) {
    ConvD d; int r = it; const int L = grp - 1;
    if (r < CI_O) { d.W = in[11] + (size_t)L * D * D; d.g = nullptr; d.WT = (bf16*)(ws + WS_WO) + (size_t)L * D * D; d.K = D; d.N = D; d.mode = 0; d.item = r; return d; } r -= CI_O;
    if (r < 2 * CI_G) { const int up = r >= CI_G ? 1 : 0; d.W = in[16 + up] + (size_t)L * D * FF; d.g = in[15] + (size_t)L * D; d.WT = (bf16*)(ws + WS_WGU) + (size_t)L * NGU * D; d.K = D; d.N = FF; d.mode = 1 + up; d.item = r - up * CI_G; return d; } r -= 2 * CI_G;
    if (r < CI_D) { d.W = in[18] + (size_t)L * FF * D; d.g = nullptr; d.WT = (bf16*)(ws + WS_WD) + (size_t)L * D * FF; d.K = FF; d.N = D; d.mode = 0; d.item = r; return d; } r -= CI_D;
    d.W = in[8] + (size_t)grp * D * NQKV; d.g = in[7] + (size_t)grp * D; d.WT = (bf16*)(ws + WS_WQKV) + (size_t)grp * NQKV * D; d.K = D; d.N = NQKV; d.mode = 0; d.item = r; return d;
}
__device__ __forceinline__ void p0_load128(const ConvD& d, f32x4 (&v)[16], float (&gs)[16], int lane) {
    const int nblk = d.N / 32, kb = d.item / nblk, nb = d.item % nblk, k0 = 128 * kb, n0 = 32 * nb;
    const int kr = lane >> 3, nc = (lane & 7) * 4;
#pragma unroll
    for (int i = 0; i < 16; ++i) { v[i] = *(const GAS f32x4*)(d.W + (size_t)(k0 + kr + 8 * i) * d.N + n0 + nc); gs[i] = d.g ? d.g[k0 + kr + 8 * i] : 1.f; }
}
__device__ __forceinline__ void p0_finish128(const ConvD& d, const f32x4 (&v)[16], const float (&gs)[16], LAS float* scr, int lane) {
    const int nblk = d.N / 32, kb = d.item / nblk, nb = d.item % nblk, k0 = 128 * kb, n0 = 32 * nb;
    const int kr = lane >> 3, nc = (lane & 7) * 4, c = lane & 7;
    const int drow0 = (d.mode == 0) ? n0 : (256 * (n0 >> 7) + (n0 & 127) + (d.mode == 2 ? 128 : 0));
#pragma unroll
    for (int hf = 0; hf < 2; ++hf) {
#pragma unroll
        for (int i = 0; i < 8; ++i) { LAS float* s = scr + (kr + 8 * i) * 33 + nc; const f32x4 x = v[hf * 8 + i]; const float gg = gs[hf * 8 + i]; s[0] = x.x * gg; s[1] = x.y * gg; s[2] = x.z * gg; s[3] = x.w * gg; }
        LDS_WAIT(); asm volatile("" ::: "memory");
#pragma unroll
        for (int j = 0; j < 4; ++j) { const int n = (lane >> 3) + 8 * j; const LAS float* s = scr + (8 * c) * 33 + n;
            v4u o; o.x = pk2(s[0 * 33], s[1 * 33]); o.y = pk2(s[2 * 33], s[3 * 33]); o.z = pk2(s[4 * 33], s[5 * 33]); o.w = pk2(s[6 * 33], s[7 * 33]);
            *(GAS v4u*)(d.WT + (size_t)(drow0 + n) * d.K + k0 + 64 * hf + 8 * c) = o; }
        LDS_WAIT(); asm volatile("" ::: "memory");
    }
}
__device__ __forceinline__ void conv_slice(const float* const __attribute__((address_space(4)))* in, unsigned char* ws, int grp, int slice, LAS unsigned char* lds, int tid) {
    asm volatile("" : "+v"(tid));
    const int lane = tid & 63, wave = __builtin_amdgcn_readfirstlane(tid >> 6);
    LAS float* scr = (LAS float*)(lds + wave * 16384);
    const int ni = conv_group_items(grp), per = (ni + N_SLICE - 1) / N_SLICE, i0 = slice * per, i1 = (i0 + per < ni) ? i0 + per : ni;
    const int first = i0 + wave, n = (first < i1) ? (i1 - first + NWAVES - 1) / NWAVES : 0;
    if (n > 0) {
        f32x4 vA[16], vB[16]; float gA[16], gB[16];
        ConvD dA = conv_desc(in, ws, grp, first), dB = dA; p0_load128(dA, vA, gA, lane);
#pragma unroll 1
        for (int j = 0; j < n; j += 2) {
            dB = conv_desc(in, ws, grp, first + NWAVES * (j + 1 < n ? j + 1 : n - 1)); p0_load128(dB, vB, gB, lane); __builtin_amdgcn_sched_barrier(0);
            p0_finish128(dA, vA, gA, scr, lane); __builtin_amdgcn_sched_barrier(0);
            dA = conv_desc(in, ws, grp, first + NWAVES * (j + 2 < n ? j + 2 : n - 1)); p0_load128(dA, vA, gA, lane); __builtin_amdgcn_sched_barrier(0);
            if (j + 1 < n) p0_finish128(dB, vB, gB, scr, lane);
            __builtin_amdgcn_sched_barrier(0);
        }
    }
    __syncthreads();
}
__device__ __forceinline__ void row_update(const float* xold, const float* crow, float* xdst, bf16* xbrow, float* rstd_p, int lane) {
    const GAS f32x4* xr = (const GAS f32x4*)xold + lane; const GAS f32x4* cr = (const GAS f32x4*)crow + lane;
    GAS f32x4* xd = (GAS f32x4*)xdst + lane; GAS unsigned long long* o8 = (GAS unsigned long long*)xbrow + lane;
    float ss = 0.f;
#pragma unroll
    for (int j = 0; j < 8; ++j) { f32x4 v = xr[64 * j]; if (crow) v = v + cr[64 * j]; if (xdst) xd[64 * j] = v;
        ss += (v.x * v.x + v.y * v.y) + (v.z * v.z + v.w * v.w);
        o8[64 * j] = (unsigned long long)pk2(v.x, v.y) | ((unsigned long long)pk2(v.z, v.w) << 32); }
    ss = wave_sum(ss);
    if (lane < 32) rstd_p[lane] = (lane == 0) ? ss : 0.f;
}

template <int MODE>
__device__ __forceinline__ void sample_attn(LAS char* lds, int u, int li, unsigned char* ws, const float* rel, const float* kcache, const float* vcache, int tid) {
    asm volatile("" : "+v"(tid));
    constexpr int L = (MODE == 0) ? WIN : PAST, Lk = L + SN, NKB = Lk / 16, LkP = (Lk + 31) / 32 * 32, NST = LkP / 32, PP = LkP;
    constexpr int OFF_P = att::OFF_BIAS + 4352, OFF_RI = OFF_P + 16 * 1056 * 2;
    static_assert(16 * Lk * 4 <= att::OFF_TAB && OFF_RI + 64 <= 131072 && 8 * 16 * 128 * 4 <= att::OFF_TAB, "sample attention LDS map");
    const int lane = tid & 63, wid = __builtin_amdgcn_readfirstlane(tid >> 6), fr = lane & 15, fq = lane >> 4, st = u >> 4, h = u & 15;
    LAS float* S = (LAS float*)lds; LAS unsigned short* P = (LAS unsigned short*)(lds + OFF_P); LAS float* RI = (LAS float*)(lds + OFF_RI);
    const bf16* QSp = (const bf16*)(ws + WS_QS) + (size_t)u * SN * HD; const bf16* KNp = (const bf16*)(ws + WS_KSN) + (size_t)u * SN * HD; const bf16* VNp = (const bf16*)(ws + WS_VSN) + (size_t)u * SN * HD;
    const float* kc = kcache + ((size_t)(li * SB + st) * L) * D + h * HD; const float* vc = vcache + ((size_t)(li * SB + st) * L) * D + h * HD;
    if constexpr (MODE == 1) {
        att::Blk b; b.aux = (const float*)(ws + WS_LFS) + (size_t)u * LS; b.jhi = 17; b.cap = LS - 1; b.jlo = 0; b.P0 = PAST; b.c0 = 0; b.skipthr = 0.f; b.Q = nullptr; b.K = nullptr; b.V = nullptr; b.O = nullptr;
        (void)att::build_bias<1>(b, lds, tid);
    }
    pg8::bf16x8 qf[4];
#pragma unroll
    for (int ds = 0; ds < 4; ++ds) qf[ds] = *(const pg8::bf16x8*)(QSp + (size_t)fr * HD + ds * 32 + fq * 8);
    asm volatile("s_waitcnt lgkmcnt(0)" ::: "memory"); __syncthreads();
#define SA_SCORE(accv, key0_) do { f32x4 lg_; _Pragma("unroll") for (int r = 0; r < 4; ++r) { const int key = (key0_) + 4 * fq + r; float v_; \
            if (MODE == 1) { v_ = ((accv)[r] + ((LAS const float*)(lds + att::OFF_BIAS))[key]) * SCALE; if (key > L + fr) v_ = -__builtin_inff(); } \
            else { int dd = L + fr - key; dd = dd < -128 ? -128 : (dd > 128 ? 128 : dd); v_ = (accv)[r] * SCALE + rel[(size_t)(li * NH + h) * NREL + dd + 128]; } \
            lg_[r] = v_; } *(LAS f32x4*)(S + fr * Lk + (key0_) + 4 * fq) = lg_; } while (0)
    constexpr int NCB = L / 16 / NWAVES;
#pragma unroll 1
    for (int i = 0; i < NCB; i += 2) {
        f32x4 ka[2][4], kb2[2][4];
#pragma unroll
        for (int u2 = 0; u2 < 2; ++u2) { const float* kr = kc + (size_t)((wid + (i + u2) * NWAVES) * 16 + fr) * D + fq * 8;
#pragma unroll
            for (int ds = 0; ds < 4; ++ds) { ka[u2][ds] = *(const GAS f32x4*)(kr + ds * 32); kb2[u2][ds] = *(const GAS f32x4*)(kr + ds * 32 + 4); } }
#pragma unroll
        for (int u2 = 0; u2 < 2; ++u2) { pg8::f32x4 acc = (pg8::f32x4){0.f, 0.f, 0.f, 0.f};
#pragma unroll
            for (int ds = 0; ds < 4; ++ds) { const f32x4 a = ka[u2][ds], b2 = kb2[u2][ds];
                v4u w; w.x = pk2(a.x, a.y); w.y = pk2(a.z, a.w); w.z = pk2(b2.x, b2.y); w.w = pk2(b2.z, b2.w);
                acc = __builtin_amdgcn_mfma_f32_16x16x32_bf16(__builtin_bit_cast(pg8::bf16x8, w), qf[ds], acc, 0, 0, 0); }
            SA_SCORE(acc, (wid + (i + u2) * NWAVES) * 16); }
    }
    if (wid == 0) { const bf16* kr = KNp + (size_t)fr * HD + fq * 8; pg8::f32x4 acc = (pg8::f32x4){0.f, 0.f, 0.f, 0.f};
#pragma unroll
        for (int ds = 0; ds < 4; ++ds) acc = __builtin_amdgcn_mfma_f32_16x16x32_bf16(*(const pg8::bf16x8*)(kr + ds * 32), qf[ds], acc, 0, 0, 0);
        SA_SCORE(acc, L); }
#undef SA_SCORE
    asm volatile("s_waitcnt lgkmcnt(0)" ::: "memory"); __syncthreads();
#pragma unroll 1
    for (int rr = 0; rr < 2; ++rr) { const int q = 2 * wid + rr; LAS const float* sr = S + q * Lk; float m = -1e30f;
        for (int k = lane; k < Lk; k += 64) m = fmaxf(m, sr[k]);
#pragma unroll
        for (int o = 1; o < 64; o <<= 1) m = fmaxf(m, __int_as_float(__builtin_amdgcn_ds_bpermute(((lane ^ o) & 63) << 2, __float_as_int(m))));
        float sum = 0.f;
        for (int k = lane; k < PP; k += 64) { float p = 0.f; if (k < Lk) { p = __expf(sr[k] - m); sum += p; } P[q * 1056 + k] = (unsigned short)f2bf(p); }
#pragma unroll
        for (int o = 1; o < 64; o <<= 1) sum += __int_as_float(__builtin_amdgcn_ds_bpermute(((lane ^ o) & 63) << 2, __float_as_int(sum)));
        if (lane == 0) RI[q] = 1.0f / sum; }
    asm volatile("s_waitcnt lgkmcnt(0)" ::: "memory"); __syncthreads();
    pg8::f32x4 oacc[8];
#pragma unroll
    for (int db = 0; db < 8; ++db) oacc[db] = (pg8::f32x4){0.f, 0.f, 0.f, 0.f};
    constexpr int NCS = L / 32 / NWAVES;
#pragma unroll 1
    for (int i = 0; i < NCS; i += 2) {
        f32x4 ev[2][2][8];
#pragma unroll
        for (int u2 = 0; u2 < 2; ++u2) { const float* vr = vc + (size_t)((wid + (i + u2) * NWAVES) * 32 + fq * 8) * D + 4 * fr;
#pragma unroll
            for (int hf = 0; hf < 2; ++hf)
#pragma unroll
                for (int j = 0; j < 8; ++j) ev[u2][hf][j] = *(const GAS f32x4*)(vr + (size_t)j * D + hf * 64); }
#pragma unroll
        for (int u2 = 0; u2 < 2; ++u2) { const pg8::bf16x8 pf = *(LAS const pg8::bf16x8*)(P + fr * 1056 + (wid + (i + u2) * NWAVES) * 32 + fq * 8);
#pragma unroll
            for (int hf = 0; hf < 2; ++hf)
#pragma unroll
                for (int c = 0; c < 4; ++c) { v4u w; w.x = pk2(ev[u2][hf][0][c], ev[u2][hf][1][c]); w.y = pk2(ev[u2][hf][2][c], ev[u2][hf][3][c]); w.z = pk2(ev[u2][hf][4][c], ev[u2][hf][5][c]); w.w = pk2(ev[u2][hf][6][c], ev[u2][hf][7][c]);
                    oacc[hf * 4 + c] = __builtin_amdgcn_mfma_f32_16x16x32_bf16(__builtin_bit_cast(pg8::bf16x8, w), pf, oacc[hf * 4 + c], 0, 0, 0); } }
    }
    if (wid == 0) { const int kq = L + fq * 8; const pg8::bf16x8 pf = *(LAS const pg8::bf16x8*)(P + fr * 1056 + kq);
        const bool ok = fq < 2; const bf16* vr = VNp + (size_t)(ok ? (kq - L) : 0) * HD + 4 * fr;
#pragma unroll
        for (int hf = 0; hf < 2; ++hf)
#pragma unroll
            for (int c = 0; c < 4; ++c) { unsigned e[8];
#pragma unroll
                for (int j = 0; j < 8; ++j) e[j] = ok ? (unsigned)vr[(size_t)j * HD + hf * 64 + c] : 0u;
                v4u w; w.x = e[0] | (e[1] << 16); w.y = e[2] | (e[3] << 16); w.z = e[4] | (e[5] << 16); w.w = e[6] | (e[7] << 16);
                oacc[hf * 4 + c] = __builtin_amdgcn_mfma_f32_16x16x32_bf16(__builtin_bit_cast(pg8::bf16x8, w), pf, oacc[hf * 4 + c], 0, 0, 0); } }
    LAS float* PO = (LAS float*)lds;
#pragma unroll
    for (int hf = 0; hf < 2; ++hf)
#pragma unroll
        for (int r = 0; r < 4; ++r) *(LAS f32x4*)(PO + (wid * 16 + fr) * 128 + hf * 64 + 16 * fq + 4 * r) = (f32x4){oacc[hf * 4][r], oacc[hf * 4 + 1][r], oacc[hf * 4 + 2][r], oacc[hf * 4 + 3][r]};
    asm volatile("s_waitcnt lgkmcnt(0)" ::: "memory"); __syncthreads();
    { const int q = tid >> 5, d4 = (tid & 31) * 4; f32x4 s = *(LAS const f32x4*)(PO + q * 128 + d4);
#pragma unroll
      for (int w = 1; w < 8; ++w) { const f32x4 t = *(LAS const f32x4*)(PO + (w * 16 + q) * 128 + d4); s = s + t; }
      const float ri = RI[q];
      bf16* o = (bf16*)(ws + WS_OB) + ((size_t)MP + st * SN + q) * D + h * HD + d4;
      *(GAS unsigned long long*)o = (unsigned long long)pk2(s.x * ri, s.y * ri) | ((unsigned long long)pk2(s.z * ri, s.w * ri) << 32); }
    __syncthreads();
}

constexpr int N_PROMPT = NB * NH * 32, N_UNIT = SB * NH, N_POS = N_PROMPT + N_UNIT + N_SLICE;
static_assert(N_UNIT == N_SLICE && N_PROMPT >= 2 * N_UNIT, "ticket layout");
template <int MODE> __device__ __forceinline__ void pos_decode(int pos, int& kind, int& id) {
    if (pos < 4 * N_UNIT) { const int g = pos >> 2, r = pos & 3; if (r == 2) { kind = 1; id = g; } else if (r == 3) { kind = 2; id = g; } else { kind = 0; id = 2 * g + r; } }
    else { kind = 0; id = pos - 2 * N_UNIT; }
}
template <int MODE>
__device__ __forceinline__ void get_blk(int p, int li, unsigned char* ws, const float* rel, att::Blk& b) {
    bf16* QPp = (bf16*)(ws + WS_QP); bf16* KPp = (bf16*)(ws + WS_KP); bf16* VPp = (bf16*)(ws + WS_VP); bf16* OBp = (bf16*)(ws + WS_OB);
    int bh, qb;
    bh = p & 31; qb = 31 - (p >> 5);
    const int bb = bh >> 4, h = bh & 15;
    b.Q = QPp + ((size_t)bh * T + qb * 256) * HD; b.K = KPp + (size_t)bh * T * HD; b.V = VPp + (size_t)bh * T * HD; b.O = OBp + ((size_t)bb * T + qb * 256) * D + h * HD; b.P0 = qb * 256;
    if (MODE == 0) { b.aux = rel + (size_t)(li * NH + h) * NREL; b.c0 = qb * 4; b.jlo = b.c0 > 8 ? b.c0 - 8 : 0; b.jhi = b.c0 + 4; b.cap = 1 << 29; b.skipthr = __builtin_inff(); }
    else { b.aux = (const float*)(ws + WS_LFP) + (size_t)bh * T; b.c0 = 0; b.jlo = 0; b.jhi = 4 * (qb + 1); b.cap = qb * 256 + 255; b.skipthr = ((const float*)(ws + WS_QKM))[li]; }
}
__device__ __forceinline__ int take_ticket(gu32* qc, LAS unsigned char* lds, int tid) {
    volatile LAS int* w = (volatile LAS int*)(lds + 131008);
    if (tid == 0) *w = (int)__hip_atomic_fetch_add(qc, 1u, RLX_AGENT);
    __syncthreads();
    return __builtin_amdgcn_readfirstlane(*w);
}
template <int MODE>
__device__ __forceinline__ void attn_phase(LAS unsigned char* lds, int bx, int G, int layer, unsigned char* ws, const float* const __attribute__((address_space(4)))* in, const int tid) {
    att::Blk cur; att::Nxt nxt; att::Seam S;
    const int li = layer >> 1;
    const float* rel = in[12]; const float* kcache = in[MODE == 1 ? 4 : 2]; const float* vcache = in[MODE == 1 ? 5 : 3];
    gu32* qc = (gu32*)(ws + WS_CTL) + CW_QUEUE + 64 * layer;
    int pos = take_ticket(qc, lds, tid);
    while (pos < N_POS) {
        int kind, id; pos_decode<MODE>(pos, kind, id);
        if (kind != 0) {
            if (kind == 1) sample_attn<MODE>((LAS char*)lds, id, li, ws, rel, kcache, vcache, tid);
            else conv_slice(in, ws, layer + 1, id, lds, tid);
            pos = take_ticket(qc, lds, tid); continue; }
        get_blk<MODE>(id, li, ws, rel, cur);
        att::attn_prime<MODE>(cur, (LAS char*)lds, S, tid);
        for (;;) {
            int np = N_POS, id2 = 0; bool nf = false;
            int tk = 0;
            att::attn_block<MODE>(cur, [&]() { if (tid == 0) tk = (int)__hip_atomic_fetch_add(qc, 1u, RLX_AGENT); },
                [&](att::Nxt& nxt) {
                { volatile LAS int* w = (volatile LAS int*)(lds + 131008); if (tid == 0) *w = tk; __syncthreads(); np = __builtin_amdgcn_readfirstlane(*w); }
                int k2 = 3; if (np < N_POS) pos_decode<MODE>(np, k2, id2);
                nf = (k2 == 0);
                att::Blk nb; if (nf) { get_blk<MODE>(id2, li, ws, rel, nb); nxt.Q = nb.Q; nxt.K = nb.K; nxt.V = nb.V; nxt.jlo = nb.jlo; } else { nxt.Q = cur.Q; nxt.K = cur.K; nxt.V = cur.V; nxt.jlo = cur.jlo; }
            }, (LAS char*)lds, S, tid);
            pos = np;
            if (!nf) break;
            int id3 = id2; asm volatile("" : "+s"(id3));
            get_blk<MODE>(id3, li, ws, rel, cur);
        }
    }
}

struct Args { const float* in[19]; float* out; unsigned char* ws; int ph_lo, ph_hi; };
constexpr int PH_PER_LAYER = 5, N_PHASES = 1 + DEPTH * PH_PER_LAYER;

typedef const __attribute__((address_space(4))) Args CArgs;
#define PH_BEGIN() CArgs* A; { unsigned long long k_ = (unsigned long long)__builtin_amdgcn_kernarg_segment_ptr(); asm volatile("" : "+s"(k_)); A = (CArgs*)k_; } \
    unsigned char* const ws = A->ws; float* const out = A->out; int bx = blockIdx.x; asm volatile("" : "+s"(bx)); (void)ws; (void)out; (void)bx; \
    unsigned m1_ = ~0u; int ws_ = wave_s; asm volatile("" : "+s"(m1_), "+s"(ws_)); int tid = ws_ * 64 + (int)__builtin_amdgcn_mbcnt_hi(m1_, __builtin_amdgcn_mbcnt_lo(m1_, 0u)); asm volatile("" : "+v"(tid)); const int lane = tid & 63, wave = wave_s; (void)lane; (void)wave; \
    const int gw = bx * NWAVES + wave, NGW = G * NWAVES; const long gt = (long)bx * (NWAVES * 64) + tid, NGT = (long)G * (NWAVES * 64); (void)gw; (void)NGW; (void)gt; (void)NGT
__global__ void __launch_bounds__(NWAVES * 64, 2) fwd_kernel(Args args_unused) {
    extern __shared__ __attribute__((aligned(16))) unsigned char lds_raw[];
    LAS unsigned char* lds = (LAS unsigned char*)lds_raw;
    volatile LAS unsigned* MISC = (volatile LAS unsigned*)(lds + MISC_OFF);
    const int G = gridDim.x;
    const int wave_s = __builtin_amdgcn_readfirstlane((int)threadIdx.x >> 6);
    for (int u = threadIdx.x; u < (LDS_BYTES - LDSCTL_OFF) / 4; u += NWAVES * 64) ((LAS unsigned*)(lds + LDSCTL_OFF))[u] = 0u;
    __syncthreads();
    int lo, hi; XcdBarrier bar;
    { PH_BEGIN(); lo = A->ph_lo; hi = A->ph_hi; bar = xcd_barrier_post((unsigned*)((gu32*)(ws + WS_CTL) + CW_BAR), MISC + 8, tid == 0); }
#define IN(k) (lo <= (k) && (k) < hi)
#define SEAM(k) do { if (IN(k) && IN((k) + 1)) { XcdBarrier b2_ = bar; unsigned m2_ = ~0u; int w2_ = wave_s; asm volatile("" : "+s"(b2_.bar), "+s"(m2_), "+s"(w2_)); \
    xcd_barrier(b2_, w2_ == 0 && __builtin_amdgcn_mbcnt_hi(m2_, __builtin_amdgcn_mbcnt_lo(m2_, 0u)) == 0u); } } while (0)
#define P_WQKV ((bf16*)(ws + WS_WQKV))
#define P_WO ((bf16*)(ws + WS_WO))
#define P_WGU ((bf16*)(ws + WS_WGU))
#define P_WD ((bf16*)(ws + WS_WD))
#define P_XB ((bf16*)(ws + WS_XB))
#define P_SSQ ((float*)(ws + WS_SSQ))
#define P_QP ((bf16*)(ws + WS_QP))
#define P_KP ((bf16*)(ws + WS_KP))
#define P_VP ((bf16*)(ws + WS_VP))
#define P_QS ((bf16*)(ws + WS_QS))
#define P_OB ((bf16*)(ws + WS_OB))
#define P_HB ((bf16*)(ws + WS_HB))
#define P_LFP ((float*)(ws + WS_LFP))
#define P_LFS ((float*)(ws + WS_LFS))
#define P_KSN ((bf16*)(ws + WS_KSN))
#define P_VSN ((bf16*)(ws + WS_VSN))
#define P_WF ((bf16*)(ws + WS_WF))
#define P_X (out + O_Y)

    if (IN(0)) { PH_BEGIN();
        LAS float* scr = (LAS float*)(lds + RING_OFF + wave * 16384);
        for (int it = gw; it < conv_group_items(0); it += NGW) conv_item(A->in, ws, 0, it, scr, lane);
        for (int row = gw; row < M; row += NGW) {
            const float* xr = row < MP ? A->in[0] + (size_t)row * D : A->in[1] + (size_t)(row - MP) * D;
            row_update(xr, nullptr, nullptr, P_XB + (size_t)row * D, P_SSQ + (size_t)row * 32, lane);
        }
        for (long idx = gt; idx < 2L * NH * D; idx += NGT) { const int ib = (int)(idx >> 15), h = (int)((idx >> 11) & 15), k = (int)(idx & (D - 1));
            P_WF[idx] = (bf16)f2bf(A->in[7][(size_t)(2 * ib + 1) * D + k] * A->in[13][((size_t)ib * D + k) * NH + h]); }
        if (gw == 0) {
#pragma unroll 1
            for (int ib = 0; ib < 2; ++ib) { const float* gq = A->in[9] + (2 * ib + 1) * HD; const float* gk = A->in[10] + (2 * ib + 1) * HD;
                float mqk = fmaxf(fabsf(gq[lane] * gk[lane]), fabsf(gq[lane + 64] * gk[lane + 64]));
#pragma unroll
                for (int o = 1; o < 64; o <<= 1) mqk = fmaxf(mqk, __shfl_xor(mqk, o));
                if (lane == 0) ((float*)(ws + WS_QKM))[ib] = 11.313708499f * mqk * 1.02f + 40.0f; }
        }
    }
    SEAM(0);

#pragma unroll 1
    for (int layer = 0; layer < DEPTH; ++layer) {
        const int pb = 1 + layer * PH_PER_LAYER, li = layer >> 1; const bool fox = (layer & 1) != 0;
        if (IN(pb + 0)) { PH_BEGIN();
            if (fox) {
                const bf16* wfp = P_WF + (size_t)li * NH * D; const float* bfp = A->in[14] + li * NH;
                const int fr = lane & 15, fq = lane >> 4, lr = lane >> 2, lc = lane & 3, pidx = (((lane & 15) << 2) | (lane >> 4)) << 2;
                const int nidle = (G > 192) ? (G - 192) * NWAVES : NGW, gw0 = (G > 192) ? (bx - 192) * NWAVES + wave : gw;
                if (gw0 >= 0)
                for (int grp = gw0; grp < M / 16; grp += nidle) {
                    const int row = grp * 16 + fr;
                    const char* ap = (const char*)(P_XB + (size_t)(grp * 16 + lr) * D) + lc * 16; const char* bp = (const char*)(wfp + (size_t)lr * D) + lc * 16;
                    pg8::f32x4 acc = (pg8::f32x4){0.f, 0.f, 0.f, 0.f};
#pragma unroll 8
                    for (int ks = 0; ks < D / 32; ++ks) { pg8::u32x4 av = *(const pg8::u32x4*)(ap + ks * 64), bv = *(const pg8::u32x4*)(bp + ks * 64);
                        av.x = (unsigned)__builtin_amdgcn_ds_bpermute(pidx, (int)av.x); av.y = (unsigned)__builtin_amdgcn_ds_bpermute(pidx, (int)av.y); av.z = (unsigned)__builtin_amdgcn_ds_bpermute(pidx, (int)av.z); av.w = (unsigned)__builtin_amdgcn_ds_bpermute(pidx, (int)av.w);
                        bv.x = (unsigned)__builtin_amdgcn_ds_bpermute(pidx, (int)bv.x); bv.y = (unsigned)__builtin_amdgcn_ds_bpermute(pidx, (int)bv.y); bv.z = (unsigned)__builtin_amdgcn_ds_bpermute(pidx, (int)bv.z); bv.w = (unsigned)__builtin_amdgcn_ds_bpermute(pidx, (int)bv.w);
                        acc = __builtin_amdgcn_mfma_f32_16x16x32_bf16(__builtin_bit_cast(pg8::bf16x8, bv), __builtin_bit_cast(pg8::bf16x8, av), acc, 0, 0, 0); }
                    const float rs = pg8::row_rstd(P_SSQ, row, fq);
                    const pg8::f32x4 bb = *(const pg8::f32x4*)(bfp + 4 * fq); pg8::f32x4 lf;
#pragma unroll
                    for (int i = 0; i < 4; ++i) { const float z = acc[i] * rs + bb[i]; lf[i] = fminf(z, 0.f) - log1pf(expf(-fabsf(z))); }
                    if (row < MP) { *(pg8::f32x4*)(out + O_BFP + ((size_t)li * MP + row) * NH + 4 * fq) = lf;
#pragma unroll
                        for (int i = 0; i < 4; ++i) P_LFP[(size_t)((row >> 13) * NH + 4 * fq + i) * T + (row & (T - 1))] = lf[i]; }
                    else { const int rs2 = row - MP; *(pg8::f32x4*)(out + O_BFS + ((size_t)li * MS + rs2) * NH + 4 * fq) = lf;
#pragma unroll
                        for (int i = 0; i < 4; ++i) P_LFS[(size_t)((rs2 >> 4) * NH + 4 * fq + i) * LS + PAST + (rs2 & 15)] = lf[i]; }
                }
                const float* clf = A->in[6] + (size_t)li * SB * PAST * NH;
                for (long idx = gt; idx < (long)SB * NH * PAST; idx += NGT) { const int unit = (int)(idx >> 10), j = (int)(idx & 1023), st = unit >> 4, h = unit & 15;
                    P_LFS[(size_t)unit * LS + j] = clf[((size_t)st * PAST + j) * NH + h]; }
            }
            pg8::Gemm g{P_XB, P_WQKV + (size_t)layer * NQKV * D, MP, NQKV, D}; pg8::StaticOrder S; S.init(MP, NQKV, G, bx);
            pg8::EpiQKV E;
            E.ssq = P_SSQ; E.gq = A->in[9] + layer * HD; E.gk = A->in[10] + layer * HD; E.QP = P_QP; E.pstride = (WS_KP - WS_QP) / 2; E.QS = P_QS;
            E.srows = SN; E.lc = 0; E.KS = P_KSN; E.sstride = (WS_VSN - WS_KSN) / 2;
            E.okp = out + (fox ? O_BKP + (size_t)li * MP * D : O_AKP + (size_t)li * NB * WIN * D); E.opstride = fox ? SZ_BP : SZ_AP;
            E.oks = out + (fox ? O_BKS : O_AKS) + (size_t)li * MS * D; E.osstride = SZ_S;
            E.fox = fox ? 1 : 0; E.red = (LAS float*)(lds + RED_OFF);
            pg8::gemm_phase<pg8::EpiQKV, pg8::StaticOrder, true, true>(lds + RING_OFF, g, S, E, tid);
            __syncthreads();
            {
                sk::SkQKV K2; K2.ssq = P_SSQ + (size_t)MP * 32; K2.gq = A->in[9] + layer * HD; K2.gk = A->in[10] + layer * HD; K2.QS = P_QS;
                K2.srows = SN; K2.lc = 0; K2.KS = P_KSN; K2.sstride = (WS_VSN - WS_KSN) / 2;
                K2.oks = out + (fox ? O_BKS : O_AKS) + (size_t)li * MS * D; K2.osstride = SZ_S;
                sk::skinny_phase<sk::SkQKV>(lds + RING_OFF, P_XB + (size_t)MP * D, P_WQKV + (size_t)layer * NQKV * D, NQKV / 128, D, (unsigned*)((gu32*)(ws + WS_CTL) + CW_SKQ + 64 * (layer * 4 + 0)), tid, K2);
            }
        }
        SEAM(pb + 0);
        if (IN(pb + 1)) { PH_BEGIN();
            if (fox) attn_phase<1>(lds + RING_OFF, bx, G, layer, ws, A->in, tid);
            else attn_phase<0>(lds + RING_OFF, bx, G, layer, ws, A->in, tid);
        }
        SEAM(pb + 1);
        if (IN(pb + 2)) { PH_BEGIN();
            pg8::Gemm g{P_OB, P_WO + (size_t)layer * D * D, MP, D, D}; pg8::StaticOrder S; S.init(MP, D, G, bx);
            pg8::EpiResid E;
            E.X = nullptr; E.XB = P_XB; E.ssq = P_SSQ;
            pg8::gemm_phase<pg8::EpiResid, pg8::StaticOrder, true, true>(lds + RING_OFF, g, S, E, tid);
            __syncthreads();
            {   sk::SkResid K2; K2.xin = (layer == 0) ? A->in[1] : P_X + (size_t)MP * D; K2.X = P_X + (size_t)MP * D; K2.XB = P_XB + (size_t)MP * D; K2.ssq = P_SSQ + (size_t)MP * 32;
                sk::skinny_phase<sk::SkResid>(lds + RING_OFF, P_OB + (size_t)MP * D, P_WO + (size_t)layer * D * D, D / 64, D, (unsigned*)((gu32*)(ws + WS_CTL) + CW_SKQ + 64 * (layer * 4 + 1)), tid, K2); }
        }
        SEAM(pb + 2);
        if (IN(pb + 3)) { PH_BEGIN();
            pg8::Gemm g{P_XB, P_WGU + (size_t)layer * NGU * D, MP, NGU, D}; pg8::StaticOrder S; S.init(MP, NGU, G, bx);
            pg8::EpiSwiglu E{P_HB, FF, P_SSQ};
            pg8::gemm_phase<pg8::EpiSwiglu, pg8::StaticOrder, true, true>(lds + RING_OFF, g, S, E, tid);
            __syncthreads();
            {   sk::SkSwiglu K2{P_HB + (size_t)MP * FF, FF, P_SSQ + (size_t)MP * 32};
                sk::skinny_phase<sk::SkSwiglu>(lds + RING_OFF, P_XB + (size_t)MP * D, P_WGU + (size_t)layer * NGU * D, NGU / 128, D, (unsigned*)((gu32*)(ws + WS_CTL) + CW_SKQ + 64 * (layer * 4 + 2)), tid, K2); }
        }
        SEAM(pb + 3);
        if (IN(pb + 4)) { PH_BEGIN();
            pg8::Gemm g{P_HB, P_WD + (size_t)layer * D * FF, MP, D, FF}; pg8::StaticOrder S; S.init(MP, D, G, bx);
            pg8::EpiResid E;
            E.X = (layer == DEPTH - 1) ? P_X : nullptr; E.XB = P_XB; E.ssq = P_SSQ;
            pg8::gemm_phase<pg8::EpiResid, pg8::StaticOrder, true, true>(lds + RING_OFF, g, S, E, tid);
            __syncthreads();
            {   sk::SkResid K2; K2.xin = P_X + (size_t)MP * D; K2.X = P_X + (size_t)MP * D; K2.XB = P_XB + (size_t)MP * D; K2.ssq = P_SSQ + (size_t)MP * 32;
                sk::skinny_phase<sk::SkResid>(lds + RING_OFF, P_HB + (size_t)MP * FF, P_WD + (size_t)layer * D * FF, D / 64, FF, (unsigned*)((gu32*)(ws + WS_CTL) + CW_SKQ + 64 * (layer * 4 + 3)), tid, K2); }
        }
        SEAM(pb + 4);
    }
#undef IN
#undef SEAM
}

#ifndef MK_SPLIT
#define MK_SPLIT 0
#endif
extern "C" void kernel_launch(void* const* d_in, const int* in_sizes, int n_in, void* d_out, int out_size, void* d_ws, size_t ws_size, hipStream_t stream) {
    static int grid = 0;
    if (grid == 0) {
        if (n_in != 19 || in_sizes[0] != MP * D || (size_t)out_size != OUT_TOTAL || ws_size < WS_END) { fprintf(stderr, "kernel_launch: shape mismatch (n_in %d in0 %d out %d ws %zu); nothing launched\n", n_in, n_in > 0 ? in_sizes[0] : -1, out_size, ws_size); grid = -1; return; }
        int dev = 0, cus = 0;
        if (hipGetDevice(&dev) != hipSuccess || hipDeviceGetAttribute(&cus, hipDeviceAttributeMultiprocessorCount, dev) != hipSuccess) { grid = -1; return; }
        if (hipFuncSetAttribute((const void*)fwd_kernel, hipFuncAttributeMaxDynamicSharedMemorySize, LDS_BYTES) != hipSuccess) { fprintf(stderr, "kernel_launch: hipFuncSetAttribute failed\n"); grid = -1; return; }
        int per_cu = 0;
        if (hipOccupancyMaxActiveBlocksPerMultiprocessor(&per_cu, (const void*)fwd_kernel, NWAVES * 64, LDS_BYTES) != hipSuccess || per_cu < 1) fprintf(stderr, "kernel_launch: occupancy query reports %d\n", per_cu);
        (void)hipGetLastError();
        grid = cus;
    }
    if (grid < 0) return;
    if (hipMemsetAsync((char*)d_ws + WS_CTL, 0, CTL_ZERO_BYTES, stream) != hipSuccess) return;
    Args a{};
    for (int i = 0; i < 19; ++i) a.in[i] = (const float*)d_in[i];
    a.out = (float*)d_out; a.ws = (unsigned char*)d_ws;
#if MK_SPLIT
    for (int p = 0; p < N_PHASES; ++p) { a.ph_lo = p; a.ph_hi = p + 1; hipLaunchKernelGGL(fwd_kernel, dim3(grid), dim3(NWAVES * 64), LDS_BYTES, stream, a); }
#else
    a.ph_lo = 0; a.ph_hi = N_PHASES;
    hipLaunchKernelGGL(fwd_kernel, dim3(grid), dim3(NWAVES * 64), LDS_BYTES, stream, a);
#endif
}
```

```cpp
#include <hip/hip_runtime.h>
#include <cstdio>
#include <cstdint>
namespace pg8 {
#define PG8_LAS __attribute__((address_space(3)))
typedef unsigned short bf16_t;
typedef short bf16x8 __attribute__((ext_vector_type(8)));
typedef float f32x4 __attribute__((ext_vector_type(4)));
typedef unsigned u32x4 __attribute__((ext_vector_type(4)));
constexpr int BM = 256, BK = 64, HALF = 128, HTB = HALF * BK * 2  , STAGE_BYTES = 8 * HTB, NXCD = 8, WGM = 2;

__host__ __device__ __forceinline__ int lds_byte(int r, int c) { const int st = (r >> 4) * 2 + (c >> 5), rr = r & 15, cc = c & 31, ob = rr * 64 + cc * 2; return st * 1024 + (ob ^ (((ob >> 9) & 1) << 5)); }
__host__ __device__ __forceinline__ void stage_rc(int b, int& R, int& C) { const int st = b / 1024, sb = b % 1024, swz = sb ^ (((sb >> 9) & 1) << 5); R = (st >> 1) * 16 + swz / 64; C = (st & 1) * 32 + (swz % 64) / 2; }
__host__ __device__ __forceinline__ int perm32(int rho) { const int n = rho >> 4, i = rho & 15; return 8 * (i >> 2) + 4 * n + (i & 3); }

struct Unit { int pm, pn; };
struct Gemm { const bf16_t* A; const bf16_t* Bt; int M, N, K; };

struct StaticOrder {
    int nM, nN, nwg, G, c;
    __host__ __device__ void init(int M, int N, int G_, int c_) { nM = M / BM; nN = N / BM; nwg = nM * nN; G = G_; c = c_; }
    __host__ __device__ bool next(int i, Unit& u) const {
        const long L = (long)i * G + c; if (L >= nwg) return false;
        int wgid = (int)L; { const int q = nwg / NXCD, r = nwg % NXCD, xcd = wgid % NXCD, off = wgid / NXCD; wgid = (xcd < r ? xcd * (q + 1) : r * (q + 1) + (xcd - r) * q) + off; }
        const int nig = WGM * nN, gid = wgid / nig, fm = gid * WGM, gsz = (nM - fm) < WGM ? (nM - fm) : WGM;
        u.pm = fm + ((wgid % nig) % gsz); u.pn = (wgid % nig) / gsz; return true;
    }
    __device__ __forceinline__ void a_ready(const Unit&) const {}
    __device__ __forceinline__ void done(const Unit&) const {}
};

__device__ __forceinline__ unsigned cvt_pk_bf16(float lo, float hi) { unsigned r; asm volatile("v_cvt_pk_bf16_f32 %0, %1, %2" : "=v"(r) : "v"(lo), "v"(hi)); return r; }
struct EpiF32 {
    static constexpr bool PERM = false, AFTER_DRAIN = false;
    float* C; int ldc;
    __device__ __forceinline__ void operator()(const f32x4 (&acc)[2][2][4][2], const Unit& u, int wr, int wc, int fr, int fq) const {
        const int row0 = u.pm * BM + wr * 64 + fr, col0 = u.pn * BM + wc * 32 + 4 * fq;
#pragma unroll
        for (int ai = 0; ai < 2; ++ai)
#pragma unroll
            for (int m = 0; m < 4; ++m) { float* rowp = C + (size_t)(row0 + ai * HALF + m * 16) * ldc + col0;
#pragma unroll
                for (int bj = 0; bj < 2; ++bj)
#pragma unroll
                    for (int n = 0; n < 2; ++n) *(f32x4*)(rowp + bj * HALF + n * 16) = acc[ai][bj][m][n]; }
    }
};
template <class Epi, class Sched, bool ALIGN_EPI = false, bool SP2 = false>
__device__ __forceinline__ void gemm_phase(PG8_LAS unsigned char* lds, const Gemm g, const Sched& S, const Epi& E, const int tid_in) {
    int tid_ = tid_in; asm volatile("" : "+v"(tid_));
    const int tid = tid_, wid = __builtin_amdgcn_readfirstlane(tid >> 6), lane = tid & 63, wr = wid >> 2, wc = wid & 3, fr = lane & 15, fq = lane >> 4;
    const int K = g.K, nt = K / BK;
    unsigned voffA[2], voffB[2];
#pragma unroll
    for (int i = 0; i < 2; ++i) { int R, C; stage_rc(tid * 16 + i * 8192, R, C); const int Rb = Epi::PERM ? ((R & ~31) + perm32(R & 31)) : R;
        voffA[i] = (unsigned)(R * K + C) * 2u; voffB[i] = (unsigned)(Rb * K + C) * 2u; }
    const size_t kstep = (size_t)(BK * 2);
    const size_t hstep = (size_t)HALF * K * 2;
    const size_t tstep = 2 * hstep;
    const unsigned ldsw = (unsigned)wid * 1024u;
    const int aoff = lds_byte(wr * 64 + fr, fq * 8), boff = lds_byte(wc * 32 + fr, fq * 8);
#define PG8_SA(b, h) (((b) * 2 + (h)) * HTB)
#define PG8_SB(b, h) ((4 + (b) * 2 + (h)) * HTB)
#define PG8_STAGE(bufoff, gbase, voff) do { _Pragma("unroll") for (int _i = 0; _i < 2; ++_i) \
        __builtin_amdgcn_global_load_lds((const unsigned*)((const char*)(gbase) + (voff)[_i]), (PG8_LAS unsigned*)(lds + (bufoff) + ldsw + _i * 8192), 16, 0, 0); } while (0)
#define PG8_LDA(dst, b, h) do { _Pragma("unroll") for (int m = 0; m < 4; ++m) _Pragma("unroll") for (int k = 0; k < 2; ++k) dst[m][k] = *(const PG8_LAS bf16x8*)(lds + PG8_SA(b, h) + aoff + m * 2048 + k * 1024); } while (0)
#define PG8_LDB(dst, b, h) do { _Pragma("unroll") for (int n = 0; n < 2; ++n) _Pragma("unroll") for (int k = 0; k < 2; ++k) dst[n][k] = *(const PG8_LAS bf16x8*)(lds + PG8_SB(b, h) + boff + n * 2048 + k * 1024); } while (0)
#define PG8_MMA(ai, bj, At, Bt) do { __builtin_amdgcn_s_setprio(1); _Pragma("unroll") for (int m = 0; m < 4; ++m) _Pragma("unroll") for (int n = 0; n < 2; ++n) _Pragma("unroll") for (int k = 0; k < 2; ++k) \
        acc[ai][bj][m][n] = __builtin_amdgcn_mfma_f32_16x16x32_bf16(Bt[n][k], At[m][k], acc[ai][bj][m][n], 0, 0, 0); __builtin_amdgcn_s_setprio(0); } while (0)
#define PG8_WAIT_V(n) asm volatile("s_waitcnt vmcnt(" #n ")" ::: "memory")
#define PG8_WAIT_L(n) asm volatile("s_waitcnt lgkmcnt(" #n ")" ::: "memory")
#define PG8_BAR __builtin_amdgcn_s_barrier()
#define PG8_SCHED __builtin_amdgcn_sched_barrier(0)
    Unit cur, nxt; int ui = 0;
    if (!S.next(0, cur)) return;
    f32x4 acc[2][2][4][2];
#pragma unroll
    for (int a = 0; a < 2; ++a)
#pragma unroll
        for (int b = 0; b < 2; ++b)
#pragma unroll
            for (int m = 0; m < 4; ++m)
#pragma unroll
                for (int n = 0; n < 2; ++n) acc[a][b][m][n] = (f32x4){0.f, 0.f, 0.f, 0.f};
    bf16x8 At[4][2], B0[2][2], B1[2][2];
    const char* cA = (const char*)g.A + (size_t)cur.pm * tstep; const char* cB = (const char*)g.Bt + (size_t)cur.pn * tstep;
    S.a_ready(cur);
    if constexpr (SP2) {
        PG8_STAGE(PG8_SB(0, 0), cB, voffB); PG8_STAGE(PG8_SB(0, 1), cB + hstep, voffB); PG8_STAGE(PG8_SA(0, 0), cA, voffA); PG8_STAGE(PG8_SA(0, 1), cA + hstep, voffA);
        if (wr == 1) PG8_BAR;
        PG8_WAIT_V(2); PG8_BAR;
        PG8_STAGE(PG8_SB(1, 0), cB + kstep, voffB); PG8_STAGE(PG8_SA(1, 0), cA + kstep, voffA); PG8_STAGE(PG8_SB(1, 1), cB + hstep + kstep, voffB);
        PG8_WAIT_V(6); PG8_BAR;
    } else {
        PG8_STAGE(PG8_SB(0, 0), cB, voffB); PG8_STAGE(PG8_SA(0, 0), cA, voffA); PG8_STAGE(PG8_SB(0, 1), cB + hstep, voffB); PG8_STAGE(PG8_SA(0, 1), cA + hstep, voffA);
        if (wr == 1) PG8_BAR;
        PG8_WAIT_V(4); PG8_BAR;
        PG8_STAGE(PG8_SB(1, 0), cB + kstep, voffB); PG8_STAGE(PG8_SA(1, 0), cA + kstep, voffA); PG8_STAGE(PG8_SB(1, 1), cB + hstep + kstep, voffB);
        PG8_WAIT_V(6); PG8_BAR;
    }
    for (;;) {
        const bool has_next = S.next(ui + 1, nxt);
        const char* nA = has_next ? (const char*)g.A + (size_t)nxt.pm * tstep : cA; const char* nB = has_next ? (const char*)g.Bt + (size_t)nxt.pn * tstep : cB;
        for (int t = 0; t < nt; t += 2) {
            const bool last = (t == nt - 2);
            const char* a1 = cA + (size_t)(t + 1) * kstep;
            const char* a2 = last ? nA : cA + (size_t)(t + 2) * kstep; const char* b2 = last ? nB : cB + (size_t)(t + 2) * kstep;
            const char* a3 = a2 + kstep; const char* b3 = b2 + kstep;
            if (last && has_next) S.a_ready(nxt);
            if constexpr (SP2) {
            PG8_LDB(B0, 0, 0); PG8_LDB(B1, 0, 1); PG8_SCHED; PG8_LDA(At, 0, 0); PG8_STAGE(PG8_SA(1, 1), a1 + hstep, voffA);
            PG8_WAIT_V(8); PG8_WAIT_L(0); PG8_BAR; PG8_MMA(0, 0, At, B0); PG8_MMA(0, 1, At, B1); PG8_BAR; PG8_SCHED;
            PG8_LDA(At, 0, 1); PG8_STAGE(PG8_SB(0, 0), b2, voffB); PG8_STAGE(PG8_SB(0, 1), b2 + hstep, voffB); PG8_STAGE(PG8_SA(0, 0), a2, voffA);
            PG8_WAIT_V(8); PG8_WAIT_L(0); PG8_BAR; PG8_MMA(1, 0, At, B0); PG8_MMA(1, 1, At, B1); PG8_BAR; PG8_SCHED;
            PG8_LDB(B0, 1, 0); PG8_LDB(B1, 1, 1); PG8_SCHED; PG8_LDA(At, 1, 0); PG8_STAGE(PG8_SA(0, 1), a2 + hstep, voffA);
            PG8_WAIT_V(8); PG8_WAIT_L(0); PG8_BAR; PG8_MMA(0, 0, At, B0); PG8_MMA(0, 1, At, B1); PG8_BAR; PG8_SCHED;
            PG8_LDA(At, 1, 1); PG8_STAGE(PG8_SB(1, 0), b3, voffB); PG8_STAGE(PG8_SB(1, 1), b3 + hstep, voffB); PG8_STAGE(PG8_SA(1, 0), a3, voffA);
            PG8_WAIT_V(8); PG8_WAIT_L(0); PG8_BAR; PG8_MMA(1, 0, At, B0); PG8_MMA(1, 1, At, B1); PG8_BAR; PG8_SCHED;
            } else {
            PG8_LDB(B0, 0, 0); PG8_SCHED; PG8_LDA(At, 0, 0); PG8_STAGE(PG8_SA(1, 1), a1 + hstep, voffA);
            PG8_WAIT_L(8); PG8_BAR; PG8_WAIT_L(0); PG8_MMA(0, 0, At, B0); PG8_BAR; PG8_SCHED;
            PG8_LDB(B1, 0, 1); PG8_STAGE(PG8_SB(0, 0), b2, voffB);
            PG8_BAR; PG8_WAIT_L(0); PG8_MMA(0, 1, At, B1); PG8_BAR;
            PG8_LDA(At, 0, 1); PG8_STAGE(PG8_SA(0, 0), a2, voffA);
            PG8_BAR; PG8_WAIT_L(0); PG8_MMA(1, 0, At, B0); PG8_BAR; PG8_SCHED;
            PG8_STAGE(PG8_SB(0, 1), b2 + hstep, voffB);
            PG8_WAIT_V(6); PG8_BAR; PG8_MMA(1, 1, At, B1); PG8_BAR;
            PG8_LDB(B0, 1, 0); PG8_SCHED; PG8_LDA(At, 1, 0); PG8_STAGE(PG8_SA(0, 1), a2 + hstep, voffA);
            PG8_WAIT_L(8); PG8_BAR; PG8_WAIT_L(0); PG8_MMA(0, 0, At, B0); PG8_BAR; PG8_SCHED;
            PG8_LDB(B1, 1, 1); PG8_STAGE(PG8_SB(1, 0), b3, voffB);
            PG8_BAR; PG8_WAIT_L(0); PG8_MMA(0, 1, At, B1); PG8_BAR;
            PG8_LDA(At, 1, 1); PG8_STAGE(PG8_SA(1, 0), a3, voffA);
            PG8_BAR; PG8_WAIT_L(0); PG8_MMA(1, 0, At, B0); PG8_BAR; PG8_SCHED;
            PG8_STAGE(PG8_SB(1, 1), b3 + hstep, voffB);
            PG8_WAIT_V(6); PG8_BAR; PG8_MMA(1, 1, At, B1); PG8_BAR;
            }
        }
        if constexpr (ALIGN_EPI) { if (wr == 0) PG8_BAR; }
        if constexpr (!Epi::AFTER_DRAIN) { E(acc, cur, wr, wc, fr, fq); S.done(cur); }
        if (!has_next) break;
#pragma unroll
        for (int a = 0; a < 2; ++a)
#pragma unroll
            for (int b = 0; b < 2; ++b)
#pragma unroll
                for (int m = 0; m < 4; ++m)
#pragma unroll
                    for (int n = 0; n < 2; ++n) acc[a][b][m][n] = (f32x4){0.f, 0.f, 0.f, 0.f};
        cur = nxt; cA = nA; cB = nB; ++ui;
        if constexpr (ALIGN_EPI) { if (wr == 1) PG8_BAR; }
    }
    PG8_WAIT_V(0);
    if constexpr (!ALIGN_EPI) { if (wr == 0) PG8_BAR; }
    PG8_BAR;
    if constexpr (Epi::AFTER_DRAIN) { E.fused(acc, cur, wr, wc, fr, fq, lds, wid, lane); S.done(cur); }
#undef PG8_SA
#undef PG8_SB
#undef PG8_STAGE
#undef PG8_LDA
#undef PG8_LDB
#undef PG8_MMA
#undef PG8_WAIT_V
#undef PG8_WAIT_L
#undef PG8_BAR
#undef PG8_SCHED
}
}

namespace pg8 {
typedef unsigned u32x2 __attribute__((ext_vector_type(2)));
typedef float f32x2 __attribute__((ext_vector_type(2)));
__device__ __forceinline__ void rows_rstd(float (&rs)[2][4], const float* ssq, int pm, int wr, int fr, int fq) {
    f32x4 pa[2][4], pb[2][4];
    const float* base = ssq + (size_t)(pm * BM + wr * 64 + fr) * 32 + fq * 8;
#pragma unroll
    for (int ai = 0; ai < 2; ++ai)
#pragma unroll
        for (int m = 0; m < 4; ++m) { pa[ai][m] = *(const f32x4*)(base + (ai * HALF + m * 16) * 32); pb[ai][m] = *(const f32x4*)(base + (ai * HALF + m * 16) * 32 + 4); }
#pragma unroll
    for (int ai = 0; ai < 2; ++ai)
#pragma unroll
        for (int m = 0; m < 4; ++m) { const f32x4 a = pa[ai][m], b = pb[ai][m];
            float s = ((a[0] + a[1]) + (a[2] + a[3])) + ((b[0] + b[1]) + (b[2] + b[3]));
            s += __shfl_xor(s, 16); s += __shfl_xor(s, 32);
            rs[ai][m] = __builtin_amdgcn_rsqf(s * (1.0f / 2048.0f) + 1e-6f); }
}
__device__ __forceinline__ f32x4 to_rowmajor(f32x4 v, int pidx) {
    f32x4 o; o[0] = __int_as_float(__builtin_amdgcn_ds_bpermute(pidx, __float_as_int(v[0]))); o[1] = __int_as_float(__builtin_amdgcn_ds_bpermute(pidx, __float_as_int(v[1])));
    o[2] = __int_as_float(__builtin_amdgcn_ds_bpermute(pidx, __float_as_int(v[2]))); o[3] = __int_as_float(__builtin_amdgcn_ds_bpermute(pidx, __float_as_int(v[3]))); return o;
}
__device__ __forceinline__ int rowmajor_pidx(int lane) { return (((lane & 3) << 4) | (lane >> 2)) << 2; }
__device__ __forceinline__ void rows_rstd_rm(float (&rs)[2][4], const float* ssq, int pm, int wr, int r2, int c2) {
    f32x4 pa[2][4], pb[2][4];
    const float* base = ssq + (size_t)(pm * BM + wr * 64 + r2) * 32 + c2 * 8;
#pragma unroll
    for (int ai = 0; ai < 2; ++ai)
#pragma unroll
        for (int m = 0; m < 4; ++m) { pa[ai][m] = *(const f32x4*)(base + (ai * HALF + m * 16) * 32); pb[ai][m] = *(const f32x4*)(base + (ai * HALF + m * 16) * 32 + 4); }
#pragma unroll
    for (int ai = 0; ai < 2; ++ai)
#pragma unroll
        for (int m = 0; m < 4; ++m) { const f32x4 a = pa[ai][m], b = pb[ai][m];
            float s = ((a[0] + a[1]) + (a[2] + a[3])) + ((b[0] + b[1]) + (b[2] + b[3]));
            s += __shfl_xor(s, 1); s += __shfl_xor(s, 2);
            rs[ai][m] = __builtin_amdgcn_rsqf(s * (1.0f / 2048.0f) + 1e-6f); }
}
__device__ __forceinline__ float row_rstd(const float* ssq, int row, int fq) {
    const f32x4 a = *(const f32x4*)(ssq + (size_t)row * 32 + fq * 8), b = *(const f32x4*)(ssq + (size_t)row * 32 + fq * 8 + 4);
    float s = ((a[0] + a[1]) + (a[2] + a[3])) + ((b[0] + b[1]) + (b[2] + b[3]));
    s += __shfl_xor(s, 16); s += __shfl_xor(s, 32);
    return __builtin_amdgcn_rsqf(s * (1.0f / 2048.0f) + 1e-6f);
}
struct EpiResid {
    static constexpr bool PERM = true, AFTER_DRAIN = false;
    float* X; bf16_t* XB; float* ssq;
    __device__ __forceinline__ void operator()(const f32x4 (&acc)[2][2][4][2], const Unit& u, int wr, int wc, int fr_, int fq_) const {
        const int lane = fq_ * 16 + fr_, r2 = lane >> 2, c2 = lane & 3, pidx = rowmajor_pidx(lane);
        const int row0 = u.pm * BM + wr * 64 + r2, col0 = u.pn * BM + wc * 32 + 8 * c2;
        u32x4 v[4][2];
#define EPR_LOAD(g) do { const size_t off_ = (size_t)(row0 + ((g) >> 2) * HALF + ((g) & 3) * 16) * 2048 + col0; _Pragma("unroll") for (int bj = 0; bj < 2; ++bj) \
            v[(g) & 3][bj] = *(const u32x4*)(XB + off_ + bj * HALF); } while (0)
        EPR_LOAD(0); EPR_LOAD(1); EPR_LOAD(2);
#pragma unroll
        for (int g = 0; g < 8; ++g) { const int ai = g >> 2, m = g & 3; const int row = row0 + ai * HALF + m * 16; const size_t off = (size_t)row * 2048 + col0; float s = 0.f;
            if (g + 3 < 8) EPR_LOAD(g + 3);
#pragma unroll
            for (int bj = 0; bj < 2; ++bj) { const u32x4 xo = v[g & 3][bj];
                const f32x4 x0 = (f32x4){__uint_as_float(xo.x << 16), __uint_as_float(xo.x & 0xffff0000u), __uint_as_float(xo.y << 16), __uint_as_float(xo.y & 0xffff0000u)} + to_rowmajor(acc[ai][bj][m][0], pidx);
                const f32x4 x1 = (f32x4){__uint_as_float(xo.z << 16), __uint_as_float(xo.z & 0xffff0000u), __uint_as_float(xo.w << 16), __uint_as_float(xo.w & 0xffff0000u)} + to_rowmajor(acc[ai][bj][m][1], pidx);
                if (X != nullptr) { *(f32x4*)(X + off + bj * HALF) = x0; *(f32x4*)(X + off + bj * HALF + 4) = x1; }
                u32x4 w; w.x = cvt_pk_bf16(x0[0], x0[1]); w.y = cvt_pk_bf16(x0[2], x0[3]); w.z = cvt_pk_bf16(x1[0], x1[1]); w.w = cvt_pk_bf16(x1[2], x1[3]); *(u32x4*)(XB + off + bj * HALF) = w;
                s += ((x0[0] * x0[0] + x0[1] * x0[1]) + (x0[2] * x0[2] + x0[3] * x0[3])) + ((x1[0] * x1[0] + x1[1] * x1[1]) + (x1[2] * x1[2] + x1[3] * x1[3])); }
            s += __shfl_xor(s, 1); s += __shfl_xor(s, 2);
            if (c2 == 0) ssq[(size_t)row * 32 + u.pn * 4 + wc] = s;
            asm volatile("" ::: "memory"); }
#undef EPR_LOAD
    }
};
struct EpiSwiglu {
    static constexpr bool PERM = true, AFTER_DRAIN = false;
    bf16_t* H; int ldh; const float* ssq;
    __device__ __forceinline__ void operator()(const f32x4 (&acc)[2][2][4][2], const Unit& u, int wr, int wc, int fr_, int fq_) const {
        const int lane = fq_ * 16 + fr_, r2 = lane >> 2, c2 = lane & 3, pidx = rowmajor_pidx(lane);
        const int row0 = u.pm * BM + wr * 64 + r2, col0 = u.pn * HALF + wc * 32 + 8 * c2;
        f32x4 pa[2][4], pb[2][4];
        { const float* base = ssq + (size_t)(u.pm * BM + wr * 64 + r2) * 32 + c2 * 8;
#pragma unroll
          for (int ai = 0; ai < 2; ++ai)
#pragma unroll
            for (int m = 0; m < 4; ++m) { pa[ai][m] = *(const f32x4*)(base + (ai * HALF + m * 16) * 32); pb[ai][m] = *(const f32x4*)(base + (ai * HALF + m * 16) * 32 + 4); } }
        __builtin_amdgcn_sched_barrier(0);
        f32x4 rm[2][2][4][2];
#pragma unroll
        for (int ai = 0; ai < 2; ++ai)
#pragma unroll
            for (int bj = 0; bj < 2; ++bj)
#pragma unroll
                for (int m = 0; m < 4; ++m)
#pragma unroll
                    for (int n = 0; n < 2; ++n) rm[ai][bj][m][n] = to_rowmajor(acc[ai][bj][m][n], pidx);
        __builtin_amdgcn_sched_barrier(0);
        float rs[2][4];
#pragma unroll
        for (int ai = 0; ai < 2; ++ai)
#pragma unroll
            for (int m = 0; m < 4; ++m) { const f32x4 a = pa[ai][m], b = pb[ai][m];
                float sq = ((a[0] + a[1]) + (a[2] + a[3])) + ((b[0] + b[1]) + (b[2] + b[3]));
                sq += __shfl_xor(sq, 1); sq += __shfl_xor(sq, 2);
                rs[ai][m] = __builtin_amdgcn_rsqf(sq * (1.0f / 2048.0f) + 1e-6f); }
#pragma unroll
        for (int ai = 0; ai < 2; ++ai)
#pragma unroll
            for (int m = 0; m < 4; ++m) { const float r = rs[ai][m], c1 = -1.4426950408889634f * r, ms = __builtin_amdgcn_rcpf(r * r); float hv[8];
#pragma unroll
                for (int n = 0; n < 2; ++n) { const f32x4 gv = rm[ai][0][m][n], uv = rm[ai][1][m][n];
#pragma unroll
                    for (int i = 0; i < 4; i += 2) {
                        const f32x2 g2 = (f32x2){gv[i], gv[i + 1]}, u2 = (f32x2){uv[i], uv[i + 1]}; const f32x2 t2 = g2 * c1;
                        f32x2 e2; e2.x = __builtin_amdgcn_exp2f(t2.x); e2.y = __builtin_amdgcn_exp2f(t2.y);
                        const f32x2 d2 = e2 * ms + ms; f32x2 s2; s2.x = __builtin_amdgcn_rcpf(d2.x); s2.y = __builtin_amdgcn_rcpf(d2.y);
                        const f32x2 h2 = (g2 * u2) * s2; hv[4 * n + i] = h2.x; hv[4 * n + i + 1] = h2.y; } }
                u32x4 w; w.x = cvt_pk_bf16(hv[0], hv[1]); w.y = cvt_pk_bf16(hv[2], hv[3]); w.z = cvt_pk_bf16(hv[4], hv[5]); w.w = cvt_pk_bf16(hv[6], hv[7]);
                *(u32x4*)(H + (size_t)(row0 + ai * HALF + m * 16) * ldh + col0) = w; }
    }
};
struct EpiQKV {
    static constexpr bool PERM = true, AFTER_DRAIN = false;
    const float* ssq; const float* gq; const float* gk;
    bf16_t* QP; size_t pstride;
    bf16_t* QS; bf16_t* KS; size_t sstride; int srows, lc;
    float* okp; size_t opstride; float* oks; size_t osstride;
    int fox;
    PG8_LAS float* red;
    __device__ __forceinline__ void operator()(const f32x4 (&acc)[2][2][4][2], const Unit& u, int wr, int wc, int fr_, int fq_) const {
        int fr = fr_, fq = fq_; asm volatile("" : "+v"(fr), "+v"(fq));
        const int which = u.pn >> 3, head0 = (u.pn & 7) * 2;
        const int lane_ = fq_ * 16 + fr_, r2 = lane_ >> 2, c2 = lane_ & 3, pidx = rowmajor_pidx(lane_);
        float rsv[2][4]; rows_rstd_rm(rsv, ssq, u.pm, wr, r2, c2);
        if (which < 2) {
#pragma unroll
            for (int ai = 0; ai < 2; ++ai)
#pragma unroll
                for (int m = 0; m < 4; ++m)
#pragma unroll
                    for (int bj = 0; bj < 2; ++bj) { float s = 0.f;
#pragma unroll
                        for (int n = 0; n < 2; ++n) { const f32x4 x = acc[ai][bj][m][n]; s += (x[0] * x[0] + x[1] * x[1]) + (x[2] * x[2] + x[3] * x[3]); }
                        s += __shfl_xor(s, 16); s += __shfl_xor(s, 32);
                        if (fq == 0) red[(wc * 256 + ai * HALF + wr * 64 + m * 16 + fr) * 2 + bj] = s; }
            asm volatile("s_waitcnt lgkmcnt(0)" ::: "memory"); __builtin_amdgcn_s_barrier(); asm volatile("" ::: "memory");
        }
        const int cih = wc * 32 + 8 * c2;
        f32x4 g0 = (f32x4){1.f, 1.f, 1.f, 1.f}, g1 = g0;
        if (which < 2) { const float* g = (which == 0 ? gq : gk) + cih; g0 = *(const f32x4*)g; g1 = *(const f32x4*)(g + 4); }
        const bool samp = u.pm >= 64;
        const bool f32out = which > 0 && (samp || fox || (u.pm & 31) >= 30);
        char* b16; char* b32 = nullptr; unsigned hs16, rowsz = 0;
        if (!samp) { const int bb = u.pm >> 5;
            b16 = (char*)(QP + (size_t)which * pstride + (size_t)(bb * 16 + head0) * (8192 * 128)); hs16 = 8192 * 128 * 2;
            if (f32out) b32 = (char*)(okp + (size_t)(which - 1) * opstride + (fox ? (size_t)bb * 8192 * 2048 : (size_t)bb * 512 * 2048) + head0 * 128);
        } else { rowsz = (which == 0) ? 16u : (unsigned)srows;
            b16 = (which == 0) ? (char*)QS : (char*)(KS + (size_t)(which == 2 ? 1 : 0) * sstride + (size_t)lc * 128); hs16 = rowsz * 256u;
            if (f32out) b32 = (char*)(oks + (size_t)(which - 1) * osstride + head0 * 128); }
        const int trow0 = samp ? 0 : ((u.pm & 31) * 256 - ((fox || !f32out) ? 0 : 7680));
#pragma unroll
        for (int ai = 0; ai < 2; ++ai)
#pragma unroll
            for (int m = 0; m < 4; ++m) { const int rit = ai * HALF + wr * 64 + m * 16 + r2;
                const float rs = rsv[ai][m];
                unsigned o16;
                if (!samp) o16 = (unsigned)((((u.pm & 31) * 256 + rit) * 128 + cih) * 2);
                else o16 = (unsigned)(((((rit >> 4) * 16 + head0) * rowsz + (rit & 15)) * 128 + cih) * 2);
                const unsigned o32 = (unsigned)(((trow0 + rit) * 2048 + cih) * 4);
#pragma unroll
                for (int bj = 0; bj < 2; ++bj) { float sc = rs;
                    if (which < 2) { const int ri = rit * 2 + bj; const float t = (red[ri] + red[512 + ri]) + (red[1024 + ri] + red[1536 + ri]);
                        sc = rs * __builtin_amdgcn_rsqf(t * rs * rs * (1.0f / 128.0f) + 1e-6f); }
                    const f32x4 x0 = to_rowmajor(acc[ai][bj][m][0], pidx) * sc * g0, x1 = to_rowmajor(acc[ai][bj][m][1], pidx) * sc * g1;
                    u32x4 w; w.x = cvt_pk_bf16(x0[0], x0[1]); w.y = cvt_pk_bf16(x0[2], x0[3]); w.z = cvt_pk_bf16(x1[0], x1[1]); w.w = cvt_pk_bf16(x1[2], x1[3]);
                    *(u32x4*)(b16 + (size_t)(o16 + (unsigned)bj * hs16)) = w;
                    if (f32out) { float* fo = (float*)(b32 + (size_t)(o32 + (unsigned)bj * 512u)); __builtin_nontemporal_store(x0, (f32x4*)fo); __builtin_nontemporal_store(x1, (f32x4*)(fo + 4)); } }
                asm volatile("" ::: "memory"); }
    }
};
}

namespace sk {
typedef short bf16x8 __attribute__((ext_vector_type(8)));
typedef float f32x4 __attribute__((ext_vector_type(4)));
typedef unsigned u32x2 __attribute__((ext_vector_type(2)));
typedef unsigned u32x4 __attribute__((ext_vector_type(4)));
typedef unsigned short bf16_t;
#define SLAS __attribute__((address_space(3)))
__device__ __forceinline__ unsigned cvtpk(float lo, float hi) { unsigned r; asm volatile("v_cvt_pk_bf16_f32 %0, %1, %2" : "=v"(r) : "v"(lo), "v"(hi)); return r; }
__device__ __forceinline__ float row_rstd(const float* ssq, int row, int fq) {
    const f32x4 a = *(const f32x4*)(ssq + (size_t)row * 32 + fq * 8), b = *(const f32x4*)(ssq + (size_t)row * 32 + fq * 8 + 4);
    float s = ((a[0] + a[1]) + (a[2] + a[3])) + ((b[0] + b[1]) + (b[2] + b[3]));
    s += __shfl_xor(s, 16); s += __shfl_xor(s, 32);
    return __builtin_amdgcn_rsqf(s * (1.0f / 2048.0f) + 1e-6f);
}
struct SkResid {
    static constexpr int MB = 2, NB = 2, NS = 6; static constexpr bool NEEDS_X = true;
    const float* xin; float* X; bf16_t* XB; float* ssq;
    __device__ __forceinline__ int brow(int ct, int ch, int n) const { return ct * 64 + ch * 32 + 16 * n; }
    __device__ __forceinline__ void partial(f32x4 (&acc)[MB][NB], int rt, int ct, int ch, int fr, int fq, SLAS float* red) const {
        f32x4 xo[MB][NB];
#pragma unroll
        for (int m = 0; m < MB; ++m)
#pragma unroll
            for (int n = 0; n < NB; ++n) xo[m][n] = *(const f32x4*)(xin + (size_t)(rt * 32 + 16 * m + fr) * 2048 + ct * 64 + ch * 32 + 16 * n + 4 * fq);
#pragma unroll
        for (int m = 0; m < MB; ++m) { float s = 0.f;
#pragma unroll
            for (int n = 0; n < NB; ++n) { const f32x4 x = xo[m][n] + acc[m][n]; acc[m][n] = x; s += (x[0] * x[0] + x[1] * x[1]) + (x[2] * x[2] + x[3] * x[3]); }
            s += __shfl_xor(s, 16); s += __shfl_xor(s, 32);
            if (fq == 0) red[ch * 32 + 16 * m + fr] = s; }
    }
    __device__ __forceinline__ void operator()(const f32x4 (&acc)[MB][NB], int rt, int ct, int ch, int fr, int fq, SLAS float* red) const {
#pragma unroll
        for (int m = 0; m < MB; ++m) { const int r = rt * 32 + 16 * m + fr; const size_t off = (size_t)r * 2048 + ct * 64 + ch * 32 + 4 * fq;
#pragma unroll
            for (int n = 0; n < NB; ++n) { const f32x4 x = acc[m][n];
                *(f32x4*)(X + off + 16 * n) = x; u32x2 w; w.x = cvtpk(x[0], x[1]); w.y = cvtpk(x[2], x[3]); *(u32x2*)(XB + off + 16 * n) = w; }
            if (ch == 0 && fq == 0) ssq[(size_t)r * 32 + ct] = red[16 * m + fr] + red[32 + 16 * m + fr]; }
    }
};
struct SkSwiglu {
    static constexpr int MB = 4, NB = 4, NS = 3; static constexpr bool NEEDS_X = false;
    bf16_t* H; int ldh; const float* ssq;
    __device__ __forceinline__ int brow(int ct, int ch, int n) const { return 256 * (ct >> 1) + (ct & 1) * 64 + ch * 32 + (n >= 2 ? 128 + 16 * (n - 2) : 16 * n); }
    __device__ __forceinline__ void partial(f32x4 (&acc)[MB][NB], int, int, int, int, int, SLAS float*) const {}
    __device__ __forceinline__ void operator()(const f32x4 (&acc)[MB][NB], int rt, int ct, int ch, int fr, int fq, SLAS float* red) const {
        float rs[MB];
        { f32x4 pa[MB], pb[MB];
#pragma unroll
          for (int m = 0; m < MB; ++m) { const float* sp = ssq + (size_t)(rt * 64 + 16 * m + fr) * 32 + fq * 8; pa[m] = *(const f32x4*)sp; pb[m] = *(const f32x4*)(sp + 4); }
#pragma unroll
          for (int m = 0; m < MB; ++m) { float s = ((pa[m][0] + pa[m][1]) + (pa[m][2] + pa[m][3])) + ((pb[m][0] + pb[m][1]) + (pb[m][2] + pb[m][3]));
              s += __shfl_xor(s, 16); s += __shfl_xor(s, 32); rs[m] = __builtin_amdgcn_rsqf(s * (1.0f / 2048.0f) + 1e-6f); } }
#pragma unroll
        for (int m = 0; m < MB; ++m) { const int r = rt * 64 + 16 * m + fr;
#pragma unroll
            for (int n = 0; n < 2; ++n) { float hv[4];
#pragma unroll
                for (int i = 0; i < 4; ++i) { const float g = acc[m][n][i] * rs[m], up = acc[m][n + 2][i] * rs[m]; hv[i] = g * __builtin_amdgcn_rcpf(1.0f + __expf(-g)) * up; }
                u32x2 w; w.x = cvtpk(hv[0], hv[1]); w.y = cvtpk(hv[2], hv[3]);
                *(u32x2*)(H + (size_t)r * ldh + 128 * (ct >> 1) + (ct & 1) * 64 + ch * 32 + 16 * n + 4 * fq) = w; } }
    }
};
struct SkQKV {
    static constexpr int MB = 4, NB = 4, NS = 3; static constexpr bool NEEDS_X = true;
    const float* ssq; const float* gq; const float* gk;
    bf16_t* QS; bf16_t* KS; size_t sstride; int srows, lc;
    float* oks; size_t osstride;
    __device__ __forceinline__ int brow(int ct, int ch, int n) const { return ct * 128 + ch * 64 + 16 * n; }
    __device__ __forceinline__ void partial(f32x4 (&acc)[MB][NB], int, int, int ch, int fr, int fq, SLAS float* red) const {
#pragma unroll
        for (int m = 0; m < MB; ++m) { float s = 0.f;
#pragma unroll
            for (int n = 0; n < NB; ++n) { const f32x4 x = acc[m][n]; s += (x[0] * x[0] + x[1] * x[1]) + (x[2] * x[2] + x[3] * x[3]); }
            s += __shfl_xor(s, 16); s += __shfl_xor(s, 32);
            if (fq == 0) red[ch * 64 + 16 * m + fr] = s; }
    }
    __device__ __forceinline__ void operator()(const f32x4 (&acc)[MB][NB], int rt, int ct, int ch, int fr, int fq, SLAS float* red) const {
        const int which = ct >> 4, h = ct & 15;
        const float* g = (which == 0 ? gq : gk) + ch * 64 + 4 * fq;
        bf16_t* b16 = (which == 0) ? QS : KS + (size_t)(which == 2 ? 1 : 0) * sstride + (size_t)lc * 128; const int rowsz = (which == 0) ? 16 : srows;
        float* b32 = oks + (size_t)(which > 0 ? which - 1 : 0) * osstride + h * 128 + ch * 64 + 4 * fq;
        float rs[MB];
        { f32x4 pa[MB], pb[MB];
#pragma unroll
          for (int m = 0; m < MB; ++m) { const float* sp = ssq + (size_t)(rt * 64 + 16 * m + fr) * 32 + fq * 8; pa[m] = *(const f32x4*)sp; pb[m] = *(const f32x4*)(sp + 4); }
#pragma unroll
          for (int m = 0; m < MB; ++m) { float s = ((pa[m][0] + pa[m][1]) + (pa[m][2] + pa[m][3])) + ((pb[m][0] + pb[m][1]) + (pb[m][2] + pb[m][3]));
              s += __shfl_xor(s, 16); s += __shfl_xor(s, 32); rs[m] = __builtin_amdgcn_rsqf(s * (1.0f / 2048.0f) + 1e-6f); } }
#pragma unroll
        for (int m = 0; m < MB; ++m) { const int r = rt * 64 + 16 * m + fr; float sc = rs[m];
            if (which < 2) { const float s = red[16 * m + fr] + red[64 + 16 * m + fr]; sc = rs[m] * __builtin_amdgcn_rsqf(s * rs[m] * rs[m] * (1.0f / 128.0f) + 1e-6f); }
            bf16_t* d16 = b16 + ((size_t)((r >> 4) * 16 + h) * rowsz + (r & 15)) * 128 + ch * 64 + 4 * fq; float* d32 = b32 + (size_t)r * 2048;
#pragma unroll
            for (int n = 0; n < NB; ++n) { f32x4 x = acc[m][n] * sc; if (which < 2) x = x * *(const f32x4*)(g + 16 * n);
                u32x2 w; w.x = cvtpk(x[0], x[1]); w.y = cvtpk(x[2], x[3]); *(u32x2*)(d16 + 16 * n) = w;
                if (which > 0) *(f32x4*)(d32 + 16 * n) = x; } }
    }
};
template <class Epi>
__device__ __forceinline__ void skinny_phase(SLAS unsigned char* lds, const bf16_t* A, const bf16_t* Bt, int nct, int K, unsigned* qc  , int tid, const Epi& E) {
    constexpr int MB = Epi::MB, NB = Epi::NB, NS = Epi::NS, NRT = 16 / MB, SLOT = MB * NB * 1024;
    const int lane = tid & 63, wid = __builtin_amdgcn_readfirstlane(tid >> 6), fr = lane & 15, fq = lane >> 4, kq = wid & 3, ch = wid >> 2;
    const int kw = K >> 2;
    SLAS float* red = (SLAS float*)(lds + 4 * SLOT);
    for (;;) {
        volatile SLAS int* tw = (volatile SLAS int*)(lds + 67712);
        if (tid == 0) *tw = (int)__hip_atomic_fetch_add(qc, 1u, __ATOMIC_RELAXED, __HIP_MEMORY_SCOPE_AGENT);
        __syncthreads();
        const int tile = __builtin_amdgcn_readfirstlane(*tw);
        if (tile >= NRT * nct) break;
        const int rt = tile % NRT, ct = tile / NRT;
        f32x4 acc[MB][NB];
#pragma unroll
        for (int m = 0; m < MB; ++m)
#pragma unroll
            for (int n = 0; n < NB; ++n) acc[m][n] = (f32x4){0.f, 0.f, 0.f, 0.f};
        const unsigned lo = (unsigned)(((lane >> 2) * K + kq * kw + (lane & 3) * 8) * 2);
        const int pidx = (((lane & 15) << 2) | (lane >> 4)) << 2;
        const char* ab = (const char*)(A + (size_t)(rt * 16 * MB) * K);
        const char* bb[NB];
#pragma unroll
        for (int n = 0; n < NB; ++n) bb[n] = (const char*)(Bt + (size_t)E.brow(ct, ch, n) * K);
        bf16x8 fa[NS][MB], fb[NS][NB];
#define SK_LOAD(st, ks) do { const unsigned o_ = lo + (unsigned)((ks) * 2); _Pragma("unroll") for (int m = 0; m < MB; ++m) fa[st][m] = *(const bf16x8*)(ab + (size_t)(o_ + (unsigned)(16 * m * K * 2))); \
            _Pragma("unroll") for (int n = 0; n < NB; ++n) fb[st][n] = *(const bf16x8*)(bb[n] + (size_t)o_); } while (0)
#define SK_PERM(v) do { u32x4 w_ = __builtin_bit_cast(u32x4, v); w_.x = (unsigned)__builtin_amdgcn_ds_bpermute(pidx, (int)w_.x); w_.y = (unsigned)__builtin_amdgcn_ds_bpermute(pidx, (int)w_.y); \
            w_.z = (unsigned)__builtin_amdgcn_ds_bpermute(pidx, (int)w_.z); w_.w = (unsigned)__builtin_amdgcn_ds_bpermute(pidx, (int)w_.w); v = __builtin_bit_cast(bf16x8, w_); } while (0)
#define SK_MMA(st) do { _Pragma("unroll") for (int m = 0; m < MB; ++m) SK_PERM(fa[st][m]); _Pragma("unroll") for (int n = 0; n < NB; ++n) SK_PERM(fb[st][n]); \
            _Pragma("unroll") for (int m = 0; m < MB; ++m) _Pragma("unroll") for (int n = 0; n < NB; ++n) acc[m][n] = __builtin_amdgcn_mfma_f32_16x16x32_bf16(fb[st][n], fa[st][m], acc[m][n], 0, 0, 0); } while (0)
#define SK_SB() __builtin_amdgcn_sched_barrier(0)
        const int nst = kw >> 5, kl = kw - 32;
#pragma unroll
        for (int j = 0; j < NS - 1; ++j) { SK_LOAD(j, (j * 32 < kw ? j * 32 : kl)); SK_SB(); }
        for (int s0 = 0; s0 < nst; s0 += NS) {
#pragma unroll
            for (int j = 0; j < NS; ++j) { const int kn = (s0 + j + NS - 1) * 32; SK_LOAD((j + NS - 1) % NS, kn < kw ? kn : kl); SK_SB(); if (s0 + j < nst) SK_MMA(j); SK_SB(); }
        }
#undef SK_SB
#undef SK_LOAD
#undef SK_MMA
#undef SK_PERM
#pragma unroll
        for (int half = 2; half >= 1; half >>= 1) {
            if (kq >= half && kq < 2 * half) { SLAS f32x4* s = (SLAS f32x4*)(lds + (ch * 2 + kq - half) * SLOT) + lane;
#pragma unroll
                for (int m = 0; m < MB; ++m)
#pragma unroll
                    for (int n = 0; n < NB; ++n) s[(m * NB + n) * 64] = acc[m][n]; }
            __syncthreads();
            if (kq < half) { const SLAS f32x4* s = (const SLAS f32x4*)(lds + (ch * 2 + kq) * SLOT) + lane;
#pragma unroll
                for (int m = 0; m < MB; ++m)
#pragma unroll
                    for (int n = 0; n < NB; ++n) acc[m][n] = acc[m][n] + s[(m * NB + n) * 64]; }
            __syncthreads();
        }
        if constexpr (Epi::NEEDS_X) { if (kq == 0) E.partial(acc, rt, ct, ch, fr, fq, red); __syncthreads(); }
        if (kq == 0) E(acc, rt, ct, ch, fr, fq, red);
        if constexpr (Epi::NEEDS_X) __syncthreads();
    }
}
}

namespace att {
typedef short bf16x8 __attribute__((ext_vector_type(8)));
typedef short s16x4 __attribute__((ext_vector_type(4)));
typedef float f32x16 __attribute__((ext_vector_type(16)));
typedef float f32x4 __attribute__((ext_vector_type(4)));
typedef unsigned u32x4 __attribute__((ext_vector_type(4)));
typedef unsigned short bf16;
#define ALAS __attribute__((address_space(3)))
constexpr int D = 128, NW = 8, QBLK = 32, KVBLK = 64, QB = NW * QBLK;
constexpr int SHM_V = KVBLK * D * 2, SHM_K = KVBLK * D * 2;
constexpr int OFF_V = 0, OFF_K = 2 * SHM_V, OFF_WS = 2 * SHM_V + 2 * SHM_K, OFF_TAB = OFF_WS + NW * 64 * 4, OFF_BIAS = OFF_TAB + 1024, LDS_END = OFF_BIAS + 8192 * 4 + 512;
constexpr float SCALE = 0.08838834764831845f, RSCALE = 11.313708498984761f;
constexpr float THR = 8.f;
#define KSWZ(row, colB) ((row) * 256 + ((colB) ^ (((row) & 7) << 4)))
#define SBAR() __builtin_amdgcn_sched_barrier(0)
__device__ __forceinline__ int v_st(int k, int c) { const int kk = (k & ~0xC) | ((k & 4) << 1) | ((k & 8) >> 1); return ((kk >> 3) * 4 + (c >> 5)) * 512 + ((kk & 7) * 32 + (c & 31)) * 2; }
__device__ __forceinline__ int v_rd_base(int lane) { return ((lane & 3) << 3) | (((lane >> 2) & 3) << 6) | (((lane >> 4) & 1) << 5) | (((lane >> 5) & 1) << 8); }
constexpr int v_rd_off(int d0, int ks, int half) { return d0 * 512 + ks * 4096 + half * 2048; }
__device__ __forceinline__ int crow(int r, int hi) { return (r & 3) + 8 * (r >> 2) + 4 * hi; }
__device__ __forceinline__ unsigned cvtpk(float lo, float hi) { unsigned r; asm volatile("v_cvt_pk_bf16_f32 %0, %1, %2" : "=v"(r) : "v"(lo), "v"(hi)); return r; }
__device__ __forceinline__ bf16x8 load8(const bf16* p) { return *reinterpret_cast<const bf16x8*>(p); }
__device__ __forceinline__ void mask_tile(f32x16& p0, f32x16& p1, int dq) {
    const float NEG = -__builtin_inff();
#pragma unroll
    for (int r = 0; r < 16; ++r) {
        const int c = (r & 3) + 8 * (r >> 2);
        if (dq - c < 0) p0[r] = NEG;
        if (dq - c - 32 < 0) p1[r] = NEG;
    }
}
__device__ __forceinline__ void partialSM(f32x16& p0, f32x16& p1, float& m_reg, float& mn, float& alpha) {
    float pmax = p0[0]; for (int r = 1; r < 16; ++r) pmax = fmaxf(pmax, p0[r]); for (int r = 0; r < 16; ++r) pmax = fmaxf(pmax, p1[r]);
    { auto rr = __builtin_amdgcn_permlane32_swap(__float_as_uint(pmax), __float_as_uint(pmax), false, false);
      pmax = fmaxf(__uint_as_float(rr[0]), __uint_as_float(rr[1])); }
    constexpr float C2 = 1.4426950408889634f * SCALE;
    if (__builtin_expect(__all((pmax - m_reg) * SCALE <= THR), 1)) { mn = m_reg; alpha = 1.f; }
    else { mn = fmaxf(m_reg, pmax); alpha = __builtin_amdgcn_exp2f((m_reg - mn) * C2); m_reg = mn; }
    const float mnL = -mn * C2;
    for (int r = 0; r < 16; ++r) p0[r] = fmaf(p0[r], C2, mnL); for (int r = 0; r < 16; ++r) p1[r] = fmaf(p1[r], C2, mnL);
    for (int r = 0; r < 16; ++r) p0[r] = __builtin_amdgcn_exp2f(p0[r]);
}
__device__ __forceinline__ void finishSM(f32x16& p0, f32x16& p1, float alpha, float& l_reg, bf16x8& pa0, bf16x8& pa1, bf16x8& pa2, bf16x8& pa3) {
    for (int r = 0; r < 16; ++r) p1[r] = __builtin_amdgcn_exp2f(p1[r]);
    float ps = 0; for (int r = 0; r < 16; ++r) ps += p0[r]; for (int r = 0; r < 16; ++r) ps += p1[r];
    { auto rr = __builtin_amdgcn_permlane32_swap(__float_as_uint(ps), __float_as_uint(ps), false, false);
      ps = __uint_as_float(rr[0]) + __uint_as_float(rr[1]); }
    l_reg = l_reg * alpha + ps;
#define PK4(P, B_, OUT) do { unsigned a0 = cvtpk(P[B_+0], P[B_+1]), a1 = cvtpk(P[B_+2], P[B_+3]);                          \
        unsigned b0 = cvtpk(P[B_+4], P[B_+5]), b1 = cvtpk(P[B_+6], P[B_+7]);                                             \
        auto r0 = __builtin_amdgcn_permlane32_swap(a0, b0, false, false); auto r1 = __builtin_amdgcn_permlane32_swap(a1, b1, false, false); \
        u32x4 w = {r0[0], r1[0], r0[1], r1[1]}; OUT = *reinterpret_cast<bf16x8*>(&w); } while (0)
    PK4(p0, 0, pa0); PK4(p0, 8, pa1); PK4(p1, 0, pa2); PK4(p1, 8, pa3);
#undef PK4
}
struct Blk {
    const bf16* Q; const bf16* K; const bf16* V; bf16* O;
    const float* aux;
    int P0;
    int jlo, jhi;
    int cap;
    int c0;
    float skipthr;
};
struct Nxt { const bf16* Q; const bf16* K; const bf16* V; int jlo; };
constexpr int OSTR = 2048;
struct Seam { bf16x8 qr[8]; bf16x8 st_v0, st_v1, st_k0, st_k1; };

template <int MODE, int KB>
__device__ __forceinline__ void qkt(f32x16& p0, f32x16& p1, ALAS const char* lds, int r32, int hi, const bf16x8* qr, bool act, int tile  , int dist  , int irow  ) {
    if (!act) { const float NEG = -__builtin_inff();
#pragma unroll
        for (int r = 0; r < 16; ++r) { p0[r] = NEG; p1[r] = NEG; } return; }
    if constexpr (MODE == 1) {
        ALAS const float* bp = (ALAS const float*)(lds + OFF_BIAS) + tile * 64 + 4 * hi;
#pragma unroll
        for (int i = 0; i < 4; ++i) { const f32x4 a = *(ALAS const f32x4*)(bp + 8 * i), b = *(ALAS const f32x4*)(bp + 32 + 8 * i);
            p0[4 * i] = a[0]; p0[4 * i + 1] = a[1]; p0[4 * i + 2] = a[2]; p0[4 * i + 3] = a[3]; p1[4 * i] = b[0]; p1[4 * i + 1] = b[1]; p1[4 * i + 2] = b[2]; p1[4 * i + 3] = b[3]; }
    } else {
        ALAS const float* R = (ALAS const float*)(lds + OFF_TAB);
        if (dist <= 2) { ALAS const float* rp = R + (191 - 64 * dist - irow + 4 * hi);
#pragma unroll
            for (int r = 0; r < 16; ++r) { p0[r] = rp[(r & 3) + 8 * (r >> 2)]; p1[r] = rp[32 + (r & 3) + 8 * (r >> 2)]; } }
        else { const float cf = R[0];
#pragma unroll
            for (int r = 0; r < 16; ++r) { p0[r] = cf; p1[r] = cf; } }
    }
    ALAS const char* K_lds = lds + OFF_K;
    ALAS const char* kb[4];
#pragma unroll
    for (int dd = 0; dd < 4; ++dd) kb[dd] = K_lds + KB * SHM_K + KSWZ(r32, (dd * 16 + hi * 8) * 2);
#pragma unroll
    for (int d0 = 0; d0 < 8; ++d0) { ALAS const char* a = kb[d0 & 3] + (d0 >> 2) * 128;
        bf16x8 b0 = *reinterpret_cast<ALAS const bf16x8*>(a);
        bf16x8 b1 = *reinterpret_cast<ALAS const bf16x8*>(a + 32 * 256);
        p0 = __builtin_amdgcn_mfma_f32_32x32x16_bf16(b0, qr[d0], p0, 0, 0, 0);
        p1 = __builtin_amdgcn_mfma_f32_32x32x16_bf16(b1, qr[d0], p1, 0, 0, 0); }
}
template <int MODE, int VB>
__device__ __forceinline__ void pv_tile(f32x16* o, int vb0, bf16x8 pa0, bf16x8 pa1, bf16x8 pa2, bf16x8 pa3, bool act) {
    if (!act) return;
#define TRRD(dst, off) asm volatile("ds_read_b64_tr_b16 %0, %1 offset:%2" : "=&v"(dst) : "v"(vb0), "i"(off) : "memory")
#define PV_D0(d0) do { s16x4 l0, l1, l2, l3, h0, h1, h2, h3; constexpr int b_ = VB * SHM_V + v_rd_off(d0, 0, 0); \
        TRRD(l0, b_); TRRD(h0, b_ + 2048); TRRD(l1, b_ + 4096); TRRD(h1, b_ + 6144); TRRD(l2, b_ + 8192); TRRD(h2, b_ + 10240); TRRD(l3, b_ + 12288); TRRD(h3, b_ + 14336); \
        asm volatile("s_waitcnt lgkmcnt(0)" ::: "memory"); SBAR();   \
        o[d0] = __builtin_amdgcn_mfma_f32_32x32x16_bf16(pa0, (bf16x8){l0[0], l0[1], l0[2], l0[3], h0[0], h0[1], h0[2], h0[3]}, o[d0], 0, 0, 0);   \
        o[d0] = __builtin_amdgcn_mfma_f32_32x32x16_bf16(pa1, (bf16x8){l1[0], l1[1], l1[2], l1[3], h1[0], h1[1], h1[2], h1[3]}, o[d0], 0, 0, 0);   \
        o[d0] = __builtin_amdgcn_mfma_f32_32x32x16_bf16(pa2, (bf16x8){l2[0], l2[1], l2[2], l2[3], h2[0], h2[1], h2[2], h2[3]}, o[d0], 0, 0, 0);   \
        o[d0] = __builtin_amdgcn_mfma_f32_32x32x16_bf16(pa3, (bf16x8){l3[0], l3[1], l3[2], l3[3], h3[0], h3[1], h3[2], h3[3]}, o[d0], 0, 0, 0); } while (0)
    PV_D0(0); PV_D0(1); PV_D0(2); PV_D0(3);
#undef PV_D0
#undef TRRD
}
#define AROW(p, k0, rr) ((const bf16*)((const char*)(p) + (size_t)(unsigned)(((k0) + (rr)) * (D * 2) + sc * 2)))
#define VMW() asm volatile("s_waitcnt vmcnt(0)" ::: "memory")
#define VMWN(n) asm volatile("s_waitcnt vmcnt(%0)" :: "i"(n) : "memory")
#define SLOAD_H(Kp, Vp, k0) do { S.st_v0 = load8(AROW(Vp, k0, sr)); S.st_v1 = load8(AROW(Vp, k0, 32 + sr));              \
                         S.st_k0 = load8(AROW(Kp, k0, sr)); S.st_k1 = load8(AROW(Kp, k0, 32 + sr)); } while (0)
#define SWRITE_HK(bf) do { *(ALAS bf16x8*)(K_lds + (bf) * SHM_K + kws) = S.st_k0; *(ALAS bf16x8*)(K_lds + (bf) * SHM_K + kws + 32 * 256) = S.st_k1; } while (0)
#define SWRITE_HV(bf) do { *(ALAS bf16x8*)(V_lds + (bf) * SHM_V + vst0) = S.st_v0; *(ALAS bf16x8*)(V_lds + (bf) * SHM_V + vst1) = S.st_v1; } while (0)
#define SWRITE_H(bf) do { SWRITE_HV(bf); SWRITE_HK(bf); } while (0)
template <int MODE>
__device__ __forceinline__ float build_bias(const Blk& b, ALAS char* lds, int tid) {
    asm volatile("" : "+v"(tid));
    if constexpr (MODE == 0) {
        if (tid < 256) { int d = 191 - tid; d = d < -128 ? -128 : (d > 128 ? 128 : d); ((ALAS float*)(lds + OFF_TAB))[tid] = b.aux[d + 128] * RSCALE; }
        return 0.f;
    } else {
        const int nk = b.jhi * 64, nv = b.cap + 1, e0 = tid * 16, lane = tid & 63, wid = tid >> 6;
        float v[16];
#pragma unroll
        for (int i = 0; i < 4; ++i) { f32x4 x = (f32x4){0.f, 0.f, 0.f, 0.f};
            if (e0 + 4 * i < nv) x = *(const f32x4*)(b.aux + e0 + 4 * i);
            v[4 * i] = x[0]; v[4 * i + 1] = x[1]; v[4 * i + 2] = x[2]; v[4 * i + 3] = x[3]; }
        float run = 0.f;
#pragma unroll
        for (int i = 15; i >= 0; --i) { const float x = v[i]; v[i] = run; run += x; }
        float incl = run;
#pragma unroll
        for (int o = 1; o < 64; o <<= 1) { const float t = __int_as_float(__builtin_amdgcn_ds_bpermute(((lane + o) & 63) << 2, __float_as_int(incl))); if (lane + o < 64) incl += t; }
        ALAS float* wt = (ALAS float*)(lds + OFF_TAB);
        if (lane == 0) wt[wid] = incl;
        asm volatile("s_waitcnt lgkmcnt(0)" ::: "memory"); __builtin_amdgcn_s_barrier(); asm volatile("" ::: "memory");
        float after = incl - run;
#pragma unroll
        for (int w = 1; w < 8; ++w) { const float t = wt[w]; if (w > wid) after += t; }
        if (e0 < nk) { ALAS f32x4* o4 = (ALAS f32x4*)(lds + OFF_BIAS) + tid * 4;
#pragma unroll
            for (int i = 0; i < 4; ++i) o4[i] = (f32x4){(v[4 * i] + after) * RSCALE, (v[4 * i + 1] + after) * RSCALE, (v[4 * i + 2] + after) * RSCALE, (v[4 * i + 3] + after) * RSCALE}; }
        return after;
    }
}
template <int MODE>
__device__ __forceinline__ void attn_prime(const Blk& cur, ALAS char* lds, Seam& S, int tid) {
    asm volatile("" : "+v"(tid));
    const int wid = __builtin_amdgcn_readfirstlane(tid >> 6), lane = tid & 63, r32 = lane & 31, hi = lane >> 5;
    const int sr = tid >> 4, sc = (tid & 15) * 8, kws = KSWZ(sr, sc * 2); ALAS char* K_lds = lds + OFF_K;
    const int kb0 = cur.jlo * KVBLK;
    const int qrow = wid * QBLK + r32;
#pragma unroll
    for (int d0 = 0; d0 < 8; ++d0) S.qr[d0] = load8((const bf16*)((const char*)cur.Q + (size_t)(unsigned)(qrow * (D * 2) + hi * 16 + d0 * 32)));
    SLOAD_H(cur.K, cur.V, kb0); VMW(); SWRITE_HK(0);
    __syncthreads();
}
template <int MODE, class IssueFn, class NextFn>
__device__ __forceinline__ void attn_block(const Blk& cur, IssueFn&& issue_fn, NextFn&& next_fn, ALAS char* lds, Seam& S, int tid) {
    asm volatile("" : "+v"(tid));
    const int wid = __builtin_amdgcn_readfirstlane(tid >> 6), lane = tid & 63, r32 = lane & 31, hi = lane >> 5;
    bf16x8 kd[8];
    if constexpr (MODE == 1) { const char* kp = (const char*)cur.K + (size_t)(unsigned)((cur.P0 + wid * QBLK + r32) * (D * 2) + hi * 16);
#pragma unroll
        for (int d0 = 0; d0 < 8; ++d0) kd[d0] = load8((const bf16*)(kp + d0 * 32)); }
    const float s_end = build_bias<MODE>(cur, lds, tid);
    asm volatile("s_waitcnt lgkmcnt(0)" ::: "memory"); __syncthreads();
    int j_lo = cur.jlo;
    const int sr = tid >> 4, sc = (tid & 15) * 8, vst0 = v_st(sr, sc), vst1 = v_st(32 + sr, sc), kws = KSWZ(sr, sc * 2);
    ALAS char* V_lds = lds + OFF_V; ALAS char* K_lds = lds + OFF_K;
    if constexpr (MODE == 1) {
        float dsum = 0.f;
#pragma unroll
        for (int d0 = 0; d0 < 8; ++d0) { const u32x4 qa = *reinterpret_cast<const u32x4*>(&S.qr[d0]), ka = *reinterpret_cast<const u32x4*>(&kd[d0]);
#pragma unroll
            for (int i = 0; i < 4; ++i) { dsum = fmaf(__uint_as_float(qa[i] << 16), __uint_as_float(ka[i] << 16), dsum);
                dsum = fmaf(__uint_as_float(qa[i] & 0xffff0000u), __uint_as_float(ka[i] & 0xffff0000u), dsum); } }
        { auto rr = __builtin_amdgcn_permlane32_swap(__float_as_uint(dsum), __float_as_uint(dsum), false, false); dsum = __uint_as_float(rr[0]) + __uint_as_float(rr[1]); }
        float gv = (((ALAS const float*)(lds + OFF_BIAS))[cur.P0 + wid * QBLK + r32] + dsum) * SCALE;
#pragma unroll
        for (int o = 1; o < 32; o <<= 1) gv = fminf(gv, __shfl_xor(gv, o));
        ALAS float* wg = (ALAS float*)(lds + OFF_TAB) + 32;
        if (lane == 0) wg[wid] = gv;
        asm volatile("s_waitcnt lgkmcnt(0)" ::: "memory"); __builtin_amdgcn_s_barrier(); asm volatile("" ::: "memory");
        float G = wg[0];
#pragma unroll
        for (int w = 1; w < 8; ++w) G = fminf(G, wg[w]);
        const bool pred = ((tid & 3) == 3) && ((tid >> 2) < (cur.P0 >> 6)) && (s_end < G - cur.skipthr);
        const int cnt = __builtin_popcountll(__ballot(pred));
        ALAS int* wcnt = (ALAS int*)(lds + OFF_TAB) + 16;
        if (lane == 0) wcnt[wid] = cnt;
        asm volatile("s_waitcnt lgkmcnt(0)" ::: "memory"); __builtin_amdgcn_s_barrier(); asm volatile("" ::: "memory");
        int tot = 0;
#pragma unroll
        for (int w = 0; w < 8; ++w) tot += wcnt[w];
        j_lo = __builtin_amdgcn_readfirstlane(tot);
        if (j_lo != cur.jlo) {
            SLOAD_H(cur.K, cur.V, j_lo * KVBLK); VMW(); SWRITE_HK(0); }
        __syncthreads();
    }
    const int NT = cur.jhi - j_lo;
    const int wlim = cur.P0 + wid * QBLK;
    const int qm = wlim + r32 - 4 * hi;
    const int cw = cur.c0 + (wid >> 1);
    const int irow = (wid & 1) * 32 + r32;
    ALAS float* wsf = (ALAS float*)(lds + OFF_WS) + wid * 64; ALAS float* li_l = wsf; ALAS float* al_l = wsf + 32;
    float m_reg = -1e30f, l_reg = 0; f32x16 o[4] = {};
    const int vb0 = (int)(unsigned)(unsigned long long)V_lds + v_rd_base(lane);
    const bf16* Kh = cur.K; const bf16* Vh = cur.V;
#define RESC(a) do { if (__any((a) < 1.f)) { if (hi == 0) al_l[r32] = (a); asm volatile("s_waitcnt lgkmcnt(0)" ::: "memory");              \
                     for (int d_ = 0; d_ < 4; ++d_) for (int r = 0; r < 16; ++r) o[d_][r] *= al_l[crow(r, hi)]; } } while (0)
#define KBASE(t) ((j_lo + (t)) * KVBLK)
#define ACT(t) (MODE == 1 ? (KBASE(t) <= wlim + QBLK - 1) : ((j_lo + (t)) >= cw - 8 && (j_lo + (t)) <= cw))
#define MASKT(P0_, P1_, t) do { if (MODE == 1) { const int kb_ = KBASE(t); if (kb_ + KVBLK - 1 > wlim) mask_tile(P0_, P1_, qm - kb_); } } while (0)
#define QKT(KB, PX0, PX1, t) qkt<MODE, KB>(PX0, PX1, lds, r32, hi, S.qr, ACT(t), j_lo + (t), cw - (j_lo + (t)), irow)
    constexpr int NQL = 8;
#define SEAM_K0() do { VMWN(NQL); SWRITE_HK(0); SBAR(); } while (0)
    f32x16 pA0, pA1, pB0, pB1; float mnA, mnB, alA, alB; bf16x8 pa0, pa1, pa2, pa3;
    SWRITE_HV(0); SBAR();
    if (NT > 1) SLOAD_H(Kh, Vh, KBASE(1));
    SBAR(); QKT(0, pA0, pA1, 0);
    MASKT(pA0, pA1, 0); partialSM(pA0, pA1, m_reg, mnA, alA);
    if (NT > 1) { VMW(); SWRITE_H(1); }
    __syncthreads();
#define HALF_STEP(PX0, PX1, mnX, alX, PY0, PY1, alY, t, KB, VB, SB) do {                                                      \
        SBAR(); QKT(KB, PX0, PX1, t);                                                                                          \
        finishSM(PY0, PY1, alY, l_reg, pa0, pa1, pa2, pa3); SBAR();                                                           \
        if ((t) + 1 < NT) { SLOAD_H(Kh, Vh, KBASE((t) + 1)); SBAR(); }                                                        \
        pv_tile<MODE, VB>(o, vb0, pa0, pa1, pa2, pa3, ACT((t) - 1)); MASKT(PX0, PX1, (t)); partialSM(PX0, PX1, m_reg, mnX, alX);   \
        __syncthreads();                                                                                                      \
        if ((t) + 1 < NT) { VMW(); SWRITE_H(SB); }                                                                            \
        RESC(alX); __syncthreads(); } while (0)
    if (NT < 3) issue_fn();
    for (int t = 1; t + 1 < NT; t += 2) {
        if (t + 3 >= NT) issue_fn();
        HALF_STEP(pB0, pB1, mnB, alB, pA0, pA1, alA, t, 1, 0, 0);
        HALF_STEP(pA0, pA1, mnA, alA, pB0, pB1, alB, t + 1, 0, 1, 1);
    }
    Nxt nxt; next_fn(nxt);
    const int kbn = nxt.jlo * KVBLK;
    const bool even = (NT & 1) == 0;
    if (even) { SBAR(); QKT(1, pB0, pB1, NT - 1); SBAR(); }
    SLOAD_H(nxt.K, nxt.V, kbn); SBAR();
    { const int qrow = wid * QBLK + r32;
#pragma unroll
      for (int d0 = 0; d0 < 8; ++d0) S.qr[d0] = load8((const bf16*)((const char*)nxt.Q + (size_t)(unsigned)(qrow * (D * 2) + hi * 16 + d0 * 32))); }
    SBAR();
    finishSM(pA0, pA1, alA, l_reg, pa0, pa1, pa2, pa3); SBAR();
    pv_tile<MODE, 0>(o, vb0, pa0, pa1, pa2, pa3, ACT(even ? NT - 2 : NT - 1));
    if (even) { MASKT(pB0, pB1, NT - 1); partialSM(pB0, pB1, m_reg, mnB, alB); __syncthreads(); RESC(alB);
        finishSM(pB0, pB1, alB, l_reg, pa0, pa1, pa2, pa3); SBAR(); pv_tile<MODE, 1>(o, vb0, pa0, pa1, pa2, pa3, ACT(NT - 1)); }
    SBAR(); SEAM_K0();
    __syncthreads();
    if (hi == 0) li_l[r32] = l_reg; asm volatile("s_waitcnt lgkmcnt(0)" ::: "memory");
    float rli[16];
#pragma unroll
    for (int r = 0; r < 16; ++r) rli[r] = __builtin_amdgcn_rcpf(li_l[crow(r, hi)]);
    ALAS char* stg = lds + OFF_V + wid * 4096 + (4 * hi) * 128 + r32 * 2;
    ALAS const char* srd = lds + OFF_V + wid * 4096 + (lane >> 3) * 128 + (lane & 7) * 16;
    unsigned ooff = (unsigned)(((wid * QBLK + (lane >> 3)) * OSTR + (lane & 7) * 8) * 2);
    asm volatile("" : "+v"(ooff));
#pragma unroll
    for (int ps = 0; ps < 2; ++ps) {
#pragma unroll
        for (int dd = 0; dd < 2; ++dd)
#pragma unroll
            for (int r = 0; r < 16; r += 2) { const unsigned w = cvtpk(o[2 * ps + dd][r] * rli[r], o[2 * ps + dd][r + 1] * rli[r + 1]);
                ALAS char* a = stg + ((r & 3) + 8 * (r >> 2)) * 128 + dd * 64;
                *(ALAS unsigned short*)a = (unsigned short)w; *(ALAS unsigned short*)(a + 128) = (unsigned short)(w >> 16); }
        asm volatile("s_waitcnt lgkmcnt(0)" ::: "memory");
        u32x4 q[4];
#pragma unroll
        for (int i = 0; i < 4; ++i) q[i] = *(ALAS const u32x4*)(srd + i * 1024);
        asm volatile("s_waitcnt lgkmcnt(0)" ::: "memory");
#pragma unroll
        for (int i = 0; i < 4; ++i) *(u32x4*)((char*)cur.O + (size_t)(ooff + (unsigned)(i * 8 * OSTR * 2 + ps * 128))) = q[i];
    }
    __syncthreads();
#undef RESC
#undef KBASE
#undef ACT
#undef MASKT
#undef QKT
#undef SEAM_K0
#undef HALF_STEP
}
#undef AROW
#undef VMW
#undef VMWN
#undef SLOAD_H
#undef SWRITE_HK
#undef SWRITE_HV
#undef SWRITE_H
}

constexpr int NWAVES = 8;
constexpr int NB = 2, T = 8192, D = 2048, NH = 16, HD = 128, FF = 5632, DEPTH = 4;
constexpr int SB = 16, SN = 16, PAST = 1024, WIN = 512, NREL = 257;
constexpr int MP = NB * T, MS = SB * SN, M = MP + MS;
constexpr int NQKV = 3 * D, NGU = 2 * FF;
constexpr int LS = PAST + SN;
constexpr float EPS = 1e-6f, SCALE = 0.08838834764831845f;
constexpr size_t O_Y = 0, O_YS = (size_t)MP * D, O_AKP = O_YS + (size_t)MS * D, SZ_AP = (size_t)2 * NB * WIN * D, O_AVP = O_AKP + SZ_AP, O_BKP = O_AVP + SZ_AP,
    SZ_BP = (size_t)2 * MP * D, O_BVP = O_BKP + SZ_BP, O_BFP = O_BVP + SZ_BP, SZ_BFP = (size_t)2 * MP * NH, O_AKS = O_BFP + SZ_BFP, SZ_S = (size_t)2 * MS * D,
    O_AVS = O_AKS + SZ_S, O_BKS = O_AVS + SZ_S, O_BVS = O_BKS + SZ_S, O_BFS = O_BVS + SZ_S, OUT_TOTAL = O_BFS + (size_t)2 * MS * NH;
static_assert(OUT_TOTAL == 181411840, "out size");
constexpr size_t MiB = 1u << 20;
constexpr size_t WS_CTL = 0, CTL_ZERO_BYTES = 1 * MiB;
constexpr size_t WS_WQKV = 2 * MiB, WS_WO = 98 * MiB, WS_WGU = 130 * MiB, WS_WD = 306 * MiB;
constexpr size_t WS_XB = 394 * MiB, WS_SSQ = 459 * MiB;
constexpr size_t WS_QP = 462 * MiB, WS_KP = 526 * MiB, WS_VP = 590 * MiB;
constexpr size_t WS_QS = 654 * MiB;
constexpr size_t WS_OB = 655 * MiB, WS_HB = 720 * MiB;
constexpr size_t WS_KSN = 899 * MiB, WS_VSN = 900 * MiB;
constexpr size_t WS_LFP = 1315 * MiB, WS_WF = 1316 * MiB  , WS_LFS = 1317 * MiB, WS_CUMS = 1319 * MiB, WS_END = 1321 * MiB;
static_assert(WS_WQKV + (size_t)DEPTH * NQKV * D * 2 <= WS_WO && WS_WO + (size_t)DEPTH * D * D * 2 <= WS_WGU && WS_WGU + (size_t)DEPTH * NGU * D * 2 <= WS_WD && WS_WD + (size_t)DEPTH * D * FF * 2 <= WS_XB, "ws map: weights");
static_assert(WS_XB + (size_t)M * D * 2 <= WS_SSQ && WS_SSQ + (size_t)M * 32 * 4 <= WS_QP && WS_OB + (size_t)M * D * 2 <= WS_HB && WS_HB + (size_t)M * FF * 2 <= WS_KSN, "ws map: activations");
constexpr int CW_BAR = 4096, CW_QUEUE = 8192, CW_SKQ = 8192 + 256;
constexpr size_t WS_QKM = WS_WF + 512 * 1024;
constexpr int RING_OFF = 0, RING_BYTES = 131072;
constexpr int LDSCTL_OFF = RING_BYTES, MISC_OFF = LDSCTL_OFF + 320, RED_OFF = LDSCTL_OFF + 1024;
constexpr int LDS_BYTES = 147456;
#define GAS __attribute__((address_space(1)))
#define LAS __attribute__((address_space(3)))
typedef unsigned short bf16;
typedef unsigned v4u __attribute__((ext_vector_type(4)));
typedef float f32x4 __attribute__((ext_vector_type(4)));
typedef short bf16x8 __attribute__((ext_vector_type(8)));
typedef GAS unsigned gu32;
typedef GAS unsigned long long gu64;
#define RLX_AGENT __ATOMIC_RELAXED, __HIP_MEMORY_SCOPE_AGENT
#define LDS_WAIT() asm volatile("s_waitcnt lgkmcnt(0)" ::: "memory")
#define VM_WAIT() asm volatile("s_waitcnt vmcnt(0)" ::: "memory")
__device__ __forceinline__ unsigned long long rt() { return __builtin_amdgcn_s_memrealtime(); }
__device__ __forceinline__ unsigned f2bf(float f) { unsigned u = __builtin_bit_cast(unsigned, f); return (u + 0x7fffu + ((u >> 16) & 1u)) >> 16; }
__device__ __forceinline__ unsigned pk2(float lo, float hi) { return f2bf(lo) | (f2bf(hi) << 16); }

#define XB_TMO      128
#define XB_XCNT(j)  (256  + 64 * (j))
#define XB_XSUB(j)  (1280 + 64 * (j))
#define XB_XGEN(j)  (2304 + 64 * (j))
#define XB_TOP      3328
#define XB_TOPGEN   3392
#define XCD_BAR_WORDS 3456
#define XB_SPIN_CAP (1u << 22)

__device__ __forceinline__ unsigned xb_ld(unsigned* p)              { return __hip_atomic_load(p, __ATOMIC_RELAXED, __HIP_MEMORY_SCOPE_AGENT); }
__device__ __forceinline__ unsigned xb_add(unsigned* p, unsigned v) { return __hip_atomic_fetch_add(p, v, __ATOMIC_RELAXED, __HIP_MEMORY_SCOPE_AGENT); }
__device__ __forceinline__ unsigned xb_xcc_id() { return (unsigned)__builtin_amdgcn_s_getreg((3 << 11) | 20) & 0xFu; }
#define XB_SPIN(cond, bar) do { unsigned _sp = 0; while (cond) { __builtin_amdgcn_s_sleep(1); \
    if ((++_sp & 255u) == 0u) { if (xb_ld(&(bar)[XB_TMO])) break; if (_sp > XB_SPIN_CAP) { atomicAdd(&(bar)[XB_TMO], 1u); break; } } } } while (0)

struct XcdBarrier {
    unsigned* bar; unsigned x;
    volatile LAS unsigned* st;
};

__device__ __forceinline__ XcdBarrier xcd_barrier_post(unsigned* bar, volatile LAS unsigned* st, const bool leader  ) {
    XcdBarrier b; b.bar = bar; b.x = xb_xcc_id(); b.st = st;
    if (leader) (void)xb_add(&bar[XB_XCNT(b.x)], 1u);
    return b;
}
__device__ __forceinline__ void xcd_barrier_complete(unsigned* bar, unsigned x, unsigned& nloc, unsigned& nx) {
    const unsigned G = gridDim.x * gridDim.y * gridDim.z;
    unsigned sum, cnt, mine, sp = 0u;
    for (;;) {
        sum = 0u; cnt = 0u; mine = 0u;
#pragma unroll
        for (unsigned j = 0; j < 16; ++j) { const unsigned c = xb_ld(&bar[XB_XCNT(j)]); sum += c; cnt += (c > 0u) ? 1u : 0u; mine = (j == x) ? c : mine; }
        if (sum == G) break;
        __builtin_amdgcn_s_sleep(1);
        if ((++sp & 255u) == 0u) { if (xb_ld(&bar[XB_TMO])) break; if (sp > XB_SPIN_CAP) { atomicAdd(&bar[XB_TMO], 1u); break; } }
    }
    nloc = mine > 0u ? mine : 1u; nx = cnt > 0u ? cnt : 1u;
}

__device__ __forceinline__ void xcd_barrier(const XcdBarrier& b, const bool leader  ) {
    asm volatile("s_waitcnt vmcnt(0)" ::: "memory");
    __syncthreads();
    if (leader) {
        unsigned* bar = b.bar;
        __builtin_amdgcn_s_waitcnt(0);
        unsigned nloc = b.st[0], nx = b.st[1];
        if (nloc == 0u) { xcd_barrier_complete(bar, b.x, nloc, nx); b.st[0] = nloc; b.st[1] = nx; }
        const unsigned old = xb_add(&bar[XB_XSUB(b.x)], 1u);
        const unsigned gen = old / nloc;
        if (old + 1u == (gen + 1u) * nloc) {
            __builtin_amdgcn_fence(__ATOMIC_RELEASE, "agent");
            asm volatile("s_waitcnt vmcnt(0)" ::: "memory");
            const unsigned og = xb_add(&bar[XB_TOP], 1u);
            const unsigned tg = og / nx;
            if (og + 1u == (tg + 1u) * nx) xb_add(&bar[XB_TOPGEN], 1u);
            else XB_SPIN(xb_ld(&bar[XB_TOPGEN]) == tg, bar);
            __builtin_amdgcn_fence(__ATOMIC_ACQUIRE, "agent");
            xb_add(&bar[XB_XGEN(b.x)], 1u);
            asm volatile("s_waitcnt vmcnt(0)" ::: "memory");
        } else {
            XB_SPIN(xb_ld(&bar[XB_XGEN(b.x)]) == gen, bar);
            __builtin_amdgcn_fence(__ATOMIC_ACQUIRE, "agent");
            asm volatile("s_waitcnt vmcnt(0)" ::: "memory");
        }
    }
    __syncthreads();
}

typedef float f32x2 __attribute__((ext_vector_type(2)));
__device__ __forceinline__ float wave_sum(float v) {
#pragma unroll
    for (int o = 1; o < 64; o <<= 1) v += __shfl_xor(v, o);
    return v;
}
__device__ __forceinline__ float bf2f(unsigned b) { return __uint_as_float(b << 16); }

__device__ __forceinline__ void p0_transpose_item(const float* W, const float* g, int K, int N, bf16* WT, int mode, LAS float* scr, int item, int lane) {
    const int nblk = N / 32, kb = item / nblk, nb = item % nblk, k0 = 64 * kb, n0 = 32 * nb;
    const int kr = lane >> 3, nc = (lane & 7) * 4;
    f32x4 v[8]; float gs[8];
#pragma unroll
    for (int i = 0; i < 8; ++i) { v[i] = *(const GAS f32x4*)(W + (size_t)(k0 + kr + 8 * i) * N + n0 + nc); gs[i] = g ? g[k0 + kr + 8 * i] : 1.f; }
#pragma unroll
    for (int i = 0; i < 8; ++i) { LAS float* s = scr + (kr + 8 * i) * 33 + nc; s[0] = v[i].x * gs[i]; s[1] = v[i].y * gs[i]; s[2] = v[i].z * gs[i]; s[3] = v[i].w * gs[i]; }
    LDS_WAIT(); asm volatile("" ::: "memory");
    const int c = lane & 7;
    const int drow0 = (mode == 0) ? n0 : (256 * (n0 >> 7) + (n0 & 127) + (mode == 2 ? 128 : 0));
#pragma unroll
    for (int j = 0; j < 4; ++j) { const int n = (lane >> 3) + 8 * j; const LAS float* s = scr + (8 * c) * 33 + n;
        v4u o; o.x = pk2(s[0 * 33], s[1 * 33]); o.y = pk2(s[2 * 33], s[3 * 33]); o.z = pk2(s[4 * 33], s[5 * 33]); o.w = pk2(s[6 * 33], s[7 * 33]);
        *(GAS v4u*)(WT + (size_t)(drow0 + n) * K + k0 + 8 * c) = o; }
    LDS_WAIT(); asm volatile("" ::: "memory");
}
__device__ __forceinline__ void p0_item128(const float* W, const float* g, int K, int N, bf16* WT, int mode, LAS float* scr, int item, int lane) {
    const int nblk = N / 32, kb = item / nblk, nb = item % nblk, k0 = 128 * kb, n0 = 32 * nb;
    const int kr = lane >> 3, nc = (lane & 7) * 4;
    f32x4 v[16]; float gs[16];
#pragma unroll
    for (int i = 0; i < 16; ++i) { v[i] = *(const GAS f32x4*)(W + (size_t)(k0 + kr + 8 * i) * N + n0 + nc); gs[i] = g ? g[k0 + kr + 8 * i] : 1.f; }
    const int c = lane & 7;
    const int drow0 = (mode == 0) ? n0 : (256 * (n0 >> 7) + (n0 & 127) + (mode == 2 ? 128 : 0));
#pragma unroll
    for (int hf = 0; hf < 2; ++hf) {
#pragma unroll
        for (int i = 0; i < 8; ++i) { LAS float* s = scr + (kr + 8 * i) * 33 + nc; const f32x4 x = v[hf * 8 + i]; const float gg = gs[hf * 8 + i]; s[0] = x.x * gg; s[1] = x.y * gg; s[2] = x.z * gg; s[3] = x.w * gg; }
        LDS_WAIT(); asm volatile("" ::: "memory");
#pragma unroll
        for (int j = 0; j < 4; ++j) { const int n = (lane >> 3) + 8 * j; const LAS float* s = scr + (8 * c) * 33 + n;
            v4u o; o.x = pk2(s[0 * 33], s[1 * 33]); o.y = pk2(s[2 * 33], s[3 * 33]); o.z = pk2(s[4 * 33], s[5 * 33]); o.w = pk2(s[6 * 33], s[7 * 33]);
            *(GAS v4u*)(WT + (size_t)(drow0 + n) * K + k0 + 64 * hf + 8 * c) = o; }
        LDS_WAIT(); asm volatile("" ::: "memory");
    }
}
constexpr int CI_QKV = (D / 128) * (NQKV / 32), CI_O = (D / 128) * (D / 32), CI_G = (D / 128) * (FF / 32), CI_D = (FF / 128) * (D / 32), CI_L = CI_O + 2 * CI_G + CI_D;
__device__ __forceinline__ int conv_group_items(int grp) { return grp == 0 ? CI_QKV : (grp <= 3 ? CI_L + CI_QKV : CI_L); }
__device__ __forceinline__ void conv_item(const float* const __attribute__((address_space(4)))* in, unsigned char* ws, int grp, int it, LAS float* scr, int lane) {
    bf16* WQKV = (bf16*)(ws + WS_WQKV); bf16* WO = (bf16*)(ws + WS_WO); bf16* WGU = (bf16*)(ws + WS_WGU); bf16* WD = (bf16*)(ws + WS_WD);
    int r = it;
    if (grp > 0) { const int L = grp - 1; const float* gf = in[15] + (size_t)L * D;
        if (r < CI_O) { p0_item128(in[11] + (size_t)L * D * D, nullptr, D, D, WO + (size_t)L * D * D, 0, scr, r, lane); return; } r -= CI_O;
        if (r < CI_G) { p0_item128(in[16] + (size_t)L * D * FF, gf, D, FF, WGU + (size_t)L * NGU * D, 1, scr, r, lane); return; } r -= CI_G;
        if (r < CI_G) { p0_item128(in[17] + (size_t)L * D * FF, gf, D, FF, WGU + (size_t)L * NGU * D, 2, scr, r, lane); return; } r -= CI_G;
        if (r < CI_D) { p0_item128(in[18] + (size_t)L * FF * D, nullptr, FF, D, WD + (size_t)L * D * FF, 0, scr, r, lane); return; } r -= CI_D;
    }
    const int Lq = grp;
    p0_item128(in[8] + (size_t)Lq * D * NQKV, in[7] + (size_t)Lq * D, D, NQKV, WQKV + (size_t)Lq * NQKV * D, 0, scr, r, lane);
}
constexpr int N_SLICE = 256;
struct ConvD { const float* W; const float* g; bf16* WT; int K, N, mode, item; };
__device__ __forceinline__ ConvD conv_desc(const float* const __attribute__((address_space(4)))* in, unsigned char* ws, int grp, int it) {
    ConvD d; int r = it; const int L = grp - 1;
    if (r < CI_O) { d.W = in[11] + (size_t)L * D * D; d.g = nullptr; d.WT = (bf16*)(ws + WS_WO) + (size_t)L * D * D; d.K = D; d.N = D; d.mode = 0; d.item = r; return d; } r -= CI_O;
    if (r < 2 * CI_G) { const int up = r >= CI_G ? 1 : 0; d.W = in[16 + up] + (size_t)L * D * FF; d.g = in[15] + (size_t)L * D; d.WT = (bf16*)(ws + WS_WGU) + (size_t)L * NGU * D; d.K = D; d.N = FF; d.mode = 1 + up; d.item = r - up * CI_G; return d; } r -= 2 * CI_G;
    if (r < CI_D) { d.W = in[18] + (size_t)L * FF * D; d.g = nullptr; d.WT = (bf16*)(ws + WS_WD) + (size_t)L * D * FF; d.K = FF; d.N = D; d.mode = 0; d.item = r; return d; } r -= CI_D;
    d.W = in[8] + (size_t)grp * D * NQKV; d.g = in[7] + (size_t)grp * D; d.WT = (bf16*)(ws + WS_WQKV) + (size_t)grp * NQKV * D; d.K = D; d.N = NQKV; d.mode = 0; d.item = r; return d;
}
__device__ __forceinline__ void p0_load128(const ConvD& d, f32x4 (&v)[16], float (&gs)[16], int lane) {
    const int nblk = d.N / 32, kb = d.item / nblk, nb = d.item % nblk, k0 = 128 * kb, n0 = 32 * nb;
    const int kr = lane >> 3, nc = (lane & 7) * 4;
#pragma unroll
    for (int i = 0; i < 16; ++i) { v[i] = *(const GAS f32x4*)(d.W + (size_t)(k0 + kr + 8 * i) * d.N + n0 + nc); gs[i] = d.g ? d.g[k0 + kr + 8 * i] : 1.f; }
}
__device__ __forceinline__ void p0_finish128(const ConvD& d, const f32x4 (&v)[16], const float (&gs)[16], LAS float* scr, int lane) {
    const int nblk = d.N / 32, kb = d.item / nblk, nb = d.item % nblk, k0 = 128 * kb, n0 = 32 * nb;
    const int kr = lane >> 3, nc = (lane & 7) * 4, c = lane & 7;
    const int drow0 = (d.mode == 0) ? n0 : (256 * (n0 >> 7) + (n0 & 127) + (d.mode == 2 ? 128 : 0));
#pragma unroll
    for (int hf = 0; hf < 2; ++hf) {
#pragma unroll
        for (int i = 0; i < 8; ++i) { LAS float* s = scr + (kr + 8 * i) * 33 + nc; const f32x4 x = v[hf * 8 + i]; const float gg = gs[hf * 8 + i]; s[0] = x.x * gg; s[1] = x.y * gg; s[2] = x.z * gg; s[3] = x.w * gg; }
        LDS_WAIT(); asm volatile("" ::: "memory");
#pragma unroll
        for (int j = 0; j < 4; ++j) { const int n = (lane >> 3) + 8 * j; const LAS float* s = scr + (8 * c) * 33 + n;
            v4u o; o.x = pk2(s[0 * 33], s[1 * 33]); o.y = pk2(s[2 * 33], s[3 * 33]); o.z = pk2(s[4 * 33], s[5 * 33]); o.w = pk2(s[6 * 33], s[7 * 33]);
            *(GAS v4u*)(d.WT + (size_t)(drow0 + n) * d.K + k0 + 64 * hf + 8 * c) = o; }
        LDS_WAIT(); asm volatile("" ::: "memory");
    }
}
__device__ __forceinline__ void conv_slice(const float* const __attribute__((address_space(4)))* in, unsigned char* ws, int grp, int slice, LAS unsigned char* lds, int tid) {
    asm volatile("" : "+v"(tid));
    const int lane = tid & 63, wave = __builtin_amdgcn_readfirstlane(tid >> 6);
    LAS float* scr = (LAS float*)(lds + wave * 16384);
    const int ni = conv_group_items(grp), per = (ni + N_SLICE - 1) / N_SLICE, i0 = slice * per, i1 = (i0 + per < ni) ? i0 + per : ni;
    const int first = i0 + wave, n = (first < i1) ? (i1 - first + NWAVES - 1) / NWAVES : 0;
    if (n > 0) {
        f32x4 vA[16], vB[16]; float gA[16], gB[16];
        ConvD dA = conv_desc(in, ws, grp, first), dB = dA; p0_load128(dA, vA, gA, lane);
#pragma unroll 1
        for (int j = 0; j < n; j += 2) {
            dB = conv_desc(in, ws, grp, first + NWAVES * (j + 1 < n ? j + 1 : n - 1)); p0_load128(dB, vB, gB, lane); __builtin_amdgcn_sched_barrier(0);
            p0_finish128(dA, vA, gA, scr, lane); __builtin_amdgcn_sched_barrier(0);
            dA = conv_desc(in, ws, grp, first + NWAVES * (j + 2 < n ? j + 2 : n - 1)); p0_load128(dA, vA, gA, lane); __builtin_amdgcn_sched_barrier(0);
            if (j + 1 < n) p0_finish128(dB, vB, gB, scr, lane);
            __builtin_amdgcn_sched_barrier(0);
        }
    }
    __syncthreads();
}
__device__ __forceinline__ void row_update(const float* xold, const float* crow, float* xdst, bf16* xbrow, float* rstd_p, int lane) {
    const GAS f32x4* xr = (const GAS f32x4*)xold + lane; const GAS f32x4* cr = (const GAS f32x4*)crow + lane;
    GAS f32x4* xd = (GAS f32x4*)xdst + lane; GAS unsigned long long* o8 = (GAS unsigned long long*)xbrow + lane;
    float ss = 0.f;
#pragma unroll
    for (int j = 0; j < 8; ++j) { f32x4 v = xr[64 * j]; if (crow) v = v + cr[64 * j]; if (xdst) xd[64 * j] = v;
        ss += (v.x * v.x + v.y * v.y) + (v.z * v.z + v.w * v.w);
        o8[64 * j] = (unsigned long long)pk2(v.x, v.y) | ((unsigned long long)pk2(v.z, v.w) << 32); }
    ss = wave_sum(ss);
    if (lane < 32) rstd_p[lane] = (lane == 0) ? ss : 0.f;
}

template <int MODE>
__device__ __forceinline__ void sample_attn(LAS char* lds, int u, int li, unsigned char* ws, const float* rel, const float* kcache, const float* vcache, int tid) {
    asm volatile("" : "+v"(tid));
    constexpr int L = (MODE == 0) ? WIN : PAST, Lk = L + SN, NKB = Lk / 16, LkP = (Lk + 31) / 32 * 32, NST = LkP / 32, PP = LkP;
    constexpr int OFF_P = att::OFF_BIAS + 4352, OFF_RI = OFF_P + 16 * 1056 * 2;
    static_assert(16 * Lk * 4 <= att::OFF_TAB && OFF_RI + 64 <= 131072 && 8 * 16 * 128 * 4 <= att::OFF_TAB, "sample attention LDS map");
    const int lane = tid & 63, wid = __builtin_amdgcn_readfirstlane(tid >> 6), fr = lane & 15, fq = lane >> 4, st = u >> 4, h = u & 15;
    LAS float* S = (LAS float*)lds; LAS unsigned short* P = (LAS unsigned short*)(lds + OFF_P); LAS float* RI = (LAS float*)(lds + OFF_RI);
    const bf16* QSp = (const bf16*)(ws + WS_QS) + (size_t)u * SN * HD; const bf16* KNp = (const bf16*)(ws + WS_KSN) + (size_t)u * SN * HD; const bf16* VNp = (const bf16*)(ws + WS_VSN) + (size_t)u * SN * HD;
    const float* kc = kcache + ((size_t)(li * SB + st) * L) * D + h * HD; const float* vc = vcache + ((size_t)(li * SB + st) * L) * D + h * HD;
    if constexpr (MODE == 1) {
        att::Blk b; b.aux = (const float*)(ws + WS_LFS) + (size_t)u * LS; b.jhi = 17; b.cap = LS - 1; b.jlo = 0; b.P0 = PAST; b.c0 = 0; b.skipthr = 0.f; b.Q = nullptr; b.K = nullptr; b.V = nullptr; b.O = nullptr;
        (void)att::build_bias<1>(b, lds, tid);
    }
    pg8::bf16x8 qf[4];
#pragma unroll
    for (int ds = 0; ds < 4; ++ds) qf[ds] = *(const pg8::bf16x8*)(QSp + (size_t)fr * HD + ds * 32 + fq * 8);
    asm volatile("s_waitcnt lgkmcnt(0)" ::: "memory"); __syncthreads();
#define SA_SCORE(accv, key0_) do { f32x4 lg_; _Pragma("unroll") for (int r = 0; r < 4; ++r) { const int key = (key0_) + 4 * fq + r; float v_; \
            if (MODE == 1) { v_ = ((accv)[r] + ((LAS const float*)(lds + att::OFF_BIAS))[key]) * SCALE; if (key > L + fr) v_ = -__builtin_inff(); } \
            else { int dd = L + fr - key; dd = dd < -128 ? -128 : (dd > 128 ? 128 : dd); v_ = (accv)[r] * SCALE + rel[(size_t)(li * NH + h) * NREL + dd + 128]; } \
            lg_[r] = v_; } *(LAS f32x4*)(S + fr * Lk + (key0_) + 4 * fq) = lg_; } while (0)
    constexpr int NCB = L / 16 / NWAVES;
#pragma unroll 1
    for (int i = 0; i < NCB; i += 2) {
        f32x4 ka[2][4], kb2[2][4];
#pragma unroll
        for (int u2 = 0; u2 < 2; ++u2) { const float* kr = kc + (size_t)((wid + (i + u2) * NWAVES) * 16 + fr) * D + fq * 8;
#pragma unroll
            for (int ds = 0; ds < 4; ++ds) { ka[u2][ds] = *(const GAS f32x4*)(kr + ds * 32); kb2[u2][ds] = *(const GAS f32x4*)(kr + ds * 32 + 4); } }
#pragma unroll
        for (int u2 = 0; u2 < 2; ++u2) { pg8::f32x4 acc = (pg8::f32x4){0.f, 0.f, 0.f, 0.f};
#pragma unroll
            for (int ds = 0; ds < 4; ++ds) { const f32x4 a = ka[u2][ds], b2 = kb2[u2][ds];
                v4u w; w.x = pk2(a.x, a.y); w.y = pk2(a.z, a.w); w.z = pk2(b2.x, b2.y); w.w = pk2(b2.z, b2.w);
                acc = __builtin_amdgcn_mfma_f32_16x16x32_bf16(__builtin_bit_cast(pg8::bf16x8, w), qf[ds], acc, 0, 0, 0); }
            SA_SCORE(acc, (wid + (i + u2) * NWAVES) * 16); }
    }
    if (wid == 0) { const bf16* kr = KNp + (size_t)fr * HD + fq * 8; pg8::f32x4 acc = (pg8::f32x4){0.f, 0.f, 0.f, 0.f};
#pragma unroll
        for (int ds = 0; ds < 4; ++ds) acc = __builtin_amdgcn_mfma_f32_16x16x32_bf16(*(const pg8::bf16x8*)(kr + ds * 32), qf[ds], acc, 0, 0, 0);
        SA_SCORE(acc, L); }
#undef SA_SCORE
    asm volatile("s_waitcnt lgkmcnt(0)" ::: "memory"); __syncthreads();
#pragma unroll 1
    for (int rr = 0; rr < 2; ++rr) { const int q = 2 * wid + rr; LAS const float* sr = S + q * Lk; float m = -1e30f;
        for (int k = lane; k < Lk; k += 64) m = fmaxf(m, sr[k]);
#pragma unroll
        for (int o = 1; o < 64; o <<= 1) m = fmaxf(m, __int_as_float(__builtin_amdgcn_ds_bpermute(((lane ^ o) & 63) << 2, __float_as_int(m))));
        float sum = 0.f;
        for (int k = lane; k < PP; k += 64) { float p = 0.f; if (k < Lk) { p = __expf(sr[k] - m); sum += p; } P[q * 1056 + k] = (unsigned short)f2bf(p); }
#pragma unroll
        for (int o = 1; o < 64; o <<= 1) sum += __int_as_float(__builtin_amdgcn_ds_bpermute(((lane ^ o) & 63) << 2, __float_as_int(sum)));
        if (lane == 0) RI[q] = 1.0f / sum; }
    asm volatile("s_waitcnt lgkmcnt(0)" ::: "memory"); __syncthreads();
    pg8::f32x4 oacc[8];
#pragma unroll
    for (int db = 0; db < 8; ++db) oacc[db] = (pg8::f32x4){0.f, 0.f, 0.f, 0.f};
    constexpr int NCS = L / 32 / NWAVES;
#pragma unroll 1
    for (int i = 0; i < NCS; i += 2) {
        f32x4 ev[2][2][8];
#pragma unroll
        for (int u2 = 0; u2 < 2; ++u2) { const float* vr = vc + (size_t)((wid + (i + u2) * NWAVES) * 32 + fq * 8) * D + 4 * fr;
#pragma unroll
            for (int hf = 0; hf < 2; ++hf)
#pragma unroll
                for (int j = 0; j < 8; ++j) ev[u2][hf][j] = *(const GAS f32x4*)(vr + (size_t)j * D + hf * 64); }
#pragma unroll
        for (int u2 = 0; u2 < 2; ++u2) { const pg8::bf16x8 pf = *(LAS const pg8::bf16x8*)(P + fr * 1056 + (wid + (i + u2) * NWAVES) * 32 + fq * 8);
#pragma unroll
            for (int hf = 0; hf < 2; ++hf)
#pragma unroll
                for (int c = 0; c < 4; ++c) { v4u w; w.x = pk2(ev[u2][hf][0][c], ev[u2][hf][1][c]); w.y = pk2(ev[u2][hf][2][c], ev[u2][hf][3][c]); w.z = pk2(ev[u2][hf][4][c], ev[u2][hf][5][c]); w.w = pk2(ev[u2][hf][6][c], ev[u2][hf][7][c]);
                    oacc[hf * 4 + c] = __builtin_amdgcn_mfma_f32_16x16x32_bf16(__builtin_bit_cast(pg8::bf16x8, w), pf, oacc[hf * 4 + c], 0, 0, 0); } }
    }
    if (wid == 0) { const int kq = L + fq * 8; const pg8::bf16x8 pf = *(LAS const pg8::bf16x8*)(P + fr * 1056 + kq);
        const bool ok = fq < 2; const bf16* vr = VNp + (size_t)(ok ? (kq - L) : 0) * HD + 4 * fr;
#pragma unroll
        for (int hf = 0; hf < 2; ++hf)
#pragma unroll
            for (int c = 0; c < 4; ++c) { unsigned e[8];
#pragma unroll
                for (int j = 0; j < 8; ++j) e[j] = ok ? (unsigned)vr[(size_t)j * HD + hf * 64 + c] : 0u;
                v4u w; w.x = e[0] | (e[1] << 16); w.y = e[2] | (e[3] << 16); w.z = e[4] | (e[5] << 16); w.w = e[6] | (e[7] << 16);
                oacc[hf * 4 + c] = __builtin_amdgcn_mfma_f32_16x16x32_bf16(__builtin_bit_cast(pg8::bf16x8, w), pf, oacc[hf * 4 + c], 0, 0, 0); } }
    LAS float* PO = (LAS float*)lds;
#pragma unroll
    for (int hf = 0; hf < 2; ++hf)
#pragma unroll
        for (int r = 0; r < 4; ++r) *(LAS f32x4*)(PO + (wid * 16 + fr) * 128 + hf * 64 + 16 * fq + 4 * r) = (f32x4){oacc[hf * 4][r], oacc[hf * 4 + 1][r], oacc[hf * 4 + 2][r], oacc[hf * 4 + 3][r]};
    asm volatile("s_waitcnt lgkmcnt(0)" ::: "memory"); __syncthreads();
    { const int q = tid >> 5, d4 = (tid & 31) * 4; f32x4 s = *(LAS const f32x4*)(PO + q * 128 + d4);
#pragma unroll
      for (int w = 1; w < 8; ++w) { const f32x4 t = *(LAS const f32x4*)(PO + (w * 16 + q) * 128 + d4); s = s + t; }
      const float ri = RI[q];
      bf16* o = (bf16*)(ws + WS_OB) + ((size_t)MP + st * SN + q) * D + h * HD + d4;
      *(GAS unsigned long long*)o = (unsigned long long)pk2(s.x * ri, s.y * ri) | ((unsigned long long)pk2(s.z * ri, s.w * ri) << 32); }
    __syncthreads();
}

constexpr int N_PROMPT = NB * NH * 32, N_UNIT = SB * NH, N_POS = N_PROMPT + N_UNIT + N_SLICE;
static_assert(N_UNIT == N_SLICE && N_PROMPT >= 2 * N_UNIT, "ticket layout");
template <int MODE> __device__ __forceinline__ void pos_decode(int pos, int& kind, int& id) {
    if (pos < 4 * N_UNIT) { const int g = pos >> 2, r = pos & 3; if (r == 2) { kind = 1; id = g; } else if (r == 3) { kind = 2; id = g; } else { kind = 0; id = 2 * g + r; } }
    else { kind = 0; id = pos - 2 * N_UNIT; }
}
template <int MODE>
__device__ __forceinline__ void get_blk(int p, int li, unsigned char* ws, const float* rel, att::Blk& b) {
    bf16* QPp = (bf16*)(ws + WS_QP); bf16* KPp = (bf16*)(ws + WS_KP); bf16* VPp = (bf16*)(ws + WS_VP); bf16* OBp = (bf16*)(ws + WS_OB);
    int bh, qb;
    bh = p & 31; qb = 31 - (p >> 5);
    const int bb = bh >> 4, h = bh & 15;
    b.Q = QPp + ((size_t)bh * T + qb * 256) * HD; b.K = KPp + (size_t)bh * T * HD; b.V = VPp + (size_t)bh * T * HD; b.O = OBp + ((size_t)bb * T + qb * 256) * D + h * HD; b.P0 = qb * 256;
    if (MODE == 0) { b.aux = rel + (size_t)(li * NH + h) * NREL; b.c0 = qb * 4; b.jlo = b.c0 > 8 ? b.c0 - 8 : 0; b.jhi = b.c0 + 4; b.cap = 1 << 29; b.skipthr = __builtin_inff(); }
    else { b.aux = (const float*)(ws + WS_LFP) + (size_t)bh * T; b.c0 = 0; b.jlo = 0; b.jhi = 4 * (qb + 1); b.cap = qb * 256 + 255; b.skipthr = ((const float*)(ws + WS_QKM))[li]; }
}
__device__ __forceinline__ int take_ticket(gu32* qc, LAS unsigned char* lds, int tid) {
    volatile LAS int* w = (volatile LAS int*)(lds + 131008);
    if (tid == 0) *w = (int)__hip_atomic_fetch_add(qc, 1u, RLX_AGENT);
    __syncthreads();
    return __builtin_amdgcn_readfirstlane(*w);
}
template <int MODE>
__device__ __forceinline__ void attn_phase(LAS unsigned char* lds, int bx, int G, int layer, unsigned char* ws, const float* const __attribute__((address_space(4)))* in, const int tid) {
    att::Blk cur; att::Nxt nxt; att::Seam S;
    const int li = layer >> 1;
    const float* rel = in[12]; const float* kcache = in[MODE == 1 ? 4 : 2]; const float* vcache = in[MODE == 1 ? 5 : 3];
    gu32* qc = (gu32*)(ws + WS_CTL) + CW_QUEUE + 64 * layer;
    int pos = take_ticket(qc, lds, tid);
    while (pos < N_POS) {
        int kind, id; pos_decode<MODE>(pos, kind, id);
        if (kind != 0) {
            if (kind == 1) sample_attn<MODE>((LAS char*)lds, id, li, ws, rel, kcache, vcache, tid);
            else conv_slice(in, ws, layer + 1, id, lds, tid);
            pos = take_ticket(qc, lds, tid); continue; }
        get_blk<MODE>(id, li, ws, rel, cur);
        att::attn_prime<MODE>(cur, (LAS char*)lds, S, tid);
        for (;;) {
            int np = N_POS, id2 = 0; bool nf = false;
            int tk = 0;
            att::attn_block<MODE>(cur, [&]() { if (tid == 0) tk = (int)__hip_atomic_fetch_add(qc, 1u, RLX_AGENT); },
                [&](att::Nxt& nxt) {
                { volatile LAS int* w = (volatile LAS int*)(lds + 131008); if (tid == 0) *w = tk; __syncthreads(); np = __builtin_amdgcn_readfirstlane(*w); }
                int k2 = 3; if (np < N_POS) pos_decode<MODE>(np, k2, id2);
                nf = (k2 == 0);
                att::Blk nb; if (nf) { get_blk<MODE>(id2, li, ws, rel, nb); nxt.Q = nb.Q; nxt.K = nb.K; nxt.V = nb.V; nxt.jlo = nb.jlo; } else { nxt.Q = cur.Q; nxt.K = cur.K; nxt.V = cur.V; nxt.jlo = cur.jlo; }
            }, (LAS char*)lds, S, tid);
            pos = np;
            if (!nf) break;
            int id3 = id2; asm volatile("" : "+s"(id3));
            get_blk<MODE>(id3, li, ws, rel, cur);
        }
    }
}

struct Args { const float* in[19]; float* out; unsigned char* ws; int ph_lo, ph_hi; };
constexpr int PH_PER_LAYER = 5, N_PHASES = 1 + DEPTH * PH_PER_LAYER;

typedef const __attribute__((address_space(4))) Args CArgs;
#define PH_BEGIN() CArgs* A; { unsigned long long k_ = (unsigned long long)__builtin_amdgcn_kernarg_segment_ptr(); asm volatile("" : "+s"(k_)); A = (CArgs*)k_; } \
    unsigned char* const ws = A->ws; float* const out = A->out; int bx = blockIdx.x; asm volatile("" : "+s"(bx)); (void)ws; (void)out; (void)bx; \
    unsigned m1_ = ~0u; int ws_ = wave_s; asm volatile("" : "+s"(m1_), "+s"(ws_)); int tid = ws_ * 64 + (int)__builtin_amdgcn_mbcnt_hi(m1_, __builtin_amdgcn_mbcnt_lo(m1_, 0u)); asm volatile("" : "+v"(tid)); const int lane = tid & 63, wave = wave_s; (void)lane; (void)wave; \
    const int gw = bx * NWAVES + wave, NGW = G * NWAVES; const long gt = (long)bx * (NWAVES * 64) + tid, NGT = (long)G * (NWAVES * 64); (void)gw; (void)NGW; (void)gt; (void)NGT
__global__ void __launch_bounds__(NWAVES * 64, 2) fwd_kernel(Args args_unused) {
    extern __shared__ __attribute__((aligned(16))) unsigned char lds_raw[];
    LAS unsigned char* lds = (LAS unsigned char*)lds_raw;
    volatile LAS unsigned* MISC = (volatile LAS unsigned*)(lds + MISC_OFF);
    const int G = gridDim.x;
    const int wave_s = __builtin_amdgcn_readfirstlane((int)threadIdx.x >> 6);
    for (int u = threadIdx.x; u < (LDS_BYTES - LDSCTL_OFF) / 4; u += NWAVES * 64) ((LAS unsigned*)(lds + LDSCTL_OFF))[u] = 0u;
    __syncthreads();
    int lo, hi; XcdBarrier bar;
    { PH_BEGIN(); lo = A->ph_lo; hi = A->ph_hi; bar = xcd_barrier_post((unsigned*)((gu32*)(ws + WS_CTL) + CW_BAR), MISC + 8, tid == 0); }
#define IN(k) (lo <= (k) && (k) < hi)
#define SEAM(k) do { if (IN(k) && IN((k) + 1)) { XcdBarrier b2_ = bar; unsigned m2_ = ~0u; int w2_ = wave_s; asm volatile("" : "+s"(b2_.bar), "+s"(m2_), "+s"(w2_)); \
    xcd_barrier(b2_, w2_ == 0 && __builtin_amdgcn_mbcnt_hi(m2_, __builtin_amdgcn_mbcnt_lo(m2_, 0u)) == 0u); } } while (0)
#define P_WQKV ((bf16*)(ws + WS_WQKV))
#define P_WO ((bf16*)(ws + WS_WO))
#define P_WGU ((bf16*)(ws + WS_WGU))
#define P_WD ((bf16*)(ws + WS_WD))
#define P_XB ((bf16*)(ws + WS_XB))
#define P_SSQ ((float*)(ws + WS_SSQ))
#define P_QP ((bf16*)(ws + WS_QP))
#define P_KP ((bf16*)(ws + WS_KP))
#define P_VP ((bf16*)(ws + WS_VP))
#define P_QS ((bf16*)(ws + WS_QS))
#define P_OB ((bf16*)(ws + WS_OB))
#define P_HB ((bf16*)(ws + WS_HB))
#define P_LFP ((float*)(ws + WS_LFP))
#define P_LFS ((float*)(ws + WS_LFS))
#define P_KSN ((bf16*)(ws + WS_KSN))
#define P_VSN ((bf16*)(ws + WS_VSN))
#define P_WF ((bf16*)(ws + WS_WF))
#define P_X (out + O_Y)

    if (IN(0)) { PH_BEGIN();
        LAS float* scr = (LAS float*)(lds + RING_OFF + wave * 16384);
        for (int it = gw; it < conv_group_items(0); it += NGW) conv_item(A->in, ws, 0, it, scr, lane);
        for (int row = gw; row < M; row += NGW) {
            const float* xr = row < MP ? A->in[0] + (size_t)row * D : A->in[1] + (size_t)(row - MP) * D;
            row_update(xr, nullptr, nullptr, P_XB + (size_t)row * D, P_SSQ + (size_t)row * 32, lane);
        }
        for (long idx = gt; idx < 2L * NH * D; idx += NGT) { const int ib = (int)(idx >> 15), h = (int)((idx >> 11) & 15), k = (int)(idx & (D - 1));
            P_WF[idx] = (bf16)f2bf(A->in[7][(size_t)(2 * ib + 1) * D + k] * A->in[13][((size_t)ib * D + k) * NH + h]); }
        if (gw == 0) {
#pragma unroll 1
            for (int ib = 0; ib < 2; ++ib) { const float* gq = A->in[9] + (2 * ib + 1) * HD; const float* gk = A->in[10] + (2 * ib + 1) * HD;
                float mqk = fmaxf(fabsf(gq[lane] * gk[lane]), fabsf(gq[lane + 64] * gk[lane + 64]));
#pragma unroll
                for (int o = 1; o < 64; o <<= 1) mqk = fmaxf(mqk, __shfl_xor(mqk, o));
                if (lane == 0) ((float*)(ws + WS_QKM))[ib] = 11.313708499f * mqk * 1.02f + 40.0f; }
        }
    }
    SEAM(0);

#pragma unroll 1
    for (int layer = 0; layer < DEPTH; ++layer) {
        const int pb = 1 + layer * PH_PER_LAYER, li = layer >> 1; const bool fox = (layer & 1) != 0;
        if (IN(pb + 0)) { PH_BEGIN();
            if (fox) {
                const bf16* wfp = P_WF + (size_t)li * NH * D; const float* bfp = A->in[14] + li * NH;
                const int fr = lane & 15, fq = lane >> 4, lr = lane >> 2, lc = lane & 3, pidx = (((lane & 15) << 2) | (lane >> 4)) << 2;
                const int nidle = (G > 192) ? (G - 192) * NWAVES : NGW, gw0 = (G > 192) ? (bx - 192) * NWAVES + wave : gw;
                if (gw0 >= 0)
                for (int grp = gw0; grp < M / 16; grp += nidle) {
                    const int row = grp * 16 + fr;
                    const char* ap = (const char*)(P_XB + (size_t)(grp * 16 + lr) * D) + lc * 16; const char* bp = (const char*)(wfp + (size_t)lr * D) + lc * 16;
                    pg8::f32x4 acc = (pg8::f32x4){0.f, 0.f, 0.f, 0.f};
#pragma unroll 8
                    for (int ks = 0; ks < D / 32; ++ks) { pg8::u32x4 av = *(const pg8::u32x4*)(ap + ks * 64), bv = *(const pg8::u32x4*)(bp + ks * 64);
                        av.x = (unsigned)__builtin_amdgcn_ds_bpermute(pidx, (int)av.x); av.y = (unsigned)__builtin_amdgcn_ds_bpermute(pidx, (int)av.y); av.z = (unsigned)__builtin_amdgcn_ds_bpermute(pidx, (int)av.z); av.w = (unsigned)__builtin_amdgcn_ds_bpermute(pidx, (int)av.w);
                        bv.x = (unsigned)__builtin_amdgcn_ds_bpermute(pidx, (int)bv.x); bv.y = (unsigned)__builtin_amdgcn_ds_bpermute(pidx, (int)bv.y); bv.z = (unsigned)__builtin_amdgcn_ds_bpermute(pidx, (int)bv.z); bv.w = (unsigned)__builtin_amdgcn_ds_bpermute(pidx, (int)bv.w);
                        acc = __builtin_amdgcn_mfma_f32_16x16x32_bf16(__builtin_bit_cast(pg8::bf16x8, bv), __builtin_bit_cast(pg8::bf16x8, av), acc, 0, 0, 0); }
                    const float rs = pg8::row_rstd(P_SSQ, row, fq);
                    const pg8::f32x4 bb = *(const pg8::f32x4*)(bfp + 4 * fq); pg8::f32x4 lf;
#pragma unroll
                    for (int i = 0; i < 4; ++i) { const float z = acc[i] * rs + bb[i]; lf[i] = fminf(z, 0.f) - log1pf(expf(-fabsf(z))); }
                    if (row < MP) { *(pg8::f32x4*)(out + O_BFP + ((size_t)li * MP + row) * NH + 4 * fq) = lf;
#pragma unroll
                        for (int i = 0; i < 4; ++i) P_LFP[(size_t)((row >> 13) * NH + 4 * fq + i) * T + (row & (T - 1))] = lf[i]; }
                    else { const int rs2 = row - MP; *(pg8::f32x4*)(out + O_BFS + ((size_t)li * MS + rs2) * NH + 4 * fq) = lf;
#pragma unroll
                        for (int i = 0; i < 4; ++i) P_LFS[(size_t)((rs2 >> 4) * NH + 4 * fq + i) * LS + PAST + (rs2 & 15)] = lf[i]; }
                }
                const float* clf = A->in[6] + (size_t)li * SB * PAST * NH;
                for (long idx = gt; idx < (long)SB * NH * PAST; idx += NGT) { const int unit = (int)(idx >> 10), j = (int)(idx & 1023), st = unit >> 4, h = unit & 15;
                    P_LFS[(size_t)unit * LS + j] = clf[((size_t)st * PAST + j) * NH + h]; }
            }
            pg8::Gemm g{P_XB, P_WQKV + (size_t)layer * NQKV * D, MP, NQKV, D}; pg8::StaticOrder S; S.init(MP, NQKV, G, bx);
            pg8::EpiQKV E;
            E.ssq = P_SSQ; E.gq = A->in[9] + layer * HD; E.gk = A->in[10] + layer * HD; E.QP = P_QP; E.pstride = (WS_KP - WS_QP) / 2; E.QS = P_QS;
            E.srows = SN; E.lc = 0; E.KS = P_KSN; E.sstride = (WS_VSN - WS_KSN) / 2;
            E.okp = out + (fox ? O_BKP + (size_t)li * MP * D : O_AKP + (size_t)li * NB * WIN * D); E.opstride = fox ? SZ_BP : SZ_AP;
            E.oks = out + (fox ? O_BKS : O_AKS) + (size_t)li * MS * D; E.osstride = SZ_S;
            E.fox = fox ? 1 : 0; E.red = (LAS float*)(lds + RED_OFF);
            pg8::gemm_phase<pg8::EpiQKV, pg8::StaticOrder, true, true>(lds + RING_OFF, g, S, E, tid);
            __syncthreads();
            {
                sk::SkQKV K2; K2.ssq = P_SSQ + (size_t)MP * 32; K2.gq = A->in[9] + layer * HD; K2.gk = A->in[10] + layer * HD; K2.QS = P_QS;
                K2.srows = SN; K2.lc = 0; K2.KS = P_KSN; K2.sstride = (WS_VSN - WS_KSN) / 2;
                K2.oks = out + (fox ? O_BKS : O_AKS) + (size_t)li * MS * D; K2.osstride = SZ_S;
                sk::skinny_phase<sk::SkQKV>(lds + RING_OFF, P_XB + (size_t)MP * D, P_WQKV + (size_t)layer * NQKV * D, NQKV / 128, D, (unsigned*)((gu32*)(ws + WS_CTL) + CW_SKQ + 64 * (layer * 4 + 0)), tid, K2);
            }
        }
        SEAM(pb + 0);
        if (IN(pb + 1)) { PH_BEGIN();
            if (fox) attn_phase<1>(lds + RING_OFF, bx, G, layer, ws, A->in, tid);
            else attn_phase<0>(lds + RING_OFF, bx, G, layer, ws, A->in, tid);
        }
        SEAM(pb + 1);
        if (IN(pb + 2)) { PH_BEGIN();
            pg8::Gemm g{P_OB, P_WO + (size_t)layer * D * D, MP, D, D}; pg8::StaticOrder S; S.init(MP, D, G, bx);
            pg8::EpiResid E;
            E.X = nullptr; E.XB = P_XB; E.ssq = P_SSQ;
            pg8::gemm_phase<pg8::EpiResid, pg8::StaticOrder, true, true>(lds + RING_OFF, g, S, E, tid);
            __syncthreads();
            {   sk::SkResid K2; K2.xin = (layer == 0) ? A->in[1] : P_X + (size_t)MP * D; K2.X = P_X + (size_t)MP * D; K2.XB = P_XB + (size_t)MP * D; K2.ssq = P_SSQ + (size_t)MP * 32;
                sk::skinny_phase<sk::SkResid>(lds + RING_OFF, P_OB + (size_t)MP * D, P_WO + (size_t)layer * D * D, D / 64, D, (unsigned*)((gu32*)(ws + WS_CTL) + CW_SKQ + 64 * (layer * 4 + 1)), tid, K2); }
        }
        SEAM(pb + 2);
        if (IN(pb + 3)) { PH_BEGIN();
            pg8::Gemm g{P_XB, P_WGU + (size_t)layer * NGU * D, MP, NGU, D}; pg8::StaticOrder S; S.init(MP, NGU, G, bx);
            pg8::EpiSwiglu E{P_HB, FF, P_SSQ};
            pg8::gemm_phase<pg8::EpiSwiglu, pg8::StaticOrder, true, true>(lds + RING_OFF, g, S, E, tid);
            __syncthreads();
            {   sk::SkSwiglu K2{P_HB + (size_t)MP * FF, FF, P_SSQ + (size_t)MP * 32};
                sk::skinny_phase<sk::SkSwiglu>(lds + RING_OFF, P_XB + (size_t)MP * D, P_WGU + (size_t)layer * NGU * D, NGU / 128, D, (unsigned*)((gu32*)(ws + WS_CTL) + CW_SKQ + 64 * (layer * 4 + 2)), tid, K2); }
        }
        SEAM(pb + 3);
        if (IN(pb + 4)) { PH_BEGIN();
            pg8::Gemm g{P_HB, P_WD + (size_t)layer * D * FF, MP, D, FF}; pg8::StaticOrder S; S.init(MP, D, G, bx);
            pg8::EpiResid E;
            E.X = (layer == DEPTH - 1) ? P_X : nullptr; E.XB = P_XB; E.ssq = P_SSQ;
            pg8::gemm_phase<pg8::EpiResid, pg8::StaticOrder, true, true>(lds + RING_OFF, g, S, E, tid);
            __syncthreads();
            {   sk::SkResid K2; K2.xin = P_X + (size_t)MP * D; K2.X = P_X + (size_t)MP * D; K2.XB = P_XB + (size_t)MP * D; K2.ssq = P_SSQ + (size_t)MP * 32;
                sk::skinny_phase<sk::SkResid>(lds + RING_OFF, P_HB + (size_t)MP * FF, P_WD + (size_t)layer * D * FF, D / 64, FF, (unsigned*)((gu32*)(ws + WS_CTL) + CW_SKQ + 64 * (layer * 4 + 3)), tid, K2); }
        }
        SEAM(pb + 4);
    }
#undef IN
#undef SEAM
}

#ifndef MK_SPLIT
#define MK_SPLIT 0
#endif
extern "C" void kernel_launch(void* const* d_in, const int* in_sizes, int n_in, void* d_out, int out_size, void* d_ws, size_t ws_size, hipStream_t stream) {
    static int grid = 0;
    if (grid == 0) {
        if (n_in != 19 || in_sizes[0] != MP * D || (size_t)out_size != OUT_TOTAL || ws_size < WS_END) { fprintf(stderr, "kernel_launch: shape mismatch (n_in %d in0 %d out %d ws %zu); nothing launched\n", n_in, n_in > 0 ? in_sizes[0] : -1, out_size, ws_size); grid = -1; return; }
        int dev = 0, cus = 0;
        if (hipGetDevice(&dev) != hipSuccess || hipDeviceGetAttribute(&cus, hipDeviceAttributeMultiprocessorCount, dev) != hipSuccess) { grid = -1; return; }
        if (hipFuncSetAttribute((const void*)fwd_kernel, hipFuncAttributeMaxDynamicSharedMemorySize, LDS_BYTES) != hipSuccess) { fprintf(stderr, "kernel_launch: hipFuncSetAttribute failed\n"); grid = -1; return; }
        int per_cu = 0;
        if (hipOccupancyMaxActiveBlocksPerMultiprocessor(&per_cu, (const void*)fwd_kernel, NWAVES * 64, LDS_BYTES) != hipSuccess || per_cu < 1) fprintf(stderr, "kernel_launch: occupancy query reports %d\n", per_cu);
        (void)hipGetLastError();
        grid = cus;
    }
    if (grid < 0) return;
    if (hipMemsetAsync((char*)d_ws + WS_CTL, 0, CTL_ZERO_BYTES, stream) != hipSuccess) return;
    Args a{};
    for (int i = 0; i < 19; ++i) a.in[i] = (const float*)d_in[i];
    a.out = (float*)d_out; a.ws = (unsigned char*)d_ws;
#if MK_SPLIT
    for (int p = 0; p < N_PHASES; ++p) { a.ph_lo = p; a.ph_hi = p + 1; hipLaunchKernelGGL(fwd_kernel, dim3(grid), dim3(NWAVES * 64), LDS_BYTES, stream, a); }
#else
    a.ph_lo = 0; a.ph_hi = N_PHASES;
    hipLaunchKernelGGL(fwd_kernel, dim3(grid), dim3(NWAVES * 64), LDS_BYTES, stream, a);
#endif
}
```

```cpp
#include <hip/hip_runtime.h>
#include <cstdio>
#include <cstdint>
namespace pg8 {
#define PG8_LAS __attribute__((address_space(3)))
typedef unsigned short bf16_t;
typedef short bf16x8 __attribute__((ext_vector_type(8)));
typedef float f32x4 __attribute__((ext_vector_type(4)));
typedef unsigned u32x4 __attribute__((ext_vector_type(4)));
constexpr int BM = 256, BK = 64, HALF = 128, HTB = HALF * BK * 2  , STAGE_BYTES = 8 * HTB, NXCD = 8, WGM = 4;

__host__ __device__ __forceinline__ int lds_byte(int r, int c) { const int st = (r >> 4) * 2 + (c >> 5), rr = r & 15, cc = c & 31, ob = rr * 64 + cc * 2; return st * 1024 + (ob ^ (((ob >> 9) & 1) << 5)); }
__host__ __device__ __forceinline__ void stage_rc(int b, int& R, int& C) { const int st = b / 1024, sb = b % 1024, swz = sb ^ (((sb >> 9) & 1) << 5); R = (st >> 1) * 16 + swz / 64; C = (st & 1) * 32 + (swz % 64) / 2; }
__host__ __device__ __forceinline__ int perm32(int rho) { const int n = rho >> 4, i = rho & 15; return 8 * (i >> 2) + 4 * n + (i & 3); }

struct Unit { int pm, pn; };
struct Gemm { const bf16_t* A; const bf16_t* Bt; int M, N, K; };

struct StaticOrder {
    int nM, nN, nwg, G, c;
    __host__ __device__ void init(int M, int N, int G_, int c_) { nM = M / BM; nN = N / BM; nwg = nM * nN; G = G_; c = c_; }
    __host__ __device__ bool next(int i, Unit& u) const {
        const long L = (long)i * G + c; if (L >= nwg) return false;
        int wgid = (int)L; { const int q = nwg / NXCD, r = nwg % NXCD, xcd = wgid % NXCD, off = wgid / NXCD; wgid = (xcd < r ? xcd * (q + 1) : r * (q + 1) + (xcd - r) * q) + off; }
        const int nig = WGM * nN, gid = wgid / nig, fm = gid * WGM, gsz = (nM - fm) < WGM ? (nM - fm) : WGM;
        u.pm = fm + ((wgid % nig) % gsz); u.pn = (wgid % nig) / gsz; return true;
    }
    __device__ __forceinline__ void a_ready(const Unit&) const {}
    __device__ __forceinline__ void done(const Unit&) const {}
};

__device__ __forceinline__ unsigned cvt_pk_bf16(float lo, float hi) { unsigned r; asm volatile("v_cvt_pk_bf16_f32 %0, %1, %2" : "=v"(r) : "v"(lo), "v"(hi)); return r; }
struct EpiF32 {
    static constexpr bool PERM = false, AFTER_DRAIN = false;
    float* C; int ldc;
    __device__ __forceinline__ void operator()(const f32x4 (&acc)[2][2][4][2], const Unit& u, int wr, int wc, int fr, int fq) const {
        const int row0 = u.pm * BM + wr * 64 + fr, col0 = u.pn * BM + wc * 32 + 4 * fq;
#pragma unroll
        for (int ai = 0; ai < 2; ++ai)
#pragma unroll
            for (int m = 0; m < 4; ++m) { float* rowp = C + (size_t)(row0 + ai * HALF + m * 16) * ldc + col0;
#pragma unroll
                for (int bj = 0; bj < 2; ++bj)
#pragma unroll
                    for (int n = 0; n < 2; ++n) *(f32x4*)(rowp + bj * HALF + n * 16) = acc[ai][bj][m][n]; }
    }
};
template <class Epi, class Sched, bool ALIGN_EPI = false, bool SP2 = false>
__device__ __forceinline__ void gemm_phase(PG8_LAS unsigned char* lds, const Gemm g, const Sched& S, const Epi& E, const int tid_in) {
    int tid_ = tid_in; asm volatile("" : "+v"(tid_));
    const int tid = tid_, wid = __builtin_amdgcn_readfirstlane(tid >> 6), lane = tid & 63, wr = wid >> 2, wc = wid & 3, fr = lane & 15, fq = lane >> 4;
    const int K = g.K, nt = K / BK;
    unsigned voffA[2], voffB[2];
#pragma unroll
    for (int i = 0; i < 2; ++i) { int R, C; stage_rc(tid * 16 + i * 8192, R, C); const int Rb = Epi::PERM ? ((R & ~31) + perm32(R & 31)) : R;
        voffA[i] = (unsigned)(R * K + C) * 2u; voffB[i] = (unsigned)(Rb * K + C) * 2u; }
    const size_t kstep = (size_t)(BK * 2);
    const size_t hstep = (size_t)HALF * K * 2;
    const size_t tstep = 2 * hstep;
    const unsigned ldsw = (unsigned)wid * 1024u;
    const int aoff = lds_byte(wr * 64 + fr, fq * 8), boff = lds_byte(wc * 32 + fr, fq * 8);
#define PG8_SA(b, h) (((b) * 2 + (h)) * HTB)
#define PG8_SB(b, h) ((4 + (b) * 2 + (h)) * HTB)
#define PG8_STAGE(bufoff, gbase, voff) do { _Pragma("unroll") for (int _i = 0; _i < 2; ++_i) \
        __builtin_amdgcn_global_load_lds((const unsigned*)((const char*)(gbase) + (voff)[_i]), (PG8_LAS unsigned*)(lds + (bufoff) + ldsw + _i * 8192), 16, 0, 0); } while (0)
#define PG8_LDA(dst, b, h) do { _Pragma("unroll") for (int m = 0; m < 4; ++m) _Pragma("unroll") for (int k = 0; k < 2; ++k) dst[m][k] = *(const PG8_LAS bf16x8*)(lds + PG8_SA(b, h) + aoff + m * 2048 + k * 1024); } while (0)
#define PG8_LDB(dst, b, h) do { _Pragma("unroll") for (int n = 0; n < 2; ++n) _Pragma("unroll") for (int k = 0; k < 2; ++k) dst[n][k] = *(const PG8_LAS bf16x8*)(lds + PG8_SB(b, h) + boff + n * 2048 + k * 1024); } while (0)
#define PG8_MMA(ai, bj, At, Bt) do { __builtin_amdgcn_s_setprio(1); _Pragma("unroll") for (int m = 0; m < 4; ++m) _Pragma("unroll") for (int n = 0; n < 2; ++n) _Pragma("unroll") for (int k = 0; k < 2; ++k) \
        acc[ai][bj][m][n] = __builtin_amdgcn_mfma_f32_16x16x32_bf16(Bt[n][k], At[m][k], acc[ai][bj][m][n], 0, 0, 0); __builtin_amdgcn_s_setprio(0); } while (0)
#define PG8_WAIT_V(n) asm volatile("s_waitcnt vmcnt(" #n ")" ::: "memory")
#define PG8_WAIT_L(n) asm volatile("s_waitcnt lgkmcnt(" #n ")" ::: "memory")
#define PG8_BAR __builtin_amdgcn_s_barrier()
#define PG8_SCHED __builtin_amdgcn_sched_barrier(0)
    Unit cur, nxt; int ui = 0;
    if (!S.next(0, cur)) return;
    f32x4 acc[2][2][4][2];
#pragma unroll
    for (int a = 0; a < 2; ++a)
#pragma unroll
        for (int b = 0; b < 2; ++b)
#pragma unroll
            for (int m = 0; m < 4; ++m)
#pragma unroll
                for (int n = 0; n < 2; ++n) acc[a][b][m][n] = (f32x4){0.f, 0.f, 0.f, 0.f};
    bf16x8 At[4][2], B0[2][2], B1[2][2];
    const char* cA = (const char*)g.A + (size_t)cur.pm * tstep; const char* cB = (const char*)g.Bt + (size_t)cur.pn * tstep;
    S.a_ready(cur);
    if constexpr (SP2) {
        PG8_STAGE(PG8_SB(0, 0), cB, voffB); PG8_STAGE(PG8_SB(0, 1), cB + hstep, voffB); PG8_STAGE(PG8_SA(0, 0), cA, voffA); PG8_STAGE(PG8_SA(0, 1), cA + hstep, voffA);
        if (wr == 1) PG8_BAR;
        PG8_WAIT_V(2); PG8_BAR;
        PG8_STAGE(PG8_SB(1, 0), cB + kstep, voffB); PG8_STAGE(PG8_SA(1, 0), cA + kstep, voffA); PG8_STAGE(PG8_SB(1, 1), cB + hstep + kstep, voffB);
        PG8_WAIT_V(6); PG8_BAR;
    } else {
        PG8_STAGE(PG8_SB(0, 0), cB, voffB); PG8_STAGE(PG8_SA(0, 0), cA, voffA); PG8_STAGE(PG8_SB(0, 1), cB + hstep, voffB); PG8_STAGE(PG8_SA(0, 1), cA + hstep, voffA);
        if (wr == 1) PG8_BAR;
        PG8_WAIT_V(4); PG8_BAR;
        PG8_STAGE(PG8_SB(1, 0), cB + kstep, voffB); PG8_STAGE(PG8_SA(1, 0), cA + kstep, voffA); PG8_STAGE(PG8_SB(1, 1), cB + hstep + kstep, voffB);
        PG8_WAIT_V(6); PG8_BAR;
    }
    for (;;) {
        const bool has_next = S.next(ui + 1, nxt);
        const char* nA = has_next ? (const char*)g.A + (size_t)nxt.pm * tstep : cA; const char* nB = has_next ? (const char*)g.Bt + (size_t)nxt.pn * tstep : cB;
        for (int t = 0; t < nt; t += 2) {
            const bool last = (t == nt - 2);
            const char* a1 = cA + (size_t)(t + 1) * kstep;
            const char* a2 = last ? nA : cA + (size_t)(t + 2) * kstep; const char* b2 = last ? nB : cB + (size_t)(t + 2) * kstep;
            const char* a3 = a2 + kstep; const char* b3 = b2 + kstep;
            if (last && has_next) S.a_ready(nxt);
            if constexpr (SP2) {
            PG8_LDB(B0, 0, 0); PG8_LDB(B1, 0, 1); PG8_SCHED; PG8_LDA(At, 0, 0); PG8_STAGE(PG8_SA(1, 1), a1 + hstep, voffA);
            PG8_WAIT_V(8); PG8_WAIT_L(0); PG8_BAR; PG8_MMA(0, 0, At, B0); PG8_MMA(0, 1, At, B1); PG8_BAR; PG8_SCHED;
            PG8_LDA(At, 0, 1); PG8_STAGE(PG8_SB(0, 0), b2, voffB); PG8_STAGE(PG8_SB(0, 1), b2 + hstep, voffB); PG8_STAGE(PG8_SA(0, 0), a2, voffA);
            PG8_WAIT_V(8); PG8_WAIT_L(0); PG8_BAR; PG8_MMA(1, 0, At, B0); PG8_MMA(1, 1, At, B1); PG8_BAR; PG8_SCHED;
            PG8_LDB(B0, 1, 0); PG8_LDB(B1, 1, 1); PG8_SCHED; PG8_LDA(At, 1, 0); PG8_STAGE(PG8_SA(0, 1), a2 + hstep, voffA);
            PG8_WAIT_V(8); PG8_WAIT_L(0); PG8_BAR; PG8_MMA(0, 0, At, B0); PG8_MMA(0, 1, At, B1); PG8_BAR; PG8_SCHED;
            PG8_LDA(At, 1, 1); PG8_STAGE(PG8_SB(1, 0), b3, voffB); PG8_STAGE(PG8_SB(1, 1), b3 + hstep, voffB); PG8_STAGE(PG8_SA(1, 0), a3, voffA);
            PG8_WAIT_V(8); PG8_WAIT_L(0); PG8_BAR; PG8_MMA(1, 0, At, B0); PG8_MMA(1, 1, At, B1); PG8_BAR; PG8_SCHED;
            } else {
            PG8_LDB(B0, 0, 0); PG8_SCHED; PG8_LDA(At, 0, 0); PG8_STAGE(PG8_SA(1, 1), a1 + hstep, voffA);
            PG8_WAIT_L(8); PG8_BAR; PG8_WAIT_L(0); PG8_MMA(0, 0, At, B0); PG8_BAR; PG8_SCHED;
            PG8_LDB(B1, 0, 1); PG8_STAGE(PG8_SB(0, 0), b2, voffB);
            PG8_BAR; PG8_WAIT_L(0); PG8_MMA(0, 1, At, B1); PG8_BAR;
            PG8_LDA(At, 0, 1); PG8_STAGE(PG8_SA(0, 0), a2, voffA);
            PG8_BAR; PG8_WAIT_L(0); PG8_MMA(1, 0, At, B0); PG8_BAR; PG8_SCHED;
            PG8_STAGE(PG8_SB(0, 1), b2 + hstep, voffB);
            PG8_WAIT_V(6); PG8_BAR; PG8_MMA(1, 1, At, B1); PG8_BAR;
            PG8_LDB(B0, 1, 0); PG8_SCHED; PG8_LDA(At, 1, 0); PG8_STAGE(PG8_SA(0, 1), a2 + hstep, voffA);
            PG8_WAIT_L(8); PG8_BAR; PG8_WAIT_L(0); PG8_MMA(0, 0, At, B0); PG8_BAR; PG8_SCHED;
            PG8_LDB(B1, 1, 1); PG8_STAGE(PG8_SB(1, 0), b3, voffB);
            PG8_BAR; PG8_WAIT_L(0); PG8_MMA(0, 1, At, B1); PG8_BAR;
            PG8_LDA(At, 1, 1); PG8_STAGE(PG8_SA(1, 0), a3, voffA);
            PG8_BAR; PG8_WAIT_L(0); PG8_MMA(1, 0, At, B0); PG8_BAR; PG8_SCHED;
            PG8_STAGE(PG8_SB(1, 1), b3 + hstep, voffB);
            PG8_WAIT_V(6); PG8_BAR; PG8_MMA(1, 1, At, B1); PG8_BAR;
            }
        }
        if constexpr (ALIGN_EPI) { if (wr == 0) PG8_BAR; }
        if constexpr (!Epi::AFTER_DRAIN) { E(acc, cur, wr, wc, fr, fq); S.done(cur); }
        if (!has_next) break;
#pragma unroll
        for (int a = 0; a < 2; ++a)
#pragma unroll
            for (int b = 0; b < 2; ++b)
#pragma unroll
                for (int m = 0; m < 4; ++m)
#pragma unroll
                    for (int n = 0; n < 2; ++n) acc[a][b][m][n] = (f32x4){0.f, 0.f, 0.f, 0.f};
        cur = nxt; cA = nA; cB = nB; ++ui;
        if constexpr (ALIGN_EPI) { if (wr == 1) PG8_BAR; }
    }
    PG8_WAIT_V(0);
    if constexpr (!ALIGN_EPI) { if (wr == 0) PG8_BAR; }
    PG8_BAR;
    if constexpr (Epi::AFTER_DRAIN) { E.fused(acc, cur, wr, wc, fr, fq, lds, wid, lane); S.done(cur); }
#undef PG8_SA
#undef PG8_SB
#undef PG8_STAGE
#undef PG8_LDA
#undef PG8_LDB
#undef PG8_MMA
#undef PG8_WAIT_V
#undef PG8_WAIT_L
#undef PG8_BAR
#undef PG8_SCHED
}
}

namespace pg8 {
typedef unsigned u32x2 __attribute__((ext_vector_type(2)));
typedef float f32x2 __attribute__((ext_vector_type(2)));
__device__ __forceinline__ void rows_rstd(float (&rs)[2][4], const float* ssq, int pm, int wr, int fr, int fq) {
    f32x4 pa[2][4], pb[2][4];
    const float* base = ssq + (size_t)(pm * BM + wr * 64 + fr) * 32 + fq * 8;
#pragma unroll
    for (int ai = 0; ai < 2; ++ai)
#pragma unroll
        for (int m = 0; m < 4; ++m) { pa[ai][m] = *(const f32x4*)(base + (ai * HALF + m * 16) * 32); pb[ai][m] = *(const f32x4*)(base + (ai * HALF + m * 16) * 32 + 4); }
#pragma unroll
    for (int ai = 0; ai < 2; ++ai)
#pragma unroll
        for (int m = 0; m < 4; ++m) { const f32x4 a = pa[ai][m], b = pb[ai][m];
            float s = ((a[0] + a[1]) + (a[2] + a[3])) + ((b[0] + b[1]) + (b[2] + b[3]));
            s += __shfl_xor(s, 16); s += __shfl_xor(s, 32);
            rs[ai][m] = __builtin_amdgcn_rsqf(s * (1.0f / 2048.0f) + 1e-6f); }
}
__device__ __forceinline__ f32x4 to_rowmajor(f32x4 v, int pidx) {
    f32x4 o; o[0] = __int_as_float(__builtin_amdgcn_ds_bpermute(pidx, __float_as_int(v[0]))); o[1] = __int_as_float(__builtin_amdgcn_ds_bpermute(pidx, __float_as_int(v[1])));
    o[2] = __int_as_float(__builtin_amdgcn_ds_bpermute(pidx, __float_as_int(v[2]))); o[3] = __int_as_float(__builtin_amdgcn_ds_bpermute(pidx, __float_as_int(v[3]))); return o;
}
__device__ __forceinline__ int rowmajor_pidx(int lane) { return (((lane & 3) << 4) | (lane >> 2)) << 2; }
__device__ __forceinline__ void rows_rstd_rm(float (&rs)[2][4], const float* ssq, int pm, int wr, int r2, int c2) {
    f32x4 pa[2][4], pb[2][4];
    const float* base = ssq + (size_t)(pm * BM + wr * 64 + r2) * 32 + c2 * 8;
#pragma unroll
    for (int ai = 0; ai < 2; ++ai)
#pragma unroll
        for (int m = 0; m < 4; ++m) { pa[ai][m] = *(const f32x4*)(base + (ai * HALF + m * 16) * 32); pb[ai][m] = *(const f32x4*)(base + (ai * HALF + m * 16) * 32 + 4); }
#pragma unroll
    for (int ai = 0; ai < 2; ++ai)
#pragma unroll
        for (int m = 0; m < 4; ++m) { const f32x4 a = pa[ai][m], b = pb[ai][m];
            float s = ((a[0] + a[1]) + (a[2] + a[3])) + ((b[0] + b[1]) + (b[2] + b[3]));
            s += __shfl_xor(s, 1); s += __shfl_xor(s, 2);
            rs[ai][m] = __builtin_amdgcn_rsqf(s * (1.0f / 2048.0f) + 1e-6f); }
}
__device__ __forceinline__ float row_rstd(const float* ssq, int row, int fq) {
    const f32x4 a = *(const f32x4*)(ssq + (size_t)row * 32 + fq * 8), b = *(const f32x4*)(ssq + (size_t)row * 32 + fq * 8 + 4);
    float s = ((a[0] + a[1]) + (a[2] + a[3])) + ((b[0] + b[1]) + (b[2] + b[3]));
    s += __shfl_xor(s, 16); s += __shfl_xor(s, 32);
    return __builtin_amdgcn_rsqf(s * (1.0f / 2048.0f) + 1e-6f);
}
struct EpiResid {
    static constexpr bool PERM = true, AFTER_DRAIN = false;
    float* X; bf16_t* XB; float* ssq;
    __device__ __forceinline__ void operator()(const f32x4 (&acc)[2][2][4][2], const Unit& u, int wr, int wc, int fr_, int fq_) const {
        const int lane = fq_ * 16 + fr_, r2 = lane >> 2, c2 = lane & 3, pidx = rowmajor_pidx(lane);
        const int row0 = u.pm * BM + wr * 64 + r2, col0 = u.pn * BM + wc * 32 + 8 * c2;
        u32x4 v[4][2];
#define EPR_LOAD(g) do { const size_t off_ = (size_t)(row0 + ((g) >> 2) * HALF + ((g) & 3) * 16) * 2048 + col0; _Pragma("unroll") for (int bj = 0; bj < 2; ++bj) \
            v[(g) & 3][bj] = *(const u32x4*)(XB + off_ + bj * HALF); } while (0)
        EPR_LOAD(0); EPR_LOAD(1); EPR_LOAD(2);
#pragma unroll
        for (int g = 0; g < 8; ++g) { const int ai = g >> 2, m = g & 3; const int row = row0 + ai * HALF + m * 16; const size_t off = (size_t)row * 2048 + col0; float s = 0.f;
            if (g + 3 < 8) EPR_LOAD(g + 3);
#pragma unroll
            for (int bj = 0; bj < 2; ++bj) { const u32x4 xo = v[g & 3][bj];
                const f32x4 x0 = (f32x4){__uint_as_float(xo.x << 16), __uint_as_float(xo.x & 0xffff0000u), __uint_as_float(xo.y << 16), __uint_as_float(xo.y & 0xffff0000u)} + to_rowmajor(acc[ai][bj][m][0], pidx);
                const f32x4 x1 = (f32x4){__uint_as_float(xo.z << 16), __uint_as_float(xo.z & 0xffff0000u), __uint_as_float(xo.w << 16), __uint_as_float(xo.w & 0xffff0000u)} + to_rowmajor(acc[ai][bj][m][1], pidx);
                if (X != nullptr) { *(f32x4*)(X + off + bj * HALF) = x0; *(f32x4*)(X + off + bj * HALF + 4) = x1; }
                u32x4 w; w.x = cvt_pk_bf16(x0[0], x0[1]); w.y = cvt_pk_bf16(x0[2], x0[3]); w.z = cvt_pk_bf16(x1[0], x1[1]); w.w = cvt_pk_bf16(x1[2], x1[3]); *(u32x4*)(XB + off + bj * HALF) = w;
                s += ((x0[0] * x0[0] + x0[1] * x0[1]) + (x0[2] * x0[2] + x0[3] * x0[3])) + ((x1[0] * x1[0] + x1[1] * x1[1]) + (x1[2] * x1[2] + x1[3] * x1[3])); }
            s += __shfl_xor(s, 1); s += __shfl_xor(s, 2);
            if (c2 == 0) ssq[(size_t)row * 32 + u.pn * 4 + wc] = s;
            asm volatile("" ::: "memory"); }
#undef EPR_LOAD
    }
};
struct EpiSwiglu {
    static constexpr bool PERM = true, AFTER_DRAIN = false;
    bf16_t* H; int ldh; const float* ssq;
    __device__ __forceinline__ void operator()(const f32x4 (&acc)[2][2][4][2], const Unit& u, int wr, int wc, int fr_, int fq_) const {
        const int lane = fq_ * 16 + fr_, r2 = lane >> 2, c2 = lane & 3, pidx = rowmajor_pidx(lane);
        const int row0 = u.pm * BM + wr * 64 + r2, col0 = u.pn * HALF + wc * 32 + 8 * c2;
        f32x4 pa[2][4], pb[2][4];
        { const float* base = ssq + (size_t)(u.pm * BM + wr * 64 + r2) * 32 + c2 * 8;
#pragma unroll
          for (int ai = 0; ai < 2; ++ai)
#pragma unroll
            for (int m = 0; m < 4; ++m) { pa[ai][m] = *(const f32x4*)(base + (ai * HALF + m * 16) * 32); pb[ai][m] = *(const f32x4*)(base + (ai * HALF + m * 16) * 32 + 4); } }
        __builtin_amdgcn_sched_barrier(0);
        f32x4 rm[2][2][4][2];
#pragma unroll
        for (int ai = 0; ai < 2; ++ai)
#pragma unroll
            for (int bj = 0; bj < 2; ++bj)
#pragma unroll
                for (int m = 0; m < 4; ++m)
#pragma unroll
                    for (int n = 0; n < 2; ++n) rm[ai][bj][m][n] = to_rowmajor(acc[ai][bj][m][n], pidx);
        __builtin_amdgcn_sched_barrier(0);
        float rs[2][4];
#pragma unroll
        for (int ai = 0; ai < 2; ++ai)
#pragma unroll
            for (int m = 0; m < 4; ++m) { const f32x4 a = pa[ai][m], b = pb[ai][m];
                float sq = ((a[0] + a[1]) + (a[2] + a[3])) + ((b[0] + b[1]) + (b[2] + b[3]));
                sq += __shfl_xor(sq, 1); sq += __shfl_xor(sq, 2);
                rs[ai][m] = __builtin_amdgcn_rsqf(sq * (1.0f / 2048.0f) + 1e-6f); }
#pragma unroll
        for (int ai = 0; ai < 2; ++ai)
#pragma unroll
            for (int m = 0; m < 4; ++m) { const float r = rs[ai][m], c1 = -1.4426950408889634f * r, ms = __builtin_amdgcn_rcpf(r * r); float hv[8];
#pragma unroll
                for (int n = 0; n < 2; ++n) { const f32x4 gv = rm[ai][0][m][n], uv = rm[ai][1][m][n];
#pragma unroll
                    for (int i = 0; i < 4; i += 2) {
                        const f32x2 g2 = (f32x2){gv[i], gv[i + 1]}, u2 = (f32x2){uv[i], uv[i + 1]}; const f32x2 t2 = g2 * c1;
                        f32x2 e2; e2.x = __builtin_amdgcn_exp2f(t2.x); e2.y = __builtin_amdgcn_exp2f(t2.y);
                        const f32x2 d2 = e2 * ms + ms; f32x2 s2; s2.x = __builtin_amdgcn_rcpf(d2.x); s2.y = __builtin_amdgcn_rcpf(d2.y);
                        const f32x2 h2 = (g2 * u2) * s2; hv[4 * n + i] = h2.x; hv[4 * n + i + 1] = h2.y; } }
                u32x4 w; w.x = cvt_pk_bf16(hv[0], hv[1]); w.y = cvt_pk_bf16(hv[2], hv[3]); w.z = cvt_pk_bf16(hv[4], hv[5]); w.w = cvt_pk_bf16(hv[6], hv[7]);
                *(u32x4*)(H + (size_t)(row0 + ai * HALF + m * 16) * ldh + col0) = w; }
    }
};
struct EpiQKV {
    static constexpr bool PERM = true, AFTER_DRAIN = false;
    const float* ssq; const float* gq; const float* gk;
    bf16_t* QP; size_t pstride;
    bf16_t* QS; bf16_t* KS; size_t sstride; int srows, lc;
    float* okp; size_t opstride; float* oks; size_t osstride;
    int fox;
    PG8_LAS float* red;
    __device__ __forceinline__ void operator()(const f32x4 (&acc)[2][2][4][2], const Unit& u, int wr, int wc, int fr_, int fq_) const {
        int fr = fr_, fq = fq_; asm volatile("" : "+v"(fr), "+v"(fq));
        const int which = u.pn >> 3, head0 = (u.pn & 7) * 2;
        const int lane_ = fq_ * 16 + fr_, r2 = lane_ >> 2, c2 = lane_ & 3, pidx = rowmajor_pidx(lane_);
        float rsv[2][4]; rows_rstd_rm(rsv, ssq, u.pm, wr, r2, c2);
        if (which < 2) {
#pragma unroll
            for (int ai = 0; ai < 2; ++ai)
#pragma unroll
                for (int m = 0; m < 4; ++m)
#pragma unroll
                    for (int bj = 0; bj < 2; ++bj) { float s = 0.f;
#pragma unroll
                        for (int n = 0; n < 2; ++n) { const f32x4 x = acc[ai][bj][m][n]; s += (x[0] * x[0] + x[1] * x[1]) + (x[2] * x[2] + x[3] * x[3]); }
                        s += __shfl_xor(s, 16); s += __shfl_xor(s, 32);
                        if (fq == 0) red[(wc * 256 + ai * HALF + wr * 64 + m * 16 + fr) * 2 + bj] = s; }
            asm volatile("s_waitcnt lgkmcnt(0)" ::: "memory"); __builtin_amdgcn_s_barrier(); asm volatile("" ::: "memory");
        }
        const int cih = wc * 32 + 8 * c2;
        f32x4 g0 = (f32x4){1.f, 1.f, 1.f, 1.f}, g1 = g0;
        if (which < 2) { const float* g = (which == 0 ? gq : gk) + cih; g0 = *(const f32x4*)g; g1 = *(const f32x4*)(g + 4); }
        const bool samp = u.pm >= 64;
        const bool f32out = which > 0 && (samp || fox || (u.pm & 31) >= 30);
        char* b16; char* b32 = nullptr; unsigned hs16, rowsz = 0;
        if (!samp) { const int bb = u.pm >> 5;
            b16 = (char*)(QP + (size_t)which * pstride + (size_t)(bb * 16 + head0) * (8192 * 128)); hs16 = 8192 * 128 * 2;
            if (f32out) b32 = (char*)(okp + (size_t)(which - 1) * opstride + (fox ? (size_t)bb * 8192 * 2048 : (size_t)bb * 512 * 2048) + head0 * 128);
        } else { rowsz = (which == 0) ? 16u : (unsigned)srows;
            b16 = (which == 0) ? (char*)QS : (char*)(KS + (size_t)(which == 2 ? 1 : 0) * sstride + (size_t)lc * 128); hs16 = rowsz * 256u;
            if (f32out) b32 = (char*)(oks + (size_t)(which - 1) * osstride + head0 * 128); }
        const int trow0 = samp ? 0 : ((u.pm & 31) * 256 - ((fox || !f32out) ? 0 : 7680));
#pragma unroll
        for (int ai = 0; ai < 2; ++ai)
#pragma unroll
            for (int m = 0; m < 4; ++m) { const int rit = ai * HALF + wr * 64 + m * 16 + r2;
                const float rs = rsv[ai][m];
                unsigned o16;
                if (!samp) o16 = (unsigned)((((u.pm & 31) * 256 + rit) * 128 + cih) * 2);
                else o16 = (unsigned)(((((rit >> 4) * 16 + head0) * rowsz + (rit & 15)) * 128 + cih) * 2);
                const unsigned o32 = (unsigned)(((trow0 + rit) * 2048 + cih) * 4);
#pragma unroll
                for (int bj = 0; bj < 2; ++bj) { float sc = rs;
                    if (which < 2) { const int ri = rit * 2 + bj; const float t = (red[ri] + red[512 + ri]) + (red[1024 + ri] + red[1536 + ri]);
                        sc = rs * __builtin_amdgcn_rsqf(t * rs * rs * (1.0f / 128.0f) + 1e-6f); }
                    const f32x4 x0 = to_rowmajor(acc[ai][bj][m][0], pidx) * sc * g0, x1 = to_rowmajor(acc[ai][bj][m][1], pidx) * sc * g1;
                    u32x4 w; w.x = cvt_pk_bf16(x0[0], x0[1]); w.y = cvt_pk_bf16(x0[2], x0[3]); w.z = cvt_pk_bf16(x1[0], x1[1]); w.w = cvt_pk_bf16(x1[2], x1[3]);
                    *(u32x4*)(b16 + (size_t)(o16 + (unsigned)bj * hs16)) = w;
                    if (f32out) { float* fo = (float*)(b32 + (size_t)(o32 + (unsigned)bj * 512u)); __builtin_nontemporal_store(x0, (f32x4*)fo); __builtin_nontemporal_store(x1, (f32x4*)(fo + 4)); } }
                asm volatile("" ::: "memory"); }
    }
};
}

namespace sk {
typedef short bf16x8 __attribute__((ext_vector_type(8)));
typedef float f32x4 __attribute__((ext_vector_type(4)));
typedef unsigned u32x2 __attribute__((ext_vector_type(2)));
typedef unsigned u32x4 __attribute__((ext_vector_type(4)));
typedef unsigned short bf16_t;
#define SLAS __attribute__((address_space(3)))
__device__ __forceinline__ unsigned cvtpk(float lo, float hi) { unsigned r; asm volatile("v_cvt_pk_bf16_f32 %0, %1, %2" : "=v"(r) : "v"(lo), "v"(hi)); return r; }
__device__ __forceinline__ float row_rstd(const float* ssq, int row, int fq) {
    const f32x4 a = *(const f32x4*)(ssq + (size_t)row * 32 + fq * 8), b = *(const f32x4*)(ssq + (size_t)row * 32 + fq * 8 + 4);
    float s = ((a[0] + a[1]) + (a[2] + a[3])) + ((b[0] + b[1]) + (b[2] + b[3]));
    s += __shfl_xor(s, 16); s += __shfl_xor(s, 32);
    return __builtin_amdgcn_rsqf(s * (1.0f / 2048.0f) + 1e-6f);
}
struct SkResid {
    static constexpr int MB = 2, NB = 2, NS = 6; static constexpr bool NEEDS_X = true;
    const float* xin; float* X; bf16_t* XB; float* ssq;
    __device__ __forceinline__ int brow(int ct, int ch, int n) const { return ct * 64 + ch * 32 + 16 * n; }
    __device__ __forceinline__ void partial(f32x4 (&acc)[MB][NB], int rt, int ct, int ch, int fr, int fq, SLAS float* red) const {
        f32x4 xo[MB][NB];
#pragma unroll
        for (int m = 0; m < MB; ++m)
#pragma unroll
            for (int n = 0; n < NB; ++n) xo[m][n] = *(const f32x4*)(xin + (size_t)(rt * 32 + 16 * m + fr) * 2048 + ct * 64 + ch * 32 + 16 * n + 4 * fq);
#pragma unroll
        for (int m = 0; m < MB; ++m) { float s = 0.f;
#pragma unroll
            for (int n = 0; n < NB; ++n) { const f32x4 x = xo[m][n] + acc[m][n]; acc[m][n] = x; s += (x[0] * x[0] + x[1] * x[1]) + (x[2] * x[2] + x[3] * x[3]); }
            s += __shfl_xor(s, 16); s += __shfl_xor(s, 32);
            if (fq == 0) red[ch * 32 + 16 * m + fr] = s; }
    }
    __device__ __forceinline__ void operator()(const f32x4 (&acc)[MB][NB], int rt, int ct, int ch, int fr, int fq, SLAS float* red) const {
#pragma unroll
        for (int m = 0; m < MB; ++m) { const int r = rt * 32 + 16 * m + fr; const size_t off = (size_t)r * 2048 + ct * 64 + ch * 32 + 4 * fq;
#pragma unroll
            for (int n = 0; n < NB; ++n) { const f32x4 x = acc[m][n];
                *(f32x4*)(X + off + 16 * n) = x; u32x2 w; w.x = cvtpk(x[0], x[1]); w.y = cvtpk(x[2], x[3]); *(u32x2*)(XB + off + 16 * n) = w; }
            if (ch == 0 && fq == 0) ssq[(size_t)r * 32 + ct] = red[16 * m + fr] + red[32 + 16 * m + fr]; }
    }
};
struct SkSwiglu {
    static constexpr int MB = 4, NB = 4, NS = 3; static constexpr bool NEEDS_X = false;
    bf16_t* H; int ldh; const float* ssq;
    __device__ __forceinline__ int brow(int ct, int ch, int n) const { return 256 * (ct >> 1) + (ct & 1) * 64 + ch * 32 + (n >= 2 ? 128 + 16 * (n - 2) : 16 * n); }
    __device__ __forceinline__ void partial(f32x4 (&acc)[MB][NB], int, int, int, int, int, SLAS float*) const {}
    __device__ __forceinline__ void operator()(const f32x4 (&acc)[MB][NB], int rt, int ct, int ch, int fr, int fq, SLAS float* red) const {
        float rs[MB];
        { f32x4 pa[MB], pb[MB];
#pragma unroll
          for (int m = 0; m < MB; ++m) { const float* sp = ssq + (size_t)(rt * 64 + 16 * m + fr) * 32 + fq * 8; pa[m] = *(const f32x4*)sp; pb[m] = *(const f32x4*)(sp + 4); }
#pragma unroll
          for (int m = 0; m < MB; ++m) { float s = ((pa[m][0] + pa[m][1]) + (pa[m][2] + pa[m][3])) + ((pb[m][0] + pb[m][1]) + (pb[m][2] + pb[m][3]));
              s += __shfl_xor(s, 16); s += __shfl_xor(s, 32); rs[m] = __builtin_amdgcn_rsqf(s * (1.0f / 2048.0f) + 1e-6f); } }
#pragma unroll
        for (int m = 0; m < MB; ++m) { const int r = rt * 64 + 16 * m + fr;
#pragma unroll
            for (int n = 0; n < 2; ++n) { float hv[4];
#pragma unroll
                for (int i = 0; i < 4; ++i) { const float g = acc[m][n][i] * rs[m], up = acc[m][n + 2][i] * rs[m]; hv[i] = g * __builtin_amdgcn_rcpf(1.0f + __expf(-g)) * up; }
                u32x2 w; w.x = cvtpk(hv[0], hv[1]); w.y = cvtpk(hv[2], hv[3]);
                *(u32x2*)(H + (size_t)r * ldh + 128 * (ct >> 1) + (ct & 1) * 64 + ch * 32 + 16 * n + 4 * fq) = w; } }
    }
};
struct SkQKV {
    static constexpr int MB = 4, NB = 4, NS = 3; static constexpr bool NEEDS_X = true;
    const float* ssq; const float* gq; const float* gk;
    bf16_t* QS; bf16_t* KS; size_t sstride; int srows, lc;
    float* oks; size_t osstride;
    __device__ __forceinline__ int brow(int ct, int ch, int n) const { return ct * 128 + ch * 64 + 16 * n; }
    __device__ __forceinline__ void partial(f32x4 (&acc)[MB][NB], int, int, int ch, int fr, int fq, SLAS float* red) const {
#pragma unroll
        for (int m = 0; m < MB; ++m) { float s = 0.f;
#pragma unroll
            for (int n = 0; n < NB; ++n) { const f32x4 x = acc[m][n]; s += (x[0] * x[0] + x[1] * x[1]) + (x[2] * x[2] + x[3] * x[3]); }
            s += __shfl_xor(s, 16); s += __shfl_xor(s, 32);
            if (fq == 0) red[ch * 64 + 16 * m + fr] = s; }
    }
    __device__ __forceinline__ void operator()(const f32x4 (&acc)[MB][NB], int rt, int ct, int ch, int fr, int fq, SLAS float* red) const {
        const int which = ct >> 4, h = ct & 15;
        const float* g = (which == 0 ? gq : gk) + ch * 64 + 4 * fq;
        bf16_t* b16 = (which == 0) ? QS : KS + (size_t)(which == 2 ? 1 : 0) * sstride + (size_t)lc * 128; const int rowsz = (which == 0) ? 16 : srows;
        float* b32 = oks + (size_t)(which > 0 ? which - 1 : 0) * osstride + h * 128 + ch * 64 + 4 * fq;
        float rs[MB];
        { f32x4 pa[MB], pb[MB];
#pragma unroll
          for (int m = 0; m < MB; ++m) { const float* sp = ssq + (size_t)(rt * 64 + 16 * m + fr) * 32 + fq * 8; pa[m] = *(const f32x4*)sp; pb[m] = *(const f32x4*)(sp + 4); }
#pragma unroll
          for (int m = 0; m < MB; ++m) { float s = ((pa[m][0] + pa[m][1]) + (pa[m][2] + pa[m][3])) + ((pb[m][0] + pb[m][1]) + (pb[m][2] + pb[m][3]));
              s += __shfl_xor(s, 16); s += __shfl_xor(s, 32); rs[m] = __builtin_amdgcn_rsqf(s * (1.0f / 2048.0f) + 1e-6f); } }
#pragma unroll
        for (int m = 0; m < MB; ++m) { const int r = rt * 64 + 16 * m + fr; float sc = rs[m];
            if (which < 2) { const float s = red[16 * m + fr] + red[64 + 16 * m + fr]; sc = rs[m] * __builtin_amdgcn_rsqf(s * rs[m] * rs[m] * (1.0f / 128.0f) + 1e-6f); }
            bf16_t* d16 = b16 + ((size_t)((r >> 4) * 16 + h) * rowsz + (r & 15)) * 128 + ch * 64 + 4 * fq; float* d32 = b32 + (size_t)r * 2048;
#pragma unroll
            for (int n = 0; n < NB; ++n) { f32x4 x = acc[m][n] * sc; if (which < 2) x = x * *(const f32x4*)(g + 16 * n);
                u32x2 w; w.x = cvtpk(x[0], x[1]); w.y = cvtpk(x[2], x[3]); *(u32x2*)(d16 + 16 * n) = w;
                if (which > 0) *(f32x4*)(d32 + 16 * n) = x; } }
    }
};
template <class Epi>
__device__ __forceinline__ void skinny_phase(SLAS unsigned char* lds, const bf16_t* A, const bf16_t* Bt, int nct, int K, unsigned* qc  , int tid, const Epi& E) {
    constexpr int MB = Epi::MB, NB = Epi::NB, NS = Epi::NS, NRT = 16 / MB, SLOT = MB * NB * 1024;
    const int lane = tid & 63, wid = __builtin_amdgcn_readfirstlane(tid >> 6), fr = lane & 15, fq = lane >> 4, kq = wid & 3, ch = wid >> 2;
    const int kw = K >> 2;
    SLAS float* red = (SLAS float*)(lds + 4 * SLOT);
    for (;;) {
        volatile SLAS int* tw = (volatile SLAS int*)(lds + 67712);
        if (tid == 0) *tw = (int)__hip_atomic_fetch_add(qc, 1u, __ATOMIC_RELAXED, __HIP_MEMORY_SCOPE_AGENT);
        __syncthreads();
        const int tile = __builtin_amdgcn_readfirstlane(*tw);
        if (tile >= NRT * nct) break;
        const int rt = tile % NRT, ct = tile / NRT;
        f32x4 acc[MB][NB];
#pragma unroll
        for (int m = 0; m < MB; ++m)
#pragma unroll
            for (int n = 0; n < NB; ++n) acc[m][n] = (f32x4){0.f, 0.f, 0.f, 0.f};
        const unsigned lo = (unsigned)(((lane >> 2) * K + kq * kw + (lane & 3) * 8) * 2);
        const int pidx = (((lane & 15) << 2) | (lane >> 4)) << 2;
        const char* ab = (const char*)(A + (size_t)(rt * 16 * MB) * K);
        const char* bb[NB];
#pragma unroll
        for (int n = 0; n < NB; ++n) bb[n] = (const char*)(Bt + (size_t)E.brow(ct, ch, n) * K);
        bf16x8 fa[NS][MB], fb[NS][NB];
#define SK_LOAD(st, ks) do { const unsigned o_ = lo + (unsigned)((ks) * 2); _Pragma("unroll") for (int m = 0; m < MB; ++m) fa[st][m] = *(const bf16x8*)(ab + (size_t)(o_ + (unsigned)(16 * m * K * 2))); \
            _Pragma("unroll") for (int n = 0; n < NB; ++n) fb[st][n] = *(const bf16x8*)(bb[n] + (size_t)o_); } while (0)
#define SK_PERM(v) do { u32x4 w_ = __builtin_bit_cast(u32x4, v); w_.x = (unsigned)__builtin_amdgcn_ds_bpermute(pidx, (int)w_.x); w_.y = (unsigned)__builtin_amdgcn_ds_bpermute(pidx, (int)w_.y); \
            w_.z = (unsigned)__builtin_amdgcn_ds_bpermute(pidx, (int)w_.z); w_.w = (unsigned)__builtin_amdgcn_ds_bpermute(pidx, (int)w_.w); v = __builtin_bit_cast(bf16x8, w_); } while (0)
#define SK_MMA(st) do { _Pragma("unroll") for (int m = 0; m < MB; ++m) SK_PERM(fa[st][m]); _Pragma("unroll") for (int n = 0; n < NB; ++n) SK_PERM(fb[st][n]); \
            _Pragma("unroll") for (int m = 0; m < MB; ++m) _Pragma("unroll") for (int n = 0; n < NB; ++n) acc[m][n] = __builtin_amdgcn_mfma_f32_16x16x32_bf16(fb[st][n], fa[st][m], acc[m][n], 0, 0, 0); } while (0)
#define SK_SB() __builtin_amdgcn_sched_barrier(0)
        const int nst = kw >> 5, kl = kw - 32;
#pragma unroll
        for (int j = 0; j < NS - 1; ++j) { SK_LOAD(j, (j * 32 < kw ? j * 32 : kl)); SK_SB(); }
        for (int s0 = 0; s0 < nst; s0 += NS) {
#pragma unroll
            for (int j = 0; j < NS; ++j) { const int kn = (s0 + j + NS - 1) * 32; SK_LOAD((j + NS - 1) % NS, kn < kw ? kn : kl); SK_SB(); if (s0 + j < nst) SK_MMA(j); SK_SB(); }
        }
#undef SK_SB
#undef SK_LOAD
#undef SK_MMA
#undef SK_PERM
#pragma unroll
        for (int half = 2; half >= 1; half >>= 1) {
            if (kq >= half && kq < 2 * half) { SLAS f32x4* s = (SLAS f32x4*)(lds + (ch * 2 + kq - half) * SLOT) + lane;
#pragma unroll
                for (int m = 0; m < MB; ++m)
#pragma unroll
                    for (int n = 0; n < NB; ++n) s[(m * NB + n) * 64] = acc[m][n]; }
            __syncthreads();
            if (kq < half) { const SLAS f32x4* s = (const SLAS f32x4*)(lds + (ch * 2 + kq) * SLOT) + lane;
#pragma unroll
                for (int m = 0; m < MB; ++m)
#pragma unroll
                    for (int n = 0; n < NB; ++n) acc[m][n] = acc[m][n] + s[(m * NB + n) * 64]; }
            __syncthreads();
        }
        if constexpr (Epi::NEEDS_X) { if (kq == 0) E.partial(acc, rt, ct, ch, fr, fq, red); __syncthreads(); }
        if (kq == 0) E(acc, rt, ct, ch, fr, fq, red);
        if constexpr (Epi::NEEDS_X) __syncthreads();
    }
}
}

namespace att {
typedef short bf16x8 __attribute__((ext_vector_type(8)));
typedef short s16x4 __attribute__((ext_vector_type(4)));
typedef float f32x16 __attribute__((ext_vector_type(16)));
typedef float f32x4 __attribute__((ext_vector_type(4)));
typedef unsigned u32x4 __attribute__((ext_vector_type(4)));
typedef unsigned short bf16;
#define ALAS __attribute__((address_space(3)))
constexpr int D = 128, NW = 8, QBLK = 32, KVBLK = 64, QB = NW * QBLK;
constexpr int SHM_V = KVBLK * D * 2, SHM_K = KVBLK * D * 2;
constexpr int OFF_V = 0, OFF_K = 2 * SHM_V, OFF_WS = 2 * SHM_V + 2 * SHM_K, OFF_TAB = OFF_WS + NW * 64 * 4, OFF_BIAS = OFF_TAB + 1024, LDS_END = OFF_BIAS + 8192 * 4 + 512;
constexpr float SCALE = 0.08838834764831845f, RSCALE = 11.313708498984761f;
constexpr float THR = 8.f;
#define KSWZ(row, colB) ((row) * 256 + ((colB) ^ (((row) & 7) << 4)))
#define SBAR() __builtin_amdgcn_sched_barrier(0)
__device__ __forceinline__ int v_st(int k, int c) { const int kk = (k & ~0xC) | ((k & 4) << 1) | ((k & 8) >> 1); return ((kk >> 3) * 4 + (c >> 5)) * 512 + ((kk & 7) * 32 + (c & 31)) * 2; }
__device__ __forceinline__ int v_rd_base(int lane) { return ((lane & 3) << 3) | (((lane >> 2) & 3) << 6) | (((lane >> 4) & 1) << 5) | (((lane >> 5) & 1) << 8); }
constexpr int v_rd_off(int d0, int ks, int half) { return d0 * 512 + ks * 4096 + half * 2048; }
__device__ __forceinline__ int crow(int r, int hi) { return (r & 3) + 8 * (r >> 2) + 4 * hi; }
__device__ __forceinline__ unsigned cvtpk(float lo, float hi) { unsigned r; asm volatile("v_cvt_pk_bf16_f32 %0, %1, %2" : "=v"(r) : "v"(lo), "v"(hi)); return r; }
__device__ __forceinline__ bf16x8 load8(const bf16* p) { return *reinterpret_cast<const bf16x8*>(p); }
__device__ __forceinline__ void mask_tile(f32x16& p0, f32x16& p1, int dq) {
    const float NEG = -__builtin_inff();
#pragma unroll
    for (int r = 0; r < 16; ++r) {
        const int c = (r & 3) + 8 * (r >> 2);
        if (dq - c < 0) p0[r] = NEG;
        if (dq - c - 32 < 0) p1[r] = NEG;
    }
}
__device__ __forceinline__ void partialSM(f32x16& p0, f32x16& p1, float& m_reg, float& mn, float& alpha) {
    float pmax = p0[0]; for (int r = 1; r < 16; ++r) pmax = fmaxf(pmax, p0[r]); for (int r = 0; r < 16; ++r) pmax = fmaxf(pmax, p1[r]);
    { auto rr = __builtin_amdgcn_permlane32_swap(__float_as_uint(pmax), __float_as_uint(pmax), false, false);
      pmax = fmaxf(__uint_as_float(rr[0]), __uint_as_float(rr[1])); }
    constexpr float C2 = 1.4426950408889634f * SCALE;
    if (__builtin_expect(__all((pmax - m_reg) * SCALE <= THR), 1)) { mn = m_reg; alpha = 1.f; }
    else { mn = fmaxf(m_reg, pmax); alpha = __builtin_amdgcn_exp2f((m_reg - mn) * C2); m_reg = mn; }
    const float mnL = -mn * C2;
    for (int r = 0; r < 16; ++r) p0[r] = fmaf(p0[r], C2, mnL); for (int r = 0; r < 16; ++r) p1[r] = fmaf(p1[r], C2, mnL);
    for (int r = 0; r < 16; ++r) p0[r] = __builtin_amdgcn_exp2f(p0[r]);
}
__device__ __forceinline__ void finishSM(f32x16& p0, f32x16& p1, float alpha, float& l_reg, bf16x8& pa0, bf16x8& pa1, bf16x8& pa2, bf16x8& pa3) {
    for (int r = 0; r < 16; ++r) p1[r] = __builtin_amdgcn_exp2f(p1[r]);
    float ps = 0; for (int r = 0; r < 16; ++r) ps += p0[r]; for (int r = 0; r < 16; ++r) ps += p1[r];
    { auto rr = __builtin_amdgcn_permlane32_swap(__float_as_uint(ps), __float_as_uint(ps), false, false);
      ps = __uint_as_float(rr[0]) + __uint_as_float(rr[1]); }
    l_reg = l_reg * alpha + ps;
#define PK4(P, B_, OUT) do { unsigned a0 = cvtpk(P[B_+0], P[B_+1]), a1 = cvtpk(P[B_+2], P[B_+3]);                          \
        unsigned b0 = cvtpk(P[B_+4], P[B_+5]), b1 = cvtpk(P[B_+6], P[B_+7]);                                             \
        auto r0 = __builtin_amdgcn_permlane32_swap(a0, b0, false, false); auto r1 = __builtin_amdgcn_permlane32_swap(a1, b1, false, false); \
        u32x4 w = {r0[0], r1[0], r0[1], r1[1]}; OUT = *reinterpret_cast<bf16x8*>(&w); } while (0)
    PK4(p0, 0, pa0); PK4(p0, 8, pa1); PK4(p1, 0, pa2); PK4(p1, 8, pa3);
#undef PK4
}
struct Blk {
    const bf16* Q; const bf16* K; const bf16* V; bf16* O;
    const float* aux;
    int P0;
    int jlo, jhi;
    int cap;
    int c0;
    float skipthr;
};
struct Nxt { const bf16* Q; const bf16* K; const bf16* V; int jlo; };
constexpr int OSTR = 2048;
struct Seam { bf16x8 qr[8]; bf16x8 st_v0, st_v1, st_k0, st_k1; };

template <int MODE, int KB>
__device__ __forceinline__ void qkt(f32x16& p0, f32x16& p1, ALAS const char* lds, int r32, int hi, const bf16x8* qr, bool act, int tile  , int dist  , int irow  ) {
    if (!act) { const float NEG = -__builtin_inff();
#pragma unroll
        for (int r = 0; r < 16; ++r) { p0[r] = NEG; p1[r] = NEG; } return; }
    if constexpr (MODE == 1) {
        ALAS const float* bp = (ALAS const float*)(lds + OFF_BIAS) + tile * 64 + 4 * hi;
#pragma unroll
        for (int i = 0; i < 4; ++i) { const f32x4 a = *(ALAS const f32x4*)(bp + 8 * i), b = *(ALAS const f32x4*)(bp + 32 + 8 * i);
            p0[4 * i] = a[0]; p0[4 * i + 1] = a[1]; p0[4 * i + 2] = a[2]; p0[4 * i + 3] = a[3]; p1[4 * i] = b[0]; p1[4 * i + 1] = b[1]; p1[4 * i + 2] = b[2]; p1[4 * i + 3] = b[3]; }
    } else {
        ALAS const float* R = (ALAS const float*)(lds + OFF_TAB);
        if (dist <= 2) { ALAS const float* rp = R + (191 - 64 * dist - irow + 4 * hi);
#pragma unroll
            for (int r = 0; r < 16; ++r) { p0[r] = rp[(r & 3) + 8 * (r >> 2)]; p1[r] = rp[32 + (r & 3) + 8 * (r >> 2)]; } }
        else { const float cf = R[0];
#pragma unroll
            for (int r = 0; r < 16; ++r) { p0[r] = cf; p1[r] = cf; } }
    }
    ALAS const char* K_lds = lds + OFF_K;
    ALAS const char* kb[4];
#pragma unroll
    for (int dd = 0; dd < 4; ++dd) kb[dd] = K_lds + KB * SHM_K + KSWZ(r32, (dd * 16 + hi * 8) * 2);
#pragma unroll
    for (int d0 = 0; d0 < 8; ++d0) { ALAS const char* a = kb[d0 & 3] + (d0 >> 2) * 128;
        bf16x8 b0 = *reinterpret_cast<ALAS const bf16x8*>(a);
        bf16x8 b1 = *reinterpret_cast<ALAS const bf16x8*>(a + 32 * 256);
        p0 = __builtin_amdgcn_mfma_f32_32x32x16_bf16(b0, qr[d0], p0, 0, 0, 0);
        p1 = __builtin_amdgcn_mfma_f32_32x32x16_bf16(b1, qr[d0], p1, 0, 0, 0); }
}
template <int MODE, int VB>
__device__ __forceinline__ void pv_tile(f32x16* o, int vb0, bf16x8 pa0, bf16x8 pa1, bf16x8 pa2, bf16x8 pa3, bool act) {
    if (!act) return;
#define TRRD(dst, off) asm volatile("ds_read_b64_tr_b16 %0, %1 offset:%2" : "=&v"(dst) : "v"(vb0), "i"(off) : "memory")
#define PV_D0(d0) do { s16x4 l0, l1, l2, l3, h0, h1, h2, h3; constexpr int b_ = VB * SHM_V + v_rd_off(d0, 0, 0); \
        TRRD(l0, b_); TRRD(h0, b_ + 2048); TRRD(l1, b_ + 4096); TRRD(h1, b_ + 6144); TRRD(l2, b_ + 8192); TRRD(h2, b_ + 10240); TRRD(l3, b_ + 12288); TRRD(h3, b_ + 14336); \
        asm volatile("s_waitcnt lgkmcnt(0)" ::: "memory"); SBAR();   \
        o[d0] = __builtin_amdgcn_mfma_f32_32x32x16_bf16(pa0, (bf16x8){l0[0], l0[1], l0[2], l0[3], h0[0], h0[1], h0[2], h0[3]}, o[d0], 0, 0, 0);   \
        o[d0] = __builtin_amdgcn_mfma_f32_32x32x16_bf16(pa1, (bf16x8){l1[0], l1[1], l1[2], l1[3], h1[0], h1[1], h1[2], h1[3]}, o[d0], 0, 0, 0);   \
        o[d0] = __builtin_amdgcn_mfma_f32_32x32x16_bf16(pa2, (bf16x8){l2[0], l2[1], l2[2], l2[3], h2[0], h2[1], h2[2], h2[3]}, o[d0], 0, 0, 0);   \
        o[d0] = __builtin_amdgcn_mfma_f32_32x32x16_bf16(pa3, (bf16x8){l3[0], l3[1], l3[2], l3[3], h3[0], h3[1], h3[2], h3[3]}, o[d0], 0, 0, 0); } while (0)
    PV_D0(0); PV_D0(1); PV_D0(2); PV_D0(3);
#undef PV_D0
#undef TRRD
}
#define AROW(p, k0, rr) ((const bf16*)((const char*)(p) + (size_t)(unsigned)(((k0) + (rr)) * (D * 2) + sc * 2)))
#define VMW() asm volatile("s_waitcnt vmcnt(0)" ::: "memory")
#define VMWN(n) asm volatile("s_waitcnt vmcnt(%0)" :: "i"(n) : "memory")
#define SLOAD_H(Kp, Vp, k0) do { S.st_v0 = load8(AROW(Vp, k0, sr)); S.st_v1 = load8(AROW(Vp, k0, 32 + sr));              \
                         S.st_k0 = load8(AROW(Kp, k0, sr)); S.st_k1 = load8(AROW(Kp, k0, 32 + sr)); } while (0)
#define SWRITE_HK(bf) do { *(ALAS bf16x8*)(K_lds + (bf) * SHM_K + kws) = S.st_k0; *(ALAS bf16x8*)(K_lds + (bf) * SHM_K + kws + 32 * 256) = S.st_k1; } while (0)
#define SWRITE_HV(bf) do { *(ALAS bf16x8*)(V_lds + (bf) * SHM_V + vst0) = S.st_v0; *(ALAS bf16x8*)(V_lds + (bf) * SHM_V + vst1) = S.st_v1; } while (0)
#define SWRITE_H(bf) do { SWRITE_HV(bf); SWRITE_HK(bf); } while (0)
template <int MODE>
__device__ __forceinline__ float build_bias(const Blk& b, ALAS char* lds, int tid) {
    asm volatile("" : "+v"(tid));
    if constexpr (MODE == 0) {
        if (tid < 256) { int d = 191 - tid; d = d < -128 ? -128 : (d > 128 ? 128 : d); ((ALAS float*)(lds + OFF_TAB))[tid] = b.aux[d + 128] * RSCALE; }
        return 0.f;
    } else {
        const int nk = b.jhi * 64, nv = b.cap + 1, e0 = tid * 16, lane = tid & 63, wid = tid >> 6;
        float v[16];
#pragma unroll
        for (int i = 0; i < 4; ++i) { f32x4 x = (f32x4){0.f, 0.f, 0.f, 0.f};
            if (e0 + 4 * i < nv) x = *(const f32x4*)(b.aux + e0 + 4 * i);
            v[4 * i] = x[0]; v[4 * i + 1] = x[1]; v[4 * i + 2] = x[2]; v[4 * i + 3] = x[3]; }
        float run = 0.f;
#pragma unroll
        for (int i = 15; i >= 0; --i) { const float x = v[i]; v[i] = run; run += x; }
        float incl = run;
#pragma unroll
        for (int o = 1; o < 64; o <<= 1) { const float t = __int_as_float(__builtin_amdgcn_ds_bpermute(((lane + o) & 63) << 2, __float_as_int(incl))); if (lane + o < 64) incl += t; }
        ALAS float* wt = (ALAS float*)(lds + OFF_TAB);
        if (lane == 0) wt[wid] = incl;
        asm volatile("s_waitcnt lgkmcnt(0)" ::: "memory"); __builtin_amdgcn_s_barrier(); asm volatile("" ::: "memory");
        float after = incl - run;
#pragma unroll
        for (int w = 1; w < 8; ++w) { const float t = wt[w]; if (w > wid) after += t; }
        if (e0 < nk) { ALAS f32x4* o4 = (ALAS f32x4*)(lds + OFF_BIAS) + tid * 4;
#pragma unroll
            for (int i = 0; i < 4; ++i) o4[i] = (f32x4){(v[4 * i] + after) * RSCALE, (v[4 * i + 1] + after) * RSCALE, (v[4 * i + 2] + after) * RSCALE, (v[4 * i + 3] + after) * RSCALE}; }
        return after;
    }
}
template <int MODE>
__device__ __forceinline__ void attn_prime(const Blk& cur, ALAS char* lds, Seam& S, int tid) {
    asm volatile("" : "+v"(tid));
    const int wid = __builtin_amdgcn_readfirstlane(tid >> 6), lane = tid & 63, r32 = lane & 31, hi = lane >> 5;
    const int sr = tid >> 4, sc = (tid & 15) * 8, kws = KSWZ(sr, sc * 2); ALAS char* K_lds = lds + OFF_K;
    const int kb0 = cur.jlo * KVBLK;
    const int qrow = wid * QBLK + r32;
#pragma unroll
    for (int d0 = 0; d0 < 8; ++d0) S.qr[d0] = load8((const bf16*)((const char*)cur.Q + (size_t)(unsigned)(qrow * (D * 2) + hi * 16 + d0 * 32)));
    SLOAD_H(cur.K, cur.V, kb0); VMW(); SWRITE_HK(0);
    __syncthreads();
}
template <int MODE, class IssueFn, class NextFn>
__device__ __forceinline__ void attn_block(const Blk& cur, IssueFn&& issue_fn, NextFn&& next_fn, ALAS char* lds, Seam& S, int tid) {
    asm volatile("" : "+v"(tid));
    const int wid = __builtin_amdgcn_readfirstlane(tid >> 6), lane = tid & 63, r32 = lane & 31, hi = lane >> 5;
    bf16x8 kd[8];
    if constexpr (MODE == 1) { const char* kp = (const char*)cur.K + (size_t)(unsigned)((cur.P0 + wid * QBLK + r32) * (D * 2) + hi * 16);
#pragma unroll
        for (int d0 = 0; d0 < 8; ++d0) kd[d0] = load8((const bf16*)(kp + d0 * 32)); }
    const float s_end = build_bias<MODE>(cur, lds, tid);
    asm volatile("s_waitcnt lgkmcnt(0)" ::: "memory"); __syncthreads();
    int j_lo = cur.jlo;
    const int sr = tid >> 4, sc = (tid & 15) * 8, vst0 = v_st(sr, sc), vst1 = v_st(32 + sr, sc), kws = KSWZ(sr, sc * 2);
    ALAS char* V_lds = lds + OFF_V; ALAS char* K_lds = lds + OFF_K;
    if constexpr (MODE == 1) {
        float dsum = 0.f;
#pragma unroll
        for (int d0 = 0; d0 < 8; ++d0) { const u32x4 qa = *reinterpret_cast<const u32x4*>(&S.qr[d0]), ka = *reinterpret_cast<const u32x4*>(&kd[d0]);
#pragma unroll
            for (int i = 0; i < 4; ++i) { dsum = fmaf(__uint_as_float(qa[i] << 16), __uint_as_float(ka[i] << 16), dsum);
                dsum = fmaf(__uint_as_float(qa[i] & 0xffff0000u), __uint_as_float(ka[i] & 0xffff0000u), dsum); } }
        { auto rr = __builtin_amdgcn_permlane32_swap(__float_as_uint(dsum), __float_as_uint(dsum), false, false); dsum = __uint_as_float(rr[0]) + __uint_as_float(rr[1]); }
        float gv = (((ALAS const float*)(lds + OFF_BIAS))[cur.P0 + wid * QBLK + r32] + dsum) * SCALE;
#pragma unroll
        for (int o = 1; o < 32; o <<= 1) gv = fminf(gv, __shfl_xor(gv, o));
        ALAS float* wg = (ALAS float*)(lds + OFF_TAB) + 32;
        if (lane == 0) wg[wid] = gv;
        asm volatile("s_waitcnt lgkmcnt(0)" ::: "memory"); __builtin_amdgcn_s_barrier(); asm volatile("" ::: "memory");
        float G = wg[0];
#pragma unroll
        for (int w = 1; w < 8; ++w) G = fminf(G, wg[w]);
        const bool pred = ((tid & 3) == 3) && ((tid >> 2) < (cur.P0 >> 6)) && (s_end < G - cur.skipthr);
        const int cnt = __builtin_popcountll(__ballot(pred));
        ALAS int* wcnt = (ALAS int*)(lds + OFF_TAB) + 16;
        if (lane == 0) wcnt[wid] = cnt;
        asm volatile("s_waitcnt lgkmcnt(0)" ::: "memory"); __builtin_amdgcn_s_barrier(); asm volatile("" ::: "memory");
        int tot = 0;
#pragma unroll
        for (int w = 0; w < 8; ++w) tot += wcnt[w];
        j_lo = __builtin_amdgcn_readfirstlane(tot);
        if (j_lo != cur.jlo) {
            SLOAD_H(cur.K, cur.V, j_lo * KVBLK); VMW(); SWRITE_HK(0); }
        __syncthreads();
    }
    const int NT = cur.jhi - j_lo;
    const int wlim = cur.P0 + wid * QBLK;
    const int qm = wlim + r32 - 4 * hi;
    const int cw = cur.c0 + (wid >> 1);
    const int irow = (wid & 1) * 32 + r32;
    ALAS float* wsf = (ALAS float*)(lds + OFF_WS) + wid * 64; ALAS float* li_l = wsf; ALAS float* al_l = wsf + 32;
    float m_reg = -1e30f, l_reg = 0; f32x16 o[4] = {};
    const int vb0 = (int)(unsigned)(unsigned long long)V_lds + v_rd_base(lane);
    const bf16* Kh = cur.K; const bf16* Vh = cur.V;
#define RESC(a) do { if (__any((a) < 1.f)) { if (hi == 0) al_l[r32] = (a); asm volatile("s_waitcnt lgkmcnt(0)" ::: "memory");              \
                     for (int d_ = 0; d_ < 4; ++d_) for (int r = 0; r < 16; ++r) o[d_][r] *= al_l[crow(r, hi)]; } } while (0)
#define KBASE(t) ((j_lo + (t)) * KVBLK)
#define ACT(t) (MODE == 1 ? (KBASE(t) <= wlim + QBLK - 1) : ((j_lo + (t)) >= cw - 8 && (j_lo + (t)) <= cw))
#define MASKT(P0_, P1_, t) do { if (MODE == 1) { const int kb_ = KBASE(t); if (kb_ + KVBLK - 1 > wlim) mask_tile(P0_, P1_, qm - kb_); } } while (0)
#define QKT(KB, PX0, PX1, t) qkt<MODE, KB>(PX0, PX1, lds, r32, hi, S.qr, ACT(t), j_lo + (t), cw - (j_lo + (t)), irow)
    constexpr int NQL = 8;
#define SEAM_K0() do { VMWN(NQL); SWRITE_HK(0); SBAR(); } while (0)
    f32x16 pA0, pA1, pB0, pB1; float mnA, mnB, alA, alB; bf16x8 pa0, pa1, pa2, pa3;
    SWRITE_HV(0); SBAR();
    if (NT > 1) SLOAD_H(Kh, Vh, KBASE(1));
    SBAR(); QKT(0, pA0, pA1, 0);
    MASKT(pA0, pA1, 0); partialSM(pA0, pA1, m_reg, mnA, alA);
    if (NT > 1) { VMW(); SWRITE_H(1); }
    __syncthreads();
#define HALF_STEP(PX0, PX1, mnX, alX, PY0, PY1, alY, t, KB, VB, SB) do {                                                      \
        SBAR(); QKT(KB, PX0, PX1, t);                                                                                          \
        finishSM(PY0, PY1, alY, l_reg, pa0, pa1, pa2, pa3); SBAR();                                                           \
        if ((t) + 1 < NT) { SLOAD_H(Kh, Vh, KBASE((t) + 1)); SBAR(); }                                                        \
        pv_tile<MODE, VB>(o, vb0, pa0, pa1, pa2, pa3, ACT((t) - 1)); MASKT(PX0, PX1, (t)); partialSM(PX0, PX1, m_reg, mnX, alX);   \
        __syncthreads();                                                                                                      \
        if ((t) + 1 < NT) { VMW(); SWRITE_H(SB); }                                                                            \
        RESC(alX); __syncthreads(); } while (0)
    if (NT < 3) issue_fn();
    for (int t = 1; t + 1 < NT; t += 2) {
        if (t + 3 >= NT) issue_fn();
        HALF_STEP(pB0, pB1, mnB, alB, pA0, pA1, alA, t, 1, 0, 0);
        HALF_STEP(pA0, pA1, mnA, alA, pB0, pB1, alB, t + 1, 0, 1, 1);
    }
    Nxt nxt; next_fn(nxt);
    const int kbn = nxt.jlo * KVBLK;
    const bool even = (NT & 1) == 0;
    if (even) { SBAR(); QKT(1, pB0, pB1, NT - 1); SBAR(); }
    SLOAD_H(nxt.K, nxt.V, kbn); SBAR();
    { const int qrow = wid * QBLK + r32;
#pragma unroll
      for (int d0 = 0; d0 < 8; ++d0) S.qr[d0] = load8((const bf16*)((const char*)nxt.Q + (size_t)(unsigned)(qrow * (D * 2) + hi * 16 + d0 * 32))); }
    SBAR();
    finishSM(pA0, pA1, alA, l_reg, pa0, pa1, pa2, pa3); SBAR();
    pv_tile<MODE, 0>(o, vb0, pa0, pa1, pa2, pa3, ACT(even ? NT - 2 : NT - 1));
    if (even) { MASKT(pB0, pB1, NT - 1); partialSM(pB0, pB1, m_reg, mnB, alB); __syncthreads(); RESC(alB);
        finishSM(pB0, pB1, alB, l_reg, pa0, pa1, pa2, pa3); SBAR(); pv_tile<MODE, 1>(o, vb0, pa0, pa1, pa2, pa3, ACT(NT - 1)); }
    SBAR(); SEAM_K0();
    __syncthreads();
    if (hi == 0) li_l[r32] = l_reg; asm volatile("s_waitcnt lgkmcnt(0)" ::: "memory");
    float rli[16];
#pragma unroll
    for (int r = 0; r < 16; ++r) rli[r] = __builtin_amdgcn_rcpf(li_l[crow(r, hi)]);
    ALAS char* stg = lds + OFF_V + wid * 4096 + (4 * hi) * 128 + r32 * 2;
    ALAS const char* srd = lds + OFF_V + wid * 4096 + (lane >> 3) * 128 + (lane & 7) * 16;
    unsigned ooff = (unsigned)(((wid * QBLK + (lane >> 3)) * OSTR + (lane & 7) * 8) * 2);
    asm volatile("" : "+v"(ooff));
#pragma unroll
    for (int ps = 0; ps < 2; ++ps) {
#pragma unroll
        for (int dd = 0; dd < 2; ++dd)
#pragma unroll
            for (int r = 0; r < 16; r += 2) { const unsigned w = cvtpk(o[2 * ps + dd][r] * rli[r], o[2 * ps + dd][r + 1] * rli[r + 1]);
                ALAS char* a = stg + ((r & 3) + 8 * (r >> 2)) * 128 + dd * 64;
                *(ALAS unsigned short*)a = (unsigned short)w; *(ALAS unsigned short*)(a + 128) = (unsigned short)(w >> 16); }
        asm volatile("s_waitcnt lgkmcnt(0)" ::: "memory");
        u32x4 q[4];
#pragma unroll
        for (int i = 0; i < 4; ++i) q[i] = *(ALAS const u32x4*)(srd + i * 1024);
        asm volatile("s_waitcnt lgkmcnt(0)" ::: "memory");
#pragma unroll
        for (int i = 0; i < 4; ++i) *(u32x4*)((char*)cur.O + (size_t)(ooff + (unsigned)(i * 8 * OSTR * 2 + ps * 128))) = q[i];
    }
    __syncthreads();
#undef RESC
#undef KBASE
#undef ACT
#undef MASKT
#undef QKT
#undef SEAM_K0
#undef HALF_STEP
}
#undef AROW
#undef VMW
#undef VMWN
#undef SLOAD_H
#undef SWRITE_HK
#undef SWRITE_HV
#undef SWRITE_H
}

constexpr int NWAVES = 8;
constexpr int NB = 2, T = 8192, D = 2048, NH = 16, HD = 128, FF = 5632, DEPTH = 4;
constexpr int SB = 16, SN = 16, PAST = 1024, WIN = 512, NREL = 257;
constexpr int MP = NB * T, MS = SB * SN, M = MP + MS;
constexpr int NQKV = 3 * D, NGU = 2 * FF;
constexpr int LS = PAST + SN;
constexpr float EPS = 1e-6f, SCALE = 0.08838834764831845f;
constexpr size_t O_Y = 0, O_YS = (size_t)MP * D, O_AKP = O_YS + (size_t)MS * D, SZ_AP = (size_t)2 * NB * WIN * D, O_AVP = O_AKP + SZ_AP, O_BKP = O_AVP + SZ_AP,
    SZ_BP = (size_t)2 * MP * D, O_BVP = O_BKP + SZ_BP, O_BFP = O_BVP + SZ_BP, SZ_BFP = (size_t)2 * MP * NH, O_AKS = O_BFP + SZ_BFP, SZ_S = (size_t)2 * MS * D,
    O_AVS = O_AKS + SZ_S, O_BKS = O_AVS + SZ_S, O_BVS = O_BKS + SZ_S, O_BFS = O_BVS + SZ_S, OUT_TOTAL = O_BFS + (size_t)2 * MS * NH;
static_assert(OUT_TOTAL == 181411840, "out size");
constexpr size_t MiB = 1u << 20;
constexpr size_t WS_CTL = 0, CTL_ZERO_BYTES = 1 * MiB;
constexpr size_t WS_WQKV = 2 * MiB, WS_WO = 98 * MiB, WS_WGU = 130 * MiB, WS_WD = 306 * MiB;
constexpr size_t WS_XB = 394 * MiB, WS_SSQ = 459 * MiB;
constexpr size_t WS_QP = 462 * MiB, WS_KP = 526 * MiB, WS_VP = 590 * MiB;
constexpr size_t WS_QS = 654 * MiB;
constexpr size_t WS_OB = 655 * MiB, WS_HB = 720 * MiB;
constexpr size_t WS_KSN = 899 * MiB, WS_VSN = 900 * MiB;
constexpr size_t WS_LFP = 1315 * MiB, WS_WF = 1316 * MiB  , WS_LFS = 1317 * MiB, WS_CUMS = 1319 * MiB, WS_END = 1321 * MiB;
static_assert(WS_WQKV + (size_t)DEPTH * NQKV * D * 2 <= WS_WO && WS_WO + (size_t)DEPTH * D * D * 2 <= WS_WGU && WS_WGU + (size_t)DEPTH * NGU * D * 2 <= WS_WD && WS_WD + (size_t)DEPTH * D * FF * 2 <= WS_XB, "ws map: weights");
static_assert(WS_XB + (size_t)M * D * 2 <= WS_SSQ && WS_SSQ + (size_t)M * 32 * 4 <= WS_QP && WS_OB + (size_t)M * D * 2 <= WS_HB && WS_HB + (size_t)M * FF * 2 <= WS_KSN, "ws map: activations");
constexpr int CW_BAR = 4096, CW_QUEUE = 8192, CW_SKQ = 8192 + 256;
constexpr size_t WS_QKM = WS_WF + 512 * 1024;
constexpr int RING_OFF = 0, RING_BYTES = 131072;
constexpr int LDSCTL_OFF = RING_BYTES, MISC_OFF = LDSCTL_OFF + 320, RED_OFF = LDSCTL_OFF + 1024;
constexpr int LDS_BYTES = 147456;
#define GAS __attribute__((address_space(1)))
#define LAS __attribute__((address_space(3)))
typedef unsigned short bf16;
typedef unsigned v4u __attribute__((ext_vector_type(4)));
typedef float f32x4 __attribute__((ext_vector_type(4)));
typedef short bf16x8 __attribute__((ext_vector_type(8)));
typedef GAS unsigned gu32;
typedef GAS unsigned long long gu64;
#define RLX_AGENT __ATOMIC_RELAXED, __HIP_MEMORY_SCOPE_AGENT
#define LDS_WAIT() asm volatile("s_waitcnt lgkmcnt(0)" ::: "memory")
#define VM_WAIT() asm volatile("s_waitcnt vmcnt(0)" ::: "memory")
__device__ __forceinline__ unsigned long long rt() { return __builtin_amdgcn_s_memrealtime(); }
__device__ __forceinline__ unsigned f2bf(float f) { unsigned u = __builtin_bit_cast(unsigned, f); return (u + 0x7fffu + ((u >> 16) & 1u)) >> 16; }
__device__ __forceinline__ unsigned pk2(float lo, float hi) { return f2bf(lo) | (f2bf(hi) << 16); }

#define XB_TMO      128
#define XB_XCNT(j)  (256  + 64 * (j))
#define XB_XSUB(j)  (1280 + 64 * (j))
#define XB_XGEN(j)  (2304 + 64 * (j))
#define XB_TOP      3328
#define XB_TOPGEN   3392
#define XCD_BAR_WORDS 3456
#define XB_SPIN_CAP (1u << 22)

__device__ __forceinline__ unsigned xb_ld(unsigned* p)              { return __hip_atomic_load(p, __ATOMIC_RELAXED, __HIP_MEMORY_SCOPE_AGENT); }
__device__ __forceinline__ unsigned xb_add(unsigned* p, unsigned v) { return __hip_atomic_fetch_add(p, v, __ATOMIC_RELAXED, __HIP_MEMORY_SCOPE_AGENT); }
__device__ __forceinline__ unsigned xb_xcc_id() { return (unsigned)__builtin_amdgcn_s_getreg((3 << 11) | 20) & 0xFu; }
#define XB_SPIN(cond, bar) do { unsigned _sp = 0; while (cond) { __builtin_amdgcn_s_sleep(1); \
    if ((++_sp & 255u) == 0u) { if (xb_ld(&(bar)[XB_TMO])) break; if (_sp > XB_SPIN_CAP) { atomicAdd(&(bar)[XB_TMO], 1u); break; } } } } while (0)

struct XcdBarrier {
    unsigned* bar; unsigned x;
    volatile LAS unsigned* st;
};

__device__ __forceinline__ XcdBarrier xcd_barrier_post(unsigned* bar, volatile LAS unsigned* st, const bool leader  ) {
    XcdBarrier b; b.bar = bar; b.x = xb_xcc_id(); b.st = st;
    if (leader) (void)xb_add(&bar[XB_XCNT(b.x)], 1u);
    return b;
}
__device__ __forceinline__ void xcd_barrier_complete(unsigned* bar, unsigned x, unsigned& nloc, unsigned& nx) {
    const unsigned G = gridDim.x * gridDim.y * gridDim.z;
    unsigned sum, cnt, mine, sp = 0u;
    for (;;) {
        sum = 0u; cnt = 0u; mine = 0u;
#pragma unroll
        for (unsigned j = 0; j < 16; ++j) { const unsigned c = xb_ld(&bar[XB_XCNT(j)]); sum += c; cnt += (c > 0u) ? 1u : 0u; mine = (j == x) ? c : mine; }
        if (sum == G) break;
        __builtin_amdgcn_s_sleep(1);
        if ((++sp & 255u) == 0u) { if (xb_ld(&bar[XB_TMO])) break; if (sp > XB_SPIN_CAP) { atomicAdd(&bar[XB_TMO], 1u); break; } }
    }
    nloc = mine > 0u ? mine : 1u; nx = cnt > 0u ? cnt : 1u;
}

__device__ __forceinline__ void xcd_barrier(const XcdBarrier& b, const bool leader  ) {
    asm volatile("s_waitcnt vmcnt(0)" ::: "memory");
    __syncthreads();
    if (leader) {
        unsigned* bar = b.bar;
        __builtin_amdgcn_s_waitcnt(0);
        unsigned nloc = b.st[0], nx = b.st[1];
        if (nloc == 0u) { xcd_barrier_complete(bar, b.x, nloc, nx); b.st[0] = nloc; b.st[1] = nx; }
        const unsigned old = xb_add(&bar[XB_XSUB(b.x)], 1u);
        const unsigned gen = old / nloc;
        if (old + 1u == (gen + 1u) * nloc) {
            __builtin_amdgcn_fence(__ATOMIC_RELEASE, "agent");
            asm volatile("s_waitcnt vmcnt(0)" ::: "memory");
            const unsigned og = xb_add(&bar[XB_TOP], 1u);
            const unsigned tg = og / nx;
            if (og + 1u == (tg + 1u) * nx) xb_add(&bar[XB_TOPGEN], 1u);
            else XB_SPIN(xb_ld(&bar[XB_TOPGEN]) == tg, bar);
            __builtin_amdgcn_fence(__ATOMIC_ACQUIRE, "agent");
            xb_add(&bar[XB_XGEN(b.x)], 1u);
            asm volatile("s_waitcnt vmcnt(0)" ::: "memory");
        } else {
            XB_SPIN(xb_ld(&bar[XB_XGEN(b.x)]) == gen, bar);
            __builtin_amdgcn_fence(__ATOMIC_ACQUIRE, "agent");
            asm volatile("s_waitcnt vmcnt(0)" ::: "memory");
        }
    }
    __syncthreads();
}

typedef float f32x2 __attribute__((ext_vector_type(2)));
__device__ __forceinline__ float wave_sum(float v) {
#pragma unroll
    for (int o = 1; o < 64; o <<= 1) v += __shfl_xor(v, o);
    return v;
}
__device__ __forceinline__ float bf2f(unsigned b) { return __uint_as_float(b << 16); }

__device__ __forceinline__ void p0_transpose_item(const float* W, const float* g, int K, int N, bf16* WT, int mode, LAS float* scr, int item, int lane) {
    const int nblk = N / 32, kb = item / nblk, nb = item % nblk, k0 = 64 * kb, n0 = 32 * nb;
    const int kr = lane >> 3, nc = (lane & 7) * 4;
    f32x4 v[8]; float gs[8];
#pragma unroll
    for (int i = 0; i < 8; ++i) { v[i] = *(const GAS f32x4*)(W + (size_t)(k0 + kr + 8 * i) * N + n0 + nc); gs[i] = g ? g[k0 + kr + 8 * i] : 1.f; }
#pragma unroll
    for (int i = 0; i < 8; ++i) { LAS float* s = scr + (kr + 8 * i) * 33 + nc; s[0] = v[i].x * gs[i]; s[1] = v[i].y * gs[i]; s[2] = v[i].z * gs[i]; s[3] = v[i].w * gs[i]; }
    LDS_WAIT(); asm volatile("" ::: "memory");
    const int c = lane & 7;
    const int drow0 = (mode == 0) ? n0 : (256 * (n0 >> 7) + (n0 & 127) + (mode == 2 ? 128 : 0));
#pragma unroll
    for (int j = 0; j < 4; ++j) { const int n = (lane >> 3) + 8 * j; const LAS float* s = scr + (8 * c) * 33 + n;
        v4u o; o.x = pk2(s[0 * 33], s[1 * 33]); o.y = pk2(s[2 * 33], s[3 * 33]); o.z = pk2(s[4 * 33], s[5 * 33]); o.w = pk2(s[6 * 33], s[7 * 33]);
        *(GAS v4u*)(WT + (size_t)(drow0 + n) * K + k0 + 8 * c) = o; }
    LDS_WAIT(); asm volatile("" ::: "memory");
}
__device__ __forceinline__ void p0_item128(const float* W, const float* g, int K, int N, bf16* WT, int mode, LAS float* scr, int item, int lane) {
    const int nblk = N / 32, kb = item / nblk, nb = item % nblk, k0 = 128 * kb, n0 = 32 * nb;
    const int kr = lane >> 3, nc = (lane & 7) * 4;
    f32x4 v[16]; float gs[16];
#pragma unroll
    for (int i = 0; i < 16; ++i) { v[i] = *(const GAS f32x4*)(W + (size_t)(k0 + kr + 8 * i) * N + n0 + nc); gs[i] = g ? g[k0 + kr + 8 * i] : 1.f; }
    const int c = lane & 7;
    const int drow0 = (mode == 0) ? n0 : (256 * (n0 >> 7) + (n0 & 127) + (mode == 2 ? 128 : 0));
#pragma unroll
    for (int hf = 0; hf < 2; ++hf) {
#pragma unroll
        for (int i = 0; i < 8; ++i) { LAS float* s = scr + (kr + 8 * i) * 33 + nc; const f32x4 x = v[hf * 8 + i]; const float gg = gs[hf * 8 + i]; s[0] = x.x * gg; s[1] = x.y * gg; s[2] = x.z * gg; s[3] = x.w * gg; }
        LDS_WAIT(); asm volatile("" ::: "memory");
#pragma unroll
        for (int j = 0; j < 4; ++j) { const int n = (lane >> 3) + 8 * j; const LAS float* s = scr + (8 * c) * 33 + n;
            v4u o; o.x = pk2(s[0 * 33], s[1 * 33]); o.y = pk2(s[2 * 33], s[3 * 33]); o.z = pk2(s[4 * 33], s[5 * 33]); o.w = pk2(s[6 * 33], s[7 * 33]);
            *(GAS v4u*)(WT + (size_t)(drow0 + n) * K + k0 + 64 * hf + 8 * c) = o; }
        LDS_WAIT(); asm volatile("" ::: "memory");
    }
}
constexpr int CI_QKV = (D / 128) * (NQKV / 32), CI_O = (D / 128) * (D / 32), CI_G = (D / 128) * (FF / 32), CI_D = (FF / 128) * (D / 32), CI_L = CI_O + 2 * CI_G + CI_D;
__device__ __forceinline__ int conv_group_items(int grp) { return grp == 0 ? CI_QKV : (grp <= 3 ? CI_L + CI_QKV : CI_L); }
__device__ __forceinline__ void conv_item(const float* const __attribute__((address_space(4)))* in, unsigned char* ws, int grp, int it, LAS float* scr, int lane) {
    bf16* WQKV = (bf16*)(ws + WS_WQKV); bf16* WO = (bf16*)(ws + WS_WO); bf16* WGU = (bf16*)(ws + WS_WGU); bf16* WD = (bf16*)(ws + WS_WD);
    int r = it;
    if (grp > 0) { const int L = grp - 1; const float* gf = in[15] + (size_t)L * D;
        if (r < CI_O) { p0_item128(in[11] + (size_t)L * D * D, nullptr, D, D, WO + (size_t)L * D * D, 0, scr, r, lane); return; } r -= CI_O;
        if (r < CI_G) { p0_item128(in[16] + (size_t)L * D * FF, gf, D, FF, WGU + (size_t)L * NGU * D, 1, scr, r, lane); return; } r -= CI_G;
        if (r < CI_G) { p0_item128(in[17] + (size_t)L * D * FF, gf, D, FF, WGU + (size_t)L * NGU * D, 2, scr, r, lane); return; } r -= CI_G;
        if (r < CI_D) { p0_item128(in[18] + (size_t)L * FF * D, nullptr, FF, D, WD + (size_t)L * D * FF, 0, scr, r, lane); return; } r -= CI_D;
    }
    const int Lq = grp;
    p0_item128(in[8] + (size_t)Lq * D * NQKV, in[7] + (size_t)Lq * D, D, NQKV, WQKV + (size_t)Lq * NQKV * D, 0, scr, r, lane);
}
constexpr int N_SLICE = 256;
struct ConvD { const float* W; const float* g; bf16* WT; int K, N, mode, item; };
__device__ __forceinline__ ConvD conv_desc(const float* const __attribute__((address_space(4)))* in, unsigned char* ws, int grp, int it) {
    ConvD d; int r = it; const int L = grp - 1;
    if (r < CI_O) { d.W = in[11] + (size_t)L * D * D; d.g = nullptr; d.WT = (bf16*)(ws + WS_WO) + (size_t)L * D * D; d.K = D; d.N = D; d.mode = 0; d.item = r; return d; } r -= CI_O;
    if (r < 2 * CI_G) { const int up = r >= CI_G ? 1 : 0; d.W = in[16 + up] + (size_t)L * D * FF; d.g = in[15] + (size_t)L * D; d.WT = (bf16*)(ws + WS_WGU) + (size_t)L * NGU * D; d.K = D; d.N = FF; d.mode = 1 + up; d.item = r - up * CI_G; return d; } r -= 2 * CI_G;
    if (r < CI_D) { d.W = in[18] + (size_t)L * FF * D; d.g = nullptr; d.WT = (bf16*)(ws + WS_WD) + (size_t)L * D * FF; d.K = FF; d.N = D; d.mode = 0; d.item = r; return d; } r -= CI_D;
    d.W = in[8] + (size_t)grp * D * NQKV; d.g = in[7] + (size_t)grp * D; d.WT = (bf16*)(ws + WS_WQKV) + (size_t)grp * NQKV * D; d.K = D; d.N = NQKV; d.mode = 0; d.item = r; return d;
}
__device__ __forceinline__ void p0_load128(const ConvD& d, f32x4 (&v)[16], float (&gs)[16], int lane) {
    const int nblk = d.N / 32, kb = d.item / nblk, nb = d.item % nblk, k0 = 128 * kb, n0 = 32 * nb;
    const int kr = lane >> 3, nc = (lane & 7) * 4;
#pragma unroll
    for (int i = 0; i < 16; ++i) { v[i] = *(const GAS f32x4*)(d.W + (size_t)(k0 + kr + 8 * i) * d.N + n0 + nc); gs[i] = d.g ? d.g[k0 + kr + 8 * i] : 1.f; }
}
__device__ __forceinline__ void p0_finish128(const ConvD& d, const f32x4 (&v)[16], const float (&gs)[16], LAS float* scr, int lane) {
    const int nblk = d.N / 32, kb = d.item / nblk, nb = d.item % nblk, k0 = 128 * kb, n0 = 32 * nb;
    const int kr = lane >> 3, nc = (lane & 7) * 4, c = lane & 7;
    const int drow0 = (d.mode == 0) ? n0 : (256 * (n0 >> 7) + (n0 & 127) + (d.mode == 2 ? 128 : 0));
#pragma unroll
    for (int hf = 0; hf < 2; ++hf) {
#pragma unroll
        for (int i = 0; i < 8; ++i) { LAS float* s = scr + (kr + 8 * i) * 33 + nc; const f32x4 x = v[hf * 8 + i]; const float gg = gs[hf * 8 + i]; s[0] = x.x * gg; s[1] = x.y * gg; s[2] = x.z * gg; s[3] = x.w * gg; }
        LDS_WAIT(); asm volatile("" ::: "memory");
#pragma unroll
        for (int j = 0; j < 4; ++j) { const int n = (lane >> 3) + 8 * j; const LAS float* s = scr + (8 * c) * 33 + n;
            v4u o; o.x = pk2(s[0 * 33], s[1 * 33]); o.y = pk2(s[2 * 33], s[3 * 33]); o.z = pk2(s[4 * 33], s[5 * 33]); o.w = pk2(s[6 * 33], s[7 * 33]);
            *(GAS v4u*)(d.WT + (size_t)(drow0 + n) * d.K + k0 + 64 * hf + 8 * c) = o; }
        LDS_WAIT(); asm volatile("" ::: "memory");
    }
}
__device__ __forceinline__ void conv_slice(const float* const __attribute__((address_space(4)))* in, unsigned char* ws, int grp, int slice, LAS unsigned char* lds, int tid) {
    asm volatile("" : "+v"(tid));
    const int lane = tid & 63, wave = __builtin_amdgcn_readfirstlane(tid >> 6);
    LAS float* scr = (LAS float*)(lds + wave * 16384);
    const int ni = conv_group_items(grp), per = (ni + N_SLICE - 1) / N_SLICE, i0 = slice * per, i1 = (i0 + per < ni) ? i0 + per : ni;
    const int first = i0 + wave, n = (first < i1) ? (i1 - first + NWAVES - 1) / NWAVES : 0;
    if (n > 0) {
        f32x4 vA[16], vB[16]; float gA[16], gB[16];
        ConvD dA = conv_desc(in, ws, grp, first), dB = dA; p0_load128(dA, vA, gA, lane);
#pragma unroll 1
        for (int j = 0; j < n; j += 2) {
            dB = conv_desc(in, ws, grp, first + NWAVES * (j + 1 < n ? j + 1 : n - 1)); p0_load128(dB, vB, gB, lane); __builtin_amdgcn_sched_barrier(0);
            p0_finish128(dA, vA, gA, scr, lane); __builtin_amdgcn_sched_barrier(0);
            dA = conv_desc(in, ws, grp, first + NWAVES * (j + 2 < n ? j + 2 : n - 1)); p0_load128(dA, vA, gA, lane); __builtin_amdgcn_sched_barrier(0);
            if (j + 1 < n) p0_finish128(dB, vB, gB, scr, lane);
            __builtin_amdgcn_sched_barrier(0);
        }
    }
    __syncthreads();
}
__device__ __forceinline__ void row_update(const float* xold, const float* crow, float* xdst, bf16* xbrow, float* rstd_p, int lane) {
    const GAS f32x4* xr = (const GAS f32x4*)xold + lane; const GAS f32x4* cr = (const GAS f32x4*)crow + lane;
    GAS f32x4* xd = (GAS f32x4*)xdst + lane; GAS unsigned long long* o8 = (GAS unsigned long long*)xbrow + lane;
    float ss = 0.f;
#pragma unroll
    for (int j = 0; j < 8; ++j) { f32x4 v = xr[64 * j]; if (crow) v = v + cr[64 * j]; if (xdst) xd[64 * j] = v;
        ss += (v.x * v.x + v.y * v.y) + (v.z * v.z + v.w * v.w);
        o8[64 * j] = (unsigned long long)pk2(v.x, v.y) | ((unsigned long long)pk2(v.z, v.w) << 32); }
    ss = wave_sum(ss);
    if (lane < 32) rstd_p[lane] = (lane == 0) ? ss : 0.f;
}

template <int MODE>
__device__ __forceinline__ void sample_attn(LAS char* lds, int u, int li, unsigned char* ws, const float* rel, const float* kcache, const float* vcache, int tid) {
    asm volatile("" : "+v"(tid));
    constexpr int L = (MODE == 0) ? WIN : PAST, Lk = L + SN, NKB = Lk / 16, LkP = (Lk + 31) / 32 * 32, NST = LkP / 32, PP = LkP;
    constexpr int OFF_P = att::OFF_BIAS + 4352, OFF_RI = OFF_P + 16 * 1056 * 2;
    static_assert(16 * Lk * 4 <= att::OFF_TAB && OFF_RI + 64 <= 131072 && 8 * 16 * 128 * 4 <= att::OFF_TAB, "sample attention LDS map");
    const int lane = tid & 63, wid = __builtin_amdgcn_readfirstlane(tid >> 6), fr = lane & 15, fq = lane >> 4, st = u >> 4, h = u & 15;
    LAS float* S = (LAS float*)lds; LAS unsigned short* P = (LAS unsigned short*)(lds + OFF_P); LAS float* RI = (LAS float*)(lds + OFF_RI);
    const bf16* QSp = (const bf16*)(ws + WS_QS) + (size_t)u * SN * HD; const bf16* KNp = (const bf16*)(ws + WS_KSN) + (size_t)u * SN * HD; const bf16* VNp = (const bf16*)(ws + WS_VSN) + (size_t)u * SN * HD;
    const float* kc = kcache + ((size_t)(li * SB + st) * L) * D + h * HD; const float* vc = vcache + ((size_t)(li * SB + st) * L) * D + h * HD;
    if constexpr (MODE == 1) {
        att::Blk b; b.aux = (const float*)(ws + WS_LFS) + (size_t)u * LS; b.jhi = 17; b.cap = LS - 1; b.jlo = 0; b.P0 = PAST; b.c0 = 0; b.skipthr = 0.f; b.Q = nullptr; b.K = nullptr; b.V = nullptr; b.O = nullptr;
        (void)att::build_bias<1>(b, lds, tid);
    }
    pg8::bf16x8 qf[4];
#pragma unroll
    for (int ds = 0; ds < 4; ++ds) qf[ds] = *(const pg8::bf16x8*)(QSp + (size_t)fr * HD + ds * 32 + fq * 8);
    asm volatile("s_waitcnt lgkmcnt(0)" ::: "memory"); __syncthreads();
#define SA_SCORE(accv, key0_) do { f32x4 lg_; _Pragma("unroll") for (int r = 0; r < 4; ++r) { const int key = (key0_) + 4 * fq + r; float v_; \
            if (MODE == 1) { v_ = ((accv)[r] + ((LAS const float*)(lds + att::OFF_BIAS))[key]) * SCALE; if (key > L + fr) v_ = -__builtin_inff(); } \
            else { int dd = L + fr - key; dd = dd < -128 ? -128 : (dd > 128 ? 128 : dd); v_ = (accv)[r] * SCALE + rel[(size_t)(li * NH + h) * NREL + dd + 128]; } \
            lg_[r] = v_; } *(LAS f32x4*)(S + fr * Lk + (key0_) + 4 * fq) = lg_; } while (0)
    constexpr int NCB = L / 16 / NWAVES;
#pragma unroll 1
    for (int i = 0; i < NCB; i += 2) {
        f32x4 ka[2][4], kb2[2][4];
#pragma unroll
        for (int u2 = 0; u2 < 2; ++u2) { const float* kr = kc + (size_t)((wid + (i + u2) * NWAVES) * 16 + fr) * D + fq * 8;
#pragma unroll
            for (int ds = 0; ds < 4; ++ds) { ka[u2][ds] = *(const GAS f32x4*)(kr + ds * 32); kb2[u2][ds] = *(const GAS f32x4*)(kr + ds * 32 + 4); } }
#pragma unroll
        for (int u2 = 0; u2 < 2; ++u2) { pg8::f32x4 acc = (pg8::f32x4){0.f, 0.f, 0.f, 0.f};
#pragma unroll
            for (int ds = 0; ds < 4; ++ds) { const f32x4 a = ka[u2][ds], b2 = kb2[u2][ds];
                v4u w; w.x = pk2(a.x, a.y); w.y = pk2(a.z, a.w); w.z = pk2(b2.x, b2.y); w.w = pk2(b2.z, b2.w);
                acc = __builtin_amdgcn_mfma_f32_16x16x32_bf16(__builtin_bit_cast(pg8::bf16x8, w), qf[ds], acc, 0, 0, 0); }
            SA_SCORE(acc, (wid + (i + u2) * NWAVES) * 16); }
    }
    if (wid == 0) { const bf16* kr = KNp + (size_t)fr * HD + fq * 8; pg8::f32x4 acc = (pg8::f32x4){0.f, 0.f, 0.f, 0.f};
#pragma unroll
        for (int ds = 0; ds < 4; ++ds) acc = __builtin_amdgcn_mfma_f32_16x16x32_bf16(*(const pg8::bf16x8*)(kr + ds * 32), qf[ds], acc, 0, 0, 0);
        SA_SCORE(acc, L); }
#undef SA_SCORE
    asm volatile("s_waitcnt lgkmcnt(0)" ::: "memory"); __syncthreads();
#pragma unroll 1
    for (int rr = 0; rr < 2; ++rr) { const int q = 2 * wid + rr; LAS const float* sr = S + q * Lk; float m = -1e30f;
        for (int k = lane; k < Lk; k += 64) m = fmaxf(m, sr[k]);
#pragma unroll
        for (int o = 1; o < 64; o <<= 1) m = fmaxf(m, __int_as_float(__builtin_amdgcn_ds_bpermute(((lane ^ o) & 63) << 2, __float_as_int(m))));
        float sum = 0.f;
        for (int k = lane; k < PP; k += 64) { float p = 0.f; if (k < Lk) { p = __expf(sr[k] - m); sum += p; } P[q * 1056 + k] = (unsigned short)f2bf(p); }
#pragma unroll
        for (int o = 1; o < 64; o <<= 1) sum += __int_as_float(__builtin_amdgcn_ds_bpermute(((lane ^ o) & 63) << 2, __float_as_int(sum)));
        if (lane == 0) RI[q] = 1.0f / sum; }
    asm volatile("s_waitcnt lgkmcnt(0)" ::: "memory"); __syncthreads();
    pg8::f32x4 oacc[8];
#pragma unroll
    for (int db = 0; db < 8; ++db) oacc[db] = (pg8::f32x4){0.f, 0.f, 0.f, 0.f};
    constexpr int NCS = L / 32 / NWAVES;
#pragma unroll 1
    for (int i = 0; i < NCS; i += 2) {
        f32x4 ev[2][2][8];
#pragma unroll
        for (int u2 = 0; u2 < 2; ++u2) { const float* vr = vc + (size_t)((wid + (i + u2) * NWAVES) * 32 + fq * 8) * D + 4 * fr;
#pragma unroll
            for (int hf = 0; hf < 2; ++hf)
#pragma unroll
                for (int j = 0; j < 8; ++j) ev[u2][hf][j] = *(const GAS f32x4*)(vr + (size_t)j * D + hf * 64); }
#pragma unroll
        for (int u2 = 0; u2 < 2; ++u2) { const pg8::bf16x8 pf = *(LAS const pg8::bf16x8*)(P + fr * 1056 + (wid + (i + u2) * NWAVES) * 32 + fq * 8);
#pragma unroll
            for (int hf = 0; hf < 2; ++hf)
#pragma unroll
                for (int c = 0; c < 4; ++c) { v4u w; w.x = pk2(ev[u2][hf][0][c], ev[u2][hf][1][c]); w.y = pk2(ev[u2][hf][2][c], ev[u2][hf][3][c]); w.z = pk2(ev[u2][hf][4][c], ev[u2][hf][5][c]); w.w = pk2(ev[u2][hf][6][c], ev[u2][hf][7][c]);
                    oacc[hf * 4 + c] = __builtin_amdgcn_mfma_f32_16x16x32_bf16(__builtin_bit_cast(pg8::bf16x8, w), pf, oacc[hf * 4 + c], 0, 0, 0); } }
    }
    if (wid == 0) { const int kq = L + fq * 8; const pg8::bf16x8 pf = *(LAS const pg8::bf16x8*)(P + fr * 1056 + kq);
        const bool ok = fq < 2; const bf16* vr = VNp + (size_t)(ok ? (kq - L) : 0) * HD + 4 * fr;
#pragma unroll
        for (int hf = 0; hf < 2; ++hf)
#pragma unroll
            for (int c = 0; c < 4; ++c) { unsigned e[8];
#pragma unroll
                for (int j = 0; j < 8; ++j) e[j] = ok ? (unsigned)vr[(size_t)j * HD + hf * 64 + c] : 0u;
                v4u w; w.x = e[0] | (e[1] << 16); w.y = e[2] | (e[3] << 16); w.z = e[4] | (e[5] << 16); w.w = e[6] | (e[7] << 16);
                oacc[hf * 4 + c] = __builtin_amdgcn_mfma_f32_16x16x32_bf16(__builtin_bit_cast(pg8::bf16x8, w), pf, oacc[hf * 4 + c], 0, 0, 0); } }
    LAS float* PO = (LAS float*)lds;
#pragma unroll
    for (int hf = 0; hf < 2; ++hf)
#pragma unroll
        for (int r = 0; r < 4; ++r) *(LAS f32x4*)(PO + (wid * 16 + fr) * 128 + hf * 64 + 16 * fq + 4 * r) = (f32x4){oacc[hf * 4][r], oacc[hf * 4 + 1][r], oacc[hf * 4 + 2][r], oacc[hf * 4 + 3][r]};
    asm volatile("s_waitcnt lgkmcnt(0)" ::: "memory"); __syncthreads();
    { const int q = tid >> 5, d4 = (tid & 31) * 4; f32x4 s = *(LAS const f32x4*)(PO + q * 128 + d4);
#pragma unroll
      for (int w = 1; w < 8; ++w) { const f32x4 t = *(LAS const f32x4*)(PO + (w * 16 + q) * 128 + d4); s = s + t; }
      const float ri = RI[q];
      bf16* o = (bf16*)(ws + WS_OB) + ((size_t)MP + st * SN + q) * D + h * HD + d4;
      *(GAS unsigned long long*)o = (unsigned long long)pk2(s.x * ri, s.y * ri) | ((unsigned long long)pk2(s.z * ri, s.w * ri) << 32); }
    __syncthreads();
}

constexpr int N_PROMPT = NB * NH * 32, N_UNIT = SB * NH, N_POS = N_PROMPT + N_UNIT + N_SLICE;
static_assert(N_UNIT == N_SLICE && N_PROMPT >= 2 * N_UNIT, "ticket layout");
template <int MODE> __device__ __forceinline__ void pos_decode(int pos, int& kind, int& id) {
    if (pos < 4 * N_UNIT) { const int g = pos >> 2, r = pos & 3; if (r == 2) { kind = 1; id = g; } else if (r == 3) { kind = 2; id = g; } else { kind = 0; id = 2 * g + r; } }
    else { kind = 0; id = pos - 2 * N_UNIT; }
}
template <int MODE>
__device__ __forceinline__ void get_blk(int p, int li, unsigned char* ws, const float* rel, att::Blk& b) {
    bf16* QPp = (bf16*)(ws + WS_QP); bf16* KPp = (bf16*)(ws + WS_KP); bf16* VPp = (bf16*)(ws + WS_VP); bf16* OBp = (bf16*)(ws + WS_OB);
    int bh, qb;
    bh = p & 31; qb = 31 - (p >> 5);
    const int bb = bh >> 4, h = bh & 15;
    b.Q = QPp + ((size_t)bh * T + qb * 256) * HD; b.K = KPp + (size_t)bh * T * HD; b.V = VPp + (size_t)bh * T * HD; b.O = OBp + ((size_t)bb * T + qb * 256) * D + h * HD; b.P0 = qb * 256;
    if (MODE == 0) { b.aux = rel + (size_t)(li * NH + h) * NREL; b.c0 = qb * 4; b.jlo = b.c0 > 8 ? b.c0 - 8 : 0; b.jhi = b.c0 + 4; b.cap = 1 << 29; b.skipthr = __builtin_inff(); }
    else { b.aux = (const float*)(ws + WS_LFP) + (size_t)bh * T; b.c0 = 0; b.jlo = 0; b.jhi = 4 * (qb + 1); b.cap = qb * 256 + 255; b.skipthr = ((const float*)(ws + WS_QKM))[li]; }
}
__device__ __forceinline__ int take_ticket(gu32* qc, LAS unsigned char* lds, int tid) {
    volatile LAS int* w = (volatile LAS int*)(lds + 131008);
    if (tid == 0) *w = (int)__hip_atomic_fetch_add(qc, 1u, RLX_AGENT);
    __syncthreads();
    return __builtin_amdgcn_readfirstlane(*w);
}
template <int MODE>
__device__ __forceinline__ void attn_phase(LAS unsigned char* lds, int bx, int G, int layer, unsigned char* ws, const float* const __attribute__((address_space(4)))* in, const int tid) {
    att::Blk cur; att::Nxt nxt; att::Seam S;
    const int li = layer >> 1;
    const float* rel = in[12]; const float* kcache = in[MODE == 1 ? 4 : 2]; const float* vcache = in[MODE == 1 ? 5 : 3];
    gu32* qc = (gu32*)(ws + WS_CTL) + CW_QUEUE + 64 * layer;
    int pos = take_ticket(qc, lds, tid);
    while (pos < N_POS) {
        int kind, id; pos_decode<MODE>(pos, kind, id);
        if (kind != 0) {
            if (kind == 1) sample_attn<MODE>((LAS char*)lds, id, li, ws, rel, kcache, vcache, tid);
            else conv_slice(in, ws, layer + 1, id, lds, tid);
            pos = take_ticket(qc, lds, tid); continue; }
        get_blk<MODE>(id, li, ws, rel, cur);
        att::attn_prime<MODE>(cur, (LAS char*)lds, S, tid);
        for (;;) {
            int np = N_POS, id2 = 0; bool nf = false;
            int tk = 0;
            att::attn_block<MODE>(cur, [&]() { if (tid == 0) tk = (int)__hip_atomic_fetch_add(qc, 1u, RLX_AGENT); },
                [&](att::Nxt& nxt) {
                { volatile LAS int* w = (volatile LAS int*)(lds + 131008); if (tid == 0) *w = tk; __syncthreads(); np = __builtin_amdgcn_readfirstlane(*w); }
                int k2 = 3; if (np < N_POS) pos_decode<MODE>(np, k2, id2);
                nf = (k2 == 0);
                att::Blk nb; if (nf) { get_blk<MODE>(id2, li, ws, rel, nb); nxt.Q = nb.Q; nxt.K = nb.K; nxt.V = nb.V; nxt.jlo = nb.jlo; } else { nxt.Q = cur.Q; nxt.K = cur.K; nxt.V = cur.V; nxt.jlo = cur.jlo; }
            }, (LAS char*)lds, S, tid);
            pos = np;
            if (!nf) break;
            int id3 = id2; asm volatile("" : "+s"(id3));
            get_blk<MODE>(id3, li, ws, rel, cur);
        }
    }
}

struct Args { const float* in[19]; float* out; unsigned char* ws; int ph_lo, ph_hi; };
constexpr int PH_PER_LAYER = 5, N_PHASES = 1 + DEPTH * PH_PER_LAYER;

typedef const __attribute__((address_space(4))) Args CArgs;
#define PH_BEGIN() CArgs* A; { unsigned long long k_ = (unsigned long long)__builtin_amdgcn_kernarg_segment_ptr(); asm volatile("" : "+s"(k_)); A = (CArgs*)k_; } \
    unsigned char* const ws = A->ws; float* const out = A->out; int bx = blockIdx.x; asm volatile("" : "+s"(bx)); (void)ws; (void)out; (void)bx; \
    unsigned m1_ = ~0u; int ws_ = wave_s; asm volatile("" : "+s"(m1_), "+s"(ws_)); int tid = ws_ * 64 + (int)__builtin_amdgcn_mbcnt_hi(m1_, __builtin_amdgcn_mbcnt_lo(m1_, 0u)); asm volatile("" : "+v"(tid)); const int lane = tid & 63, wave = wave_s; (void)lane; (void)wave; \
    const int gw = bx * NWAVES + wave, NGW = G * NWAVES; const long gt = (long)bx * (NWAVES * 64) + tid, NGT = (long)G * (NWAVES * 64); (void)gw; (void)NGW; (void)gt; (void)NGT
__global__ void __launch_bounds__(NWAVES * 64, 2) fwd_kernel(Args args_unused) {
    extern __shared__ __attribute__((aligned(16))) unsigned char lds_raw[];
    LAS unsigned char* lds = (LAS unsigned char*)lds_raw;
    volatile LAS unsigned* MISC = (volatile LAS unsigned*)(lds + MISC_OFF);
    const int G = gridDim.x;
    const int wave_s = __builtin_amdgcn_readfirstlane((int)threadIdx.x >> 6);
    for (int u = threadIdx.x; u < (LDS_BYTES - LDSCTL_OFF) / 4; u += NWAVES * 64) ((LAS unsigned*)(lds + LDSCTL_OFF))[u] = 0u;
    __syncthreads();
    int lo, hi; XcdBarrier bar;
    { PH_BEGIN(); lo = A->ph_lo; hi = A->ph_hi; bar = xcd_barrier_post((unsigned*)((gu32*)(ws + WS_CTL) + CW_BAR), MISC + 8, tid == 0); }
#define IN(k) (lo <= (k) && (k) < hi)
#define SEAM(k) do { if (IN(k) && IN((k) + 1)) { XcdBarrier b2_ = bar; unsigned m2_ = ~0u; int w2_ = wave_s; asm volatile("" : "+s"(b2_.bar), "+s"(m2_), "+s"(w2_)); \
    xcd_barrier(b2_, w2_ == 0 && __builtin_amdgcn_mbcnt_hi(m2_, __builtin_amdgcn_mbcnt_lo(m2_, 0u)) == 0u); } } while (0)
#define P_WQKV ((bf16*)(ws + WS_WQKV))
#define P_WO ((bf16*)(ws + WS_WO))
#define P_WGU ((bf16*)(ws + WS_WGU))
#define P_WD ((bf16*)(ws + WS_WD))
#define P_XB ((bf16*)(ws + WS_XB))
#define P_SSQ ((float*)(ws + WS_SSQ))
#define P_QP ((bf16*)(ws + WS_QP))
#define P_KP ((bf16*)(ws + WS_KP))
#define P_VP ((bf16*)(ws + WS_VP))
#define P_QS ((bf16*)(ws + WS_QS))
#define P_OB ((bf16*)(ws + WS_OB))
#define P_HB ((bf16*)(ws + WS_HB))
#define P_LFP ((float*)(ws + WS_LFP))
#define P_LFS ((float*)(ws + WS_LFS))
#define P_KSN ((bf16*)(ws + WS_KSN))
#define P_VSN ((bf16*)(ws + WS_VSN))
#define P_WF ((bf16*)(ws + WS_WF))
#define P_X (out + O_Y)

    if (IN(0)) { PH_BEGIN();
        LAS float* scr = (LAS float*)(lds + RING_OFF + wave * 16384);
        for (int it = gw; it < conv_group_items(0); it += NGW) conv_item(A->in, ws, 0, it, scr, lane);
        for (int row = gw; row < M; row += NGW) {
            const float* xr = row < MP ? A->in[0] + (size_t)row * D : A->in[1] + (size_t)(row - MP) * D;
            row_update(xr, nullptr, nullptr, P_XB + (size_t)row * D, P_SSQ + (size_t)row * 32, lane);
        }
        for (long idx = gt; idx < 2L * NH * D; idx += NGT) { const int ib = (int)(idx >> 15), h = (int)((idx >> 11) & 15), k = (int)(idx & (D - 1));
            P_WF[idx] = (bf16)f2bf(A->in[7][(size_t)(2 * ib + 1) * D + k] * A->in[13][((size_t)ib * D + k) * NH + h]); }
        if (gw == 0) {
#pragma unroll 1
            for (int ib = 0; ib < 2; ++ib) { const float* gq = A->in[9] + (2 * ib + 1) * HD; const float* gk = A->in[10] + (2 * ib + 1) * HD;
                float mqk = fmaxf(fabsf(gq[lane] * gk[lane]), fabsf(gq[lane + 64] * gk[lane + 64]));
#pragma unroll
                for (int o = 1; o < 64; o <<= 1) mqk = fmaxf(mqk, __shfl_xor(mqk, o));
                if (lane == 0) ((float*)(ws + WS_QKM))[ib] = 11.313708499f * mqk * 1.02f + 40.0f; }
        }
    }
    SEAM(0);

#pragma unroll 1
    for (int layer = 0; layer < DEPTH; ++layer) {
        const int pb = 1 + layer * PH_PER_LAYER, li = layer >> 1; const bool fox = (layer & 1) != 0;
        if (IN(pb + 0)) { PH_BEGIN();
            if (fox) {
                const bf16* wfp = P_WF + (size_t)li * NH * D; const float* bfp = A->in[14] + li * NH;
                const int fr = lane & 15, fq = lane >> 4, lr = lane >> 2, lc = lane & 3, pidx = (((lane & 15) << 2) | (lane >> 4)) << 2;
                const int nidle = (G > 192) ? (G - 192) * NWAVES : NGW, gw0 = (G > 192) ? (bx - 192) * NWAVES + wave : gw;
                if (gw0 >= 0)
                for (int grp = gw0; grp < M / 16; grp += nidle) {
                    const int row = grp * 16 + fr;
                    const char* ap = (const char*)(P_XB + (size_t)(grp * 16 + lr) * D) + lc * 16; const char* bp = (const char*)(wfp + (size_t)lr * D) + lc * 16;
                    pg8::f32x4 acc = (pg8::f32x4){0.f, 0.f, 0.f, 0.f};
#pragma unroll 8
                    for (int ks = 0; ks < D / 32; ++ks) { pg8::u32x4 av = *(const pg8::u32x4*)(ap + ks * 64), bv = *(const pg8::u32x4*)(bp + ks * 64);
                        av.x = (unsigned)__builtin_amdgcn_ds_bpermute(pidx, (int)av.x); av.y = (unsigned)__builtin_amdgcn_ds_bpermute(pidx, (int)av.y); av.z = (unsigned)__builtin_amdgcn_ds_bpermute(pidx, (int)av.z); av.w = (unsigned)__builtin_amdgcn_ds_bpermute(pidx, (int)av.w);
                        bv.x = (unsigned)__builtin_amdgcn_ds_bpermute(pidx, (int)bv.x); bv.y = (unsigned)__builtin_amdgcn_ds_bpermute(pidx, (int)bv.y); bv.z = (unsigned)__builtin_amdgcn_ds_bpermute(pidx, (int)bv.z); bv.w = (unsigned)__builtin_amdgcn_ds_bpermute(pidx, (int)bv.w);
                        acc = __builtin_amdgcn_mfma_f32_16x16x32_bf16(__builtin_bit_cast(pg8::bf16x8, bv), __builtin_bit_cast(pg8::bf16x8, av), acc, 0, 0, 0); }
                    const float rs = pg8::row_rstd(P_SSQ, row, fq);
                    const pg8::f32x4 bb = *(const pg8::f32x4*)(bfp + 4 * fq); pg8::f32x4 lf;
#pragma unroll
                    for (int i = 0; i < 4; ++i) { const float z = acc[i] * rs + bb[i]; lf[i] = fminf(z, 0.f) - log1pf(expf(-fabsf(z))); }
                    if (row < MP) { *(pg8::f32x4*)(out + O_BFP + ((size_t)li * MP + row) * NH + 4 * fq) = lf;
#pragma unroll
                        for (int i = 0; i < 4; ++i) P_LFP[(size_t)((row >> 13) * NH + 4 * fq + i) * T + (row & (T - 1))] = lf[i]; }
                    else { const int rs2 = row - MP; *(pg8::f32x4*)(out + O_BFS + ((size_t)li * MS + rs2) * NH + 4 * fq) = lf;
#pragma unroll
                        for (int i = 0; i < 4; ++i) P_LFS[(size_t)((rs2 >> 4) * NH + 4 * fq + i) * LS + PAST + (rs2 & 15)] = lf[i]; }
                }
                const float* clf = A->in[6] + (size_t)li * SB * PAST * NH;
                for (long idx = gt; idx < (long)SB * NH * PAST; idx += NGT) { const int unit = (int)(idx >> 10), j = (int)(idx & 1023), st = unit >> 4, h = unit & 15;
                    P_LFS[(size_t)unit * LS + j] = clf[((size_t)st * PAST + j) * NH + h]; }
            }
            pg8::Gemm g{P_XB, P_WQKV + (size_t)layer * NQKV * D, MP, NQKV, D}; pg8::StaticOrder S; S.init(MP, NQKV, G, bx);
            pg8::EpiQKV E;
            E.ssq = P_SSQ; E.gq = A->in[9] + layer * HD; E.gk = A->in[10] + layer * HD; E.QP = P_QP; E.pstride = (WS_KP - WS_QP) / 2; E.QS = P_QS;
            E.srows = SN; E.lc = 0; E.KS = P_KSN; E.sstride = (WS_VSN - WS_KSN) / 2;
            E.okp = out + (fox ? O_BKP + (size_t)li * MP * D : O_AKP + (size_t)li * NB * WIN * D); E.opstride = fox ? SZ_BP : SZ_AP;
            E.oks = out + (fox ? O_BKS : O_AKS) + (size_t)li * MS * D; E.osstride = SZ_S;
            E.fox = fox ? 1 : 0; E.red = (LAS float*)(lds + RED_OFF);
            pg8::gemm_phase<pg8::EpiQKV, pg8::StaticOrder, true, true>(lds + RING_OFF, g, S, E, tid);
            __syncthreads();
            {
                sk::SkQKV K2; K2.ssq = P_SSQ + (size_t)MP * 32; K2.gq = A->in[9] + layer * HD; K2.gk = A->in[10] + layer * HD; K2.QS = P_QS;
                K2.srows = SN; K2.lc = 0; K2.KS = P_KSN; K2.sstride = (WS_VSN - WS_KSN) / 2;
                K2.oks = out + (fox ? O_BKS : O_AKS) + (size_t)li * MS * D; K2.osstride = SZ_S;
                sk::skinny_phase<sk::SkQKV>(lds + RING_OFF, P_XB + (size_t)MP * D, P_WQKV + (size_t)layer * NQKV * D, NQKV / 128, D, (unsigned*)((gu32*)(ws + WS_CTL) + CW_SKQ + 64 * (layer * 4 + 0)), tid, K2);
            }
        }
        SEAM(pb + 0);
        if (IN(pb + 1)) { PH_BEGIN();
            if (fox) attn_phase<1>(lds + RING_OFF, bx, G, layer, ws, A->in, tid);
            else attn_phase<0>(lds + RING_OFF, bx, G, layer, ws, A->in, tid);
        }
        SEAM(pb + 1);
        if (IN(pb + 2)) { PH_BEGIN();
            pg8::Gemm g{P_OB, P_WO + (size_t)layer * D * D, MP, D, D}; pg8::StaticOrder S; S.init(MP, D, G, bx);
            pg8::EpiResid E;
            E.X = nullptr; E.XB = P_XB; E.ssq = P_SSQ;
            pg8::gemm_phase<pg8::EpiResid, pg8::StaticOrder, true, true>(lds + RING_OFF, g, S, E, tid);
            __syncthreads();
            {   sk::SkResid K2; K2.xin = (layer == 0) ? A->in[1] : P_X + (size_t)MP * D; K2.X = P_X + (size_t)MP * D; K2.XB = P_XB + (size_t)MP * D; K2.ssq = P_SSQ + (size_t)MP * 32;
                sk::skinny_phase<sk::SkResid>(lds + RING_OFF, P_OB + (size_t)MP * D, P_WO + (size_t)layer * D * D, D / 64, D, (unsigned*)((gu32*)(ws + WS_CTL) + CW_SKQ + 64 * (layer * 4 + 1)), tid, K2); }
        }
        SEAM(pb + 2);
        if (IN(pb + 3)) { PH_BEGIN();
            pg8::Gemm g{P_XB, P_WGU + (size_t)layer * NGU * D, MP, NGU, D}; pg8::StaticOrder S; S.init(MP, NGU, G, bx);
            pg8::EpiSwiglu E{P_HB, FF, P_SSQ};
            pg8::gemm_phase<pg8::EpiSwiglu, pg8::StaticOrder, true, true>(lds + RING_OFF, g, S, E, tid);
            __syncthreads();
            {   sk::SkSwiglu K2{P_HB + (size_t)MP * FF, FF, P_SSQ + (size_t)MP * 32};
                sk::skinny_phase<sk::SkSwiglu>(lds + RING_OFF, P_XB + (size_t)MP * D, P_WGU + (size_t)layer * NGU * D, NGU / 128, D, (unsigned*)((gu32*)(ws + WS_CTL) + CW_SKQ + 64 * (layer * 4 + 2)), tid, K2); }
        }
        SEAM(pb + 3);
        if (IN(pb + 4)) { PH_BEGIN();
            pg8::Gemm g{P_HB, P_WD + (size_t)layer * D * FF, MP, D, FF}; pg8::StaticOrder S; S.init(MP, D, G, bx);
            pg8::EpiResid E;
            E.X = (layer == DEPTH - 1) ? P_X : nullptr; E.XB = P_XB; E.ssq = P_SSQ;
            pg8::gemm_phase<pg8::EpiResid, pg8::StaticOrder, true, true>(lds + RING_OFF, g, S, E, tid);
            __syncthreads();
            {   sk::SkResid K2; K2.xin = P_X + (size_t)MP * D; K2.X = P_X + (size_t)MP * D; K2.XB = P_XB + (size_t)MP * D; K2.ssq = P_SSQ + (size_t)MP * 32;
                sk::skinny_phase<sk::SkResid>(lds + RING_OFF, P_HB + (size_t)MP * FF, P_WD + (size_t)layer * D * FF, D / 64, FF, (unsigned*)((gu32*)(ws + WS_CTL) + CW_SKQ + 64 * (layer * 4 + 3)), tid, K2); }
        }
        SEAM(pb + 4);
    }
#undef IN
#undef SEAM
}

#ifndef MK_SPLIT
#define MK_SPLIT 0
#endif
extern "C" void kernel_launch(void* const* d_in, const int* in_sizes, int n_in, void* d_out, int out_size, void* d_ws, size_t ws_size, hipStream_t stream) {
    static int grid = 0;
    if (grid == 0) {
        if (n_in != 19 || in_sizes[0] != MP * D || (size_t)out_size != OUT_TOTAL || ws_size < WS_END) { fprintf(stderr, "kernel_launch: shape mismatch (n_in %d in0 %d out %d ws %zu); nothing launched\n", n_in, n_in > 0 ? in_sizes[0] : -1, out_size, ws_size); grid = -1; return; }
        int dev = 0, cus = 0;
        if (hipGetDevice(&dev) != hipSuccess || hipDeviceGetAttribute(&cus, hipDeviceAttributeMultiprocessorCount, dev) != hipSuccess) { grid = -1; return; }
        if (hipFuncSetAttribute((const void*)fwd_kernel, hipFuncAttributeMaxDynamicSharedMemorySize, LDS_BYTES) != hipSuccess) { fprintf(stderr, "kernel_launch: hipFuncSetAttribute failed\n"); grid = -1; return; }
        int per_cu = 0;
        if (hipOccupancyMaxActiveBlocksPerMultiprocessor(&per_cu, (const void*)fwd_kernel, NWAVES * 64, LDS_BYTES) != hipSuccess || per_cu < 1) fprintf(stderr, "kernel_launch: occupancy query reports %d\n", per_cu);
        (void)hipGetLastError();
        grid = cus;
    }
    if (grid < 0) return;
    if (hipMemsetAsync((char*)d_ws + WS_CTL, 0, CTL_ZERO_BYTES, stream) != hipSuccess) return;
    Args a{};
    for (int i = 0; i < 19; ++i) a.in[i] = (const float*)d_in[i];
    a.out = (float*)d_out; a.ws = (unsigned char*)d_ws;
#if MK_SPLIT
    for (int p = 0; p < N_PHASES; ++p) { a.ph_lo = p; a.ph_hi = p + 1; hipLaunchKernelGGL(fwd_kernel, dim3(grid), dim3(NWAVES * 64), LDS_BYTES, stream, a); }
#else
    a.ph_lo = 0; a.ph_hi = N_PHASES;
    hipLaunchKernelGGL(fwd_kernel, dim3(grid), dim3(NWAVES * 64), LDS_BYTES, stream, a);
#endif
}
```

```cpp
#include <hip/hip_runtime.h>
#include <cstdio>
#include <cstdint>
namespace pg8 {
#define PG8_LAS __attribute__((address_space(3)))
typedef unsigned short bf16_t;
typedef short bf16x8 __attribute__((ext_vector_type(8)));
typedef float f32x4 __attribute__((ext_vector_type(4)));
typedef unsigned u32x4 __attribute__((ext_vector_type(4)));
constexpr int BM = 256, BK = 64, HALF = 128, HTB = HALF * BK * 2  , STAGE_BYTES = 8 * HTB, NXCD = 8, WGM = 4;

__host__ __device__ __forceinline__ int lds_byte(int r, int c) { const int st = (r >> 4) * 2 + (c >> 5), rr = r & 15, cc = c & 31, ob = rr * 64 + cc * 2; return st * 1024 + (ob ^ (((ob >> 9) & 1) << 5)); }
__host__ __device__ __forceinline__ void stage_rc(int b, int& R, int& C) { const int st = b / 1024, sb = b % 1024, swz = sb ^ (((sb >> 9) & 1) << 5); R = (st >> 1) * 16 + swz / 64; C = (st & 1) * 32 + (swz % 64) / 2; }
__host__ __device__ __forceinline__ int perm32(int rho) { const int n = rho >> 4, i = rho & 15; return 8 * (i >> 2) + 4 * n + (i & 3); }

struct Unit { int pm, pn; };
struct Gemm { const bf16_t* A; const bf16_t* Bt; int M, N, K; };

struct StaticOrder {
    int nM, nN, nwg, G, c, mix3;
    __host__ __device__ void init(int M, int N, int G_, int c_, int mix3_ = 0) { nM = M / BM; nN = N / BM; nwg = nM * nN; G = G_; c = c_; mix3 = mix3_; }
    __host__ __device__ bool next(int i, Unit& u) const {
        const long L = (long)i * G + c; if (L >= nwg) return false;
        int wgid = (int)L; { const int q = nwg / NXCD, r = nwg % NXCD, xcd = wgid % NXCD, off = wgid / NXCD; wgid = (xcd < r ? xcd * (q + 1) : r * (q + 1) + (xcd - r) * q) + off; }
        const int nig = WGM * nN, gid = wgid / nig, fm = gid * WGM, gsz = (nM - fm) < WGM ? (nM - fm) : WGM;
        u.pm = fm + ((wgid % nig) % gsz); u.pn = (wgid % nig) / gsz; if (mix3) u.pn = (u.pn % 3) * (nN / 3) + u.pn / 3; return true;
    }
    __device__ __forceinline__ void a_ready(const Unit&) const {}
    __device__ __forceinline__ void done(const Unit&) const {}
};

__device__ __forceinline__ unsigned cvt_pk_bf16(float lo, float hi) { unsigned r; asm volatile("v_cvt_pk_bf16_f32 %0, %1, %2" : "=v"(r) : "v"(lo), "v"(hi)); return r; }
struct EpiF32 {
    static constexpr bool PERM = false, AFTER_DRAIN = false;
    float* C; int ldc;
    __device__ __forceinline__ void operator()(const f32x4 (&acc)[2][2][4][2], const Unit& u, int wr, int wc, int fr, int fq) const {
        const int row0 = u.pm * BM + wr * 64 + fr, col0 = u.pn * BM + wc * 32 + 4 * fq;
#pragma unroll
        for (int ai = 0; ai < 2; ++ai)
#pragma unroll
            for (int m = 0; m < 4; ++m) { float* rowp = C + (size_t)(row0 + ai * HALF + m * 16) * ldc + col0;
#pragma unroll
                for (int bj = 0; bj < 2; ++bj)
#pragma unroll
                    for (int n = 0; n < 2; ++n) *(f32x4*)(rowp + bj * HALF + n * 16) = acc[ai][bj][m][n]; }
    }
};
template <class Epi, class Sched, bool ALIGN_EPI = false, bool SP2 = false>
__device__ __forceinline__ void gemm_phase(PG8_LAS unsigned char* lds, const Gemm g, const Sched& S, const Epi& E, const int tid_in) {
    int tid_ = tid_in; asm volatile("" : "+v"(tid_));
    const int tid = tid_, wid = __builtin_amdgcn_readfirstlane(tid >> 6), lane = tid & 63, wr = wid >> 2, wc = wid & 3, fr = lane & 15, fq = lane >> 4;
    const int K = g.K, nt = K / BK;
    unsigned voffA[2], voffB[2];
#pragma unroll
    for (int i = 0; i < 2; ++i) { int R, C; stage_rc(tid * 16 + i * 8192, R, C); const int Rb = Epi::PERM ? ((R & ~31) + perm32(R & 31)) : R;
        voffA[i] = (unsigned)(R * K + C) * 2u; voffB[i] = (unsigned)(Rb * K + C) * 2u; }
    const size_t kstep = (size_t)(BK * 2);
    const size_t hstep = (size_t)HALF * K * 2;
    const size_t tstep = 2 * hstep;
    const unsigned ldsw = (unsigned)wid * 1024u;
    const int aoff = lds_byte(wr * 64 + fr, fq * 8), boff = lds_byte(wc * 32 + fr, fq * 8);
#define PG8_SA(b, h) (((b) * 2 + (h)) * HTB)
#define PG8_SB(b, h) ((4 + (b) * 2 + (h)) * HTB)
#define PG8_STAGE(bufoff, gbase, voff) do { _Pragma("unroll") for (int _i = 0; _i < 2; ++_i) \
        __builtin_amdgcn_global_load_lds((const unsigned*)((const char*)(gbase) + (voff)[_i]), (PG8_LAS unsigned*)(lds + (bufoff) + ldsw + _i * 8192), 16, 0, 0); } while (0)
#define PG8_LDA(dst, b, h) do { _Pragma("unroll") for (int m = 0; m < 4; ++m) _Pragma("unroll") for (int k = 0; k < 2; ++k) dst[m][k] = *(const PG8_LAS bf16x8*)(lds + PG8_SA(b, h) + aoff + m * 2048 + k * 1024); } while (0)
#define PG8_LDB(dst, b, h) do { _Pragma("unroll") for (int n = 0; n < 2; ++n) _Pragma("unroll") for (int k = 0; k < 2; ++k) dst[n][k] = *(const PG8_LAS bf16x8*)(lds + PG8_SB(b, h) + boff + n * 2048 + k * 1024); } while (0)
#define PG8_MMA(ai, bj, At, Bt) do { __builtin_amdgcn_s_setprio(1); _Pragma("unroll") for (int m = 0; m < 4; ++m) _Pragma("unroll") for (int n = 0; n < 2; ++n) _Pragma("unroll") for (int k = 0; k < 2; ++k) \
        acc[ai][bj][m][n] = __builtin_amdgcn_mfma_f32_16x16x32_bf16(Bt[n][k], At[m][k], acc[ai][bj][m][n], 0, 0, 0); __builtin_amdgcn_s_setprio(0); } while (0)
#define PG8_WAIT_V(n) asm volatile("s_waitcnt vmcnt(" #n ")" ::: "memory")
#define PG8_WAIT_L(n) asm volatile("s_waitcnt lgkmcnt(" #n ")" ::: "memory")
#define PG8_BAR __builtin_amdgcn_s_barrier()
#define PG8_SCHED __builtin_amdgcn_sched_barrier(0)
    Unit cur, nxt; int ui = 0;
    if (!S.next(0, cur)) return;
    f32x4 acc[2][2][4][2];
#pragma unroll
    for (int a = 0; a < 2; ++a)
#pragma unroll
        for (int b = 0; b < 2; ++b)
#pragma unroll
            for (int m = 0; m < 4; ++m)
#pragma unroll
                for (int n = 0; n < 2; ++n) acc[a][b][m][n] = (f32x4){0.f, 0.f, 0.f, 0.f};
    bf16x8 At[4][2], B0[2][2], B1[2][2];
    const char* cA = (const char*)g.A + (size_t)cur.pm * tstep; const char* cB = (const char*)g.Bt + (size_t)cur.pn * tstep;
    S.a_ready(cur);
    if constexpr (SP2) {
        PG8_STAGE(PG8_SB(0, 0), cB, voffB); PG8_STAGE(PG8_SB(0, 1), cB + hstep, voffB); PG8_STAGE(PG8_SA(0, 0), cA, voffA); PG8_STAGE(PG8_SA(0, 1), cA + hstep, voffA);
        if (wr == 1) PG8_BAR;
        PG8_WAIT_V(2); PG8_BAR;
        PG8_STAGE(PG8_SB(1, 0), cB + kstep, voffB); PG8_STAGE(PG8_SA(1, 0), cA + kstep, voffA); PG8_STAGE(PG8_SB(1, 1), cB + hstep + kstep, voffB);
        PG8_WAIT_V(6); PG8_BAR;
    } else {
        PG8_STAGE(PG8_SB(0, 0), cB, voffB); PG8_STAGE(PG8_SA(0, 0), cA, voffA); PG8_STAGE(PG8_SB(0, 1), cB + hstep, voffB); PG8_STAGE(PG8_SA(0, 1), cA + hstep, voffA);
        if (wr == 1) PG8_BAR;
        PG8_WAIT_V(4); PG8_BAR;
        PG8_STAGE(PG8_SB(1, 0), cB + kstep, voffB); PG8_STAGE(PG8_SA(1, 0), cA + kstep, voffA); PG8_STAGE(PG8_SB(1, 1), cB + hstep + kstep, voffB);
        PG8_WAIT_V(6); PG8_BAR;
    }
    for (;;) {
        const bool has_next = S.next(ui + 1, nxt);
        const char* nA = has_next ? (const char*)g.A + (size_t)nxt.pm * tstep : cA; const char* nB = has_next ? (const char*)g.Bt + (size_t)nxt.pn * tstep : cB;
        for (int t = 0; t < nt; t += 2) {
            const bool last = (t == nt - 2);
            const char* a1 = cA + (size_t)(t + 1) * kstep;
            const char* a2 = last ? nA : cA + (size_t)(t + 2) * kstep; const char* b2 = last ? nB : cB + (size_t)(t + 2) * kstep;
            const char* a3 = a2 + kstep; const char* b3 = b2 + kstep;
            if (last && has_next) S.a_ready(nxt);
            if constexpr (SP2) {
            PG8_LDB(B0, 0, 0); PG8_LDB(B1, 0, 1); PG8_SCHED; PG8_LDA(At, 0, 0); PG8_STAGE(PG8_SA(1, 1), a1 + hstep, voffA);
            PG8_WAIT_V(8); PG8_WAIT_L(0); PG8_BAR; PG8_MMA(0, 0, At, B0); PG8_MMA(0, 1, At, B1); PG8_BAR; PG8_SCHED;
            PG8_LDA(At, 0, 1); PG8_STAGE(PG8_SB(0, 0), b2, voffB); PG8_STAGE(PG8_SB(0, 1), b2 + hstep, voffB); PG8_STAGE(PG8_SA(0, 0), a2, voffA);
            PG8_WAIT_V(8); PG8_WAIT_L(0); PG8_BAR; PG8_MMA(1, 0, At, B0); PG8_MMA(1, 1, At, B1); PG8_BAR; PG8_SCHED;
            PG8_LDB(B0, 1, 0); PG8_LDB(B1, 1, 1); PG8_SCHED; PG8_LDA(At, 1, 0); PG8_STAGE(PG8_SA(0, 1), a2 + hstep, voffA);
            PG8_WAIT_V(8); PG8_WAIT_L(0); PG8_BAR; PG8_MMA(0, 0, At, B0); PG8_MMA(0, 1, At, B1); PG8_BAR; PG8_SCHED;
            PG8_LDA(At, 1, 1); PG8_STAGE(PG8_SB(1, 0), b3, voffB); PG8_STAGE(PG8_SB(1, 1), b3 + hstep, voffB); PG8_STAGE(PG8_SA(1, 0), a3, voffA);
            PG8_WAIT_V(8); PG8_WAIT_L(0); PG8_BAR; PG8_MMA(1, 0, At, B0); PG8_MMA(1, 1, At, B1); PG8_BAR; PG8_SCHED;
            } else {
            PG8_LDB(B0, 0, 0); PG8_SCHED; PG8_LDA(At, 0, 0); PG8_STAGE(PG8_SA(1, 1), a1 + hstep, voffA);
            PG8_WAIT_L(8); PG8_BAR; PG8_WAIT_L(0); PG8_MMA(0, 0, At, B0); PG8_BAR; PG8_SCHED;
            PG8_LDB(B1, 0, 1); PG8_STAGE(PG8_SB(0, 0), b2, voffB);
            PG8_BAR; PG8_WAIT_L(0); PG8_MMA(0, 1, At, B1); PG8_BAR;
            PG8_LDA(At, 0, 1); PG8_STAGE(PG8_SA(0, 0), a2, voffA);
            PG8_BAR; PG8_WAIT_L(0); PG8_MMA(1, 0, At, B0); PG8_BAR; PG8_SCHED;
            PG8_STAGE(PG8_SB(0, 1), b2 + hstep, voffB);
            PG8_WAIT_V(6); PG8_BAR; PG8_MMA(1, 1, At, B1); PG8_BAR;
            PG8_LDB(B0, 1, 0); PG8_SCHED; PG8_LDA(At, 1, 0); PG8_STAGE(PG8_SA(0, 1), a2 + hstep, voffA);
            PG8_WAIT_L(8); PG8_BAR; PG8_WAIT_L(0); PG8_MMA(0, 0, At, B0); PG8_BAR; PG8_SCHED;
            PG8_LDB(B1, 1, 1); PG8_STAGE(PG8_SB(1, 0), b3, voffB);
            PG8_BAR; PG8_WAIT_L(0); PG8_MMA(0, 1, At, B1); PG8_BAR;
            PG8_LDA(At, 1, 1); PG8_STAGE(PG8_SA(1, 0), a3, voffA);
            PG8_BAR; PG8_WAIT_L(0); PG8_MMA(1, 0, At, B0); PG8_BAR; PG8_SCHED;
            PG8_STAGE(PG8_SB(1, 1), b3 + hstep, voffB);
            PG8_WAIT_V(6); PG8_BAR; PG8_MMA(1, 1, At, B1); PG8_BAR;
            }
        }
        if constexpr (ALIGN_EPI) { if (wr == 0) PG8_BAR; }
        if constexpr (!Epi::AFTER_DRAIN) { E(acc, cur, wr, wc, fr, fq); S.done(cur); }
        if (!has_next) break;
#pragma unroll
        for (int a = 0; a < 2; ++a)
#pragma unroll
            for (int b = 0; b < 2; ++b)
#pragma unroll
                for (int m = 0; m < 4; ++m)
#pragma unroll
                    for (int n = 0; n < 2; ++n) acc[a][b][m][n] = (f32x4){0.f, 0.f, 0.f, 0.f};
        cur = nxt; cA = nA; cB = nB; ++ui;
        if constexpr (ALIGN_EPI) { if (wr == 1) PG8_BAR; }
    }
    PG8_WAIT_V(0);
    if constexpr (!ALIGN_EPI) { if (wr == 0) PG8_BAR; }
    PG8_BAR;
    if constexpr (Epi::AFTER_DRAIN) { E.fused(acc, cur, wr, wc, fr, fq, lds, wid, lane); S.done(cur); }
#undef PG8_SA
#undef PG8_SB
#undef PG8_STAGE
#undef PG8_LDA
#undef PG8_LDB
#undef PG8_MMA
#undef PG8_WAIT_V
#undef PG8_WAIT_L
#undef PG8_BAR
#undef PG8_SCHED
}
}

namespace pg8 {
typedef unsigned u32x2 __attribute__((ext_vector_type(2)));
typedef float f32x2 __attribute__((ext_vector_type(2)));
__device__ __forceinline__ void rows_rstd(float (&rs)[2][4], const float* ssq, int pm, int wr, int fr, int fq) {
    f32x4 pa[2][4], pb[2][4];
    const float* base = ssq + (size_t)(pm * BM + wr * 64 + fr) * 32 + fq * 8;
#pragma unroll
    for (int ai = 0; ai < 2; ++ai)
#pragma unroll
        for (int m = 0; m < 4; ++m) { pa[ai][m] = *(const f32x4*)(base + (ai * HALF + m * 16) * 32); pb[ai][m] = *(const f32x4*)(base + (ai * HALF + m * 16) * 32 + 4); }
#pragma unroll
    for (int ai = 0; ai < 2; ++ai)
#pragma unroll
        for (int m = 0; m < 4; ++m) { const f32x4 a = pa[ai][m], b = pb[ai][m];
            float s = ((a[0] + a[1]) + (a[2] + a[3])) + ((b[0] + b[1]) + (b[2] + b[3]));
            s += __shfl_xor(s, 16); s += __shfl_xor(s, 32);
            rs[ai][m] = __builtin_amdgcn_rsqf(s * (1.0f / 2048.0f) + 1e-6f); }
}
__device__ __forceinline__ f32x4 to_rowmajor(f32x4 v, int pidx) {
    f32x4 o; o[0] = __int_as_float(__builtin_amdgcn_ds_bpermute(pidx, __float_as_int(v[0]))); o[1] = __int_as_float(__builtin_amdgcn_ds_bpermute(pidx, __float_as_int(v[1])));
    o[2] = __int_as_float(__builtin_amdgcn_ds_bpermute(pidx, __float_as_int(v[2]))); o[3] = __int_as_float(__builtin_amdgcn_ds_bpermute(pidx, __float_as_int(v[3]))); return o;
}
__device__ __forceinline__ int rowmajor_pidx(int lane) { return (((lane & 3) << 4) | (lane >> 2)) << 2; }
__device__ __forceinline__ void rows_rstd_rm(float (&rs)[2][4], const float* ssq, int pm, int wr, int r2, int c2) {
    f32x4 pa[2][4], pb[2][4];
    const float* base = ssq + (size_t)(pm * BM + wr * 64 + r2) * 32 + c2 * 8;
#pragma unroll
    for (int ai = 0; ai < 2; ++ai)
#pragma unroll
        for (int m = 0; m < 4; ++m) { pa[ai][m] = *(const f32x4*)(base + (ai * HALF + m * 16) * 32); pb[ai][m] = *(const f32x4*)(base + (ai * HALF + m * 16) * 32 + 4); }
#pragma unroll
    for (int ai = 0; ai < 2; ++ai)
#pragma unroll
        for (int m = 0; m < 4; ++m) { const f32x4 a = pa[ai][m], b = pb[ai][m];
            float s = ((a[0] + a[1]) + (a[2] + a[3])) + ((b[0] + b[1]) + (b[2] + b[3]));
            s += __shfl_xor(s, 1); s += __shfl_xor(s, 2);
            rs[ai][m] = __builtin_amdgcn_rsqf(s * (1.0f / 2048.0f) + 1e-6f); }
}
__device__ __forceinline__ float row_rstd(const float* ssq, int row, int fq) {
    const f32x4 a = *(const f32x4*)(ssq + (size_t)row * 32 + fq * 8), b = *(const f32x4*)(ssq + (size_t)row * 32 + fq * 8 + 4);
    float s = ((a[0] + a[1]) + (a[2] + a[3])) + ((b[0] + b[1]) + (b[2] + b[3]));
    s += __shfl_xor(s, 16); s += __shfl_xor(s, 32);
    return __builtin_amdgcn_rsqf(s * (1.0f / 2048.0f) + 1e-6f);
}
struct EpiResid {
    static constexpr bool PERM = true, AFTER_DRAIN = false;
    float* X; bf16_t* XB; float* ssq;
    __device__ __forceinline__ void operator()(const f32x4 (&acc)[2][2][4][2], const Unit& u, int wr, int wc, int fr_, int fq_) const {
        const int lane = fq_ * 16 + fr_, r2 = lane >> 2, c2 = lane & 3, pidx = rowmajor_pidx(lane);
        const int row0 = u.pm * BM + wr * 64 + r2, col0 = u.pn * BM + wc * 32 + 8 * c2;
        u32x4 v[4][2];
#define EPR_LOAD(g) do { const size_t off_ = (size_t)(row0 + ((g) >> 2) * HALF + ((g) & 3) * 16) * 2048 + col0; _Pragma("unroll") for (int bj = 0; bj < 2; ++bj) \
            v[(g) & 3][bj] = *(const u32x4*)(XB + off_ + bj * HALF); } while (0)
        EPR_LOAD(0); EPR_LOAD(1); EPR_LOAD(2);
#pragma unroll
        for (int g = 0; g < 8; ++g) { const int ai = g >> 2, m = g & 3; const int row = row0 + ai * HALF + m * 16; const size_t off = (size_t)row * 2048 + col0; float s = 0.f;
            if (g + 3 < 8) EPR_LOAD(g + 3);
#pragma unroll
            for (int bj = 0; bj < 2; ++bj) { const u32x4 xo = v[g & 3][bj];
                const f32x4 x0 = (f32x4){__uint_as_float(xo.x << 16), __uint_as_float(xo.x & 0xffff0000u), __uint_as_float(xo.y << 16), __uint_as_float(xo.y & 0xffff0000u)} + to_rowmajor(acc[ai][bj][m][0], pidx);
                const f32x4 x1 = (f32x4){__uint_as_float(xo.z << 16), __uint_as_float(xo.z & 0xffff0000u), __uint_as_float(xo.w << 16), __uint_as_float(xo.w & 0xffff0000u)} + to_rowmajor(acc[ai][bj][m][1], pidx);
                if (X != nullptr) { *(f32x4*)(X + off + bj * HALF) = x0; *(f32x4*)(X + off + bj * HALF + 4) = x1; }
                u32x4 w; w.x = cvt_pk_bf16(x0[0], x0[1]); w.y = cvt_pk_bf16(x0[2], x0[3]); w.z = cvt_pk_bf16(x1[0], x1[1]); w.w = cvt_pk_bf16(x1[2], x1[3]); *(u32x4*)(XB + off + bj * HALF) = w;
                s += ((x0[0] * x0[0] + x0[1] * x0[1]) + (x0[2] * x0[2] + x0[3] * x0[3])) + ((x1[0] * x1[0] + x1[1] * x1[1]) + (x1[2] * x1[2] + x1[3] * x1[3])); }
            s += __shfl_xor(s, 1); s += __shfl_xor(s, 2);
            if (c2 == 0) ssq[(size_t)row * 32 + u.pn * 4 + wc] = s;
            asm volatile("" ::: "memory"); }
#undef EPR_LOAD
    }
};
struct EpiSwiglu {
    static constexpr bool PERM = true, AFTER_DRAIN = false;
    bf16_t* H; int ldh; const float* ssq;
    __device__ __forceinline__ void operator()(const f32x4 (&acc)[2][2][4][2], const Unit& u, int wr, int wc, int fr_, int fq_) const {
        const int lane = fq_ * 16 + fr_, r2 = lane >> 2, c2 = lane & 3, pidx = rowmajor_pidx(lane);
        const int row0 = u.pm * BM + wr * 64 + r2, col0 = u.pn * HALF + wc * 32 + 8 * c2;
        f32x4 pa[2][4], pb[2][4];
        { const float* base = ssq + (size_t)(u.pm * BM + wr * 64 + r2) * 32 + c2 * 8;
#pragma unroll
          for (int ai = 0; ai < 2; ++ai)
#pragma unroll
            for (int m = 0; m < 4; ++m) { pa[ai][m] = *(const f32x4*)(base + (ai * HALF + m * 16) * 32); pb[ai][m] = *(const f32x4*)(base + (ai * HALF + m * 16) * 32 + 4); } }
        __builtin_amdgcn_sched_barrier(0);
        f32x4 rm[2][2][4][2];
#pragma unroll
        for (int ai = 0; ai < 2; ++ai)
#pragma unroll
            for (int bj = 0; bj < 2; ++bj)
#pragma unroll
                for (int m = 0; m < 4; ++m)
#pragma unroll
                    for (int n = 0; n < 2; ++n) rm[ai][bj][m][n] = to_rowmajor(acc[ai][bj][m][n], pidx);
        __builtin_amdgcn_sched_barrier(0);
        float rs[2][4];
#pragma unroll
        for (int ai = 0; ai < 2; ++ai)
#pragma unroll
            for (int m = 0; m < 4; ++m) { const f32x4 a = pa[ai][m], b = pb[ai][m];
                float sq = ((a[0] + a[1]) + (a[2] + a[3])) + ((b[0] + b[1]) + (b[2] + b[3]));
                sq += __shfl_xor(sq, 1); sq += __shfl_xor(sq, 2);
                rs[ai][m] = __builtin_amdgcn_rsqf(sq * (1.0f / 2048.0f) + 1e-6f); }
#pragma unroll
        for (int ai = 0; ai < 2; ++ai)
#pragma unroll
            for (int m = 0; m < 4; ++m) { const float r = rs[ai][m], c1 = -1.4426950408889634f * r, ms = __builtin_amdgcn_rcpf(r * r); float hv[8];
#pragma unroll
                for (int n = 0; n < 2; ++n) { const f32x4 gv = rm[ai][0][m][n], uv = rm[ai][1][m][n];
#pragma unroll
                    for (int i = 0; i < 4; i += 2) {
                        const f32x2 g2 = (f32x2){gv[i], gv[i + 1]}, u2 = (f32x2){uv[i], uv[i + 1]}; const f32x2 t2 = g2 * c1;
                        f32x2 e2; e2.x = __builtin_amdgcn_exp2f(t2.x); e2.y = __builtin_amdgcn_exp2f(t2.y);
                        const f32x2 d2 = e2 * ms + ms; f32x2 s2; s2.x = __builtin_amdgcn_rcpf(d2.x); s2.y = __builtin_amdgcn_rcpf(d2.y);
                        const f32x2 h2 = (g2 * u2) * s2; hv[4 * n + i] = h2.x; hv[4 * n + i + 1] = h2.y; } }
                u32x4 w; w.x = cvt_pk_bf16(hv[0], hv[1]); w.y = cvt_pk_bf16(hv[2], hv[3]); w.z = cvt_pk_bf16(hv[4], hv[5]); w.w = cvt_pk_bf16(hv[6], hv[7]);
                *(u32x4*)(H + (size_t)(row0 + ai * HALF + m * 16) * ldh + col0) = w; }
    }
};
struct EpiQKV {
    static constexpr bool PERM = true, AFTER_DRAIN = false;
    const float* ssq; const float* gq; const float* gk;
    bf16_t* QP; size_t pstride;
    bf16_t* QS; bf16_t* KS; size_t sstride; int srows, lc;
    float* okp; size_t opstride; float* oks; size_t osstride;
    int fox;
    PG8_LAS float* red;
    __device__ __forceinline__ void operator()(const f32x4 (&acc)[2][2][4][2], const Unit& u, int wr, int wc, int fr_, int fq_) const {
        int fr = fr_, fq = fq_; asm volatile("" : "+v"(fr), "+v"(fq));
        const int which = u.pn >> 3, head0 = (u.pn & 7) * 2;
        const int lane_ = fq_ * 16 + fr_, r2 = lane_ >> 2, c2 = lane_ & 3, pidx = rowmajor_pidx(lane_);
        float rsv[2][4]; rows_rstd_rm(rsv, ssq, u.pm, wr, r2, c2);
        if (which < 2) {
#pragma unroll
            for (int ai = 0; ai < 2; ++ai)
#pragma unroll
                for (int m = 0; m < 4; ++m)
#pragma unroll
                    for (int bj = 0; bj < 2; ++bj) { float s = 0.f;
#pragma unroll
                        for (int n = 0; n < 2; ++n) { const f32x4 x = acc[ai][bj][m][n]; s += (x[0] * x[0] + x[1] * x[1]) + (x[2] * x[2] + x[3] * x[3]); }
                        s += __shfl_xor(s, 16); s += __shfl_xor(s, 32);
                        if (fq == 0) red[(wc * 256 + ai * HALF + wr * 64 + m * 16 + fr) * 2 + bj] = s; }
            asm volatile("s_waitcnt lgkmcnt(0)" ::: "memory"); __builtin_amdgcn_s_barrier(); asm volatile("" ::: "memory");
        }
        const int cih = wc * 32 + 8 * c2;
        f32x4 g0 = (f32x4){1.f, 1.f, 1.f, 1.f}, g1 = g0;
        if (which < 2) { const float* g = (which == 0 ? gq : gk) + cih; g0 = *(const f32x4*)g; g1 = *(const f32x4*)(g + 4); }
        const bool samp = u.pm >= 64;
        const bool f32out = which > 0 && (samp || fox || (u.pm & 31) >= 30);
        char* b16; char* b32 = nullptr; unsigned hs16, rowsz = 0;
        if (!samp) { const int bb = u.pm >> 5;
            b16 = (char*)(QP + (size_t)which * pstride + (size_t)(bb * 16 + head0) * (8192 * 128)); hs16 = 8192 * 128 * 2;
            if (f32out) b32 = (char*)(okp + (size_t)(which - 1) * opstride + (fox ? (size_t)bb * 8192 * 2048 : (size_t)bb * 512 * 2048) + head0 * 128);
        } else { rowsz = (which == 0) ? 16u : (unsigned)srows;
            b16 = (which == 0) ? (char*)QS : (char*)(KS + (size_t)(which == 2 ? 1 : 0) * sstride + (size_t)lc * 128); hs16 = rowsz * 256u;
            if (f32out) b32 = (char*)(oks + (size_t)(which - 1) * osstride + head0 * 128); }
        const int trow0 = samp ? 0 : ((u.pm & 31) * 256 - ((fox || !f32out) ? 0 : 7680));
#pragma unroll
        for (int ai = 0; ai < 2; ++ai)
#pragma unroll
            for (int m = 0; m < 4; ++m) { const int rit = ai * HALF + wr * 64 + m * 16 + r2;
                const float rs = rsv[ai][m];
                unsigned o16;
                if (!samp) o16 = (unsigned)((((u.pm & 31) * 256 + rit) * 128 + cih) * 2);
                else o16 = (unsigned)(((((rit >> 4) * 16 + head0) * rowsz + (rit & 15)) * 128 + cih) * 2);
                const unsigned o32 = (unsigned)(((trow0 + rit) * 2048 + cih) * 4);
#pragma unroll
                for (int bj = 0; bj < 2; ++bj) { float sc = rs;
                    if (which < 2) { const int ri = rit * 2 + bj; const float t = (red[ri] + red[512 + ri]) + (red[1024 + ri] + red[1536 + ri]);
                        sc = rs * __builtin_amdgcn_rsqf(t * rs * rs * (1.0f / 128.0f) + 1e-6f); }
                    const f32x4 x0 = to_rowmajor(acc[ai][bj][m][0], pidx) * sc * g0, x1 = to_rowmajor(acc[ai][bj][m][1], pidx) * sc * g1;
                    u32x4 w; w.x = cvt_pk_bf16(x0[0], x0[1]); w.y = cvt_pk_bf16(x0[2], x0[3]); w.z = cvt_pk_bf16(x1[0], x1[1]); w.w = cvt_pk_bf16(x1[2], x1[3]);
                    *(u32x4*)(b16 + (size_t)(o16 + (unsigned)bj * hs16)) = w;
                    if (f32out) { float* fo = (float*)(b32 + (size_t)(o32 + (unsigned)bj * 512u)); __builtin_nontemporal_store(x0, (f32x4*)fo); __builtin_nontemporal_store(x1, (f32x4*)(fo + 4)); } }
                asm volatile("" ::: "memory"); }
    }
};
}

namespace sk {
typedef short bf16x8 __attribute__((ext_vector_type(8)));
typedef float f32x4 __attribute__((ext_vector_type(4)));
typedef unsigned u32x2 __attribute__((ext_vector_type(2)));
typedef unsigned u32x4 __attribute__((ext_vector_type(4)));
typedef unsigned short bf16_t;
#define SLAS __attribute__((address_space(3)))
__device__ __forceinline__ unsigned cvtpk(float lo, float hi) { unsigned r; asm volatile("v_cvt_pk_bf16_f32 %0, %1, %2" : "=v"(r) : "v"(lo), "v"(hi)); return r; }
__device__ __forceinline__ float row_rstd(const float* ssq, int row, int fq) {
    const f32x4 a = *(const f32x4*)(ssq + (size_t)row * 32 + fq * 8), b = *(const f32x4*)(ssq + (size_t)row * 32 + fq * 8 + 4);
    float s = ((a[0] + a[1]) + (a[2] + a[3])) + ((b[0] + b[1]) + (b[2] + b[3]));
    s += __shfl_xor(s, 16); s += __shfl_xor(s, 32);
    return __builtin_amdgcn_rsqf(s * (1.0f / 2048.0f) + 1e-6f);
}
struct SkResid {
    static constexpr int MB = 2, NB = 2, NS = 6; static constexpr bool NEEDS_X = true;
    const float* xin; float* X; bf16_t* XB; float* ssq;
    __device__ __forceinline__ int brow(int ct, int ch, int n) const { return ct * 64 + ch * 32 + 16 * n; }
    __device__ __forceinline__ void partial(f32x4 (&acc)[MB][NB], int rt, int ct, int ch, int fr, int fq, SLAS float* red) const {
        f32x4 xo[MB][NB];
#pragma unroll
        for (int m = 0; m < MB; ++m)
#pragma unroll
            for (int n = 0; n < NB; ++n) xo[m][n] = *(const f32x4*)(xin + (size_t)(rt * 32 + 16 * m + fr) * 2048 + ct * 64 + ch * 32 + 16 * n + 4 * fq);
#pragma unroll
        for (int m = 0; m < MB; ++m) { float s = 0.f;
#pragma unroll
            for (int n = 0; n < NB; ++n) { const f32x4 x = xo[m][n] + acc[m][n]; acc[m][n] = x; s += (x[0] * x[0] + x[1] * x[1]) + (x[2] * x[2] + x[3] * x[3]); }
            s += __shfl_xor(s, 16); s += __shfl_xor(s, 32);
            if (fq == 0) red[ch * 32 + 16 * m + fr] = s; }
    }
    __device__ __forceinline__ void operator()(const f32x4 (&acc)[MB][NB], int rt, int ct, int ch, int fr, int fq, SLAS float* red) const {
#pragma unroll
        for (int m = 0; m < MB; ++m) { const int r = rt * 32 + 16 * m + fr; const size_t off = (size_t)r * 2048 + ct * 64 + ch * 32 + 4 * fq;
#pragma unroll
            for (int n = 0; n < NB; ++n) { const f32x4 x = acc[m][n];
                *(f32x4*)(X + off + 16 * n) = x; u32x2 w; w.x = cvtpk(x[0], x[1]); w.y = cvtpk(x[2], x[3]); *(u32x2*)(XB + off + 16 * n) = w; }
            if (ch == 0 && fq == 0) ssq[(size_t)r * 32 + ct] = red[16 * m + fr] + red[32 + 16 * m + fr]; }
    }
};
struct SkSwiglu {
    static constexpr int MB = 4, NB = 4, NS = 3; static constexpr bool NEEDS_X = false;
    bf16_t* H; int ldh; const float* ssq;
    __device__ __forceinline__ int brow(int ct, int ch, int n) const { return 256 * (ct >> 1) + (ct & 1) * 64 + ch * 32 + (n >= 2 ? 128 + 16 * (n - 2) : 16 * n); }
    __device__ __forceinline__ void partial(f32x4 (&acc)[MB][NB], int, int, int, int, int, SLAS float*) const {}
    __device__ __forceinline__ void operator()(const f32x4 (&acc)[MB][NB], int rt, int ct, int ch, int fr, int fq, SLAS float* red) const {
        float rs[MB];
        { f32x4 pa[MB], pb[MB];
#pragma unroll
          for (int m = 0; m < MB; ++m) { const float* sp = ssq + (size_t)(rt * 64 + 16 * m + fr) * 32 + fq * 8; pa[m] = *(const f32x4*)sp; pb[m] = *(const f32x4*)(sp + 4); }
#pragma unroll
          for (int m = 0; m < MB; ++m) { float s = ((pa[m][0] + pa[m][1]) + (pa[m][2] + pa[m][3])) + ((pb[m][0] + pb[m][1]) + (pb[m][2] + pb[m][3]));
              s += __shfl_xor(s, 16); s += __shfl_xor(s, 32); rs[m] = __builtin_amdgcn_rsqf(s * (1.0f / 2048.0f) + 1e-6f); } }
#pragma unroll
        for (int m = 0; m < MB; ++m) { const int r = rt * 64 + 16 * m + fr;
#pragma unroll
            for (int n = 0; n < 2; ++n) { float hv[4];
#pragma unroll
                for (int i = 0; i < 4; ++i) { const float g = acc[m][n][i] * rs[m], up = acc[m][n + 2][i] * rs[m]; hv[i] = g * __builtin_amdgcn_rcpf(1.0f + __expf(-g)) * up; }
                u32x2 w; w.x = cvtpk(hv[0], hv[1]); w.y = cvtpk(hv[2], hv[3]);
                *(u32x2*)(H + (size_t)r * ldh + 128 * (ct >> 1) + (ct & 1) * 64 + ch * 32 + 16 * n + 4 * fq) = w; } }
    }
};
struct SkQKV {
    static constexpr int MB = 4, NB = 4, NS = 3; static constexpr bool NEEDS_X = true;
    const float* ssq; const float* gq; const float* gk;
    bf16_t* QS; bf16_t* KS; size_t sstride; int srows, lc;
    float* oks; size_t osstride;
    __device__ __forceinline__ int brow(int ct, int ch, int n) const { return ct * 128 + ch * 64 + 16 * n; }
    __device__ __forceinline__ void partial(f32x4 (&acc)[MB][NB], int, int, int ch, int fr, int fq, SLAS float* red) const {
#pragma unroll
        for (int m = 0; m < MB; ++m) { float s = 0.f;
#pragma unroll
            for (int n = 0; n < NB; ++n) { const f32x4 x = acc[m][n]; s += (x[0] * x[0] + x[1] * x[1]) + (x[2] * x[2] + x[3] * x[3]); }
            s += __shfl_xor(s, 16); s += __shfl_xor(s, 32);
            if (fq == 0) red[ch * 64 + 16 * m + fr] = s; }
    }
    __device__ __forceinline__ void operator()(const f32x4 (&acc)[MB][NB], int rt, int ct, int ch, int fr, int fq, SLAS float* red) const {
        const int which = ct >> 4, h = ct & 15;
        const float* g = (which == 0 ? gq : gk) + ch * 64 + 4 * fq;
        bf16_t* b16 = (which == 0) ? QS : KS + (size_t)(which == 2 ? 1 : 0) * sstride + (size_t)lc * 128; const int rowsz = (which == 0) ? 16 : srows;
        float* b32 = oks + (size_t)(which > 0 ? which - 1 : 0) * osstride + h * 128 + ch * 64 + 4 * fq;
        float rs[MB];
        { f32x4 pa[MB], pb[MB];
#pragma unroll
          for (int m = 0; m < MB; ++m) { const float* sp = ssq + (size_t)(rt * 64 + 16 * m + fr) * 32 + fq * 8; pa[m] = *(const f32x4*)sp; pb[m] = *(const f32x4*)(sp + 4); }
#pragma unroll
          for (int m = 0; m < MB; ++m) { float s = ((pa[m][0] + pa[m][1]) + (pa[m][2] + pa[m][3])) + ((pb[m][0] + pb[m][1]) + (pb[m][2] + pb[m][3]));
              s += __shfl_xor(s, 16); s += __shfl_xor(s, 32); rs[m] = __builtin_amdgcn_rsqf(s * (1.0f / 2048.0f) + 1e-6f); } }
#pragma unroll
        for (int m = 0; m < MB; ++m) { const int r = rt * 64 + 16 * m + fr; float sc = rs[m];
            if (which < 2) { const float s = red[16 * m + fr] + red[64 + 16 * m + fr]; sc = rs[m] * __builtin_amdgcn_rsqf(s * rs[m] * rs[m] * (1.0f / 128.0f) + 1e-6f); }
            bf16_t* d16 = b16 + ((size_t)((r >> 4) * 16 + h) * rowsz + (r & 15)) * 128 + ch * 64 + 4 * fq; float* d32 = b32 + (size_t)r * 2048;
#pragma unroll
            for (int n = 0; n < NB; ++n) { f32x4 x = acc[m][n] * sc; if (which < 2) x = x * *(const f32x4*)(g + 16 * n);
                u32x2 w; w.x = cvtpk(x[0], x[1]); w.y = cvtpk(x[2], x[3]); *(u32x2*)(d16 + 16 * n) = w;
                if (which > 0) *(f32x4*)(d32 + 16 * n) = x; } }
    }
};
template <class Epi>
__device__ __forceinline__ void skinny_phase(SLAS unsigned char* lds, const bf16_t* A, const bf16_t* Bt, int nct, int K, unsigned* qc  , int tid, const Epi& E) {
    constexpr int MB = Epi::MB, NB = Epi::NB, NS = Epi::NS, NRT = 16 / MB, SLOT = MB * NB * 1024;
    const int lane = tid & 63, wid = __builtin_amdgcn_readfirstlane(tid >> 6), fr = lane & 15, fq = lane >> 4, kq = wid & 3, ch = wid >> 2;
    const int kw = K >> 2;
    SLAS float* red = (SLAS float*)(lds + 4 * SLOT);
    for (;;) {
        volatile SLAS int* tw = (volatile SLAS int*)(lds + 67712);
        if (tid == 0) *tw = (int)__hip_atomic_fetch_add(qc, 1u, __ATOMIC_RELAXED, __HIP_MEMORY_SCOPE_AGENT);
        __syncthreads();
        const int tile = __builtin_amdgcn_readfirstlane(*tw);
        if (tile >= NRT * nct) break;
        const int rt = tile % NRT, ct = tile / NRT;
        f32x4 acc[MB][NB];
#pragma unroll
        for (int m = 0; m < MB; ++m)
#pragma unroll
            for (int n = 0; n < NB; ++n) acc[m][n] = (f32x4){0.f, 0.f, 0.f, 0.f};
        const unsigned lo = (unsigned)(((lane >> 2) * K + kq * kw + (lane & 3) * 8) * 2);
        const int pidx = (((lane & 15) << 2) | (lane >> 4)) << 2;
        const char* ab = (const char*)(A + (size_t)(rt * 16 * MB) * K);
        const char* bb[NB];
#pragma unroll
        for (int n = 0; n < NB; ++n) bb[n] = (const char*)(Bt + (size_t)E.brow(ct, ch, n) * K);
        bf16x8 fa[NS][MB], fb[NS][NB];
#define SK_LOAD(st, ks) do { const unsigned o_ = lo + (unsigned)((ks) * 2); _Pragma("unroll") for (int m = 0; m < MB; ++m) fa[st][m] = *(const bf16x8*)(ab + (size_t)(o_ + (unsigned)(16 * m * K * 2))); \
            _Pragma("unroll") for (int n = 0; n < NB; ++n) fb[st][n] = *(const bf16x8*)(bb[n] + (size_t)o_); } while (0)
#define SK_PERM(v) do { u32x4 w_ = __builtin_bit_cast(u32x4, v); w_.x = (unsigned)__builtin_amdgcn_ds_bpermute(pidx, (int)w_.x); w_.y = (unsigned)__builtin_amdgcn_ds_bpermute(pidx, (int)w_.y); \
            w_.z = (unsigned)__builtin_amdgcn_ds_bpermute(pidx, (int)w_.z); w_.w = (unsigned)__builtin_amdgcn_ds_bpermute(pidx, (int)w_.w); v = __builtin_bit_cast(bf16x8, w_); } while (0)
#define SK_MMA(st) do { _Pragma("unroll") for (int m = 0; m < MB; ++m) SK_PERM(fa[st][m]); _Pragma("unroll") for (int n = 0; n < NB; ++n) SK_PERM(fb[st][n]); \
            _Pragma("unroll") for (int m = 0; m < MB; ++m) _Pragma("unroll") for (int n = 0; n < NB; ++n) acc[m][n] = __builtin_amdgcn_mfma_f32_16x16x32_bf16(fb[st][n], fa[st][m], acc[m][n], 0, 0, 0); } while (0)
#define SK_SB() __builtin_amdgcn_sched_barrier(0)
        const int nst = kw >> 5, kl = kw - 32;
#pragma unroll
        for (int j = 0; j < NS - 1; ++j) { SK_LOAD(j, (j * 32 < kw ? j * 32 : kl)); SK_SB(); }
        for (int s0 = 0; s0 < nst; s0 += NS) {
#pragma unroll
            for (int j = 0; j < NS; ++j) { const int kn = (s0 + j + NS - 1) * 32; SK_LOAD((j + NS - 1) % NS, kn < kw ? kn : kl); SK_SB(); if (s0 + j < nst) SK_MMA(j); SK_SB(); }
        }
#undef SK_SB
#undef SK_LOAD
#undef SK_MMA
#undef SK_PERM
#pragma unroll
        for (int half = 2; half >= 1; half >>= 1) {
            if (kq >= half && kq < 2 * half) { SLAS f32x4* s = (SLAS f32x4*)(lds + (ch * 2 + kq - half) * SLOT) + lane;
#pragma unroll
                for (int m = 0; m < MB; ++m)
#pragma unroll
                    for (int n = 0; n < NB; ++n) s[(m * NB + n) * 64] = acc[m][n]; }
            __syncthreads();
            if (kq < half) { const SLAS f32x4* s = (const SLAS f32x4*)(lds + (ch * 2 + kq) * SLOT) + lane;
#pragma unroll
                for (int m = 0; m < MB; ++m)
#pragma unroll
                    for (int n = 0; n < NB; ++n) acc[m][n] = acc[m][n] + s[(m * NB + n) * 64]; }
            __syncthreads();
        }
        if constexpr (Epi::NEEDS_X) { if (kq == 0) E.partial(acc, rt, ct, ch, fr, fq, red); __syncthreads(); }
        if (kq == 0) E(acc, rt, ct, ch, fr, fq, red);
        if constexpr (Epi::NEEDS_X) __syncthreads();
    }
}
}

namespace att {
typedef short bf16x8 __attribute__((ext_vector_type(8)));
typedef short s16x4 __attribute__((ext_vector_type(4)));
typedef float f32x16 __attribute__((ext_vector_type(16)));
typedef float f32x4 __attribute__((ext_vector_type(4)));
typedef unsigned u32x4 __attribute__((ext_vector_type(4)));
typedef unsigned short bf16;
#define ALAS __attribute__((address_space(3)))
constexpr int D = 128, NW = 8, QBLK = 32, KVBLK = 64, QB = NW * QBLK;
constexpr int SHM_V = KVBLK * D * 2, SHM_K = KVBLK * D * 2;
constexpr int OFF_V = 0, OFF_K = 2 * SHM_V, OFF_WS = 2 * SHM_V + 2 * SHM_K, OFF_TAB = OFF_WS + NW * 64 * 4, OFF_BIAS = OFF_TAB + 1024, LDS_END = OFF_BIAS + 8192 * 4 + 512;
constexpr float SCALE = 0.08838834764831845f, RSCALE = 11.313708498984761f;
constexpr float THR = 8.f;
#define KSWZ(row, colB) ((row) * 256 + ((colB) ^ (((row) & 7) << 4)))
#define SBAR() __builtin_amdgcn_sched_barrier(0)
__device__ __forceinline__ int v_st(int k, int c) { const int kk = (k & ~0xC) | ((k & 4) << 1) | ((k & 8) >> 1); return ((kk >> 3) * 4 + (c >> 5)) * 512 + ((kk & 7) * 32 + (c & 31)) * 2; }
__device__ __forceinline__ int v_rd_base(int lane) { return ((lane & 3) << 3) | (((lane >> 2) & 3) << 6) | (((lane >> 4) & 1) << 5) | (((lane >> 5) & 1) << 8); }
constexpr int v_rd_off(int d0, int ks, int half) { return d0 * 512 + ks * 4096 + half * 2048; }
__device__ __forceinline__ int crow(int r, int hi) { return (r & 3) + 8 * (r >> 2) + 4 * hi; }
__device__ __forceinline__ unsigned cvtpk(float lo, float hi) { unsigned r; asm volatile("v_cvt_pk_bf16_f32 %0, %1, %2" : "=v"(r) : "v"(lo), "v"(hi)); return r; }
__device__ __forceinline__ bf16x8 load8(const bf16* p) { return *reinterpret_cast<const bf16x8*>(p); }
__device__ __forceinline__ void mask_tile(f32x16& p0, f32x16& p1, int dq) {
    const float NEG = -__builtin_inff();
#pragma unroll
    for (int r = 0; r < 16; ++r) {
        const int c = (r & 3) + 8 * (r >> 2);
        if (dq - c < 0) p0[r] = NEG;
        if (dq - c - 32 < 0) p1[r] = NEG;
    }
}
__device__ __forceinline__ void partialSM(f32x16& p0, f32x16& p1, float& m_reg, float& mn, float& alpha) {
    float pmax = p0[0]; for (int r = 1; r < 16; ++r) pmax = fmaxf(pmax, p0[r]); for (int r = 0; r < 16; ++r) pmax = fmaxf(pmax, p1[r]);
    { auto rr = __builtin_amdgcn_permlane32_swap(__float_as_uint(pmax), __float_as_uint(pmax), false, false);
      pmax = fmaxf(__uint_as_float(rr[0]), __uint_as_float(rr[1])); }
    constexpr float C2 = 1.4426950408889634f * SCALE;
    if (__builtin_expect(__all((pmax - m_reg) * SCALE <= THR), 1)) { mn = m_reg; alpha = 1.f; }
    else { mn = fmaxf(m_reg, pmax); alpha = __builtin_amdgcn_exp2f((m_reg - mn) * C2); m_reg = mn; }
    const float mnL = -mn * C2;
    for (int r = 0; r < 16; ++r) p0[r] = fmaf(p0[r], C2, mnL); for (int r = 0; r < 16; ++r) p1[r] = fmaf(p1[r], C2, mnL);
    for (int r = 0; r < 16; ++r) p0[r] = __builtin_amdgcn_exp2f(p0[r]);
}
__device__ __forceinline__ void finishSM(f32x16& p0, f32x16& p1, float alpha, float& l_reg, bf16x8& pa0, bf16x8& pa1, bf16x8& pa2, bf16x8& pa3) {
    for (int r = 0; r < 16; ++r) p1[r] = __builtin_amdgcn_exp2f(p1[r]);
    float ps = 0; for (int r = 0; r < 16; ++r) ps += p0[r]; for (int r = 0; r < 16; ++r) ps += p1[r];
    { auto rr = __builtin_amdgcn_permlane32_swap(__float_as_uint(ps), __float_as_uint(ps), false, false);
      ps = __uint_as_float(rr[0]) + __uint_as_float(rr[1]); }
    l_reg = l_reg * alpha + ps;
#define PK4(P, B_, OUT) do { unsigned a0 = cvtpk(P[B_+0], P[B_+1]), a1 = cvtpk(P[B_+2], P[B_+3]);                          \
        unsigned b0 = cvtpk(P[B_+4], P[B_+5]), b1 = cvtpk(P[B_+6], P[B_+7]);                                             \
        auto r0 = __builtin_amdgcn_permlane32_swap(a0, b0, false, false); auto r1 = __builtin_amdgcn_permlane32_swap(a1, b1, false, false); \
        u32x4 w = {r0[0], r1[0], r0[1], r1[1]}; OUT = *reinterpret_cast<bf16x8*>(&w); } while (0)
    PK4(p0, 0, pa0); PK4(p0, 8, pa1); PK4(p1, 0, pa2); PK4(p1, 8, pa3);
#undef PK4
}
struct Blk {
    const bf16* Q; const bf16* K; const bf16* V; bf16* O;
    const float* aux;
    int P0;
    int jlo, jhi;
    int cap;
    int c0;
    float skipthr;
};
struct Nxt { const bf16* Q; const bf16* K; const bf16* V; int jlo; };
constexpr int OSTR = 2048;
struct Seam { bf16x8 qr[8]; bf16x8 st_v0, st_v1, st_k0, st_k1; };

template <int MODE, int KB>
__device__ __forceinline__ void qkt(f32x16& p0, f32x16& p1, ALAS const char* lds, int r32, int hi, const bf16x8* qr, bool act, int tile  , int dist  , int irow  ) {
    if (!act) { const float NEG = -__builtin_inff();
#pragma unroll
        for (int r = 0; r < 16; ++r) { p0[r] = NEG; p1[r] = NEG; } return; }
    if constexpr (MODE == 1) {
        ALAS const float* bp = (ALAS const float*)(lds + OFF_BIAS) + tile * 64 + 4 * hi;
#pragma unroll
        for (int i = 0; i < 4; ++i) { const f32x4 a = *(ALAS const f32x4*)(bp + 8 * i), b = *(ALAS const f32x4*)(bp + 32 + 8 * i);
            p0[4 * i] = a[0]; p0[4 * i + 1] = a[1]; p0[4 * i + 2] = a[2]; p0[4 * i + 3] = a[3]; p1[4 * i] = b[0]; p1[4 * i + 1] = b[1]; p1[4 * i + 2] = b[2]; p1[4 * i + 3] = b[3]; }
    } else {
        ALAS const float* R = (ALAS const float*)(lds + OFF_TAB);
        if (dist <= 2) { ALAS const float* rp = R + (191 - 64 * dist - irow + 4 * hi);
#pragma unroll
            for (int r = 0; r < 16; ++r) { p0[r] = rp[(r & 3) + 8 * (r >> 2)]; p1[r] = rp[32 + (r & 3) + 8 * (r >> 2)]; } }
        else { const float cf = R[0];
#pragma unroll
            for (int r = 0; r < 16; ++r) { p0[r] = cf; p1[r] = cf; } }
    }
    ALAS const char* K_lds = lds + OFF_K;
    ALAS const char* kb[4];
#pragma unroll
    for (int dd = 0; dd < 4; ++dd) kb[dd] = K_lds + KB * SHM_K + KSWZ(r32, (dd * 16 + hi * 8) * 2);
#pragma unroll
    for (int d0 = 0; d0 < 8; ++d0) { ALAS const char* a = kb[d0 & 3] + (d0 >> 2) * 128;
        bf16x8 b0 = *reinterpret_cast<ALAS const bf16x8*>(a);
        bf16x8 b1 = *reinterpret_cast<ALAS const bf16x8*>(a + 32 * 256);
        p0 = __builtin_amdgcn_mfma_f32_32x32x16_bf16(b0, qr[d0], p0, 0, 0, 0);
        p1 = __builtin_amdgcn_mfma_f32_32x32x16_bf16(b1, qr[d0], p1, 0, 0, 0); }
}
template <int MODE, int VB>
__device__ __forceinline__ void pv_tile(f32x16* o, int vb0, bf16x8 pa0, bf16x8 pa1, bf16x8 pa2, bf16x8 pa3, bool act) {
    if (!act) return;
#define TRRD(dst, off) asm volatile("ds_read_b64_tr_b16 %0, %1 offset:%2" : "=&v"(dst) : "v"(vb0), "i"(off) : "memory")
#define PV_D0(d0) do { s16x4 l0, l1, l2, l3, h0, h1, h2, h3; constexpr int b_ = VB * SHM_V + v_rd_off(d0, 0, 0); \
        TRRD(l0, b_); TRRD(h0, b_ + 2048); TRRD(l1, b_ + 4096); TRRD(h1, b_ + 6144); TRRD(l2, b_ + 8192); TRRD(h2, b_ + 10240); TRRD(l3, b_ + 12288); TRRD(h3, b_ + 14336); \
        asm volatile("s_waitcnt lgkmcnt(0)" ::: "memory"); SBAR();   \
        o[d0] = __builtin_amdgcn_mfma_f32_32x32x16_bf16(pa0, (bf16x8){l0[0], l0[1], l0[2], l0[3], h0[0], h0[1], h0[2], h0[3]}, o[d0], 0, 0, 0);   \
        o[d0] = __builtin_amdgcn_mfma_f32_32x32x16_bf16(pa1, (bf16x8){l1[0], l1[1], l1[2], l1[3], h1[0], h1[1], h1[2], h1[3]}, o[d0], 0, 0, 0);   \
        o[d0] = __builtin_amdgcn_mfma_f32_32x32x16_bf16(pa2, (bf16x8){l2[0], l2[1], l2[2], l2[3], h2[0], h2[1], h2[2], h2[3]}, o[d0], 0, 0, 0);   \
        o[d0] = __builtin_amdgcn_mfma_f32_32x32x16_bf16(pa3, (bf16x8){l3[0], l3[1], l3[2], l3[3], h3[0], h3[1], h3[2], h3[3]}, o[d0], 0, 0, 0); } while (0)
    PV_D0(0); PV_D0(1); PV_D0(2); PV_D0(3);
#undef PV_D0
#undef TRRD
}
#define AROW(p, k0, rr) ((const bf16*)((const char*)(p) + (size_t)(unsigned)(((k0) + (rr)) * (D * 2) + sc * 2)))
#define VMW() asm volatile("s_waitcnt vmcnt(0)" ::: "memory")
#define VMWN(n) asm volatile("s_waitcnt vmcnt(%0)" :: "i"(n) : "memory")
#define SLOAD_H(Kp, Vp, k0) do { S.st_v0 = load8(AROW(Vp, k0, sr)); S.st_v1 = load8(AROW(Vp, k0, 32 + sr));              \
                         S.st_k0 = load8(AROW(Kp, k0, sr)); S.st_k1 = load8(AROW(Kp, k0, 32 + sr)); } while (0)
#define SWRITE_HK(bf) do { *(ALAS bf16x8*)(K_lds + (bf) * SHM_K + kws) = S.st_k0; *(ALAS bf16x8*)(K_lds + (bf) * SHM_K + kws + 32 * 256) = S.st_k1; } while (0)
#define SWRITE_HV(bf) do { *(ALAS bf16x8*)(V_lds + (bf) * SHM_V + vst0) = S.st_v0; *(ALAS bf16x8*)(V_lds + (bf) * SHM_V + vst1) = S.st_v1; } while (0)
#define SWRITE_H(bf) do { SWRITE_HV(bf); SWRITE_HK(bf); } while (0)
template <int MODE>
__device__ __forceinline__ float build_bias(const Blk& b, ALAS char* lds, int tid) {
    asm volatile("" : "+v"(tid));
    if constexpr (MODE == 0) {
        if (tid < 256) { int d = 191 - tid; d = d < -128 ? -128 : (d > 128 ? 128 : d); ((ALAS float*)(lds + OFF_TAB))[tid] = b.aux[d + 128] * RSCALE; }
        return 0.f;
    } else {
        const int nk = b.jhi * 64, nv = b.cap + 1, e0 = tid * 16, lane = tid & 63, wid = tid >> 6;
        float v[16];
#pragma unroll
        for (int i = 0; i < 4; ++i) { f32x4 x = (f32x4){0.f, 0.f, 0.f, 0.f};
            if (e0 + 4 * i < nv) x = *(const f32x4*)(b.aux + e0 + 4 * i);
            v[4 * i] = x[0]; v[4 * i + 1] = x[1]; v[4 * i + 2] = x[2]; v[4 * i + 3] = x[3]; }
        float run = 0.f;
#pragma unroll
        for (int i = 15; i >= 0; --i) { const float x = v[i]; v[i] = run; run += x; }
        float incl = run;
#pragma unroll
        for (int o = 1; o < 64; o <<= 1) { const float t = __int_as_float(__builtin_amdgcn_ds_bpermute(((lane + o) & 63) << 2, __float_as_int(incl))); if (lane + o < 64) incl += t; }
        ALAS float* wt = (ALAS float*)(lds + OFF_TAB);
        if (lane == 0) wt[wid] = incl;
        asm volatile("s_waitcnt lgkmcnt(0)" ::: "memory"); __builtin_amdgcn_s_barrier(); asm volatile("" ::: "memory");
        float after = incl - run;
#pragma unroll
        for (int w = 1; w < 8; ++w) { const float t = wt[w]; if (w > wid) after += t; }
        if (e0 < nk) { ALAS f32x4* o4 = (ALAS f32x4*)(lds + OFF_BIAS) + tid * 4;
#pragma unroll
            for (int i = 0; i < 4; ++i) o4[i] = (f32x4){(v[4 * i] + after) * RSCALE, (v[4 * i + 1] + after) * RSCALE, (v[4 * i + 2] + after) * RSCALE, (v[4 * i + 3] + after) * RSCALE}; }
        return after;
    }
}
template <int MODE>
__device__ __forceinline__ void attn_prime(const Blk& cur, ALAS char* lds, Seam& S, int tid) {
    asm volatile("" : "+v"(tid));
    const int wid = __builtin_amdgcn_readfirstlane(tid >> 6), lane = tid & 63, r32 = lane & 31, hi = lane >> 5;
    const int sr = tid >> 4, sc = (tid & 15) * 8, kws = KSWZ(sr, sc * 2); ALAS char* K_lds = lds + OFF_K;
    const int kb0 = cur.jlo * KVBLK;
    const int qrow = wid * QBLK + r32;
#pragma unroll
    for (int d0 = 0; d0 < 8; ++d0) S.qr[d0] = load8((const bf16*)((const char*)cur.Q + (size_t)(unsigned)(qrow * (D * 2) + hi * 16 + d0 * 32)));
    SLOAD_H(cur.K, cur.V, kb0); VMW(); SWRITE_HK(0);
    __syncthreads();
}
template <int MODE, class IssueFn, class NextFn>
__device__ __forceinline__ void attn_block(const Blk& cur, IssueFn&& issue_fn, NextFn&& next_fn, ALAS char* lds, Seam& S, int tid) {
    asm volatile("" : "+v"(tid));
    const int wid = __builtin_amdgcn_readfirstlane(tid >> 6), lane = tid & 63, r32 = lane & 31, hi = lane >> 5;
    bf16x8 kd[8];
    if constexpr (MODE == 1) { const char* kp = (const char*)cur.K + (size_t)(unsigned)((cur.P0 + wid * QBLK + r32) * (D * 2) + hi * 16);
#pragma unroll
        for (int d0 = 0; d0 < 8; ++d0) kd[d0] = load8((const bf16*)(kp + d0 * 32)); }
    const float s_end = build_bias<MODE>(cur, lds, tid);
    asm volatile("s_waitcnt lgkmcnt(0)" ::: "memory"); __syncthreads();
    int j_lo = cur.jlo;
    const int sr = tid >> 4, sc = (tid & 15) * 8, vst0 = v_st(sr, sc), vst1 = v_st(32 + sr, sc), kws = KSWZ(sr, sc * 2);
    ALAS char* V_lds = lds + OFF_V; ALAS char* K_lds = lds + OFF_K;
    if constexpr (MODE == 1) {
        float dsum = 0.f;
#pragma unroll
        for (int d0 = 0; d0 < 8; ++d0) { const u32x4 qa = *reinterpret_cast<const u32x4*>(&S.qr[d0]), ka = *reinterpret_cast<const u32x4*>(&kd[d0]);
#pragma unroll
            for (int i = 0; i < 4; ++i) { dsum = fmaf(__uint_as_float(qa[i] << 16), __uint_as_float(ka[i] << 16), dsum);
                dsum = fmaf(__uint_as_float(qa[i] & 0xffff0000u), __uint_as_float(ka[i] & 0xffff0000u), dsum); } }
        { auto rr = __builtin_amdgcn_permlane32_swap(__float_as_uint(dsum), __float_as_uint(dsum), false, false); dsum = __uint_as_float(rr[0]) + __uint_as_float(rr[1]); }
        float gv = (((ALAS const float*)(lds + OFF_BIAS))[cur.P0 + wid * QBLK + r32] + dsum) * SCALE;
#pragma unroll
        for (int o = 1; o < 32; o <<= 1) gv = fminf(gv, __shfl_xor(gv, o));
        ALAS float* wg = (ALAS float*)(lds + OFF_TAB) + 32;
        if (lane == 0) wg[wid] = gv;
        asm volatile("s_waitcnt lgkmcnt(0)" ::: "memory"); __builtin_amdgcn_s_barrier(); asm volatile("" ::: "memory");
        float G = wg[0];
#pragma unroll
        for (int w = 1; w < 8; ++w) G = fminf(G, wg[w]);
        const bool pred = ((tid & 3) == 3) && ((tid >> 2) < (cur.P0 >> 6)) && (s_end < G - cur.skipthr);
        const int cnt = __builtin_popcountll(__ballot(pred));
        ALAS int* wcnt = (ALAS int*)(lds + OFF_TAB) + 16;
        if (lane == 0) wcnt[wid] = cnt;
        asm volatile("s_waitcnt lgkmcnt(0)" ::: "memory"); __builtin_amdgcn_s_barrier(); asm volatile("" ::: "memory");
        int tot = 0;
#pragma unroll
        for (int w = 0; w < 8; ++w) tot += wcnt[w];
        j_lo = __builtin_amdgcn_readfirstlane(tot);
        if (j_lo != cur.jlo) {
            SLOAD_H(cur.K, cur.V, j_lo * KVBLK); VMW(); SWRITE_HK(0); }
        __syncthreads();
    }
    const int NT = cur.jhi - j_lo;
    const int wlim = cur.P0 + wid * QBLK;
    const int qm = wlim + r32 - 4 * hi;
    const int cw = cur.c0 + (wid >> 1);
    const int irow = (wid & 1) * 32 + r32;
    ALAS float* wsf = (ALAS float*)(lds + OFF_WS) + wid * 64; ALAS float* li_l = wsf; ALAS float* al_l = wsf + 32;
    float m_reg = -1e30f, l_reg = 0; f32x16 o[4] = {};
    const int vb0 = (int)(unsigned)(unsigned long long)V_lds + v_rd_base(lane);
    const bf16* Kh = cur.K; const bf16* Vh = cur.V;
#define RESC(a) do { if (__any((a) < 1.f)) { if (hi == 0) al_l[r32] = (a); asm volatile("s_waitcnt lgkmcnt(0)" ::: "memory");              \
                     for (int d_ = 0; d_ < 4; ++d_) for (int r = 0; r < 16; ++r) o[d_][r] *= al_l[crow(r, hi)]; } } while (0)
#define KBASE(t) ((j_lo + (t)) * KVBLK)
#define ACT(t) (MODE == 1 ? (KBASE(t) <= wlim + QBLK - 1) : ((j_lo + (t)) >= cw - 8 && (j_lo + (t)) <= cw))
#define MASKT(P0_, P1_, t) do { if (MODE == 1) { const int kb_ = KBASE(t); if (kb_ + KVBLK - 1 > wlim) mask_tile(P0_, P1_, qm - kb_); } } while (0)
#define QKT(KB, PX0, PX1, t) qkt<MODE, KB>(PX0, PX1, lds, r32, hi, S.qr, ACT(t), j_lo + (t), cw - (j_lo + (t)), irow)
    constexpr int NQL = 8;
#define SEAM_K0() do { VMWN(NQL); SWRITE_HK(0); SBAR(); } while (0)
    f32x16 pA0, pA1, pB0, pB1; float mnA, mnB, alA, alB; bf16x8 pa0, pa1, pa2, pa3;
    SWRITE_HV(0); SBAR();
    if (NT > 1) SLOAD_H(Kh, Vh, KBASE(1));
    SBAR(); QKT(0, pA0, pA1, 0);
    MASKT(pA0, pA1, 0); partialSM(pA0, pA1, m_reg, mnA, alA);
    if (NT > 1) { VMW(); SWRITE_H(1); }
    __syncthreads();
#define HALF_STEP(PX0, PX1, mnX, alX, PY0, PY1, alY, t, KB, VB, SB) do {                                                      \
        SBAR(); QKT(KB, PX0, PX1, t);                                                                                          \
        finishSM(PY0, PY1, alY, l_reg, pa0, pa1, pa2, pa3); SBAR();                                                           \
        if ((t) + 1 < NT) { SLOAD_H(Kh, Vh, KBASE((t) + 1)); SBAR(); }                                                        \
        pv_tile<MODE, VB>(o, vb0, pa0, pa1, pa2, pa3, ACT((t) - 1)); MASKT(PX0, PX1, (t)); partialSM(PX0, PX1, m_reg, mnX, alX);   \
        __syncthreads();                                                                                                      \
        if ((t) + 1 < NT) { VMW(); SWRITE_H(SB); }                                                                            \
        RESC(alX); __syncthreads(); } while (0)
    if (NT < 3) issue_fn();
    for (int t = 1; t + 1 < NT; t += 2) {
        if (t + 3 >= NT) issue_fn();
        HALF_STEP(pB0, pB1, mnB, alB, pA0, pA1, alA, t, 1, 0, 0);
        HALF_STEP(pA0, pA1, mnA, alA, pB0, pB1, alB, t + 1, 0, 1, 1);
    }
    Nxt nxt; next_fn(nxt);
    const int kbn = nxt.jlo * KVBLK;
    const bool even = (NT & 1) == 0;
    if (even) { SBAR(); QKT(1, pB0, pB1, NT - 1); SBAR(); }
    SLOAD_H(nxt.K, nxt.V, kbn); SBAR();
    { const int qrow = wid * QBLK + r32;
#pragma unroll
      for (int d0 = 0; d0 < 8; ++d0) S.qr[d0] = load8((const bf16*)((const char*)nxt.Q + (size_t)(unsigned)(qrow * (D * 2) + hi * 16 + d0 * 32))); }
    SBAR();
    finishSM(pA0, pA1, alA, l_reg, pa0, pa1, pa2, pa3); SBAR();
    pv_tile<MODE, 0>(o, vb0, pa0, pa1, pa2, pa3, ACT(even ? NT - 2 : NT - 1));
    if (even) { MASKT(pB0, pB1, NT - 1); partialSM(pB0, pB1, m_reg, mnB, alB); __syncthreads(); RESC(alB);
        finishSM(pB0, pB1, alB, l_reg, pa0, pa1, pa2, pa3); SBAR(); pv_tile<MODE, 1>(o, vb0, pa0, pa1, pa2, pa3, ACT(NT - 1)); }
    SBAR(); SEAM_K0();
    __syncthreads();
    if (hi == 0) li_l[r32] = l_reg; asm volatile("s_waitcnt lgkmcnt(0)" ::: "memory");
    float rli[16];
#pragma unroll
    for (int r = 0; r < 16; ++r) rli[r] = __builtin_amdgcn_rcpf(li_l[crow(r, hi)]);
    ALAS char* stg = lds + OFF_V + wid * 4096 + (4 * hi) * 128 + r32 * 2;
    ALAS const char* srd = lds + OFF_V + wid * 4096 + (lane >> 3) * 128 + (lane & 7) * 16;
    unsigned ooff = (unsigned)(((wid * QBLK + (lane >> 3)) * OSTR + (lane & 7) * 8) * 2);
    asm volatile("" : "+v"(ooff));
#pragma unroll
    for (int ps = 0; ps < 2; ++ps) {
#pragma unroll
        for (int dd = 0; dd < 2; ++dd)
#pragma unroll
            for (int r = 0; r < 16; r += 2) { const unsigned w = cvtpk(o[2 * ps + dd][r] * rli[r], o[2 * ps + dd][r + 1] * rli[r + 1]);
                ALAS char* a = stg + ((r & 3) + 8 * (r >> 2)) * 128 + dd * 64;
                *(ALAS unsigned short*)a = (unsigned short)w; *(ALAS unsigned short*)(a + 128) = (unsigned short)(w >> 16); }
        asm volatile("s_waitcnt lgkmcnt(0)" ::: "memory");
        u32x4 q[4];
#pragma unroll
        for (int i = 0; i < 4; ++i) q[i] = *(ALAS const u32x4*)(srd + i * 1024);
        asm volatile("s_waitcnt lgkmcnt(0)" ::: "memory");
#pragma unroll
        for (int i = 0; i < 4; ++i) *(u32x4*)((char*)cur.O + (size_t)(ooff + (unsigned)(i * 8 * OSTR * 2 + ps * 128))) = q[i];
    }
    __syncthreads();
#undef RESC
#undef KBASE
#undef ACT
#undef MASKT
#undef QKT
#undef SEAM_K0
#undef HALF_STEP
}
#undef AROW
#undef VMW
#undef VMWN
#undef SLOAD_H
#undef SWRITE_HK
#undef SWRITE_HV
#undef SWRITE_H
}

constexpr int NWAVES = 8;
constexpr int NB = 2, T = 8192, D = 2048, NH = 16, HD = 128, FF = 5632, DEPTH = 4;
constexpr int SB = 16, SN = 16, PAST = 1024, WIN = 512, NREL = 257;
constexpr int MP = NB * T, MS = SB * SN, M = MP + MS;
constexpr int NQKV = 3 * D, NGU = 2 * FF;
constexpr int LS = PAST + SN;
constexpr float EPS = 1e-6f, SCALE = 0.08838834764831845f;
constexpr size_t O_Y = 0, O_YS = (size_t)MP * D, O_AKP = O_YS + (size_t)MS * D, SZ_AP = (size_t)2 * NB * WIN * D, O_AVP = O_AKP + SZ_AP, O_BKP = O_AVP + SZ_AP,
    SZ_BP = (size_t)2 * MP * D, O_BVP = O_BKP + SZ_BP, O_BFP = O_BVP + SZ_BP, SZ_BFP = (size_t)2 * MP * NH, O_AKS = O_BFP + SZ_BFP, SZ_S = (size_t)2 * MS * D,
    O_AVS = O_AKS + SZ_S, O_BKS = O_AVS + SZ_S, O_BVS = O_BKS + SZ_S, O_BFS = O_BVS + SZ_S, OUT_TOTAL = O_BFS + (size_t)2 * MS * NH;
static_assert(OUT_TOTAL == 181411840, "out size");
constexpr size_t MiB = 1u << 20;
constexpr size_t WS_CTL = 0, CTL_ZERO_BYTES = 1 * MiB;
constexpr size_t WS_WQKV = 2 * MiB, WS_WO = 98 * MiB, WS_WGU = 130 * MiB, WS_WD = 306 * MiB;
constexpr size_t WS_XB = 394 * MiB, WS_SSQ = 459 * MiB;
constexpr size_t WS_QP = 462 * MiB, WS_KP = 526 * MiB, WS_VP = 590 * MiB;
constexpr size_t WS_QS = 654 * MiB;
constexpr size_t WS_OB = 655 * MiB, WS_HB = 720 * MiB;
constexpr size_t WS_KSN = 899 * MiB, WS_VSN = 900 * MiB;
constexpr size_t WS_LFP = 1315 * MiB, WS_WF = 1316 * MiB  , WS_LFS = 1317 * MiB, WS_CUMS = 1319 * MiB, WS_END = 1321 * MiB;
static_assert(WS_WQKV + (size_t)DEPTH * NQKV * D * 2 <= WS_WO && WS_WO + (size_t)DEPTH * D * D * 2 <= WS_WGU && WS_WGU + (size_t)DEPTH * NGU * D * 2 <= WS_WD && WS_WD + (size_t)DEPTH * D * FF * 2 <= WS_XB, "ws map: weights");
static_assert(WS_XB + (size_t)M * D * 2 <= WS_SSQ && WS_SSQ + (size_t)M * 32 * 4 <= WS_QP && WS_OB + (size_t)M * D * 2 <= WS_HB && WS_HB + (size_t)M * FF * 2 <= WS_KSN, "ws map: activations");
constexpr int CW_BAR = 4096, CW_QUEUE = 8192, CW_SKQ = 8192 + 256;
constexpr size_t WS_QKM = WS_WF + 512 * 1024;
constexpr int RING_OFF = 0, RING_BYTES = 131072;
constexpr int LDSCTL_OFF = RING_BYTES, MISC_OFF = LDSCTL_OFF + 320, RED_OFF = LDSCTL_OFF + 1024;
constexpr int LDS_BYTES = 147456;
#define GAS __attribute__((address_space(1)))
#define LAS __attribute__((address_space(3)))
typedef unsigned short bf16;
typedef unsigned v4u __attribute__((ext_vector_type(4)));
typedef float f32x4 __attribute__((ext_vector_type(4)));
typedef short bf16x8 __attribute__((ext_vector_type(8)));
typedef GAS unsigned gu32;
typedef GAS unsigned long long gu64;
#define RLX_AGENT __ATOMIC_RELAXED, __HIP_MEMORY_SCOPE_AGENT
#define LDS_WAIT() asm volatile("s_waitcnt lgkmcnt(0)" ::: "memory")
#define VM_WAIT() asm volatile("s_waitcnt vmcnt(0)" ::: "memory")
__device__ __forceinline__ unsigned long long rt() { return __builtin_amdgcn_s_memrealtime(); }
__device__ __forceinline__ unsigned f2bf(float f) { unsigned u = __builtin_bit_cast(unsigned, f); return (u + 0x7fffu + ((u >> 16) & 1u)) >> 16; }
__device__ __forceinline__ unsigned pk2(float lo, float hi) { return f2bf(lo) | (f2bf(hi) << 16); }

#define XB_TMO      128
#define XB_XCNT(j)  (256  + 64 * (j))
#define XB_XSUB(j)  (1280 + 64 * (j))
#define XB_XGEN(j)  (2304 + 64 * (j))
#define XB_TOP      3328
#define XB_TOPGEN   3392
#define XCD_BAR_WORDS 3456
#define XB_SPIN_CAP (1u << 22)

__device__ __forceinline__ unsigned xb_ld(unsigned* p)              { return __hip_atomic_load(p, __ATOMIC_RELAXED, __HIP_MEMORY_SCOPE_AGENT); }
__device__ __forceinline__ unsigned xb_add(unsigned* p, unsigned v) { return __hip_atomic_fetch_add(p, v, __ATOMIC_RELAXED, __HIP_MEMORY_SCOPE_AGENT); }
__device__ __forceinline__ unsigned xb_xcc_id() { return (unsigned)__builtin_amdgcn_s_getreg((3 << 11) | 20) & 0xFu; }
#define XB_SPIN(cond, bar) do { unsigned _sp = 0; while (cond) { __builtin_amdgcn_s_sleep(1); \
    if ((++_sp & 255u) == 0u) { if (xb_ld(&(bar)[XB_TMO])) break; if (_sp > XB_SPIN_CAP) { atomicAdd(&(bar)[XB_TMO], 1u); break; } } } } while (0)

struct XcdBarrier {
    unsigned* bar; unsigned x;
    volatile LAS unsigned* st;
};

__device__ __forceinline__ XcdBarrier xcd_barrier_post(unsigned* bar, volatile LAS unsigned* st, const bool leader  ) {
    XcdBarrier b; b.bar = bar; b.x = xb_xcc_id(); b.st = st;
    if (leader) (void)xb_add(&bar[XB_XCNT(b.x)], 1u);
    return b;
}
__device__ __forceinline__ void xcd_barrier_complete(unsigned* bar, unsigned x, unsigned& nloc, unsigned& nx) {
    const unsigned G = gridDim.x * gridDim.y * gridDim.z;
    unsigned sum, cnt, mine, sp = 0u;
    for (;;) {
        sum = 0u; cnt = 0u; mine = 0u;
#pragma unroll
        for (unsigned j = 0; j < 16; ++j) { const unsigned c = xb_ld(&bar[XB_XCNT(j)]); sum += c; cnt += (c > 0u) ? 1u : 0u; mine = (j == x) ? c : mine; }
        if (sum == G) break;
        __builtin_amdgcn_s_sleep(1);
        if ((++sp & 255u) == 0u) { if (xb_ld(&bar[XB_TMO])) break; if (sp > XB_SPIN_CAP) { atomicAdd(&bar[XB_TMO], 1u); break; } }
    }
    nloc = mine > 0u ? mine : 1u; nx = cnt > 0u ? cnt : 1u;
}

__device__ __forceinline__ void xcd_barrier(const XcdBarrier& b, const bool leader  ) {
    asm volatile("s_waitcnt vmcnt(0)" ::: "memory");
    __syncthreads();
    if (leader) {
        unsigned* bar = b.bar;
        __builtin_amdgcn_s_waitcnt(0);
        unsigned nloc = b.st[0], nx = b.st[1];
        if (nloc == 0u) { xcd_barrier_complete(bar, b.x, nloc, nx); b.st[0] = nloc; b.st[1] = nx; }
        const unsigned old = xb_add(&bar[XB_XSUB(b.x)], 1u);
        const unsigned gen = old / nloc;
        if (old + 1u == (gen + 1u) * nloc) {
            __builtin_amdgcn_fence(__ATOMIC_RELEASE, "agent");
            asm volatile("s_waitcnt vmcnt(0)" ::: "memory");
            const unsigned og = xb_add(&bar[XB_TOP], 1u);
            const unsigned tg = og / nx;
            if (og + 1u == (tg + 1u) * nx) xb_add(&bar[XB_TOPGEN], 1u);
            else XB_SPIN(xb_ld(&bar[XB_TOPGEN]) == tg, bar);
            __builtin_amdgcn_fence(__ATOMIC_ACQUIRE, "agent");
            xb_add(&bar[XB_XGEN(b.x)], 1u);
            asm volatile("s_waitcnt vmcnt(0)" ::: "memory");
        } else {
            XB_SPIN(xb_ld(&bar[XB_XGEN(b.x)]) == gen, bar);
            __builtin_amdgcn_fence(__ATOMIC_ACQUIRE, "agent");
            asm volatile("s_waitcnt vmcnt(0)" ::: "memory");
        }
    }
    __syncthreads();
}

typedef float f32x2 __attribute__((ext_vector_type(2)));
__device__ __forceinline__ float wave_sum(float v) {
#pragma unroll
    for (int o = 1; o < 64; o <<= 1) v += __shfl_xor(v, o);
    return v;
}
__device__ __forceinline__ float bf2f(unsigned b) { return __uint_as_float(b << 16); }

__device__ __forceinline__ void p0_transpose_item(const float* W, const float* g, int K, int N, bf16* WT, int mode, LAS float* scr, int item, int lane) {
    const int nblk = N / 32, kb = item / nblk, nb = item % nblk, k0 = 64 * kb, n0 = 32 * nb;
    const int kr = lane >> 3, nc = (lane & 7) * 4;
    f32x4 v[8]; float gs[8];
#pragma unroll
    for (int i = 0; i < 8; ++i) { v[i] = *(const GAS f32x4*)(W + (size_t)(k0 + kr + 8 * i) * N + n0 + nc); gs[i] = g ? g[k0 + kr + 8 * i] : 1.f; }
#pragma unroll
    for (int i = 0; i < 8; ++i) { LAS float* s = scr + (kr + 8 * i) * 33 + nc; s[0] = v[i].x * gs[i]; s[1] = v[i].y * gs[i]; s[2] = v[i].z * gs[i]; s[3] = v[i].w * gs[i]; }
    LDS_WAIT(); asm volatile("" ::: "memory");
    const int c = lane & 7;
    const int drow0 = (mode == 0) ? n0 : (256 * (n0 >> 7) + (n0 & 127) + (mode == 2 ? 128 : 0));
#pragma unroll
    for (int j = 0; j < 4; ++j) { const int n = (lane >> 3) + 8 * j; const LAS float* s = scr + (8 * c) * 33 + n;
        v4u o; o.x = pk2(s[0 * 33], s[1 * 33]); o.y = pk2(s[2 * 33], s[3 * 33]); o.z = pk2(s[4 * 33], s[5 * 33]); o.w = pk2(s[6 * 33], s[7 * 33]);
        *(GAS v4u*)(WT + (size_t)(drow0 + n) * K + k0 + 8 * c) = o; }
    LDS_WAIT(); asm volatile("" ::: "memory");
}
__device__ __forceinline__ void p0_item128(const float* W, const float* g, int K, int N, bf16* WT, int mode, LAS float* scr, int item, int lane) {
    const int nblk = N / 32, kb = item / nblk, nb = item % nblk, k0 = 128 * kb, n0 = 32 * nb;
    const int kr = lane >> 3, nc = (lane & 7) * 4;
    f32x4 v[16]; float gs[16];
#pragma unroll
    for (int i = 0; i < 16; ++i) { v[i] = *(const GAS f32x4*)(W + (size_t)(k0 + kr + 8 * i) * N + n0 + nc); gs[i] = g ? g[k0 + kr + 8 * i] : 1.f; }
    const int c = lane & 7;
    const int drow0 = (mode == 0) ? n0 : (256 * (n0 >> 7) + (n0 & 127) + (mode == 2 ? 128 : 0));
#pragma unroll
    for (int hf = 0; hf < 2; ++hf) {
#pragma unroll
        for (int i = 0; i < 8; ++i) { LAS float* s = scr + (kr + 8 * i) * 33 + nc; const f32x4 x = v[hf * 8 + i]; const float gg = gs[hf * 8 + i]; s[0] = x.x * gg; s[1] = x.y * gg; s[2] = x.z * gg; s[3] = x.w * gg; }
        LDS_WAIT(); asm volatile("" ::: "memory");
#pragma unroll
        for (int j = 0; j < 4; ++j) { const int n = (lane >> 3) + 8 * j; const LAS float* s = scr + (8 * c) * 33 + n;
            v4u o; o.x = pk2(s[0 * 33], s[1 * 33]); o.y = pk2(s[2 * 33], s[3 * 33]); o.z = pk2(s[4 * 33], s[5 * 33]); o.w = pk2(s[6 * 33], s[7 * 33]);
            *(GAS v4u*)(WT + (size_t)(drow0 + n) * K + k0 + 64 * hf + 8 * c) = o; }
        LDS_WAIT(); asm volatile("" ::: "memory");
    }
}
constexpr int CI_QKV = (D / 128) * (NQKV / 32), CI_O = (D / 128) * (D / 32), CI_G = (D / 128) * (FF / 32), CI_D = (FF / 128) * (D / 32), CI_L = CI_O + 2 * CI_G + CI_D;
__device__ __forceinline__ int conv_group_items(int grp) { return grp == 0 ? CI_QKV : (grp <= 3 ? CI_L + CI_QKV : CI_L); }
__device__ __forceinline__ void conv_item(const float* const __attribute__((address_space(4)))* in, unsigned char* ws, int grp, int it, LAS float* scr, int lane) {
    bf16* WQKV = (bf16*)(ws + WS_WQKV); bf16* WO = (bf16*)(ws + WS_WO); bf16* WGU = (bf16*)(ws + WS_WGU); bf16* WD = (bf16*)(ws + WS_WD);
    int r = it;
    if (grp > 0) { const int L = grp - 1; const float* gf = in[15] + (size_t)L * D;
        if (r < CI_O) { p0_item128(in[11] + (size_t)L * D * D, nullptr, D, D, WO + (size_t)L * D * D, 0, scr, r, lane); return; } r -= CI_O;
        if (r < CI_G) { p0_item128(in[16] + (size_t)L * D * FF, gf, D, FF, WGU + (size_t)L * NGU * D, 1, scr, r, lane); return; } r -= CI_G;
        if (r < CI_G) { p0_item128(in[17] + (size_t)L * D * FF, gf, D, FF, WGU + (size_t)L * NGU * D, 2, scr, r, lane); return; } r -= CI_G;
        if (r < CI_D) { p0_item128(in[18] + (size_t)L * FF * D, nullptr, FF, D, WD + (size_t)L * D * FF, 0, scr, r, lane); return; } r -= CI_D;
    }
    const int Lq = grp;
    p0_item128(in[8] + (size_t)Lq * D * NQKV, in[7] + (size_t)Lq * D, D, NQKV, WQKV + (size_t)Lq * NQKV * D, 0, scr, r, lane);
}
constexpr int N_SLICE = 256;
struct ConvD { const float* W; const float* g; bf16* WT; int K, N, mode, item; };
__device__ __forceinline__ ConvD conv_desc(const float* const __attribute__((address_space(4)))* in, unsigned char* ws, int grp, int it) {
    ConvD d; int r = it; const int L = grp - 1;
    if (r < CI_O) { d.W = in[11] + (size_t)L * D * D; d.g = nullptr; d.WT = (bf16*)(ws + WS_WO) + (size_t)L * D * D; d.K = D; d.N = D; d.mode = 0; d.item = r; return d; } r -= CI_O;
    if (r < 2 * CI_G) { const int up = r >= CI_G ? 1 : 0; d.W = in[16 + up] + (size_t)L * D * FF; d.g = in[15] + (size_t)L * D; d.WT = (bf16*)(ws + WS_WGU) + (size_t)L * NGU * D; d.K = D; d.N = FF; d.mode = 1 + up; d.item = r - up * CI_G; return d; } r -= 2 * CI_G;
    if (r < CI_D) { d.W = in[18] + (size_t)L * FF * D; d.g = nullptr; d.WT = (bf16*)(ws + WS_WD) + (size_t)L * D * FF; d.K = FF; d.N = D; d.mode = 0; d.item = r; return d; } r -= CI_D;
    d.W = in[8] + (size_t)grp * D * NQKV; d.g = in[7] + (size_t)grp * D; d.WT = (bf16*)(ws + WS_WQKV) + (size_t)grp * NQKV * D; d.K = D; d.N = NQKV; d.mode = 0; d.item = r; return d;
}
__device__ __forceinline__ void p0_load128(const ConvD& d, f32x4 (&v)[16], float (&gs)[16], int lane) {
    const int nblk = d.N / 32, kb = d.item / nblk, nb = d.item % nblk, k0 = 128 * kb, n0 = 32 * nb;
    const int kr = lane >> 3, nc = (lane & 7) * 4;
#pragma unroll
    for (int i = 0; i < 16; ++i) { v[i] = *(const GAS f32x4*)(d.W + (size_t)(k0 + kr + 8 * i) * d.N + n0 + nc); gs[i] = d.g ? d.g[k0 + kr + 8 * i] : 1.f; }
}
__device__ __forceinline__ void p0_finish128(const ConvD& d, const f32x4 (&v)[16], const float (&gs)[16], LAS float* scr, int lane) {
    const int nblk = d.N / 32, kb = d.item / nblk, nb = d.item % nblk, k0 = 128 * kb, n0 = 32 * nb;
    const int kr = lane >> 3, nc = (lane & 7) * 4, c = lane & 7;
    const int drow0 = (d.mode == 0) ? n0 : (256 * (n0 >> 7) + (n0 & 127) + (d.mode == 2 ? 128 : 0));
#pragma unroll
    for (int hf = 0; hf < 2; ++hf) {
#pragma unroll
        for (int i = 0; i < 8; ++i) { LAS float* s = scr + (kr + 8 * i) * 33 + nc; const f32x4 x = v[hf * 8 + i]; const float gg = gs[hf * 8 + i]; s[0] = x.x * gg; s[1] = x.y * gg; s[2] = x.z * gg; s[3] = x.w * gg; }
        LDS_WAIT(); asm volatile("" ::: "memory");
#pragma unroll
        for (int j = 0; j < 4; ++j) { const int n = (lane >> 3) + 8 * j; const LAS float* s = scr + (8 * c) * 33 + n;
            v4u o; o.x = pk2(s[0 * 33], s[1 * 33]); o.y = pk2(s[2 * 33], s[3 * 33]); o.z = pk2(s[4 * 33], s[5 * 33]); o.w = pk2(s[6 * 33], s[7 * 33]);
            *(GAS v4u*)(d.WT + (size_t)(drow0 + n) * d.K + k0 + 64 * hf + 8 * c) = o; }
        LDS_WAIT(); asm volatile("" ::: "memory");
    }
}
__device__ __forceinline__ void conv_slice(const float* const __attribute__((address_space(4)))* in, unsigned char* ws, int grp, int slice, LAS unsigned char* lds, int tid) {
    asm volatile("" : "+v"(tid));
    const int lane = tid & 63, wave = __builtin_amdgcn_readfirstlane(tid >> 6);
    LAS float* scr = (LAS float*)(lds + wave * 16384);
    const int ni = conv_group_items(grp), per = (ni + N_SLICE - 1) / N_SLICE, i0 = slice * per, i1 = (i0 + per < ni) ? i0 + per : ni;
    const int first = i0 + wave, n = (first < i1) ? (i1 - first + NWAVES - 1) / NWAVES : 0;
    if (n > 0) {
        f32x4 vA[16], vB[16]; float gA[16], gB[16];
        ConvD dA = conv_desc(in, ws, grp, first), dB = dA; p0_load128(dA, vA, gA, lane);
#pragma unroll 1
        for (int j = 0; j < n; j += 2) {
            dB = conv_desc(in, ws, grp, first + NWAVES * (j + 1 < n ? j + 1 : n - 1)); p0_load128(dB, vB, gB, lane); __builtin_amdgcn_sched_barrier(0);
            p0_finish128(dA, vA, gA, scr, lane); __builtin_amdgcn_sched_barrier(0);
            dA = conv_desc(in, ws, grp, first + NWAVES * (j + 2 < n ? j + 2 : n - 1)); p0_load128(dA, vA, gA, lane); __builtin_amdgcn_sched_barrier(0);
            if (j + 1 < n) p0_finish128(dB, vB, gB, scr, lane);
            __builtin_amdgcn_sched_barrier(0);
        }
    }
    __syncthreads();
}
__device__ __forceinline__ void row_update(const float* xold, const float* crow, float* xdst, bf16* xbrow, float* rstd_p, int lane) {
    const GAS f32x4* xr = (const GAS f32x4*)xold + lane; const GAS f32x4* cr = (const GAS f32x4*)crow + lane;
    GAS f32x4* xd = (GAS f32x4*)xdst + lane; GAS unsigned long long* o8 = (GAS unsigned long long*)xbrow + lane;
    float ss = 0.f;
#pragma unroll
    for (int j = 0; j < 8; ++j) { f32x4 v = xr[64 * j]; if (crow) v = v + cr[64 * j]; if (xdst) xd[64 * j] = v;
        ss += (v.x * v.x + v.y * v.y) + (v.z * v.z + v.w * v.w);
        o8[64 * j] = (unsigned long long)pk2(v.x, v.y) | ((unsigned long long)pk2(v.z, v.w) << 32); }
    ss = wave_sum(ss);
    if (lane < 32) rstd_p[lane] = (lane == 0) ? ss : 0.f;
}

template <int MODE>
__device__ __forceinline__ void sample_attn(LAS char* lds, int u, int li, unsigned char* ws, const float* rel, const float* kcache, const float* vcache, int tid) {
    asm volatile("" : "+v"(tid));
    constexpr int L = (MODE == 0) ? WIN : PAST, Lk = L + SN, NKB = Lk / 16, LkP = (Lk + 31) / 32 * 32, NST = LkP / 32, PP = LkP;
    constexpr int OFF_P = att::OFF_BIAS + 4352, OFF_RI = OFF_P + 16 * 1056 * 2;
    static_assert(16 * Lk * 4 <= att::OFF_TAB && OFF_RI + 64 <= 131072 && 8 * 16 * 128 * 4 <= att::OFF_TAB, "sample attention LDS map");
    const int lane = tid & 63, wid = __builtin_amdgcn_readfirstlane(tid >> 6), fr = lane & 15, fq = lane >> 4, st = u >> 4, h = u & 15;
    LAS float* S = (LAS float*)lds; LAS unsigned short* P = (LAS unsigned short*)(lds + OFF_P); LAS float* RI = (LAS float*)(lds + OFF_RI);
    const bf16* QSp = (const bf16*)(ws + WS_QS) + (size_t)u * SN * HD; const bf16* KNp = (const bf16*)(ws + WS_KSN) + (size_t)u * SN * HD; const bf16* VNp = (const bf16*)(ws + WS_VSN) + (size_t)u * SN * HD;
    const float* kc = kcache + ((size_t)(li * SB + st) * L) * D + h * HD; const float* vc = vcache + ((size_t)(li * SB + st) * L) * D + h * HD;
    if constexpr (MODE == 1) {
        att::Blk b; b.aux = (const float*)(ws + WS_LFS) + (size_t)u * LS; b.jhi = 17; b.cap = LS - 1; b.jlo = 0; b.P0 = PAST; b.c0 = 0; b.skipthr = 0.f; b.Q = nullptr; b.K = nullptr; b.V = nullptr; b.O = nullptr;
        (void)att::build_bias<1>(b, lds, tid);
    }
    pg8::bf16x8 qf[4];
#pragma unroll
    for (int ds = 0; ds < 4; ++ds) qf[ds] = *(const pg8::bf16x8*)(QSp + (size_t)fr * HD + ds * 32 + fq * 8);
    asm volatile("s_waitcnt lgkmcnt(0)" ::: "memory"); __syncthreads();
#define SA_SCORE(accv, key0_) do { f32x4 lg_; _Pragma("unroll") for (int r = 0; r < 4; ++r) { const int key = (key0_) + 4 * fq + r; float v_; \
            if (MODE == 1) { v_ = ((accv)[r] + ((LAS const float*)(lds + att::OFF_BIAS))[key]) * SCALE; if (key > L + fr) v_ = -__builtin_inff(); } \
            else { int dd = L + fr - key; dd = dd < -128 ? -128 : (dd > 128 ? 128 : dd); v_ = (accv)[r] * SCALE + rel[(size_t)(li * NH + h) * NREL + dd + 128]; } \
            lg_[r] = v_; } *(LAS f32x4*)(S + fr * Lk + (key0_) + 4 * fq) = lg_; } while (0)
    constexpr int NCB = L / 16 / NWAVES;
#pragma unroll 1
    for (int i = 0; i < NCB; i += 2) {
        f32x4 ka[2][4], kb2[2][4];
#pragma unroll
        for (int u2 = 0; u2 < 2; ++u2) { const float* kr = kc + (size_t)((wid + (i + u2) * NWAVES) * 16 + fr) * D + fq * 8;
#pragma unroll
            for (int ds = 0; ds < 4; ++ds) { ka[u2][ds] = *(const GAS f32x4*)(kr + ds * 32); kb2[u2][ds] = *(const GAS f32x4*)(kr + ds * 32 + 4); } }
#pragma unroll
        for (int u2 = 0; u2 < 2; ++u2) { pg8::f32x4 acc = (pg8::f32x4){0.f, 0.f, 0.f, 0.f};
#pragma unroll
            for (int ds = 0; ds < 4; ++ds) { const f32x4 a = ka[u2][ds], b2 = kb2[u2][ds];
                v4u w; w.x = pk2(a.x, a.y); w.y = pk2(a.z, a.w); w.z = pk2(b2.x, b2.y); w.w = pk2(b2.z, b2.w);
                acc = __builtin_amdgcn_mfma_f32_16x16x32_bf16(__builtin_bit_cast(pg8::bf16x8, w), qf[ds], acc, 0, 0, 0); }
            SA_SCORE(acc, (wid + (i + u2) * NWAVES) * 16); }
    }
    if (wid == 0) { const bf16* kr = KNp + (size_t)fr * HD + fq * 8; pg8::f32x4 acc = (pg8::f32x4){0.f, 0.f, 0.f, 0.f};
#pragma unroll
        for (int ds = 0; ds < 4; ++ds) acc = __builtin_amdgcn_mfma_f32_16x16x32_bf16(*(const pg8::bf16x8*)(kr + ds * 32), qf[ds], acc, 0, 0, 0);
        SA_SCORE(acc, L); }
#undef SA_SCORE
    asm volatile("s_waitcnt lgkmcnt(0)" ::: "memory"); __syncthreads();
#pragma unroll 1
    for (int rr = 0; rr < 2; ++rr) { const int q = 2 * wid + rr; LAS const float* sr = S + q * Lk; float m = -1e30f;
        for (int k = lane; k < Lk; k += 64) m = fmaxf(m, sr[k]);
#pragma unroll
        for (int o = 1; o < 64; o <<= 1) m = fmaxf(m, __int_as_float(__builtin_amdgcn_ds_bpermute(((lane ^ o) & 63) << 2, __float_as_int(m))));
        float sum = 0.f;
        for (int k = lane; k < PP; k += 64) { float p = 0.f; if (k < Lk) { p = __expf(sr[k] - m); sum += p; } P[q * 1056 + k] = (unsigned short)f2bf(p); }
#pragma unroll
        for (int o = 1; o < 64; o <<= 1) sum += __int_as_float(__builtin_amdgcn_ds_bpermute(((lane ^ o) & 63) << 2, __float_as_int(sum)));
        if (lane == 0) RI[q] = 1.0f / sum; }
    asm volatile("s_waitcnt lgkmcnt(0)" ::: "memory"); __syncthreads();
    pg8::f32x4 oacc[8];
#pragma unroll
    for (int db = 0; db < 8; ++db) oacc[db] = (pg8::f32x4){0.f, 0.f, 0.f, 0.f};
    constexpr int NCS = L / 32 / NWAVES;
#pragma unroll 1
    for (int i = 0; i < NCS; i += 2) {
        f32x4 ev[2][2][8];
#pragma unroll
        for (int u2 = 0; u2 < 2; ++u2) { const float* vr = vc + (size_t)((wid + (i + u2) * NWAVES) * 32 + fq * 8) * D + 4 * fr;
#pragma unroll
            for (int hf = 0; hf < 2; ++hf)
#pragma unroll
                for (int j = 0; j < 8; ++j) ev[u2][hf][j] = *(const GAS f32x4*)(vr + (size_t)j * D + hf * 64); }
#pragma unroll
        for (int u2 = 0; u2 < 2; ++u2) { const pg8::bf16x8 pf = *(LAS const pg8::bf16x8*)(P + fr * 1056 + (wid + (i + u2) * NWAVES) * 32 + fq * 8);
#pragma unroll
            for (int hf = 0; hf < 2; ++hf)
#pragma unroll
                for (int c = 0; c < 4; ++c) { v4u w; w.x = pk2(ev[u2][hf][0][c], ev[u2][hf][1][c]); w.y = pk2(ev[u2][hf][2][c], ev[u2][hf][3][c]); w.z = pk2(ev[u2][hf][4][c], ev[u2][hf][5][c]); w.w = pk2(ev[u2][hf][6][c], ev[u2][hf][7][c]);
                    oacc[hf * 4 + c] = __builtin_amdgcn_mfma_f32_16x16x32_bf16(__builtin_bit_cast(pg8::bf16x8, w), pf, oacc[hf * 4 + c], 0, 0, 0); } }
    }
    if (wid == 0) { const int kq = L + fq * 8; const pg8::bf16x8 pf = *(LAS const pg8::bf16x8*)(P + fr * 1056 + kq);
        const bool ok = fq < 2; const bf16* vr = VNp + (size_t)(ok ? (kq - L) : 0) * HD + 4 * fr;
#pragma unroll
        for (int hf = 0; hf < 2; ++hf)
#pragma unroll
            for (int c = 0; c < 4; ++c) { unsigned e[8];
#pragma unroll
                for (int j = 0; j < 8; ++j) e[j] = ok ? (unsigned)vr[(size_t)j * HD + hf * 64 + c] : 0u;
                v4u w; w.x = e[0] | (e[1] << 16); w.y = e[2] | (e[3] << 16); w.z = e[4] | (e[5] << 16); w.w = e[6] | (e[7] << 16);
                oacc[hf * 4 + c] = __builtin_amdgcn_mfma_f32_16x16x32_bf16(__builtin_bit_cast(pg8::bf16x8, w), pf, oacc[hf * 4 + c], 0, 0, 0); } }
    LAS float* PO = (LAS float*)lds;
#pragma unroll
    for (int hf = 0; hf < 2; ++hf)
#pragma unroll
        for (int r = 0; r < 4; ++r) *(LAS f32x4*)(PO + (wid * 16 + fr) * 128 + hf * 64 + 16 * fq + 4 * r) = (f32x4){oacc[hf * 4][r], oacc[hf * 4 + 1][r], oacc[hf * 4 + 2][r], oacc[hf * 4 + 3][r]};
    asm volatile("s_waitcnt lgkmcnt(0)" ::: "memory"); __syncthreads();
    { const int q = tid >> 5, d4 = (tid & 31) * 4; f32x4 s = *(LAS const f32x4*)(PO + q * 128 + d4);
#pragma unroll
      for (int w = 1; w < 8; ++w) { const f32x4 t = *(LAS const f32x4*)(PO + (w * 16 + q) * 128 + d4); s = s + t; }
      const float ri = RI[q];
      bf16* o = (bf16*)(ws + WS_OB) + ((size_t)MP + st * SN + q) * D + h * HD + d4;
      *(GAS unsigned long long*)o = (unsigned long long)pk2(s.x * ri, s.y * ri) | ((unsigned long long)pk2(s.z * ri, s.w * ri) << 32); }
    __syncthreads();
}

constexpr int N_PROMPT = NB * NH * 32, N_UNIT = SB * NH, N_POS = N_PROMPT + N_UNIT + N_SLICE;
static_assert(N_UNIT == N_SLICE && N_PROMPT >= 2 * N_UNIT, "ticket layout");
template <int MODE> __device__ __forceinline__ void pos_decode(int pos, int& kind, int& id) {
    if (pos < 4 * N_UNIT) { const int g = pos >> 2, r = pos & 3; if (r == 2) { kind = 1; id = g; } else if (r == 3) { kind = 2; id = g; } else { kind = 0; id = 2 * g + r; } }
    else { kind = 0; id = pos - 2 * N_UNIT; }
}
template <int MODE>
__device__ __forceinline__ void get_blk(int p, int li, unsigned char* ws, const float* rel, att::Blk& b) {
    bf16* QPp = (bf16*)(ws + WS_QP); bf16* KPp = (bf16*)(ws + WS_KP); bf16* VPp = (bf16*)(ws + WS_VP); bf16* OBp = (bf16*)(ws + WS_OB);
    int bh, qb;
    bh = p & 31; qb = 31 - (p >> 5);
    const int bb = bh >> 4, h = bh & 15;
    b.Q = QPp + ((size_t)bh * T + qb * 256) * HD; b.K = KPp + (size_t)bh * T * HD; b.V = VPp + (size_t)bh * T * HD; b.O = OBp + ((size_t)bb * T + qb * 256) * D + h * HD; b.P0 = qb * 256;
    if (MODE == 0) { b.aux = rel + (size_t)(li * NH + h) * NREL; b.c0 = qb * 4; b.jlo = b.c0 > 8 ? b.c0 - 8 : 0; b.jhi = b.c0 + 4; b.cap = 1 << 29; b.skipthr = __builtin_inff(); }
    else { b.aux = (const float*)(ws + WS_LFP) + (size_t)bh * T; b.c0 = 0; b.jlo = 0; b.jhi = 4 * (qb + 1); b.cap = qb * 256 + 255; b.skipthr = ((const float*)(ws + WS_QKM))[li]; }
}
__device__ __forceinline__ int take_ticket(gu32* qc, LAS unsigned char* lds, int tid) {
    volatile LAS int* w = (volatile LAS int*)(lds + 131008);
    if (tid == 0) *w = (int)__hip_atomic_fetch_add(qc, 1u, RLX_AGENT);
    __syncthreads();
    return __builtin_amdgcn_readfirstlane(*w);
}
template <int MODE>
__device__ __forceinline__ void attn_phase(LAS unsigned char* lds, int bx, int G, int layer, unsigned char* ws, const float* const __attribute__((address_space(4)))* in, const int tid) {
    att::Blk cur; att::Nxt nxt; att::Seam S;
    const int li = layer >> 1;
    const float* rel = in[12]; const float* kcache = in[MODE == 1 ? 4 : 2]; const float* vcache = in[MODE == 1 ? 5 : 3];
    gu32* qc = (gu32*)(ws + WS_CTL) + CW_QUEUE + 64 * layer;
    int pos = take_ticket(qc, lds, tid);
    while (pos < N_POS) {
        int kind, id; pos_decode<MODE>(pos, kind, id);
        if (kind != 0) {
            if (kind == 1) sample_attn<MODE>((LAS char*)lds, id, li, ws, rel, kcache, vcache, tid);
            else conv_slice(in, ws, layer + 1, id, lds, tid);
            pos = take_ticket(qc, lds, tid); continue; }
        get_blk<MODE>(id, li, ws, rel, cur);
        att::attn_prime<MODE>(cur, (LAS char*)lds, S, tid);
        for (;;) {
            int np = N_POS, id2 = 0; bool nf = false;
            int tk = 0;
            att::attn_block<MODE>(cur, [&]() { if (tid == 0) tk = (int)__hip_atomic_fetch_add(qc, 1u, RLX_AGENT); },
                [&](att::Nxt& nxt) {
                { volatile LAS int* w = (volatile LAS int*)(lds + 131008); if (tid == 0) *w = tk; __syncthreads(); np = __builtin_amdgcn_readfirstlane(*w); }
                int k2 = 3; if (np < N_POS) pos_decode<MODE>(np, k2, id2);
                nf = (k2 == 0);
                att::Blk nb; if (nf) { get_blk<MODE>(id2, li, ws, rel, nb); nxt.Q = nb.Q; nxt.K = nb.K; nxt.V = nb.V; nxt.jlo = nb.jlo; } else { nxt.Q = cur.Q; nxt.K = cur.K; nxt.V = cur.V; nxt.jlo = cur.jlo; }
            }, (LAS char*)lds, S, tid);
            pos = np;
            if (!nf) break;
            int id3 = id2; asm volatile("" : "+s"(id3));
            get_blk<MODE>(id3, li, ws, rel, cur);
        }
    }
}

struct Args { const float* in[19]; float* out; unsigned char* ws; int ph_lo, ph_hi; };
constexpr int PH_PER_LAYER = 5, N_PHASES = 1 + DEPTH * PH_PER_LAYER;

typedef const __attribute__((address_space(4))) Args CArgs;
#define PH_BEGIN() CArgs* A; { unsigned long long k_ = (unsigned long long)__builtin_amdgcn_kernarg_segment_ptr(); asm volatile("" : "+s"(k_)); A = (CArgs*)k_; } \
    unsigned char* const ws = A->ws; float* const out = A->out; int bx = blockIdx.x; asm volatile("" : "+s"(bx)); (void)ws; (void)out; (void)bx; \
    unsigned m1_ = ~0u; int ws_ = wave_s; asm volatile("" : "+s"(m1_), "+s"(ws_)); int tid = ws_ * 64 + (int)__builtin_amdgcn_mbcnt_hi(m1_, __builtin_amdgcn_mbcnt_lo(m1_, 0u)); asm volatile("" : "+v"(tid)); const int lane = tid & 63, wave = wave_s; (void)lane; (void)wave; \
    const int gw = bx * NWAVES + wave, NGW = G * NWAVES; const long gt = (long)bx * (NWAVES * 64) + tid, NGT = (long)G * (NWAVES * 64); (void)gw; (void)NGW; (void)gt; (void)NGT
__global__ void __launch_bounds__(NWAVES * 64, 2) fwd_kernel(Args args_unused) {
    extern __shared__ __attribute__((aligned(16))) unsigned char lds_raw[];
    LAS unsigned char* lds = (LAS unsigned char*)lds_raw;
    volatile LAS unsigned* MISC = (volatile LAS unsigned*)(lds + MISC_OFF);
    const int G = gridDim.x;
    const int wave_s = __builtin_amdgcn_readfirstlane((int)threadIdx.x >> 6);
    for (int u = threadIdx.x; u < (LDS_BYTES - LDSCTL_OFF) / 4; u += NWAVES * 64) ((LAS unsigned*)(lds + LDSCTL_OFF))[u] = 0u;
    __syncthreads();
    int lo, hi; XcdBarrier bar;
    { PH_BEGIN(); lo = A->ph_lo; hi = A->ph_hi; bar = xcd_barrier_post((unsigned*)((gu32*)(ws + WS_CTL) + CW_BAR), MISC + 8, tid == 0); }
#define IN(k) (lo <= (k) && (k) < hi)
#define SEAM(k) do { if (IN(k) && IN((k) + 1)) { XcdBarrier b2_ = bar; unsigned m2_ = ~0u; int w2_ = wave_s; asm volatile("" : "+s"(b2_.bar), "+s"(m2_), "+s"(w2_)); \
    xcd_barrier(b2_, w2_ == 0 && __builtin_amdgcn_mbcnt_hi(m2_, __builtin_amdgcn_mbcnt_lo(m2_, 0u)) == 0u); } } while (0)
#define P_WQKV ((bf16*)(ws + WS_WQKV))
#define P_WO ((bf16*)(ws + WS_WO))
#define P_WGU ((bf16*)(ws + WS_WGU))
#define P_WD ((bf16*)(ws + WS_WD))
#define P_XB ((bf16*)(ws + WS_XB))
#define P_SSQ ((float*)(ws + WS_SSQ))
#define P_QP ((bf16*)(ws + WS_QP))
#define P_KP ((bf16*)(ws + WS_KP))
#define P_VP ((bf16*)(ws + WS_VP))
#define P_QS ((bf16*)(ws + WS_QS))
#define P_OB ((bf16*)(ws + WS_OB))
#define P_HB ((bf16*)(ws + WS_HB))
#define P_LFP ((float*)(ws + WS_LFP))
#define P_LFS ((float*)(ws + WS_LFS))
#define P_KSN ((bf16*)(ws + WS_KSN))
#define P_VSN ((bf16*)(ws + WS_VSN))
#define P_WF ((bf16*)(ws + WS_WF))
#define P_X (out + O_Y)

    if (IN(0)) { PH_BEGIN();
        LAS float* scr = (LAS float*)(lds + RING_OFF + wave * 16384);
        for (int it = gw; it < conv_group_items(0); it += NGW) conv_item(A->in, ws, 0, it, scr, lane);
        for (int row = gw; row < M; row += NGW) {
            const float* xr = row < MP ? A->in[0] + (size_t)row * D : A->in[1] + (size_t)(row - MP) * D;
            row_update(xr, nullptr, nullptr, P_XB + (size_t)row * D, P_SSQ + (size_t)row * 32, lane);
        }
        for (long idx = gt; idx < 2L * NH * D; idx += NGT) { const int ib = (int)(idx >> 15), h = (int)((idx >> 11) & 15), k = (int)(idx & (D - 1));
            P_WF[idx] = (bf16)f2bf(A->in[7][(size_t)(2 * ib + 1) * D + k] * A->in[13][((size_t)ib * D + k) * NH + h]); }
        if (gw == 0) {
#pragma unroll 1
            for (int ib = 0; ib < 2; ++ib) { const float* gq = A->in[9] + (2 * ib + 1) * HD; const float* gk = A->in[10] + (2 * ib + 1) * HD;
                float mqk = fmaxf(fabsf(gq[lane] * gk[lane]), fabsf(gq[lane + 64] * gk[lane + 64]));
#pragma unroll
                for (int o = 1; o < 64; o <<= 1) mqk = fmaxf(mqk, __shfl_xor(mqk, o));
                if (lane == 0) ((float*)(ws + WS_QKM))[ib] = 11.313708499f * mqk * 1.02f + 40.0f; }
        }
    }
    SEAM(0);

#pragma unroll 1
    for (int layer = 0; layer < DEPTH; ++layer) {
        const int pb = 1 + layer * PH_PER_LAYER, li = layer >> 1; const bool fox = (layer & 1) != 0;
        if (IN(pb + 0)) { PH_BEGIN();
            if (fox) {
                const bf16* wfp = P_WF + (size_t)li * NH * D; const float* bfp = A->in[14] + li * NH;
                const int fr = lane & 15, fq = lane >> 4, lr = lane >> 2, lc = lane & 3, pidx = (((lane & 15) << 2) | (lane >> 4)) << 2;
                const int nidle = (G > 192) ? (G - 192) * NWAVES : NGW, gw0 = (G > 192) ? (bx - 192) * NWAVES + wave : gw;
                if (gw0 >= 0)
                for (int grp = gw0; grp < M / 16; grp += nidle) {
                    const int row = grp * 16 + fr;
                    const char* ap = (const char*)(P_XB + (size_t)(grp * 16 + lr) * D) + lc * 16; const char* bp = (const char*)(wfp + (size_t)lr * D) + lc * 16;
                    pg8::f32x4 acc = (pg8::f32x4){0.f, 0.f, 0.f, 0.f};
#pragma unroll 8
                    for (int ks = 0; ks < D / 32; ++ks) { pg8::u32x4 av = *(const pg8::u32x4*)(ap + ks * 64), bv = *(const pg8::u32x4*)(bp + ks * 64);
                        av.x = (unsigned)__builtin_amdgcn_ds_bpermute(pidx, (int)av.x); av.y = (unsigned)__builtin_amdgcn_ds_bpermute(pidx, (int)av.y); av.z = (unsigned)__builtin_amdgcn_ds_bpermute(pidx, (int)av.z); av.w = (unsigned)__builtin_amdgcn_ds_bpermute(pidx, (int)av.w);
                        bv.x = (unsigned)__builtin_amdgcn_ds_bpermute(pidx, (int)bv.x); bv.y = (unsigned)__builtin_amdgcn_ds_bpermute(pidx, (int)bv.y); bv.z = (unsigned)__builtin_amdgcn_ds_bpermute(pidx, (int)bv.z); bv.w = (unsigned)__builtin_amdgcn_ds_bpermute(pidx, (int)bv.w);
                        acc = __builtin_amdgcn_mfma_f32_16x16x32_bf16(__builtin_bit_cast(pg8::bf16x8, bv), __builtin_bit_cast(pg8::bf16x8, av), acc, 0, 0, 0); }
                    const float rs = pg8::row_rstd(P_SSQ, row, fq);
                    const pg8::f32x4 bb = *(const pg8::f32x4*)(bfp + 4 * fq); pg8::f32x4 lf;
#pragma unroll
                    for (int i = 0; i < 4; ++i) { const float z = acc[i] * rs + bb[i]; lf[i] = fminf(z, 0.f) - log1pf(expf(-fabsf(z))); }
                    if (row < MP) { *(pg8::f32x4*)(out + O_BFP + ((size_t)li * MP + row) * NH + 4 * fq) = lf;
#pragma unroll
                        for (int i = 0; i < 4; ++i) P_LFP[(size_t)((row >> 13) * NH + 4 * fq + i) * T + (row & (T - 1))] = lf[i]; }
                    else { const int rs2 = row - MP; *(pg8::f32x4*)(out + O_BFS + ((size_t)li * MS + rs2) * NH + 4 * fq) = lf;
#pragma unroll
                        for (int i = 0; i < 4; ++i) P_LFS[(size_t)((rs2 >> 4) * NH + 4 * fq + i) * LS + PAST + (rs2 & 15)] = lf[i]; }
                }
                const float* clf = A->in[6] + (size_t)li * SB * PAST * NH;
                for (long idx = gt; idx < (long)SB * NH * PAST; idx += NGT) { const int unit = (int)(idx >> 10), j = (int)(idx & 1023), st = unit >> 4, h = unit & 15;
                    P_LFS[(size_t)unit * LS + j] = clf[((size_t)st * PAST + j) * NH + h]; }
            }
            pg8::Gemm g{P_XB, P_WQKV + (size_t)layer * NQKV * D, MP, NQKV, D}; pg8::StaticOrder S; S.init(MP, NQKV, G, bx, 1);
            pg8::EpiQKV E;
            E.ssq = P_SSQ; E.gq = A->in[9] + layer * HD; E.gk = A->in[10] + layer * HD; E.QP = P_QP; E.pstride = (WS_KP - WS_QP) / 2; E.QS = P_QS;
            E.srows = SN; E.lc = 0; E.KS = P_KSN; E.sstride = (WS_VSN - WS_KSN) / 2;
            E.okp = out + (fox ? O_BKP + (size_t)li * MP * D : O_AKP + (size_t)li * NB * WIN * D); E.opstride = fox ? SZ_BP : SZ_AP;
            E.oks = out + (fox ? O_BKS : O_AKS) + (size_t)li * MS * D; E.osstride = SZ_S;
            E.fox = fox ? 1 : 0; E.red = (LAS float*)(lds + RED_OFF);
            pg8::gemm_phase<pg8::EpiQKV, pg8::StaticOrder, true, true>(lds + RING_OFF, g, S, E, tid);
            __syncthreads();
            {
                sk::SkQKV K2; K2.ssq = P_SSQ + (size_t)MP * 32; K2.gq = A->in[9] + layer * HD; K2.gk = A->in[10] + layer * HD; K2.QS = P_QS;
                K2.srows = SN; K2.lc = 0; K2.KS = P_KSN; K2.sstride = (WS_VSN - WS_KSN) / 2;
                K2.oks = out + (fox ? O_BKS : O_AKS) + (size_t)li * MS * D; K2.osstride = SZ_S;
                sk::skinny_phase<sk::SkQKV>(lds + RING_OFF, P_XB + (size_t)MP * D, P_WQKV + (size_t)layer * NQKV * D, NQKV / 128, D, (unsigned*)((gu32*)(ws + WS_CTL) + CW_SKQ + 64 * (layer * 4 + 0)), tid, K2);
            }
        }
        SEAM(pb + 0);
        if (IN(pb + 1)) { PH_BEGIN();
            if (fox) attn_phase<1>(lds + RING_OFF, bx, G, layer, ws, A->in, tid);
            else attn_phase<0>(lds + RING_OFF, bx, G, layer, ws, A->in, tid);
        }
        SEAM(pb + 1);
        if (IN(pb + 2)) { PH_BEGIN();
            pg8::Gemm g{P_OB, P_WO + (size_t)layer * D * D, MP, D, D}; pg8::StaticOrder S; S.init(MP, D, G, bx);
            pg8::EpiResid E;
            E.X = nullptr; E.XB = P_XB; E.ssq = P_SSQ;
            pg8::gemm_phase<pg8::EpiResid, pg8::StaticOrder, true, true>(lds + RING_OFF, g, S, E, tid);
            __syncthreads();
            {   sk::SkResid K2; K2.xin = (layer == 0) ? A->in[1] : P_X + (size_t)MP * D; K2.X = P_X + (size_t)MP * D; K2.XB = P_XB + (size_t)MP * D; K2.ssq = P_SSQ + (size_t)MP * 32;
                sk::skinny_phase<sk::SkResid>(lds + RING_OFF, P_OB + (size_t)MP * D, P_WO + (size_t)layer * D * D, D / 64, D, (unsigned*)((gu32*)(ws + WS_CTL) + CW_SKQ + 64 * (layer * 4 + 1)), tid, K2); }
        }
        SEAM(pb + 2);
        if (IN(pb + 3)) { PH_BEGIN();
            pg8::Gemm g{P_XB, P_WGU + (size_t)layer * NGU * D, MP, NGU, D}; pg8::StaticOrder S; S.init(MP, NGU, G, bx);
            pg8::EpiSwiglu E{P_HB, FF, P_SSQ};
            pg8::gemm_phase<pg8::EpiSwiglu, pg8::StaticOrder, true, true>(lds + RING_OFF, g, S, E, tid);
            __syncthreads();
            {   sk::SkSwiglu K2{P_HB + (size_t)MP * FF, FF, P_SSQ + (size_t)MP * 32};
                sk::skinny_phase<sk::SkSwiglu>(lds + RING_OFF, P_XB + (size_t)MP * D, P_WGU + (size_t)layer * NGU * D, NGU / 128, D, (unsigned*)((gu32*)(ws + WS_CTL) + CW_SKQ + 64 * (layer * 4 + 2)), tid, K2); }
        }
        SEAM(pb + 3);
        if (IN(pb + 4)) { PH_BEGIN();
            pg8::Gemm g{P_HB, P_WD + (size_t)layer * D * FF, MP, D, FF}; pg8::StaticOrder S; S.init(MP, D, G, bx);
            pg8::EpiResid E;
            E.X = (layer == DEPTH - 1) ? P_X : nullptr; E.XB = P_XB; E.ssq = P_SSQ;
            pg8::gemm_phase<pg8::EpiResid, pg8::StaticOrder, true, true>(lds + RING_OFF, g, S, E, tid);
            __syncthreads();
            {   sk::SkResid K2; K2.xin = P_X + (size_t)MP * D; K2.X = P_X + (size_t)MP * D; K2.XB = P_XB + (size_t)MP * D; K2.ssq = P_SSQ + (size_t)MP * 32;
                sk::skinny_phase<sk::SkResid>(lds + RING_OFF, P_HB + (size_t)MP * FF, P_WD + (size_t)layer * D * FF, D / 64, FF, (unsigned*)((gu32*)(ws + WS_CTL) + CW_SKQ + 64 * (layer * 4 + 3)), tid, K2); }
        }
        SEAM(pb + 4);
    }
#undef IN
#undef SEAM
}

#ifndef MK_SPLIT
#define MK_SPLIT 0
#endif
extern "C" void kernel_launch(void* const* d_in, const int* in_sizes, int n_in, void* d_out, int out_size, void* d_ws, size_t ws_size, hipStream_t stream) {
    static int grid = 0;
    if (grid == 0) {
        if (n_in != 19 || in_sizes[0] != MP * D || (size_t)out_size != OUT_TOTAL || ws_size < WS_END) { fprintf(stderr, "kernel_launch: shape mismatch (n_in %d in0 %d out %d ws %zu); nothing launched\n", n_in, n_in > 0 ? in_sizes[0] : -1, out_size, ws_size); grid = -1; return; }
        int dev = 0, cus = 0;
        if (hipGetDevice(&dev) != hipSuccess || hipDeviceGetAttribute(&cus, hipDeviceAttributeMultiprocessorCount, dev) != hipSuccess) { grid = -1; return; }
        if (hipFuncSetAttribute((const void*)fwd_kernel, hipFuncAttributeMaxDynamicSharedMemorySize, LDS_BYTES) != hipSuccess) { fprintf(stderr, "kernel_launch: hipFuncSetAttribute failed\n"); grid = -1; return; }
        int per_cu = 0;
        if (hipOccupancyMaxActiveBlocksPerMultiprocessor(&per_cu, (const void*)fwd_kernel, NWAVES * 64, LDS_BYTES) != hipSuccess || per_cu < 1) fprintf(stderr, "kernel_launch: occupancy query reports %d\n", per_cu);
        (void)hipGetLastError();
        grid = cus;
    }
    if (grid < 0) return;
    if (hipMemsetAsync((char*)d_ws + WS_CTL, 0, CTL_ZERO_BYTES, stream) != hipSuccess) return;
    Args a{};
    for (int i = 0; i < 19; ++i) a.in[i] = (const float*)d_in[i];
    a.out = (float*)d_out; a.ws = (unsigned char*)d_ws;
#if MK_SPLIT
    for (int p = 0; p < N_PHASES; ++p) { a.ph_lo = p; a.ph_hi = p + 1; hipLaunchKernelGGL(fwd_kernel, dim3(grid), dim3(NWAVES * 64), LDS_BYTES, stream, a); }
#else
    a.ph_lo = 0; a.ph_hi = N_PHASES;
    hipLaunchKernelGGL(fwd_kernel, dim3(grid), dim3(NWAVES * 64), LDS_BYTES, stream, a);
#endif
}
```

```cpp
#include <hip/hip_runtime.h>
#include <cstdio>
#include <cstdint>
namespace pg8 {
#define PG8_LAS __attribute__((address_space(3)))
typedef unsigned short bf16_t;
typedef short bf16x8 __attribute__((ext_vector_type(8)));
typedef float f32x4 __attribute__((ext_vector_type(4)));
typedef unsigned u32x4 __attribute__((ext_vector_type(4)));
constexpr int BM = 256, BK = 64, HALF = 128, HTB = HALF * BK * 2  , STAGE_BYTES = 8 * HTB, NXCD = 8, WGM = 4;

__host__ __device__ __forceinline__ int lds_byte(int r, int c) { const int st = (r >> 4) * 2 + (c >> 5), rr = r & 15, cc = c & 31, ob = rr * 64 + cc * 2; return st * 1024 + (ob ^ (((ob >> 9) & 1) << 5)); }
__host__ __device__ __forceinline__ void stage_rc(int b, int& R, int& C) { const int st = b / 1024, sb = b % 1024, swz = sb ^ (((sb >> 9) & 1) << 5); R = (st >> 1) * 16 + swz / 64; C = (st & 1) * 32 + (swz % 64) / 2; }
__host__ __device__ __forceinline__ int perm32(int rho) { const int n = rho >> 4, i = rho & 15; return 8 * (i >> 2) + 4 * n + (i & 3); }

struct Unit { int pm, pn; };
struct Gemm { const bf16_t* A; const bf16_t* Bt; int M, N, K; };

struct StaticOrder {
    int nM, nN, nwg, G, c, mix3, rev;
    __host__ __device__ void init(int M, int N, int G_, int c_, int mix3_ = 0, int rev_ = 0) { nM = M / BM; nN = N / BM; nwg = nM * nN; G = G_; c = c_; mix3 = mix3_; rev = rev_ && (nwg % NXCD == 0); }
    __host__ __device__ bool next(int i, Unit& u) const {
        const long L = (long)i * G + c; if (L >= nwg) return false;
        int wgid = (int)L; { const int q = nwg / NXCD, r = nwg % NXCD, xcd = wgid % NXCD, off = wgid / NXCD; wgid = (xcd < r ? xcd * (q + 1) : r * (q + 1) + (xcd - r) * q) + (rev ? q - 1 - off : off); }
        const int nig = WGM * nN, gid = wgid / nig, fm = gid * WGM, gsz = (nM - fm) < WGM ? (nM - fm) : WGM;
        u.pm = fm + ((wgid % nig) % gsz); u.pn = (wgid % nig) / gsz; if (mix3) u.pn = (u.pn % 3) * (nN / 3) + u.pn / 3; return true;
    }
    __device__ __forceinline__ void a_ready(const Unit&) const {}
    __device__ __forceinline__ void done(const Unit&) const {}
};

__device__ __forceinline__ unsigned cvt_pk_bf16(float lo, float hi) { unsigned r; asm volatile("v_cvt_pk_bf16_f32 %0, %1, %2" : "=v"(r) : "v"(lo), "v"(hi)); return r; }
struct EpiF32 {
    static constexpr bool PERM = false, AFTER_DRAIN = false;
    float* C; int ldc;
    __device__ __forceinline__ void operator()(const f32x4 (&acc)[2][2][4][2], const Unit& u, int wr, int wc, int fr, int fq) const {
        const int row0 = u.pm * BM + wr * 64 + fr, col0 = u.pn * BM + wc * 32 + 4 * fq;
#pragma unroll
        for (int ai = 0; ai < 2; ++ai)
#pragma unroll
            for (int m = 0; m < 4; ++m) { float* rowp = C + (size_t)(row0 + ai * HALF + m * 16) * ldc + col0;
#pragma unroll
                for (int bj = 0; bj < 2; ++bj)
#pragma unroll
                    for (int n = 0; n < 2; ++n) *(f32x4*)(rowp + bj * HALF + n * 16) = acc[ai][bj][m][n]; }
    }
};
template <class Epi, class Sched, bool ALIGN_EPI = false, bool SP2 = false>
__device__ __forceinline__ void gemm_phase(PG8_LAS unsigned char* lds, const Gemm g, const Sched& S, const Epi& E, const int tid_in) {
    int tid_ = tid_in; asm volatile("" : "+v"(tid_));
    const int tid = tid_, wid = __builtin_amdgcn_readfirstlane(tid >> 6), lane = tid & 63, wr = wid >> 2, wc = wid & 3, fr = lane & 15, fq = lane >> 4;
    const int K = g.K, nt = K / BK;
    unsigned voffA[2], voffB[2];
#pragma unroll
    for (int i = 0; i < 2; ++i) { int R, C; stage_rc(tid * 16 + i * 8192, R, C); const int Rb = Epi::PERM ? ((R & ~31) + perm32(R & 31)) : R;
        voffA[i] = (unsigned)(R * K + C) * 2u; voffB[i] = (unsigned)(Rb * K + C) * 2u; }
    const size_t kstep = (size_t)(BK * 2);
    const size_t hstep = (size_t)HALF * K * 2;
    const size_t tstep = 2 * hstep;
    const unsigned ldsw = (unsigned)wid * 1024u;
    const int aoff = lds_byte(wr * 64 + fr, fq * 8), boff = lds_byte(wc * 32 + fr, fq * 8);
#define PG8_SA(b, h) (((b) * 2 + (h)) * HTB)
#define PG8_SB(b, h) ((4 + (b) * 2 + (h)) * HTB)
#define PG8_STAGE(bufoff, gbase, voff) do { _Pragma("unroll") for (int _i = 0; _i < 2; ++_i) \
        __builtin_amdgcn_global_load_lds((const unsigned*)((const char*)(gbase) + (voff)[_i]), (PG8_LAS unsigned*)(lds + (bufoff) + ldsw + _i * 8192), 16, 0, 0); } while (0)
#define PG8_LDA(dst, b, h) do { _Pragma("unroll") for (int m = 0; m < 4; ++m) _Pragma("unroll") for (int k = 0; k < 2; ++k) dst[m][k] = *(const PG8_LAS bf16x8*)(lds + PG8_SA(b, h) + aoff + m * 2048 + k * 1024); } while (0)
#define PG8_LDB(dst, b, h) do { _Pragma("unroll") for (int n = 0; n < 2; ++n) _Pragma("unroll") for (int k = 0; k < 2; ++k) dst[n][k] = *(const PG8_LAS bf16x8*)(lds + PG8_SB(b, h) + boff + n * 2048 + k * 1024); } while (0)
#define PG8_MMA(ai, bj, At, Bt) do { __builtin_amdgcn_s_setprio(1); _Pragma("unroll") for (int m = 0; m < 4; ++m) _Pragma("unroll") for (int n = 0; n < 2; ++n) _Pragma("unroll") for (int k = 0; k < 2; ++k) \
        acc[ai][bj][m][n] = __builtin_amdgcn_mfma_f32_16x16x32_bf16(Bt[n][k], At[m][k], acc[ai][bj][m][n], 0, 0, 0); __builtin_amdgcn_s_setprio(0); } while (0)
#define PG8_WAIT_V(n) asm volatile("s_waitcnt vmcnt(" #n ")" ::: "memory")
#define PG8_WAIT_L(n) asm volatile("s_waitcnt lgkmcnt(" #n ")" ::: "memory")
#define PG8_BAR __builtin_amdgcn_s_barrier()
#define PG8_SCHED __builtin_amdgcn_sched_barrier(0)
    Unit cur, nxt; int ui = 0;
    if (!S.next(0, cur)) return;
    f32x4 acc[2][2][4][2];
#pragma unroll
    for (int a = 0; a < 2; ++a)
#pragma unroll
        for (int b = 0; b < 2; ++b)
#pragma unroll
            for (int m = 0; m < 4; ++m)
#pragma unroll
                for (int n = 0; n < 2; ++n) acc[a][b][m][n] = (f32x4){0.f, 0.f, 0.f, 0.f};
    bf16x8 At[4][2], B0[2][2], B1[2][2];
    const char* cA = (const char*)g.A + (size_t)cur.pm * tstep; const char* cB = (const char*)g.Bt + (size_t)cur.pn * tstep;
    S.a_ready(cur);
    if constexpr (SP2) {
        PG8_STAGE(PG8_SB(0, 0), cB, voffB); PG8_STAGE(PG8_SB(0, 1), cB + hstep, voffB); PG8_STAGE(PG8_SA(0, 0), cA, voffA); PG8_STAGE(PG8_SA(0, 1), cA + hstep, voffA);
        if (wr == 1) PG8_BAR;
        PG8_WAIT_V(2); PG8_BAR;
        PG8_STAGE(PG8_SB(1, 0), cB + kstep, voffB); PG8_STAGE(PG8_SA(1, 0), cA + kstep, voffA); PG8_STAGE(PG8_SB(1, 1), cB + hstep + kstep, voffB);
        PG8_WAIT_V(6); PG8_BAR;
    } else {
        PG8_STAGE(PG8_SB(0, 0), cB, voffB); PG8_STAGE(PG8_SA(0, 0), cA, voffA); PG8_STAGE(PG8_SB(0, 1), cB + hstep, voffB); PG8_STAGE(PG8_SA(0, 1), cA + hstep, voffA);
        if (wr == 1) PG8_BAR;
        PG8_WAIT_V(4); PG8_BAR;
        PG8_STAGE(PG8_SB(1, 0), cB + kstep, voffB); PG8_STAGE(PG8_SA(1, 0), cA + kstep, voffA); PG8_STAGE(PG8_SB(1, 1), cB + hstep + kstep, voffB);
        PG8_WAIT_V(6); PG8_BAR;
    }
    for (;;) {
        const bool has_next = S.next(ui + 1, nxt);
        const char* nA = has_next ? (const char*)g.A + (size_t)nxt.pm * tstep : cA; const char* nB = has_next ? (const char*)g.Bt + (size_t)nxt.pn * tstep : cB;
        for (int t = 0; t < nt; t += 2) {
            const bool last = (t == nt - 2);
            const char* a1 = cA + (size_t)(t + 1) * kstep;
            const char* a2 = last ? nA : cA + (size_t)(t + 2) * kstep; const char* b2 = last ? nB : cB + (size_t)(t + 2) * kstep;
            const char* a3 = a2 + kstep; const char* b3 = b2 + kstep;
            if (last && has_next) S.a_ready(nxt);
            if constexpr (SP2) {
            PG8_LDB(B0, 0, 0); PG8_LDB(B1, 0, 1); PG8_SCHED; PG8_LDA(At, 0, 0); PG8_STAGE(PG8_SA(1, 1), a1 + hstep, voffA);
            PG8_WAIT_V(8); PG8_WAIT_L(0); PG8_BAR; PG8_MMA(0, 0, At, B0); PG8_MMA(0, 1, At, B1); PG8_BAR; PG8_SCHED;
            PG8_LDA(At, 0, 1); PG8_STAGE(PG8_SB(0, 0), b2, voffB); PG8_STAGE(PG8_SB(0, 1), b2 + hstep, voffB); PG8_STAGE(PG8_SA(0, 0), a2, voffA);
            PG8_WAIT_V(8); PG8_WAIT_L(0); PG8_BAR; PG8_MMA(1, 0, At, B0); PG8_MMA(1, 1, At, B1); PG8_BAR; PG8_SCHED;
            PG8_LDB(B0, 1, 0); PG8_LDB(B1, 1, 1); PG8_SCHED; PG8_LDA(At, 1, 0); PG8_STAGE(PG8_SA(0, 1), a2 + hstep, voffA);
            PG8_WAIT_V(8); PG8_WAIT_L(0); PG8_BAR; PG8_MMA(0, 0, At, B0); PG8_MMA(0, 1, At, B1); PG8_BAR; PG8_SCHED;
            PG8_LDA(At, 1, 1); PG8_STAGE(PG8_SB(1, 0), b3, voffB); PG8_STAGE(PG8_SB(1, 1), b3 + hstep, voffB); PG8_STAGE(PG8_SA(1, 0), a3, voffA);
            PG8_WAIT_V(8); PG8_WAIT_L(0); PG8_BAR; PG8_MMA(1, 0, At, B0); PG8_MMA(1, 1, At, B1); PG8_BAR; PG8_SCHED;
            } else {
            PG8_LDB(B0, 0, 0); PG8_SCHED; PG8_LDA(At, 0, 0); PG8_STAGE(PG8_SA(1, 1), a1 + hstep, voffA);
            PG8_WAIT_L(8); PG8_BAR; PG8_WAIT_L(0); PG8_MMA(0, 0, At, B0); PG8_BAR; PG8_SCHED;
            PG8_LDB(B1, 0, 1); PG8_STAGE(PG8_SB(0, 0), b2, voffB);
            PG8_BAR; PG8_WAIT_L(0); PG8_MMA(0, 1, At, B1); PG8_BAR;
            PG8_LDA(At, 0, 1); PG8_STAGE(PG8_SA(0, 0), a2, voffA);
            PG8_BAR; PG8_WAIT_L(0); PG8_MMA(1, 0, At, B0); PG8_BAR; PG8_SCHED;
            PG8_STAGE(PG8_SB(0, 1), b2 + hstep, voffB);
            PG8_WAIT_V(6); PG8_BAR; PG8_MMA(1, 1, At, B1); PG8_BAR;
            PG8_LDB(B0, 1, 0); PG8_SCHED; PG8_LDA(At, 1, 0); PG8_STAGE(PG8_SA(0, 1), a2 + hstep, voffA);
            PG8_WAIT_L(8); PG8_BAR; PG8_WAIT_L(0); PG8_MMA(0, 0, At, B0); PG8_BAR; PG8_SCHED;
            PG8_LDB(B1, 1, 1); PG8_STAGE(PG8_SB(1, 0), b3, voffB);
            PG8_BAR; PG8_WAIT_L(0); PG8_MMA(0, 1, At, B1); PG8_BAR;
            PG8_LDA(At, 1, 1); PG8_STAGE(PG8_SA(1, 0), a3, voffA);
            PG8_BAR; PG8_WAIT_L(0); PG8_MMA(1, 0, At, B0); PG8_BAR; PG8_SCHED;
            PG8_STAGE(PG8_SB(1, 1), b3 + hstep, voffB);
            PG8_WAIT_V(6); PG8_BAR; PG8_MMA(1, 1, At, B1); PG8_BAR;
            }
        }
        if constexpr (ALIGN_EPI) { if (wr == 0) PG8_BAR; }
        if constexpr (!Epi::AFTER_DRAIN) { E(acc, cur, wr, wc, fr, fq); S.done(cur); }
        if (!has_next) break;
#pragma unroll
        for (int a = 0; a < 2; ++a)
#pragma unroll
            for (int b = 0; b < 2; ++b)
#pragma unroll
                for (int m = 0; m < 4; ++m)
#pragma unroll
                    for (int n = 0; n < 2; ++n) acc[a][b][m][n] = (f32x4){0.f, 0.f, 0.f, 0.f};
        cur = nxt; cA = nA; cB = nB; ++ui;
        if constexpr (ALIGN_EPI) { if (wr == 1) PG8_BAR; }
    }
    PG8_WAIT_V(0);
    if constexpr (!ALIGN_EPI) { if (wr == 0) PG8_BAR; }
    PG8_BAR;
    if constexpr (Epi::AFTER_DRAIN) { E.fused(acc, cur, wr, wc, fr, fq, lds, wid, lane); S.done(cur); }
#undef PG8_SA
#undef PG8_SB
#undef PG8_STAGE
#undef PG8_LDA
#undef PG8_LDB
#undef PG8_MMA
#undef PG8_WAIT_V
#undef PG8_WAIT_L
#undef PG8_BAR
#undef PG8_SCHED
}
}

namespace pg8 {
typedef unsigned u32x2 __attribute__((ext_vector_type(2)));
typedef float f32x2 __attribute__((ext_vector_type(2)));
__device__ __forceinline__ void rows_rstd(float (&rs)[2][4], const float* ssq, int pm, int wr, int fr, int fq) {
    f32x4 pa[2][4], pb[2][4];
    const float* base = ssq + (size_t)(pm * BM + wr * 64 + fr) * 32 + fq * 8;
#pragma unroll
    for (int ai = 0; ai < 2; ++ai)
#pragma unroll
        for (int m = 0; m < 4; ++m) { pa[ai][m] = *(const f32x4*)(base + (ai * HALF + m * 16) * 32); pb[ai][m] = *(const f32x4*)(base + (ai * HALF + m * 16) * 32 + 4); }
#pragma unroll
    for (int ai = 0; ai < 2; ++ai)
#pragma unroll
        for (int m = 0; m < 4; ++m) { const f32x4 a = pa[ai][m], b = pb[ai][m];
            float s = ((a[0] + a[1]) + (a[2] + a[3])) + ((b[0] + b[1]) + (b[2] + b[3]));
            s += __shfl_xor(s, 16); s += __shfl_xor(s, 32);
            rs[ai][m] = __builtin_amdgcn_rsqf(s * (1.0f / 2048.0f) + 1e-6f); }
}
__device__ __forceinline__ f32x4 to_rowmajor(f32x4 v, int pidx) {
    f32x4 o; o[0] = __int_as_float(__builtin_amdgcn_ds_bpermute(pidx, __float_as_int(v[0]))); o[1] = __int_as_float(__builtin_amdgcn_ds_bpermute(pidx, __float_as_int(v[1])));
    o[2] = __int_as_float(__builtin_amdgcn_ds_bpermute(pidx, __float_as_int(v[2]))); o[3] = __int_as_float(__builtin_amdgcn_ds_bpermute(pidx, __float_as_int(v[3]))); return o;
}
__device__ __forceinline__ int rowmajor_pidx(int lane) { return (((lane & 3) << 4) | (lane >> 2)) << 2; }
__device__ __forceinline__ void rows_rstd_rm(float (&rs)[2][4], const float* ssq, int pm, int wr, int r2, int c2) {
    f32x4 pa[2][4], pb[2][4];
    const float* base = ssq + (size_t)(pm * BM + wr * 64 + r2) * 32 + c2 * 8;
#pragma unroll
    for (int ai = 0; ai < 2; ++ai)
#pragma unroll
        for (int m = 0; m < 4; ++m) { pa[ai][m] = *(const f32x4*)(base + (ai * HALF + m * 16) * 32); pb[ai][m] = *(const f32x4*)(base + (ai * HALF + m * 16) * 32 + 4); }
#pragma unroll
    for (int ai = 0; ai < 2; ++ai)
#pragma unroll
        for (int m = 0; m < 4; ++m) { const f32x4 a = pa[ai][m], b = pb[ai][m];
            float s = ((a[0] + a[1]) + (a[2] + a[3])) + ((b[0] + b[1]) + (b[2] + b[3]));
            s += __shfl_xor(s, 1); s += __shfl_xor(s, 2);
            rs[ai][m] = __builtin_amdgcn_rsqf(s * (1.0f / 2048.0f) + 1e-6f); }
}
__device__ __forceinline__ float row_rstd(const float* ssq, int row, int fq) {
    const f32x4 a = *(const f32x4*)(ssq + (size_t)row * 32 + fq * 8), b = *(const f32x4*)(ssq + (size_t)row * 32 + fq * 8 + 4);
    float s = ((a[0] + a[1]) + (a[2] + a[3])) + ((b[0] + b[1]) + (b[2] + b[3]));
    s += __shfl_xor(s, 16); s += __shfl_xor(s, 32);
    return __builtin_amdgcn_rsqf(s * (1.0f / 2048.0f) + 1e-6f);
}
struct EpiResid {
    static constexpr bool PERM = true, AFTER_DRAIN = false;
    float* X; bf16_t* XB; float* ssq;
    __device__ __forceinline__ void operator()(const f32x4 (&acc)[2][2][4][2], const Unit& u, int wr, int wc, int fr_, int fq_) const {
        const int lane = fq_ * 16 + fr_, r2 = lane >> 2, c2 = lane & 3, pidx = rowmajor_pidx(lane);
        const int row0 = u.pm * BM + wr * 64 + r2, col0 = u.pn * BM + wc * 32 + 8 * c2;
        u32x4 v[4][2];
#define EPR_LOAD(g) do { const size_t off_ = (size_t)(row0 + ((g) >> 2) * HALF + ((g) & 3) * 16) * 2048 + col0; _Pragma("unroll") for (int bj = 0; bj < 2; ++bj) \
            v[(g) & 3][bj] = *(const u32x4*)(XB + off_ + bj * HALF); } while (0)
        EPR_LOAD(0); EPR_LOAD(1); EPR_LOAD(2);
#pragma unroll
        for (int g = 0; g < 8; ++g) { const int ai = g >> 2, m = g & 3; const int row = row0 + ai * HALF + m * 16; const size_t off = (size_t)row * 2048 + col0; float s = 0.f;
            if (g + 3 < 8) EPR_LOAD(g + 3);
#pragma unroll
            for (int bj = 0; bj < 2; ++bj) { const u32x4 xo = v[g & 3][bj];
                const f32x4 x0 = (f32x4){__uint_as_float(xo.x << 16), __uint_as_float(xo.x & 0xffff0000u), __uint_as_float(xo.y << 16), __uint_as_float(xo.y & 0xffff0000u)} + to_rowmajor(acc[ai][bj][m][0], pidx);
                const f32x4 x1 = (f32x4){__uint_as_float(xo.z << 16), __uint_as_float(xo.z & 0xffff0000u), __uint_as_float(xo.w << 16), __uint_as_float(xo.w & 0xffff0000u)} + to_rowmajor(acc[ai][bj][m][1], pidx);
                if (X != nullptr) { *(f32x4*)(X + off + bj * HALF) = x0; *(f32x4*)(X + off + bj * HALF + 4) = x1; }
                u32x4 w; w.x = cvt_pk_bf16(x0[0], x0[1]); w.y = cvt_pk_bf16(x0[2], x0[3]); w.z = cvt_pk_bf16(x1[0], x1[1]); w.w = cvt_pk_bf16(x1[2], x1[3]); *(u32x4*)(XB + off + bj * HALF) = w;
                s += ((x0[0] * x0[0] + x0[1] * x0[1]) + (x0[2] * x0[2] + x0[3] * x0[3])) + ((x1[0] * x1[0] + x1[1] * x1[1]) + (x1[2] * x1[2] + x1[3] * x1[3])); }
            s += __shfl_xor(s, 1); s += __shfl_xor(s, 2);
            if (c2 == 0) ssq[(size_t)row * 32 + u.pn * 4 + wc] = s;
            asm volatile("" ::: "memory"); }
#undef EPR_LOAD
    }
};
struct EpiSwiglu {
    static constexpr bool PERM = true, AFTER_DRAIN = false;
    bf16_t* H; int ldh; const float* ssq;
    __device__ __forceinline__ void operator()(const f32x4 (&acc)[2][2][4][2], const Unit& u, int wr, int wc, int fr_, int fq_) const {
        const int lane = fq_ * 16 + fr_, r2 = lane >> 2, c2 = lane & 3, pidx = rowmajor_pidx(lane);
        const int row0 = u.pm * BM + wr * 64 + r2, col0 = u.pn * HALF + wc * 32 + 8 * c2;
        f32x4 pa[2][4], pb[2][4];
        { const float* base = ssq + (size_t)(u.pm * BM + wr * 64 + r2) * 32 + c2 * 8;
#pragma unroll
          for (int ai = 0; ai < 2; ++ai)
#pragma unroll
            for (int m = 0; m < 4; ++m) { pa[ai][m] = *(const f32x4*)(base + (ai * HALF + m * 16) * 32); pb[ai][m] = *(const f32x4*)(base + (ai * HALF + m * 16) * 32 + 4); } }
        __builtin_amdgcn_sched_barrier(0);
        f32x4 rm[2][2][4][2];
#pragma unroll
        for (int ai = 0; ai < 2; ++ai)
#pragma unroll
            for (int bj = 0; bj < 2; ++bj)
#pragma unroll
                for (int m = 0; m < 4; ++m)
#pragma unroll
                    for (int n = 0; n < 2; ++n) rm[ai][bj][m][n] = to_rowmajor(acc[ai][bj][m][n], pidx);
        __builtin_amdgcn_sched_barrier(0);
        float rs[2][4];
#pragma unroll
        for (int ai = 0; ai < 2; ++ai)
#pragma unroll
            for (int m = 0; m < 4; ++m) { const f32x4 a = pa[ai][m], b = pb[ai][m];
                float sq = ((a[0] + a[1]) + (a[2] + a[3])) + ((b[0] + b[1]) + (b[2] + b[3]));
                sq += __shfl_xor(sq, 1); sq += __shfl_xor(sq, 2);
                rs[ai][m] = __builtin_amdgcn_rsqf(sq * (1.0f / 2048.0f) + 1e-6f); }
#pragma unroll
        for (int ai = 0; ai < 2; ++ai)
#pragma unroll
            for (int m = 0; m < 4; ++m) { const float r = rs[ai][m], c1 = -1.4426950408889634f * r, ms = __builtin_amdgcn_rcpf(r * r); float hv[8];
#pragma unroll
                for (int n = 0; n < 2; ++n) { const f32x4 gv = rm[ai][0][m][n], uv = rm[ai][1][m][n];
#pragma unroll
                    for (int i = 0; i < 4; i += 2) {
                        const f32x2 g2 = (f32x2){gv[i], gv[i + 1]}, u2 = (f32x2){uv[i], uv[i + 1]}; const f32x2 t2 = g2 * c1;
                        f32x2 e2; e2.x = __builtin_amdgcn_exp2f(t2.x); e2.y = __builtin_amdgcn_exp2f(t2.y);
                        const f32x2 d2 = e2 * ms + ms; f32x2 s2; s2.x = __builtin_amdgcn_rcpf(d2.x); s2.y = __builtin_amdgcn_rcpf(d2.y);
                        const f32x2 h2 = (g2 * u2) * s2; hv[4 * n + i] = h2.x; hv[4 * n + i + 1] = h2.y; } }
                u32x4 w; w.x = cvt_pk_bf16(hv[0], hv[1]); w.y = cvt_pk_bf16(hv[2], hv[3]); w.z = cvt_pk_bf16(hv[4], hv[5]); w.w = cvt_pk_bf16(hv[6], hv[7]);
                *(u32x4*)(H + (size_t)(row0 + ai * HALF + m * 16) * ldh + col0) = w; }
    }
};
struct EpiQKV {
    static constexpr bool PERM = true, AFTER_DRAIN = false;
    const float* ssq; const float* gq; const float* gk;
    bf16_t* QP; size_t pstride;
    bf16_t* QS; bf16_t* KS; size_t sstride; int srows, lc;
    float* okp; size_t opstride; float* oks; size_t osstride;
    int fox;
    PG8_LAS float* red;
    __device__ __forceinline__ void operator()(const f32x4 (&acc)[2][2][4][2], const Unit& u, int wr, int wc, int fr_, int fq_) const {
        int fr = fr_, fq = fq_; asm volatile("" : "+v"(fr), "+v"(fq));
        const int which = u.pn >> 3, head0 = (u.pn & 7) * 2;
        const int lane_ = fq_ * 16 + fr_, r2 = lane_ >> 2, c2 = lane_ & 3, pidx = rowmajor_pidx(lane_);
        float rsv[2][4]; rows_rstd_rm(rsv, ssq, u.pm, wr, r2, c2);
        if (which < 2) {
#pragma unroll
            for (int ai = 0; ai < 2; ++ai)
#pragma unroll
                for (int m = 0; m < 4; ++m)
#pragma unroll
                    for (int bj = 0; bj < 2; ++bj) { float s = 0.f;
#pragma unroll
                        for (int n = 0; n < 2; ++n) { const f32x4 x = acc[ai][bj][m][n]; s += (x[0] * x[0] + x[1] * x[1]) + (x[2] * x[2] + x[3] * x[3]); }
                        s += __shfl_xor(s, 16); s += __shfl_xor(s, 32);
                        if (fq == 0) red[(wc * 256 + ai * HALF + wr * 64 + m * 16 + fr) * 2 + bj] = s; }
            asm volatile("s_waitcnt lgkmcnt(0)" ::: "memory"); __builtin_amdgcn_s_barrier(); asm volatile("" ::: "memory");
        }
        const int cih = wc * 32 + 8 * c2;
        f32x4 g0 = (f32x4){1.f, 1.f, 1.f, 1.f}, g1 = g0;
        if (which < 2) { const float* g = (which == 0 ? gq : gk) + cih; g0 = *(const f32x4*)g; g1 = *(const f32x4*)(g + 4); }
        const bool samp = u.pm >= 64;
        const bool f32out = which > 0 && (samp || fox || (u.pm & 31) >= 30);
        char* b16; char* b32 = nullptr; unsigned hs16, rowsz = 0;
        if (!samp) { const int bb = u.pm >> 5;
            b16 = (char*)(QP + (size_t)which * pstride + (size_t)(bb * 16 + head0) * (8192 * 128)); hs16 = 8192 * 128 * 2;
            if (f32out) b32 = (char*)(okp + (size_t)(which - 1) * opstride + (fox ? (size_t)bb * 8192 * 2048 : (size_t)bb * 512 * 2048) + head0 * 128);
        } else { rowsz = (which == 0) ? 16u : (unsigned)srows;
            b16 = (which == 0) ? (char*)QS : (char*)(KS + (size_t)(which == 2 ? 1 : 0) * sstride + (size_t)lc * 128); hs16 = rowsz * 256u;
            if (f32out) b32 = (char*)(oks + (size_t)(which - 1) * osstride + head0 * 128); }
        const int trow0 = samp ? 0 : ((u.pm & 31) * 256 - ((fox || !f32out) ? 0 : 7680));
#pragma unroll
        for (int ai = 0; ai < 2; ++ai)
#pragma unroll
            for (int m = 0; m < 4; ++m) { const int rit = ai * HALF + wr * 64 + m * 16 + r2;
                const float rs = rsv[ai][m];
                unsigned o16;
                if (!samp) o16 = (unsigned)((((u.pm & 31) * 256 + rit) * 128 + cih) * 2);
                else o16 = (unsigned)(((((rit >> 4) * 16 + head0) * rowsz + (rit & 15)) * 128 + cih) * 2);
                const unsigned o32 = (unsigned)(((trow0 + rit) * 2048 + cih) * 4);
#pragma unroll
                for (int bj = 0; bj < 2; ++bj) { float sc = rs;
                    if (which < 2) { const int ri = rit * 2 + bj; const float t = (red[ri] + red[512 + ri]) + (red[1024 + ri] + red[1536 + ri]);
                        sc = rs * __builtin_amdgcn_rsqf(t * rs * rs * (1.0f / 128.0f) + 1e-6f); }
                    const f32x4 x0 = to_rowmajor(acc[ai][bj][m][0], pidx) * sc * g0, x1 = to_rowmajor(acc[ai][bj][m][1], pidx) * sc * g1;
                    u32x4 w; w.x = cvt_pk_bf16(x0[0], x0[1]); w.y = cvt_pk_bf16(x0[2], x0[3]); w.z = cvt_pk_bf16(x1[0], x1[1]); w.w = cvt_pk_bf16(x1[2], x1[3]);
                    *(u32x4*)(b16 + (size_t)(o16 + (unsigned)bj * hs16)) = w;
                    if (f32out) { float* fo = (float*)(b32 + (size_t)(o32 + (unsigned)bj * 512u)); __builtin_nontemporal_store(x0, (f32x4*)fo); __builtin_nontemporal_store(x1, (f32x4*)(fo + 4)); } }
                asm volatile("" ::: "memory"); }
    }
};
}

namespace sk {
typedef short bf16x8 __attribute__((ext_vector_type(8)));
typedef float f32x4 __attribute__((ext_vector_type(4)));
typedef unsigned u32x2 __attribute__((ext_vector_type(2)));
typedef unsigned u32x4 __attribute__((ext_vector_type(4)));
typedef unsigned short bf16_t;
#define SLAS __attribute__((address_space(3)))
__device__ __forceinline__ unsigned cvtpk(float lo, float hi) { unsigned r; asm volatile("v_cvt_pk_bf16_f32 %0, %1, %2" : "=v"(r) : "v"(lo), "v"(hi)); return r; }
__device__ __forceinline__ float row_rstd(const float* ssq, int row, int fq) {
    const f32x4 a = *(const f32x4*)(ssq + (size_t)row * 32 + fq * 8), b = *(const f32x4*)(ssq + (size_t)row * 32 + fq * 8 + 4);
    float s = ((a[0] + a[1]) + (a[2] + a[3])) + ((b[0] + b[1]) + (b[2] + b[3]));
    s += __shfl_xor(s, 16); s += __shfl_xor(s, 32);
    return __builtin_amdgcn_rsqf(s * (1.0f / 2048.0f) + 1e-6f);
}
struct SkResid {
    static constexpr int MB = 2, NB = 2, NS = 6; static constexpr bool NEEDS_X = true;
    const float* xin; float* X; bf16_t* XB; float* ssq;
    __device__ __forceinline__ int brow(int ct, int ch, int n) const { return ct * 64 + ch * 32 + 16 * n; }
    __device__ __forceinline__ void partial(f32x4 (&acc)[MB][NB], int rt, int ct, int ch, int fr, int fq, SLAS float* red) const {
        f32x4 xo[MB][NB];
#pragma unroll
        for (int m = 0; m < MB; ++m)
#pragma unroll
            for (int n = 0; n < NB; ++n) xo[m][n] = *(const f32x4*)(xin + (size_t)(rt * 32 + 16 * m + fr) * 2048 + ct * 64 + ch * 32 + 16 * n + 4 * fq);
#pragma unroll
        for (int m = 0; m < MB; ++m) { float s = 0.f;
#pragma unroll
            for (int n = 0; n < NB; ++n) { const f32x4 x = xo[m][n] + acc[m][n]; acc[m][n] = x; s += (x[0] * x[0] + x[1] * x[1]) + (x[2] * x[2] + x[3] * x[3]); }
            s += __shfl_xor(s, 16); s += __shfl_xor(s, 32);
            if (fq == 0) red[ch * 32 + 16 * m + fr] = s; }
    }
    __device__ __forceinline__ void operator()(const f32x4 (&acc)[MB][NB], int rt, int ct, int ch, int fr, int fq, SLAS float* red) const {
#pragma unroll
        for (int m = 0; m < MB; ++m) { const int r = rt * 32 + 16 * m + fr; const size_t off = (size_t)r * 2048 + ct * 64 + ch * 32 + 4 * fq;
#pragma unroll
            for (int n = 0; n < NB; ++n) { const f32x4 x = acc[m][n];
                *(f32x4*)(X + off + 16 * n) = x; u32x2 w; w.x = cvtpk(x[0], x[1]); w.y = cvtpk(x[2], x[3]); *(u32x2*)(XB + off + 16 * n) = w; }
            if (ch == 0 && fq == 0) ssq[(size_t)r * 32 + ct] = red[16 * m + fr] + red[32 + 16 * m + fr]; }
    }
};
struct SkSwiglu {
    static constexpr int MB = 4, NB = 4, NS = 3; static constexpr bool NEEDS_X = false;
    bf16_t* H; int ldh; const float* ssq;
    __device__ __forceinline__ int brow(int ct, int ch, int n) const { return 256 * (ct >> 1) + (ct & 1) * 64 + ch * 32 + (n >= 2 ? 128 + 16 * (n - 2) : 16 * n); }
    __device__ __forceinline__ void partial(f32x4 (&acc)[MB][NB], int, int, int, int, int, SLAS float*) const {}
    __device__ __forceinline__ void operator()(const f32x4 (&acc)[MB][NB], int rt, int ct, int ch, int fr, int fq, SLAS float* red) const {
        float rs[MB];
        { f32x4 pa[MB], pb[MB];
#pragma unroll
          for (int m = 0; m < MB; ++m) { const float* sp = ssq + (size_t)(rt * 64 + 16 * m + fr) * 32 + fq * 8; pa[m] = *(const f32x4*)sp; pb[m] = *(const f32x4*)(sp + 4); }
#pragma unroll
          for (int m = 0; m < MB; ++m) { float s = ((pa[m][0] + pa[m][1]) + (pa[m][2] + pa[m][3])) + ((pb[m][0] + pb[m][1]) + (pb[m][2] + pb[m][3]));
              s += __shfl_xor(s, 16); s += __shfl_xor(s, 32); rs[m] = __builtin_amdgcn_rsqf(s * (1.0f / 2048.0f) + 1e-6f); } }
#pragma unroll
        for (int m = 0; m < MB; ++m) { const int r = rt * 64 + 16 * m + fr;
#pragma unroll
            for (int n = 0; n < 2; ++n) { float hv[4];
#pragma unroll
                for (int i = 0; i < 4; ++i) { const float g = acc[m][n][i] * rs[m], up = acc[m][n + 2][i] * rs[m]; hv[i] = g * __builtin_amdgcn_rcpf(1.0f + __expf(-g)) * up; }
                u32x2 w; w.x = cvtpk(hv[0], hv[1]); w.y = cvtpk(hv[2], hv[3]);
                *(u32x2*)(H + (size_t)r * ldh + 128 * (ct >> 1) + (ct & 1) * 64 + ch * 32 + 16 * n + 4 * fq) = w; } }
    }
};
struct SkQKV {
    static constexpr int MB = 4, NB = 4, NS = 3; static constexpr bool NEEDS_X = true;
    const float* ssq; const float* gq; const float* gk;
    bf16_t* QS; bf16_t* KS; size_t sstride; int srows, lc;
    float* oks; size_t osstride;
    __device__ __forceinline__ int brow(int ct, int ch, int n) const { return ct * 128 + ch * 64 + 16 * n; }
    __device__ __forceinline__ void partial(f32x4 (&acc)[MB][NB], int, int, int ch, int fr, int fq, SLAS float* red) const {
#pragma unroll
        for (int m = 0; m < MB; ++m) { float s = 0.f;
#pragma unroll
            for (int n = 0; n < NB; ++n) { const f32x4 x = acc[m][n]; s += (x[0] * x[0] + x[1] * x[1]) + (x[2] * x[2] + x[3] * x[3]); }
            s += __shfl_xor(s, 16); s += __shfl_xor(s, 32);
            if (fq == 0) red[ch * 64 + 16 * m + fr] = s; }
    }
    __device__ __forceinline__ void operator()(const f32x4 (&acc)[MB][NB], int rt, int ct, int ch, int fr, int fq, SLAS float* red) const {
        const int which = ct >> 4, h = ct & 15;
        const float* g = (which == 0 ? gq : gk) + ch * 64 + 4 * fq;
        bf16_t* b16 = (which == 0) ? QS : KS + (size_t)(which == 2 ? 1 : 0) * sstride + (size_t)lc * 128; const int rowsz = (which == 0) ? 16 : srows;
        float* b32 = oks + (size_t)(which > 0 ? which - 1 : 0) * osstride + h * 128 + ch * 64 + 4 * fq;
        float rs[MB];
        { f32x4 pa[MB], pb[MB];
#pragma unroll
          for (int m = 0; m < MB; ++m) { const float* sp = ssq + (size_t)(rt * 64 + 16 * m + fr) * 32 + fq * 8; pa[m] = *(const f32x4*)sp; pb[m] = *(const f32x4*)(sp + 4); }
#pragma unroll
          for (int m = 0; m < MB; ++m) { float s = ((pa[m][0] + pa[m][1]) + (pa[m][2] + pa[m][3])) + ((pb[m][0] + pb[m][1]) + (pb[m][2] + pb[m][3]));
              s += __shfl_xor(s, 16); s += __shfl_xor(s, 32); rs[m] = __builtin_amdgcn_rsqf(s * (1.0f / 2048.0f) + 1e-6f); } }
#pragma unroll
        for (int m = 0; m < MB; ++m) { const int r = rt * 64 + 16 * m + fr; float sc = rs[m];
            if (which < 2) { const float s = red[16 * m + fr] + red[64 + 16 * m + fr]; sc = rs[m] * __builtin_amdgcn_rsqf(s * rs[m] * rs[m] * (1.0f / 128.0f) + 1e-6f); }
            bf16_t* d16 = b16 + ((size_t)((r >> 4) * 16 + h) * rowsz + (r & 15)) * 128 + ch * 64 + 4 * fq; float* d32 = b32 + (size_t)r * 2048;
#pragma unroll
            for (int n = 0; n < NB; ++n) { f32x4 x = acc[m][n] * sc; if (which < 2) x = x * *(const f32x4*)(g + 16 * n);
                u32x2 w; w.x = cvtpk(x[0], x[1]); w.y = cvtpk(x[2], x[3]); *(u32x2*)(d16 + 16 * n) = w;
                if (which > 0) *(f32x4*)(d32 + 16 * n) = x; } }
    }
};
template <class Epi>
__device__ __forceinline__ void skinny_phase(SLAS unsigned char* lds, const bf16_t* A, const bf16_t* Bt, int nct, int K, unsigned* qc  , int tid, const Epi& E) {
    constexpr int MB = Epi::MB, NB = Epi::NB, NS = Epi::NS, NRT = 16 / MB, SLOT = MB * NB * 1024;
    const int lane = tid & 63, wid = __builtin_amdgcn_readfirstlane(tid >> 6), fr = lane & 15, fq = lane >> 4, kq = wid & 3, ch = wid >> 2;
    const int kw = K >> 2;
    SLAS float* red = (SLAS float*)(lds + 4 * SLOT);
    for (;;) {
        volatile SLAS int* tw = (volatile SLAS int*)(lds + 67712);
        if (tid == 0) *tw = (int)__hip_atomic_fetch_add(qc, 1u, __ATOMIC_RELAXED, __HIP_MEMORY_SCOPE_AGENT);
        __syncthreads();
        const int tile = __builtin_amdgcn_readfirstlane(*tw);
        if (tile >= NRT * nct) break;
        const int rt = tile % NRT, ct = tile / NRT;
        f32x4 acc[MB][NB];
#pragma unroll
        for (int m = 0; m < MB; ++m)
#pragma unroll
            for (int n = 0; n < NB; ++n) acc[m][n] = (f32x4){0.f, 0.f, 0.f, 0.f};
        const unsigned lo = (unsigned)(((lane >> 2) * K + kq * kw + (lane & 3) * 8) * 2);
        const int pidx = (((lane & 15) << 2) | (lane >> 4)) << 2;
        const char* ab = (const char*)(A + (size_t)(rt * 16 * MB) * K);
        const char* bb[NB];
#pragma unroll
        for (int n = 0; n < NB; ++n) bb[n] = (const char*)(Bt + (size_t)E.brow(ct, ch, n) * K);
        bf16x8 fa[NS][MB], fb[NS][NB];
#define SK_LOAD(st, ks) do { const unsigned o_ = lo + (unsigned)((ks) * 2); _Pragma("unroll") for (int m = 0; m < MB; ++m) fa[st][m] = *(const bf16x8*)(ab + (size_t)(o_ + (unsigned)(16 * m * K * 2))); \
            _Pragma("unroll") for (int n = 0; n < NB; ++n) fb[st][n] = *(const bf16x8*)(bb[n] + (size_t)o_); } while (0)
#define SK_PERM(v) do { u32x4 w_ = __builtin_bit_cast(u32x4, v); w_.x = (unsigned)__builtin_amdgcn_ds_bpermute(pidx, (int)w_.x); w_.y = (unsigned)__builtin_amdgcn_ds_bpermute(pidx, (int)w_.y); \
            w_.z = (unsigned)__builtin_amdgcn_ds_bpermute(pidx, (int)w_.z); w_.w = (unsigned)__builtin_amdgcn_ds_bpermute(pidx, (int)w_.w); v = __builtin_bit_cast(bf16x8, w_); } while (0)
#define SK_MMA(st) do { _Pragma("unroll") for (int m = 0; m < MB; ++m) SK_PERM(fa[st][m]); _Pragma("unroll") for (int n = 0; n < NB; ++n) SK_PERM(fb[st][n]); \
            _Pragma("unroll") for (int m = 0; m < MB; ++m) _Pragma("unroll") for (int n = 0; n < NB; ++n) acc[m][n] = __builtin_amdgcn_mfma_f32_16x16x32_bf16(fb[st][n], fa[st][m], acc[m][n], 0, 0, 0); } while (0)
#define SK_SB() __builtin_amdgcn_sched_barrier(0)
        const int nst = kw >> 5, kl = kw - 32;
#pragma unroll
        for (int j = 0; j < NS - 1; ++j) { SK_LOAD(j, (j * 32 < kw ? j * 32 : kl)); SK_SB(); }
        for (int s0 = 0; s0 < nst; s0 += NS) {
#pragma unroll
            for (int j = 0; j < NS; ++j) { const int kn = (s0 + j + NS - 1) * 32; SK_LOAD((j + NS - 1) % NS, kn < kw ? kn : kl); SK_SB(); if (s0 + j < nst) SK_MMA(j); SK_SB(); }
        }
#undef SK_SB
#undef SK_LOAD
#undef SK_MMA
#undef SK_PERM
#pragma unroll
        for (int half = 2; half >= 1; half >>= 1) {
            if (kq >= half && kq < 2 * half) { SLAS f32x4* s = (SLAS f32x4*)(lds + (ch * 2 + kq - half) * SLOT) + lane;
#pragma unroll
                for (int m = 0; m < MB; ++m)
#pragma unroll
                    for (int n = 0; n < NB; ++n) s[(m * NB + n) * 64] = acc[m][n]; }
            __syncthreads();
            if (kq < half) { const SLAS f32x4* s = (const SLAS f32x4*)(lds + (ch * 2 + kq) * SLOT) + lane;
#pragma unroll
                for (int m = 0; m < MB; ++m)
#pragma unroll
                    for (int n = 0; n < NB; ++n) acc[m][n] = acc[m][n] + s[(m * NB + n) * 64]; }
            __syncthreads();
        }
        if constexpr (Epi::NEEDS_X) { if (kq == 0) E.partial(acc, rt, ct, ch, fr, fq, red); __syncthreads(); }
        if (kq == 0) E(acc, rt, ct, ch, fr, fq, red);
        if constexpr (Epi::NEEDS_X) __syncthreads();
    }
}
}

namespace att {
typedef short bf16x8 __attribute__((ext_vector_type(8)));
typedef short s16x4 __attribute__((ext_vector_type(4)));
typedef float f32x16 __attribute__((ext_vector_type(16)));
typedef float f32x4 __attribute__((ext_vector_type(4)));
typedef unsigned u32x4 __attribute__((ext_vector_type(4)));
typedef unsigned short bf16;
#define ALAS __attribute__((address_space(3)))
constexpr int D = 128, NW = 8, QBLK = 32, KVBLK = 64, QB = NW * QBLK;
constexpr int SHM_V = KVBLK * D * 2, SHM_K = KVBLK * D * 2;
constexpr int OFF_V = 0, OFF_K = 2 * SHM_V, OFF_WS = 2 * SHM_V + 2 * SHM_K, OFF_TAB = OFF_WS + NW * 64 * 4, OFF_BIAS = OFF_TAB + 1024, LDS_END = OFF_BIAS + 8192 * 4 + 512;
constexpr float SCALE = 0.08838834764831845f, RSCALE = 11.313708498984761f;
constexpr float THR = 8.f;
#define KSWZ(row, colB) ((row) * 256 + ((colB) ^ (((row) & 7) << 4)))
#define SBAR() __builtin_amdgcn_sched_barrier(0)
__device__ __forceinline__ int v_st(int k, int c) { const int kk = (k & ~0xC) | ((k & 4) << 1) | ((k & 8) >> 1); return ((kk >> 3) * 4 + (c >> 5)) * 512 + ((kk & 7) * 32 + (c & 31)) * 2; }
__device__ __forceinline__ int v_rd_base(int lane) { return ((lane & 3) << 3) | (((lane >> 2) & 3) << 6) | (((lane >> 4) & 1) << 5) | (((lane >> 5) & 1) << 8); }
constexpr int v_rd_off(int d0, int ks, int half) { return d0 * 512 + ks * 4096 + half * 2048; }
__device__ __forceinline__ int crow(int r, int hi) { return (r & 3) + 8 * (r >> 2) + 4 * hi; }
__device__ __forceinline__ unsigned cvtpk(float lo, float hi) { unsigned r; asm volatile("v_cvt_pk_bf16_f32 %0, %1, %2" : "=v"(r) : "v"(lo), "v"(hi)); return r; }
__device__ __forceinline__ bf16x8 load8(const bf16* p) { return *reinterpret_cast<const bf16x8*>(p); }
__device__ __forceinline__ void mask_tile(f32x16& p0, f32x16& p1, int dq) {
    const float NEG = -__builtin_inff();
#pragma unroll
    for (int r = 0; r < 16; ++r) {
        const int c = (r & 3) + 8 * (r >> 2);
        if (dq - c < 0) p0[r] = NEG;
        if (dq - c - 32 < 0) p1[r] = NEG;
    }
}
__device__ __forceinline__ void partialSM(f32x16& p0, f32x16& p1, float& m_reg, float& mn, float& alpha) {
    float pmax = p0[0]; for (int r = 1; r < 16; ++r) pmax = fmaxf(pmax, p0[r]); for (int r = 0; r < 16; ++r) pmax = fmaxf(pmax, p1[r]);
    { auto rr = __builtin_amdgcn_permlane32_swap(__float_as_uint(pmax), __float_as_uint(pmax), false, false);
      pmax = fmaxf(__uint_as_float(rr[0]), __uint_as_float(rr[1])); }
    constexpr float C2 = 1.4426950408889634f * SCALE;
    if (__builtin_expect(__all((pmax - m_reg) * SCALE <= THR), 1)) { mn = m_reg; alpha = 1.f; }
    else { mn = fmaxf(m_reg, pmax); alpha = __builtin_amdgcn_exp2f((m_reg - mn) * C2); m_reg = mn; }
    const float mnL = -mn * C2;
    for (int r = 0; r < 16; ++r) p0[r] = fmaf(p0[r], C2, mnL); for (int r = 0; r < 16; ++r) p1[r] = fmaf(p1[r], C2, mnL);
    for (int r = 0; r < 16; ++r) p0[r] = __builtin_amdgcn_exp2f(p0[r]);
}
__device__ __forceinline__ void finishSM(f32x16& p0, f32x16& p1, float alpha, float& l_reg, bf16x8& pa0, bf16x8& pa1, bf16x8& pa2, bf16x8& pa3) {
    for (int r = 0; r < 16; ++r) p1[r] = __builtin_amdgcn_exp2f(p1[r]);
    float ps = 0; for (int r = 0; r < 16; ++r) ps += p0[r]; for (int r = 0; r < 16; ++r) ps += p1[r];
    { auto rr = __builtin_amdgcn_permlane32_swap(__float_as_uint(ps), __float_as_uint(ps), false, false);
      ps = __uint_as_float(rr[0]) + __uint_as_float(rr[1]); }
    l_reg = l_reg * alpha + ps;
#define PK4(P, B_, OUT) do { unsigned a0 = cvtpk(P[B_+0], P[B_+1]), a1 = cvtpk(P[B_+2], P[B_+3]);                          \
        unsigned b0 = cvtpk(P[B_+4], P[B_+5]), b1 = cvtpk(P[B_+6], P[B_+7]);                                             \
        auto r0 = __builtin_amdgcn_permlane32_swap(a0, b0, false, false); auto r1 = __builtin_amdgcn_permlane32_swap(a1, b1, false, false); \
        u32x4 w = {r0[0], r1[0], r0[1], r1[1]}; OUT = *reinterpret_cast<bf16x8*>(&w); } while (0)
    PK4(p0, 0, pa0); PK4(p0, 8, pa1); PK4(p1, 0, pa2); PK4(p1, 8, pa3);
#undef PK4
}
struct Blk {
    const bf16* Q; const bf16* K; const bf16* V; bf16* O;
    const float* aux;
    int P0;
    int jlo, jhi;
    int cap;
    int c0;
    float skipthr;
};
struct Nxt { const bf16* Q; const bf16* K; const bf16* V; int jlo; };
constexpr int OSTR = 2048;
struct Seam { bf16x8 qr[8]; bf16x8 st_v0, st_v1, st_k0, st_k1; };

template <int MODE, int KB>
__device__ __forceinline__ void qkt(f32x16& p0, f32x16& p1, ALAS const char* lds, int r32, int hi, const bf16x8* qr, bool act, int tile  , int dist  , int irow  ) {
    if (!act) { const float NEG = -__builtin_inff();
#pragma unroll
        for (int r = 0; r < 16; ++r) { p0[r] = NEG; p1[r] = NEG; } return; }
    if constexpr (MODE == 1) {
        ALAS const float* bp = (ALAS const float*)(lds + OFF_BIAS) + tile * 64 + 4 * hi;
#pragma unroll
        for (int i = 0; i < 4; ++i) { const f32x4 a = *(ALAS const f32x4*)(bp + 8 * i), b = *(ALAS const f32x4*)(bp + 32 + 8 * i);
            p0[4 * i] = a[0]; p0[4 * i + 1] = a[1]; p0[4 * i + 2] = a[2]; p0[4 * i + 3] = a[3]; p1[4 * i] = b[0]; p1[4 * i + 1] = b[1]; p1[4 * i + 2] = b[2]; p1[4 * i + 3] = b[3]; }
    } else {
        ALAS const float* R = (ALAS const float*)(lds + OFF_TAB);
        if (dist <= 2) { ALAS const float* rp = R + (191 - 64 * dist - irow + 4 * hi);
#pragma unroll
            for (int r = 0; r < 16; ++r) { p0[r] = rp[(r & 3) + 8 * (r >> 2)]; p1[r] = rp[32 + (r & 3) + 8 * (r >> 2)]; } }
        else { const float cf = R[0];
#pragma unroll
            for (int r = 0; r < 16; ++r) { p0[r] = cf; p1[r] = cf; } }
    }
    ALAS const char* K_lds = lds + OFF_K;
    ALAS const char* kb[4];
#pragma unroll
    for (int dd = 0; dd < 4; ++dd) kb[dd] = K_lds + KB * SHM_K + KSWZ(r32, (dd * 16 + hi * 8) * 2);
#pragma unroll
    for (int d0 = 0; d0 < 8; ++d0) { ALAS const char* a = kb[d0 & 3] + (d0 >> 2) * 128;
        bf16x8 b0 = *reinterpret_cast<ALAS const bf16x8*>(a);
        bf16x8 b1 = *reinterpret_cast<ALAS const bf16x8*>(a + 32 * 256);
        p0 = __builtin_amdgcn_mfma_f32_32x32x16_bf16(b0, qr[d0], p0, 0, 0, 0);
        p1 = __builtin_amdgcn_mfma_f32_32x32x16_bf16(b1, qr[d0], p1, 0, 0, 0); }
}
template <int MODE, int VB>
__device__ __forceinline__ void pv_tile(f32x16* o, int vb0, bf16x8 pa0, bf16x8 pa1, bf16x8 pa2, bf16x8 pa3, bool act) {
    if (!act) return;
#define TRRD(dst, off) asm volatile("ds_read_b64_tr_b16 %0, %1 offset:%2" : "=&v"(dst) : "v"(vb0), "i"(off) : "memory")
#define PV_D0(d0) do { s16x4 l0, l1, l2, l3, h0, h1, h2, h3; constexpr int b_ = VB * SHM_V + v_rd_off(d0, 0, 0); \
        TRRD(l0, b_); TRRD(h0, b_ + 2048); TRRD(l1, b_ + 4096); TRRD(h1, b_ + 6144); TRRD(l2, b_ + 8192); TRRD(h2, b_ + 10240); TRRD(l3, b_ + 12288); TRRD(h3, b_ + 14336); \
        asm volatile("s_waitcnt lgkmcnt(0)" ::: "memory"); SBAR();   \
        o[d0] = __builtin_amdgcn_mfma_f32_32x32x16_bf16(pa0, (bf16x8){l0[0], l0[1], l0[2], l0[3], h0[0], h0[1], h0[2], h0[3]}, o[d0], 0, 0, 0);   \
        o[d0] = __builtin_amdgcn_mfma_f32_32x32x16_bf16(pa1, (bf16x8){l1[0], l1[1], l1[2], l1[3], h1[0], h1[1], h1[2], h1[3]}, o[d0], 0, 0, 0);   \
        o[d0] = __builtin_amdgcn_mfma_f32_32x32x16_bf16(pa2, (bf16x8){l2[0], l2[1], l2[2], l2[3], h2[0], h2[1], h2[2], h2[3]}, o[d0], 0, 0, 0);   \
        o[d0] = __builtin_amdgcn_mfma_f32_32x32x16_bf16(pa3, (bf16x8){l3[0], l3[1], l3[2], l3[3], h3[0], h3[1], h3[2], h3[3]}, o[d0], 0, 0, 0); } while (0)
    PV_D0(0); PV_D0(1); PV_D0(2); PV_D0(3);
#undef PV_D0
#undef TRRD
}
#define AROW(p, k0, rr) ((const bf16*)((const char*)(p) + (size_t)(unsigned)(((k0) + (rr)) * (D * 2) + sc * 2)))
#define VMW() asm volatile("s_waitcnt vmcnt(0)" ::: "memory")
#define VMWN(n) asm volatile("s_waitcnt vmcnt(%0)" :: "i"(n) : "memory")
#define SLOAD_H(Kp, Vp, k0) do { S.st_v0 = load8(AROW(Vp, k0, sr)); S.st_v1 = load8(AROW(Vp, k0, 32 + sr));              \
                         S.st_k0 = load8(AROW(Kp, k0, sr)); S.st_k1 = load8(AROW(Kp, k0, 32 + sr)); } while (0)
#define SWRITE_HK(bf) do { *(ALAS bf16x8*)(K_lds + (bf) * SHM_K + kws) = S.st_k0; *(ALAS bf16x8*)(K_lds + (bf) * SHM_K + kws + 32 * 256) = S.st_k1; } while (0)
#define SWRITE_HV(bf) do { *(ALAS bf16x8*)(V_lds + (bf) * SHM_V + vst0) = S.st_v0; *(ALAS bf16x8*)(V_lds + (bf) * SHM_V + vst1) = S.st_v1; } while (0)
#define SWRITE_H(bf) do { SWRITE_HV(bf); SWRITE_HK(bf); } while (0)
template <int MODE>
__device__ __forceinline__ float build_bias(const Blk& b, ALAS char* lds, int tid) {
    asm volatile("" : "+v"(tid));
    if constexpr (MODE == 0) {
        if (tid < 256) { int d = 191 - tid; d = d < -128 ? -128 : (d > 128 ? 128 : d); ((ALAS float*)(lds + OFF_TAB))[tid] = b.aux[d + 128] * RSCALE; }
        return 0.f;
    } else {
        const int nk = b.jhi * 64, nv = b.cap + 1, e0 = tid * 16, lane = tid & 63, wid = tid >> 6;
        float v[16];
#pragma unroll
        for (int i = 0; i < 4; ++i) { f32x4 x = (f32x4){0.f, 0.f, 0.f, 0.f};
            if (e0 + 4 * i < nv) x = *(const f32x4*)(b.aux + e0 + 4 * i);
            v[4 * i] = x[0]; v[4 * i + 1] = x[1]; v[4 * i + 2] = x[2]; v[4 * i + 3] = x[3]; }
        float run = 0.f;
#pragma unroll
        for (int i = 15; i >= 0; --i) { const float x = v[i]; v[i] = run; run += x; }
        float incl = run;
#pragma unroll
        for (int o = 1; o < 64; o <<= 1) { const float t = __int_as_float(__builtin_amdgcn_ds_bpermute(((lane + o) & 63) << 2, __float_as_int(incl))); if (lane + o < 64) incl += t; }
        ALAS float* wt = (ALAS float*)(lds + OFF_TAB);
        if (lane == 0) wt[wid] = incl;
        asm volatile("s_waitcnt lgkmcnt(0)" ::: "memory"); __builtin_amdgcn_s_barrier(); asm volatile("" ::: "memory");
        float after = incl - run;
#pragma unroll
        for (int w = 1; w < 8; ++w) { const float t = wt[w]; if (w > wid) after += t; }
        if (e0 < nk) { ALAS f32x4* o4 = (ALAS f32x4*)(lds + OFF_BIAS) + tid * 4;
#pragma unroll
            for (int i = 0; i < 4; ++i) o4[i] = (f32x4){(v[4 * i] + after) * RSCALE, (v[4 * i + 1] + after) * RSCALE, (v[4 * i + 2] + after) * RSCALE, (v[4 * i + 3] + after) * RSCALE}; }
        return after;
    }
}
template <int MODE>
__device__ __forceinline__ void attn_prime(const Blk& cur, ALAS char* lds, Seam& S, int tid) {
    asm volatile("" : "+v"(tid));
    const int wid = __builtin_amdgcn_readfirstlane(tid >> 6), lane = tid & 63, r32 = lane & 31, hi = lane >> 5;
    const int sr = tid >> 4, sc = (tid & 15) * 8, kws = KSWZ(sr, sc * 2); ALAS char* K_lds = lds + OFF_K;
    const int kb0 = cur.jlo * KVBLK;
    const int qrow = wid * QBLK + r32;
#pragma unroll
    for (int d0 = 0; d0 < 8; ++d0) S.qr[d0] = load8((const bf16*)((const char*)cur.Q + (size_t)(unsigned)(qrow * (D * 2) + hi * 16 + d0 * 32)));
    SLOAD_H(cur.K, cur.V, kb0); VMW(); SWRITE_HK(0);
    __syncthreads();
}
template <int MODE, class IssueFn, class NextFn>
__device__ __forceinline__ void attn_block(const Blk& cur, IssueFn&& issue_fn, NextFn&& next_fn, ALAS char* lds, Seam& S, int tid) {
    asm volatile("" : "+v"(tid));
    const int wid = __builtin_amdgcn_readfirstlane(tid >> 6), lane = tid & 63, r32 = lane & 31, hi = lane >> 5;
    bf16x8 kd[8];
    if constexpr (MODE == 1) { const char* kp = (const char*)cur.K + (size_t)(unsigned)((cur.P0 + wid * QBLK + r32) * (D * 2) + hi * 16);
#pragma unroll
        for (int d0 = 0; d0 < 8; ++d0) kd[d0] = load8((const bf16*)(kp + d0 * 32)); }
    const float s_end = build_bias<MODE>(cur, lds, tid);
    asm volatile("s_waitcnt lgkmcnt(0)" ::: "memory"); __syncthreads();
    int j_lo = cur.jlo;
    const int sr = tid >> 4, sc = (tid & 15) * 8, vst0 = v_st(sr, sc), vst1 = v_st(32 + sr, sc), kws = KSWZ(sr, sc * 2);
    ALAS char* V_lds = lds + OFF_V; ALAS char* K_lds = lds + OFF_K;
    if constexpr (MODE == 1) {
        float dsum = 0.f;
#pragma unroll
        for (int d0 = 0; d0 < 8; ++d0) { const u32x4 qa = *reinterpret_cast<const u32x4*>(&S.qr[d0]), ka = *reinterpret_cast<const u32x4*>(&kd[d0]);
#pragma unroll
            for (int i = 0; i < 4; ++i) { dsum = fmaf(__uint_as_float(qa[i] << 16), __uint_as_float(ka[i] << 16), dsum);
                dsum = fmaf(__uint_as_float(qa[i] & 0xffff0000u), __uint_as_float(ka[i] & 0xffff0000u), dsum); } }
        { auto rr = __builtin_amdgcn_permlane32_swap(__float_as_uint(dsum), __float_as_uint(dsum), false, false); dsum = __uint_as_float(rr[0]) + __uint_as_float(rr[1]); }
        float gv = (((ALAS const float*)(lds + OFF_BIAS))[cur.P0 + wid * QBLK + r32] + dsum) * SCALE;
#pragma unroll
        for (int o = 1; o < 32; o <<= 1) gv = fminf(gv, __shfl_xor(gv, o));
        ALAS float* wg = (ALAS float*)(lds + OFF_TAB) + 32;
        if (lane == 0) wg[wid] = gv;
        asm volatile("s_waitcnt lgkmcnt(0)" ::: "memory"); __builtin_amdgcn_s_barrier(); asm volatile("" ::: "memory");
        float G = wg[0];
#pragma unroll
        for (int w = 1; w < 8; ++w) G = fminf(G, wg[w]);
        const bool pred = ((tid & 3) == 3) && ((tid >> 2) < (cur.P0 >> 6)) && (s_end < G - cur.skipthr);
        const int cnt = __builtin_popcountll(__ballot(pred));
        ALAS int* wcnt = (ALAS int*)(lds + OFF_TAB) + 16;
        if (lane == 0) wcnt[wid] = cnt;
        asm volatile("s_waitcnt lgkmcnt(0)" ::: "memory"); __builtin_amdgcn_s_barrier(); asm volatile("" ::: "memory");
        int tot = 0;
#pragma unroll
        for (int w = 0; w < 8; ++w) tot += wcnt[w];
        j_lo = __builtin_amdgcn_readfirstlane(tot);
        if (j_lo != cur.jlo) {
            SLOAD_H(cur.K, cur.V, j_lo * KVBLK); VMW(); SWRITE_HK(0); }
        __syncthreads();
    }
    const int NT = cur.jhi - j_lo;
    const int wlim = cur.P0 + wid * QBLK;
    const int qm = wlim + r32 - 4 * hi;
    const int cw = cur.c0 + (wid >> 1);
    const int irow = (wid & 1) * 32 + r32;
    ALAS float* wsf = (ALAS float*)(lds + OFF_WS) + wid * 64; ALAS float* li_l = wsf; ALAS float* al_l = wsf + 32;
    float m_reg = -1e30f, l_reg = 0; f32x16 o[4] = {};
    const int vb0 = (int)(unsigned)(unsigned long long)V_lds + v_rd_base(lane);
    const bf16* Kh = cur.K; const bf16* Vh = cur.V;
#define RESC(a) do { if (__any((a) < 1.f)) { if (hi == 0) al_l[r32] = (a); asm volatile("s_waitcnt lgkmcnt(0)" ::: "memory");              \
                     for (int d_ = 0; d_ < 4; ++d_) for (int r = 0; r < 16; ++r) o[d_][r] *= al_l[crow(r, hi)]; } } while (0)
#define KBASE(t) ((j_lo + (t)) * KVBLK)
#define ACT(t) (MODE == 1 ? (KBASE(t) <= wlim + QBLK - 1) : ((j_lo + (t)) >= cw - 8 && (j_lo + (t)) <= cw))
#define MASKT(P0_, P1_, t) do { if (MODE == 1) { const int kb_ = KBASE(t); if (kb_ + KVBLK - 1 > wlim) mask_tile(P0_, P1_, qm - kb_); } } while (0)
#define QKT(KB, PX0, PX1, t) qkt<MODE, KB>(PX0, PX1, lds, r32, hi, S.qr, ACT(t), j_lo + (t), cw - (j_lo + (t)), irow)
    constexpr int NQL = 8;
#define SEAM_K0() do { VMWN(NQL); SWRITE_HK(0); SBAR(); } while (0)
    f32x16 pA0, pA1, pB0, pB1; float mnA, mnB, alA, alB; bf16x8 pa0, pa1, pa2, pa3;
    SWRITE_HV(0); SBAR();
    if (NT > 1) SLOAD_H(Kh, Vh, KBASE(1));
    SBAR(); QKT(0, pA0, pA1, 0);
    MASKT(pA0, pA1, 0); partialSM(pA0, pA1, m_reg, mnA, alA);
    if (NT > 1) { VMW(); SWRITE_H(1); }
    __syncthreads();
#define HALF_STEP(PX0, PX1, mnX, alX, PY0, PY1, alY, t, KB, VB, SB) do {                                                      \
        SBAR(); QKT(KB, PX0, PX1, t);                                                                                          \
        finishSM(PY0, PY1, alY, l_reg, pa0, pa1, pa2, pa3); SBAR();                                                           \
        if ((t) + 1 < NT) { SLOAD_H(Kh, Vh, KBASE((t) + 1)); SBAR(); }                                                        \
        pv_tile<MODE, VB>(o, vb0, pa0, pa1, pa2, pa3, ACT((t) - 1)); MASKT(PX0, PX1, (t)); partialSM(PX0, PX1, m_reg, mnX, alX);   \
        __syncthreads();                                                                                                      \
        if ((t) + 1 < NT) { VMW(); SWRITE_H(SB); }                                                                            \
        RESC(alX); __syncthreads(); } while (0)
    if (NT < 3) issue_fn();
    for (int t = 1; t + 1 < NT; t += 2) {
        if (t + 3 >= NT) issue_fn();
        HALF_STEP(pB0, pB1, mnB, alB, pA0, pA1, alA, t, 1, 0, 0);
        HALF_STEP(pA0, pA1, mnA, alA, pB0, pB1, alB, t + 1, 0, 1, 1);
    }
    Nxt nxt; next_fn(nxt);
    const int kbn = nxt.jlo * KVBLK;
    const bool even = (NT & 1) == 0;
    if (even) { SBAR(); QKT(1, pB0, pB1, NT - 1); SBAR(); }
    SLOAD_H(nxt.K, nxt.V, kbn); SBAR();
    { const int qrow = wid * QBLK + r32;
#pragma unroll
      for (int d0 = 0; d0 < 8; ++d0) S.qr[d0] = load8((const bf16*)((const char*)nxt.Q + (size_t)(unsigned)(qrow * (D * 2) + hi * 16 + d0 * 32))); }
    SBAR();
    finishSM(pA0, pA1, alA, l_reg, pa0, pa1, pa2, pa3); SBAR();
    pv_tile<MODE, 0>(o, vb0, pa0, pa1, pa2, pa3, ACT(even ? NT - 2 : NT - 1));
    if (even) { MASKT(pB0, pB1, NT - 1); partialSM(pB0, pB1, m_reg, mnB, alB); __syncthreads(); RESC(alB);
        finishSM(pB0, pB1, alB, l_reg, pa0, pa1, pa2, pa3); SBAR(); pv_tile<MODE, 1>(o, vb0, pa0, pa1, pa2, pa3, ACT(NT - 1)); }
    SBAR(); SEAM_K0();
    __syncthreads();
    if (hi == 0) li_l[r32] = l_reg; asm volatile("s_waitcnt lgkmcnt(0)" ::: "memory");
    float rli[16];
#pragma unroll
    for (int r = 0; r < 16; ++r) rli[r] = __builtin_amdgcn_rcpf(li_l[crow(r, hi)]);
    ALAS char* stg = lds + OFF_V + wid * 4096 + (4 * hi) * 128 + r32 * 2;
    ALAS const char* srd = lds + OFF_V + wid * 4096 + (lane >> 3) * 128 + (lane & 7) * 16;
    unsigned ooff = (unsigned)(((wid * QBLK + (lane >> 3)) * OSTR + (lane & 7) * 8) * 2);
    asm volatile("" : "+v"(ooff));
#pragma unroll
    for (int ps = 0; ps < 2; ++ps) {
#pragma unroll
        for (int dd = 0; dd < 2; ++dd)
#pragma unroll
            for (int r = 0; r < 16; r += 2) { const unsigned w = cvtpk(o[2 * ps + dd][r] * rli[r], o[2 * ps + dd][r + 1] * rli[r + 1]);
                ALAS char* a = stg + ((r & 3) + 8 * (r >> 2)) * 128 + dd * 64;
                *(ALAS unsigned short*)a = (unsigned short)w; *(ALAS unsigned short*)(a + 128) = (unsigned short)(w >> 16); }
        asm volatile("s_waitcnt lgkmcnt(0)" ::: "memory");
        u32x4 q[4];
#pragma unroll
        for (int i = 0; i < 4; ++i) q[i] = *(ALAS const u32x4*)(srd + i * 1024);
        asm volatile("s_waitcnt lgkmcnt(0)" ::: "memory");
#pragma unroll
        for (int i = 0; i < 4; ++i) *(u32x4*)((char*)cur.O + (size_t)(ooff + (unsigned)(i * 8 * OSTR * 2 + ps * 128))) = q[i];
    }
    __syncthreads();
#undef RESC
#undef KBASE
#undef ACT
#undef MASKT
#undef QKT
#undef SEAM_K0
#undef HALF_STEP
}
#undef AROW
#undef VMW
#undef VMWN
#undef SLOAD_H
#undef SWRITE_HK
#undef SWRITE_HV
#undef SWRITE_H
}

constexpr int NWAVES = 8;
constexpr int NB = 2, T = 8192, D = 2048, NH = 16, HD = 128, FF = 5632, DEPTH = 4;
constexpr int SB = 16, SN = 16, PAST = 1024, WIN = 512, NREL = 257;
constexpr int MP = NB * T, MS = SB * SN, M = MP + MS;
constexpr int NQKV = 3 * D, NGU = 2 * FF;
constexpr int LS = PAST + SN;
constexpr float EPS = 1e-6f, SCALE = 0.08838834764831845f;
constexpr size_t O_Y = 0, O_YS = (size_t)MP * D, O_AKP = O_YS + (size_t)MS * D, SZ_AP = (size_t)2 * NB * WIN * D, O_AVP = O_AKP + SZ_AP, O_BKP = O_AVP + SZ_AP,
    SZ_BP = (size_t)2 * MP * D, O_BVP = O_BKP + SZ_BP, O_BFP = O_BVP + SZ_BP, SZ_BFP = (size_t)2 * MP * NH, O_AKS = O_BFP + SZ_BFP, SZ_S = (size_t)2 * MS * D,
    O_AVS = O_AKS + SZ_S, O_BKS = O_AVS + SZ_S, O_BVS = O_BKS + SZ_S, O_BFS = O_BVS + SZ_S, OUT_TOTAL = O_BFS + (size_t)2 * MS * NH;
static_assert(OUT_TOTAL == 181411840, "out size");
constexpr size_t MiB = 1u << 20;
constexpr size_t WS_CTL = 0, CTL_ZERO_BYTES = 1 * MiB;
constexpr size_t WS_WQKV = 2 * MiB, WS_WO = 98 * MiB, WS_WGU = 130 * MiB, WS_WD = 306 * MiB;
constexpr size_t WS_XB = 394 * MiB, WS_SSQ = 459 * MiB;
constexpr size_t WS_QP = 462 * MiB, WS_KP = 526 * MiB, WS_VP = 590 * MiB;
constexpr size_t WS_QS = 654 * MiB;
constexpr size_t WS_OB = 655 * MiB, WS_HB = 720 * MiB;
constexpr size_t WS_KSN = 899 * MiB, WS_VSN = 900 * MiB;
constexpr size_t WS_LFP = 1315 * MiB, WS_WF = 1316 * MiB  , WS_LFS = 1317 * MiB, WS_CUMS = 1319 * MiB, WS_END = 1321 * MiB;
static_assert(WS_WQKV + (size_t)DEPTH * NQKV * D * 2 <= WS_WO && WS_WO + (size_t)DEPTH * D * D * 2 <= WS_WGU && WS_WGU + (size_t)DEPTH * NGU * D * 2 <= WS_WD && WS_WD + (size_t)DEPTH * D * FF * 2 <= WS_XB, "ws map: weights");
static_assert(WS_XB + (size_t)M * D * 2 <= WS_SSQ && WS_SSQ + (size_t)M * 32 * 4 <= WS_QP && WS_OB + (size_t)M * D * 2 <= WS_HB && WS_HB + (size_t)M * FF * 2 <= WS_KSN, "ws map: activations");
constexpr int CW_BAR = 4096, CW_QUEUE = 8192, CW_SKQ = 8192 + 256;
constexpr size_t WS_QKM = WS_WF + 512 * 1024;
constexpr int RING_OFF = 0, RING_BYTES = 131072;
constexpr int LDSCTL_OFF = RING_BYTES, MISC_OFF = LDSCTL_OFF + 320, RED_OFF = LDSCTL_OFF + 1024;
constexpr int LDS_BYTES = 147456;
#define GAS __attribute__((address_space(1)))
#define LAS __attribute__((address_space(3)))
typedef unsigned short bf16;
typedef unsigned v4u __attribute__((ext_vector_type(4)));
typedef float f32x4 __attribute__((ext_vector_type(4)));
typedef short bf16x8 __attribute__((ext_vector_type(8)));
typedef GAS unsigned gu32;
typedef GAS unsigned long long gu64;
#define RLX_AGENT __ATOMIC_RELAXED, __HIP_MEMORY_SCOPE_AGENT
#define LDS_WAIT() asm volatile("s_waitcnt lgkmcnt(0)" ::: "memory")
#define VM_WAIT() asm volatile("s_waitcnt vmcnt(0)" ::: "memory")
__device__ __forceinline__ unsigned long long rt() { return __builtin_amdgcn_s_memrealtime(); }
__device__ __forceinline__ unsigned f2bf(float f) { unsigned u = __builtin_bit_cast(unsigned, f); return (u + 0x7fffu + ((u >> 16) & 1u)) >> 16; }
__device__ __forceinline__ unsigned pk2(float lo, float hi) { return f2bf(lo) | (f2bf(hi) << 16); }

#define XB_TMO      128
#define XB_XCNT(j)  (256  + 64 * (j))
#define XB_XSUB(j)  (1280 + 64 * (j))
#define XB_XGEN(j)  (2304 + 64 * (j))
#define XB_TOP      3328
#define XB_TOPGEN   3392
#define XCD_BAR_WORDS 3456
#define XB_SPIN_CAP (1u << 22)

__device__ __forceinline__ unsigned xb_ld(unsigned* p)              { return __hip_atomic_load(p, __ATOMIC_RELAXED, __HIP_MEMORY_SCOPE_AGENT); }
__device__ __forceinline__ unsigned xb_add(unsigned* p, unsigned v) { return __hip_atomic_fetch_add(p, v, __ATOMIC_RELAXED, __HIP_MEMORY_SCOPE_AGENT); }
__device__ __forceinline__ unsigned xb_xcc_id() { return (unsigned)__builtin_amdgcn_s_getreg((3 << 11) | 20) & 0xFu; }
#define XB_SPIN(cond, bar) do { unsigned _sp = 0; while (cond) { __builtin_amdgcn_s_sleep(1); \
    if ((++_sp & 255u) == 0u) { if (xb_ld(&(bar)[XB_TMO])) break; if (_sp > XB_SPIN_CAP) { atomicAdd(&(bar)[XB_TMO], 1u); break; } } } } while (0)

struct XcdBarrier {
    unsigned* bar; unsigned x;
    volatile LAS unsigned* st;
};

__device__ __forceinline__ XcdBarrier xcd_barrier_post(unsigned* bar, volatile LAS unsigned* st, const bool leader  ) {
    XcdBarrier b; b.bar = bar; b.x = xb_xcc_id(); b.st = st;
    if (leader) (void)xb_add(&bar[XB_XCNT(b.x)], 1u);
    return b;
}
__device__ __forceinline__ void xcd_barrier_complete(unsigned* bar, unsigned x, unsigned& nloc, unsigned& nx) {
    const unsigned G = gridDim.x * gridDim.y * gridDim.z;
    unsigned sum, cnt, mine, sp = 0u;
    for (;;) {
        sum = 0u; cnt = 0u; mine = 0u;
#pragma unroll
        for (unsigned j = 0; j < 16; ++j) { const unsigned c = xb_ld(&bar[XB_XCNT(j)]); sum += c; cnt += (c > 0u) ? 1u : 0u; mine = (j == x) ? c : mine; }
        if (sum == G) break;
        __builtin_amdgcn_s_sleep(1);
        if ((++sp & 255u) == 0u) { if (xb_ld(&bar[XB_TMO])) break; if (sp > XB_SPIN_CAP) { atomicAdd(&bar[XB_TMO], 1u); break; } }
    }
    nloc = mine > 0u ? mine : 1u; nx = cnt > 0u ? cnt : 1u;
}

__device__ __forceinline__ void xcd_barrier(const XcdBarrier& b, const bool leader  ) {
    asm volatile("s_waitcnt vmcnt(0)" ::: "memory");
    __syncthreads();
    if (leader) {
        unsigned* bar = b.bar;
        __builtin_amdgcn_s_waitcnt(0);
        unsigned nloc = b.st[0], nx = b.st[1];
        if (nloc == 0u) { xcd_barrier_complete(bar, b.x, nloc, nx); b.st[0] = nloc; b.st[1] = nx; }
        const unsigned old = xb_add(&bar[XB_XSUB(b.x)], 1u);
        const unsigned gen = old / nloc;
        if (old + 1u == (gen + 1u) * nloc) {
            __builtin_amdgcn_fence(__ATOMIC_RELEASE, "agent");
            asm volatile("s_waitcnt vmcnt(0)" ::: "memory");
            const unsigned og = xb_add(&bar[XB_TOP], 1u);
            const unsigned tg = og / nx;
            if (og + 1u == (tg + 1u) * nx) xb_add(&bar[XB_TOPGEN], 1u);
            else XB_SPIN(xb_ld(&bar[XB_TOPGEN]) == tg, bar);
            __builtin_amdgcn_fence(__ATOMIC_ACQUIRE, "agent");
            xb_add(&bar[XB_XGEN(b.x)], 1u);
            asm volatile("s_waitcnt vmcnt(0)" ::: "memory");
        } else {
            XB_SPIN(xb_ld(&bar[XB_XGEN(b.x)]) == gen, bar);
            __builtin_amdgcn_fence(__ATOMIC_ACQUIRE, "agent");
            asm volatile("s_waitcnt vmcnt(0)" ::: "memory");
        }
    }
    __syncthreads();
}

typedef float f32x2 __attribute__((ext_vector_type(2)));
__device__ __forceinline__ float wave_sum(float v) {
#pragma unroll
    for (int o = 1; o < 64; o <<= 1) v += __shfl_xor(v, o);
    return v;
}
__device__ __forceinline__ float bf2f(unsigned b) { return __uint_as_float(b << 16); }

__device__ __forceinline__ void p0_transpose_item(const float* W, const float* g, int K, int N, bf16* WT, int mode, LAS float* scr, int item, int lane) {
    const int nblk = N / 32, kb = item / nblk, nb = item % nblk, k0 = 64 * kb, n0 = 32 * nb;
    const int kr = lane >> 3, nc = (lane & 7) * 4;
    f32x4 v[8]; float gs[8];
#pragma unroll
    for (int i = 0; i < 8; ++i) { v[i] = *(const GAS f32x4*)(W + (size_t)(k0 + kr + 8 * i) * N + n0 + nc); gs[i] = g ? g[k0 + kr + 8 * i] : 1.f; }
#pragma unroll
    for (int i = 0; i < 8; ++i) { LAS float* s = scr + (kr + 8 * i) * 33 + nc; s[0] = v[i].x * gs[i]; s[1] = v[i].y * gs[i]; s[2] = v[i].z * gs[i]; s[3] = v[i].w * gs[i]; }
    LDS_WAIT(); asm volatile("" ::: "memory");
    const int c = lane & 7;
    const int drow0 = (mode == 0) ? n0 : (256 * (n0 >> 7) + (n0 & 127) + (mode == 2 ? 128 : 0));
#pragma unroll
    for (int j = 0; j < 4; ++j) { const int n = (lane >> 3) + 8 * j; const LAS float* s = scr + (8 * c) * 33 + n;
        v4u o; o.x = pk2(s[0 * 33], s[1 * 33]); o.y = pk2(s[2 * 33], s[3 * 33]); o.z = pk2(s[4 * 33], s[5 * 33]); o.w = pk2(s[6 * 33], s[7 * 33]);
        *(GAS v4u*)(WT + (size_t)(drow0 + n) * K + k0 + 8 * c) = o; }
    LDS_WAIT(); asm volatile("" ::: "memory");
}
__device__ __forceinline__ void p0_item128(const float* W, const float* g, int K, int N, bf16* WT, int mode, LAS float* scr, int item, int lane) {
    const int nblk = N / 32, kb = item / nblk, nb = item % nblk, k0 = 128 * kb, n0 = 32 * nb;
    const int kr = lane >> 3, nc = (lane & 7) * 4;
    f32x4 v[16]; float gs[16];
#pragma unroll
    for (int i = 0; i < 16; ++i) { v[i] = *(const GAS f32x4*)(W + (size_t)(k0 + kr + 8 * i) * N + n0 + nc); gs[i] = g ? g[k0 + kr + 8 * i] : 1.f; }
    const int c = lane & 7;
    const int drow0 = (mode == 0) ? n0 : (256 * (n0 >> 7) + (n0 & 127) + (mode == 2 ? 128 : 0));
#pragma unroll
    for (int hf = 0; hf < 2; ++hf) {
#pragma unroll
        for (int i = 0; i < 8; ++i) { LAS float* s = scr + (kr + 8 * i) * 33 + nc; const f32x4 x = v[hf * 8 + i]; const float gg = gs[hf * 8 + i]; s[0] = x.x * gg; s[1] = x.y * gg; s[2] = x.z * gg; s[3] = x.w * gg; }
        LDS_WAIT(); asm volatile("" ::: "memory");
#pragma unroll
        for (int j = 0; j < 4; ++j) { const int n = (lane >> 3) + 8 * j; const LAS float* s = scr + (8 * c) * 33 + n;
            v4u o; o.x = pk2(s[0 * 33], s[1 * 33]); o.y = pk2(s[2 * 33], s[3 * 33]); o.z = pk2(s[4 * 33], s[5 * 33]); o.w = pk2(s[6 * 33], s[7 * 33]);
            *(GAS v4u*)(WT + (size_t)(drow0 + n) * K + k0 + 64 * hf + 8 * c) = o; }
        LDS_WAIT(); asm volatile("" ::: "memory");
    }
}
constexpr int CI_QKV = (D / 128) * (NQKV / 32), CI_O = (D / 128) * (D / 32), CI_G = (D / 128) * (FF / 32), CI_D = (FF / 128) * (D / 32), CI_L = CI_O + 2 * CI_G + CI_D;
__device__ __forceinline__ int conv_group_items(int grp) { return grp == 0 ? CI_QKV : (grp <= 3 ? CI_L + CI_QKV : CI_L); }
__device__ __forceinline__ void conv_item(const float* const __attribute__((address_space(4)))* in, unsigned char* ws, int grp, int it, LAS float* scr, int lane) {
    bf16* WQKV = (bf16*)(ws + WS_WQKV); bf16* WO = (bf16*)(ws + WS_WO); bf16* WGU = (bf16*)(ws + WS_WGU); bf16* WD = (bf16*)(ws + WS_WD);
    int r = it;
    if (grp > 0) { const int L = grp - 1; const float* gf = in[15] + (size_t)L * D;
        if (r < CI_O) { p0_item128(in[11] + (size_t)L * D * D, nullptr, D, D, WO + (size_t)L * D * D, 0, scr, r, lane); return; } r -= CI_O;
        if (r < CI_G) { p0_item128(in[16] + (size_t)L * D * FF, gf, D, FF, WGU + (size_t)L * NGU * D, 1, scr, r, lane); return; } r -= CI_G;
        if (r < CI_G) { p0_item128(in[17] + (size_t)L * D * FF, gf, D, FF, WGU + (size_t)L * NGU * D, 2, scr, r, lane); return; } r -= CI_G;
        if (r < CI_D) { p0_item128(in[18] + (size_t)L * FF * D, nullptr, FF, D, WD + (size_t)L * D * FF, 0, scr, r, lane); return; } r -= CI_D;
    }
    const int Lq = grp;
    p0_item128(in[8] + (size_t)Lq * D * NQKV, in[7] + (size_t)Lq * D, D, NQKV, WQKV + (size_t)Lq * NQKV * D, 0, scr, r, lane);
}
constexpr int N_SLICE = 256;
struct ConvD { const float* W; const float* g; bf16* WT; int K, N, mode, item; };
__device__ __forceinline__ ConvD conv_desc(const float* const __attribute__((address_space(4)))* in, unsigned char* ws, int grp, int it) {
    ConvD d; int r = it; const int L = grp - 1;
    if (r < CI_O) { d.W = in[11] + (size_t)L * D * D; d.g = nullptr; d.WT = (bf16*)(ws + WS_WO) + (size_t)L * D * D; d.K = D; d.N = D; d.mode = 0; d.item = r; return d; } r -= CI_O;
    if (r < 2 * CI_G) { const int up = r >= CI_G ? 1 : 0; d.W = in[16 + up] + (size_t)L * D * FF; d.g = in[15] + (size_t)L * D; d.WT = (bf16*)(ws + WS_WGU) + (size_t)L * NGU * D; d.K = D; d.N = FF; d.mode = 1 + up; d.item = r - up * CI_G; return d; } r -= 2 * CI_G;
    if (r < CI_D) { d.W = in[18] + (size_t)L * FF * D; d.g = nullptr; d.WT = (bf16*)(ws + WS_WD) + (size_t)L * D * FF; d.K = FF; d.N = D; d.mode = 0; d.item = r; return d; } r -= CI_D;
    d.W = in[8] + (size_t)grp * D * NQKV; d.g = in[7] + (size_t)grp * D; d.WT = (bf16*)(ws + WS_WQKV) + (size_t)grp * NQKV * D; d.K = D; d.N = NQKV; d.mode = 0; d.item = r; return d;
}
__device__ __forceinline__ void p0_load128(const ConvD& d, f32x4 (&v)[16], float (&gs)[16], int lane) {
    const int nblk = d.N / 32, kb = d.item / nblk, nb = d.item % nblk, k0 = 128 * kb, n0 = 32 * nb;
    const int kr = lane >> 3, nc = (lane & 7) * 4;
#pragma unroll
    for (int i = 0; i < 16; ++i) { v[i] = *(const GAS f32x4*)(d.W + (size_t)(k0 + kr + 8 * i) * d.N + n0 + nc); gs[i] = d.g ? d.g[k0 + kr + 8 * i] : 1.f; }
}
__device__ __forceinline__ void p0_finish128(const ConvD& d, const f32x4 (&v)[16], const float (&gs)[16], LAS float* scr, int lane) {
    const int nblk = d.N / 32, kb = d.item / nblk, nb = d.item % nblk, k0 = 128 * kb, n0 = 32 * nb;
    const int kr = lane >> 3, nc = (lane & 7) * 4, c = lane & 7;
    const int drow0 = (d.mode == 0) ? n0 : (256 * (n0 >> 7) + (n0 & 127) + (d.mode == 2 ? 128 : 0));
#pragma unroll
    for (int hf = 0; hf < 2; ++hf) {
#pragma unroll
        for (int i = 0; i < 8; ++i) { LAS float* s = scr + (kr + 8 * i) * 33 + nc; const f32x4 x = v[hf * 8 + i]; const float gg = gs[hf * 8 + i]; s[0] = x.x * gg; s[1] = x.y * gg; s[2] = x.z * gg; s[3] = x.w * gg; }
        LDS_WAIT(); asm volatile("" ::: "memory");
#pragma unroll
        for (int j = 0; j < 4; ++j) { const int n = (lane >> 3) + 8 * j; const LAS float* s = scr + (8 * c) * 33 + n;
            v4u o; o.x = pk2(s[0 * 33], s[1 * 33]); o.y = pk2(s[2 * 33], s[3 * 33]); o.z = pk2(s[4 * 33], s[5 * 33]); o.w = pk2(s[6 * 33], s[7 * 33]);
            *(GAS v4u*)(d.WT + (size_t)(drow0 + n) * d.K + k0 + 64 * hf + 8 * c) = o; }
        LDS_WAIT(); asm volatile("" ::: "memory");
    }
}
__device__ __forceinline__ void conv_slice(const float* const __attribute__((address_space(4)))* in, unsigned char* ws, int grp, int slice, LAS unsigned char* lds, int tid) {
    asm volatile("" : "+v"(tid));
    const int lane = tid & 63, wave = __builtin_amdgcn_readfirstlane(tid >> 6);
    LAS float* scr = (LAS float*)(lds + wave * 16384);
    const int ni = conv_group_items(grp), per = (ni + N_SLICE - 1) / N_SLICE, i0 = slice * per, i1 = (i0 + per < ni) ? i0 + per : ni;
    const int first = i0 + wave, n = (first < i1) ? (i1 - first + NWAVES - 1) / NWAVES : 0;
    if (n > 0) {
        f32x4 vA[16], vB[16]; float gA[16], gB[16];
        ConvD dA = conv_desc(in, ws, grp, first), dB = dA; p0_load128(dA, vA, gA, lane);
#pragma unroll 1
        for (int j = 0; j < n; j += 2) {
            dB = conv_desc(in, ws, grp, first + NWAVES * (j + 1 < n ? j + 1 : n - 1)); p0_load128(dB, vB, gB, lane); __builtin_amdgcn_sched_barrier(0);
            p0_finish128(dA, vA, gA, scr, lane); __builtin_amdgcn_sched_barrier(0);
            dA = conv_desc(in, ws, grp, first + NWAVES * (j + 2 < n ? j + 2 : n - 1)); p0_load128(dA, vA, gA, lane); __builtin_amdgcn_sched_barrier(0);
            if (j + 1 < n) p0_finish128(dB, vB, gB, scr, lane);
            __builtin_amdgcn_sched_barrier(0);
        }
    }
    __syncthreads();
}
__device__ __forceinline__ void row_update(const float* xold, const float* crow, float* xdst, bf16* xbrow, float* rstd_p, int lane) {
    const GAS f32x4* xr = (const GAS f32x4*)xold + lane; const GAS f32x4* cr = (const GAS f32x4*)crow + lane;
    GAS f32x4* xd = (GAS f32x4*)xdst + lane; GAS unsigned long long* o8 = (GAS unsigned long long*)xbrow + lane;
    float ss = 0.f;
#pragma unroll
    for (int j = 0; j < 8; ++j) { f32x4 v = xr[64 * j]; if (crow) v = v + cr[64 * j]; if (xdst) xd[64 * j] = v;
        ss += (v.x * v.x + v.y * v.y) + (v.z * v.z + v.w * v.w);
        o8[64 * j] = (unsigned long long)pk2(v.x, v.y) | ((unsigned long long)pk2(v.z, v.w) << 32); }
    ss = wave_sum(ss);
    if (lane < 32) rstd_p[lane] = (lane == 0) ? ss : 0.f;
}

template <int MODE>
__device__ __forceinline__ void sample_attn(LAS char* lds, int u, int li, unsigned char* ws, const float* rel, const float* kcache, const float* vcache, int tid) {
    asm volatile("" : "+v"(tid));
    constexpr int L = (MODE == 0) ? WIN : PAST, Lk = L + SN, NKB = Lk / 16, LkP = (Lk + 31) / 32 * 32, NST = LkP / 32, PP = LkP;
    constexpr int OFF_P = att::OFF_BIAS + 4352, OFF_RI = OFF_P + 16 * 1056 * 2;
    static_assert(16 * Lk * 4 <= att::OFF_TAB && OFF_RI + 64 <= 131072 && 8 * 16 * 128 * 4 <= att::OFF_TAB, "sample attention LDS map");
    const int lane = tid & 63, wid = __builtin_amdgcn_readfirstlane(tid >> 6), fr = lane & 15, fq = lane >> 4, st = u >> 4, h = u & 15;
    LAS float* S = (LAS float*)lds; LAS unsigned short* P = (LAS unsigned short*)(lds + OFF_P); LAS float* RI = (LAS float*)(lds + OFF_RI);
    const bf16* QSp = (const bf16*)(ws + WS_QS) + (size_t)u * SN * HD; const bf16* KNp = (const bf16*)(ws + WS_KSN) + (size_t)u * SN * HD; const bf16* VNp = (const bf16*)(ws + WS_VSN) + (size_t)u * SN * HD;
    const float* kc = kcache + ((size_t)(li * SB + st) * L) * D + h * HD; const float* vc = vcache + ((size_t)(li * SB + st) * L) * D + h * HD;
    if constexpr (MODE == 1) {
        att::Blk b; b.aux = (const float*)(ws + WS_LFS) + (size_t)u * LS; b.jhi = 17; b.cap = LS - 1; b.jlo = 0; b.P0 = PAST; b.c0 = 0; b.skipthr = 0.f; b.Q = nullptr; b.K = nullptr; b.V = nullptr; b.O = nullptr;
        (void)att::build_bias<1>(b, lds, tid);
    }
    pg8::bf16x8 qf[4];
#pragma unroll
    for (int ds = 0; ds < 4; ++ds) qf[ds] = *(const pg8::bf16x8*)(QSp + (size_t)fr * HD + ds * 32 + fq * 8);
    asm volatile("s_waitcnt lgkmcnt(0)" ::: "memory"); __syncthreads();
#define SA_SCORE(accv, key0_) do { f32x4 lg_; _Pragma("unroll") for (int r = 0; r < 4; ++r) { const int key = (key0_) + 4 * fq + r; float v_; \
            if (MODE == 1) { v_ = ((accv)[r] + ((LAS const float*)(lds + att::OFF_BIAS))[key]) * SCALE; if (key > L + fr) v_ = -__builtin_inff(); } \
            else { int dd = L + fr - key; dd = dd < -128 ? -128 : (dd > 128 ? 128 : dd); v_ = (accv)[r] * SCALE + rel[(size_t)(li * NH + h) * NREL + dd + 128]; } \
            lg_[r] = v_; } *(LAS f32x4*)(S + fr * Lk + (key0_) + 4 * fq) = lg_; } while (0)
    constexpr int NCB = L / 16 / NWAVES;
#pragma unroll 1
    for (int i = 0; i < NCB; i += 2) {
        f32x4 ka[2][4], kb2[2][4];
#pragma unroll
        for (int u2 = 0; u2 < 2; ++u2) { const float* kr = kc + (size_t)((wid + (i + u2) * NWAVES) * 16 + fr) * D + fq * 8;
#pragma unroll
            for (int ds = 0; ds < 4; ++ds) { ka[u2][ds] = *(const GAS f32x4*)(kr + ds * 32); kb2[u2][ds] = *(const GAS f32x4*)(kr + ds * 32 + 4); } }
#pragma unroll
        for (int u2 = 0; u2 < 2; ++u2) { pg8::f32x4 acc = (pg8::f32x4){0.f, 0.f, 0.f, 0.f};
#pragma unroll
            for (int ds = 0; ds < 4; ++ds) { const f32x4 a = ka[u2][ds], b2 = kb2[u2][ds];
                v4u w; w.x = pk2(a.x, a.y); w.y = pk2(a.z, a.w); w.z = pk2(b2.x, b2.y); w.w = pk2(b2.z, b2.w);
                acc = __builtin_amdgcn_mfma_f32_16x16x32_bf16(__builtin_bit_cast(pg8::bf16x8, w), qf[ds], acc, 0, 0, 0); }
            SA_SCORE(acc, (wid + (i + u2) * NWAVES) * 16); }
    }
    if (wid == 0) { const bf16* kr = KNp + (size_t)fr * HD + fq * 8; pg8::f32x4 acc = (pg8::f32x4){0.f, 0.f, 0.f, 0.f};
#pragma unroll
        for (int ds = 0; ds < 4; ++ds) acc = __builtin_amdgcn_mfma_f32_16x16x32_bf16(*(const pg8::bf16x8*)(kr + ds * 32), qf[ds], acc, 0, 0, 0);
        SA_SCORE(acc, L); }
#undef SA_SCORE
    asm volatile("s_waitcnt lgkmcnt(0)" ::: "memory"); __syncthreads();
#pragma unroll 1
    for (int rr = 0; rr < 2; ++rr) { const int q = 2 * wid + rr; LAS const float* sr = S + q * Lk; float m = -1e30f;
        for (int k = lane; k < Lk; k += 64) m = fmaxf(m, sr[k]);
#pragma unroll
        for (int o = 1; o < 64; o <<= 1) m = fmaxf(m, __int_as_float(__builtin_amdgcn_ds_bpermute(((lane ^ o) & 63) << 2, __float_as_int(m))));
        float sum = 0.f;
        for (int k = lane; k < PP; k += 64) { float p = 0.f; if (k < Lk) { p = __expf(sr[k] - m); sum += p; } P[q * 1056 + k] = (unsigned short)f2bf(p); }
#pragma unroll
        for (int o = 1; o < 64; o <<= 1) sum += __int_as_float(__builtin_amdgcn_ds_bpermute(((lane ^ o) & 63) << 2, __float_as_int(sum)));
        if (lane == 0) RI[q] = 1.0f / sum; }
    asm volatile("s_waitcnt lgkmcnt(0)" ::: "memory"); __syncthreads();
    pg8::f32x4 oacc[8];
#pragma unroll
    for (int db = 0; db < 8; ++db) oacc[db] = (pg8::f32x4){0.f, 0.f, 0.f, 0.f};
    constexpr int NCS = L / 32 / NWAVES;
#pragma unroll 1
    for (int i = 0; i < NCS; i += 2) {
        f32x4 ev[2][2][8];
#pragma unroll
        for (int u2 = 0; u2 < 2; ++u2) { const float* vr = vc + (size_t)((wid + (i + u2) * NWAVES) * 32 + fq * 8) * D + 4 * fr;
#pragma unroll
            for (int hf = 0; hf < 2; ++hf)
#pragma unroll
                for (int j = 0; j < 8; ++j) ev[u2][hf][j] = *(const GAS f32x4*)(vr + (size_t)j * D + hf * 64); }
#pragma unroll
        for (int u2 = 0; u2 < 2; ++u2) { const pg8::bf16x8 pf = *(LAS const pg8::bf16x8*)(P + fr * 1056 + (wid + (i + u2) * NWAVES) * 32 + fq * 8);
#pragma unroll
            for (int hf = 0; hf < 2; ++hf)
#pragma unroll
                for (int c = 0; c < 4; ++c) { v4u w; w.x = pk2(ev[u2][hf][0][c], ev[u2][hf][1][c]); w.y = pk2(ev[u2][hf][2][c], ev[u2][hf][3][c]); w.z = pk2(ev[u2][hf][4][c], ev[u2][hf][5][c]); w.w = pk2(ev[u2][hf][6][c], ev[u2][hf][7][c]);
                    oacc[hf * 4 + c] = __builtin_amdgcn_mfma_f32_16x16x32_bf16(__builtin_bit_cast(pg8::bf16x8, w), pf, oacc[hf * 4 + c], 0, 0, 0); } }
    }
    if (wid == 0) { const int kq = L + fq * 8; const pg8::bf16x8 pf = *(LAS const pg8::bf16x8*)(P + fr * 1056 + kq);
        const bool ok = fq < 2; const bf16* vr = VNp + (size_t)(ok ? (kq - L) : 0) * HD + 4 * fr;
#pragma unroll
        for (int hf = 0; hf < 2; ++hf)
#pragma unroll
            for (int c = 0; c < 4; ++c) { unsigned e[8];
#pragma unroll
                for (int j = 0; j < 8; ++j) e[j] = ok ? (unsigned)vr[(size_t)j * HD + hf * 64 + c] : 0u;
                v4u w; w.x = e[0] | (e[1] << 16); w.y = e[2] | (e[3] << 16); w.z = e[4] | (e[5] << 16); w.w = e[6] | (e[7] << 16);
                oacc[hf * 4 + c] = __builtin_amdgcn_mfma_f32_16x16x32_bf16(__builtin_bit_cast(pg8::bf16x8, w), pf, oacc[hf * 4 + c], 0, 0, 0); } }
    LAS float* PO = (LAS float*)lds;
#pragma unroll
    for (int hf = 0; hf < 2; ++hf)
#pragma unroll
        for (int r = 0; r < 4; ++r) *(LAS f32x4*)(PO + (wid * 16 + fr) * 128 + hf * 64 + 16 * fq + 4 * r) = (f32x4){oacc[hf * 4][r], oacc[hf * 4 + 1][r], oacc[hf * 4 + 2][r], oacc[hf * 4 + 3][r]};
    asm volatile("s_waitcnt lgkmcnt(0)" ::: "memory"); __syncthreads();
    { const int q = tid >> 5, d4 = (tid & 31) * 4; f32x4 s = *(LAS const f32x4*)(PO + q * 128 + d4);
#pragma unroll
      for (int w = 1; w < 8; ++w) { const f32x4 t = *(LAS const f32x4*)(PO + (w * 16 + q) * 128 + d4); s = s + t; }
      const float ri = RI[q];
      bf16* o = (bf16*)(ws + WS_OB) + ((size_t)MP + st * SN + q) * D + h * HD + d4;
      *(GAS unsigned long long*)o = (unsigned long long)pk2(s.x * ri, s.y * ri) | ((unsigned long long)pk2(s.z * ri, s.w * ri) << 32); }
    __syncthreads();
}

constexpr int N_PROMPT = NB * NH * 32, N_UNIT = SB * NH, N_POS = N_PROMPT + N_UNIT + N_SLICE;
static_assert(N_UNIT == N_SLICE && N_PROMPT >= 2 * N_UNIT, "ticket layout");
template <int MODE> __device__ __forceinline__ void pos_decode(int pos, int& kind, int& id) {
    if (pos < 4 * N_UNIT) { const int g = pos >> 2, r = pos & 3; if (r == 2) { kind = 1; id = g; } else if (r == 3) { kind = 2; id = g; } else { kind = 0; id = 2 * g + r; } }
    else { kind = 0; id = pos - 2 * N_UNIT; }
}
template <int MODE>
__device__ __forceinline__ void get_blk(int p, int li, unsigned char* ws, const float* rel, att::Blk& b) {
    bf16* QPp = (bf16*)(ws + WS_QP); bf16* KPp = (bf16*)(ws + WS_KP); bf16* VPp = (bf16*)(ws + WS_VP); bf16* OBp = (bf16*)(ws + WS_OB);
    int bh, qb;
    bh = p & 31; qb = 31 - (p >> 5);
    const int bb = bh >> 4, h = bh & 15;
    b.Q = QPp + ((size_t)bh * T + qb * 256) * HD; b.K = KPp + (size_t)bh * T * HD; b.V = VPp + (size_t)bh * T * HD; b.O = OBp + ((size_t)bb * T + qb * 256) * D + h * HD; b.P0 = qb * 256;
    if (MODE == 0) { b.aux = rel + (size_t)(li * NH + h) * NREL; b.c0 = qb * 4; b.jlo = b.c0 > 8 ? b.c0 - 8 : 0; b.jhi = b.c0 + 4; b.cap = 1 << 29; b.skipthr = __builtin_inff(); }
    else { b.aux = (const float*)(ws + WS_LFP) + (size_t)bh * T; b.c0 = 0; b.jlo = 0; b.jhi = 4 * (qb + 1); b.cap = qb * 256 + 255; b.skipthr = ((const float*)(ws + WS_QKM))[li]; }
}
__device__ __forceinline__ int take_ticket(gu32* qc, LAS unsigned char* lds, int tid) {
    volatile LAS int* w = (volatile LAS int*)(lds + 131008);
    if (tid == 0) *w = (int)__hip_atomic_fetch_add(qc, 1u, RLX_AGENT);
    __syncthreads();
    return __builtin_amdgcn_readfirstlane(*w);
}
template <int MODE>
__device__ __forceinline__ void attn_phase(LAS unsigned char* lds, int bx, int G, int layer, unsigned char* ws, const float* const __attribute__((address_space(4)))* in, const int tid) {
    att::Blk cur; att::Nxt nxt; att::Seam S;
    const int li = layer >> 1;
    const float* rel = in[12]; const float* kcache = in[MODE == 1 ? 4 : 2]; const float* vcache = in[MODE == 1 ? 5 : 3];
    gu32* qc = (gu32*)(ws + WS_CTL) + CW_QUEUE + 64 * layer;
    int pos = take_ticket(qc, lds, tid);
    while (pos < N_POS) {
        int kind, id; pos_decode<MODE>(pos, kind, id);
        if (kind != 0) {
            if (kind == 1) sample_attn<MODE>((LAS char*)lds, id, li, ws, rel, kcache, vcache, tid);
            else conv_slice(in, ws, layer + 1, id, lds, tid);
            pos = take_ticket(qc, lds, tid); continue; }
        get_blk<MODE>(id, li, ws, rel, cur);
        att::attn_prime<MODE>(cur, (LAS char*)lds, S, tid);
        for (;;) {
            int np = N_POS, id2 = 0; bool nf = false;
            int tk = 0;
            att::attn_block<MODE>(cur, [&]() { if (tid == 0) tk = (int)__hip_atomic_fetch_add(qc, 1u, RLX_AGENT); },
                [&](att::Nxt& nxt) {
                { volatile LAS int* w = (volatile LAS int*)(lds + 131008); if (tid == 0) *w = tk; __syncthreads(); np = __builtin_amdgcn_readfirstlane(*w); }
                int k2 = 3; if (np < N_POS) pos_decode<MODE>(np, k2, id2);
                nf = (k2 == 0);
                att::Blk nb; if (nf) { get_blk<MODE>(id2, li, ws, rel, nb); nxt.Q = nb.Q; nxt.K = nb.K; nxt.V = nb.V; nxt.jlo = nb.jlo; } else { nxt.Q = cur.Q; nxt.K = cur.K; nxt.V = cur.V; nxt.jlo = cur.jlo; }
            }, (LAS char*)lds, S, tid);
            pos = np;
            if (!nf) break;
            int id3 = id2; asm volatile("" : "+s"(id3));
            get_blk<MODE>(id3, li, ws, rel, cur);
        }
    }
}

struct Args { const float* in[19]; float* out; unsigned char* ws; int ph_lo, ph_hi; };
constexpr int PH_PER_LAYER = 5, N_PHASES = 1 + DEPTH * PH_PER_LAYER;

typedef const __attribute__((address_space(4))) Args CArgs;
#define PH_BEGIN() CArgs* A; { unsigned long long k_ = (unsigned long long)__builtin_amdgcn_kernarg_segment_ptr(); asm volatile("" : "+s"(k_)); A = (CArgs*)k_; } \
    unsigned char* const ws = A->ws; float* const out = A->out; int bx = blockIdx.x; asm volatile("" : "+s"(bx)); (void)ws; (void)out; (void)bx; \
    unsigned m1_ = ~0u; int ws_ = wave_s; asm volatile("" : "+s"(m1_), "+s"(ws_)); int tid = ws_ * 64 + (int)__builtin_amdgcn_mbcnt_hi(m1_, __builtin_amdgcn_mbcnt_lo(m1_, 0u)); asm volatile("" : "+v"(tid)); const int lane = tid & 63, wave = wave_s; (void)lane; (void)wave; \
    const int gw = bx * NWAVES + wave, NGW = G * NWAVES; const long gt = (long)bx * (NWAVES * 64) + tid, NGT = (long)G * (NWAVES * 64); (void)gw; (void)NGW; (void)gt; (void)NGT
__global__ void __launch_bounds__(NWAVES * 64, 2) fwd_kernel(Args args_unused) {
    extern __shared__ __attribute__((aligned(16))) unsigned char lds_raw[];
    LAS unsigned char* lds = (LAS unsigned char*)lds_raw;
    volatile LAS unsigned* MISC = (volatile LAS unsigned*)(lds + MISC_OFF);
    const int G = gridDim.x;
    const int wave_s = __builtin_amdgcn_readfirstlane((int)threadIdx.x >> 6);
    for (int u = threadIdx.x; u < (LDS_BYTES - LDSCTL_OFF) / 4; u += NWAVES * 64) ((LAS unsigned*)(lds + LDSCTL_OFF))[u] = 0u;
    __syncthreads();
    int lo, hi; XcdBarrier bar;
    { PH_BEGIN(); lo = A->ph_lo; hi = A->ph_hi; bar = xcd_barrier_post((unsigned*)((gu32*)(ws + WS_CTL) + CW_BAR), MISC + 8, tid == 0); }
#define IN(k) (lo <= (k) && (k) < hi)
#define SEAM(k) do { if (IN(k) && IN((k) + 1)) { XcdBarrier b2_ = bar; unsigned m2_ = ~0u; int w2_ = wave_s; asm volatile("" : "+s"(b2_.bar), "+s"(m2_), "+s"(w2_)); \
    xcd_barrier(b2_, w2_ == 0 && __builtin_amdgcn_mbcnt_hi(m2_, __builtin_amdgcn_mbcnt_lo(m2_, 0u)) == 0u); } } while (0)
#define P_WQKV ((bf16*)(ws + WS_WQKV))
#define P_WO ((bf16*)(ws + WS_WO))
#define P_WGU ((bf16*)(ws + WS_WGU))
#define P_WD ((bf16*)(ws + WS_WD))
#define P_XB ((bf16*)(ws + WS_XB))
#define P_SSQ ((float*)(ws + WS_SSQ))
#define P_QP ((bf16*)(ws + WS_QP))
#define P_KP ((bf16*)(ws + WS_KP))
#define P_VP ((bf16*)(ws + WS_VP))
#define P_QS ((bf16*)(ws + WS_QS))
#define P_OB ((bf16*)(ws + WS_OB))
#define P_HB ((bf16*)(ws + WS_HB))
#define P_LFP ((float*)(ws + WS_LFP))
#define P_LFS ((float*)(ws + WS_LFS))
#define P_KSN ((bf16*)(ws + WS_KSN))
#define P_VSN ((bf16*)(ws + WS_VSN))
#define P_WF ((bf16*)(ws + WS_WF))
#define P_X (out + O_Y)

    if (IN(0)) { PH_BEGIN();
        LAS float* scr = (LAS float*)(lds + RING_OFF + wave * 16384);
        for (int it = gw; it < conv_group_items(0); it += NGW) conv_item(A->in, ws, 0, it, scr, lane);
        for (int row = gw; row < M; row += NGW) {
            const float* xr = row < MP ? A->in[0] + (size_t)row * D : A->in[1] + (size_t)(row - MP) * D;
            row_update(xr, nullptr, nullptr, P_XB + (size_t)row * D, P_SSQ + (size_t)row * 32, lane);
        }
        for (long idx = gt; idx < 2L * NH * D; idx += NGT) { const int ib = (int)(idx >> 15), h = (int)((idx >> 11) & 15), k = (int)(idx & (D - 1));
            P_WF[idx] = (bf16)f2bf(A->in[7][(size_t)(2 * ib + 1) * D + k] * A->in[13][((size_t)ib * D + k) * NH + h]); }
        if (gw == 0) {
#pragma unroll 1
            for (int ib = 0; ib < 2; ++ib) { const float* gq = A->in[9] + (2 * ib + 1) * HD; const float* gk = A->in[10] + (2 * ib + 1) * HD;
                float mqk = fmaxf(fabsf(gq[lane] * gk[lane]), fabsf(gq[lane + 64] * gk[lane + 64]));
#pragma unroll
                for (int o = 1; o < 64; o <<= 1) mqk = fmaxf(mqk, __shfl_xor(mqk, o));
                if (lane == 0) ((float*)(ws + WS_QKM))[ib] = 11.313708499f * mqk * 1.02f + 40.0f; }
        }
    }
    SEAM(0);

#pragma unroll 1
    for (int layer = 0; layer < DEPTH; ++layer) {
        const int pb = 1 + layer * PH_PER_LAYER, li = layer >> 1; const bool fox = (layer & 1) != 0;
        if (IN(pb + 0)) { PH_BEGIN();
            if (fox) {
                const bf16* wfp = P_WF + (size_t)li * NH * D; const float* bfp = A->in[14] + li * NH;
                const int fr = lane & 15, fq = lane >> 4, lr = lane >> 2, lc = lane & 3, pidx = (((lane & 15) << 2) | (lane >> 4)) << 2;
                const int nidle = (G > 192) ? (G - 192) * NWAVES : NGW, gw0 = (G > 192) ? (bx - 192) * NWAVES + wave : gw;
                if (gw0 >= 0)
                for (int grp = gw0; grp < M / 16; grp += nidle) {
                    const int row = grp * 16 + fr;
                    const char* ap = (const char*)(P_XB + (size_t)(grp * 16 + lr) * D) + lc * 16; const char* bp = (const char*)(wfp + (size_t)lr * D) + lc * 16;
                    pg8::f32x4 acc = (pg8::f32x4){0.f, 0.f, 0.f, 0.f};
#pragma unroll 8
                    for (int ks = 0; ks < D / 32; ++ks) { pg8::u32x4 av = *(const pg8::u32x4*)(ap + ks * 64), bv = *(const pg8::u32x4*)(bp + ks * 64);
                        av.x = (unsigned)__builtin_amdgcn_ds_bpermute(pidx, (int)av.x); av.y = (unsigned)__builtin_amdgcn_ds_bpermute(pidx, (int)av.y); av.z = (unsigned)__builtin_amdgcn_ds_bpermute(pidx, (int)av.z); av.w = (unsigned)__builtin_amdgcn_ds_bpermute(pidx, (int)av.w);
                        bv.x = (unsigned)__builtin_amdgcn_ds_bpermute(pidx, (int)bv.x); bv.y = (unsigned)__builtin_amdgcn_ds_bpermute(pidx, (int)bv.y); bv.z = (unsigned)__builtin_amdgcn_ds_bpermute(pidx, (int)bv.z); bv.w = (unsigned)__builtin_amdgcn_ds_bpermute(pidx, (int)bv.w);
                        acc = __builtin_amdgcn_mfma_f32_16x16x32_bf16(__builtin_bit_cast(pg8::bf16x8, bv), __builtin_bit_cast(pg8::bf16x8, av), acc, 0, 0, 0); }
                    const float rs = pg8::row_rstd(P_SSQ, row, fq);
                    const pg8::f32x4 bb = *(const pg8::f32x4*)(bfp + 4 * fq); pg8::f32x4 lf;
#pragma unroll
                    for (int i = 0; i < 4; ++i) { const float z = acc[i] * rs + bb[i]; lf[i] = fminf(z, 0.f) - log1pf(expf(-fabsf(z))); }
                    if (row < MP) { *(pg8::f32x4*)(out + O_BFP + ((size_t)li * MP + row) * NH + 4 * fq) = lf;
#pragma unroll
                        for (int i = 0; i < 4; ++i) P_LFP[(size_t)((row >> 13) * NH + 4 * fq + i) * T + (row & (T - 1))] = lf[i]; }
                    else { const int rs2 = row - MP; *(pg8::f32x4*)(out + O_BFS + ((size_t)li * MS + rs2) * NH + 4 * fq) = lf;
#pragma unroll
                        for (int i = 0; i < 4; ++i) P_LFS[(size_t)((rs2 >> 4) * NH + 4 * fq + i) * LS + PAST + (rs2 & 15)] = lf[i]; }
                }
                const float* clf = A->in[6] + (size_t)li * SB * PAST * NH;
                for (long idx = gt; idx < (long)SB * NH * PAST; idx += NGT) { const int unit = (int)(idx >> 10), j = (int)(idx & 1023), st = unit >> 4, h = unit & 15;
                    P_LFS[(size_t)unit * LS + j] = clf[((size_t)st * PAST + j) * NH + h]; }
            }
            pg8::Gemm g{P_XB, P_WQKV + (size_t)layer * NQKV * D, MP, NQKV, D}; pg8::StaticOrder S; S.init(MP, NQKV, G, bx, 1, 1);
            pg8::EpiQKV E;
            E.ssq = P_SSQ; E.gq = A->in[9] + layer * HD; E.gk = A->in[10] + layer * HD; E.QP = P_QP; E.pstride = (WS_KP - WS_QP) / 2; E.QS = P_QS;
            E.srows = SN; E.lc = 0; E.KS = P_KSN; E.sstride = (WS_VSN - WS_KSN) / 2;
            E.okp = out + (fox ? O_BKP + (size_t)li * MP * D : O_AKP + (size_t)li * NB * WIN * D); E.opstride = fox ? SZ_BP : SZ_AP;
            E.oks = out + (fox ? O_BKS : O_AKS) + (size_t)li * MS * D; E.osstride = SZ_S;
            E.fox = fox ? 1 : 0; E.red = (LAS float*)(lds + RED_OFF);
            pg8::gemm_phase<pg8::EpiQKV, pg8::StaticOrder, true, true>(lds + RING_OFF, g, S, E, tid);
            __syncthreads();
            {
                sk::SkQKV K2; K2.ssq = P_SSQ + (size_t)MP * 32; K2.gq = A->in[9] + layer * HD; K2.gk = A->in[10] + layer * HD; K2.QS = P_QS;
                K2.srows = SN; K2.lc = 0; K2.KS = P_KSN; K2.sstride = (WS_VSN - WS_KSN) / 2;
                K2.oks = out + (fox ? O_BKS : O_AKS) + (size_t)li * MS * D; K2.osstride = SZ_S;
                sk::skinny_phase<sk::SkQKV>(lds + RING_OFF, P_XB + (size_t)MP * D, P_WQKV + (size_t)layer * NQKV * D, NQKV / 128, D, (unsigned*)((gu32*)(ws + WS_CTL) + CW_SKQ + 64 * (layer * 4 + 0)), tid, K2);
            }
        }
        SEAM(pb + 0);
        if (IN(pb + 1)) { PH_BEGIN();
            if (fox) attn_phase<1>(lds + RING_OFF, bx, G, layer, ws, A->in, tid);
            else attn_phase<0>(lds + RING_OFF, bx, G, layer, ws, A->in, tid);
        }
        SEAM(pb + 1);
        if (IN(pb + 2)) { PH_BEGIN();
            pg8::Gemm g{P_OB, P_WO + (size_t)layer * D * D, MP, D, D}; pg8::StaticOrder S; S.init(MP, D, G, bx);
            pg8::EpiResid E;
            E.X = nullptr; E.XB = P_XB; E.ssq = P_SSQ;
            pg8::gemm_phase<pg8::EpiResid, pg8::StaticOrder, true, true>(lds + RING_OFF, g, S, E, tid);
            __syncthreads();
            {   sk::SkResid K2; K2.xin = (layer == 0) ? A->in[1] : P_X + (size_t)MP * D; K2.X = P_X + (size_t)MP * D; K2.XB = P_XB + (size_t)MP * D; K2.ssq = P_SSQ + (size_t)MP * 32;
                sk::skinny_phase<sk::SkResid>(lds + RING_OFF, P_OB + (size_t)MP * D, P_WO + (size_t)layer * D * D, D / 64, D, (unsigned*)((gu32*)(ws + WS_CTL) + CW_SKQ + 64 * (layer * 4 + 1)), tid, K2); }
        }
        SEAM(pb + 2);
        if (IN(pb + 3)) { PH_BEGIN();
            pg8::Gemm g{P_XB, P_WGU + (size_t)layer * NGU * D, MP, NGU, D}; pg8::StaticOrder S; S.init(MP, NGU, G, bx, 0, 1);
            pg8::EpiSwiglu E{P_HB, FF, P_SSQ};
            pg8::gemm_phase<pg8::EpiSwiglu, pg8::StaticOrder, true, true>(lds + RING_OFF, g, S, E, tid);
            __syncthreads();
            {   sk::SkSwiglu K2{P_HB + (size_t)MP * FF, FF, P_SSQ + (size_t)MP * 32};
                sk::skinny_phase<sk::SkSwiglu>(lds + RING_OFF, P_XB + (size_t)MP * D, P_WGU + (size_t)layer * NGU * D, NGU / 128, D, (unsigned*)((gu32*)(ws + WS_CTL) + CW_SKQ + 64 * (layer * 4 + 2)), tid, K2); }
        }
        SEAM(pb + 3);
        if (IN(pb + 4)) { PH_BEGIN();
            pg8::Gemm g{P_HB, P_WD + (size_t)layer * D * FF, MP, D, FF}; pg8::StaticOrder S; S.init(MP, D, G, bx);
            pg8::EpiResid E;
            E.X = (layer == DEPTH - 1) ? P_X : nullptr; E.XB = P_XB; E.ssq = P_SSQ;
            pg8::gemm_phase<pg8::EpiResid, pg8::StaticOrder, true, true>(lds + RING_OFF, g, S, E, tid);
            __syncthreads();
            {   sk::SkResid K2; K2.xin = P_X + (size_t)MP * D; K2.X = P_X + (size_t)MP * D; K2.XB = P_XB + (size_t)MP * D; K2.ssq = P_SSQ + (size_t)MP * 32;
                sk::skinny_phase<sk::SkResid>(lds + RING_OFF, P_HB + (size_t)MP * FF, P_WD + (size_t)layer * D * FF, D / 64, FF, (unsigned*)((gu32*)(ws + WS_CTL) + CW_SKQ + 64 * (layer * 4 + 3)), tid, K2); }
        }
        SEAM(pb + 4);
    }
#undef IN
#undef SEAM
}

#ifndef MK_SPLIT
#define MK_SPLIT 0
#endif
extern "C" void kernel_launch(void* const* d_in, const int* in_sizes, int n_in, void* d_out, int out_size, void* d_ws, size_t ws_size, hipStream_t stream) {
    static int grid = 0;
    if (grid == 0) {
        if (n_in != 19 || in_sizes[0] != MP * D || (size_t)out_size != OUT_TOTAL || ws_size < WS_END) { fprintf(stderr, "kernel_launch: shape mismatch (n_in %d in0 %d out %d ws %zu); nothing launched\n", n_in, n_in > 0 ? in_sizes[0] : -1, out_size, ws_size); grid = -1; return; }
        int dev = 0, cus = 0;
        if (hipGetDevice(&dev) != hipSuccess || hipDeviceGetAttribute(&cus, hipDeviceAttributeMultiprocessorCount, dev) != hipSuccess) { grid = -1; return; }
        if (hipFuncSetAttribute((const void*)fwd_kernel, hipFuncAttributeMaxDynamicSharedMemorySize, LDS_BYTES) != hipSuccess) { fprintf(stderr, "kernel_launch: hipFuncSetAttribute failed\n"); grid = -1; return; }
        int per_cu = 0;
        if (hipOccupancyMaxActiveBlocksPerMultiprocessor(&per_cu, (const void*)fwd_kernel, NWAVES * 64, LDS_BYTES) != hipSuccess || per_cu < 1) fprintf(stderr, "kernel_launch: occupancy query reports %d\n", per_cu);
        (void)hipGetLastError();
        grid = cus;
    }
    if (grid < 0) return;
    if (hipMemsetAsync((char*)d_ws + WS_CTL, 0, CTL_ZERO_BYTES, stream) != hipSuccess) return;
    Args a{};
    for (int i = 0; i < 19; ++i) a.in[i] = (const float*)d_in[i];
    a.out = (float*)d_out; a.ws = (unsigned char*)d_ws;
#if MK_SPLIT
    for (int p = 0; p < N_PHASES; ++p) { a.ph_lo = p; a.ph_hi = p + 1; hipLaunchKernelGGL(fwd_kernel, dim3(grid), dim3(NWAVES * 64), LDS_BYTES, stream, a); }
#else
    a.ph_lo = 0; a.ph_hi = N_PHASES;
    hipLaunchKernelGGL(fwd_kernel, dim3(grid), dim3(NWAVES * 64), LDS_BYTES, stream, a);
#endif
}
```

```cpp
#include <hip/hip_runtime.h>
#include <cstdio>
#include <cstdint>
namespace pg8 {
#define PG8_LAS __attribute__((address_space(3)))
typedef unsigned short bf16_t;
typedef short bf16x8 __attribute__((ext_vector_type(8)));
typedef float f32x4 __attribute__((ext_vector_type(4)));
typedef unsigned u32x4 __attribute__((ext_vector_type(4)));
constexpr int BM = 256, BK = 64, HALF = 128, HTB = HALF * BK * 2  , STAGE_BYTES = 8 * HTB, NXCD = 8, WGM = 4;

__host__ __device__ __forceinline__ int lds_byte(int r, int c) { const int st = (r >> 4) * 2 + (c >> 5), rr = r & 15, cc = c & 31, ob = rr * 64 + cc * 2; return st * 1024 + (ob ^ (((ob >> 9) & 1) << 5)); }
__host__ __device__ __forceinline__ void stage_rc(int b, int& R, int& C) { const int st = b / 1024, sb = b % 1024, swz = sb ^ (((sb >> 9) & 1) << 5); R = (st >> 1) * 16 + swz / 64; C = (st & 1) * 32 + (swz % 64) / 2; }
__host__ __device__ __forceinline__ int perm32(int rho) { const int n = rho >> 4, i = rho & 15; return 8 * (i >> 2) + 4 * n + (i & 3); }

struct Unit { int pm, pn; };
struct Gemm { const bf16_t* A; const bf16_t* Bt; int M, N, K; };

struct StaticOrder {
    int nM, nN, nwg, G, c, mix3, rev;
    __host__ __device__ void init(int M, int N, int G_, int c_, int mix3_ = 0, int rev_ = 0) { nM = M / BM; nN = N / BM; nwg = nM * nN; G = G_; c = c_; mix3 = mix3_; rev = rev_ && (nwg % NXCD == 0); }
    __host__ __device__ bool next(int i, Unit& u) const {
        const long L = (long)i * G + c; if (L >= nwg) return false;
        int wgid = (int)L; { const int q = nwg / NXCD, r = nwg % NXCD, xcd = wgid % NXCD, off = wgid / NXCD; wgid = (xcd < r ? xcd * (q + 1) : r * (q + 1) + (xcd - r) * q) + (rev ? q - 1 - off : off); }
        const int nig = WGM * nN, gid = wgid / nig, fm = gid * WGM, gsz = (nM - fm) < WGM ? (nM - fm) : WGM;
        u.pm = fm + ((wgid % nig) % gsz); u.pn = (wgid % nig) / gsz; if (mix3) u.pn = (u.pn % 3) * (nN / 3) + u.pn / 3; return true;
    }
    __device__ __forceinline__ void a_ready(const Unit&) const {}
    __device__ __forceinline__ void done(const Unit&) const {}
};

__device__ __forceinline__ unsigned cvt_pk_bf16(float lo, float hi) { unsigned r; asm volatile("v_cvt_pk_bf16_f32 %0, %1, %2" : "=v"(r) : "v"(lo), "v"(hi)); return r; }
struct EpiF32 {
    static constexpr bool PERM = false, AFTER_DRAIN = false;
    float* C; int ldc;
    __device__ __forceinline__ void operator()(const f32x4 (&acc)[2][2][4][2], const Unit& u, int wr, int wc, int fr, int fq) const {
        const int row0 = u.pm * BM + wr * 64 + fr, col0 = u.pn * BM + wc * 32 + 4 * fq;
#pragma unroll
        for (int ai = 0; ai < 2; ++ai)
#pragma unroll
            for (int m = 0; m < 4; ++m) { float* rowp = C + (size_t)(row0 + ai * HALF + m * 16) * ldc + col0;
#pragma unroll
                for (int bj = 0; bj < 2; ++bj)
#pragma unroll
                    for (int n = 0; n < 2; ++n) *(f32x4*)(rowp + bj * HALF + n * 16) = acc[ai][bj][m][n]; }
    }
};
template <class Epi, class Sched, bool ALIGN_EPI = false, bool SP2 = false>
__device__ __forceinline__ void gemm_phase(PG8_LAS unsigned char* lds, const Gemm g, const Sched& S, const Epi& E, const int tid_in) {
    int tid_ = tid_in; asm volatile("" : "+v"(tid_));
    const int tid = tid_, wid = __builtin_amdgcn_readfirstlane(tid >> 6), lane = tid & 63, wr = wid >> 2, wc = wid & 3, fr = lane & 15, fq = lane >> 4;
    const int K = g.K, nt = K / BK;
    unsigned voffA[2], voffB[2];
#pragma unroll
    for (int i = 0; i < 2; ++i) { int R, C; stage_rc(tid * 16 + i * 8192, R, C); const int Rb = Epi::PERM ? ((R & ~31) + perm32(R & 31)) : R;
        voffA[i] = (unsigned)(R * K + C) * 2u; voffB[i] = (unsigned)(Rb * K + C) * 2u; }
    const size_t kstep = (size_t)(BK * 2);
    const size_t hstep = (size_t)HALF * K * 2;
    const size_t tstep = 2 * hstep;
    const unsigned ldsw = (unsigned)wid * 1024u;
    const int aoff = lds_byte(wr * 64 + fr, fq * 8), boff = lds_byte(wc * 32 + fr, fq * 8);
#define PG8_SA(b, h) (((b) * 2 + (h)) * HTB)
#define PG8_SB(b, h) ((4 + (b) * 2 + (h)) * HTB)
#define PG8_STAGE(bufoff, gbase, voff) do { _Pragma("unroll") for (int _i = 0; _i < 2; ++_i) \
        __builtin_amdgcn_global_load_lds((const unsigned*)((const char*)(gbase) + (voff)[_i]), (PG8_LAS unsigned*)(lds + (bufoff) + ldsw + _i * 8192), 16, 0, 0); } while (0)
#define PG8_LDA(dst, b, h) do { _Pragma("unroll") for (int m = 0; m < 4; ++m) _Pragma("unroll") for (int k = 0; k < 2; ++k) dst[m][k] = *(const PG8_LAS bf16x8*)(lds + PG8_SA(b, h) + aoff + m * 2048 + k * 1024); } while (0)
#define PG8_LDB(dst, b, h) do { _Pragma("unroll") for (int n = 0; n < 2; ++n) _Pragma("unroll") for (int k = 0; k < 2; ++k) dst[n][k] = *(const PG8_LAS bf16x8*)(lds + PG8_SB(b, h) + boff + n * 2048 + k * 1024); } while (0)
#define PG8_MMA(ai, bj, At, Bt) do { __builtin_amdgcn_s_setprio(1); _Pragma("unroll") for (int m = 0; m < 4; ++m) _Pragma("unroll") for (int n = 0; n < 2; ++n) _Pragma("unroll") for (int k = 0; k < 2; ++k) \
        acc[ai][bj][m][n] = __builtin_amdgcn_mfma_f32_16x16x32_bf16(Bt[n][k], At[m][k], acc[ai][bj][m][n], 0, 0, 0); __builtin_amdgcn_s_setprio(0); } while (0)
#define PG8_WAIT_V(n) asm volatile("s_waitcnt vmcnt(" #n ")" ::: "memory")
#define PG8_WAIT_L(n) asm volatile("s_waitcnt lgkmcnt(" #n ")" ::: "memory")
#define PG8_BAR __builtin_amdgcn_s_barrier()
#define PG8_SCHED __builtin_amdgcn_sched_barrier(0)
    Unit cur, nxt; int ui = 0;
    if (!S.next(0, cur)) return;
    f32x4 acc[2][2][4][2];
#pragma unroll
    for (int a = 0; a < 2; ++a)
#pragma unroll
        for (int b = 0; b < 2; ++b)
#pragma unroll
            for (int m = 0; m < 4; ++m)
#pragma unroll
                for (int n = 0; n < 2; ++n) acc[a][b][m][n] = (f32x4){0.f, 0.f, 0.f, 0.f};
    bf16x8 At[4][2], B0[2][2], B1[2][2];
    const char* cA = (const char*)g.A + (size_t)cur.pm * tstep; const char* cB = (const char*)g.Bt + (size_t)cur.pn * tstep;
    S.a_ready(cur);
    if constexpr (SP2) {
        PG8_STAGE(PG8_SB(0, 0), cB, voffB); PG8_STAGE(PG8_SB(0, 1), cB + hstep, voffB); PG8_STAGE(PG8_SA(0, 0), cA, voffA); PG8_STAGE(PG8_SA(0, 1), cA + hstep, voffA);
        if (wr == 1) PG8_BAR;
        PG8_WAIT_V(2); PG8_BAR;
        PG8_STAGE(PG8_SB(1, 0), cB + kstep, voffB); PG8_STAGE(PG8_SA(1, 0), cA + kstep, voffA); PG8_STAGE(PG8_SB(1, 1), cB + hstep + kstep, voffB);
        PG8_WAIT_V(6); PG8_BAR;
    } else {
        PG8_STAGE(PG8_SB(0, 0), cB, voffB); PG8_STAGE(PG8_SA(0, 0), cA, voffA); PG8_STAGE(PG8_SB(0, 1), cB + hstep, voffB); PG8_STAGE(PG8_SA(0, 1), cA + hstep, voffA);
        if (wr == 1) PG8_BAR;
        PG8_WAIT_V(4); PG8_BAR;
        PG8_STAGE(PG8_SB(1, 0), cB + kstep, voffB); PG8_STAGE(PG8_SA(1, 0), cA + kstep, voffA); PG8_STAGE(PG8_SB(1, 1), cB + hstep + kstep, voffB);
        PG8_WAIT_V(6); PG8_BAR;
    }
    for (;;) {
        const bool has_next = S.next(ui + 1, nxt);
        const char* nA = has_next ? (const char*)g.A + (size_t)nxt.pm * tstep : cA; const char* nB = has_next ? (const char*)g.Bt + (size_t)nxt.pn * tstep : cB;
        for (int t = 0; t < nt; t += 2) {
            const bool last = (t == nt - 2);
            const char* a1 = cA + (size_t)(t + 1) * kstep;
            const char* a2 = last ? nA : cA + (size_t)(t + 2) * kstep; const char* b2 = last ? nB : cB + (size_t)(t + 2) * kstep;
            const char* a3 = a2 + kstep; const char* b3 = b2 + kstep;
            if (last && has_next) S.a_ready(nxt);
            if constexpr (SP2) {
            PG8_LDB(B0, 0, 0); PG8_LDB(B1, 0, 1); PG8_SCHED; PG8_LDA(At, 0, 0); PG8_STAGE(PG8_SA(1, 1), a1 + hstep, voffA);
            PG8_WAIT_V(8); PG8_WAIT_L(0); PG8_BAR; PG8_MMA(0, 0, At, B0); PG8_MMA(0, 1, At, B1); PG8_BAR; PG8_SCHED;
            PG8_LDA(At, 0, 1); PG8_STAGE(PG8_SB(0, 0), b2, voffB); PG8_STAGE(PG8_SB(0, 1), b2 + hstep, voffB); PG8_STAGE(PG8_SA(0, 0), a2, voffA);
            PG8_WAIT_V(8); PG8_WAIT_L(0); PG8_BAR; PG8_MMA(1, 0, At, B0); PG8_MMA(1, 1, At, B1); PG8_BAR; PG8_SCHED;
            PG8_LDB(B0, 1, 0); PG8_LDB(B1, 1, 1); PG8_SCHED; PG8_LDA(At, 1, 0); PG8_STAGE(PG8_SA(0, 1), a2 + hstep, voffA);
            PG8_WAIT_V(8); PG8_WAIT_L(0); PG8_BAR; PG8_MMA(0, 0, At, B0); PG8_MMA(0, 1, At, B1); PG8_BAR; PG8_SCHED;
            PG8_LDA(At, 1, 1); PG8_STAGE(PG8_SB(1, 0), b3, voffB); PG8_STAGE(PG8_SB(1, 1), b3 + hstep, voffB); PG8_STAGE(PG8_SA(1, 0), a3, voffA);
            PG8_WAIT_V(8); PG8_WAIT_L(0); PG8_BAR; PG8_MMA(1, 0, At, B0); PG8_MMA(1, 1, At, B1); PG8_BAR; PG8_SCHED;
            } else {
            PG8_LDB(B0, 0, 0); PG8_SCHED; PG8_LDA(At, 0, 0); PG8_STAGE(PG8_SA(1, 1), a1 + hstep, voffA);
            PG8_WAIT_L(8); PG8_BAR; PG8_WAIT_L(0); PG8_MMA(0, 0, At, B0); PG8_BAR; PG8_SCHED;
            PG8_LDB(B1, 0, 1); PG8_STAGE(PG8_SB(0, 0), b2, voffB);
            PG8_BAR; PG8_WAIT_L(0); PG8_MMA(0, 1, At, B1); PG8_BAR;
            PG8_LDA(At, 0, 1); PG8_STAGE(PG8_SA(0, 0), a2, voffA);
            PG8_BAR; PG8_WAIT_L(0); PG8_MMA(1, 0, At, B0); PG8_BAR; PG8_SCHED;
            PG8_STAGE(PG8_SB(0, 1), b2 + hstep, voffB);
            PG8_WAIT_V(6); PG8_BAR; PG8_MMA(1, 1, At, B1); PG8_BAR;
            PG8_LDB(B0, 1, 0); PG8_SCHED; PG8_LDA(At, 1, 0); PG8_STAGE(PG8_SA(0, 1), a2 + hstep, voffA);
            PG8_WAIT_L(8); PG8_BAR; PG8_WAIT_L(0); PG8_MMA(0, 0, At, B0); PG8_BAR; PG8_SCHED;
            PG8_LDB(B1, 1, 1); PG8_STAGE(PG8_SB(1, 0), b3, voffB);
            PG8_BAR; PG8_WAIT_L(0); PG8_MMA(0, 1, At, B1); PG8_BAR;
            PG8_LDA(At, 1, 1); PG8_STAGE(PG8_SA(1, 0), a3, voffA);
            PG8_BAR; PG8_WAIT_L(0); PG8_MMA(1, 0, At, B0); PG8_BAR; PG8_SCHED;
            PG8_STAGE(PG8_SB(1, 1), b3 + hstep, voffB);
            PG8_WAIT_V(6); PG8_BAR; PG8_MMA(1, 1, At, B1); PG8_BAR;
            }
        }
        if constexpr (ALIGN_EPI) { if (wr == 0) PG8_BAR; }
        if constexpr (!Epi::AFTER_DRAIN) { E(acc, cur, wr, wc, fr, fq); S.done(cur); }
        if (!has_next) break;
#pragma unroll
        for (int a = 0; a < 2; ++a)
#pragma unroll
            for (int b = 0; b < 2; ++b)
#pragma unroll
                for (int m = 0; m < 4; ++m)
#pragma unroll
                    for (int n = 0; n < 2; ++n) acc[a][b][m][n] = (f32x4){0.f, 0.f, 0.f, 0.f};
        cur = nxt; cA = nA; cB = nB; ++ui;
        if constexpr (ALIGN_EPI) { if (wr == 1) PG8_BAR; }
    }
    PG8_WAIT_V(0);
    if constexpr (!ALIGN_EPI) { if (wr == 0) PG8_BAR; }
    PG8_BAR;
    if constexpr (Epi::AFTER_DRAIN) { E.fused(acc, cur, wr, wc, fr, fq, lds, wid, lane); S.done(cur); }
#undef PG8_SA
#undef PG8_SB
#undef PG8_STAGE
#undef PG8_LDA
#undef PG8_LDB
#undef PG8_MMA
#undef PG8_WAIT_V
#undef PG8_WAIT_L
#undef PG8_BAR
#undef PG8_SCHED
}
}

namespace pg8 {
typedef unsigned u32x2 __attribute__((ext_vector_type(2)));
typedef float f32x2 __attribute__((ext_vector_type(2)));
__device__ __forceinline__ void rows_rstd(float (&rs)[2][4], const float* ssq, int pm, int wr, int fr, int fq) {
    f32x4 pa[2][4], pb[2][4];
    const float* base = ssq + (size_t)(pm * BM + wr * 64 + fr) * 32 + fq * 8;
#pragma unroll
    for (int ai = 0; ai < 2; ++ai)
#pragma unroll
        for (int m = 0; m < 4; ++m) { pa[ai][m] = *(const f32x4*)(base + (ai * HALF + m * 16) * 32); pb[ai][m] = *(const f32x4*)(base + (ai * HALF + m * 16) * 32 + 4); }
#pragma unroll
    for (int ai = 0; ai < 2; ++ai)
#pragma unroll
        for (int m = 0; m < 4; ++m) { const f32x4 a = pa[ai][m], b = pb[ai][m];
            float s = ((a[0] + a[1]) + (a[2] + a[3])) + ((b[0] + b[1]) + (b[2] + b[3]));
            s += __shfl_xor(s, 16); s += __shfl_xor(s, 32);
            rs[ai][m] = __builtin_amdgcn_rsqf(s * (1.0f / 2048.0f) + 1e-6f); }
}
__device__ __forceinline__ f32x4 to_rowmajor(f32x4 v, int pidx) {
    f32x4 o; o[0] = __int_as_float(__builtin_amdgcn_ds_bpermute(pidx, __float_as_int(v[0]))); o[1] = __int_as_float(__builtin_amdgcn_ds_bpermute(pidx, __float_as_int(v[1])));
    o[2] = __int_as_float(__builtin_amdgcn_ds_bpermute(pidx, __float_as_int(v[2]))); o[3] = __int_as_float(__builtin_amdgcn_ds_bpermute(pidx, __float_as_int(v[3]))); return o;
}
__device__ __forceinline__ int rowmajor_pidx(int lane) { return (((lane & 3) << 4) | (lane >> 2)) << 2; }
__device__ __forceinline__ void rows_rstd_rm(float (&rs)[2][4], const float* ssq, int pm, int wr, int r2, int c2) {
    f32x4 pa[2][4], pb[2][4];
    const float* base = ssq + (size_t)(pm * BM + wr * 64 + r2) * 32 + c2 * 8;
#pragma unroll
    for (int ai = 0; ai < 2; ++ai)
#pragma unroll
        for (int m = 0; m < 4; ++m) { pa[ai][m] = *(const f32x4*)(base + (ai * HALF + m * 16) * 32); pb[ai][m] = *(const f32x4*)(base + (ai * HALF + m * 16) * 32 + 4); }
#pragma unroll
    for (int ai = 0; ai < 2; ++ai)
#pragma unroll
        for (int m = 0; m < 4; ++m) { const f32x4 a = pa[ai][m], b = pb[ai][m];
            float s = ((a[0] + a[1]) + (a[2] + a[3])) + ((b[0] + b[1]) + (b[2] + b[3]));
            s += __shfl_xor(s, 1); s += __shfl_xor(s, 2);
            rs[ai][m] = __builtin_amdgcn_rsqf(s * (1.0f / 2048.0f) + 1e-6f); }
}
__device__ __forceinline__ float row_rstd(const float* ssq, int row, int fq) {
    const f32x4 a = *(const f32x4*)(ssq + (size_t)row * 32 + fq * 8), b = *(const f32x4*)(ssq + (size_t)row * 32 + fq * 8 + 4);
    float s = ((a[0] + a[1]) + (a[2] + a[3])) + ((b[0] + b[1]) + (b[2] + b[3]));
    s += __shfl_xor(s, 16); s += __shfl_xor(s, 32);
    return __builtin_amdgcn_rsqf(s * (1.0f / 2048.0f) + 1e-6f);
}
struct EpiResid {
    static constexpr bool PERM = true, AFTER_DRAIN = false;
    float* X; bf16_t* XB; float* ssq;
    __device__ __forceinline__ void operator()(const f32x4 (&acc)[2][2][4][2], const Unit& u, int wr, int wc, int fr_, int fq_) const {
        const int lane = fq_ * 16 + fr_, r2 = lane >> 2, c2 = lane & 3, pidx = rowmajor_pidx(lane);
        const int row0 = u.pm * BM + wr * 64 + r2, col0 = u.pn * BM + wc * 32 + 8 * c2;
        u32x4 v[4][2];
#define EPR_LOAD(g) do { const size_t off_ = (size_t)(row0 + ((g) >> 2) * HALF + ((g) & 3) * 16) * 2048 + col0; _Pragma("unroll") for (int bj = 0; bj < 2; ++bj) \
            v[(g) & 3][bj] = *(const u32x4*)(XB + off_ + bj * HALF); } while (0)
        EPR_LOAD(0); EPR_LOAD(1); EPR_LOAD(2);
#pragma unroll
        for (int g = 0; g < 8; ++g) { const int ai = g >> 2, m = g & 3; const int row = row0 + ai * HALF + m * 16; const size_t off = (size_t)row * 2048 + col0; float s = 0.f;
            if (g + 3 < 8) EPR_LOAD(g + 3);
#pragma unroll
            for (int bj = 0; bj < 2; ++bj) { const u32x4 xo = v[g & 3][bj];
                const f32x4 x0 = (f32x4){__uint_as_float(xo.x << 16), __uint_as_float(xo.x & 0xffff0000u), __uint_as_float(xo.y << 16), __uint_as_float(xo.y & 0xffff0000u)} + to_rowmajor(acc[ai][bj][m][0], pidx);
                const f32x4 x1 = (f32x4){__uint_as_float(xo.z << 16), __uint_as_float(xo.z & 0xffff0000u), __uint_as_float(xo.w << 16), __uint_as_float(xo.w & 0xffff0000u)} + to_rowmajor(acc[ai][bj][m][1], pidx);
                if (X != nullptr) { *(f32x4*)(X + off + bj * HALF) = x0; *(f32x4*)(X + off + bj * HALF + 4) = x1; }
                u32x4 w; w.x = cvt_pk_bf16(x0[0], x0[1]); w.y = cvt_pk_bf16(x0[2], x0[3]); w.z = cvt_pk_bf16(x1[0], x1[1]); w.w = cvt_pk_bf16(x1[2], x1[3]); *(u32x4*)(XB + off + bj * HALF) = w;
                s += ((x0[0] * x0[0] + x0[1] * x0[1]) + (x0[2] * x0[2] + x0[3] * x0[3])) + ((x1[0] * x1[0] + x1[1] * x1[1]) + (x1[2] * x1[2] + x1[3] * x1[3])); }
            s += __shfl_xor(s, 1); s += __shfl_xor(s, 2);
            if (c2 == 0) ssq[(size_t)row * 32 + u.pn * 4 + wc] = s;
            asm volatile("" ::: "memory"); }
#undef EPR_LOAD
    }
};
struct EpiSwiglu {
    static constexpr bool PERM = true, AFTER_DRAIN = false;
    bf16_t* H; int ldh; const float* ssq;
    __device__ __forceinline__ void operator()(const f32x4 (&acc)[2][2][4][2], const Unit& u, int wr, int wc, int fr_, int fq_) const {
        const int lane = fq_ * 16 + fr_, r2 = lane >> 2, c2 = lane & 3, pidx = rowmajor_pidx(lane);
        const int row0 = u.pm * BM + wr * 64 + r2, col0 = u.pn * HALF + wc * 32 + 8 * c2;
        f32x4 pa[2][4], pb[2][4];
        { const float* base = ssq + (size_t)(u.pm * BM + wr * 64 + r2) * 32 + c2 * 8;
#pragma unroll
          for (int ai = 0; ai < 2; ++ai)
#pragma unroll
            for (int m = 0; m < 4; ++m) { pa[ai][m] = *(const f32x4*)(base + (ai * HALF + m * 16) * 32); pb[ai][m] = *(const f32x4*)(base + (ai * HALF + m * 16) * 32 + 4); } }
        __builtin_amdgcn_sched_barrier(0);
        f32x4 rm[2][2][4][2];
#pragma unroll
        for (int ai = 0; ai < 2; ++ai)
#pragma unroll
            for (int bj = 0; bj < 2; ++bj)
#pragma unroll
                for (int m = 0; m < 4; ++m)
#pragma unroll
                    for (int n = 0; n < 2; ++n) rm[ai][bj][m][n] = to_rowmajor(acc[ai][bj][m][n], pidx);
        __builtin_amdgcn_sched_barrier(0);
        float rs[2][4];
#pragma unroll
        for (int ai = 0; ai < 2; ++ai)
#pragma unroll
            for (int m = 0; m < 4; ++m) { const f32x4 a = pa[ai][m], b = pb[ai][m];
                float sq = ((a[0] + a[1]) + (a[2] + a[3])) + ((b[0] + b[1]) + (b[2] + b[3]));
                sq += __shfl_xor(sq, 1); sq += __shfl_xor(sq, 2);
                rs[ai][m] = __builtin_amdgcn_rsqf(sq * (1.0f / 2048.0f) + 1e-6f); }
#pragma unroll
        for (int ai = 0; ai < 2; ++ai)
#pragma unroll
            for (int m = 0; m < 4; ++m) { const float r = rs[ai][m], c1 = -1.4426950408889634f * r, ms = __builtin_amdgcn_rcpf(r * r); float hv[8];
#pragma unroll
                for (int n = 0; n < 2; ++n) { const f32x4 gv = rm[ai][0][m][n], uv = rm[ai][1][m][n];
#pragma unroll
                    for (int i = 0; i < 4; i += 2) {
                        const f32x2 g2 = (f32x2){gv[i], gv[i + 1]}, u2 = (f32x2){uv[i], uv[i + 1]}; const f32x2 t2 = g2 * c1;
                        f32x2 e2; e2.x = __builtin_amdgcn_exp2f(t2.x); e2.y = __builtin_amdgcn_exp2f(t2.y);
                        const f32x2 d2 = e2 * ms + ms; f32x2 s2; s2.x = __builtin_amdgcn_rcpf(d2.x); s2.y = __builtin_amdgcn_rcpf(d2.y);
                        const f32x2 h2 = (g2 * u2) * s2; hv[4 * n + i] = h2.x; hv[4 * n + i + 1] = h2.y; } }
                u32x4 w; w.x = cvt_pk_bf16(hv[0], hv[1]); w.y = cvt_pk_bf16(hv[2], hv[3]); w.z = cvt_pk_bf16(hv[4], hv[5]); w.w = cvt_pk_bf16(hv[6], hv[7]);
                *(u32x4*)(H + (size_t)(row0 + ai * HALF + m * 16) * ldh + col0) = w; }
    }
};
struct EpiQKV {
    static constexpr bool PERM = true, AFTER_DRAIN = false;
    const float* ssq; const float* gq; const float* gk;
    bf16_t* QP; size_t pstride;
    bf16_t* QS; bf16_t* KS; size_t sstride; int srows, lc;
    float* okp; size_t opstride; float* oks; size_t osstride;
    int fox;
    PG8_LAS float* red;
    __device__ __forceinline__ void operator()(const f32x4 (&acc)[2][2][4][2], const Unit& u, int wr, int wc, int fr_, int fq_) const {
        int fr = fr_, fq = fq_; asm volatile("" : "+v"(fr), "+v"(fq));
        const int which = u.pn >> 3, head0 = (u.pn & 7) * 2;
        const int lane_ = fq_ * 16 + fr_, r2 = lane_ >> 2, c2 = lane_ & 3, pidx = rowmajor_pidx(lane_);
        float rsv[2][4]; rows_rstd_rm(rsv, ssq, u.pm, wr, r2, c2);
        if (which < 2) {
#pragma unroll
            for (int ai = 0; ai < 2; ++ai)
#pragma unroll
                for (int m = 0; m < 4; ++m)
#pragma unroll
                    for (int bj = 0; bj < 2; ++bj) { float s = 0.f;
#pragma unroll
                        for (int n = 0; n < 2; ++n) { const f32x4 x = acc[ai][bj][m][n]; s += (x[0] * x[0] + x[1] * x[1]) + (x[2] * x[2] + x[3] * x[3]); }
                        s += __shfl_xor(s, 16); s += __shfl_xor(s, 32);
                        if (fq == 0) red[(wc * 256 + ai * HALF + wr * 64 + m * 16 + fr) * 2 + bj] = s; }
            asm volatile("s_waitcnt lgkmcnt(0)" ::: "memory"); __builtin_amdgcn_s_barrier(); asm volatile("" ::: "memory");
        }
        const int cih = wc * 32 + 8 * c2;
        f32x4 g0 = (f32x4){1.f, 1.f, 1.f, 1.f}, g1 = g0;
        if (which < 2) { const float* g = (which == 0 ? gq : gk) + cih; g0 = *(const f32x4*)g; g1 = *(const f32x4*)(g + 4); }
        const bool samp = u.pm >= 64;
        const bool f32out = which > 0 && (samp || fox || (u.pm & 31) >= 30);
        char* b16; char* b32 = nullptr; unsigned hs16, rowsz = 0;
        if (!samp) { const int bb = u.pm >> 5;
            b16 = (char*)(QP + (size_t)which * pstride + (size_t)(bb * 16 + head0) * (8192 * 128)); hs16 = 8192 * 128 * 2;
            if (f32out) b32 = (char*)(okp + (size_t)(which - 1) * opstride + (fox ? (size_t)bb * 8192 * 2048 : (size_t)bb * 512 * 2048) + head0 * 128);
        } else { rowsz = (which == 0) ? 16u : (unsigned)srows;
            b16 = (which == 0) ? (char*)QS : (char*)(KS + (size_t)(which == 2 ? 1 : 0) * sstride + (size_t)lc * 128); hs16 = rowsz * 256u;
            if (f32out) b32 = (char*)(oks + (size_t)(which - 1) * osstride + head0 * 128); }
        const int trow0 = samp ? 0 : ((u.pm & 31) * 256 - ((fox || !f32out) ? 0 : 7680));
#pragma unroll
        for (int ai = 0; ai < 2; ++ai)
#pragma unroll
            for (int m = 0; m < 4; ++m) { const int rit = ai * HALF + wr * 64 + m * 16 + r2;
                const float rs = rsv[ai][m];
                unsigned o16;
                if (!samp) o16 = (unsigned)((((u.pm & 31) * 256 + rit) * 128 + cih) * 2);
                else o16 = (unsigned)(((((rit >> 4) * 16 + head0) * rowsz + (rit & 15)) * 128 + cih) * 2);
                const unsigned o32 = (unsigned)(((trow0 + rit) * 2048 + cih) * 4);
#pragma unroll
                for (int bj = 0; bj < 2; ++bj) { float sc = rs;
                    if (which < 2) { const int ri = rit * 2 + bj; const float t = (red[ri] + red[512 + ri]) + (red[1024 + ri] + red[1536 + ri]);
                        sc = rs * __builtin_amdgcn_rsqf(t * rs * rs * (1.0f / 128.0f) + 1e-6f); }
                    const f32x4 x0 = to_rowmajor(acc[ai][bj][m][0], pidx) * sc * g0, x1 = to_rowmajor(acc[ai][bj][m][1], pidx) * sc * g1;
                    u32x4 w; w.x = cvt_pk_bf16(x0[0], x0[1]); w.y = cvt_pk_bf16(x0[2], x0[3]); w.z = cvt_pk_bf16(x1[0], x1[1]); w.w = cvt_pk_bf16(x1[2], x1[3]);
                    *(u32x4*)(b16 + (size_t)(o16 + (unsigned)bj * hs16)) = w;
                    if (f32out) { float* fo = (float*)(b32 + (size_t)(o32 + (unsigned)bj * 512u)); __builtin_nontemporal_store(x0, (f32x4*)fo); __builtin_nontemporal_store(x1, (f32x4*)(fo + 4)); } }
                asm volatile("" ::: "memory"); }
    }
};
}

namespace sk {
typedef short bf16x8 __attribute__((ext_vector_type(8)));
typedef float f32x4 __attribute__((ext_vector_type(4)));
typedef unsigned u32x2 __attribute__((ext_vector_type(2)));
typedef unsigned u32x4 __attribute__((ext_vector_type(4)));
typedef unsigned short bf16_t;
#define SLAS __attribute__((address_space(3)))
__device__ __forceinline__ unsigned cvtpk(float lo, float hi) { unsigned r; asm volatile("v_cvt_pk_bf16_f32 %0, %1, %2" : "=v"(r) : "v"(lo), "v"(hi)); return r; }
__device__ __forceinline__ float row_rstd(const float* ssq, int row, int fq) {
    const f32x4 a = *(const f32x4*)(ssq + (size_t)row * 32 + fq * 8), b = *(const f32x4*)(ssq + (size_t)row * 32 + fq * 8 + 4);
    float s = ((a[0] + a[1]) + (a[2] + a[3])) + ((b[0] + b[1]) + (b[2] + b[3]));
    s += __shfl_xor(s, 16); s += __shfl_xor(s, 32);
    return __builtin_amdgcn_rsqf(s * (1.0f / 2048.0f) + 1e-6f);
}
struct SkResid {
    static constexpr int MB = 2, NB = 2, NS = 6; static constexpr bool NEEDS_X = true;
    const float* xin; float* X; bf16_t* XB; float* ssq;
    __device__ __forceinline__ int brow(int ct, int ch, int n) const { return ct * 64 + ch * 32 + 16 * n; }
    __device__ __forceinline__ void partial(f32x4 (&acc)[MB][NB], int rt, int ct, int ch, int fr, int fq, SLAS float* red) const {
        f32x4 xo[MB][NB];
#pragma unroll
        for (int m = 0; m < MB; ++m)
#pragma unroll
            for (int n = 0; n < NB; ++n) xo[m][n] = *(const f32x4*)(xin + (size_t)(rt * 32 + 16 * m + fr) * 2048 + ct * 64 + ch * 32 + 16 * n + 4 * fq);
#pragma unroll
        for (int m = 0; m < MB; ++m) { float s = 0.f;
#pragma unroll
            for (int n = 0; n < NB; ++n) { const f32x4 x = xo[m][n] + acc[m][n]; acc[m][n] = x; s += (x[0] * x[0] + x[1] * x[1]) + (x[2] * x[2] + x[3] * x[3]); }
            s += __shfl_xor(s, 16); s += __shfl_xor(s, 32);
            if (fq == 0) red[ch * 32 + 16 * m + fr] = s; }
    }
    __device__ __forceinline__ void operator()(const f32x4 (&acc)[MB][NB], int rt, int ct, int ch, int fr, int fq, SLAS float* red) const {
#pragma unroll
        for (int m = 0; m < MB; ++m) { const int r = rt * 32 + 16 * m + fr; const size_t off = (size_t)r * 2048 + ct * 64 + ch * 32 + 4 * fq;
#pragma unroll
            for (int n = 0; n < NB; ++n) { const f32x4 x = acc[m][n];
                *(f32x4*)(X + off + 16 * n) = x; u32x2 w; w.x = cvtpk(x[0], x[1]); w.y = cvtpk(x[2], x[3]); *(u32x2*)(XB + off + 16 * n) = w; }
            if (ch == 0 && fq == 0) ssq[(size_t)r * 32 + ct] = red[16 * m + fr] + red[32 + 16 * m + fr]; }
    }
};
struct SkSwiglu {
    static constexpr int MB = 4, NB = 4, NS = 3; static constexpr bool NEEDS_X = false;
    bf16_t* H; int ldh; const float* ssq;
    __device__ __forceinline__ int brow(int ct, int ch, int n) const { return 256 * (ct >> 1) + (ct & 1) * 64 + ch * 32 + (n >= 2 ? 128 + 16 * (n - 2) : 16 * n); }
    __device__ __forceinline__ void partial(f32x4 (&acc)[MB][NB], int, int, int, int, int, SLAS float*) const {}
    __device__ __forceinline__ void operator()(const f32x4 (&acc)[MB][NB], int rt, int ct, int ch, int fr, int fq, SLAS float* red) const {
        float rs[MB];
        { f32x4 pa[MB], pb[MB];
#pragma unroll
          for (int m = 0; m < MB; ++m) { const float* sp = ssq + (size_t)(rt * 64 + 16 * m + fr) * 32 + fq * 8; pa[m] = *(const f32x4*)sp; pb[m] = *(const f32x4*)(sp + 4); }
#pragma unroll
          for (int m = 0; m < MB; ++m) { float s = ((pa[m][0] + pa[m][1]) + (pa[m][2] + pa[m][3])) + ((pb[m][0] + pb[m][1]) + (pb[m][2] + pb[m][3]));
              s += __shfl_xor(s, 16); s += __shfl_xor(s, 32); rs[m] = __builtin_amdgcn_rsqf(s * (1.0f / 2048.0f) + 1e-6f); } }
#pragma unroll
        for (int m = 0; m < MB; ++m) { const int r = rt * 64 + 16 * m + fr;
#pragma unroll
            for (int n = 0; n < 2; ++n) { float hv[4];
#pragma unroll
                for (int i = 0; i < 4; ++i) { const float g = acc[m][n][i] * rs[m], up = acc[m][n + 2][i] * rs[m]; hv[i] = g * __builtin_amdgcn_rcpf(1.0f + __expf(-g)) * up; }
                u32x2 w; w.x = cvtpk(hv[0], hv[1]); w.y = cvtpk(hv[2], hv[3]);
                *(u32x2*)(H + (size_t)r * ldh + 128 * (ct >> 1) + (ct & 1) * 64 + ch * 32 + 16 * n + 4 * fq) = w; } }
    }
};
struct SkQKV {
    static constexpr int MB = 4, NB = 4, NS = 3; static constexpr bool NEEDS_X = true;
    const float* ssq; const float* gq; const float* gk;
    bf16_t* QS; bf16_t* KS; size_t sstride; int srows, lc;
    float* oks; size_t osstride;
    __device__ __forceinline__ int brow(int ct, int ch, int n) const { return ct * 128 + ch * 64 + 16 * n; }
    __device__ __forceinline__ void partial(f32x4 (&acc)[MB][NB], int, int, int ch, int fr, int fq, SLAS float* red) const {
#pragma unroll
        for (int m = 0; m < MB; ++m) { float s = 0.f;
#pragma unroll
            for (int n = 0; n < NB; ++n) { const f32x4 x = acc[m][n]; s += (x[0] * x[0] + x[1] * x[1]) + (x[2] * x[2] + x[3] * x[3]); }
            s += __shfl_xor(s, 16); s += __shfl_xor(s, 32);
            if (fq == 0) red[ch * 64 + 16 * m + fr] = s; }
    }
    __device__ __forceinline__ void operator()(const f32x4 (&acc)[MB][NB], int rt, int ct, int ch, int fr, int fq, SLAS float* red) const {
        const int which = ct >> 4, h = ct & 15;
        const float* g = (which == 0 ? gq : gk) + ch * 64 + 4 * fq;
        bf16_t* b16 = (which == 0) ? QS : KS + (size_t)(which == 2 ? 1 : 0) * sstride + (size_t)lc * 128; const int rowsz = (which == 0) ? 16 : srows;
        float* b32 = oks + (size_t)(which > 0 ? which - 1 : 0) * osstride + h * 128 + ch * 64 + 4 * fq;
        float rs[MB];
        { f32x4 pa[MB], pb[MB];
#pragma unroll
          for (int m = 0; m < MB; ++m) { const float* sp = ssq + (size_t)(rt * 64 + 16 * m + fr) * 32 + fq * 8; pa[m] = *(const f32x4*)sp; pb[m] = *(const f32x4*)(sp + 4); }
#pragma unroll
          for (int m = 0; m < MB; ++m) { float s = ((pa[m][0] + pa[m][1]) + (pa[m][2] + pa[m][3])) + ((pb[m][0] + pb[m][1]) + (pb[m][2] + pb[m][3]));
              s += __shfl_xor(s, 16); s += __shfl_xor(s, 32); rs[m] = __builtin_amdgcn_rsqf(s * (1.0f / 2048.0f) + 1e-6f); } }
#pragma unroll
        for (int m = 0; m < MB; ++m) { const int r = rt * 64 + 16 * m + fr; float sc = rs[m];
            if (which < 2) { const float s = red[16 * m + fr] + red[64 + 16 * m + fr]; sc = rs[m] * __builtin_amdgcn_rsqf(s * rs[m] * rs[m] * (1.0f / 128.0f) + 1e-6f); }
            bf16_t* d16 = b16 + ((size_t)((r >> 4) * 16 + h) * rowsz + (r & 15)) * 128 + ch * 64 + 4 * fq; float* d32 = b32 + (size_t)r * 2048;
#pragma unroll
            for (int n = 0; n < NB; ++n) { f32x4 x = acc[m][n] * sc; if (which < 2) x = x * *(const f32x4*)(g + 16 * n);
                u32x2 w; w.x = cvtpk(x[0], x[1]); w.y = cvtpk(x[2], x[3]); *(u32x2*)(d16 + 16 * n) = w;
                if (which > 0) *(f32x4*)(d32 + 16 * n) = x; } }
    }
};
template <class Epi>
__device__ __forceinline__ void skinny_phase(SLAS unsigned char* lds, const bf16_t* A, const bf16_t* Bt, int nct, int K, unsigned* qc  , int tid, const Epi& E) {
    constexpr int MB = Epi::MB, NB = Epi::NB, NS = Epi::NS, NRT = 16 / MB, SLOT = MB * NB * 1024;
    const int lane = tid & 63, wid = __builtin_amdgcn_readfirstlane(tid >> 6), fr = lane & 15, fq = lane >> 4, kq = wid & 3, ch = wid >> 2;
    const int kw = K >> 2;
    SLAS float* red = (SLAS float*)(lds + 4 * SLOT);
    for (;;) {
        volatile SLAS int* tw = (volatile SLAS int*)(lds + 67712);
        if (tid == 0) *tw = (int)__hip_atomic_fetch_add(qc, 1u, __ATOMIC_RELAXED, __HIP_MEMORY_SCOPE_AGENT);
        __syncthreads();
        const int tile = __builtin_amdgcn_readfirstlane(*tw);
        if (tile >= NRT * nct) break;
        const int rt = tile % NRT, ct = tile / NRT;
        f32x4 acc[MB][NB];
#pragma unroll
        for (int m = 0; m < MB; ++m)
#pragma unroll
            for (int n = 0; n < NB; ++n) acc[m][n] = (f32x4){0.f, 0.f, 0.f, 0.f};
        const unsigned lo = (unsigned)(((lane >> 2) * K + kq * kw + (lane & 3) * 8) * 2);
        const int pidx = (((lane & 15) << 2) | (lane >> 4)) << 2;
        const char* ab = (const char*)(A + (size_t)(rt * 16 * MB) * K);
        const char* bb[NB];
#pragma unroll
        for (int n = 0; n < NB; ++n) bb[n] = (const char*)(Bt + (size_t)E.brow(ct, ch, n) * K);
        bf16x8 fa[NS][MB], fb[NS][NB];
#define SK_LOAD(st, ks) do { const unsigned o_ = lo + (unsigned)((ks) * 2); _Pragma("unroll") for (int m = 0; m < MB; ++m) fa[st][m] = *(const bf16x8*)(ab + (size_t)(o_ + (unsigned)(16 * m * K * 2))); \
            _Pragma("unroll") for (int n = 0; n < NB; ++n) fb[st][n] = *(const bf16x8*)(bb[n] + (size_t)o_); } while (0)
#define SK_PERM(v) do { u32x4 w_ = __builtin_bit_cast(u32x4, v); w_.x = (unsigned)__builtin_amdgcn_ds_bpermute(pidx, (int)w_.x); w_.y = (unsigned)__builtin_amdgcn_ds_bpermute(pidx, (int)w_.y); \
            w_.z = (unsigned)__builtin_amdgcn_ds_bpermute(pidx, (int)w_.z); w_.w = (unsigned)__builtin_amdgcn_ds_bpermute(pidx, (int)w_.w); v = __builtin_bit_cast(bf16x8, w_); } while (0)
#define SK_MMA(st) do { _Pragma("unroll") for (int m = 0; m < MB; ++m) SK_PERM(fa[st][m]); _Pragma("unroll") for (int n = 0; n < NB; ++n) SK_PERM(fb[st][n]); \
            _Pragma("unroll") for (int m = 0; m < MB; ++m) _Pragma("unroll") for (int n = 0; n < NB; ++n) acc[m][n] = __builtin_amdgcn_mfma_f32_16x16x32_bf16(fb[st][n], fa[st][m], acc[m][n], 0, 0, 0); } while (0)
#define SK_SB() __builtin_amdgcn_sched_barrier(0)
        const int nst = kw >> 5, kl = kw - 32;
#pragma unroll
        for (int j = 0; j < NS - 1; ++j) { SK_LOAD(j, (j * 32 < kw ? j * 32 : kl)); SK_SB(); }
        for (int s0 = 0; s0 < nst; s0 += NS) {
#pragma unroll
            for (int j = 0; j < NS; ++j) { const int kn = (s0 + j + NS - 1) * 32; SK_LOAD((j + NS - 1) % NS, kn < kw ? kn : kl); SK_SB(); if (s0 + j < nst) SK_MMA(j); SK_SB(); }
        }
#undef SK_SB
#undef SK_LOAD
#undef SK_MMA
#undef SK_PERM
#pragma unroll
        for (int half = 2; half >= 1; half >>= 1) {
            if (kq >= half && kq < 2 * half) { SLAS f32x4* s = (SLAS f32x4*)(lds + (ch * 2 + kq - half) * SLOT) + lane;
#pragma unroll
                for (int m = 0; m < MB; ++m)
#pragma unroll
                    for (int n = 0; n < NB; ++n) s[(m * NB + n) * 64] = acc[m][n]; }
            __syncthreads();
            if (kq < half) { const SLAS f32x4* s = (const SLAS f32x4*)(lds + (ch * 2 + kq) * SLOT) + lane;
#pragma unroll
                for (int m = 0; m < MB; ++m)
#pragma unroll
                    for (int n = 0; n < NB; ++n) acc[m][n] = acc[m][n] + s[(m * NB + n) * 64]; }
            __syncthreads();
        }
        if constexpr (Epi::NEEDS_X) { if (kq == 0) E.partial(acc, rt, ct, ch, fr, fq, red); __syncthreads(); }
        if (kq == 0) E(acc, rt, ct, ch, fr, fq, red);
        if constexpr (Epi::NEEDS_X) __syncthreads();
    }
}
}

namespace att {
typedef short bf16x8 __attribute__((ext_vector_type(8)));
typedef short s16x4 __attribute__((ext_vector_type(4)));
typedef float f32x16 __attribute__((ext_vector_type(16)));
typedef float f32x4 __attribute__((ext_vector_type(4)));
typedef unsigned u32x4 __attribute__((ext_vector_type(4)));
typedef unsigned short bf16;
#define ALAS __attribute__((address_space(3)))
constexpr int D = 128, NW = 8, QBLK = 32, KVBLK = 64, QB = NW * QBLK;
constexpr int SHM_V = KVBLK * D * 2, SHM_K = KVBLK * D * 2;
constexpr int OFF_V = 0, OFF_K = 2 * SHM_V, OFF_WS = 2 * SHM_V + 2 * SHM_K, OFF_TAB = OFF_WS + NW * 64 * 4, OFF_BIAS = OFF_TAB + 1024, LDS_END = OFF_BIAS + 8192 * 4 + 512;
constexpr float SCALE = 0.08838834764831845f, RSCALE = 11.313708498984761f;
constexpr float THR = 8.f;
#define KSWZ(row, colB) ((row) * 256 + ((colB) ^ (((row) & 7) << 4)))
#define SBAR() __builtin_amdgcn_sched_barrier(0)
__device__ __forceinline__ int v_st(int k, int c) { const int kk = (k & ~0xC) | ((k & 4) << 1) | ((k & 8) >> 1); return ((kk >> 3) * 4 + (c >> 5)) * 512 + ((kk & 7) * 32 + (c & 31)) * 2; }
__device__ __forceinline__ int v_rd_base(int lane) { return ((lane & 3) << 3) | (((lane >> 2) & 3) << 6) | (((lane >> 4) & 1) << 5) | (((lane >> 5) & 1) << 8); }
constexpr int v_rd_off(int d0, int ks, int half) { return d0 * 512 + ks * 4096 + half * 2048; }
__device__ __forceinline__ int crow(int r, int hi) { return (r & 3) + 8 * (r >> 2) + 4 * hi; }
__device__ __forceinline__ unsigned cvtpk(float lo, float hi) { unsigned r; asm volatile("v_cvt_pk_bf16_f32 %0, %1, %2" : "=v"(r) : "v"(lo), "v"(hi)); return r; }
__device__ __forceinline__ bf16x8 load8(const bf16* p) { return *reinterpret_cast<const bf16x8*>(p); }
__device__ __forceinline__ void mask_tile(f32x16& p0, f32x16& p1, int dq) {
    const float NEG = -__builtin_inff();
#pragma unroll
    for (int r = 0; r < 16; ++r) {
        const int c = (r & 3) + 8 * (r >> 2);
        if (dq - c < 0) p0[r] = NEG;
        if (dq - c - 32 < 0) p1[r] = NEG;
    }
}
__device__ __forceinline__ void partialSM(f32x16& p0, f32x16& p1, float& m_reg, float& mn, float& alpha) {
    float pmax = p0[0]; for (int r = 1; r < 16; ++r) pmax = fmaxf(pmax, p0[r]); for (int r = 0; r < 16; ++r) pmax = fmaxf(pmax, p1[r]);
    { auto rr = __builtin_amdgcn_permlane32_swap(__float_as_uint(pmax), __float_as_uint(pmax), false, false);
      pmax = fmaxf(__uint_as_float(rr[0]), __uint_as_float(rr[1])); }
    constexpr float C2 = 1.4426950408889634f * SCALE;
    if (__builtin_expect(__all((pmax - m_reg) * SCALE <= THR), 1)) { mn = m_reg; alpha = 1.f; }
    else { mn = fmaxf(m_reg, pmax); alpha = __builtin_amdgcn_exp2f((m_reg - mn) * C2); m_reg = mn; }
    const float mnL = -mn * C2;
    for (int r = 0; r < 16; ++r) p0[r] = fmaf(p0[r], C2, mnL); for (int r = 0; r < 16; ++r) p1[r] = fmaf(p1[r], C2, mnL);
    for (int r = 0; r < 16; ++r) p0[r] = __builtin_amdgcn_exp2f(p0[r]);
}
__device__ __forceinline__ void finishSM(f32x16& p0, f32x16& p1, float alpha, float& l_reg, bf16x8& pa0, bf16x8& pa1, bf16x8& pa2, bf16x8& pa3) {
    for (int r = 0; r < 16; ++r) p1[r] = __builtin_amdgcn_exp2f(p1[r]);
    float ps = 0; for (int r = 0; r < 16; ++r) ps += p0[r]; for (int r = 0; r < 16; ++r) ps += p1[r];
    { auto rr = __builtin_amdgcn_permlane32_swap(__float_as_uint(ps), __float_as_uint(ps), false, false);
      ps = __uint_as_float(rr[0]) + __uint_as_float(rr[1]); }
    l_reg = l_reg * alpha + ps;
#define PK4(P, B_, OUT) do { unsigned a0 = cvtpk(P[B_+0], P[B_+1]), a1 = cvtpk(P[B_+2], P[B_+3]);                          \
        unsigned b0 = cvtpk(P[B_+4], P[B_+5]), b1 = cvtpk(P[B_+6], P[B_+7]);                                             \
        auto r0 = __builtin_amdgcn_permlane32_swap(a0, b0, false, false); auto r1 = __builtin_amdgcn_permlane32_swap(a1, b1, false, false); \
        u32x4 w = {r0[0], r1[0], r0[1], r1[1]}; OUT = *reinterpret_cast<bf16x8*>(&w); } while (0)
    PK4(p0, 0, pa0); PK4(p0, 8, pa1); PK4(p1, 0, pa2); PK4(p1, 8, pa3);
#undef PK4
}
struct Blk {
    const bf16* Q; const bf16* K; const bf16* V; bf16* O;
    const float* aux;
    int P0;
    int jlo, jhi;
    int cap;
    int c0;
    float skipthr;
};
struct Nxt { const bf16* Q; const bf16* K; const bf16* V; int jlo; };
constexpr int OSTR = 2048;
struct Seam { bf16x8 qr[8]; bf16x8 st_v0, st_v1, st_k0, st_k1; };

template <int MODE, int KB>
__device__ __forceinline__ void qkt(f32x16& p0, f32x16& p1, ALAS const char* lds, int r32, int hi, const bf16x8* qr, bool act, int tile  , int dist  , int irow  ) {
    if (!act) { const float NEG = -__builtin_inff();
#pragma unroll
        for (int r = 0; r < 16; ++r) { p0[r] = NEG; p1[r] = NEG; } return; }
    if constexpr (MODE == 1) {
        ALAS const float* bp = (ALAS const float*)(lds + OFF_BIAS) + tile * 64 + 4 * hi;
#pragma unroll
        for (int i = 0; i < 4; ++i) { const f32x4 a = *(ALAS const f32x4*)(bp + 8 * i), b = *(ALAS const f32x4*)(bp + 32 + 8 * i);
            p0[4 * i] = a[0]; p0[4 * i + 1] = a[1]; p0[4 * i + 2] = a[2]; p0[4 * i + 3] = a[3]; p1[4 * i] = b[0]; p1[4 * i + 1] = b[1]; p1[4 * i + 2] = b[2]; p1[4 * i + 3] = b[3]; }
    } else {
        ALAS const float* R = (ALAS const float*)(lds + OFF_TAB);
        if (dist <= 2) { ALAS const float* rp = R + (191 - 64 * dist - irow + 4 * hi);
#pragma unroll
            for (int r = 0; r < 16; ++r) { p0[r] = rp[(r & 3) + 8 * (r >> 2)]; p1[r] = rp[32 + (r & 3) + 8 * (r >> 2)]; } }
        else { const float cf = R[0];
#pragma unroll
            for (int r = 0; r < 16; ++r) { p0[r] = cf; p1[r] = cf; } }
    }
    ALAS const char* K_lds = lds + OFF_K;
    ALAS const char* kb[4];
#pragma unroll
    for (int dd = 0; dd < 4; ++dd) kb[dd] = K_lds + KB * SHM_K + KSWZ(r32, (dd * 16 + hi * 8) * 2);
#pragma unroll
    for (int d0 = 0; d0 < 8; ++d0) { ALAS const char* a = kb[d0 & 3] + (d0 >> 2) * 128;
        bf16x8 b0 = *reinterpret_cast<ALAS const bf16x8*>(a);
        bf16x8 b1 = *reinterpret_cast<ALAS const bf16x8*>(a + 32 * 256);
        p0 = __builtin_amdgcn_mfma_f32_32x32x16_bf16(b0, qr[d0], p0, 0, 0, 0);
        p1 = __builtin_amdgcn_mfma_f32_32x32x16_bf16(b1, qr[d0], p1, 0, 0, 0); }
}
template <int MODE, int VB>
__device__ __forceinline__ void pv_tile(f32x16* o, int vb0, bf16x8 pa0, bf16x8 pa1, bf16x8 pa2, bf16x8 pa3, bool act) {
    if (!act) return;
#define TRRD(dst, off) asm volatile("ds_read_b64_tr_b16 %0, %1 offset:%2" : "=&v"(dst) : "v"(vb0), "i"(off) : "memory")
#define PV_D0(d0) do { s16x4 l0, l1, l2, l3, h0, h1, h2, h3; constexpr int b_ = VB * SHM_V + v_rd_off(d0, 0, 0); \
        TRRD(l0, b_); TRRD(h0, b_ + 2048); TRRD(l1, b_ + 4096); TRRD(h1, b_ + 6144); TRRD(l2, b_ + 8192); TRRD(h2, b_ + 10240); TRRD(l3, b_ + 12288); TRRD(h3, b_ + 14336); \
        asm volatile("s_waitcnt lgkmcnt(0)" ::: "memory"); SBAR();   \
        o[d0] = __builtin_amdgcn_mfma_f32_32x32x16_bf16(pa0, (bf16x8){l0[0], l0[1], l0[2], l0[3], h0[0], h0[1], h0[2], h0[3]}, o[d0], 0, 0, 0);   \
        o[d0] = __builtin_amdgcn_mfma_f32_32x32x16_bf16(pa1, (bf16x8){l1[0], l1[1], l1[2], l1[3], h1[0], h1[1], h1[2], h1[3]}, o[d0], 0, 0, 0);   \
        o[d0] = __builtin_amdgcn_mfma_f32_32x32x16_bf16(pa2, (bf16x8){l2[0], l2[1], l2[2], l2[3], h2[0], h2[1], h2[2], h2[3]}, o[d0], 0, 0, 0);   \
        o[d0] = __builtin_amdgcn_mfma_f32_32x32x16_bf16(pa3, (bf16x8){l3[0], l3[1], l3[2], l3[3], h3[0], h3[1], h3[2], h3[3]}, o[d0], 0, 0, 0); } while (0)
    PV_D0(0); PV_D0(1); PV_D0(2); PV_D0(3);
#undef PV_D0
#undef TRRD
}
#define AROW(p, k0, rr) ((const bf16*)((const char*)(p) + (size_t)(unsigned)(((k0) + (rr)) * (D * 2) + sc * 2)))
#define VMW() asm volatile("s_waitcnt vmcnt(0)" ::: "memory")
#define VMWN(n) asm volatile("s_waitcnt vmcnt(%0)" :: "i"(n) : "memory")
#define SLOAD_H(Kp, Vp, k0) do { S.st_v0 = load8(AROW(Vp, k0, sr)); S.st_v1 = load8(AROW(Vp, k0, 32 + sr));              \
                         S.st_k0 = load8(AROW(Kp, k0, sr)); S.st_k1 = load8(AROW(Kp, k0, 32 + sr)); } while (0)
#define SWRITE_HK(bf) do { *(ALAS bf16x8*)(K_lds + (bf) * SHM_K + kws) = S.st_k0; *(ALAS bf16x8*)(K_lds + (bf) * SHM_K + kws + 32 * 256) = S.st_k1; } while (0)
#define SWRITE_HV(bf) do { *(ALAS bf16x8*)(V_lds + (bf) * SHM_V + vst0) = S.st_v0; *(ALAS bf16x8*)(V_lds + (bf) * SHM_V + vst1) = S.st_v1; } while (0)
#define SWRITE_H(bf) do { SWRITE_HV(bf); SWRITE_HK(bf); } while (0)
template <int MODE>
__device__ __forceinline__ float build_bias(const Blk& b, ALAS char* lds, int tid) {
    asm volatile("" : "+v"(tid));
    if constexpr (MODE == 0) {
        if (tid < 256) { int d = 191 - tid; d = d < -128 ? -128 : (d > 128 ? 128 : d); ((ALAS float*)(lds + OFF_TAB))[tid] = b.aux[d + 128] * RSCALE; }
        return 0.f;
    } else {
        const int nk = b.jhi * 64, nv = b.cap + 1, e0 = tid * 16, lane = tid & 63, wid = tid >> 6;
        float v[16];
#pragma unroll
        for (int i = 0; i < 4; ++i) { f32x4 x = (f32x4){0.f, 0.f, 0.f, 0.f};
            if (e0 + 4 * i < nv) x = *(const f32x4*)(b.aux + e0 + 4 * i);
            v[4 * i] = x[0]; v[4 * i + 1] = x[1]; v[4 * i + 2] = x[2]; v[4 * i + 3] = x[3]; }
        float run = 0.f;
#pragma unroll
        for (int i = 15; i >= 0; --i) { const float x = v[i]; v[i] = run; run += x; }
        float incl = run;
#pragma unroll
        for (int o = 1; o < 64; o <<= 1) { const float t = __int_as_float(__builtin_amdgcn_ds_bpermute(((lane + o) & 63) << 2, __float_as_int(incl))); if (lane + o < 64) incl += t; }
        ALAS float* wt = (ALAS float*)(lds + OFF_TAB);
        if (lane == 0) wt[wid] = incl;
        asm volatile("s_waitcnt lgkmcnt(0)" ::: "memory"); __builtin_amdgcn_s_barrier(); asm volatile("" ::: "memory");
        float after = incl - run;
#pragma unroll
        for (int w = 1; w < 8; ++w) { const float t = wt[w]; if (w > wid) after += t; }
        if (e0 < nk) { ALAS f32x4* o4 = (ALAS f32x4*)(lds + OFF_BIAS) + tid * 4;
#pragma unroll
            for (int i = 0; i < 4; ++i) o4[i] = (f32x4){(v[4 * i] + after) * RSCALE, (v[4 * i + 1] + after) * RSCALE, (v[4 * i + 2] + after) * RSCALE, (v[4 * i + 3] + after) * RSCALE}; }
        return after;
    }
}
template <int MODE>
__device__ __forceinline__ void attn_prime(const Blk& cur, ALAS char* lds, Seam& S, int tid) {
    asm volatile("" : "+v"(tid));
    const int wid = __builtin_amdgcn_readfirstlane(tid >> 6), lane = tid & 63, r32 = lane & 31, hi = lane >> 5;
    const int sr = tid >> 4, sc = (tid & 15) * 8, kws = KSWZ(sr, sc * 2); ALAS char* K_lds = lds + OFF_K;
    const int kb0 = cur.jlo * KVBLK;
    const int qrow = wid * QBLK + r32;
#pragma unroll
    for (int d0 = 0; d0 < 8; ++d0) S.qr[d0] = load8((const bf16*)((const char*)cur.Q + (size_t)(unsigned)(qrow * (D * 2) + hi * 16 + d0 * 32)));
    SLOAD_H(cur.K, cur.V, kb0); VMW(); SWRITE_HK(0);
    __syncthreads();
}
template <int MODE, class IssueFn, class NextFn>
__device__ __forceinline__ void attn_block(const Blk& cur, IssueFn&& issue_fn, NextFn&& next_fn, ALAS char* lds, Seam& S, int tid) {
    asm volatile("" : "+v"(tid));
    const int wid = __builtin_amdgcn_readfirstlane(tid >> 6), lane = tid & 63, r32 = lane & 31, hi = lane >> 5;
    bf16x8 kd[8];
    if constexpr (MODE == 1) { const char* kp = (const char*)cur.K + (size_t)(unsigned)((cur.P0 + wid * QBLK + r32) * (D * 2) + hi * 16);
#pragma unroll
        for (int d0 = 0; d0 < 8; ++d0) kd[d0] = load8((const bf16*)(kp + d0 * 32)); }
    const float s_end = build_bias<MODE>(cur, lds, tid);
    asm volatile("s_waitcnt lgkmcnt(0)" ::: "memory"); __syncthreads();
    int j_lo = cur.jlo;
    const int sr = tid >> 4, sc = (tid & 15) * 8, vst0 = v_st(sr, sc), vst1 = v_st(32 + sr, sc), kws = KSWZ(sr, sc * 2);
    ALAS char* V_lds = lds + OFF_V; ALAS char* K_lds = lds + OFF_K;
    if constexpr (MODE == 1) {
        float dsum = 0.f;
#pragma unroll
        for (int d0 = 0; d0 < 8; ++d0) { const u32x4 qa = *reinterpret_cast<const u32x4*>(&S.qr[d0]), ka = *reinterpret_cast<const u32x4*>(&kd[d0]);
#pragma unroll
            for (int i = 0; i < 4; ++i) { dsum = fmaf(__uint_as_float(qa[i] << 16), __uint_as_float(ka[i] << 16), dsum);
                dsum = fmaf(__uint_as_float(qa[i] & 0xffff0000u), __uint_as_float(ka[i] & 0xffff0000u), dsum); } }
        { auto rr = __builtin_amdgcn_permlane32_swap(__float_as_uint(dsum), __float_as_uint(dsum), false, false); dsum = __uint_as_float(rr[0]) + __uint_as_float(rr[1]); }
        float gv = (((ALAS const float*)(lds + OFF_BIAS))[cur.P0 + wid * QBLK + r32] + dsum) * SCALE;
#pragma unroll
        for (int o = 1; o < 32; o <<= 1) gv = fminf(gv, __shfl_xor(gv, o));
        ALAS float* wg = (ALAS float*)(lds + OFF_TAB) + 32;
        if (lane == 0) wg[wid] = gv;
        asm volatile("s_waitcnt lgkmcnt(0)" ::: "memory"); __builtin_amdgcn_s_barrier(); asm volatile("" ::: "memory");
        float G = wg[0];
#pragma unroll
        for (int w = 1; w < 8; ++w) G = fminf(G, wg[w]);
        const bool pred = ((tid & 3) == 3) && ((tid >> 2) < (cur.P0 >> 6)) && (s_end < G - cur.skipthr);
        const int cnt = __builtin_popcountll(__ballot(pred));
        ALAS int* wcnt = (ALAS int*)(lds + OFF_TAB) + 16;
        if (lane == 0) wcnt[wid] = cnt;
        asm volatile("s_waitcnt lgkmcnt(0)" ::: "memory"); __builtin_amdgcn_s_barrier(); asm volatile("" ::: "memory");
        int tot = 0;
#pragma unroll
        for (int w = 0; w < 8; ++w) tot += wcnt[w];
        j_lo = __builtin_amdgcn_readfirstlane(tot);
        if (j_lo != cur.jlo) {
            SLOAD_H(cur.K, cur.V, j_lo * KVBLK); VMW(); SWRITE_HK(0); }
        __syncthreads();
    }
    const int NT = cur.jhi - j_lo;
    const int wlim = cur.P0 + wid * QBLK;
    const int qm = wlim + r32 - 4 * hi;
    const int cw = cur.c0 + (wid >> 1);
    const int irow = (wid & 1) * 32 + r32;
    ALAS float* wsf = (ALAS float*)(lds + OFF_WS) + wid * 64; ALAS float* li_l = wsf; ALAS float* al_l = wsf + 32;
    float m_reg = -1e30f, l_reg = 0; f32x16 o[4] = {};
    const int vb0 = (int)(unsigned)(unsigned long long)V_lds + v_rd_base(lane);
    const bf16* Kh = cur.K; const bf16* Vh = cur.V;
#define RESC(a) do { if (__any((a) < 1.f)) { if (hi == 0) al_l[r32] = (a); asm volatile("s_waitcnt lgkmcnt(0)" ::: "memory");              \
                     for (int d_ = 0; d_ < 4; ++d_) for (int r = 0; r < 16; ++r) o[d_][r] *= al_l[crow(r, hi)]; } } while (0)
#define KBASE(t) ((j_lo + (t)) * KVBLK)
#define ACT(t) (MODE == 1 ? (KBASE(t) <= wlim + QBLK - 1) : ((j_lo + (t)) >= cw - 8 && (j_lo + (t)) <= cw))
#define MASKT(P0_, P1_, t) do { if (MODE == 1) { const int kb_ = KBASE(t); if (kb_ + KVBLK - 1 > wlim) mask_tile(P0_, P1_, qm - kb_); } } while (0)
#define QKT(KB, PX0, PX1, t) qkt<MODE, KB>(PX0, PX1, lds, r32, hi, S.qr, ACT(t), j_lo + (t), cw - (j_lo + (t)), irow)
    constexpr int NQL = 8;
#define SEAM_K0() do { VMWN(NQL); SWRITE_HK(0); SBAR(); } while (0)
    f32x16 pA0, pA1, pB0, pB1; float mnA, mnB, alA, alB; bf16x8 pa0, pa1, pa2, pa3;
    SWRITE_HV(0); SBAR();
    if (NT > 1) SLOAD_H(Kh, Vh, KBASE(1));
    SBAR(); QKT(0, pA0, pA1, 0);
    MASKT(pA0, pA1, 0); partialSM(pA0, pA1, m_reg, mnA, alA);
    if (NT > 1) { VMW(); SWRITE_H(1); }
    __syncthreads();
#define HALF_STEP(PX0, PX1, mnX, alX, PY0, PY1, alY, t, KB, VB, SB) do {                                                      \
        SBAR(); QKT(KB, PX0, PX1, t);                                                                                          \
        finishSM(PY0, PY1, alY, l_reg, pa0, pa1, pa2, pa3); SBAR();                                                           \
        if ((t) + 1 < NT) { SLOAD_H(Kh, Vh, KBASE((t) + 1)); SBAR(); }                                                        \
        pv_tile<MODE, VB>(o, vb0, pa0, pa1, pa2, pa3, ACT((t) - 1)); MASKT(PX0, PX1, (t)); partialSM(PX0, PX1, m_reg, mnX, alX);   \
        __syncthreads();                                                                                                      \
        if ((t) + 1 < NT) { VMW(); SWRITE_H(SB); }                                                                            \
        RESC(alX); __syncthreads(); } while (0)
    if (NT < 3) issue_fn();
    for (int t = 1; t + 1 < NT; t += 2) {
        if (t + 3 >= NT) issue_fn();
        HALF_STEP(pB0, pB1, mnB, alB, pA0, pA1, alA, t, 1, 0, 0);
        HALF_STEP(pA0, pA1, mnA, alA, pB0, pB1, alB, t + 1, 0, 1, 1);
    }
    Nxt nxt; next_fn(nxt);
    const int kbn = nxt.jlo * KVBLK;
    const bool even = (NT & 1) == 0;
    if (even) { SBAR(); QKT(1, pB0, pB1, NT - 1); SBAR(); }
    SLOAD_H(nxt.K, nxt.V, kbn); SBAR();
    { const int qrow = wid * QBLK + r32;
#pragma unroll
      for (int d0 = 0; d0 < 8; ++d0) S.qr[d0] = load8((const bf16*)((const char*)nxt.Q + (size_t)(unsigned)(qrow * (D * 2) + hi * 16 + d0 * 32))); }
    SBAR();
    finishSM(pA0, pA1, alA, l_reg, pa0, pa1, pa2, pa3); SBAR();
    pv_tile<MODE, 0>(o, vb0, pa0, pa1, pa2, pa3, ACT(even ? NT - 2 : NT - 1));
    if (even) { MASKT(pB0, pB1, NT - 1); partialSM(pB0, pB1, m_reg, mnB, alB); __syncthreads(); RESC(alB);
        finishSM(pB0, pB1, alB, l_reg, pa0, pa1, pa2, pa3); SBAR(); pv_tile<MODE, 1>(o, vb0, pa0, pa1, pa2, pa3, ACT(NT - 1)); }
    SBAR(); SEAM_K0();
    __syncthreads();
    if (hi == 0) li_l[r32] = l_reg; asm volatile("s_waitcnt lgkmcnt(0)" ::: "memory");
    float rli[16];
#pragma unroll
    for (int r = 0; r < 16; ++r) rli[r] = __builtin_amdgcn_rcpf(li_l[crow(r, hi)]);
    ALAS char* stg = lds + OFF_V + wid * 4096 + (4 * hi) * 128 + r32 * 2;
    ALAS const char* srd = lds + OFF_V + wid * 4096 + (lane >> 3) * 128 + (lane & 7) * 16;
    unsigned ooff = (unsigned)(((wid * QBLK + (lane >> 3)) * OSTR + (lane & 7) * 8) * 2);
    asm volatile("" : "+v"(ooff));
#pragma unroll
    for (int ps = 0; ps < 2; ++ps) {
#pragma unroll
        for (int dd = 0; dd < 2; ++dd)
#pragma unroll
            for (int r = 0; r < 16; r += 2) { const unsigned w = cvtpk(o[2 * ps + dd][r] * rli[r], o[2 * ps + dd][r + 1] * rli[r + 1]);
                ALAS char* a = stg + ((r & 3) + 8 * (r >> 2)) * 128 + dd * 64;
                *(ALAS unsigned short*)a = (unsigned short)w; *(ALAS unsigned short*)(a + 128) = (unsigned short)(w >> 16); }
        asm volatile("s_waitcnt lgkmcnt(0)" ::: "memory");
        u32x4 q[4];
#pragma unroll
        for (int i = 0; i < 4; ++i) q[i] = *(ALAS const u32x4*)(srd + i * 1024);
        asm volatile("s_waitcnt lgkmcnt(0)" ::: "memory");
#pragma unroll
        for (int i = 0; i < 4; ++i) *(u32x4*)((char*)cur.O + (size_t)(ooff + (unsigned)(i * 8 * OSTR * 2 + ps * 128))) = q[i];
    }
    __syncthreads();
#undef RESC
#undef KBASE
#undef ACT
#undef MASKT
#undef QKT
#undef SEAM_K0
#undef HALF_STEP
}
#undef AROW
#undef VMW
#undef VMWN
#undef SLOAD_H
#undef SWRITE_HK
#undef SWRITE_HV
#undef SWRITE_H
}

constexpr int NWAVES = 8;
constexpr int NB = 2, T = 8192, D = 2048, NH = 16, HD = 128, FF = 5632, DEPTH = 4;
constexpr int SB = 16, SN = 16, PAST = 1024, WIN = 512, NREL = 257;
constexpr int MP = NB * T, MS = SB * SN, M = MP + MS;
constexpr int NQKV = 3 * D, NGU = 2 * FF;
constexpr int LS = PAST + SN;
constexpr float EPS = 1e-6f, SCALE = 0.08838834764831845f;
constexpr size_t O_Y = 0, O_YS = (size_t)MP * D, O_AKP = O_YS + (size_t)MS * D, SZ_AP = (size_t)2 * NB * WIN * D, O_AVP = O_AKP + SZ_AP, O_BKP = O_AVP + SZ_AP,
    SZ_BP = (size_t)2 * MP * D, O_BVP = O_BKP + SZ_BP, O_BFP = O_BVP + SZ_BP, SZ_BFP = (size_t)2 * MP * NH, O_AKS = O_BFP + SZ_BFP, SZ_S = (size_t)2 * MS * D,
    O_AVS = O_AKS + SZ_S, O_BKS = O_AVS + SZ_S, O_BVS = O_BKS + SZ_S, O_BFS = O_BVS + SZ_S, OUT_TOTAL = O_BFS + (size_t)2 * MS * NH;
static_assert(OUT_TOTAL == 181411840, "out size");
constexpr size_t MiB = 1u << 20;
constexpr size_t WS_CTL = 0, CTL_ZERO_BYTES = 1 * MiB;
constexpr size_t WS_WQKV = 2 * MiB, WS_WO = 98 * MiB, WS_WGU = 130 * MiB, WS_WD = 306 * MiB;
constexpr size_t WS_XB = 394 * MiB, WS_SSQ = 459 * MiB;
constexpr size_t WS_QP = 462 * MiB, WS_KP = 526 * MiB, WS_VP = 590 * MiB;
constexpr size_t WS_QS = 654 * MiB;
constexpr size_t WS_OB = 655 * MiB, WS_HB = 720 * MiB;
constexpr size_t WS_KSN = 899 * MiB, WS_VSN = 900 * MiB;
constexpr size_t WS_LFP = 1315 * MiB, WS_WF = 1316 * MiB  , WS_LFS = 1317 * MiB, WS_CUMS = 1319 * MiB, WS_END = 1321 * MiB;
static_assert(WS_WQKV + (size_t)DEPTH * NQKV * D * 2 <= WS_WO && WS_WO + (size_t)DEPTH * D * D * 2 <= WS_WGU && WS_WGU + (size_t)DEPTH * NGU * D * 2 <= WS_WD && WS_WD + (size_t)DEPTH * D * FF * 2 <= WS_XB, "ws map: weights");
static_assert(WS_XB + (size_t)M * D * 2 <= WS_SSQ && WS_SSQ + (size_t)M * 32 * 4 <= WS_QP && WS_OB + (size_t)M * D * 2 <= WS_HB && WS_HB + (size_t)M * FF * 2 <= WS_KSN, "ws map: activations");
constexpr int CW_BAR = 4096, CW_QUEUE = 8192, CW_SKQ = 8192 + 256;
constexpr size_t WS_QKM = WS_WF + 512 * 1024;
constexpr int RING_OFF = 0, RING_BYTES = 131072;
constexpr int LDSCTL_OFF = RING_BYTES, MISC_OFF = LDSCTL_OFF + 320, RED_OFF = LDSCTL_OFF + 1024;
constexpr int LDS_BYTES = 147456;
#define GAS __attribute__((address_space(1)))
#define LAS __attribute__((address_space(3)))
typedef unsigned short bf16;
typedef unsigned v4u __attribute__((ext_vector_type(4)));
typedef float f32x4 __attribute__((ext_vector_type(4)));
typedef short bf16x8 __attribute__((ext_vector_type(8)));
typedef GAS unsigned gu32;
typedef GAS unsigned long long gu64;
#define RLX_AGENT __ATOMIC_RELAXED, __HIP_MEMORY_SCOPE_AGENT
#define LDS_WAIT() asm volatile("s_waitcnt lgkmcnt(0)" ::: "memory")
#define VM_WAIT() asm volatile("s_waitcnt vmcnt(0)" ::: "memory")
__device__ __forceinline__ unsigned long long rt() { return __builtin_amdgcn_s_memrealtime(); }
__device__ __forceinline__ unsigned f2bf(float f) { unsigned u = __builtin_bit_cast(unsigned, f); return (u + 0x7fffu + ((u >> 16) & 1u)) >> 16; }
__device__ __forceinline__ unsigned pk2(float lo, float hi) { return f2bf(lo) | (f2bf(hi) << 16); }

#define XB_TMO      128
#define XB_XCNT(j)  (256  + 64 * (j))
#define XB_XSUB(j)  (1280 + 64 * (j))
#define XB_XGEN(j)  (2304 + 64 * (j))
#define XB_TOP      3328
#define XB_TOPGEN   3392
#define XCD_BAR_WORDS 3456
#define XB_SPIN_CAP (1u << 22)

__device__ __forceinline__ unsigned xb_ld(unsigned* p)              { return __hip_atomic_load(p, __ATOMIC_RELAXED, __HIP_MEMORY_SCOPE_AGENT); }
__device__ __forceinline__ unsigned xb_add(unsigned* p, unsigned v) { return __hip_atomic_fetch_add(p, v, __ATOMIC_RELAXED, __HIP_MEMORY_SCOPE_AGENT); }
__device__ __forceinline__ unsigned xb_xcc_id() { return (unsigned)__builtin_amdgcn_s_getreg((3 << 11) | 20) & 0xFu; }
#define XB_SPIN(cond, bar) do { unsigned _sp = 0; while (cond) { __builtin_amdgcn_s_sleep(1); \
    if ((++_sp & 255u) == 0u) { if (xb_ld(&(bar)[XB_TMO])) break; if (_sp > XB_SPIN_CAP) { atomicAdd(&(bar)[XB_TMO], 1u); break; } } } } while (0)

struct XcdBarrier {
    unsigned* bar; unsigned x;
    volatile LAS unsigned* st;
};

__device__ __forceinline__ XcdBarrier xcd_barrier_post(unsigned* bar, volatile LAS unsigned* st, const bool leader  ) {
    XcdBarrier b; b.bar = bar; b.x = xb_xcc_id(); b.st = st;
    if (leader) (void)xb_add(&bar[XB_XCNT(b.x)], 1u);
    return b;
}
__device__ __forceinline__ void xcd_barrier_complete(unsigned* bar, unsigned x, unsigned& nloc, unsigned& nx) {
    const unsigned G = gridDim.x * gridDim.y * gridDim.z;
    unsigned sum, cnt, mine, sp = 0u;
    for (;;) {
        sum = 0u; cnt = 0u; mine = 0u;
#pragma unroll
        for (unsigned j = 0; j < 16; ++j) { const unsigned c = xb_ld(&bar[XB_XCNT(j)]); sum += c; cnt += (c > 0u) ? 1u : 0u; mine = (j == x) ? c : mine; }
        if (sum == G) break;
        __builtin_amdgcn_s_sleep(1);
        if ((++sp & 255u) == 0u) { if (xb_ld(&bar[XB_TMO])) break; if (sp > XB_SPIN_CAP) { atomicAdd(&bar[XB_TMO], 1u); break; } }
    }
    nloc = mine > 0u ? mine : 1u; nx = cnt > 0u ? cnt : 1u;
}

__device__ __forceinline__ void xcd_barrier(const XcdBarrier& b, const bool leader  ) {
    asm volatile("s_waitcnt vmcnt(0)" ::: "memory");
    __syncthreads();
    if (leader) {
        unsigned* bar = b.bar;
        __builtin_amdgcn_s_waitcnt(0);
        unsigned nloc = b.st[0], nx = b.st[1];
        if (nloc == 0u) { xcd_barrier_complete(bar, b.x, nloc, nx); b.st[0] = nloc; b.st[1] = nx; }
        const unsigned old = xb_add(&bar[XB_XSUB(b.x)], 1u);
        const unsigned gen = old / nloc;
        if (old + 1u == (gen + 1u) * nloc) {
            __builtin_amdgcn_fence(__ATOMIC_RELEASE, "agent");
            asm volatile("s_waitcnt vmcnt(0)" ::: "memory");
            const unsigned og = xb_add(&bar[XB_TOP], 1u);
            const unsigned tg = og / nx;
            if (og + 1u == (tg + 1u) * nx) xb_add(&bar[XB_TOPGEN], 1u);
            else XB_SPIN(xb_ld(&bar[XB_TOPGEN]) == tg, bar);
            __builtin_amdgcn_fence(__ATOMIC_ACQUIRE, "agent");
            xb_add(&bar[XB_XGEN(b.x)], 1u);
            asm volatile("s_waitcnt vmcnt(0)" ::: "memory");
        } else {
            XB_SPIN(xb_ld(&bar[XB_XGEN(b.x)]) == gen, bar);
            __builtin_amdgcn_fence(__ATOMIC_ACQUIRE, "agent");
            asm volatile("s_waitcnt vmcnt(0)" ::: "memory");
        }
    }
    __syncthreads();
}

typedef float f32x2 __attribute__((ext_vector_type(2)));
__device__ __forceinline__ float wave_sum(float v) {
#pragma unroll
    for (int o = 1; o < 64; o <<= 1) v += __shfl_xor(v, o);
    return v;
}
__device__ __forceinline__ float bf2f(unsigned b) { return __uint_as_float(b << 16); }

__device__ __forceinline__ void p0_transpose_item(const float* W, const float* g, int K, int N, bf16* WT, int mode, LAS float* scr, int item, int lane) {
    const int nblk = N / 32, kb = item / nblk, nb = item % nblk, k0 = 64 * kb, n0 = 32 * nb;
    const int kr = lane >> 3, nc = (lane & 7) * 4;
    f32x4 v[8]; float gs[8];
#pragma unroll
    for (int i = 0; i < 8; ++i) { v[i] = *(const GAS f32x4*)(W + (size_t)(k0 + kr + 8 * i) * N + n0 + nc); gs[i] = g ? g[k0 + kr + 8 * i] : 1.f; }
#pragma unroll
    for (int i = 0; i < 8; ++i) { LAS float* s = scr + (kr + 8 * i) * 33 + nc; s[0] = v[i].x * gs[i]; s[1] = v[i].y * gs[i]; s[2] = v[i].z * gs[i]; s[3] = v[i].w * gs[i]; }
    LDS_WAIT(); asm volatile("" ::: "memory");
    const int c = lane & 7;
    const int drow0 = (mode == 0) ? n0 : (256 * (n0 >> 7) + (n0 & 127) + (mode == 2 ? 128 : 0));
#pragma unroll
    for (int j = 0; j < 4; ++j) { const int n = (lane >> 3) + 8 * j; const LAS float* s = scr + (8 * c) * 33 + n;
        v4u o; o.x = pk2(s[0 * 33], s[1 * 33]); o.y = pk2(s[2 * 33], s[3 * 33]); o.z = pk2(s[4 * 33], s[5 * 33]); o.w = pk2(s[6 * 33], s[7 * 33]);
        *(GAS v4u*)(WT + (size_t)(drow0 + n) * K + k0 + 8 * c) = o; }
    LDS_WAIT(); asm volatile("" ::: "memory");
}
__device__ __forceinline__ void p0_item128(const float* W, const float* g, int K, int N, bf16* WT, int mode, LAS float* scr, int item, int lane) {
    const int nblk = N / 32, kb = item / nblk, nb = item % nblk, k0 = 128 * kb, n0 = 32 * nb;
    const int kr = lane >> 3, nc = (lane & 7) * 4;
    f32x4 v[16]; float gs[16];
#pragma unroll
    for (int i = 0; i < 16; ++i) { v[i] = *(const GAS f32x4*)(W + (size_t)(k0 + kr + 8 * i) * N + n0 + nc); gs[i] = g ? g[k0 + kr + 8 * i] : 1.f; }
    const int c = lane & 7;
    const int drow0 = (mode == 0) ? n0 : (256 * (n0 >> 7) + (n0 & 127) + (mode == 2 ? 128 : 0));
#pragma unroll
    for (int hf = 0; hf < 2; ++hf) {
#pragma unroll
        for (int i = 0; i < 8; ++i) { LAS float* s = scr + (kr + 8 * i) * 33 + nc; const f32x4 x = v[hf * 8 + i]; const float gg = gs[hf * 8 + i]; s[0] = x.x * gg; s[1] = x.y * gg; s[2] = x.z * gg; s[3] = x.w * gg; }
        LDS_WAIT(); asm volatile("" ::: "memory");
#pragma unroll
        for (int j = 0; j < 4; ++j) { const int n = (lane >> 3) + 8 * j; const LAS float* s = scr + (8 * c) * 33 + n;
            v4u o; o.x = pk2(s[0 * 33], s[1 * 33]); o.y = pk2(s[2 * 33], s[3 * 33]); o.z = pk2(s[4 * 33], s[5 * 33]); o.w = pk2(s[6 * 33], s[7 * 33]);
            *(GAS v4u*)(WT + (size_t)(drow0 + n) * K + k0 + 64 * hf + 8 * c) = o; }
        LDS_WAIT(); asm volatile("" ::: "memory");
    }
}
constexpr int CI_QKV = (D / 128) * (NQKV / 32), CI_O = (D / 128) * (D / 32), CI_G = (D / 128) * (FF / 32), CI_D = (FF / 128) * (D / 32), CI_L = CI_O + 2 * CI_G + CI_D;
__device__ __forceinline__ int conv_group_items(int grp) { return grp == 0 ? CI_QKV : (grp <= 3 ? CI_L + CI_QKV : CI_L); }
__device__ __forceinline__ void conv_item(const float* const __attribute__((address_space(4)))* in, unsigned char* ws, int grp, int it, LAS float* scr, int lane) {
    bf16* WQKV = (bf16*)(ws + WS_WQKV); bf16* WO = (bf16*)(ws + WS_WO); bf16* WGU = (bf16*)(ws + WS_WGU); bf16* WD = (bf16*)(ws + WS_WD);
    int r = it;
    if (grp > 0) { const int L = grp - 1; const float* gf = in[15] + (size_t)L * D;
        if (r < CI_O) { p0_item128(in[11] + (size_t)L * D * D, nullptr, D, D, WO + (size_t)L * D * D, 0, scr, r, lane); return; } r -= CI_O;
        if (r < CI_G) { p0_item128(in[16] + (size_t)L * D * FF, gf, D, FF, WGU + (size_t)L * NGU * D, 1, scr, r, lane); return; } r -= CI_G;
        if (r < CI_G) { p0_item128(in[17] + (size_t)L * D * FF, gf, D, FF, WGU + (size_t)L * NGU * D, 2, scr, r, lane); return; } r -= CI_G;
        if (r < CI_D) { p0_item128(in[18] + (size_t)L * FF * D, nullptr, FF, D, WD + (size_t)L * D * FF, 0, scr, r, lane); return; } r -= CI_D;
    }
    const int Lq = grp;
    p0_item128(in[8] + (size_t)Lq * D * NQKV, in[7] + (size_t)Lq * D, D, NQKV, WQKV + (size_t)Lq * NQKV * D, 0, scr, r, lane);
}
constexpr int N_SLICE = 256;
struct ConvD { const float* W; const float* g; bf16* WT; int K, N, mode, item; };
__device__ __forceinline__ ConvD conv_desc(const float* const __attribute__((address_space(4)))* in, unsigned char* ws, int grp, int it) {
    ConvD d; int r = it; const int L = grp - 1;
    if (r < CI_O) { d.W = in[11] + (size_t)L * D * D; d.g = nullptr; d.WT = (bf16*)(ws + WS_WO) + (size_t)L * D * D; d.K = D; d.N = D; d.mode = 0; d.item = r; return d; } r -= CI_O;
    if (r < 2 * CI_G) { const int up = r >= CI_G ? 1 : 0; d.W = in[16 + up] + (size_t)L * D * FF; d.g = in[15] + (size_t)L * D; d.WT = (bf16*)(ws + WS_WGU) + (size_t)L * NGU * D; d.K = D; d.N = FF; d.mode = 1 + up; d.item = r - up * CI_G; return d; } r -= 2 * CI_G;
    if (r < CI_D) { d.W = in[18] + (size_t)L * FF * D; d.g = nullptr; d.WT = (bf16*)(ws + WS_WD) + (size_t)L * D * FF; d.K = FF; d.N = D; d.mode = 0; d.item = r; return d; } r -= CI_D;
    d.W = in[8] + (size_t)grp * D * NQKV; d.g = in[7] + (size_t)grp * D; d.WT = (bf16*)(ws + WS_WQKV) + (size_t)grp * NQKV * D; d.K = D; d.N = NQKV; d.mode = 0; d.item = r; return d;
}
__device__ __forceinline__ void p0_load128(const ConvD& d, f32x4 (&v)[16], float (&gs)[16], int lane) {
    const int nblk = d.N / 32, kb = d.item / nblk, nb = d.item % nblk, k0 = 128 * kb, n0 = 32 * nb;
    const int kr = lane >> 3, nc = (lane & 7) * 4;
#pragma unroll
    for (int i = 0; i < 16; ++i) { v[i] = *(const GAS f32x4*)(d.W + (size_t)(k0 + kr + 8 * i) * d.N + n0 + nc); gs[i] = d.g ? d.g[k0 + kr + 8 * i] : 1.f; }
}
__device__ __forceinline__ void p0_finish128(const ConvD& d, const f32x4 (&v)[16], const float (&gs)[16], LAS float* scr, int lane) {
    const int nblk = d.N / 32, kb = d.item / nblk, nb = d.item % nblk, k0 = 128 * kb, n0 = 32 * nb;
    const int kr = lane >> 3, nc = (lane & 7) * 4, c = lane & 7;
    const int drow0 = (d.mode == 0) ? n0 : (256 * (n0 >> 7) + (n0 & 127) + (d.mode == 2 ? 128 : 0));
#pragma unroll
    for (int hf = 0; hf < 2; ++hf) {
#pragma unroll
        for (int i = 0; i < 8; ++i) { LAS float* s = scr + (kr + 8 * i) * 33 + nc; const f32x4 x = v[hf * 8 + i]; const float gg = gs[hf * 8 + i]; s[0] = x.x * gg; s[1] = x.y * gg; s[2] = x.z * gg; s[3] = x.w * gg; }
        LDS_WAIT(); asm volatile("" ::: "memory");
#pragma unroll
        for (int j = 0; j < 4; ++j) { const int n = (lane >> 3) + 8 * j; const LAS float* s = scr + (8 * c) * 33 + n;
            v4u o; o.x = pk2(s[0 * 33], s[1 * 33]); o.y = pk2(s[2 * 33], s[3 * 33]); o.z = pk2(s[4 * 33], s[5 * 33]); o.w = pk2(s[6 * 33], s[7 * 33]);
            *(GAS v4u*)(d.WT + (size_t)(drow0 + n) * d.K + k0 + 64 * hf + 8 * c) = o; }
        LDS_WAIT(); asm volatile("" ::: "memory");
    }
}
__device__ __forceinline__ void conv_slice(const float* const __attribute__((address_space(4)))* in, unsigned char* ws, int grp, int slice, LAS unsigned char* lds, int tid) {
    asm volatile("" : "+v"(tid));
    const int lane = tid & 63, wave = __builtin_amdgcn_readfirstlane(tid >> 6);
    LAS float* scr = (LAS float*)(lds + wave * 16384);
    const int ni = conv_group_items(grp), per = (ni + N_SLICE - 1) / N_SLICE, i0 = slice * per, i1 = (i0 + per < ni) ? i0 + per : ni;
    const int first = i0 + wave, n = (first < i1) ? (i1 - first + NWAVES - 1) / NWAVES : 0;
    if (n > 0) {
        f32x4 vA[16], vB[16]; float gA[16], gB[16];
        ConvD dA = conv_desc(in, ws, grp, first), dB = dA; p0_load128(dA, vA, gA, lane);
#pragma unroll 1
        for (int j = 0; j < n; j += 2) {
            dB = conv_desc(in, ws, grp, first + NWAVES * (j + 1 < n ? j + 1 : n - 1)); p0_load128(dB, vB, gB, lane); __builtin_amdgcn_sched_barrier(0);
            p0_finish128(dA, vA, gA, scr, lane); __builtin_amdgcn_sched_barrier(0);
            dA = conv_desc(in, ws, grp, first + NWAVES * (j + 2 < n ? j + 2 : n - 1)); p0_load128(dA, vA, gA, lane); __builtin_amdgcn_sched_barrier(0);
            if (j + 1 < n) p0_finish128(dB, vB, gB, scr, lane);
            __builtin_amdgcn_sched_barrier(0);
        }
    }
    __syncthreads();
}
__device__ __forceinline__ void row_update(const float* xold, const float* crow, float* xdst, bf16* xbrow, float* rstd_p, int lane) {
    const GAS f32x4* xr = (const GAS f32x4*)xold + lane; const GAS f32x4* cr = (const GAS f32x4*)crow + lane;
    GAS f32x4* xd = (GAS f32x4*)xdst + lane; GAS unsigned long long* o8 = (GAS unsigned long long*)xbrow + lane;
    float ss = 0.f;
#pragma unroll
    for (int j = 0; j < 8; ++j) { f32x4 v = xr[64 * j]; if (crow) v = v + cr[64 * j]; if (xdst) xd[64 * j] = v;
        ss += (v.x * v.x + v.y * v.y) + (v.z * v.z + v.w * v.w);
        o8[64 * j] = (unsigned long long)pk2(v.x, v.y) | ((unsigned long long)pk2(v.z, v.w) << 32); }
    ss = wave_sum(ss);
    if (lane < 32) rstd_p[lane] = (lane == 0) ? ss : 0.f;
}

template <int MODE>
__device__ __forceinline__ void sample_attn(LAS char* lds, int u, int li, unsigned char* ws, const float* rel, const float* kcache, const float* vcache, int tid) {
    asm volatile("" : "+v"(tid));
    constexpr int L = (MODE == 0) ? WIN : PAST, Lk = L + SN, NKB = Lk / 16, LkP = (Lk + 31) / 32 * 32, NST = LkP / 32, PP = LkP;
    constexpr int OFF_P = att::OFF_BIAS + 4352, OFF_RI = OFF_P + 16 * 1056 * 2;
    static_assert(16 * Lk * 4 <= att::OFF_TAB && OFF_RI + 64 <= 131072 && 8 * 16 * 128 * 4 <= att::OFF_TAB, "sample attention LDS map");
    const int lane = tid & 63, wid = __builtin_amdgcn_readfirstlane(tid >> 6), fr = lane & 15, fq = lane >> 4, st = u >> 4, h = u & 15;
    LAS float* S = (LAS float*)lds; LAS unsigned short* P = (LAS unsigned short*)(lds + OFF_P); LAS float* RI = (LAS float*)(lds + OFF_RI);
    const bf16* QSp = (const bf16*)(ws + WS_QS) + (size_t)u * SN * HD; const bf16* KNp = (const bf16*)(ws + WS_KSN) + (size_t)u * SN * HD; const bf16* VNp = (const bf16*)(ws + WS_VSN) + (size_t)u * SN * HD;
    const float* kc = kcache + ((size_t)(li * SB + st) * L) * D + h * HD; const float* vc = vcache + ((size_t)(li * SB + st) * L) * D + h * HD;
    if constexpr (MODE == 1) {
        att::Blk b; b.aux = (const float*)(ws + WS_LFS) + (size_t)u * LS; b.jhi = 17; b.cap = LS - 1; b.jlo = 0; b.P0 = PAST; b.c0 = 0; b.skipthr = 0.f; b.Q = nullptr; b.K = nullptr; b.V = nullptr; b.O = nullptr;
        (void)att::build_bias<1>(b, lds, tid);
    }
    pg8::bf16x8 qf[4];
#pragma unroll
    for (int ds = 0; ds < 4; ++ds) qf[ds] = *(const pg8::bf16x8*)(QSp + (size_t)fr * HD + ds * 32 + fq * 8);
    asm volatile("s_waitcnt lgkmcnt(0)" ::: "memory"); __syncthreads();
#define SA_SCORE(accv, key0_) do { f32x4 lg_; _Pragma("unroll") for (int r = 0; r < 4; ++r) { const int key = (key0_) + 4 * fq + r; float v_; \
            if (MODE == 1) { v_ = ((accv)[r] + ((LAS const float*)(lds + att::OFF_BIAS))[key]) * SCALE; if (key > L + fr) v_ = -__builtin_inff(); } \
            else { int dd = L + fr - key; dd = dd < -128 ? -128 : (dd > 128 ? 128 : dd); v_ = (accv)[r] * SCALE + rel[(size_t)(li * NH + h) * NREL + dd + 128]; } \
            lg_[r] = v_; } *(LAS f32x4*)(S + fr * Lk + (key0_) + 4 * fq) = lg_; } while (0)
    constexpr int NCB = L / 16 / NWAVES;
#pragma unroll 1
    for (int i = 0; i < NCB; i += 2) {
        f32x4 ka[2][4], kb2[2][4];
#pragma unroll
        for (int u2 = 0; u2 < 2; ++u2) { const float* kr = kc + (size_t)((wid + (i + u2) * NWAVES) * 16 + fr) * D + fq * 8;
#pragma unroll
            for (int ds = 0; ds < 4; ++ds) { ka[u2][ds] = *(const GAS f32x4*)(kr + ds * 32); kb2[u2][ds] = *(const GAS f32x4*)(kr + ds * 32 + 4); } }
#pragma unroll
        for (int u2 = 0; u2 < 2; ++u2) { pg8::f32x4 acc = (pg8::f32x4){0.f, 0.f, 0.f, 0.f};
#pragma unroll
            for (int ds = 0; ds < 4; ++ds) { const f32x4 a = ka[u2][ds], b2 = kb2[u2][ds];
                v4u w; w.x = pk2(a.x, a.y); w.y = pk2(a.z, a.w); w.z = pk2(b2.x, b2.y); w.w = pk2(b2.z, b2.w);
                acc = __builtin_amdgcn_mfma_f32_16x16x32_bf16(__builtin_bit_cast(pg8::bf16x8, w), qf[ds], acc, 0, 0, 0); }
            SA_SCORE(acc, (wid + (i + u2) * NWAVES) * 16); }
    }
    if (wid == 0) { const bf16* kr = KNp + (size_t)fr * HD + fq * 8; pg8::f32x4 acc = (pg8::f32x4){0.f, 0.f, 0.f, 0.f};
#pragma unroll
        for (int ds = 0; ds < 4; ++ds) acc = __builtin_amdgcn_mfma_f32_16x16x32_bf16(*(const pg8::bf16x8*)(kr + ds * 32), qf[ds], acc, 0, 0, 0);
        SA_SCORE(acc, L); }
#undef SA_SCORE
    asm volatile("s_waitcnt lgkmcnt(0)" ::: "memory"); __syncthreads();
#pragma unroll 1
    for (int rr = 0; rr < 2; ++rr) { const int q = 2 * wid + rr; LAS const float* sr = S + q * Lk; float m = -1e30f;
        for (int k = lane; k < Lk; k += 64) m = fmaxf(m, sr[k]);
#pragma unroll
        for (int o = 1; o < 64; o <<= 1) m = fmaxf(m, __int_as_float(__builtin_amdgcn_ds_bpermute(((lane ^ o) & 63) << 2, __float_as_int(m))));
        float sum = 0.f;
        for (int k = lane; k < PP; k += 64) { float p = 0.f; if (k < Lk) { p = __expf(sr[k] - m); sum += p; } P[q * 1056 + k] = (unsigned short)f2bf(p); }
#pragma unroll
        for (int o = 1; o < 64; o <<= 1) sum += __int_as_float(__builtin_amdgcn_ds_bpermute(((lane ^ o) & 63) << 2, __float_as_int(sum)));
        if (lane == 0) RI[q] = 1.0f / sum; }
    asm volatile("s_waitcnt lgkmcnt(0)" ::: "memory"); __syncthreads();
    pg8::f32x4 oacc[8];
#pragma unroll
    for (int db = 0; db < 8; ++db) oacc[db] = (pg8::f32x4){0.f, 0.f, 0.f, 0.f};
    constexpr int NCS = L / 32 / NWAVES;
#pragma unroll 1
    for (int i = 0; i < NCS; i += 2) {
        f32x4 ev[2][2][8];
#pragma unroll
        for (int u2 = 0; u2 < 2; ++u2) { const float* vr = vc + (size_t)((wid + (i + u2) * NWAVES) * 32 + fq * 8) * D + 4 * fr;
#pragma unroll
            for (int hf = 0; hf < 2; ++hf)
#pragma unroll
                for (int j = 0; j < 8; ++j) ev[u2][hf][j] = *(const GAS f32x4*)(vr + (size_t)j * D + hf * 64); }
#pragma unroll
        for (int u2 = 0; u2 < 2; ++u2) { const pg8::bf16x8 pf = *(LAS const pg8::bf16x8*)(P + fr * 1056 + (wid + (i + u2) * NWAVES) * 32 + fq * 8);
#pragma unroll
            for (int hf = 0; hf < 2; ++hf)
#pragma unroll
                for (int c = 0; c < 4; ++c) { v4u w; w.x = pk2(ev[u2][hf][0][c], ev[u2][hf][1][c]); w.y = pk2(ev[u2][hf][2][c], ev[u2][hf][3][c]); w.z = pk2(ev[u2][hf][4][c], ev[u2][hf][5][c]); w.w = pk2(ev[u2][hf][6][c], ev[u2][hf][7][c]);
                    oacc[hf * 4 + c] = __builtin_amdgcn_mfma_f32_16x16x32_bf16(__builtin_bit_cast(pg8::bf16x8, w), pf, oacc[hf * 4 + c], 0, 0, 0); } }
    }
    if (wid == 0) { const int kq = L + fq * 8; const pg8::bf16x8 pf = *(LAS const pg8::bf16x8*)(P + fr * 1056 + kq);
        const bool ok = fq < 2; const bf16* vr = VNp + (size_t)(ok ? (kq - L) : 0) * HD + 4 * fr;
#pragma unroll
        for (int hf = 0; hf < 2; ++hf)
#pragma unroll
            for (int c = 0; c < 4; ++c) { unsigned e[8];
#pragma unroll
                for (int j = 0; j < 8; ++j) e[j] = ok ? (unsigned)vr[(size_t)j * HD + hf * 64 + c] : 0u;
                v4u w; w.x = e[0] | (e[1] << 16); w.y = e[2] | (e[3] << 16); w.z = e[4] | (e[5] << 16); w.w = e[6] | (e[7] << 16);
                oacc[hf * 4 + c] = __builtin_amdgcn_mfma_f32_16x16x32_bf16(__builtin_bit_cast(pg8::bf16x8, w), pf, oacc[hf * 4 + c], 0, 0, 0); } }
    LAS float* PO = (LAS float*)lds;
#pragma unroll
    for (int hf = 0; hf < 2; ++hf)
#pragma unroll
        for (int r = 0; r < 4; ++r) *(LAS f32x4*)(PO + (wid * 16 + fr) * 128 + hf * 64 + 16 * fq + 4 * r) = (f32x4){oacc[hf * 4][r], oacc[hf * 4 + 1][r], oacc[hf * 4 + 2][r], oacc[hf * 4 + 3][r]};
    asm volatile("s_waitcnt lgkmcnt(0)" ::: "memory"); __syncthreads();
    { const int q = tid >> 5, d4 = (tid & 31) * 4; f32x4 s = *(LAS const f32x4*)(PO + q * 128 + d4);
#pragma unroll
      for (int w = 1; w < 8; ++w) { const f32x4 t = *(LAS const f32x4*)(PO + (w * 16 + q) * 128 + d4); s = s + t; }
      const float ri = RI[q];
      bf16* o = (bf16*)(ws + WS_OB) + ((size_t)MP + st * SN + q) * D + h * HD + d4;
      *(GAS unsigned long long*)o = (unsigned long long)pk2(s.x * ri, s.y * ri) | ((unsigned long long)pk2(s.z * ri, s.w * ri) << 32); }
    __syncthreads();
}

constexpr int N_PROMPT = NB * NH * 32, N_UNIT = SB * NH, N_POS = N_PROMPT + N_UNIT + N_SLICE;
static_assert(N_UNIT == N_SLICE && N_PROMPT >= 2 * N_UNIT, "ticket layout");
template <int MODE> __device__ __forceinline__ void pos_decode(int pos, int& kind, int& id) {
    if (pos < 4 * N_UNIT) { const int g = pos >> 2, r = pos & 3; if (r == 2) { kind = 1; id = g; } else if (r == 3) { kind = 2; id = g; } else { kind = 0; id = 2 * g + r; } }
    else { kind = 0; id = pos - 2 * N_UNIT; }
}
template <int MODE>
__device__ __forceinline__ void get_blk(int p, int li, unsigned char* ws, const float* rel, att::Blk& b) {
    bf16* QPp = (bf16*)(ws + WS_QP); bf16* KPp = (bf16*)(ws + WS_KP); bf16* VPp = (bf16*)(ws + WS_VP); bf16* OBp = (bf16*)(ws + WS_OB);
    int bh, qb;
    bh = p & 31; qb = 31 - (p >> 5);
    const int bb = bh >> 4, h = bh & 15;
    b.Q = QPp + ((size_t)bh * T + qb * 256) * HD; b.K = KPp + (size_t)bh * T * HD; b.V = VPp + (size_t)bh * T * HD; b.O = OBp + ((size_t)bb * T + qb * 256) * D + h * HD; b.P0 = qb * 256;
    if (MODE == 0) { b.aux = rel + (size_t)(li * NH + h) * NREL; b.c0 = qb * 4; b.jlo = b.c0 > 8 ? b.c0 - 8 : 0; b.jhi = b.c0 + 4; b.cap = 1 << 29; b.skipthr = __builtin_inff(); }
    else { b.aux = (const float*)(ws + WS_LFP) + (size_t)bh * T; b.c0 = 0; b.jlo = 0; b.jhi = 4 * (qb + 1); b.cap = qb * 256 + 255; b.skipthr = ((const float*)(ws + WS_QKM))[li]; }
}
__device__ __forceinline__ int take_ticket(gu32* qc, LAS unsigned char* lds, int tid) {
    volatile LAS int* w = (volatile LAS int*)(lds + 131008);
    if (tid == 0) *w = (int)__hip_atomic_fetch_add(qc, 1u, RLX_AGENT);
    __syncthreads();
    return __builtin_amdgcn_readfirstlane(*w);
}
template <int MODE>
__device__ __forceinline__ void attn_phase(LAS unsigned char* lds, int bx, int G, int layer, unsigned char* ws, const float* const __attribute__((address_space(4)))* in, const int tid) {
    att::Blk cur; att::Nxt nxt; att::Seam S;
    const int li = layer >> 1;
    const float* rel = in[12]; const float* kcache = in[MODE == 1 ? 4 : 2]; const float* vcache = in[MODE == 1 ? 5 : 3];
    gu32* qc = (gu32*)(ws + WS_CTL) + CW_QUEUE + 64 * layer;
    int pos = take_ticket(qc, lds, tid);
    while (pos < N_POS) {
        int kind, id; pos_decode<MODE>(pos, kind, id);
        if (kind != 0) {
            if (kind == 1) sample_attn<MODE>((LAS char*)lds, id, li, ws, rel, kcache, vcache, tid);
            else conv_slice(in, ws, layer + 1, id, lds, tid);
            pos = take_ticket(qc, lds, tid); continue; }
        get_blk<MODE>(id, li, ws, rel, cur);
        att::attn_prime<MODE>(cur, (LAS char*)lds, S, tid);
        for (;;) {
            int np = N_POS, id2 = 0; bool nf = false;
            int tk = 0;
            att::attn_block<MODE>(cur, [&]() { if (tid == 0) tk = (int)__hip_atomic_fetch_add(qc, 1u, RLX_AGENT); },
                [&](att::Nxt& nxt) {
                { volatile LAS int* w = (volatile LAS int*)(lds + 131008); if (tid == 0) *w = tk; __syncthreads(); np = __builtin_amdgcn_readfirstlane(*w); }
                int k2 = 3; if (np < N_POS) pos_decode<MODE>(np, k2, id2);
                nf = (k2 == 0);
                att::Blk nb; if (nf) { get_blk<MODE>(id2, li, ws, rel, nb); nxt.Q = nb.Q; nxt.K = nb.K; nxt.V = nb.V; nxt.jlo = nb.jlo; } else { nxt.Q = cur.Q; nxt.K = cur.K; nxt.V = cur.V; nxt.jlo = cur.jlo; }
            }, (LAS char*)lds, S, tid);
            pos = np;
            if (!nf) break;
            int id3 = id2; asm volatile("" : "+s"(id3));
            get_blk<MODE>(id3, li, ws, rel, cur);
        }
    }
}

struct Args { const float* in[19]; float* out; unsigned char* ws; int ph_lo, ph_hi; };
constexpr int PH_PER_LAYER = 5, N_PHASES = 1 + DEPTH * PH_PER_LAYER;

typedef const __attribute__((address_space(4))) Args CArgs;
#define PH_BEGIN() CArgs* A; { unsigned long long k_ = (unsigned long long)__builtin_amdgcn_kernarg_segment_ptr(); asm volatile("" : "+s"(k_)); A = (CArgs*)k_; } \
    unsigned char* const ws = A->ws; float* const out = A->out; int bx = blockIdx.x; asm volatile("" : "+s"(bx)); (void)ws; (void)out; (void)bx; \
    unsigned m1_ = ~0u; int ws_ = wave_s; asm volatile("" : "+s"(m1_), "+s"(ws_)); int tid = ws_ * 64 + (int)__builtin_amdgcn_mbcnt_hi(m1_, __builtin_amdgcn_mbcnt_lo(m1_, 0u)); asm volatile("" : "+v"(tid)); const int lane = tid & 63, wave = wave_s; (void)lane; (void)wave; \
    const int gw = bx * NWAVES + wave, NGW = G * NWAVES; const long gt = (long)bx * (NWAVES * 64) + tid, NGT = (long)G * (NWAVES * 64); (void)gw; (void)NGW; (void)gt; (void)NGT
__global__ void __launch_bounds__(NWAVES * 64, 2) fwd_kernel(Args args_unused) {
    extern __shared__ __attribute__((aligned(16))) unsigned char lds_raw[];
    LAS unsigned char* lds = (LAS unsigned char*)lds_raw;
    volatile LAS unsigned* MISC = (volatile LAS unsigned*)(lds + MISC_OFF);
    const int G = gridDim.x;
    const int wave_s = __builtin_amdgcn_readfirstlane((int)threadIdx.x >> 6);
    for (int u = threadIdx.x; u < (LDS_BYTES - LDSCTL_OFF) / 4; u += NWAVES * 64) ((LAS unsigned*)(lds + LDSCTL_OFF))[u] = 0u;
    __syncthreads();
    int lo, hi; XcdBarrier bar;
    { PH_BEGIN(); lo = A->ph_lo; hi = A->ph_hi; bar = xcd_barrier_post((unsigned*)((gu32*)(ws + WS_CTL) + CW_BAR), MISC + 8, tid == 0); }
#define IN(k) (lo <= (k) && (k) < hi)
#define SEAM(k) do { if (IN(k) && IN((k) + 1)) { XcdBarrier b2_ = bar; unsigned m2_ = ~0u; int w2_ = wave_s; asm volatile("" : "+s"(b2_.bar), "+s"(m2_), "+s"(w2_)); \
    xcd_barrier(b2_, w2_ == 0 && __builtin_amdgcn_mbcnt_hi(m2_, __builtin_amdgcn_mbcnt_lo(m2_, 0u)) == 0u); } } while (0)
#define P_WQKV ((bf16*)(ws + WS_WQKV))
#define P_WO ((bf16*)(ws + WS_WO))
#define P_WGU ((bf16*)(ws + WS_WGU))
#define P_WD ((bf16*)(ws + WS_WD))
#define P_XB ((bf16*)(ws + WS_XB))
#define P_SSQ ((float*)(ws + WS_SSQ))
#define P_QP ((bf16*)(ws + WS_QP))
#define P_KP ((bf16*)(ws + WS_KP))
#define P_VP ((bf16*)(ws + WS_VP))
#define P_QS ((bf16*)(ws + WS_QS))
#define P_OB ((bf16*)(ws + WS_OB))
#define P_HB ((bf16*)(ws + WS_HB))
#define P_LFP ((float*)(ws + WS_LFP))
#define P_LFS ((float*)(ws + WS_LFS))
#define P_KSN ((bf16*)(ws + WS_KSN))
#define P_VSN ((bf16*)(ws + WS_VSN))
#define P_WF ((bf16*)(ws + WS_WF))
#define P_X (out + O_Y)

    if (IN(0)) { PH_BEGIN();
        LAS float* scr = (LAS float*)(lds + RING_OFF + wave * 16384);
        for (int it = gw; it < conv_group_items(0); it += NGW) conv_item(A->in, ws, 0, it, scr, lane);
        for (int row = gw; row < M; row += NGW) {
            const float* xr = row < MP ? A->in[0] + (size_t)row * D : A->in[1] + (size_t)(row - MP) * D;
            row_update(xr, nullptr, nullptr, P_XB + (size_t)row * D, P_SSQ + (size_t)row * 32, lane);
        }
        for (long idx = gt; idx < 2L * NH * D; idx += NGT) { const int ib = (int)(idx >> 15), h = (int)((idx >> 11) & 15), k = (int)(idx & (D - 1));
            P_WF[idx] = (bf16)f2bf(A->in[7][(size_t)(2 * ib + 1) * D + k] * A->in[13][((size_t)ib * D + k) * NH + h]); }
        if (gw == 0) {
#pragma unroll 1
            for (int ib = 0; ib < 2; ++ib) { const float* gq = A->in[9] + (2 * ib + 1) * HD; const float* gk = A->in[10] + (2 * ib + 1) * HD;
                float mqk = fmaxf(fabsf(gq[lane] * gk[lane]), fabsf(gq[lane + 64] * gk[lane + 64]));
#pragma unroll
                for (int o = 1; o < 64; o <<= 1) mqk = fmaxf(mqk, __shfl_xor(mqk, o));
                if (lane == 0) ((float*)(ws + WS_QKM))[ib] = 11.313708499f * mqk * 1.02f + 40.0f; }
        }
    }
    SEAM(0);

#pragma unroll 1
    for (int layer = 0; layer < DEPTH; ++layer) {
        const int pb = 1 + layer * PH_PER_LAYER, li = layer >> 1; const bool fox = (layer & 1) != 0;
        if (IN(pb + 0)) { PH_BEGIN();
            if (fox) {
                const bf16* wfp = P_WF + (size_t)li * NH * D; const float* bfp = A->in[14] + li * NH;
                const int fr = lane & 15, fq = lane >> 4, lr = lane >> 2, lc = lane & 3, pidx = (((lane & 15) << 2) | (lane >> 4)) << 2;
                const int nidle = (G > 192) ? (G - 192) * NWAVES : NGW, gw0 = (G > 192) ? (bx - 192) * NWAVES + wave : gw;
                if (gw0 >= 0)
                for (int grp = gw0; grp < M / 16; grp += nidle) {
                    const int row = grp * 16 + fr;
                    const char* ap = (const char*)(P_XB + (size_t)(grp * 16 + lr) * D) + lc * 16; const char* bp = (const char*)(wfp + (size_t)lr * D) + lc * 16;
                    pg8::f32x4 acc = (pg8::f32x4){0.f, 0.f, 0.f, 0.f};
#pragma unroll 8
                    for (int ks = 0; ks < D / 32; ++ks) { pg8::u32x4 av = *(const pg8::u32x4*)(ap + ks * 64), bv = *(const pg8::u32x4*)(bp + ks * 64);
                        av.x = (unsigned)__builtin_amdgcn_ds_bpermute(pidx, (int)av.x); av.y = (unsigned)__builtin_amdgcn_ds_bpermute(pidx, (int)av.y); av.z = (unsigned)__builtin_amdgcn_ds_bpermute(pidx, (int)av.z); av.w = (unsigned)__builtin_amdgcn_ds_bpermute(pidx, (int)av.w);
                        bv.x = (unsigned)__builtin_amdgcn_ds_bpermute(pidx, (int)bv.x); bv.y = (unsigned)__builtin_amdgcn_ds_bpermute(pidx, (int)bv.y); bv.z = (unsigned)__builtin_amdgcn_ds_bpermute(pidx, (int)bv.z); bv.w = (unsigned)__builtin_amdgcn_ds_bpermute(pidx, (int)bv.w);
                        acc = __builtin_amdgcn_mfma_f32_16x16x32_bf16(__builtin_bit_cast(pg8::bf16x8, bv), __builtin_bit_cast(pg8::bf16x8, av), acc, 0, 0, 0); }
                    const float rs = pg8::row_rstd(P_SSQ, row, fq);
                    const pg8::f32x4 bb = *(const pg8::f32x4*)(bfp + 4 * fq); pg8::f32x4 lf;
#pragma unroll
                    for (int i = 0; i < 4; ++i) { const float z = acc[i] * rs + bb[i]; lf[i] = fminf(z, 0.f) - log1pf(expf(-fabsf(z))); }
                    if (row < MP) { *(pg8::f32x4*)(out + O_BFP + ((size_t)li * MP + row) * NH + 4 * fq) = lf;
#pragma unroll
                        for (int i = 0; i < 4; ++i) P_LFP[(size_t)((row >> 13) * NH + 4 * fq + i) * T + (row & (T - 1))] = lf[i]; }
                    else { const int rs2 = row - MP; *(pg8::f32x4*)(out + O_BFS + ((size_t)li * MS + rs2) * NH + 4 * fq) = lf;
#pragma unroll
                        for (int i = 0; i < 4; ++i) P_LFS[(size_t)((rs2 >> 4) * NH + 4 * fq + i) * LS + PAST + (rs2 & 15)] = lf[i]; }
                }
                const float* clf = A->in[6] + (size_t)li * SB * PAST * NH;
                for (long idx = gt; idx < (long)SB * NH * PAST; idx += NGT) { const int unit = (int)(idx >> 10), j = (int)(idx & 1023), st = unit >> 4, h = unit & 15;
                    P_LFS[(size_t)unit * LS + j] = clf[((size_t)st * PAST + j) * NH + h]; }
            }
            pg8::Gemm g{P_XB, P_WQKV + (size_t)layer * NQKV * D, MP, NQKV, D}; pg8::StaticOrder S; S.init(MP, NQKV, G, bx, 1, 0);
            pg8::EpiQKV E;
            E.ssq = P_SSQ; E.gq = A->in[9] + layer * HD; E.gk = A->in[10] + layer * HD; E.QP = P_QP; E.pstride = (WS_KP - WS_QP) / 2; E.QS = P_QS;
            E.srows = SN; E.lc = 0; E.KS = P_KSN; E.sstride = (WS_VSN - WS_KSN) / 2;
            E.okp = out + (fox ? O_BKP + (size_t)li * MP * D : O_AKP + (size_t)li * NB * WIN * D); E.opstride = fox ? SZ_BP : SZ_AP;
            E.oks = out + (fox ? O_BKS : O_AKS) + (size_t)li * MS * D; E.osstride = SZ_S;
            E.fox = fox ? 1 : 0; E.red = (LAS float*)(lds + RED_OFF);
            pg8::gemm_phase<pg8::EpiQKV, pg8::StaticOrder, true, true>(lds + RING_OFF, g, S, E, tid);
            __syncthreads();
            {
                sk::SkQKV K2; K2.ssq = P_SSQ + (size_t)MP * 32; K2.gq = A->in[9] + layer * HD; K2.gk = A->in[10] + layer * HD; K2.QS = P_QS;
                K2.srows = SN; K2.lc = 0; K2.KS = P_KSN; K2.sstride = (WS_VSN - WS_KSN) / 2;
                K2.oks = out + (fox ? O_BKS : O_AKS) + (size_t)li * MS * D; K2.osstride = SZ_S;
                sk::skinny_phase<sk::SkQKV>(lds + RING_OFF, P_XB + (size_t)MP * D, P_WQKV + (size_t)layer * NQKV * D, NQKV / 128, D, (unsigned*)((gu32*)(ws + WS_CTL) + CW_SKQ + 64 * (layer * 4 + 0)), tid, K2);
            }
        }
        SEAM(pb + 0);
        if (IN(pb + 1)) { PH_BEGIN();
            if (fox) attn_phase<1>(lds + RING_OFF, bx, G, layer, ws, A->in, tid);
            else attn_phase<0>(lds + RING_OFF, bx, G, layer, ws, A->in, tid);
        }
        SEAM(pb + 1);
        if (IN(pb + 2)) { PH_BEGIN();
            pg8::Gemm g{P_OB, P_WO + (size_t)layer * D * D, MP, D, D}; pg8::StaticOrder S; S.init(MP, D, G, bx);
            pg8::EpiResid E;
            E.X = nullptr; E.XB = P_XB; E.ssq = P_SSQ;
            pg8::gemm_phase<pg8::EpiResid, pg8::StaticOrder, true, true>(lds + RING_OFF, g, S, E, tid);
            __syncthreads();
            {   sk::SkResid K2; K2.xin = (layer == 0) ? A->in[1] : P_X + (size_t)MP * D; K2.X = P_X + (size_t)MP * D; K2.XB = P_XB + (size_t)MP * D; K2.ssq = P_SSQ + (size_t)MP * 32;
                sk::skinny_phase<sk::SkResid>(lds + RING_OFF, P_OB + (size_t)MP * D, P_WO + (size_t)layer * D * D, D / 64, D, (unsigned*)((gu32*)(ws + WS_CTL) + CW_SKQ + 64 * (layer * 4 + 1)), tid, K2); }
        }
        SEAM(pb + 2);
        if (IN(pb + 3)) { PH_BEGIN();
            pg8::Gemm g{P_XB, P_WGU + (size_t)layer * NGU * D, MP, NGU, D}; pg8::StaticOrder S; S.init(MP, NGU, G, bx, 0, 1);
            pg8::EpiSwiglu E{P_HB, FF, P_SSQ};
            pg8::gemm_phase<pg8::EpiSwiglu, pg8::StaticOrder, true, true>(lds + RING_OFF, g, S, E, tid);
            __syncthreads();
            {   sk::SkSwiglu K2{P_HB + (size_t)MP * FF, FF, P_SSQ + (size_t)MP * 32};
                sk::skinny_phase<sk::SkSwiglu>(lds + RING_OFF, P_XB + (size_t)MP * D, P_WGU + (size_t)layer * NGU * D, NGU / 128, D, (unsigned*)((gu32*)(ws + WS_CTL) + CW_SKQ + 64 * (layer * 4 + 2)), tid, K2); }
        }
        SEAM(pb + 3);
        if (IN(pb + 4)) { PH_BEGIN();
            pg8::Gemm g{P_HB, P_WD + (size_t)layer * D * FF, MP, D, FF}; pg8::StaticOrder S; S.init(MP, D, G, bx);
            pg8::EpiResid E;
            E.X = (layer == DEPTH - 1) ? P_X : nullptr; E.XB = P_XB; E.ssq = P_SSQ;
            pg8::gemm_phase<pg8::EpiResid, pg8::StaticOrder, true, true>(lds + RING_OFF, g, S, E, tid);
            __syncthreads();
            {   sk::SkResid K2; K2.xin = P_X + (size_t)MP * D; K2.X = P_X + (size_t)MP * D; K2.XB = P_XB + (size_t)MP * D; K2.ssq = P_SSQ + (size_t)MP * 32;
                sk::skinny_phase<sk::SkResid>(lds + RING_OFF, P_HB + (size_t)MP * FF, P_WD + (size_t)layer * D * FF, D / 64, FF, (unsigned*)((gu32*)(ws + WS_CTL) + CW_SKQ + 64 * (layer * 4 + 3)), tid, K2); }
        }
        SEAM(pb + 4);
    }
#undef IN
#undef SEAM
}

#ifndef MK_SPLIT
#define MK_SPLIT 0
#endif
extern "C" void kernel_launch(void* const* d_in, const int* in_sizes, int n_in, void* d_out, int out_size, void* d_ws, size_t ws_size, hipStream_t stream) {
    static int grid = 0;
    if (grid == 0) {
        if (n_in != 19 || in_sizes[0] != MP * D || (size_t)out_size != OUT_TOTAL || ws_size < WS_END) { fprintf(stderr, "kernel_launch: shape mismatch (n_in %d in0 %d out %d ws %zu); nothing launched\n", n_in, n_in > 0 ? in_sizes[0] : -1, out_size, ws_size); grid = -1; return; }
        int dev = 0, cus = 0;
        if (hipGetDevice(&dev) != hipSuccess || hipDeviceGetAttribute(&cus, hipDeviceAttributeMultiprocessorCount, dev) != hipSuccess) { grid = -1; return; }
        if (hipFuncSetAttribute((const void*)fwd_kernel, hipFuncAttributeMaxDynamicSharedMemorySize, LDS_BYTES) != hipSuccess) { fprintf(stderr, "kernel_launch: hipFuncSetAttribute failed\n"); grid = -1; return; }
        int per_cu = 0;
        if (hipOccupancyMaxActiveBlocksPerMultiprocessor(&per_cu, (const void*)fwd_kernel, NWAVES * 64, LDS_BYTES) != hipSuccess || per_cu < 1) fprintf(stderr, "kernel_launch: occupancy query reports %d\n", per_cu);
        (void)hipGetLastError();
        grid = cus;
    }
    if (grid < 0) return;
    if (hipMemsetAsync((char*)d_ws + WS_CTL, 0, CTL_ZERO_BYTES, stream) != hipSuccess) return;
    Args a{};
    for (int i = 0; i < 19; ++i) a.in[i] = (const float*)d_in[i];
    a.out = (float*)d_out; a.ws = (unsigned char*)d_ws;
#if MK_SPLIT
    for (int p = 0; p < N_PHASES; ++p) { a.ph_lo = p; a.ph_hi = p + 1; hipLaunchKernelGGL(fwd_kernel, dim3(grid), dim3(NWAVES * 64), LDS_BYTES, stream, a); }
#else
    a.ph_lo = 0; a.ph_hi = N_PHASES;
    hipLaunchKernelGGL(fwd_kernel, dim3(grid), dim3(NWAVES * 64), LDS_BYTES, stream, a);
#endif
}
```
